# Optimizing an MI355X kernel written in HIP

```python
import jax, jax.numpy as jnp
from jax import lax
import numpy as np

D_MODEL = 1024
BATCH = 16
SEQ = 2048
DEPTH = 1
DEC_BATCH = 8
DEC_SEQ = 64
PAST_LEN = 2048

CHUNK = 64
QUERY_BLOCK = 128
MIX_WIDTH = D_MODEL
RET_HEADS = 4
RET_HEAD_DIM = MIX_WIDTH // 2 // RET_HEADS
RET_WIDTH = RET_HEADS * RET_HEAD_DIM
RET_ROPE_THETA = 10000.0
ATT_HEADS = 8
ATT_HEAD_DIM = (MIX_WIDTH - RET_WIDTH) // ATT_HEADS
ATT_WIDTH = ATT_HEADS * ATT_HEAD_DIM
ATT_KV_HEADS = 2
ATT_ROT_DIM = ATT_HEAD_DIM // 4
ATT_ROPE_THETA = 500000.0
IDX_HEADS = 8
IDX_DIM = 64
IDX_ROT_DIM = IDX_DIM // 4
MAX_TOPK = 256
NORM_EPS = 1e-6
SPLIT_SIZES = (RET_WIDTH, RET_WIDTH, RET_WIDTH, RET_WIDTH,
               ATT_WIDTH, ATT_KV_HEADS * ATT_HEAD_DIM, ATT_KV_HEADS * ATT_HEAD_DIM, ATT_WIDTH,
               IDX_HEADS * IDX_DIM, IDX_DIM, IDX_HEADS)
D_IN = sum(SPLIT_SIZES)
SPLIT_POINTS = tuple(sum(SPLIT_SIZES[:i + 1]) for i in range(len(SPLIT_SIZES) - 1))

kernel_name = "hybrid_retention_dsa_stream_step"


def rmsnorm(x, g):
    xf = x.astype(jnp.float32)
    r = lax.rsqrt(jnp.mean(xf * xf, axis=-1, keepdims=True) + NORM_EPS)
    return (xf * r).astype(x.dtype) * g


def rope(x, pos, rot_dim, theta):
    half = rot_dim // 2
    inv = jnp.power(theta, -jnp.arange(half, dtype=jnp.float32) / half)
    ang = pos.astype(jnp.float32)[:, None] * inv[None, :]
    cos = jnp.cos(ang)[None, :, None, :].astype(x.dtype)
    sin = jnp.sin(ang)[None, :, None, :].astype(x.dtype)
    x1 = x[..., :half]
    x2 = x[..., half:rot_dim]
    return jnp.concatenate([x1 * cos - x2 * sin, x2 * cos + x1 * sin, x[..., rot_dim:]], axis=-1)


def retention(q, k, v, s0):
    b, t, h, dk = q.shape
    dv = v.shape[-1]
    c = min(t, CHUNK)
    nc = t // c
    log_gamma = jnp.log1p(-jnp.exp2(-5.0 - jnp.arange(h, dtype=jnp.float32)))
    n = jnp.arange(c, dtype=jnp.float32)
    intra = jnp.exp(log_gamma[:, None, None] * jnp.abs(n[:, None] - n[None, :])).astype(q.dtype)
    to_end = jnp.exp(log_gamma[None, :] * (c - 1.0 - n)[:, None]).astype(q.dtype)
    from_start = jnp.exp(log_gamma[None, :] * (n + 1.0)[:, None]).astype(q.dtype)
    chunk_decay = jnp.exp(log_gamma * c)
    qc = q.reshape(b, nc, c, h, dk)
    kc = k.reshape(b, nc, c, h, dk)
    vc = v.reshape(b, nc, c, h, dv)
    scores = jnp.einsum('bcnhd,bcmhd->bchnm', qc, kc) * intra
    out = jnp.einsum('bchnm,bcmhe->bcnhe', scores, vc)
    kv = jnp.einsum('bcmhd,bcmhe->cbhde', kc * to_end[:, :, None], vc).astype(jnp.float32)

    def step(s, kv_c):
        return s * chunk_decay[None, :, None, None] + kv_c, s

    s_final, s_prev = lax.scan(step, s0.astype(jnp.float32), kv)
    out = out + jnp.einsum('bcnhd,cbhde->bcnhe', qc * from_start[:, :, None], s_prev.astype(q.dtype))
    return out.reshape(b, t, h, dv), s_final.astype(q.dtype)


def dsa_attend(q, qi, wi, qpos, k, v, ki, kpos, topk):
    b, nq, _, hd = q.shape
    logits = jax.nn.relu(jnp.einsum('bqhd,bld->bqhl', qi, ki))
    index = jnp.einsum('bqhl,bqh->bql', logits, wi).astype(jnp.float32)
    admissible = (kpos // CHUNK)[None, :] <= (qpos // CHUNK)[:, None]
    index = jnp.where(admissible[None], index, -jnp.inf)
    top_val, sel = lax.top_k(index, topk)
    valid = jnp.isfinite(top_val)
    gather = jax.vmap(lambda rows, idx: rows[idx])
    kg = gather(k, sel)
    vg = gather(v, sel)
    qg = q.reshape(b, nq, ATT_KV_HEADS, ATT_HEADS // ATT_KV_HEADS, hd)
    s = jnp.einsum('bqkgd,bqnkd->bqkgn', qg, kg).astype(jnp.float32) * (hd ** -0.5)
    s = jnp.where(valid[:, :, None, None, :], s, -jnp.inf)
    p = jax.nn.softmax(s, axis=-1).astype(v.dtype)
    o = jnp.einsum('bqkgn,bqnkd->bqkgd', p, vg)
    return o.reshape(b, nq, ATT_WIDTH)


def mixer_layer(x, pos, ret_state, past_k, past_v, past_ki, norm_g, w_in, ret_gn_g, w_out):
    b, t, _ = x.shape
    h = rmsnorm(x, norm_g)
    proj = jnp.einsum('btd,de->bte', h, w_in)
    rq, rk, rv, rg, aq, ak, av, ag, iq, ik, iw = jnp.split(proj, SPLIT_POINTS, axis=-1)

    rq = rope(rq.reshape(b, t, RET_HEADS, RET_HEAD_DIM), pos, RET_HEAD_DIM, RET_ROPE_THETA)
    rk = rope(rk.reshape(b, t, RET_HEADS, RET_HEAD_DIM), pos, RET_HEAD_DIM, RET_ROPE_THETA) * (RET_HEAD_DIM ** -0.5)
    rv = rv.reshape(b, t, RET_HEADS, RET_HEAD_DIM)
    ro, new_ret = retention(rq, rk, rv, ret_state)
    ro = rmsnorm(ro, ret_gn_g.reshape(RET_HEADS, RET_HEAD_DIM)).reshape(b, t, RET_WIDTH) * jax.nn.silu(rg)

    aq = rope(aq.reshape(b, t, ATT_HEADS, ATT_HEAD_DIM), pos, ATT_ROT_DIM, ATT_ROPE_THETA)
    ak = rope(ak.reshape(b, t, ATT_KV_HEADS, ATT_HEAD_DIM), pos, ATT_ROT_DIM, ATT_ROPE_THETA)
    av = av.reshape(b, t, ATT_KV_HEADS, ATT_HEAD_DIM)
    iq = rope(iq.reshape(b, t, IDX_HEADS, IDX_DIM), pos, IDX_ROT_DIM, ATT_ROPE_THETA)
    ik = rope(ik.reshape(b, t, 1, IDX_DIM), pos, IDX_ROT_DIM, ATT_ROPE_THETA)[:, :, 0]
    iw = iw * (IDX_HEADS ** -0.5 * IDX_DIM ** -0.5)

    if past_k is None:
        n_keys = t
        topk = min(MAX_TOPK, n_keys // 4)
        nb = t // QUERY_BLOCK

        def blocks(a):
            return a.reshape((b, nb, QUERY_BLOCK) + a.shape[2:]).swapaxes(0, 1)

        def attend_block(args):
            qb, qib, wib, posb = args
            return dsa_attend(qb, qib, wib, posb, ak, av, ik, pos, topk)

        ao = lax.map(attend_block, (blocks(aq), blocks(iq), blocks(iw), pos.reshape(nb, QUERY_BLOCK)))
        ao = ao.swapaxes(0, 1).reshape(b, t, ATT_WIDTH)
    else:
        n_keys = past_k.shape[1] + t
        topk = min(MAX_TOPK, n_keys // 4)
        k_all = jnp.concatenate([past_k, ak], axis=1)
        v_all = jnp.concatenate([past_v, av], axis=1)
        ki_all = jnp.concatenate([past_ki, ik], axis=1)
        kpos = jnp.arange(n_keys, dtype=jnp.int32)
        ao = dsa_attend(aq, iq, iw, pos, k_all, v_all, ki_all, kpos, topk)
    ao = ao * jax.nn.silu(ag)

    mix = jnp.einsum('bte,ed->btd', jnp.concatenate([ro, ao], axis=-1), w_out)
    return x + mix, new_ret, ak, av, ik


def setup_inputs(seed: int = 0) -> dict:
    key = jax.random.key(seed)
    ks = jax.random.split(key, 11)
    f32 = jnp.float32
    return {
        'x_prompt': jax.random.normal(ks[0], (BATCH, SEQ, D_MODEL), f32),
        'x_sample': jax.random.normal(ks[1], (DEC_BATCH, DEC_SEQ, D_MODEL), f32),
        'state_ret': 0.05 * jax.random.normal(ks[2], (DEPTH, DEC_BATCH, RET_HEADS, RET_HEAD_DIM, RET_HEAD_DIM), f32),
        'cache_k': jax.random.normal(ks[3], (DEPTH, DEC_BATCH, PAST_LEN, ATT_KV_HEADS, ATT_HEAD_DIM), f32),
        'cache_v': jax.random.normal(ks[4], (DEPTH, DEC_BATCH, PAST_LEN, ATT_KV_HEADS, ATT_HEAD_DIM), f32),
        'cache_kidx': jax.random.normal(ks[5], (DEPTH, DEC_BATCH, PAST_LEN, IDX_DIM), f32),
        'norm_g': 1.0 + 0.05 * jax.random.normal(ks[6], (DEPTH, D_MODEL), f32),
        'w_in': jax.random.normal(ks[7], (DEPTH, D_MODEL, D_IN), f32) * (D_MODEL ** -0.5),
        'ret_gn_g': 1.0 + 0.05 * jax.random.normal(ks[8], (DEPTH, RET_WIDTH), f32),
        'w_out': jax.random.normal(ks[9], (DEPTH, MIX_WIDTH, D_MODEL), f32) * (MIX_WIDTH ** -0.5),
        'final_g': 1.0 + 0.05 * jax.random.normal(ks[10], (D_MODEL,), f32),
    }


def reference(x_prompt, x_sample, state_ret, cache_k, cache_v, cache_kidx, norm_g, w_in, ret_gn_g, w_out, final_g):
    pos_p = jnp.arange(x_prompt.shape[1], dtype=jnp.int32)
    pos_s = PAST_LEN + jnp.arange(x_sample.shape[1], dtype=jnp.int32)
    xp = x_prompt
    xs = x_sample
    ret_p, k_p, v_p, ki_p = [], [], [], []
    ret_s, k_s, v_s, ki_s = [], [], [], []
    for l in range(DEPTH):
        zero_state = jnp.zeros((xp.shape[0], RET_HEADS, RET_HEAD_DIM, RET_HEAD_DIM), xp.dtype)
        xp, sp, kp, vp, ip = mixer_layer(xp, pos_p, zero_state, None, None, None,
                                         norm_g[l], w_in[l], ret_gn_g[l], w_out[l])
        xs, ss, kss, vss, iss = mixer_layer(xs, pos_s, state_ret[l], cache_k[l], cache_v[l], cache_kidx[l],
                                            norm_g[l], w_in[l], ret_gn_g[l], w_out[l])
        ret_p.append(sp); k_p.append(kp); v_p.append(vp); ki_p.append(ip)
        ret_s.append(ss); k_s.append(kss); v_s.append(vss); ki_s.append(iss)
    y_prompt = rmsnorm(xp, final_g)
    y_sample = rmsnorm(xs, final_g)
    return (y_prompt, y_sample,
            jnp.stack(ret_p), jnp.stack(k_p), jnp.stack(v_p), jnp.stack(ki_p),
            jnp.stack(ret_s), jnp.stack(k_s), jnp.stack(v_s), jnp.stack(ki_s))
```

```cpp
#include <hip/hip_runtime.h>
#include <hip/hip_cooperative_groups.h>
#include <stdint.h>
#include <cstdio>
namespace cg = cooperative_groups;

typedef __attribute__((ext_vector_type(8))) short bf16x8;
typedef __attribute__((ext_vector_type(4))) short s16x4;
typedef __attribute__((ext_vector_type(16))) float f32x16;
typedef __attribute__((ext_vector_type(4))) float f32x4;
typedef unsigned short u16;
typedef unsigned long long u64;

#define DI __device__ __forceinline__
#define MFMA32(a, b, c) __builtin_amdgcn_mfma_f32_32x32x16_bf16((a), (b), (c), 0, 0, 0)
#define MFMA16(a, b, c) __builtin_amdgcn_mfma_f32_16x16x32_bf16((a), (b), (c), 0, 0, 0)

#define NTOK 33280
#define NPROMPT 32768
#define LDS_BYTES 67712
#define KPITCH 2116

struct Params {
  const float *x_p, *x_s, *state_ret, *cache_k, *cache_v, *cache_kidx, *norm_g, *w_in, *ret_gn_g, *w_out, *final_g;
  float* out;
  u16 *xb, *WtIn, *WtOut, *qr, *kr, *krT, *vrT, *gate, *qa, *qi, *kaP, *kaS, *vaTP, *vaTS, *kiP, *kiS, *sprevT;
  float *rinv, *wi, *kvT, *cosR, *sinR, *cosA, *sinA;
  u64* maskbits;
};

#define OUT_Y 0
#define OUT_STP (34078720)
#define OUT_KP (OUT_STP + 1048576)
#define OUT_VP (OUT_KP + 4194304)
#define OUT_KIP (OUT_VP + 4194304)
#define OUT_STS (OUT_KIP + 2097152)
#define OUT_KS (OUT_STS + 524288)
#define OUT_VS (OUT_KS + 65536)
#define OUT_KIS (OUT_VS + 65536)

DI u16 f2bf(float x) {
  unsigned u = __float_as_uint(x);
  u += 0x7fffu + ((u >> 16) & 1u);
  return (u16)(u >> 16);
}
DI bf16x8 ldg8(const u16* p) { return *(const bf16x8*)p; }
DI s16x4 ldg4(const u16* p) { return *(const s16x4*)p; }
DI float siluf(float x) { return x / (1.f + __expf(-x)); }
DI int crow(int reg, int hh) { return (reg & 3) + 8 * (reg >> 2) + 4 * hh; }
DI const float* xrow(const Params& p, int g) { return g < NPROMPT ? p.x_p + (size_t)g * 1024 : p.x_s + (size_t)(g - NPROMPT) * 1024; }
DI float log2gamma(int h) { return log1pf(-exp2f(-5.f - (float)h)) * 1.4426950408889634f; }
DI bf16x8 pack8(float a0, float a1, float a2, float a3, float a4, float a5, float a6, float a7) {
  bf16x8 v;
  v[0] = (short)f2bf(a0); v[1] = (short)f2bf(a1); v[2] = (short)f2bf(a2); v[3] = (short)f2bf(a3);
  v[4] = (short)f2bf(a4); v[5] = (short)f2bf(a5); v[6] = (short)f2bf(a6); v[7] = (short)f2bf(a7);
  return v;
}
DI f32x16 zero16() { f32x16 z; for (int i = 0; i < 16; ++i) z[i] = 0.f; return z; }

DI void phase_prep(const Params& p, int tid) {
  const int gt = blockIdx.x * 256 + tid, GT = gridDim.x * 256;
  const int lane = tid & 63;
  for (int row = gt >> 6; row < NTOK; row += (GT >> 6)) {
    const float* src = xrow(p, row);
    float ss = 0.f;
    f32x4 v[4];
#pragma unroll
    for (int i = 0; i < 4; ++i) { v[i] = *(const f32x4*)(src + i * 256 + lane * 4); ss += v[i][0] * v[i][0] + v[i][1] * v[i][1] + v[i][2] * v[i][2] + v[i][3] * v[i][3]; }
#pragma unroll
    for (int o = 32; o >= 1; o >>= 1) ss += __shfl_xor(ss, o);
#pragma unroll
    for (int i = 0; i < 4; ++i) {
      s16x4 o; o[0] = (short)f2bf(v[i][0]); o[1] = (short)f2bf(v[i][1]); o[2] = (short)f2bf(v[i][2]); o[3] = (short)f2bf(v[i][3]);
      *(s16x4*)(p.xb + (size_t)row * 1024 + i * 256 + lane * 4) = o;
    }
    if (lane == 0) p.rinv[row] = rsqrtf(ss * (1.f / 1024.f) + 1e-6f);
  }
  for (int i = gt; i < 3968 * 128; i += GT) {
    int n = i % 3968, kg = i / 3968;
    float a[8];
#pragma unroll
    for (int j = 0; j < 8; ++j) a[j] = (n < 3912) ? p.w_in[(size_t)(kg * 8 + j) * 3912 + n] * p.norm_g[kg * 8 + j] : 0.f;
    *(bf16x8*)(p.WtIn + (size_t)n * 1024 + kg * 8) = pack8(a[0], a[1], a[2], a[3], a[4], a[5], a[6], a[7]);
  }
  for (int i = gt; i < 1024 * 128; i += GT) {
    int n = i % 1024, kg = i / 1024;
    float a[8];
#pragma unroll
    for (int j = 0; j < 8; ++j) a[j] = p.w_out[(size_t)(kg * 8 + j) * 1024 + n];
    *(bf16x8*)(p.WtOut + (size_t)n * 1024 + kg * 8) = pack8(a[0], a[1], a[2], a[3], a[4], a[5], a[6], a[7]);
  }
  for (int i = gt; i < 2112 * 64; i += GT) {
    int pos = i >> 6, k = i & 63;
    float inv = powf(10000.f, -(float)k / 64.f);
    float ang = (float)pos * inv;
    p.cosR[i] = cosf(ang); p.sinR[i] = sinf(ang);
  }
  for (int i = gt; i < 2112 * 8; i += GT) {
    int pos = i >> 3, k = i & 7;
    float inv = powf(500000.f, -(float)k / 8.f);
    float ang = (float)pos * inv;
    p.cosA[i] = cosf(ang); p.sinA[i] = sinf(ang);
  }
  for (int i = gt; i < 8 * 2048 * 2 * 8; i += GT) {
    int dg = i & 7, kvh = (i >> 3) & 1, t = (i >> 4) & 2047, b = i >> 15;
    const float* s = p.cache_k + ((size_t)(b * 2048 + t) * 2 + kvh) * 64 + dg * 8;
    *(bf16x8*)(p.kaS + ((size_t)(b * 2 + kvh) * 2112 + t) * 64 + dg * 8) = pack8(s[0], s[1], s[2], s[3], s[4], s[5], s[6], s[7]);
  }
  for (int i = gt; i < 8 * 2 * 256 * 64; i += GT) {
    int d = i & 63, tg = (i >> 6) & 255, kvh = (i >> 14) & 1, b = i >> 15;
    float a[8];
#pragma unroll
    for (int j = 0; j < 8; ++j) a[j] = p.cache_v[((size_t)(b * 2048 + tg * 8 + j) * 2 + kvh) * 64 + d];
    *(bf16x8*)(p.vaTS + ((size_t)(b * 2 + kvh) * 64 + d) * 2112 + tg * 8) = pack8(a[0], a[1], a[2], a[3], a[4], a[5], a[6], a[7]);
  }
  for (int i = gt; i < 8 * 2048 * 8; i += GT) {
    int dg = i & 7, t = (i >> 3) & 2047, b = i >> 14;
    const float* s = p.cache_kidx + (size_t)(b * 2048 + t) * 64 + dg * 8;
    *(bf16x8*)(p.kiS + ((size_t)b * 2112 + t) * 64 + dg * 8) = pack8(s[0], s[1], s[2], s[3], s[4], s[5], s[6], s[7]);
  }
}

DI void gemm_core(const u16* __restrict__ A, const u16* __restrict__ B, u16* lds, f32x16 (&acc)[2][2], int tid) {
  const int lane = tid & 63, w = tid >> 6, wm = w & 1, wn = w >> 1, r = lane & 31, hh = lane >> 5;
  u16* As = lds;
  u16* Bs = lds + 2 * 5120;
  const int row0 = tid >> 2, cc = tid & 3;
  const u16* ga = A + (size_t)row0 * 1024 + cc * 8;
  const u16* gb = B + (size_t)row0 * 1024 + cc * 8;
  const int lo = row0 * 40 + cc * 8;
  bf16x8 ra0 = ldg8(ga), ra1 = ldg8(ga + 64 * 1024), rb0 = ldg8(gb), rb1 = ldg8(gb + 64 * 1024);
  *(bf16x8*)(As + lo) = ra0; *(bf16x8*)(As + lo + 64 * 40) = ra1;
  *(bf16x8*)(Bs + lo) = rb0; *(bf16x8*)(Bs + lo + 64 * 40) = rb1;
  __syncthreads();
  for (int kt = 0; kt < 32; ++kt) {
    if (kt < 31) {
      ra0 = ldg8(ga + (kt + 1) * 32); ra1 = ldg8(ga + 64 * 1024 + (kt + 1) * 32);
      rb0 = ldg8(gb + (kt + 1) * 32); rb1 = ldg8(gb + 64 * 1024 + (kt + 1) * 32);
    }
    const u16* as = As + (kt & 1) * 5120;
    const u16* bs = Bs + (kt & 1) * 5120;
#pragma unroll
    for (int ks = 0; ks < 2; ++ks) {
      bf16x8 a0 = *(const bf16x8*)(as + (wm * 64 + r) * 40 + ks * 16 + hh * 8);
      bf16x8 a1 = *(const bf16x8*)(as + (wm * 64 + 32 + r) * 40 + ks * 16 + hh * 8);
      bf16x8 b0 = *(const bf16x8*)(bs + (wn * 64 + r) * 40 + ks * 16 + hh * 8);
      bf16x8 b1 = *(const bf16x8*)(bs + (wn * 64 + 32 + r) * 40 + ks * 16 + hh * 8);
      acc[0][0] = MFMA32(a0, b0, acc[0][0]);
      acc[0][1] = MFMA32(a0, b1, acc[0][1]);
      acc[1][0] = MFMA32(a1, b0, acc[1][0]);
      acc[1][1] = MFMA32(a1, b1, acc[1][1]);
    }
    if (kt < 31) {
      u16* as2 = As + ((kt + 1) & 1) * 5120;
      u16* bs2 = Bs + ((kt + 1) & 1) * 5120;
      *(bf16x8*)(as2 + lo) = ra0; *(bf16x8*)(as2 + lo + 64 * 40) = ra1;
      *(bf16x8*)(bs2 + lo) = rb0; *(bf16x8*)(bs2 + lo + 64 * 40) = rb1;
    }
    __syncthreads();
  }
}

struct TileCtx {
  const float* st; const float* rinv; int m0; bool samp; int b0; int t0;
};
DI void tok_info(const TileCtx& c, int row, int& b, int& t, int& pos) {
  if (!c.samp) { b = c.b0; t = c.t0 + row; pos = t; }
  else { b = c.b0 + (row >> 6); t = row & 63; pos = 2048 + t; }
}
DI float val_plain(const TileCtx& c, int row, int col) { return c.st[row * 132 + col] * c.rinv[c.m0 + row]; }
DI float val_rope_ret(const Params& p, const TileCtx& c, int row, int col, int pos) {
  float x = c.st[row * 132 + col], xp = c.st[row * 132 + (col ^ 64)];
  int i = col & 63;
  float cs = p.cosR[pos * 64 + i], sn = p.sinR[pos * 64 + i];
  float o = (col < 64) ? x * cs - xp * sn : x * cs + xp * sn;
  return o * c.rinv[c.m0 + row];
}
DI float val_rope_att(const Params& p, const TileCtx& c, int row, int col, int pos) {
  float x = c.st[row * 132 + col];
  int d = col & 63;
  float o = x;
  if (d < 16) {
    float xp = c.st[row * 132 + (col ^ 8)];
    int i = d & 7;
    float cs = p.cosA[pos * 8 + i], sn = p.sinA[pos * 8 + i];
    o = (d < 8) ? x * cs - xp * sn : x * cs + xp * sn;
  }
  return o * c.rinv[c.m0 + row];
}

DI void phase_gemm1(const Params& p, unsigned char* lds, int tid) {
  const int lane = tid & 63, w = tid >> 6, wm = w & 1, wn = w >> 1, r = lane & 31, hh = lane >> 5;
  float* st = (float*)lds;
  for (int tile = blockIdx.x; tile < 260 * 31; tile += gridDim.x) {
    const int mt = tile / 31, nt = tile % 31;
    const int m0 = mt * 128, n0 = nt * 128;
    f32x16 acc[2][2];
    acc[0][0] = zero16(); acc[0][1] = zero16(); acc[1][0] = zero16(); acc[1][1] = zero16();
    gemm_core(p.xb + (size_t)m0 * 1024, p.WtIn + (size_t)n0 * 1024, (u16*)lds, acc, tid);
#pragma unroll
    for (int a = 0; a < 2; ++a)
#pragma unroll
      for (int b = 0; b < 2; ++b)
#pragma unroll
        for (int i = 0; i < 16; ++i)
          st[(wm * 64 + a * 32 + crow(i, hh)) * 132 + wn * 64 + b * 32 + r] = acc[a][b][i];
    __syncthreads();
    TileCtx c;
    c.st = st; c.rinv = p.rinv; c.m0 = m0; c.samp = (m0 >= NPROMPT);
    if (!c.samp) { c.b0 = m0 >> 11; c.t0 = m0 & 2047; } else { c.b0 = (m0 - NPROMPT) >> 6; c.t0 = 0; }
    if (!(nt >= 8 && nt < 12)) {
      for (int it = 0; it < 8; ++it) {
        const int row = it * 16 + (tid >> 4), cg0 = (tid & 15) * 8;
        const int g = m0 + row;
        int b, t, pos; tok_info(c, row, b, t, pos);
        float v[8];
        if (nt < 8) {
#pragma unroll
          for (int j = 0; j < 8; ++j) v[j] = val_rope_ret(p, c, row, cg0 + j, pos);
          if (nt >= 4) {
#pragma unroll
            for (int j = 0; j < 8; ++j) v[j] *= 0.08838834764831845f;
          }
          u16* dst = (nt < 4 ? p.qr : p.kr) + (size_t)g * 512 + (nt & 3) * 128 + cg0;
          *(bf16x8*)dst = pack8(v[0], v[1], v[2], v[3], v[4], v[5], v[6], v[7]);
        } else if ((nt >= 12 && nt < 16) || (nt >= 22 && nt < 26)) {
#pragma unroll
          for (int j = 0; j < 8; ++j) v[j] = siluf(val_plain(c, row, cg0 + j));
          const int colbase = (nt < 16) ? (nt - 12) * 128 : 512 + (nt - 22) * 128;
          *(bf16x8*)(p.gate + (size_t)g * 1024 + colbase + cg0) = pack8(v[0], v[1], v[2], v[3], v[4], v[5], v[6], v[7]);
        } else if (nt >= 16 && nt < 20) {
#pragma unroll
          for (int j = 0; j < 8; ++j) v[j] = val_rope_att(p, c, row, cg0 + j, pos) * (0.125f * 1.4426950408889634f);
          *(bf16x8*)(p.qa + (size_t)g * 512 + (nt - 16) * 128 + cg0) = pack8(v[0], v[1], v[2], v[3], v[4], v[5], v[6], v[7]);
        } else if (nt >= 26 && nt < 30) {
#pragma unroll
          for (int j = 0; j < 8; ++j) v[j] = val_rope_att(p, c, row, cg0 + j, pos);
          *(bf16x8*)(p.qi + (size_t)g * 512 + (nt - 26) * 128 + cg0) = pack8(v[0], v[1], v[2], v[3], v[4], v[5], v[6], v[7]);
        } else if (nt == 20 || nt == 21) {
          if (nt == 20) {
#pragma unroll
            for (int j = 0; j < 8; ++j) v[j] = val_rope_att(p, c, row, cg0 + j, pos);
          } else {
#pragma unroll
            for (int j = 0; j < 8; ++j) v[j] = val_plain(c, row, cg0 + j);
          }
          float* o;
          if (!c.samp) o = p.out + (nt == 20 ? OUT_KP : OUT_VP) + (size_t)g * 128 + cg0;
          else o = p.out + (nt == 20 ? OUT_KS : OUT_VS) + (size_t)(g - NPROMPT) * 128 + cg0;
          f32x4 o0 = {v[0], v[1], v[2], v[3]}, o1 = {v[4], v[5], v[6], v[7]};
          *(f32x4*)o = o0; *(f32x4*)(o + 4) = o1;
          if (nt == 20) {
            const int kvh = cg0 >> 6, d = cg0 & 63;
            u16* dst = c.samp ? p.kaS + ((size_t)(b * 2 + kvh) * 2112 + 2048 + t) * 64 + d
                              : p.kaP + ((size_t)(b * 2 + kvh) * 2048 + t) * 64 + d;
            *(bf16x8*)dst = pack8(v[0], v[1], v[2], v[3], v[4], v[5], v[6], v[7]);
          }
        } else {
          if (cg0 < 64) {
#pragma unroll
            for (int j = 0; j < 8; ++j) v[j] = val_rope_att(p, c, row, cg0 + j, pos);
            float* o = c.samp ? p.out + OUT_KIS + (size_t)(g - NPROMPT) * 64 + cg0 : p.out + OUT_KIP + (size_t)g * 64 + cg0;
            f32x4 o0 = {v[0], v[1], v[2], v[3]}, o1 = {v[4], v[5], v[6], v[7]};
            *(f32x4*)o = o0; *(f32x4*)(o + 4) = o1;
            u16* dst = c.samp ? p.kiS + ((size_t)b * 2112 + 2048 + t) * 64 + cg0 : p.kiP + ((size_t)b * 2048 + t) * 64 + cg0;
            *(bf16x8*)dst = pack8(v[0], v[1], v[2], v[3], v[4], v[5], v[6], v[7]);
          } else if (cg0 == 64) {
            float* o = p.wi + (size_t)g * 8;
#pragma unroll
            for (int j = 0; j < 8; ++j) o[j] = val_plain(c, row, 64 + j) * 0.044194173824159216f;
          }
        }
      }
    }
    if ((nt >= 4 && nt < 12) || nt == 21) {
      const int h = nt & 3;
      const float l2g = log2gamma(h);
      for (int it = 0; it < 8; ++it) {
        const int f = it * 16 + (tid >> 4), tg = tid & 15;
        float v[8];
#pragma unroll
        for (int j = 0; j < 8; ++j) {
          const int row = tg * 8 + j;
          if (nt < 8) {
            int b, t, pos; tok_info(c, row, b, t, pos);
            v[j] = val_rope_ret(p, c, row, f, pos) * 0.08838834764831845f * exp2f((float)(63 - (t & 63)) * l2g);
          } else v[j] = val_plain(c, row, f);
        }
        int b, t, pos; tok_info(c, tg * 8, b, t, pos);
        u16* dst;
        if (nt < 12) {
          u16* base = (nt < 8) ? p.krT : p.vrT;
          dst = c.samp ? base + (size_t)64 * 128 * 2048 + ((size_t)(b * 4 + h) * 128 + f) * 64 + t
                       : base + ((size_t)(b * 4 + h) * 128 + f) * 2048 + t;
        } else {
          const int kvh = f >> 6, d = f & 63;
          dst = c.samp ? p.vaTS + ((size_t)(b * 2 + kvh) * 64 + d) * 2112 + 2048 + t
                       : p.vaTP + ((size_t)(b * 2 + kvh) * 64 + d) * 2048 + t;
        }
        *(bf16x8*)dst = pack8(v[0], v[1], v[2], v[3], v[4], v[5], v[6], v[7]);
      }
    }
    __syncthreads();
  }
}

DI void ret_kv_item(const Params& p, int item, int tid) {
  const int lane = tid & 63, w = tid >> 6, r = lane & 31, hh = lane >> 5;
  const u16 *kT, *vT; int T, c;
  if (item < 2048) { const int bh = item >> 5; c = item & 31; T = 2048; kT = p.krT + (size_t)bh * 128 * 2048; vT = p.vrT + (size_t)bh * 128 * 2048; }
  else { const int bh = item - 2048; c = 0; T = 64; kT = p.krT + (size_t)64 * 128 * 2048 + (size_t)bh * 128 * 64; vT = p.vrT + (size_t)64 * 128 * 2048 + (size_t)bh * 128 * 64; }
  const int e0 = (w & 1) * 64, d0 = (w >> 1) * 64;
  f32x16 acc[2][2];
  acc[0][0] = zero16(); acc[0][1] = zero16(); acc[1][0] = zero16(); acc[1][1] = zero16();
#pragma unroll
  for (int ks = 0; ks < 4; ++ks) {
    bf16x8 a0 = ldg8(vT + (size_t)(e0 + r) * T + c * 64 + ks * 16 + hh * 8);
    bf16x8 a1 = ldg8(vT + (size_t)(e0 + 32 + r) * T + c * 64 + ks * 16 + hh * 8);
    bf16x8 b0 = ldg8(kT + (size_t)(d0 + r) * T + c * 64 + ks * 16 + hh * 8);
    bf16x8 b1 = ldg8(kT + (size_t)(d0 + 32 + r) * T + c * 64 + ks * 16 + hh * 8);
    acc[0][0] = MFMA32(a0, b0, acc[0][0]);
    acc[0][1] = MFMA32(a0, b1, acc[0][1]);
    acc[1][0] = MFMA32(a1, b0, acc[1][0]);
    acc[1][1] = MFMA32(a1, b1, acc[1][1]);
  }
  float* o = p.kvT + (size_t)item * 16384;
#pragma unroll
  for (int a = 0; a < 2; ++a)
#pragma unroll
    for (int b = 0; b < 2; ++b)
#pragma unroll
      for (int i = 0; i < 16; ++i)
        o[(e0 + a * 32 + crow(i, hh)) * 128 + d0 + b * 32 + r] = acc[a][b][i];
}

DI void idx_item(const Params& p, unsigned char* lds, int tid, bool samp, int b, int grp) {
  const int lane = tid & 63, w = tid >> 6;
  const int t0 = grp * 16;
  int L, g0; const u16* ki;
  if (!samp) { const int c = t0 >> 6; L = (c + 1) * 64; g0 = b * 2048 + t0; ki = p.kiP + (size_t)b * 2048 * 64; }
  else { L = 2112; g0 = NPROMPT + b * 64 + t0; ki = p.kiS + (size_t)b * 2112 * 64; }
  const int nj = L >> 6;
  if (L <= 256) {
    for (int qq = 0; qq < 4; ++qq) {
      const int q = w * 4 + qq;
      if (lane < nj) p.maskbits[(size_t)(g0 + q) * 33 + lane] = ~0ull;
    }
    return;
  }
  u16* keys = (u16*)lds;
  {
    const int qn = lane & 15, quad = lane >> 4;
    bf16x8 qf[8][2];
    float wv[8];
#pragma unroll
    for (int h = 0; h < 8; ++h) {
      qf[h][0] = ldg8(p.qi + (size_t)(g0 + qn) * 512 + h * 64 + quad * 8);
      qf[h][1] = ldg8(p.qi + (size_t)(g0 + qn) * 512 + h * 64 + 32 + quad * 8);
      wv[h] = p.wi[(size_t)(g0 + qn) * 8 + h];
    }
    const int nt16 = L >> 4;
    for (int kt = w; kt < nt16; kt += 4) {
      bf16x8 a0 = ldg8(ki + (size_t)(kt * 16 + qn) * 64 + quad * 8);
      bf16x8 a1 = ldg8(ki + (size_t)(kt * 16 + qn) * 64 + 32 + quad * 8);
      float idx[4] = {0.f, 0.f, 0.f, 0.f};
#pragma unroll
      for (int h = 0; h < 8; ++h) {
        f32x4 acc = {0.f, 0.f, 0.f, 0.f};
        acc = MFMA16(a0, qf[h][0], acc);
        acc = MFMA16(a1, qf[h][1], acc);
#pragma unroll
        for (int i = 0; i < 4; ++i) idx[i] += fmaxf(acc[i], 0.f) * wv[h];
      }
      s16x4 kv;
#pragma unroll
      for (int i = 0; i < 4; ++i) {
        _Float16 hv = (_Float16)idx[i];
        u16 bits = __builtin_bit_cast(u16, hv);
        kv[i] = (short)((bits & 0x8000) ? (u16)~bits : (u16)(bits | 0x8000));
      }
      *(s16x4*)(keys + qn * KPITCH + kt * 16 + quad * 4) = kv;
    }
  }
  __syncthreads();
  for (int qq = 0; qq < 4; ++qq) {
    const int q = w * 4 + qq;
    unsigned key[33];
#pragma unroll
    for (int j = 0; j < 33; ++j) key[j] = (j < nj) ? (unsigned)keys[q * KPITCH + j * 64 + lane] : 0u;
    unsigned prefix = 0;
    for (int bit = 15; bit >= 0; --bit) {
      const unsigned cand = prefix | (1u << bit);
      int cnt = 0;
#pragma unroll
      for (int j = 0; j < 33; ++j) cnt += __popcll(__ballot(key[j] >= cand));
      if (cnt >= 256) prefix = cand;
    }
    int cgt = 0;
#pragma unroll
    for (int j = 0; j < 33; ++j) cgt += __popcll(__ballot(key[j] > prefix));
    const int rneed = 256 - cgt;
    int running = 0;
    u64 myword = 0;
    const u64 lt = (1ull << lane) - 1ull;
#pragma unroll
    for (int j = 0; j < 33; ++j) {
      const bool eq = key[j] == prefix;
      const u64 em = __ballot(eq);
      const int rank = running + __popcll(em & lt);
      const bool sel = (key[j] > prefix) || (eq && rank < rneed);
      const u64 sm = __ballot(sel);
      if (lane == j) myword = sm;
      running += __popcll(em);
    }
    if (lane < nj) p.maskbits[(size_t)(g0 + q) * 33 + lane] = myword;
  }
  __syncthreads();
}

DI void scan_item(const Params& p, int item, int tid) {
  if (item < 1024) {
    const int bh = item >> 4, slab = item & 15;
    const int idx = slab * 1024 + tid * 4;
    const int h = bh & 3;
    const float cd = exp2f(64.f * log2gamma(h));
    f32x4 s = {0.f, 0.f, 0.f, 0.f};
    for (int c = 0; c < 32; ++c) {
      const size_t base = (size_t)(bh * 32 + c) * 16384 + idx;
      s16x4 o; o[0] = (short)f2bf(s[0]); o[1] = (short)f2bf(s[1]); o[2] = (short)f2bf(s[2]); o[3] = (short)f2bf(s[3]);
      *(s16x4*)(p.sprevT + base) = o;
      f32x4 kv = *(const f32x4*)(p.kvT + base);
      s = s * cd + kv;
    }
    const int e = idx >> 7, d = idx & 127;
    float* o = p.out + OUT_STP + (size_t)bh * 16384;
#pragma unroll
    for (int j = 0; j < 4; ++j) o[(d + j) * 128 + e] = s[j];
  } else {
    const int it = item - 1024;
    const int bh = it >> 4, slab = it & 15;
    const int idx = slab * 1024 + tid * 4;
    const int h = bh & 3;
    const float cd = exp2f(64.f * log2gamma(h));
    const int e = idx >> 7, d = idx & 127;
    const float* s0 = p.state_ret + (size_t)bh * 16384;
    f32x4 s;
#pragma unroll
    for (int j = 0; j < 4; ++j) s[j] = s0[(d + j) * 128 + e];
    const size_t base = (size_t)(2048 + bh) * 16384 + idx;
    s16x4 o; o[0] = (short)f2bf(s[0]); o[1] = (short)f2bf(s[1]); o[2] = (short)f2bf(s[2]); o[3] = (short)f2bf(s[3]);
    *(s16x4*)(p.sprevT + base) = o;
    f32x4 kv = *(const f32x4*)(p.kvT + base);
    s = s * cd + kv;
    float* oo = p.out + OUT_STS + (size_t)bh * 16384;
#pragma unroll
    for (int j = 0; j < 4; ++j) oo[(d + j) * 128 + e] = s[j];
  }
}

DI void attn_item(const Params& p, unsigned char* lds, int tid, bool samp, int b, int c, int kvh, int qh) {
  const int lane = tid & 63, w = tid >> 6, r = lane & 31, hh = lane >> 5;
  const int T = samp ? 2112 : 2048;
  const int nkt = samp ? 33 : c + 1;
  const int g0 = (samp ? NPROMPT + b * 64 : b * 2048 + c * 64) + qh * 32;
  const u16* K = samp ? p.kaS + (size_t)(b * 2 + kvh) * 2112 * 64 : p.kaP + (size_t)(b * 2 + kvh) * 2048 * 64;
  const u16* VT = samp ? p.vaTS + (size_t)(b * 2 + kvh) * 64 * 2112 : p.vaTP + (size_t)(b * 2 + kvh) * 64 * 2048;
  const int head = kvh * 4 + w;
  u16* Ks = (u16*)lds;
  u16* Vs = Ks + 64 * 72;
  u64* mL = (u64*)(lds + 2 * 9216);
  for (int i = tid; i < 32 * 33; i += 256) mL[i] = p.maskbits[(size_t)g0 * 33 + i];
  bf16x8 qf[4];
#pragma unroll
  for (int ks = 0; ks < 4; ++ks) qf[ks] = ldg8(p.qa + (size_t)(g0 + r) * 512 + head * 64 + ks * 16 + hh * 8);
  f32x16 O[2];
  O[0] = zero16(); O[1] = zero16();
  float mrun = -1e30f, lrun = 0.f;
  const int lrow = tid >> 3, lch = tid & 7;
  bf16x8 pk0, pk1, pv0, pv1;
  pk0 = ldg8(K + (size_t)(lrow)*64 + lch * 8);
  pk1 = ldg8(K + (size_t)(lrow + 32) * 64 + lch * 8);
  pv0 = ldg8(VT + (size_t)(lrow)*T + lch * 8);
  pv1 = ldg8(VT + (size_t)(lrow + 32) * T + lch * 8);
  for (int kt = 0; kt < nkt; ++kt) {
    __syncthreads();
    *(bf16x8*)(Ks + lrow * 72 + lch * 8) = pk0;
    *(bf16x8*)(Ks + (lrow + 32) * 72 + lch * 8) = pk1;
    *(bf16x8*)(Vs + lrow * 72 + lch * 8) = pv0;
    *(bf16x8*)(Vs + (lrow + 32) * 72 + lch * 8) = pv1;
    __syncthreads();
    if (kt + 1 < nkt) {
      pk0 = ldg8(K + (size_t)((kt + 1) * 64 + lrow) * 64 + lch * 8);
      pk1 = ldg8(K + (size_t)((kt + 1) * 64 + lrow + 32) * 64 + lch * 8);
      pv0 = ldg8(VT + (size_t)(lrow)*T + (kt + 1) * 64 + lch * 8);
      pv1 = ldg8(VT + (size_t)(lrow + 32) * T + (kt + 1) * 64 + lch * 8);
    }
    f32x16 S[2];
#pragma unroll
    for (int st = 0; st < 2; ++st) {
      S[st] = zero16();
#pragma unroll
      for (int ks = 0; ks < 4; ++ks) {
        bf16x8 kf = *(const bf16x8*)(Ks + (st * 32 + r) * 72 + ks * 16 + hh * 8);
        S[st] = MFMA32(kf, qf[ks], S[st]);
      }
    }
    const u64 W = mL[r * 33 + kt];
    const unsigned wl = ((unsigned)W) >> (4 * hh), wh = ((unsigned)(W >> 32)) >> (4 * hh);
    float mx = -1e30f;
#pragma unroll
    for (int st = 0; st < 2; ++st)
#pragma unroll
      for (int i = 0; i < 16; ++i) {
        const unsigned bit = ((st ? wh : wl) >> ((i & 3) + 8 * (i >> 2))) & 1u;
        const float s = bit ? S[st][i] : -1e30f;
        S[st][i] = s;
        mx = fmaxf(mx, s);
      }
    mx = fmaxf(mx, __shfl_xor(mx, 32));
    const float mn = fmaxf(mrun, mx);
    const float alpha = __builtin_amdgcn_exp2f(mrun - mn);
    mrun = mn;
    float ls = 0.f;
#pragma unroll
    for (int st = 0; st < 2; ++st)
#pragma unroll
      for (int i = 0; i < 16; ++i) {
        const float pvv = __builtin_amdgcn_exp2f(S[st][i] - mn);
        S[st][i] = pvv;
        ls += pvv;
      }
    lrun = lrun * alpha + ls;
#pragma unroll
    for (int dt = 0; dt < 2; ++dt)
#pragma unroll
      for (int i = 0; i < 16; ++i) O[dt][i] *= alpha;
#pragma unroll
    for (int st = 0; st < 2; ++st)
#pragma unroll
      for (int s2 = 0; s2 < 2; ++s2) {
        bf16x8 pf = pack8(S[st][8 * s2 + 0], S[st][8 * s2 + 1], S[st][8 * s2 + 2], S[st][8 * s2 + 3],
                          S[st][8 * s2 + 4], S[st][8 * s2 + 5], S[st][8 * s2 + 6], S[st][8 * s2 + 7]);
#pragma unroll
        for (int dt = 0; dt < 2; ++dt) {
          s16x4 lo = *(const s16x4*)(Vs + (dt * 32 + r) * 72 + st * 32 + 16 * s2 + 4 * hh);
          s16x4 hi = *(const s16x4*)(Vs + (dt * 32 + r) * 72 + st * 32 + 16 * s2 + 8 + 4 * hh);
          bf16x8 vf = __builtin_shufflevector(lo, hi, 0, 1, 2, 3, 4, 5, 6, 7);
          O[dt] = MFMA32(vf, pf, O[dt]);
        }
      }
  }
  {
    float lt = lrun + __shfl_xor(lrun, 32);
    const float inv = 1.f / lt;
    u16* grow = p.gate + (size_t)(g0 + r) * 1024 + 512 + head * 64;
#pragma unroll
    for (int dt = 0; dt < 2; ++dt)
#pragma unroll
      for (int q4 = 0; q4 < 4; ++q4) {
        const int d = dt * 32 + 8 * q4 + 4 * hh;
        s16x4 gv = *(const s16x4*)(grow + d);
        s16x4 ov;
#pragma unroll
        for (int j = 0; j < 4; ++j) {
          const float gf = __uint_as_float(((unsigned)(u16)gv[j]) << 16);
          ov[j] = (short)f2bf(O[dt][q4 * 4 + j] * inv * gf);
        }
        *(s16x4*)(grow + d) = ov;
      }
  }
  __syncthreads();
}

DI void ret_out_item(const Params& p, unsigned char* lds, int item, int tid) {
  const int lane = tid & 63, w = tid >> 6, r = lane & 31, hh = lane >> 5;
  int bh, c, T, g0; const u16* vT;
  if (item < 2048) { bh = item >> 5; c = item & 31; T = 2048; g0 = (bh >> 2) * 2048 + c * 64; vT = p.vrT + (size_t)bh * 128 * 2048; }
  else { bh = item - 2048; c = 0; T = 64; g0 = NPROMPT + (bh >> 2) * 64; vT = p.vrT + (size_t)64 * 128 * 2048 + (size_t)bh * 128 * 64; }
  const int h = bh & 3;
  const float l2g = log2gamma(h);
  const int nt = w & 1, eh = w >> 1;
  const int n = nt * 32 + r;
  bf16x8 qf[8];
#pragma unroll
  for (int ks = 0; ks < 8; ++ks) qf[ks] = ldg8(p.qr + (size_t)(g0 + n) * 512 + h * 128 + ks * 16 + hh * 8);
  bf16x8 pf[2][2];
#pragma unroll
  for (int mt = 0; mt < 2; ++mt) {
    f32x16 S = zero16();
#pragma unroll
    for (int ks = 0; ks < 8; ++ks) {
      bf16x8 kf = ldg8(p.kr + (size_t)(g0 + mt * 32 + r) * 512 + h * 128 + ks * 16 + hh * 8);
      S = MFMA32(kf, qf[ks], S);
    }
#pragma unroll
    for (int i = 0; i < 16; ++i) {
      const int m = mt * 32 + crow(i, hh);
      const int dd = n > m ? n - m : m - n;
      S[i] *= exp2f((float)dd * l2g);
    }
    pf[mt][0] = pack8(S[0], S[1], S[2], S[3], S[4], S[5], S[6], S[7]);
    pf[mt][1] = pack8(S[8], S[9], S[10], S[11], S[12], S[13], S[14], S[15]);
  }
  const float fs = exp2f((float)(n + 1) * l2g);
  const u16* sp = p.sprevT + (size_t)item * 16384;
  f32x16 tot[2];
  float ss = 0.f;
#pragma unroll
  for (int et = 0; et < 2; ++et) {
    const int e = (2 * eh + et) * 32 + r;
    f32x16 Oi = zero16(), X = zero16();
#pragma unroll
    for (int mt = 0; mt < 2; ++mt)
#pragma unroll
      for (int s2 = 0; s2 < 2; ++s2) {
        const u16* vp = vT + (size_t)e * T + c * 64 + mt * 32 + 16 * s2 + 4 * hh;
        s16x4 lo = ldg4(vp), hi = ldg4(vp + 8);
        bf16x8 vf = __builtin_shufflevector(lo, hi, 0, 1, 2, 3, 4, 5, 6, 7);
        Oi = MFMA32(vf, pf[mt][s2], Oi);
      }
#pragma unroll
    for (int ks = 0; ks < 8; ++ks) {
      bf16x8 sf = ldg8(sp + (size_t)e * 128 + ks * 16 + hh * 8);
      X = MFMA32(sf, qf[ks], X);
    }
#pragma unroll
    for (int i = 0; i < 16; ++i) { const float t = Oi[i] + X[i] * fs; tot[et][i] = t; ss += t * t; }
  }
  ss += __shfl_xor(ss, 32);
  float* red = (float*)lds;
  __syncthreads();
  if (hh == 0) red[w * 32 + r] = ss;
  __syncthreads();
  const float tsum = red[w * 32 + r] + red[(w ^ 2) * 32 + r];
  const float rinv = rsqrtf(tsum * (1.f / 128.f) + 1e-6f);
  u16* grow = p.gate + (size_t)(g0 + n) * 1024 + h * 128;
#pragma unroll
  for (int et = 0; et < 2; ++et)
#pragma unroll
    for (int q4 = 0; q4 < 4; ++q4) {
      const int e = (2 * eh + et) * 32 + 8 * q4 + 4 * hh;
      s16x4 gv = *(const s16x4*)(grow + e);
      f32x4 gg = *(const f32x4*)(p.ret_gn_g + h * 128 + e);
      s16x4 ov;
#pragma unroll
      for (int j = 0; j < 4; ++j) {
        const float gf = __uint_as_float(((unsigned)(u16)gv[j]) << 16);
        ov[j] = (short)f2bf(tot[et][q4 * 4 + j] * rinv * gg[j] * gf);
      }
      *(s16x4*)(grow + e) = ov;
    }
}

DI void phase_gemm2(const Params& p, unsigned char* lds, int tid) {
  const int lane = tid & 63, w = tid >> 6, wm = w & 1, wn = w >> 1, r = lane & 31, hh = lane >> 5;
  for (int tile = blockIdx.x; tile < 260 * 8; tile += gridDim.x) {
    const int mt = tile >> 3, nt = tile & 7;
    const int m0 = mt * 128, n0 = nt * 128;
    f32x16 acc[2][2];
    acc[0][0] = zero16(); acc[0][1] = zero16(); acc[1][0] = zero16(); acc[1][1] = zero16();
    gemm_core(p.gate + (size_t)m0 * 1024, p.WtOut + (size_t)n0 * 1024, (u16*)lds, acc, tid);
#pragma unroll
    for (int a = 0; a < 2; ++a)
#pragma unroll
      for (int i = 0; i < 16; ++i) {
        const int g = m0 + wm * 64 + a * 32 + crow(i, hh);
        const float* xr = xrow(p, g);
#pragma unroll
        for (int b = 0; b < 2; ++b) {
          const int col = n0 + wn * 64 + b * 32 + r;
          p.out[OUT_Y + (size_t)g * 1024 + col] = acc[a][b][i] + xr[col];
        }
      }
  }
}

DI void phase_final(const Params& p, int tid) {
  const int gt = blockIdx.x * 256 + tid, GT = gridDim.x * 256;
  const int lane = tid & 63;
  for (int row = gt >> 6; row < NTOK; row += (GT >> 6)) {
    float* y = p.out + OUT_Y + (size_t)row * 1024;
    f32x4 v[4];
    float ss = 0.f;
#pragma unroll
    for (int i = 0; i < 4; ++i) { v[i] = *(const f32x4*)(y + i * 256 + lane * 4); ss += v[i][0] * v[i][0] + v[i][1] * v[i][1] + v[i][2] * v[i][2] + v[i][3] * v[i][3]; }
#pragma unroll
    for (int o = 32; o >= 1; o >>= 1) ss += __shfl_xor(ss, o);
    const float rv = rsqrtf(ss * (1.f / 1024.f) + 1e-6f);
#pragma unroll
    for (int i = 0; i < 4; ++i) {
      f32x4 g = *(const f32x4*)(p.final_g + i * 256 + lane * 4);
      f32x4 o = v[i] * rv * g;
      *(f32x4*)(y + i * 256 + lane * 4) = o;
    }
  }
}

__global__ void __launch_bounds__(256, 2) fwd_megakernel(Params p) {
  __shared__ __attribute__((aligned(16))) unsigned char lds[LDS_BYTES];
  cg::grid_group grid = cg::this_grid();
  const int tid = threadIdx.x;

  phase_prep(p, tid);
  grid.sync();
  phase_gemm1(p, lds, tid);
  grid.sync();
  for (int it = blockIdx.x; it < 2080 + 2080; it += gridDim.x) {
    if (it < 32) idx_item(p, lds, tid, true, it >> 2, it & 3);
    else if (it < 2080) {
      const int j = it - 32;
      const int c = 31 - (j >> 6), b = (j & 63) >> 2, sub = j & 3;
      idx_item(p, lds, tid, false, b, c * 4 + sub);
    } else ret_kv_item(p, it - 2080, tid);
  }
  grid.sync();
  for (int it = blockIdx.x; it < 2080 + 1536; it += gridDim.x) {
    if (it < 32) attn_item(p, lds, tid, true, it >> 2, 0, (it >> 1) & 1, it & 1);
    else if (it < 2080) {
      const int j = it - 32;
      const int c = 31 - (j >> 6), b = (j & 63) >> 2, kvh = (j >> 1) & 1, qh = j & 1;
      attn_item(p, lds, tid, false, b, c, kvh, qh);
    } else scan_item(p, it - 2080, tid);
  }
  grid.sync();
  for (int it = blockIdx.x; it < 2080; it += gridDim.x) ret_out_item(p, lds, it, tid);
  grid.sync();
  phase_gemm2(p, lds, tid);
  grid.sync();
  phase_final(p, tid);
}

extern "C" void kernel_launch(void* const* d_in, const int* in_sizes, int n_in, void* d_out, int out_size, void* d_ws,
                              size_t ws_size, hipStream_t stream) {
  static int grid_blocks = 0;
  if (!grid_blocks) {
    int dev = 0, cus = 0, per_cu = 0;
    hipGetDevice(&dev);
    hipDeviceGetAttribute(&cus, hipDeviceAttributeMultiprocessorCount, dev);
    hipOccupancyMaxActiveBlocksPerMultiprocessor(&per_cu, fwd_megakernel, 256, 0);
    if (per_cu < 1) per_cu = 1;
    if (per_cu > 2) per_cu = 2;
    grid_blocks = cus * per_cu;
  }
  Params p{};
  p.x_p = (const float*)d_in[0]; p.x_s = (const float*)d_in[1]; p.state_ret = (const float*)d_in[2];
  p.cache_k = (const float*)d_in[3]; p.cache_v = (const float*)d_in[4]; p.cache_kidx = (const float*)d_in[5];
  p.norm_g = (const float*)d_in[6]; p.w_in = (const float*)d_in[7]; p.ret_gn_g = (const float*)d_in[8];
  p.w_out = (const float*)d_in[9]; p.final_g = (const float*)d_in[10];
  p.out = (float*)d_out;
  unsigned char* ws = (unsigned char*)d_ws;
  size_t off = 0;
  auto alloc = [&](size_t bytes) { unsigned char* q = ws + off; off += (bytes + 255) & ~(size_t)255; return q; };
  unsigned char* regA = alloc((size_t)2080 * 65536);
  p.kvT = (float*)regA; p.xb = (u16*)regA;
  p.WtIn = (u16*)alloc((size_t)3968 * 1024 * 2);
  p.WtOut = (u16*)alloc((size_t)1024 * 1024 * 2);
  p.qr = (u16*)alloc((size_t)NTOK * 512 * 2);
  p.kr = (u16*)alloc((size_t)NTOK * 512 * 2);
  unsigned char* regB = alloc((size_t)2080 * 16384 * 2);
  p.sprevT = (u16*)regB; p.qi = (u16*)regB; p.krT = (u16*)(regB + (size_t)NTOK * 512 * 2);
  p.vrT = (u16*)alloc((size_t)NTOK * 512 * 2);
  p.gate = (u16*)alloc((size_t)NTOK * 1024 * 2);
  p.qa = (u16*)alloc((size_t)NTOK * 512 * 2);
  p.kaP = (u16*)alloc((size_t)16 * 2 * 2048 * 64 * 2);
  p.kaS = (u16*)alloc((size_t)8 * 2 * 2112 * 64 * 2);
  p.vaTP = (u16*)alloc((size_t)16 * 2 * 2048 * 64 * 2);
  p.vaTS = (u16*)alloc((size_t)8 * 2 * 2112 * 64 * 2);
  p.kiP = (u16*)alloc((size_t)16 * 2048 * 64 * 2);
  p.kiS = (u16*)alloc((size_t)8 * 2112 * 64 * 2);
  p.rinv = (float*)alloc((size_t)NTOK * 4);
  p.wi = (float*)alloc((size_t)NTOK * 8 * 4);
  p.cosR = (float*)alloc((size_t)2112 * 64 * 4);
  p.sinR = (float*)alloc((size_t)2112 * 64 * 4);
  p.cosA = (float*)alloc((size_t)2112 * 8 * 4);
  p.sinA = (float*)alloc((size_t)2112 * 8 * 4);
  p.maskbits = (u64*)alloc((size_t)NTOK * 33 * 8);
  void* args[] = {&p};
  hipError_t e = hipLaunchCooperativeKernel((void*)fwd_megakernel, dim3(grid_blocks), dim3(256), args, 0, stream);
  if (e != hipSuccess) fprintf(stderr, "cooperative launch failed: %s (grid %d)\n", hipGetErrorString(e), grid_blocks);
}
```

```cpp
#include <hip/hip_runtime.h>
#include <hip/hip_cooperative_groups.h>
#include <stdint.h>
#include <cstdio>
namespace cg = cooperative_groups;

typedef __attribute__((ext_vector_type(8))) short bf16x8;
typedef __attribute__((ext_vector_type(4))) short s16x4;
typedef __attribute__((ext_vector_type(16))) float f32x16;
typedef __attribute__((ext_vector_type(4))) float f32x4;
typedef unsigned short u16;
typedef unsigned long long u64;


#define DI __device__ __forceinline__
#define MFMA32(a, b, c) __builtin_amdgcn_mfma_f32_32x32x16_bf16((a), (b), (c), 0, 0, 0)
#define MFMA16(a, b, c) __builtin_amdgcn_mfma_f32_16x16x32_bf16((a), (b), (c), 0, 0, 0)

#define NTOK 33280
#define NPROMPT 32768
#define LDS_BYTES 163840
#define HALF_LDS 81920
#define LAS __attribute__((address_space(3)))
#define KPITCH 2116

struct Params {
  const float *x_p, *x_s, *state_ret, *cache_k, *cache_v, *cache_kidx, *norm_g, *w_in, *ret_gn_g, *w_out, *final_g;
  float* out;
  unsigned char* ws;
  DI u16* xb() const { return (u16*)(ws + 0ull); }
  DI float* kvT() const { return (float*)(ws + 0ull); }
  DI u16* WtIn() const { return (u16*)(ws + 136314880ull); }
  DI u16* WtOut() const { return (u16*)(ws + 144703488ull); }
  DI u16* qr() const { return (u16*)(ws + 146800640ull); }
  DI u16* kr() const { return (u16*)(ws + 180879360ull); }
  DI u16* sprevT() const { return (u16*)(ws + 214958080ull); }
  DI u16* qi() const { return (u16*)(ws + 214958080ull); }
  DI u16* krT() const { return (u16*)(ws + 249036800ull); }
  DI u16* vrT() const { return (u16*)(ws + 283115520ull); }
  DI u16* gate() const { return (u16*)(ws + 317194240ull); }
  DI u16* mix() const { return (u16*)(ws + 385351680ull); }
  DI u16* qa() const { return (u16*)(ws + 453509120ull); }
  DI u16* kaP() const { return (u16*)(ws + 487587840ull); }
  DI u16* kaS() const { return (u16*)(ws + 495976448ull); }
  DI u16* vaTP() const { return (u16*)(ws + 500301824ull); }
  DI u16* vaTS() const { return (u16*)(ws + 508690432ull); }
  DI u16* kiP() const { return (u16*)(ws + 513015808ull); }
  DI u16* kiS() const { return (u16*)(ws + 517210112ull); }
  DI float* rinv() const { return (float*)(ws + 519372800ull); }
  DI float* wi() const { return (float*)(ws + 519505920ull); }
  DI float* cosR() const { return (float*)(ws + 520570880ull); }
  DI float* sinR() const { return (float*)(ws + 521111552ull); }
  DI float* cosA() const { return (float*)(ws + 521652224ull); }
  DI float* sinA() const { return (float*)(ws + 521719808ull); }
  DI u64* maskbits() const { return (u64*)(ws + 521787392ull); }
};

#define OUT_Y 0
#define OUT_STP (34078720)
#define OUT_KP (OUT_STP + 1048576)
#define OUT_VP (OUT_KP + 4194304)
#define OUT_KIP (OUT_VP + 4194304)
#define OUT_STS (OUT_KIP + 2097152)
#define OUT_KS (OUT_STS + 524288)
#define OUT_VS (OUT_KS + 65536)
#define OUT_KIS (OUT_VS + 65536)

DI u16 f2bf(float x) {
  unsigned u = __float_as_uint(x);
  u += 0x7fffu + ((u >> 16) & 1u);
  return (u16)(u >> 16);
}
DI bf16x8 ldg8(const u16* p) { return *(const bf16x8*)p; }
DI s16x4 ldg4(const u16* p) { return *(const s16x4*)p; }
DI float siluf(float x) { return x / (1.f + __expf(-x)); }
DI int crow(int reg, int hh) { return (reg & 3) + 8 * (reg >> 2) + 4 * hh; }
DI const float* xrow(const Params& p, int g) { return g < NPROMPT ? p.x_p + (size_t)g * 1024 : p.x_s + (size_t)(g - NPROMPT) * 1024; }
DI float log2gamma(int h) { return log1pf(-exp2f(-5.f - (float)h)) * 1.4426950408889634f; }
DI bf16x8 pack8(float a0, float a1, float a2, float a3, float a4, float a5, float a6, float a7) {
  bf16x8 v;
  v[0] = (short)f2bf(a0); v[1] = (short)f2bf(a1); v[2] = (short)f2bf(a2); v[3] = (short)f2bf(a3);
  v[4] = (short)f2bf(a4); v[5] = (short)f2bf(a5); v[6] = (short)f2bf(a6); v[7] = (short)f2bf(a7);
  return v;
}
DI f32x16 zero16() { f32x16 z; for (int i = 0; i < 16; ++i) z[i] = 0.f; return z; }

DI void phase_prep(const Params& p, int tid) {
  const int gt = blockIdx.x * 512 + tid, GT = gridDim.x * 512;
  const int lane = tid & 63;
  for (int row = gt >> 6; row < NTOK; row += (GT >> 6)) {
    const float* src = xrow(p, row);
    float ss = 0.f;
    f32x4 v[4];
#pragma unroll
    for (int i = 0; i < 4; ++i) { v[i] = *(const f32x4*)(src + i * 256 + lane * 4); ss += v[i][0] * v[i][0] + v[i][1] * v[i][1] + v[i][2] * v[i][2] + v[i][3] * v[i][3]; }
#pragma unroll
    for (int o = 32; o >= 1; o >>= 1) ss += __shfl_xor(ss, o);
#pragma unroll
    for (int i = 0; i < 4; ++i) {
      s16x4 o; o[0] = (short)f2bf(v[i][0]); o[1] = (short)f2bf(v[i][1]); o[2] = (short)f2bf(v[i][2]); o[3] = (short)f2bf(v[i][3]);
      *(s16x4*)(p.xb() + (size_t)row * 1024 + i * 256 + lane * 4) = o;
    }
    if (lane == 0) p.rinv()[row] = rsqrtf(ss * (1.f / 1024.f) + 1e-6f);
  }
  for (int i = gt; i < 4096 * 128; i += GT) {
    int n = i & 4095, kg = i >> 12;
    int sc = n;
    if (n < 1024) { const int P = n & 127; sc = (n & ~127) + 64 * ((P >> 4) & 1) + 16 * (P >> 5) + (P & 15); }
    float a[8];
#pragma unroll
    for (int j = 0; j < 8; ++j) a[j] = (n < 3912) ? p.w_in[(size_t)(kg * 8 + j) * 3912 + sc] * p.norm_g[kg * 8 + j] : 0.f;
    *(bf16x8*)(p.WtIn() + (size_t)n * 1024 + kg * 8) = pack8(a[0], a[1], a[2], a[3], a[4], a[5], a[6], a[7]);
  }
  for (int i = gt; i < 1024 * 128; i += GT) {
    int n = i % 1024, kg = i / 1024;
    float a[8];
#pragma unroll
    for (int j = 0; j < 8; ++j) a[j] = p.w_out[(size_t)(kg * 8 + j) * 1024 + n];
    *(bf16x8*)(p.WtOut() + (size_t)n * 1024 + kg * 8) = pack8(a[0], a[1], a[2], a[3], a[4], a[5], a[6], a[7]);
  }
  for (int i = gt; i < 2112 * 64; i += GT) {
    int pos = i >> 6, k = i & 63;
    float inv = powf(10000.f, -(float)k / 64.f);
    float ang = (float)pos * inv;
    p.cosR()[i] = cosf(ang); p.sinR()[i] = sinf(ang);
  }
  for (int i = gt; i < 2112 * 8; i += GT) {
    int pos = i >> 3, k = i & 7;
    float inv = powf(500000.f, -(float)k / 8.f);
    float ang = (float)pos * inv;
    p.cosA()[i] = cosf(ang); p.sinA()[i] = sinf(ang);
  }
  for (int i = gt; i < 8 * 2048 * 2 * 8; i += GT) {
    int dg = i & 7, kvh = (i >> 3) & 1, t = (i >> 4) & 2047, b = i >> 15;
    const float* s = p.cache_k + ((size_t)(b * 2048 + t) * 2 + kvh) * 64 + dg * 8;
    *(bf16x8*)(p.kaS() + ((size_t)(b * 2 + kvh) * 2112 + t) * 64 + dg * 8) = pack8(s[0], s[1], s[2], s[3], s[4], s[5], s[6], s[7]);
  }
  for (int i = gt; i < 8 * 2 * 256 * 64; i += GT) {
    int d = i & 63, tg = (i >> 6) & 255, kvh = (i >> 14) & 1, b = i >> 15;
    float a[8];
#pragma unroll
    for (int j = 0; j < 8; ++j) a[j] = p.cache_v[((size_t)(b * 2048 + tg * 8 + j) * 2 + kvh) * 64 + d];
    *(bf16x8*)(p.vaTS() + ((size_t)(b * 2 + kvh) * 64 + d) * 2112 + tg * 8) = pack8(a[0], a[1], a[2], a[3], a[4], a[5], a[6], a[7]);
  }
  for (int i = gt; i < 8 * 2048 * 8; i += GT) {
    int dg = i & 7, t = (i >> 3) & 2047, b = i >> 14;
    const float* s = p.cache_kidx + (size_t)(b * 2048 + t) * 64 + dg * 8;
    *(bf16x8*)(p.kiS() + ((size_t)b * 2112 + t) * 64 + dg * 8) = pack8(s[0], s[1], s[2], s[3], s[4], s[5], s[6], s[7]);
  }
}

namespace pg8 {
constexpr int BM = 256, BK = 64, HALF = 128, HTB = HALF * BK * 2, STAGE_BYTES = 8 * HTB, NXCD = 8, WGM = 8;
DI int lds_byte(int r, int c) { const int st = (r >> 4) * 2 + (c >> 5), rr = r & 15, cc = c & 31, ob = rr * 64 + cc * 2; return st * 1024 + (ob ^ (((ob >> 9) & 1) << 5)); }
DI void stage_rc(int b, int& R, int& C) { const int st = b / 1024, sb = b % 1024, swz = sb ^ (((sb >> 9) & 1) << 5); R = (st >> 1) * 16 + swz / 64; C = (st & 1) * 32 + (swz % 64) / 2; }
struct Unit { int pm, pn; };
struct Gemm { const u16* A; const u16* Bt; int M, N, K; };
struct StaticOrder {
  int nM, nN, nwg, G, c;
  DI void init(int M, int N, int G_, int c_) { nM = M / BM; nN = N / BM; nwg = nM * nN; G = G_; c = c_; }
  DI bool next(int i, Unit& u) const {
    const long L = (long)i * G + c; if (L >= nwg) return false;
    int wgid = (int)L; { const int q = nwg / NXCD, r = nwg % NXCD, xcd = wgid % NXCD, off = wgid / NXCD; wgid = (xcd < r ? xcd * (q + 1) : r * (q + 1) + (xcd - r) * q) + off; }
    const int nig = WGM * nN, gid = wgid / nig, fm = gid * WGM, gsz = (nM - fm) < WGM ? (nM - fm) : WGM;
    u.pm = fm + ((wgid % nig) % gsz); u.pn = (wgid % nig) / gsz; return true;
  }
};
template <class Epi>
DI void gemm_phase(LAS unsigned char* lds, const Gemm g, const StaticOrder& S, const Epi& E) {
  int tid = threadIdx.x; asm volatile("" : "+v"(tid));
  const int wid = __builtin_amdgcn_readfirstlane(tid >> 6), lane = tid & 63, wr = wid >> 2, wc = wid & 3, fr = lane & 15, fq = lane >> 4;
  const int K = g.K, nt = K / BK;
  unsigned voffA[2], voffB[2];
#pragma unroll
  for (int i = 0; i < 2; ++i) { int R, C; stage_rc(tid * 16 + i * 8192, R, C); voffA[i] = (unsigned)(R * K + C) * 2u; voffB[i] = voffA[i]; }
  const size_t kstep = (size_t)(BK * 2);
  const size_t hstep = (size_t)HALF * K * 2;
  const size_t tstep = 2 * hstep;
  const unsigned ldsw = (unsigned)wid * 1024u;
  const int aoff = lds_byte(wr * 64 + fr, fq * 8), boff = lds_byte(wc * 32 + fr, fq * 8);
#define PG8_SA(b, h) (((b) * 2 + (h)) * HTB)
#define PG8_SB(b, h) ((4 + (b) * 2 + (h)) * HTB)
#define PG8_STAGE(bufoff, gbase, voff) do { _Pragma("unroll") for (int _i = 0; _i < 2; ++_i) \
    __builtin_amdgcn_global_load_lds((const unsigned*)((const char*)(gbase) + (voff)[_i]), (LAS unsigned*)(lds + (bufoff) + ldsw + _i * 8192), 16, 0, 0); } while (0)
#define PG8_LDA(dst, b, h) do { _Pragma("unroll") for (int m = 0; m < 4; ++m) _Pragma("unroll") for (int k = 0; k < 2; ++k) dst[m][k] = *(const LAS bf16x8*)(lds + PG8_SA(b, h) + aoff + m * 2048 + k * 1024); } while (0)
#define PG8_LDB(dst, b, h) do { _Pragma("unroll") for (int n = 0; n < 2; ++n) _Pragma("unroll") for (int k = 0; k < 2; ++k) dst[n][k] = *(const LAS bf16x8*)(lds + PG8_SB(b, h) + boff + n * 2048 + k * 1024); } while (0)
#define PG8_MMA(ai, bj, At, Bt) do { __builtin_amdgcn_s_setprio(1); _Pragma("unroll") for (int m = 0; m < 4; ++m) _Pragma("unroll") for (int n = 0; n < 2; ++n) _Pragma("unroll") for (int k = 0; k < 2; ++k) \
    acc[ai][bj][m][n] = __builtin_amdgcn_mfma_f32_16x16x32_bf16(Bt[n][k], At[m][k], acc[ai][bj][m][n], 0, 0, 0); __builtin_amdgcn_s_setprio(0); } while (0)
#define PG8_WAIT_V(n) asm volatile("s_waitcnt vmcnt(" #n ")" ::: "memory")
#define PG8_WAIT_L(n) asm volatile("s_waitcnt lgkmcnt(" #n ")" ::: "memory")
#define PG8_BAR __builtin_amdgcn_s_barrier()
#define PG8_SCHED __builtin_amdgcn_sched_barrier(0)
  Unit cur, nxt; int ui = 0;
  if (!S.next(0, cur)) return;
  f32x4 acc[2][2][4][2];
#pragma unroll
  for (int a = 0; a < 2; ++a)
#pragma unroll
    for (int b = 0; b < 2; ++b)
#pragma unroll
      for (int m = 0; m < 4; ++m)
#pragma unroll
        for (int n = 0; n < 2; ++n) acc[a][b][m][n] = (f32x4){0.f, 0.f, 0.f, 0.f};
  bf16x8 At[4][2], B0[2][2], B1[2][2];
  const char* cA = (const char*)g.A + (size_t)cur.pm * tstep; const char* cB = (const char*)g.Bt + (size_t)cur.pn * tstep;
  PG8_STAGE(PG8_SB(0, 0), cB, voffB); PG8_STAGE(PG8_SA(0, 0), cA, voffA); PG8_STAGE(PG8_SB(0, 1), cB + hstep, voffB); PG8_STAGE(PG8_SA(0, 1), cA + hstep, voffA);
  if (wr == 1) PG8_BAR;
  PG8_WAIT_V(4); PG8_BAR;
  PG8_STAGE(PG8_SB(1, 0), cB + kstep, voffB); PG8_STAGE(PG8_SA(1, 0), cA + kstep, voffA); PG8_STAGE(PG8_SB(1, 1), cB + hstep + kstep, voffB);
  PG8_WAIT_V(6); PG8_BAR;
  for (;;) {
    const bool has_next = S.next(ui + 1, nxt);
    const char* nA = has_next ? (const char*)g.A + (size_t)nxt.pm * tstep : cA; const char* nB = has_next ? (const char*)g.Bt + (size_t)nxt.pn * tstep : cB;
    for (int t = 0; t < nt; t += 2) {
      const bool last = (t == nt - 2);
      const char* a1 = cA + (size_t)(t + 1) * kstep;
      const char* a2 = last ? nA : cA + (size_t)(t + 2) * kstep; const char* b2 = last ? nB : cB + (size_t)(t + 2) * kstep;
      const char* a3 = a2 + kstep; const char* b3 = b2 + kstep;
      PG8_LDB(B0, 0, 0); PG8_SCHED; PG8_LDA(At, 0, 0); PG8_STAGE(PG8_SA(1, 1), a1 + hstep, voffA);
      PG8_WAIT_L(8); PG8_BAR; PG8_WAIT_L(0); PG8_MMA(0, 0, At, B0); PG8_BAR; PG8_SCHED;
      PG8_LDB(B1, 0, 1); PG8_STAGE(PG8_SB(0, 0), b2, voffB);
      PG8_BAR; PG8_WAIT_L(0); PG8_MMA(0, 1, At, B1); PG8_BAR;
      PG8_LDA(At, 0, 1); PG8_STAGE(PG8_SA(0, 0), a2, voffA);
      PG8_BAR; PG8_WAIT_L(0); PG8_MMA(1, 0, At, B0); PG8_BAR; PG8_SCHED;
      PG8_STAGE(PG8_SB(0, 1), b2 + hstep, voffB);
      PG8_WAIT_V(6); PG8_BAR; PG8_MMA(1, 1, At, B1); PG8_BAR;
      PG8_LDB(B0, 1, 0); PG8_SCHED; PG8_LDA(At, 1, 0); PG8_STAGE(PG8_SA(0, 1), a2 + hstep, voffA);
      PG8_WAIT_L(8); PG8_BAR; PG8_WAIT_L(0); PG8_MMA(0, 0, At, B0); PG8_BAR; PG8_SCHED;
      PG8_LDB(B1, 1, 1); PG8_STAGE(PG8_SB(1, 0), b3, voffB);
      PG8_BAR; PG8_WAIT_L(0); PG8_MMA(0, 1, At, B1); PG8_BAR;
      PG8_LDA(At, 1, 1); PG8_STAGE(PG8_SA(1, 0), a3, voffA);
      PG8_BAR; PG8_WAIT_L(0); PG8_MMA(1, 0, At, B0); PG8_BAR; PG8_SCHED;
      PG8_STAGE(PG8_SB(1, 1), b3 + hstep, voffB);
      PG8_WAIT_V(6); PG8_BAR; PG8_MMA(1, 1, At, B1); PG8_BAR;
    }
    {
      Unit eu = cur; int ewr = wr, ewc = wc, efr = fr, efq = fq;
      asm volatile("" : "+s"(eu.pm), "+s"(eu.pn), "+s"(ewr), "+s"(ewc), "+v"(efr), "+v"(efq));
      E(acc, eu, ewr, ewc, efr, efq);
    }
    if (!has_next) break;
#pragma unroll
    for (int a = 0; a < 2; ++a)
#pragma unroll
      for (int b = 0; b < 2; ++b)
#pragma unroll
        for (int m = 0; m < 4; ++m)
#pragma unroll
          for (int n = 0; n < 2; ++n) acc[a][b][m][n] = (f32x4){0.f, 0.f, 0.f, 0.f};
    cur = nxt; cA = nA; cB = nB; ++ui;
  }
  PG8_WAIT_V(0);
  if (wr == 0) PG8_BAR;
  PG8_BAR;
#undef PG8_SA
#undef PG8_SB
#undef PG8_STAGE
#undef PG8_LDA
#undef PG8_LDB
#undef PG8_MMA
#undef PG8_WAIT_V
#undef PG8_WAIT_L
#undef PG8_BAR
#undef PG8_SCHED
}
}

DI s16x4 pack4(f32x4 v) { s16x4 o; o[0] = (short)f2bf(v[0]); o[1] = (short)f2bf(v[1]); o[2] = (short)f2bf(v[2]); o[3] = (short)f2bf(v[3]); return o; }

struct Epi1 {
  Params p; u16* tl;
  DI void flush_T(int lane, u16* dstbase, size_t fstride, const int* fmap_kind, int wc) const {}
  DI void operator()(f32x4 (&acc)[2][2][4][2], const pg8::Unit& u, int wr, int wc, int fr, int fq) const {
#pragma unroll
    for (int ai = 0; ai < 2; ++ai)
#pragma unroll
      for (int m = 0; m < 4; ++m) {
        const float rv = p.rinv()[u.pm * 256 + ai * 128 + wr * 64 + 16 * m + fr];
#pragma unroll
        for (int bj = 0; bj < 2; ++bj)
#pragma unroll
          for (int n = 0; n < 2; ++n) acc[ai][bj][m][n] *= rv;
      }
    asm volatile("" ::: "memory");
    const bool samp = (u.pm * 256 >= NPROMPT);
#pragma unroll
    for (int bj = 0; bj < 2; ++bj) {
      const int blk = u.pn * 2 + bj;
      if (blk == 31) continue;
#pragma unroll
      for (int ai = 0; ai < 2; ++ai) {
        asm volatile("" : "+v"(fr), "+v"(fq));
        const int lane = fr + 16 * fq;
        const int P0 = 32 * wc + 4 * fq;
        const int R0 = u.pm * 256 + ai * 128 + wr * 64;
        int b, tb;
        if (!samp) { b = R0 >> 11; tb = R0 & 2047; } else { b = (R0 - NPROMPT) >> 6; tb = 0; }
        const int posb = samp ? 2048 : tb;
        const int T = samp ? 64 : 2048;
        if (blk < 8) {
          const int head = blk & 3;
          const int f0 = 16 * wc + 4 * fq;
          const float l2g = log2gamma(head);
#pragma unroll
          for (int m = 0; m < 4; ++m) {
            __builtin_amdgcn_sched_barrier(0);
            const int rr = 16 * m + fr, g = R0 + rr, pos = posb + rr;
            const f32x4 v0 = acc[ai][bj][m][0], v1 = acc[ai][bj][m][1];
            const f32x4 cs = *(const f32x4*)(p.cosR() + pos * 64 + f0), sn = *(const f32x4*)(p.sinR() + pos * 64 + f0);
            f32x4 o0 = v0 * cs - v1 * sn, o1 = v1 * cs + v0 * sn;
            if (blk < 4) {
              *(s16x4*)(p.qr() + (unsigned)g * 512 + head * 128 + f0) = pack4(o0);
              *(s16x4*)(p.qr() + (unsigned)g * 512 + head * 128 + 64 + f0) = pack4(o1);
            } else {
              o0 *= 0.08838834764831845f; o1 *= 0.08838834764831845f;
              *(s16x4*)(p.kr() + (unsigned)g * 512 + head * 128 + f0) = pack4(o0);
              *(s16x4*)(p.kr() + (unsigned)g * 512 + head * 128 + 64 + f0) = pack4(o1);
              const float dec = exp2f((float)(63 - (rr & 63)) * l2g);
#pragma unroll
              for (int j = 0; j < 4; ++j) {
                tl[(4 * fq + j) * 64 + rr] = f2bf(o0[j] * dec);
                tl[(16 + 4 * fq + j) * 64 + rr] = f2bf(o1[j] * dec);
              }
            }
          }
          if (blk >= 4) {
#pragma unroll
            for (int i = 0; i < 4; ++i) {
              const int id = lane + 64 * i, cp = id >> 3, tg = id & 7;
              const bf16x8 v = *(const bf16x8*)(tl + cp * 64 + tg * 8);
              const int f = 64 * (cp >> 4) + 16 * wc + (cp & 15);
              u16* dst = samp ? p.krT() + (unsigned)64 * 128 * 2048 + ((unsigned)(b * 4 + head) * 128 + f) * 64 + tg * 8
                              : p.krT() + ((unsigned)(b * 4 + head) * 128 + f) * 2048 + tb + tg * 8;
              *(bf16x8*)dst = v;
            }
          }
        } else if (blk < 12 || blk == 21) {
#pragma unroll
          for (int m = 0; m < 4; ++m) {
            __builtin_amdgcn_sched_barrier(0);
            const int rr = 16 * m + fr, g = R0 + rr;
#pragma unroll
            for (int n = 0; n < 2; ++n) {
              const f32x4 v = acc[ai][bj][m][n];
              if (blk == 21) {
                float* o = samp ? p.out + OUT_VS + (unsigned)(g - NPROMPT) * 128 + P0 + 16 * n : p.out + OUT_VP + (unsigned)g * 128 + P0 + 16 * n;
                *(f32x4*)o = v;
              }
#pragma unroll
              for (int j = 0; j < 4; ++j) tl[(16 * n + 4 * fq + j) * 64 + rr] = f2bf(v[j]);
            }
          }
#pragma unroll
          for (int i = 0; i < 4; ++i) {
            const int id = lane + 64 * i, cp = id >> 3, tg = id & 7;
            const bf16x8 v = *(const bf16x8*)(tl + cp * 64 + tg * 8);
            const int f = 32 * wc + cp;
            u16* dst;
            if (blk < 12) {
              const int head = blk & 3;
              dst = samp ? p.vrT() + (unsigned)64 * 128 * 2048 + ((unsigned)(b * 4 + head) * 128 + f) * 64 + tg * 8
                         : p.vrT() + ((unsigned)(b * 4 + head) * 128 + f) * 2048 + tb + tg * 8;
            } else {
              const int kvh = f >> 6, d = f & 63;
              dst = samp ? p.vaTS() + ((unsigned)(b * 2 + kvh) * 64 + d) * 2112 + 2048 + tg * 8
                         : p.vaTP() + ((unsigned)(b * 2 + kvh) * 64 + d) * 2048 + tb + tg * 8;
            }
            *(bf16x8*)dst = v;
          }
        } else if ((blk >= 12 && blk < 16) || (blk >= 22 && blk < 26)) {
          const int colbase = (blk < 16) ? (blk - 12) * 128 : 512 + (blk - 22) * 128;
#pragma unroll
          for (int m = 0; m < 4; ++m) {
            __builtin_amdgcn_sched_barrier(0);
            const int g = R0 + 16 * m + fr;
#pragma unroll
            for (int n = 0; n < 2; ++n) {
              f32x4 v = acc[ai][bj][m][n];
              v[0] = siluf(v[0]); v[1] = siluf(v[1]); v[2] = siluf(v[2]); v[3] = siluf(v[3]);
              *(s16x4*)(p.gate() + (unsigned)g * 1024 + colbase + P0 + 16 * n) = pack4(v);
            }
          }
        } else {
          const bool ropew = ((wc & 1) == 0) && !(blk == 30 && wc >= 2);
#pragma unroll
          for (int m = 0; m < 4; ++m) {
            __builtin_amdgcn_sched_barrier(0);
            const int rr = 16 * m + fr, g = R0 + rr, pos = posb + rr;
            f32x4 v0 = acc[ai][bj][m][0];
            const f32x4 v1 = acc[ai][bj][m][1];
            if (ropew) {
              f32x4 pr;
              pr[0] = __shfl_xor(v0[0], 32); pr[1] = __shfl_xor(v0[1], 32); pr[2] = __shfl_xor(v0[2], 32); pr[3] = __shfl_xor(v0[3], 32);
              const f32x4 cs = *(const f32x4*)(p.cosA() + pos * 8 + 4 * (fq & 1)), sn = *(const f32x4*)(p.sinA() + pos * 8 + 4 * (fq & 1));
              v0 = (fq < 2) ? v0 * cs - pr * sn : v0 * cs + pr * sn;
            }
            if (blk < 20) {
              const float sc = 0.125f * 1.4426950408889634f;
              *(s16x4*)(p.qa() + (unsigned)g * 512 + (blk - 16) * 128 + P0) = pack4(v0 * sc);
              *(s16x4*)(p.qa() + (unsigned)g * 512 + (blk - 16) * 128 + P0 + 16) = pack4(v1 * sc);
            } else if (blk == 20) {
              float* o = samp ? p.out + OUT_KS + (unsigned)(g - NPROMPT) * 128 + P0 : p.out + OUT_KP + (unsigned)g * 128 + P0;
              *(f32x4*)o = v0; *(f32x4*)(o + 16) = v1;
              const int kvh = wc >> 1, d = P0 & 63;
              u16* dst = samp ? p.kaS() + ((unsigned)(b * 2 + kvh) * 2112 + 2048 + rr) * 64 + d
                              : p.kaP() + ((unsigned)(b * 2 + kvh) * 2048 + tb + rr) * 64 + d;
              *(s16x4*)dst = pack4(v0); *(s16x4*)(dst + 16) = pack4(v1);
            } else if (blk < 30) {
              *(s16x4*)(p.qi() + (unsigned)g * 512 + (blk - 26) * 128 + P0) = pack4(v0);
              *(s16x4*)(p.qi() + (unsigned)g * 512 + (blk - 26) * 128 + P0 + 16) = pack4(v1);
            } else {
              if (wc < 2) {
                float* o = samp ? p.out + OUT_KIS + (unsigned)(g - NPROMPT) * 64 + P0 : p.out + OUT_KIP + (unsigned)g * 64 + P0;
                *(f32x4*)o = v0; *(f32x4*)(o + 16) = v1;
                u16* dst = samp ? p.kiS() + ((unsigned)b * 2112 + 2048 + rr) * 64 + P0 : p.kiP() + ((unsigned)b * 2048 + tb + rr) * 64 + P0;
                *(s16x4*)dst = pack4(v0); *(s16x4*)(dst + 16) = pack4(v1);
              } else if (wc == 2 && fq < 2) {
                *(f32x4*)(p.wi() + (unsigned)g * 8 + 4 * fq) = v0 * 0.044194173824159216f;
              }
            }
          }
        }
      }
    }
  }
};

struct Epi2 {
  Params p;
  DI void operator()(f32x4 (&acc)[2][2][4][2], const pg8::Unit& u, int wr, int wc, int fr, int fq) const {
#pragma unroll
    for (int ai = 0; ai < 2; ++ai)
#pragma unroll
      for (int m = 0; m < 4; ++m) {
        const int g = u.pm * 256 + ai * 128 + wr * 64 + 16 * m + fr;
        const float* xr = xrow(p, g);
        float* yr = p.out + OUT_Y + (size_t)g * 1024;
#pragma unroll
        for (int bj = 0; bj < 2; ++bj)
#pragma unroll
          for (int n = 0; n < 2; ++n) {
            const int c = u.pn * 256 + bj * 128 + 32 * wc + 16 * n + 4 * fq;
            *(f32x4*)(yr + c) = acc[ai][bj][m][n] + *(const f32x4*)(xr + c);
          }
      }
  }
};

DI void ret_kv_item(const Params& p, int item, int tid) {
  const int lane = tid & 63, w = tid >> 6, r = lane & 31, hh = lane >> 5;
  const u16 *kT, *vT; int T, c;
  if (item < 2048) { const int bh = item >> 5; c = item & 31; T = 2048; kT = p.krT() + (size_t)bh * 128 * 2048; vT = p.vrT() + (size_t)bh * 128 * 2048; }
  else { const int bh = item - 2048; c = 0; T = 64; kT = p.krT() + (size_t)64 * 128 * 2048 + (size_t)bh * 128 * 64; vT = p.vrT() + (size_t)64 * 128 * 2048 + (size_t)bh * 128 * 64; }
  const int e0 = (w & 1) * 64, d0 = (w >> 1) * 64;
  f32x16 acc[2][2];
  acc[0][0] = zero16(); acc[0][1] = zero16(); acc[1][0] = zero16(); acc[1][1] = zero16();
#pragma unroll
  for (int ks = 0; ks < 4; ++ks) {
    bf16x8 a0 = ldg8(vT + (size_t)(e0 + r) * T + c * 64 + ks * 16 + hh * 8);
    bf16x8 a1 = ldg8(vT + (size_t)(e0 + 32 + r) * T + c * 64 + ks * 16 + hh * 8);
    bf16x8 b0 = ldg8(kT + (size_t)(d0 + r) * T + c * 64 + ks * 16 + hh * 8);
    bf16x8 b1 = ldg8(kT + (size_t)(d0 + 32 + r) * T + c * 64 + ks * 16 + hh * 8);
    acc[0][0] = MFMA32(a0, b0, acc[0][0]);
    acc[0][1] = MFMA32(a0, b1, acc[0][1]);
    acc[1][0] = MFMA32(a1, b0, acc[1][0]);
    acc[1][1] = MFMA32(a1, b1, acc[1][1]);
  }
  float* o = p.kvT() + (size_t)item * 16384;
#pragma unroll
  for (int a = 0; a < 2; ++a)
#pragma unroll
    for (int b = 0; b < 2; ++b)
#pragma unroll
      for (int i = 0; i < 16; ++i)
        o[(e0 + a * 32 + crow(i, hh)) * 128 + d0 + b * 32 + r] = acc[a][b][i];
}

DI void idx_item(const Params& p, unsigned char* lds, int tid, bool samp, int b, int grp) {
  const int lane = tid & 63, w = tid >> 6;
  const int t0 = grp * 16;
  int L, g0; const u16* ki;
  if (!samp) { const int c = t0 >> 6; L = (c + 1) * 64; g0 = b * 2048 + t0; ki = p.kiP() + (size_t)b * 2048 * 64; }
  else { L = 2112; g0 = NPROMPT + b * 64 + t0; ki = p.kiS() + (size_t)b * 2112 * 64; }
  const int nj = L >> 6;
  if (L <= 256) {
    for (int qq = 0; qq < 4; ++qq) {
      const int q = w * 4 + qq;
      if (lane < nj) p.maskbits()[(size_t)(g0 + q) * 33 + lane] = ~0ull;
    }
    return;
  }
  u16* keys = (u16*)lds;
  {
    const int qn = lane & 15, quad = lane >> 4;
    bf16x8 qf[8][2];
    float wv[8];
#pragma unroll
    for (int h = 0; h < 8; ++h) {
      qf[h][0] = ldg8(p.qi() + (size_t)(g0 + qn) * 512 + h * 64 + quad * 8);
      qf[h][1] = ldg8(p.qi() + (size_t)(g0 + qn) * 512 + h * 64 + 32 + quad * 8);
      wv[h] = p.wi()[(size_t)(g0 + qn) * 8 + h];
    }
    const int nt16 = L >> 4;
    for (int kt = w; kt < nt16; kt += 4) {
      bf16x8 a0 = ldg8(ki + (size_t)(kt * 16 + qn) * 64 + quad * 8);
      bf16x8 a1 = ldg8(ki + (size_t)(kt * 16 + qn) * 64 + 32 + quad * 8);
      float idx[4] = {0.f, 0.f, 0.f, 0.f};
#pragma unroll
      for (int h = 0; h < 8; ++h) {
        f32x4 acc = {0.f, 0.f, 0.f, 0.f};
        acc = MFMA16(a0, qf[h][0], acc);
        acc = MFMA16(a1, qf[h][1], acc);
#pragma unroll
        for (int i = 0; i < 4; ++i) idx[i] += fmaxf(acc[i], 0.f) * wv[h];
      }
      s16x4 kv;
#pragma unroll
      for (int i = 0; i < 4; ++i) {
        _Float16 hv = (_Float16)idx[i];
        u16 bits = __builtin_bit_cast(u16, hv);
        kv[i] = (short)((bits & 0x8000) ? (u16)~bits : (u16)(bits | 0x8000));
      }
      *(s16x4*)(keys + qn * KPITCH + kt * 16 + quad * 4) = kv;
    }
  }
  __syncthreads();
  for (int qq = 0; qq < 4; ++qq) {
    const int q = w * 4 + qq;
    unsigned key[33];
#pragma unroll
    for (int j = 0; j < 33; ++j) key[j] = (j < nj) ? (unsigned)keys[q * KPITCH + j * 64 + lane] : 0u;
    unsigned prefix = 0;
    for (int bit = 15; bit >= 0; --bit) {
      const unsigned cand = prefix | (1u << bit);
      int cnt = 0;
#pragma unroll
      for (int j = 0; j < 33; ++j) cnt += __popcll(__ballot(key[j] >= cand));
      if (cnt >= 256) prefix = cand;
    }
    int cgt = 0;
#pragma unroll
    for (int j = 0; j < 33; ++j) cgt += __popcll(__ballot(key[j] > prefix));
    const int rneed = 256 - cgt;
    int running = 0;
    u64 myword = 0;
    const u64 lt = (1ull << lane) - 1ull;
#pragma unroll
    for (int j = 0; j < 33; ++j) {
      const bool eq = key[j] == prefix;
      const u64 em = __ballot(eq);
      const int rank = running + __popcll(em & lt);
      const bool sel = (key[j] > prefix) || (eq && rank < rneed);
      const u64 sm = __ballot(sel);
      if (lane == j) myword = sm;
      running += __popcll(em);
    }
    if (lane < nj) p.maskbits()[(size_t)(g0 + q) * 33 + lane] = myword;
  }
  __syncthreads();
}

DI void scan_item(const Params& p, int item, int tid) {
  if (item < 1024) {
    const int bh = item >> 4, slab = item & 15;
    const int idx = slab * 1024 + tid * 4;
    const int h = bh & 3;
    const float cd = exp2f(64.f * log2gamma(h));
    f32x4 s = {0.f, 0.f, 0.f, 0.f};
    for (int c = 0; c < 32; ++c) {
      const size_t base = (size_t)(bh * 32 + c) * 16384 + idx;
      s16x4 o; o[0] = (short)f2bf(s[0]); o[1] = (short)f2bf(s[1]); o[2] = (short)f2bf(s[2]); o[3] = (short)f2bf(s[3]);
      *(s16x4*)(p.sprevT() + base) = o;
      f32x4 kv = *(const f32x4*)(p.kvT() + base);
      s = s * cd + kv;
    }
    const int e = idx >> 7, d = idx & 127;
    float* o = p.out + OUT_STP + (size_t)bh * 16384;
#pragma unroll
    for (int j = 0; j < 4; ++j) o[(d + j) * 128 + e] = s[j];
  } else {
    const int it = item - 1024;
    const int bh = it >> 4, slab = it & 15;
    const int idx = slab * 1024 + tid * 4;
    const int h = bh & 3;
    const float cd = exp2f(64.f * log2gamma(h));
    const int e = idx >> 7, d = idx & 127;
    const float* s0 = p.state_ret + (size_t)bh * 16384;
    f32x4 s;
#pragma unroll
    for (int j = 0; j < 4; ++j) s[j] = s0[(d + j) * 128 + e];
    const size_t base = (size_t)(2048 + bh) * 16384 + idx;
    s16x4 o; o[0] = (short)f2bf(s[0]); o[1] = (short)f2bf(s[1]); o[2] = (short)f2bf(s[2]); o[3] = (short)f2bf(s[3]);
    *(s16x4*)(p.sprevT() + base) = o;
    f32x4 kv = *(const f32x4*)(p.kvT() + base);
    s = s * cd + kv;
    float* oo = p.out + OUT_STS + (size_t)bh * 16384;
#pragma unroll
    for (int j = 0; j < 4; ++j) oo[(d + j) * 128 + e] = s[j];
  }
}

DI void attn_item(const Params& p, unsigned char* lds, int tid, bool samp, int b, int c, int kvh, int qh) {
  const int lane = tid & 63, w = tid >> 6, r = lane & 31, hh = lane >> 5;
  const int T = samp ? 2112 : 2048;
  const int nkt = samp ? 33 : c + 1;
  const int g0 = (samp ? NPROMPT + b * 64 : b * 2048 + c * 64) + qh * 32;
  const u16* K = samp ? p.kaS() + (size_t)(b * 2 + kvh) * 2112 * 64 : p.kaP() + (size_t)(b * 2 + kvh) * 2048 * 64;
  const u16* VT = samp ? p.vaTS() + (size_t)(b * 2 + kvh) * 64 * 2112 : p.vaTP() + (size_t)(b * 2 + kvh) * 64 * 2048;
  const int head = kvh * 4 + w;
  u16* Ks = (u16*)lds;
  u16* Vs = Ks + 64 * 72;
  u64* mL = (u64*)(lds + 2 * 9216);
  for (int i = tid; i < 32 * 33; i += 256) mL[i] = p.maskbits()[(size_t)g0 * 33 + i];
  bf16x8 qf[4];
#pragma unroll
  for (int ks = 0; ks < 4; ++ks) qf[ks] = ldg8(p.qa() + (size_t)(g0 + r) * 512 + head * 64 + ks * 16 + hh * 8);
  f32x16 O[2];
  O[0] = zero16(); O[1] = zero16();
  float mrun = -1e30f, lrun = 0.f;
  const int lrow = tid >> 3, lch = tid & 7;
  bf16x8 pk0, pk1, pv0, pv1;
  pk0 = ldg8(K + (size_t)(lrow)*64 + lch * 8);
  pk1 = ldg8(K + (size_t)(lrow + 32) * 64 + lch * 8);
  pv0 = ldg8(VT + (size_t)(lrow)*T + lch * 8);
  pv1 = ldg8(VT + (size_t)(lrow + 32) * T + lch * 8);
  for (int kt = 0; kt < nkt; ++kt) {
    __syncthreads();
    *(bf16x8*)(Ks + lrow * 72 + lch * 8) = pk0;
    *(bf16x8*)(Ks + (lrow + 32) * 72 + lch * 8) = pk1;
    *(bf16x8*)(Vs + lrow * 72 + lch * 8) = pv0;
    *(bf16x8*)(Vs + (lrow + 32) * 72 + lch * 8) = pv1;
    __syncthreads();
    if (kt + 1 < nkt) {
      pk0 = ldg8(K + (size_t)((kt + 1) * 64 + lrow) * 64 + lch * 8);
      pk1 = ldg8(K + (size_t)((kt + 1) * 64 + lrow + 32) * 64 + lch * 8);
      pv0 = ldg8(VT + (size_t)(lrow)*T + (kt + 1) * 64 + lch * 8);
      pv1 = ldg8(VT + (size_t)(lrow + 32) * T + (kt + 1) * 64 + lch * 8);
    }
    f32x16 S[2];
#pragma unroll
    for (int st = 0; st < 2; ++st) {
      S[st] = zero16();
#pragma unroll
      for (int ks = 0; ks < 4; ++ks) {
        bf16x8 kf = *(const bf16x8*)(Ks + (st * 32 + r) * 72 + ks * 16 + hh * 8);
        S[st] = MFMA32(kf, qf[ks], S[st]);
      }
    }
    const u64 W = mL[r * 33 + kt];
    const unsigned wl = ((unsigned)W) >> (4 * hh), wh = ((unsigned)(W >> 32)) >> (4 * hh);
    float mx = -1e30f;
#pragma unroll
    for (int st = 0; st < 2; ++st)
#pragma unroll
      for (int i = 0; i < 16; ++i) {
        const unsigned bit = ((st ? wh : wl) >> ((i & 3) + 8 * (i >> 2))) & 1u;
        const float s = bit ? S[st][i] : -1e30f;
        S[st][i] = s;
        mx = fmaxf(mx, s);
      }
    mx = fmaxf(mx, __shfl_xor(mx, 32));
    const float mn = fmaxf(mrun, mx);
    const float alpha = __builtin_amdgcn_exp2f(mrun - mn);
    mrun = mn;
    float ls = 0.f;
#pragma unroll
    for (int st = 0; st < 2; ++st)
#pragma unroll
      for (int i = 0; i < 16; ++i) {
        const float pvv = __builtin_amdgcn_exp2f(S[st][i] - mn);
        S[st][i] = pvv;
        ls += pvv;
      }
    lrun = lrun * alpha + ls;
#pragma unroll
    for (int dt = 0; dt < 2; ++dt)
#pragma unroll
      for (int i = 0; i < 16; ++i) O[dt][i] *= alpha;
#pragma unroll
    for (int st = 0; st < 2; ++st)
#pragma unroll
      for (int s2 = 0; s2 < 2; ++s2) {
        bf16x8 pf = pack8(S[st][8 * s2 + 0], S[st][8 * s2 + 1], S[st][8 * s2 + 2], S[st][8 * s2 + 3],
                          S[st][8 * s2 + 4], S[st][8 * s2 + 5], S[st][8 * s2 + 6], S[st][8 * s2 + 7]);
#pragma unroll
        for (int dt = 0; dt < 2; ++dt) {
          s16x4 lo = *(const s16x4*)(Vs + (dt * 32 + r) * 72 + st * 32 + 16 * s2 + 4 * hh);
          s16x4 hi = *(const s16x4*)(Vs + (dt * 32 + r) * 72 + st * 32 + 16 * s2 + 8 + 4 * hh);
          bf16x8 vf = __builtin_shufflevector(lo, hi, 0, 1, 2, 3, 4, 5, 6, 7);
          O[dt] = MFMA32(vf, pf, O[dt]);
        }
      }
  }
  {
    float lt = lrun + __shfl_xor(lrun, 32);
    const float inv = 1.f / lt;
    const u16* grow = p.gate() + (size_t)(g0 + r) * 1024 + 512 + head * 64;
    u16* mrow = p.mix() + (size_t)(g0 + r) * 1024 + 512 + head * 64;
#pragma unroll
    for (int dt = 0; dt < 2; ++dt)
#pragma unroll
      for (int q4 = 0; q4 < 4; ++q4) {
        const int d = dt * 32 + 8 * q4 + 4 * hh;
        s16x4 gv = *(const s16x4*)(grow + d);
        s16x4 ov;
#pragma unroll
        for (int j = 0; j < 4; ++j) {
          const float gf = __uint_as_float(((unsigned)(u16)gv[j]) << 16);
          ov[j] = (short)f2bf(O[dt][q4 * 4 + j] * inv * gf);
        }
        *(s16x4*)(mrow + d) = ov;
      }
  }
  __syncthreads();
}

DI void ret_out_item(const Params& p, unsigned char* lds, int item, int tid) {
  const int lane = tid & 63, w = tid >> 6, r = lane & 31, hh = lane >> 5;
  int bh, c, T, g0; const u16* vT;
  if (item < 2048) { bh = item >> 5; c = item & 31; T = 2048; g0 = (bh >> 2) * 2048 + c * 64; vT = p.vrT() + (size_t)bh * 128 * 2048; }
  else { bh = item - 2048; c = 0; T = 64; g0 = NPROMPT + (bh >> 2) * 64; vT = p.vrT() + (size_t)64 * 128 * 2048 + (size_t)bh * 128 * 64; }
  const int h = bh & 3;
  const float l2g = log2gamma(h);
  const int nt = w & 1, eh = w >> 1;
  const int n = nt * 32 + r;
  bf16x8 qf[8];
#pragma unroll
  for (int ks = 0; ks < 8; ++ks) qf[ks] = ldg8(p.qr() + (size_t)(g0 + n) * 512 + h * 128 + ks * 16 + hh * 8);
  bf16x8 pf[2][2];
#pragma unroll
  for (int mt = 0; mt < 2; ++mt) {
    f32x16 S = zero16();
#pragma unroll
    for (int ks = 0; ks < 8; ++ks) {
      bf16x8 kf = ldg8(p.kr() + (size_t)(g0 + mt * 32 + r) * 512 + h * 128 + ks * 16 + hh * 8);
      S = MFMA32(kf, qf[ks], S);
    }
#pragma unroll
    for (int i = 0; i < 16; ++i) {
      const int m = mt * 32 + crow(i, hh);
      const int dd = n > m ? n - m : m - n;
      S[i] *= exp2f((float)dd * l2g);
    }
    pf[mt][0] = pack8(S[0], S[1], S[2], S[3], S[4], S[5], S[6], S[7]);
    pf[mt][1] = pack8(S[8], S[9], S[10], S[11], S[12], S[13], S[14], S[15]);
  }
  const float fs = exp2f((float)(n + 1) * l2g);
  const u16* sp = p.sprevT() + (size_t)item * 16384;
  f32x16 tot[2];
  float ss = 0.f;
#pragma unroll
  for (int et = 0; et < 2; ++et) {
    const int e = (2 * eh + et) * 32 + r;
    f32x16 Oi = zero16(), X = zero16();
#pragma unroll
    for (int mt = 0; mt < 2; ++mt)
#pragma unroll
      for (int s2 = 0; s2 < 2; ++s2) {
        const u16* vp = vT + (size_t)e * T + c * 64 + mt * 32 + 16 * s2 + 4 * hh;
        s16x4 lo = ldg4(vp), hi = ldg4(vp + 8);
        bf16x8 vf = __builtin_shufflevector(lo, hi, 0, 1, 2, 3, 4, 5, 6, 7);
        Oi = MFMA32(vf, pf[mt][s2], Oi);
      }
#pragma unroll
    for (int ks = 0; ks < 8; ++ks) {
      bf16x8 sf = ldg8(sp + (size_t)e * 128 + ks * 16 + hh * 8);
      X = MFMA32(sf, qf[ks], X);
    }
#pragma unroll
    for (int i = 0; i < 16; ++i) { const float t = Oi[i] + X[i] * fs; tot[et][i] = t; ss += t * t; }
  }
  ss += __shfl_xor(ss, 32);
  float* red = (float*)lds;
  __syncthreads();
  if (hh == 0) red[w * 32 + r] = ss;
  __syncthreads();
  const float tsum = red[w * 32 + r] + red[(w ^ 2) * 32 + r];
  const float rinv = rsqrtf(tsum * (1.f / 128.f) + 1e-6f);
  const u16* grow = p.gate() + (size_t)(g0 + n) * 1024 + h * 128;
  u16* mrow = p.mix() + (size_t)(g0 + n) * 1024 + h * 128;
#pragma unroll
  for (int et = 0; et < 2; ++et)
#pragma unroll
    for (int q4 = 0; q4 < 4; ++q4) {
      const int e = (2 * eh + et) * 32 + 8 * q4 + 4 * hh;
      s16x4 gv = *(const s16x4*)(grow + e);
      f32x4 gg = *(const f32x4*)(p.ret_gn_g + h * 128 + e);
      s16x4 ov;
#pragma unroll
      for (int j = 0; j < 4; ++j) {
        const float gf = __uint_as_float(((unsigned)(u16)gv[j]) << 16);
        ov[j] = (short)f2bf(tot[et][q4 * 4 + j] * rinv * gg[j] * gf);
      }
      *(s16x4*)(mrow + e) = ov;
    }
}

DI void phase_final(const Params& p, int tid) {
  const int gt = blockIdx.x * 512 + tid, GT = gridDim.x * 512;
  const int lane = tid & 63;
  for (int row = gt >> 6; row < NTOK; row += (GT >> 6)) {
    float* y = p.out + OUT_Y + (size_t)row * 1024;
    f32x4 v[4];
    float ss = 0.f;
#pragma unroll
    for (int i = 0; i < 4; ++i) { v[i] = *(const f32x4*)(y + i * 256 + lane * 4); ss += v[i][0] * v[i][0] + v[i][1] * v[i][1] + v[i][2] * v[i][2] + v[i][3] * v[i][3]; }
#pragma unroll
    for (int o = 32; o >= 1; o >>= 1) ss += __shfl_xor(ss, o);
    const float rv = rsqrtf(ss * (1.f / 1024.f) + 1e-6f);
#pragma unroll
    for (int i = 0; i < 4; ++i) {
      f32x4 g = *(const f32x4*)(p.final_g + i * 256 + lane * 4);
      f32x4 o = v[i] * rv * g;
      *(f32x4*)(y + i * 256 + lane * 4) = o;
    }
  }
}

__global__ void __launch_bounds__(512, 2) fwd_megakernel(Params p) {
  __shared__ __attribute__((aligned(16))) unsigned char lds[LDS_BYTES];
  cg::grid_group grid = cg::this_grid();
#define FRESH_TID() int tid = threadIdx.x; asm volatile("" : "+v"(tid)); const int half = tid >> 8, htid = tid & 255; unsigned char* ldsh = lds + half * HALF_LDS; (void)htid; (void)ldsh;
  { FRESH_TID(); phase_prep(p, tid); }
  grid.sync();
  {
    FRESH_TID();
    pg8::Gemm g; g.A = p.xb(); g.Bt = p.WtIn(); g.M = NTOK; g.N = 4096; g.K = 1024;
    pg8::StaticOrder S; S.init(g.M, g.N, (int)gridDim.x, (int)blockIdx.x);
    Epi1 E; E.p = p; E.tl = (u16*)(lds + pg8::STAGE_BYTES + (tid >> 6) * 4096);
    pg8::gemm_phase<Epi1>((LAS unsigned char*)lds, g, S, E);
  }
  grid.sync();
  {
    FRESH_TID();
    for (int it0 = blockIdx.x * 2; it0 < 2080 + 2080; it0 += gridDim.x * 2) {
      const int it = it0 + half;
      int ht = htid; asm volatile("" : "+v"(ht));
      if (it < 2080) {
        const bool samp = it < 32;
        const int j = it - 32;
        const int c = 31 - (j >> 6);
        const int b = samp ? (it >> 2) : ((j & 63) >> 2);
        const int grp = samp ? (it & 3) : (c * 4 + (j & 3));
        idx_item(p, ldsh, ht, samp, b, grp);
      } else ret_kv_item(p, it - 2080, ht);
    }
  }
  grid.sync();
  {
    FRESH_TID();
    for (int it0 = blockIdx.x * 2; it0 < 2080 + 1536; it0 += gridDim.x * 2) {
      const int it = it0 + half;
      int ht = htid; asm volatile("" : "+v"(ht));
      if (it < 2080) {
        const bool samp = it < 32;
        const int j = it - 32;
        const int c = samp ? 0 : 31 - (j >> 6);
        const int b = samp ? (it >> 2) : ((j & 63) >> 2);
        attn_item(p, ldsh, ht, samp, b, c, (it >> 1) & 1, it & 1);
      } else scan_item(p, it - 2080, ht);
    }
  }
  grid.sync();
  {
    FRESH_TID();
    for (int it0 = blockIdx.x * 2; it0 < 2080; it0 += gridDim.x * 2) { int ht = htid; asm volatile("" : "+v"(ht)); ret_out_item(p, ldsh, it0 + half, ht); }
  }
  grid.sync();
  {
    pg8::Gemm g; g.A = p.mix(); g.Bt = p.WtOut(); g.M = NTOK; g.N = 1024; g.K = 1024;
    pg8::StaticOrder S; S.init(g.M, g.N, (int)gridDim.x, (int)blockIdx.x);
    Epi2 E; E.p = p;
    pg8::gemm_phase<Epi2>((LAS unsigned char*)lds, g, S, E);
  }
  grid.sync();
  { FRESH_TID(); phase_final(p, tid); }
}

extern "C" void kernel_launch(void* const* d_in, const int* in_sizes, int n_in, void* d_out, int out_size, void* d_ws,
                              size_t ws_size, hipStream_t stream) {
  static int grid_blocks = 0;
  if (!grid_blocks) {
    int dev = 0, cus = 0, per_cu = 0;
    (void)hipGetDevice(&dev);
    (void)hipDeviceGetAttribute(&cus, hipDeviceAttributeMultiprocessorCount, dev);
    (void)hipOccupancyMaxActiveBlocksPerMultiprocessor(&per_cu, fwd_megakernel, 512, 0);
    if (per_cu < 1) per_cu = 1;
    if (per_cu > 1) per_cu = 1;
    grid_blocks = cus * per_cu;
  }
  Params p{};
  p.x_p = (const float*)d_in[0]; p.x_s = (const float*)d_in[1]; p.state_ret = (const float*)d_in[2];
  p.cache_k = (const float*)d_in[3]; p.cache_v = (const float*)d_in[4]; p.cache_kidx = (const float*)d_in[5];
  p.norm_g = (const float*)d_in[6]; p.w_in = (const float*)d_in[7]; p.ret_gn_g = (const float*)d_in[8];
  p.w_out = (const float*)d_in[9]; p.final_g = (const float*)d_in[10];
  p.out = (float*)d_out;
  p.ws = (unsigned char*)d_ws;
  void* args[] = {&p};
  hipError_t e = hipLaunchCooperativeKernel((void*)fwd_megakernel, dim3(grid_blocks), dim3(512), args, 0, stream);
  if (e != hipSuccess) fprintf(stderr, "cooperative launch failed: %s (grid %d)\n", hipGetErrorString(e), grid_blocks);
}
```

```cpp
#include <hip/hip_runtime.h>
#include <hip/hip_cooperative_groups.h>
#include <stdint.h>
#include <cstdio>
namespace cg = cooperative_groups;

typedef __attribute__((ext_vector_type(8))) short bf16x8;
typedef __attribute__((ext_vector_type(4))) short s16x4;
typedef __attribute__((ext_vector_type(16))) float f32x16;
typedef __attribute__((ext_vector_type(4))) float f32x4;
typedef unsigned short u16;
typedef unsigned long long u64;


#define DI __device__ __forceinline__
#define MFMA32(a, b, c) __builtin_amdgcn_mfma_f32_32x32x16_bf16((a), (b), (c), 0, 0, 0)
#define MFMA16(a, b, c) __builtin_amdgcn_mfma_f32_16x16x32_bf16((a), (b), (c), 0, 0, 0)

#define NTOK 33280
#define NPROMPT 32768
#define LDS_BYTES 163840
#define HALF_LDS 81920
#define LAS __attribute__((address_space(3)))
#define KPITCH 2116

struct Params {
  const float *x_p, *x_s, *state_ret, *cache_k, *cache_v, *cache_kidx, *norm_g, *w_in, *ret_gn_g, *w_out, *final_g;
  float* out;
  unsigned char* ws;
  DI u16* xb() const { return (u16*)(ws + 0ull); }
  DI float* kvT() const { return (float*)(ws + 0ull); }
  DI u16* WtIn() const { return (u16*)(ws + 136314880ull); }
  DI u16* WtOut() const { return (u16*)(ws + 144703488ull); }
  DI u16* qr() const { return (u16*)(ws + 146800640ull); }
  DI u16* kr() const { return (u16*)(ws + 180879360ull); }
  DI u16* sprevT() const { return (u16*)(ws + 214958080ull); }
  DI u16* qi() const { return (u16*)(ws + 214958080ull); }
  DI u16* krT() const { return (u16*)(ws + 249036800ull); }
  DI u16* vrT() const { return (u16*)(ws + 283115520ull); }
  DI u16* gate() const { return (u16*)(ws + 317194240ull); }
  DI u16* mix() const { return (u16*)(ws + 385351680ull); }
  DI u16* qa() const { return (u16*)(ws + 453509120ull); }
  DI u16* kaP() const { return (u16*)(ws + 487587840ull); }
  DI u16* kaS() const { return (u16*)(ws + 495976448ull); }
  DI u16* vaTP() const { return (u16*)(ws + 500301824ull); }
  DI u16* vaTS() const { return (u16*)(ws + 508690432ull); }
  DI u16* kiP() const { return (u16*)(ws + 513015808ull); }
  DI u16* kiS() const { return (u16*)(ws + 517210112ull); }
  DI float* rinv() const { return (float*)(ws + 519372800ull); }
  DI float* wi() const { return (float*)(ws + 519505920ull); }
  DI float* cosR() const { return (float*)(ws + 520570880ull); }
  DI float* sinR() const { return (float*)(ws + 521111552ull); }
  DI float* cosA() const { return (float*)(ws + 521652224ull); }
  DI float* sinA() const { return (float*)(ws + 521719808ull); }
  DI u64* maskbits() const { return (u64*)(ws + 521787392ull); }
};

#define OUT_Y 0
#define OUT_STP (34078720)
#define OUT_KP (OUT_STP + 1048576)
#define OUT_VP (OUT_KP + 4194304)
#define OUT_KIP (OUT_VP + 4194304)
#define OUT_STS (OUT_KIP + 2097152)
#define OUT_KS (OUT_STS + 524288)
#define OUT_VS (OUT_KS + 65536)
#define OUT_KIS (OUT_VS + 65536)

typedef __bf16 bf16x2_t __attribute__((ext_vector_type(2)));
typedef float f32x2_t __attribute__((ext_vector_type(2)));
typedef unsigned u32x4_t __attribute__((ext_vector_type(4)));
typedef unsigned u32x2_t __attribute__((ext_vector_type(2)));
DI unsigned pk2(float a, float b) { f32x2_t v = {a, b}; bf16x2_t r = __builtin_convertvector(v, bf16x2_t); return __builtin_bit_cast(unsigned, r); }
DI u16 f2bf(float x) { return (u16)(pk2(x, x) & 0xffffu); }
DI bf16x8 ldg8(const u16* p) { return *(const bf16x8*)p; }
DI s16x4 ldg4(const u16* p) { return *(const s16x4*)p; }
DI float siluf(float x) { return x / (1.f + __expf(-x)); }
DI int crow(int reg, int hh) { return (reg & 3) + 8 * (reg >> 2) + 4 * hh; }
DI const float* xrow(const Params& p, int g) { return g < NPROMPT ? p.x_p + (size_t)g * 1024 : p.x_s + (size_t)(g - NPROMPT) * 1024; }
DI float log2gamma(int h) { return log1pf(-exp2f(-5.f - (float)h)) * 1.4426950408889634f; }
DI bf16x8 pack8(float a0, float a1, float a2, float a3, float a4, float a5, float a6, float a7) {
  u32x4_t v = {pk2(a0, a1), pk2(a2, a3), pk2(a4, a5), pk2(a6, a7)};
  return __builtin_bit_cast(bf16x8, v);
}
DI s16x4 pack4(f32x4 v) { u32x2_t o = {pk2(v[0], v[1]), pk2(v[2], v[3])}; return __builtin_bit_cast(s16x4, o); }
DI int wave_sum(int v) {
  v += __builtin_amdgcn_update_dpp(0, v, 0xB1, 0xf, 0xf, false);
  v += __builtin_amdgcn_update_dpp(0, v, 0x4E, 0xf, 0xf, false);
  v += __builtin_amdgcn_update_dpp(0, v, 0x124, 0xf, 0xf, false);
  v += __builtin_amdgcn_update_dpp(0, v, 0x128, 0xf, 0xf, false);
  return __builtin_amdgcn_readlane(v, 0) + __builtin_amdgcn_readlane(v, 16) + __builtin_amdgcn_readlane(v, 32) + __builtin_amdgcn_readlane(v, 48);
}
DI f32x16 zero16() { f32x16 z; for (int i = 0; i < 16; ++i) z[i] = 0.f; return z; }

DI void phase_prep(const Params& p, int tid) {
  const int gt = blockIdx.x * 512 + tid, GT = gridDim.x * 512;
  const int lane = tid & 63;
  for (int row = gt >> 6; row < NTOK; row += (GT >> 6)) {
    const float* src = xrow(p, row);
    float ss = 0.f;
    f32x4 v[4];
#pragma unroll
    for (int i = 0; i < 4; ++i) { v[i] = *(const f32x4*)(src + i * 256 + lane * 4); ss += v[i][0] * v[i][0] + v[i][1] * v[i][1] + v[i][2] * v[i][2] + v[i][3] * v[i][3]; }
#pragma unroll
    for (int o = 32; o >= 1; o >>= 1) ss += __shfl_xor(ss, o);
#pragma unroll
    for (int i = 0; i < 4; ++i) {
      s16x4 o = pack4(v[i]);
      *(s16x4*)(p.xb() + (size_t)row * 1024 + i * 256 + lane * 4) = o;
    }
    if (lane == 0) p.rinv()[row] = rsqrtf(ss * (1.f / 1024.f) + 1e-6f);
  }
  for (int i = gt; i < 4096 * 128; i += GT) {
    int n = i & 4095, kg = i >> 12;
    int sc = n;
    if (n < 1024) { const int P = n & 127; sc = (n & ~127) + 64 * ((P >> 4) & 1) + 16 * (P >> 5) + (P & 15); }
    float a[8];
#pragma unroll
    for (int j = 0; j < 8; ++j) a[j] = (n < 3912) ? p.w_in[(size_t)(kg * 8 + j) * 3912 + sc] * p.norm_g[kg * 8 + j] : 0.f;
    *(bf16x8*)(p.WtIn() + (size_t)n * 1024 + kg * 8) = pack8(a[0], a[1], a[2], a[3], a[4], a[5], a[6], a[7]);
  }
  for (int i = gt; i < 1024 * 128; i += GT) {
    int n = i % 1024, kg = i / 1024;
    float a[8];
#pragma unroll
    for (int j = 0; j < 8; ++j) a[j] = p.w_out[(size_t)(kg * 8 + j) * 1024 + n];
    *(bf16x8*)(p.WtOut() + (size_t)n * 1024 + kg * 8) = pack8(a[0], a[1], a[2], a[3], a[4], a[5], a[6], a[7]);
  }
  for (int i = gt; i < 2112 * 64; i += GT) {
    int pos = i >> 6, k = i & 63;
    float inv = powf(10000.f, -(float)k / 64.f);
    float ang = (float)pos * inv;
    p.cosR()[i] = cosf(ang); p.sinR()[i] = sinf(ang);
  }
  for (int i = gt; i < 2112 * 8; i += GT) {
    int pos = i >> 3, k = i & 7;
    float inv = powf(500000.f, -(float)k / 8.f);
    float ang = (float)pos * inv;
    p.cosA()[i] = cosf(ang); p.sinA()[i] = sinf(ang);
  }
  for (int i = gt; i < 8 * 2048 * 2 * 8; i += GT) {
    int dg = i & 7, kvh = (i >> 3) & 1, t = (i >> 4) & 2047, b = i >> 15;
    const float* s = p.cache_k + ((size_t)(b * 2048 + t) * 2 + kvh) * 64 + dg * 8;
    *(bf16x8*)(p.kaS() + ((size_t)(b * 2 + kvh) * 2112 + t) * 64 + dg * 8) = pack8(s[0], s[1], s[2], s[3], s[4], s[5], s[6], s[7]);
  }
  for (int i = gt; i < 8 * 2 * 256 * 64; i += GT) {
    int d = i & 63, tg = (i >> 6) & 255, kvh = (i >> 14) & 1, b = i >> 15;
    float a[8];
#pragma unroll
    for (int j = 0; j < 8; ++j) a[j] = p.cache_v[((size_t)(b * 2048 + tg * 8 + j) * 2 + kvh) * 64 + d];
    *(bf16x8*)(p.vaTS() + ((size_t)(b * 2 + kvh) * 64 + d) * 2112 + tg * 8) = pack8(a[0], a[1], a[2], a[3], a[4], a[5], a[6], a[7]);
  }
  for (int i = gt; i < 8 * 2048 * 8; i += GT) {
    int dg = i & 7, t = (i >> 3) & 2047, b = i >> 14;
    const float* s = p.cache_kidx + (size_t)(b * 2048 + t) * 64 + dg * 8;
    *(bf16x8*)(p.kiS() + ((size_t)b * 2112 + t) * 64 + dg * 8) = pack8(s[0], s[1], s[2], s[3], s[4], s[5], s[6], s[7]);
  }
}

namespace pg8 {
constexpr int BM = 256, BK = 64, HALF = 128, HTB = HALF * BK * 2, STAGE_BYTES = 8 * HTB, NXCD = 8, WGM = 8;
DI int lds_byte(int r, int c) { const int st = (r >> 4) * 2 + (c >> 5), rr = r & 15, cc = c & 31, ob = rr * 64 + cc * 2; return st * 1024 + (ob ^ (((ob >> 9) & 1) << 5)); }
DI void stage_rc(int b, int& R, int& C) { const int st = b / 1024, sb = b % 1024, swz = sb ^ (((sb >> 9) & 1) << 5); R = (st >> 1) * 16 + swz / 64; C = (st & 1) * 32 + (swz % 64) / 2; }
struct Unit { int pm, pn; };
struct Gemm { const u16* A; const u16* Bt; int M, N, K; };
struct StaticOrder {
  int nM, nN, nwg, G, c;
  DI void init(int M, int N, int G_, int c_) { nM = M / BM; nN = N / BM; nwg = nM * nN; G = G_; c = c_; }
  DI bool next(int i, Unit& u) const {
    const long L = (long)i * G + c; if (L >= nwg) return false;
    int wgid = (int)L; { const int q = nwg / NXCD, r = nwg % NXCD, xcd = wgid % NXCD, off = wgid / NXCD; wgid = (xcd < r ? xcd * (q + 1) : r * (q + 1) + (xcd - r) * q) + off; }
    const int nig = WGM * nN, gid = wgid / nig, fm = gid * WGM, gsz = (nM - fm) < WGM ? (nM - fm) : WGM;
    u.pm = fm + ((wgid % nig) % gsz); u.pn = (wgid % nig) / gsz; return true;
  }
};
template <class Epi>
DI void gemm_phase(LAS unsigned char* lds, const Gemm g, const StaticOrder& S, const Epi& E) {
  int tid = threadIdx.x; asm volatile("" : "+v"(tid));
  const int wid = __builtin_amdgcn_readfirstlane(tid >> 6), lane = tid & 63, wr = wid >> 2, wc = wid & 3, fr = lane & 15, fq = lane >> 4;
  const int K = g.K, nt = K / BK;
  unsigned voffA[2], voffB[2];
#pragma unroll
  for (int i = 0; i < 2; ++i) { int R, C; stage_rc(tid * 16 + i * 8192, R, C); voffA[i] = (unsigned)(R * K + C) * 2u; voffB[i] = voffA[i]; }
  const size_t kstep = (size_t)(BK * 2);
  const size_t hstep = (size_t)HALF * K * 2;
  const size_t tstep = 2 * hstep;
  const unsigned ldsw = (unsigned)wid * 1024u;
  const int aoff = lds_byte(wr * 64 + fr, fq * 8), boff = lds_byte(wc * 32 + fr, fq * 8);
#define PG8_SA(b, h) (((b) * 2 + (h)) * HTB)
#define PG8_SB(b, h) ((4 + (b) * 2 + (h)) * HTB)
#define PG8_STAGE(bufoff, gbase, voff) do { _Pragma("unroll") for (int _i = 0; _i < 2; ++_i) \
    __builtin_amdgcn_global_load_lds((const unsigned*)((const char*)(gbase) + (voff)[_i]), (LAS unsigned*)(lds + (bufoff) + ldsw + _i * 8192), 16, 0, 0); } while (0)
#define PG8_LDA(dst, b, h) do { _Pragma("unroll") for (int m = 0; m < 4; ++m) _Pragma("unroll") for (int k = 0; k < 2; ++k) dst[m][k] = *(const LAS bf16x8*)(lds + PG8_SA(b, h) + aoff + m * 2048 + k * 1024); } while (0)
#define PG8_LDB(dst, b, h) do { _Pragma("unroll") for (int n = 0; n < 2; ++n) _Pragma("unroll") for (int k = 0; k < 2; ++k) dst[n][k] = *(const LAS bf16x8*)(lds + PG8_SB(b, h) + boff + n * 2048 + k * 1024); } while (0)
#define PG8_MMA(ai, bj, At, Bt) do { __builtin_amdgcn_s_setprio(1); _Pragma("unroll") for (int m = 0; m < 4; ++m) _Pragma("unroll") for (int n = 0; n < 2; ++n) _Pragma("unroll") for (int k = 0; k < 2; ++k) \
    acc[ai][bj][m][n] = __builtin_amdgcn_mfma_f32_16x16x32_bf16(Bt[n][k], At[m][k], acc[ai][bj][m][n], 0, 0, 0); __builtin_amdgcn_s_setprio(0); } while (0)
#define PG8_WAIT_V(n) asm volatile("s_waitcnt vmcnt(" #n ")" ::: "memory")
#define PG8_WAIT_L(n) asm volatile("s_waitcnt lgkmcnt(" #n ")" ::: "memory")
#define PG8_BAR __builtin_amdgcn_s_barrier()
#define PG8_SCHED __builtin_amdgcn_sched_barrier(0)
  Unit cur, nxt; int ui = 0;
  if (!S.next(0, cur)) return;
  f32x4 acc[2][2][4][2];
#pragma unroll
  for (int a = 0; a < 2; ++a)
#pragma unroll
    for (int b = 0; b < 2; ++b)
#pragma unroll
      for (int m = 0; m < 4; ++m)
#pragma unroll
        for (int n = 0; n < 2; ++n) acc[a][b][m][n] = (f32x4){0.f, 0.f, 0.f, 0.f};
  bf16x8 At[4][2], B0[2][2], B1[2][2];
  const char* cA = (const char*)g.A + (size_t)cur.pm * tstep; const char* cB = (const char*)g.Bt + (size_t)cur.pn * tstep;
  PG8_STAGE(PG8_SB(0, 0), cB, voffB); PG8_STAGE(PG8_SA(0, 0), cA, voffA); PG8_STAGE(PG8_SB(0, 1), cB + hstep, voffB); PG8_STAGE(PG8_SA(0, 1), cA + hstep, voffA);
  if (wr == 1) PG8_BAR;
  PG8_WAIT_V(4); PG8_BAR;
  PG8_STAGE(PG8_SB(1, 0), cB + kstep, voffB); PG8_STAGE(PG8_SA(1, 0), cA + kstep, voffA); PG8_STAGE(PG8_SB(1, 1), cB + hstep + kstep, voffB);
  PG8_WAIT_V(6); PG8_BAR;
  for (;;) {
    const bool has_next = S.next(ui + 1, nxt);
    const char* nA = has_next ? (const char*)g.A + (size_t)nxt.pm * tstep : cA; const char* nB = has_next ? (const char*)g.Bt + (size_t)nxt.pn * tstep : cB;
    for (int t = 0; t < nt; t += 2) {
      const bool last = (t == nt - 2);
      const char* a1 = cA + (size_t)(t + 1) * kstep;
      const char* a2 = last ? nA : cA + (size_t)(t + 2) * kstep; const char* b2 = last ? nB : cB + (size_t)(t + 2) * kstep;
      const char* a3 = a2 + kstep; const char* b3 = b2 + kstep;
      PG8_LDB(B0, 0, 0); PG8_SCHED; PG8_LDA(At, 0, 0); PG8_STAGE(PG8_SA(1, 1), a1 + hstep, voffA);
      PG8_WAIT_L(8); PG8_BAR; PG8_WAIT_L(0); PG8_MMA(0, 0, At, B0); PG8_BAR; PG8_SCHED;
      PG8_LDB(B1, 0, 1); PG8_STAGE(PG8_SB(0, 0), b2, voffB);
      PG8_BAR; PG8_WAIT_L(0); PG8_MMA(0, 1, At, B1); PG8_BAR;
      PG8_LDA(At, 0, 1); PG8_STAGE(PG8_SA(0, 0), a2, voffA);
      PG8_BAR; PG8_WAIT_L(0); PG8_MMA(1, 0, At, B0); PG8_BAR; PG8_SCHED;
      PG8_STAGE(PG8_SB(0, 1), b2 + hstep, voffB);
      PG8_WAIT_V(6); PG8_BAR; PG8_MMA(1, 1, At, B1); PG8_BAR;
      PG8_LDB(B0, 1, 0); PG8_SCHED; PG8_LDA(At, 1, 0); PG8_STAGE(PG8_SA(0, 1), a2 + hstep, voffA);
      PG8_WAIT_L(8); PG8_BAR; PG8_WAIT_L(0); PG8_MMA(0, 0, At, B0); PG8_BAR; PG8_SCHED;
      PG8_LDB(B1, 1, 1); PG8_STAGE(PG8_SB(1, 0), b3, voffB);
      PG8_BAR; PG8_WAIT_L(0); PG8_MMA(0, 1, At, B1); PG8_BAR;
      PG8_LDA(At, 1, 1); PG8_STAGE(PG8_SA(1, 0), a3, voffA);
      PG8_BAR; PG8_WAIT_L(0); PG8_MMA(1, 0, At, B0); PG8_BAR; PG8_SCHED;
      PG8_STAGE(PG8_SB(1, 1), b3 + hstep, voffB);
      PG8_WAIT_V(6); PG8_BAR; PG8_MMA(1, 1, At, B1); PG8_BAR;
    }
    {
      Unit eu = cur; int ewr = wr, ewc = wc, efr = fr, efq = fq;
      asm volatile("" : "+s"(eu.pm), "+s"(eu.pn), "+s"(ewr), "+s"(ewc), "+v"(efr), "+v"(efq));
      E(acc, eu, ewr, ewc, efr, efq);
    }
    if (!has_next) break;
#pragma unroll
    for (int a = 0; a < 2; ++a)
#pragma unroll
      for (int b = 0; b < 2; ++b)
#pragma unroll
        for (int m = 0; m < 4; ++m)
#pragma unroll
          for (int n = 0; n < 2; ++n) acc[a][b][m][n] = (f32x4){0.f, 0.f, 0.f, 0.f};
    cur = nxt; cA = nA; cB = nB; ++ui;
  }
  PG8_WAIT_V(0);
  if (wr == 0) PG8_BAR;
  PG8_BAR;
#undef PG8_SA
#undef PG8_SB
#undef PG8_STAGE
#undef PG8_LDA
#undef PG8_LDB
#undef PG8_MMA
#undef PG8_WAIT_V
#undef PG8_WAIT_L
#undef PG8_BAR
#undef PG8_SCHED
}
}


struct Epi1 {
  Params p; u16* tl;
  DI void flush_T(int lane, u16* dstbase, size_t fstride, const int* fmap_kind, int wc) const {}
  DI void operator()(f32x4 (&acc)[2][2][4][2], const pg8::Unit& u, int wr, int wc, int fr, int fq) const {
#pragma unroll
    for (int ai = 0; ai < 2; ++ai)
#pragma unroll
      for (int m = 0; m < 4; ++m) {
        const float rv = p.rinv()[u.pm * 256 + ai * 128 + wr * 64 + 16 * m + fr];
#pragma unroll
        for (int bj = 0; bj < 2; ++bj)
#pragma unroll
          for (int n = 0; n < 2; ++n) acc[ai][bj][m][n] *= rv;
      }
    asm volatile("" ::: "memory");
    const bool samp = (u.pm * 256 >= NPROMPT);
#pragma unroll
    for (int bj = 0; bj < 2; ++bj) {
      const int blk = u.pn * 2 + bj;
      if (blk == 31) continue;
#pragma unroll
      for (int ai = 0; ai < 2; ++ai) {
        asm volatile("" : "+v"(fr), "+v"(fq));
        const int lane = fr + 16 * fq;
        const int P0 = 32 * wc + 4 * fq;
        const int R0 = u.pm * 256 + ai * 128 + wr * 64;
        int b, tb;
        if (!samp) { b = R0 >> 11; tb = R0 & 2047; } else { b = (R0 - NPROMPT) >> 6; tb = 0; }
        const int posb = samp ? 2048 : tb;
        const int T = samp ? 64 : 2048;
        if (blk < 8) {
          const int head = blk & 3;
          const int f0 = 16 * wc + 4 * fq;
          const float l2g = log2gamma(head);
#pragma unroll
          for (int m = 0; m < 4; ++m) {
            __builtin_amdgcn_sched_barrier(0);
            const int rr = 16 * m + fr, g = R0 + rr, pos = posb + rr;
            const f32x4 v0 = acc[ai][bj][m][0], v1 = acc[ai][bj][m][1];
            const f32x4 cs = *(const f32x4*)(p.cosR() + pos * 64 + f0), sn = *(const f32x4*)(p.sinR() + pos * 64 + f0);
            f32x4 o0 = v0 * cs - v1 * sn, o1 = v1 * cs + v0 * sn;
            if (blk < 4) {
              *(s16x4*)(p.qr() + (unsigned)g * 512 + head * 128 + f0) = pack4(o0);
              *(s16x4*)(p.qr() + (unsigned)g * 512 + head * 128 + 64 + f0) = pack4(o1);
            } else {
              o0 *= 0.08838834764831845f; o1 *= 0.08838834764831845f;
              *(s16x4*)(p.kr() + (unsigned)g * 512 + head * 128 + f0) = pack4(o0);
              *(s16x4*)(p.kr() + (unsigned)g * 512 + head * 128 + 64 + f0) = pack4(o1);
              const float dec = exp2f((float)(63 - (rr & 63)) * l2g);
#pragma unroll
              for (int j = 0; j < 4; ++j) {
                tl[(4 * fq + j) * 64 + rr] = f2bf(o0[j] * dec);
                tl[(16 + 4 * fq + j) * 64 + rr] = f2bf(o1[j] * dec);
              }
            }
          }
          if (blk >= 4) {
#pragma unroll
            for (int i = 0; i < 4; ++i) {
              const int id = lane + 64 * i, cp = id >> 3, tg = id & 7;
              const bf16x8 v = *(const bf16x8*)(tl + cp * 64 + tg * 8);
              const int f = 64 * (cp >> 4) + 16 * wc + (cp & 15);
              u16* dst = samp ? p.krT() + (unsigned)64 * 128 * 2048 + ((unsigned)(b * 4 + head) * 128 + f) * 64 + tg * 8
                              : p.krT() + ((unsigned)(b * 4 + head) * 128 + f) * 2048 + tb + tg * 8;
              *(bf16x8*)dst = v;
            }
          }
        } else if (blk < 12 || blk == 21) {
#pragma unroll
          for (int m = 0; m < 4; ++m) {
            __builtin_amdgcn_sched_barrier(0);
            const int rr = 16 * m + fr, g = R0 + rr;
#pragma unroll
            for (int n = 0; n < 2; ++n) {
              const f32x4 v = acc[ai][bj][m][n];
              if (blk == 21) {
                float* o = samp ? p.out + OUT_VS + (unsigned)(g - NPROMPT) * 128 + P0 + 16 * n : p.out + OUT_VP + (unsigned)g * 128 + P0 + 16 * n;
                *(f32x4*)o = v;
              }
#pragma unroll
              for (int j = 0; j < 4; ++j) tl[(16 * n + 4 * fq + j) * 64 + rr] = f2bf(v[j]);
            }
          }
#pragma unroll
          for (int i = 0; i < 4; ++i) {
            const int id = lane + 64 * i, cp = id >> 3, tg = id & 7;
            const bf16x8 v = *(const bf16x8*)(tl + cp * 64 + tg * 8);
            const int f = 32 * wc + cp;
            u16* dst;
            if (blk < 12) {
              const int head = blk & 3;
              dst = samp ? p.vrT() + (unsigned)64 * 128 * 2048 + ((unsigned)(b * 4 + head) * 128 + f) * 64 + tg * 8
                         : p.vrT() + ((unsigned)(b * 4 + head) * 128 + f) * 2048 + tb + tg * 8;
            } else {
              const int kvh = f >> 6, d = f & 63;
              dst = samp ? p.vaTS() + ((unsigned)(b * 2 + kvh) * 64 + d) * 2112 + 2048 + tg * 8
                         : p.vaTP() + ((unsigned)(b * 2 + kvh) * 64 + d) * 2048 + tb + tg * 8;
            }
            *(bf16x8*)dst = v;
          }
        } else if ((blk >= 12 && blk < 16) || (blk >= 22 && blk < 26)) {
          const int colbase = (blk < 16) ? (blk - 12) * 128 : 512 + (blk - 22) * 128;
#pragma unroll
          for (int m = 0; m < 4; ++m) {
            __builtin_amdgcn_sched_barrier(0);
            const int g = R0 + 16 * m + fr;
#pragma unroll
            for (int n = 0; n < 2; ++n) {
              f32x4 v = acc[ai][bj][m][n];
              v[0] = siluf(v[0]); v[1] = siluf(v[1]); v[2] = siluf(v[2]); v[3] = siluf(v[3]);
              *(s16x4*)(p.gate() + (unsigned)g * 1024 + colbase + P0 + 16 * n) = pack4(v);
            }
          }
        } else {
          const bool ropew = ((wc & 1) == 0) && !(blk == 30 && wc >= 2);
#pragma unroll
          for (int m = 0; m < 4; ++m) {
            __builtin_amdgcn_sched_barrier(0);
            const int rr = 16 * m + fr, g = R0 + rr, pos = posb + rr;
            f32x4 v0 = acc[ai][bj][m][0];
            const f32x4 v1 = acc[ai][bj][m][1];
            if (ropew) {
              f32x4 pr;
              pr[0] = __shfl_xor(v0[0], 32); pr[1] = __shfl_xor(v0[1], 32); pr[2] = __shfl_xor(v0[2], 32); pr[3] = __shfl_xor(v0[3], 32);
              const f32x4 cs = *(const f32x4*)(p.cosA() + pos * 8 + 4 * (fq & 1)), sn = *(const f32x4*)(p.sinA() + pos * 8 + 4 * (fq & 1));
              v0 = (fq < 2) ? v0 * cs - pr * sn : v0 * cs + pr * sn;
            }
            if (blk < 20) {
              const float sc = 0.125f * 1.4426950408889634f;
              *(s16x4*)(p.qa() + (unsigned)g * 512 + (blk - 16) * 128 + P0) = pack4(v0 * sc);
              *(s16x4*)(p.qa() + (unsigned)g * 512 + (blk - 16) * 128 + P0 + 16) = pack4(v1 * sc);
            } else if (blk == 20) {
              float* o = samp ? p.out + OUT_KS + (unsigned)(g - NPROMPT) * 128 + P0 : p.out + OUT_KP + (unsigned)g * 128 + P0;
              *(f32x4*)o = v0; *(f32x4*)(o + 16) = v1;
              const int kvh = wc >> 1, d = P0 & 63;
              u16* dst = samp ? p.kaS() + ((unsigned)(b * 2 + kvh) * 2112 + 2048 + rr) * 64 + d
                              : p.kaP() + ((unsigned)(b * 2 + kvh) * 2048 + tb + rr) * 64 + d;
              *(s16x4*)dst = pack4(v0); *(s16x4*)(dst + 16) = pack4(v1);
            } else if (blk < 30) {
              *(s16x4*)(p.qi() + (unsigned)g * 512 + (blk - 26) * 128 + P0) = pack4(v0);
              *(s16x4*)(p.qi() + (unsigned)g * 512 + (blk - 26) * 128 + P0 + 16) = pack4(v1);
            } else {
              if (wc < 2) {
                float* o = samp ? p.out + OUT_KIS + (unsigned)(g - NPROMPT) * 64 + P0 : p.out + OUT_KIP + (unsigned)g * 64 + P0;
                *(f32x4*)o = v0; *(f32x4*)(o + 16) = v1;
                u16* dst = samp ? p.kiS() + ((unsigned)b * 2112 + 2048 + rr) * 64 + P0 : p.kiP() + ((unsigned)b * 2048 + tb + rr) * 64 + P0;
                *(s16x4*)dst = pack4(v0); *(s16x4*)(dst + 16) = pack4(v1);
              } else if (wc == 2 && fq < 2) {
                *(f32x4*)(p.wi() + (unsigned)g * 8 + 4 * fq) = v0 * 0.044194173824159216f;
              }
            }
          }
        }
      }
    }
  }
};

struct Epi2 {
  Params p;
  DI void operator()(f32x4 (&acc)[2][2][4][2], const pg8::Unit& u, int wr, int wc, int fr, int fq) const {
    u16* z = p.gate();
#pragma unroll
    for (int ai = 0; ai < 2; ++ai)
#pragma unroll
      for (int m = 0; m < 4; ++m) {
        const unsigned g = u.pm * 256 + ai * 128 + wr * 64 + 16 * m + fr;
#pragma unroll
        for (int bj = 0; bj < 2; ++bj)
#pragma unroll
          for (int n = 0; n < 2; ++n) {
            const unsigned c = u.pn * 256 + bj * 128 + 32 * wc + 16 * n + 4 * fq;
            *(s16x4*)(z + g * 1024u + c) = pack4(acc[ai][bj][m][n]);
          }
      }
  }
};

DI void ret_kv_item(const Params& p, int item, int tid) {
  const int lane = tid & 63, w = tid >> 6, r = lane & 31, hh = lane >> 5;
  const u16 *kT, *vT; int T, c;
  if (item < 2048) { const int bh = item >> 5; c = item & 31; T = 2048; kT = p.krT() + (size_t)bh * 128 * 2048; vT = p.vrT() + (size_t)bh * 128 * 2048; }
  else { const int bh = item - 2048; c = 0; T = 64; kT = p.krT() + (size_t)64 * 128 * 2048 + (size_t)bh * 128 * 64; vT = p.vrT() + (size_t)64 * 128 * 2048 + (size_t)bh * 128 * 64; }
  const int e0 = (w & 1) * 64, d0 = (w >> 1) * 64;
  f32x16 acc[2][2];
  acc[0][0] = zero16(); acc[0][1] = zero16(); acc[1][0] = zero16(); acc[1][1] = zero16();
#pragma unroll
  for (int ks = 0; ks < 4; ++ks) {
    bf16x8 a0 = ldg8(vT + (size_t)(e0 + r) * T + c * 64 + ks * 16 + hh * 8);
    bf16x8 a1 = ldg8(vT + (size_t)(e0 + 32 + r) * T + c * 64 + ks * 16 + hh * 8);
    bf16x8 b0 = ldg8(kT + (size_t)(d0 + r) * T + c * 64 + ks * 16 + hh * 8);
    bf16x8 b1 = ldg8(kT + (size_t)(d0 + 32 + r) * T + c * 64 + ks * 16 + hh * 8);
    acc[0][0] = MFMA32(a0, b0, acc[0][0]);
    acc[0][1] = MFMA32(a0, b1, acc[0][1]);
    acc[1][0] = MFMA32(a1, b0, acc[1][0]);
    acc[1][1] = MFMA32(a1, b1, acc[1][1]);
  }
  float* o = p.kvT() + (size_t)item * 16384;
#pragma unroll
  for (int a = 0; a < 2; ++a)
#pragma unroll
    for (int b = 0; b < 2; ++b)
#pragma unroll
      for (int i = 0; i < 16; ++i)
        o[(e0 + a * 32 + crow(i, hh)) * 128 + d0 + b * 32 + r] = acc[a][b][i];
}

DI void idx_item(const Params& p, unsigned char* lds, int tid, bool samp, int b, int grp) {
  const int lane = tid & 63, w = tid >> 6;
  const int t0 = grp * 16;
  int L, g0; const u16* ki;
  if (!samp) { const int c = t0 >> 6; L = (c + 1) * 64; g0 = b * 2048 + t0; ki = p.kiP() + (size_t)b * 2048 * 64; }
  else { L = 2112; g0 = NPROMPT + b * 64 + t0; ki = p.kiS() + (size_t)b * 2112 * 64; }
  const int nj = L >> 6;
  if (L <= 256) {
    for (int qq = 0; qq < 4; ++qq) {
      const int q = w * 4 + qq;
      if (lane < nj) p.maskbits()[(size_t)(g0 + q) * 33 + lane] = ~0ull;
    }
    return;
  }
  u16* keys = (u16*)lds;
#ifndef REPMF
#define REPMF 1
#endif
#ifndef REPSEL
#define REPSEL 1
#endif
#ifndef REPKV
#define REPKV 1
#endif
  for (int rmf = 0; rmf < REPMF; ++rmf) {
    const int qn = lane & 15, quad = lane >> 4;
    bf16x8 qf[8][2];
    float wv[8];
#pragma unroll
    for (int h = 0; h < 8; ++h) {
      qf[h][0] = ldg8(p.qi() + (size_t)(g0 + qn) * 512 + h * 64 + quad * 8);
      qf[h][1] = ldg8(p.qi() + (size_t)(g0 + qn) * 512 + h * 64 + 32 + quad * 8);
      wv[h] = p.wi()[(size_t)(g0 + qn) * 8 + h];
    }
    bf16x8 A0[4], A1[4], N0[4], N1[4];
#pragma unroll
    for (int i = 0; i < 4; ++i) {
      const int kt = w + 4 * i;
      A0[i] = ldg8(ki + (size_t)(kt * 16 + qn) * 64 + quad * 8);
      A1[i] = ldg8(ki + (size_t)(kt * 16 + qn) * 64 + 32 + quad * 8);
    }
    for (int base = 0; base < nj; base += 4) {
#pragma unroll
      for (int i = 0; i < 4; ++i) {
        const int t = base + 4 + i;
        if (t < nj) {
          const int kt = w + 4 * t;
          N0[i] = ldg8(ki + (size_t)(kt * 16 + qn) * 64 + quad * 8);
          N1[i] = ldg8(ki + (size_t)(kt * 16 + qn) * 64 + 32 + quad * 8);
        }
      }
#pragma unroll
      for (int i = 0; i < 4; ++i) {
        const int t = base + i;
        if (t < nj) {
          const int kt = w + 4 * t;
          float idx[4] = {0.f, 0.f, 0.f, 0.f};
#pragma unroll
          for (int h = 0; h < 8; ++h) {
            f32x4 acc = {0.f, 0.f, 0.f, 0.f};
            acc = MFMA16(A0[i], qf[h][0], acc);
            acc = MFMA16(A1[i], qf[h][1], acc);
#pragma unroll
            for (int e = 0; e < 4; ++e) idx[e] += fmaxf(acc[e], 0.f) * wv[h];
          }
          s16x4 kv;
#pragma unroll
          for (int e = 0; e < 4; ++e) {
            _Float16 hv = (_Float16)idx[e];
            u16 bits = __builtin_bit_cast(u16, hv);
            kv[e] = (short)((bits & 0x8000) ? (u16)~bits : (u16)(bits | 0x8000));
          }
          *(s16x4*)(keys + qn * KPITCH + kt * 16 + quad * 4) = kv;
        }
      }
#pragma unroll
      for (int i = 0; i < 4; ++i) { A0[i] = N0[i]; A1[i] = N1[i]; }
    }
  }
  __syncthreads();
  for (int qq = 0; qq < 4 * REPSEL; ++qq) {
    const int q = w * 4 + (qq & 3);
    unsigned key[33];
#pragma unroll
    for (int j = 0; j < 33; ++j) key[j] = (j < nj) ? (unsigned)keys[q * KPITCH + j * 64 + lane] : 0u;
    unsigned prefix = 0;
    for (int bit = 15; bit >= 0; --bit) {
      const unsigned cand = prefix | (1u << bit);
      int c0 = 0, c1 = 0;
#pragma unroll
      for (int g = 0; g < 5; ++g) {
        if (g * 8 < nj) {
#pragma unroll
          for (int jj = 0; jj < 8; ++jj) {
            const int j = g * 8 + jj;
            if (j < 33) { if (jj & 1) c1 += (key[j] >= cand) ? 1 : 0; else c0 += (key[j] >= cand) ? 1 : 0; }
          }
        }
      }
      const int cnt = wave_sum(c0 + c1);
      if (cnt >= 256) prefix = cand;
      if (cnt == 256) break;
    }
    int cgt = 0;
#pragma unroll
    for (int j = 0; j < 33; ++j) cgt += __popcll(__ballot(key[j] > prefix));
    const int rneed = 256 - cgt;
    int running = 0;
    u64 myword = 0;
    const u64 lt = (1ull << lane) - 1ull;
#pragma unroll
    for (int j = 0; j < 33; ++j) {
      const bool eq = key[j] == prefix;
      const u64 em = __ballot(eq);
      const int rank = running + __popcll(em & lt);
      const bool sel = (key[j] > prefix) || (eq && rank < rneed);
      const u64 sm = __ballot(sel);
      if (lane == j) myword = sm;
      running += __popcll(em);
    }
    if (lane < nj) p.maskbits()[(size_t)(g0 + q) * 33 + lane] = myword;
  }
  __syncthreads();
}

DI void scan_item(const Params& p, int item, int tid) {
  if (item < 1024) {
    const int bh = item >> 4, slab = item & 15;
    const int idx = slab * 1024 + tid * 4;
    const int h = bh & 3;
    const float cd = exp2f(64.f * log2gamma(h));
    f32x4 s = {0.f, 0.f, 0.f, 0.f};
    for (int c = 0; c < 32; ++c) {
      const size_t base = (size_t)(bh * 32 + c) * 16384 + idx;
      s16x4 o = pack4(s);
      *(s16x4*)(p.sprevT() + base) = o;
      f32x4 kv = *(const f32x4*)(p.kvT() + base);
      s = s * cd + kv;
    }
    const int e = idx >> 7, d = idx & 127;
    float* o = p.out + OUT_STP + (size_t)bh * 16384;
#pragma unroll
    for (int j = 0; j < 4; ++j) o[(d + j) * 128 + e] = s[j];
  } else {
    const int it = item - 1024;
    const int bh = it >> 4, slab = it & 15;
    const int idx = slab * 1024 + tid * 4;
    const int h = bh & 3;
    const float cd = exp2f(64.f * log2gamma(h));
    const int e = idx >> 7, d = idx & 127;
    const float* s0 = p.state_ret + (size_t)bh * 16384;
    f32x4 s;
#pragma unroll
    for (int j = 0; j < 4; ++j) s[j] = s0[(d + j) * 128 + e];
    const size_t base = (size_t)(2048 + bh) * 16384 + idx;
    s16x4 o = pack4(s);
    *(s16x4*)(p.sprevT() + base) = o;
    f32x4 kv = *(const f32x4*)(p.kvT() + base);
    s = s * cd + kv;
    float* oo = p.out + OUT_STS + (size_t)bh * 16384;
#pragma unroll
    for (int j = 0; j < 4; ++j) oo[(d + j) * 128 + e] = s[j];
  }
}

DI void attn_item(const Params& p, unsigned char* lds, int tid, bool samp, int b, int c, int kvh, int qh) {
  const int lane = tid & 63, w = tid >> 6, r = lane & 31, hh = lane >> 5;
  const int T = samp ? 2112 : 2048;
  const int nkt = samp ? 33 : c + 1;
  const int g0 = (samp ? NPROMPT + b * 64 : b * 2048 + c * 64) + qh * 32;
  const u16* K = samp ? p.kaS() + (size_t)(b * 2 + kvh) * 2112 * 64 : p.kaP() + (size_t)(b * 2 + kvh) * 2048 * 64;
  const u16* VT = samp ? p.vaTS() + (size_t)(b * 2 + kvh) * 64 * 2112 : p.vaTP() + (size_t)(b * 2 + kvh) * 64 * 2048;
  const int head = kvh * 4 + w;
  u16* Ks = (u16*)lds;
  u16* Vs = Ks + 64 * 72;
  u64* mL = (u64*)(lds + 2 * 9216);
  for (int i = tid; i < 32 * 33; i += 256) mL[i] = p.maskbits()[(size_t)g0 * 33 + i];
  bf16x8 qf[4];
#pragma unroll
  for (int ks = 0; ks < 4; ++ks) qf[ks] = ldg8(p.qa() + (size_t)(g0 + r) * 512 + head * 64 + ks * 16 + hh * 8);
  f32x16 O[2];
  O[0] = zero16(); O[1] = zero16();
  float mrun = -1e30f, lrun = 0.f;
  const int lrow = tid >> 3, lch = tid & 7;
  bf16x8 pk0, pk1, pv0, pv1;
  pk0 = ldg8(K + (size_t)(lrow)*64 + lch * 8);
  pk1 = ldg8(K + (size_t)(lrow + 32) * 64 + lch * 8);
  pv0 = ldg8(VT + (size_t)(lrow)*T + lch * 8);
  pv1 = ldg8(VT + (size_t)(lrow + 32) * T + lch * 8);
  for (int kt = 0; kt < nkt; ++kt) {
    __syncthreads();
    *(bf16x8*)(Ks + lrow * 72 + lch * 8) = pk0;
    *(bf16x8*)(Ks + (lrow + 32) * 72 + lch * 8) = pk1;
    *(bf16x8*)(Vs + lrow * 72 + lch * 8) = pv0;
    *(bf16x8*)(Vs + (lrow + 32) * 72 + lch * 8) = pv1;
    __syncthreads();
    if (kt + 1 < nkt) {
      pk0 = ldg8(K + (size_t)((kt + 1) * 64 + lrow) * 64 + lch * 8);
      pk1 = ldg8(K + (size_t)((kt + 1) * 64 + lrow + 32) * 64 + lch * 8);
      pv0 = ldg8(VT + (size_t)(lrow)*T + (kt + 1) * 64 + lch * 8);
      pv1 = ldg8(VT + (size_t)(lrow + 32) * T + (kt + 1) * 64 + lch * 8);
    }
    f32x16 S[2];
#pragma unroll
    for (int st = 0; st < 2; ++st) {
      S[st] = zero16();
#pragma unroll
      for (int ks = 0; ks < 4; ++ks) {
        bf16x8 kf = *(const bf16x8*)(Ks + (st * 32 + r) * 72 + ks * 16 + hh * 8);
        S[st] = MFMA32(kf, qf[ks], S[st]);
      }
    }
    const u64 W = mL[r * 33 + kt];
    const unsigned wl = ((unsigned)W) >> (4 * hh), wh = ((unsigned)(W >> 32)) >> (4 * hh);
    float mx = -1e30f;
#pragma unroll
    for (int st = 0; st < 2; ++st)
#pragma unroll
      for (int i = 0; i < 16; ++i) {
        const unsigned bit = ((st ? wh : wl) >> ((i & 3) + 8 * (i >> 2))) & 1u;
        const float s = bit ? S[st][i] : -1e30f;
        S[st][i] = s;
        mx = fmaxf(mx, s);
      }
    mx = fmaxf(mx, __shfl_xor(mx, 32));
    const float mn = fmaxf(mrun, mx);
    const float alpha = __builtin_amdgcn_exp2f(mrun - mn);
    mrun = mn;
    float ls = 0.f;
#pragma unroll
    for (int st = 0; st < 2; ++st)
#pragma unroll
      for (int i = 0; i < 16; ++i) {
        const float pvv = __builtin_amdgcn_exp2f(S[st][i] - mn);
        S[st][i] = pvv;
        ls += pvv;
      }
    lrun = lrun * alpha + ls;
#pragma unroll
    for (int dt = 0; dt < 2; ++dt)
#pragma unroll
      for (int i = 0; i < 16; ++i) O[dt][i] *= alpha;
#pragma unroll
    for (int st = 0; st < 2; ++st)
#pragma unroll
      for (int s2 = 0; s2 < 2; ++s2) {
        bf16x8 pf = pack8(S[st][8 * s2 + 0], S[st][8 * s2 + 1], S[st][8 * s2 + 2], S[st][8 * s2 + 3],
                          S[st][8 * s2 + 4], S[st][8 * s2 + 5], S[st][8 * s2 + 6], S[st][8 * s2 + 7]);
#pragma unroll
        for (int dt = 0; dt < 2; ++dt) {
          s16x4 lo = *(const s16x4*)(Vs + (dt * 32 + r) * 72 + st * 32 + 16 * s2 + 4 * hh);
          s16x4 hi = *(const s16x4*)(Vs + (dt * 32 + r) * 72 + st * 32 + 16 * s2 + 8 + 4 * hh);
          bf16x8 vf = __builtin_shufflevector(lo, hi, 0, 1, 2, 3, 4, 5, 6, 7);
          O[dt] = MFMA32(vf, pf, O[dt]);
        }
      }
  }
  {
    float lt = lrun + __shfl_xor(lrun, 32);
    const float inv = 1.f / lt;
    const u16* grow = p.gate() + (size_t)(g0 + r) * 1024 + 512 + head * 64;
    u16* mrow = p.mix() + (size_t)(g0 + r) * 1024 + 512 + head * 64;
#pragma unroll
    for (int dt = 0; dt < 2; ++dt)
#pragma unroll
      for (int q4 = 0; q4 < 4; ++q4) {
        const int d = dt * 32 + 8 * q4 + 4 * hh;
        s16x4 gv = *(const s16x4*)(grow + d);
        f32x4 of;
#pragma unroll
        for (int j = 0; j < 4; ++j) {
          const float gf = __uint_as_float(((unsigned)(u16)gv[j]) << 16);
          of[j] = O[dt][q4 * 4 + j] * inv * gf;
        }
        *(s16x4*)(mrow + d) = pack4(of);
      }
  }
  __syncthreads();
}

DI void ret_out_item(const Params& p, unsigned char* lds, int item, int tid) {
  const int lane = tid & 63, w = tid >> 6, r = lane & 31, hh = lane >> 5;
  int bh, c, T, g0; const u16* vT;
  if (item < 2048) { bh = item >> 5; c = item & 31; T = 2048; g0 = (bh >> 2) * 2048 + c * 64; vT = p.vrT() + (size_t)bh * 128 * 2048; }
  else { bh = item - 2048; c = 0; T = 64; g0 = NPROMPT + (bh >> 2) * 64; vT = p.vrT() + (size_t)64 * 128 * 2048 + (size_t)bh * 128 * 64; }
  const int h = bh & 3;
  const float l2g = log2gamma(h);
  const int nt = w & 1, eh = w >> 1;
  const int n = nt * 32 + r;
  bf16x8 qf[8];
#pragma unroll
  for (int ks = 0; ks < 8; ++ks) qf[ks] = ldg8(p.qr() + (size_t)(g0 + n) * 512 + h * 128 + ks * 16 + hh * 8);
  bf16x8 pf[2][2];
#pragma unroll
  for (int mt = 0; mt < 2; ++mt) {
    f32x16 S = zero16();
#pragma unroll
    for (int ks = 0; ks < 8; ++ks) {
      bf16x8 kf = ldg8(p.kr() + (size_t)(g0 + mt * 32 + r) * 512 + h * 128 + ks * 16 + hh * 8);
      S = MFMA32(kf, qf[ks], S);
    }
#pragma unroll
    for (int i = 0; i < 16; ++i) {
      const int m = mt * 32 + crow(i, hh);
      const int dd = n > m ? n - m : m - n;
      S[i] *= exp2f((float)dd * l2g);
    }
    pf[mt][0] = pack8(S[0], S[1], S[2], S[3], S[4], S[5], S[6], S[7]);
    pf[mt][1] = pack8(S[8], S[9], S[10], S[11], S[12], S[13], S[14], S[15]);
  }
  const float fs = exp2f((float)(n + 1) * l2g);
  const u16* sp = p.sprevT() + (size_t)item * 16384;
  f32x16 tot[2];
  float ss = 0.f;
#pragma unroll
  for (int et = 0; et < 2; ++et) {
    const int e = (2 * eh + et) * 32 + r;
    f32x16 Oi = zero16(), X = zero16();
#pragma unroll
    for (int mt = 0; mt < 2; ++mt)
#pragma unroll
      for (int s2 = 0; s2 < 2; ++s2) {
        const u16* vp = vT + (size_t)e * T + c * 64 + mt * 32 + 16 * s2 + 4 * hh;
        s16x4 lo = ldg4(vp), hi = ldg4(vp + 8);
        bf16x8 vf = __builtin_shufflevector(lo, hi, 0, 1, 2, 3, 4, 5, 6, 7);
        Oi = MFMA32(vf, pf[mt][s2], Oi);
      }
#pragma unroll
    for (int ks = 0; ks < 8; ++ks) {
      bf16x8 sf = ldg8(sp + (size_t)e * 128 + ks * 16 + hh * 8);
      X = MFMA32(sf, qf[ks], X);
    }
#pragma unroll
    for (int i = 0; i < 16; ++i) { const float t = Oi[i] + X[i] * fs; tot[et][i] = t; ss += t * t; }
  }
  ss += __shfl_xor(ss, 32);
  float* red = (float*)lds;
  __syncthreads();
  if (hh == 0) red[w * 32 + r] = ss;
  __syncthreads();
  const float tsum = red[w * 32 + r] + red[(w ^ 2) * 32 + r];
  const float rinv = rsqrtf(tsum * (1.f / 128.f) + 1e-6f);
  const u16* grow = p.gate() + (size_t)(g0 + n) * 1024 + h * 128;
  u16* mrow = p.mix() + (size_t)(g0 + n) * 1024 + h * 128;
#pragma unroll
  for (int et = 0; et < 2; ++et)
#pragma unroll
    for (int q4 = 0; q4 < 4; ++q4) {
      const int e = (2 * eh + et) * 32 + 8 * q4 + 4 * hh;
      s16x4 gv = *(const s16x4*)(grow + e);
      f32x4 gg = *(const f32x4*)(p.ret_gn_g + h * 128 + e);
      f32x4 of;
#pragma unroll
      for (int j = 0; j < 4; ++j) {
        const float gf = __uint_as_float(((unsigned)(u16)gv[j]) << 16);
        of[j] = tot[et][q4 * 4 + j] * rinv * gg[j] * gf;
      }
      *(s16x4*)(mrow + e) = pack4(of);
    }
}

DI void phase_final(const Params& p, int tid) {
  const int gt = blockIdx.x * 512 + tid, GT = gridDim.x * 512;
  const int lane = tid & 63;
  for (int row = gt >> 6; row < NTOK; row += (GT >> 6)) {
    float* y = p.out + OUT_Y + (size_t)row * 1024;
    const float* xr = xrow(p, row);
    const u16* zr = p.gate() + (size_t)row * 1024;
    f32x4 v[4];
    float ss = 0.f;
#pragma unroll
    for (int i = 0; i < 4; ++i) {
      v[i] = *(const f32x4*)(xr + i * 256 + lane * 4);
      const s16x4 zz = *(const s16x4*)(zr + i * 256 + lane * 4);
#pragma unroll
      for (int j = 0; j < 4; ++j) v[i][j] += __uint_as_float(((unsigned)(u16)zz[j]) << 16);
      ss += v[i][0] * v[i][0] + v[i][1] * v[i][1] + v[i][2] * v[i][2] + v[i][3] * v[i][3];
    }
#pragma unroll
    for (int o = 32; o >= 1; o >>= 1) ss += __shfl_xor(ss, o);
    const float rv = rsqrtf(ss * (1.f / 1024.f) + 1e-6f);
#pragma unroll
    for (int i = 0; i < 4; ++i) {
      f32x4 g = *(const f32x4*)(p.final_g + i * 256 + lane * 4);
      f32x4 o = v[i] * rv * g;
      *(f32x4*)(y + i * 256 + lane * 4) = o;
    }
  }
}

#ifndef REP0
#define REP0 1
#endif
#ifndef REP1
#define REP1 1
#endif
#ifndef REP2
#define REP2 1
#endif
#ifndef REP3
#define REP3 1
#endif
#ifndef REP4
#define REP4 1
#endif
#ifndef REP5
#define REP5 1
#endif
__global__ void __launch_bounds__(512, 2) fwd_megakernel(Params p) {
  __shared__ __attribute__((aligned(16))) unsigned char lds[LDS_BYTES];
  cg::grid_group grid = cg::this_grid();
#define FRESH_TID() int tid = threadIdx.x; asm volatile("" : "+v"(tid)); const int half = tid >> 8, htid = tid & 255; unsigned char* ldsh = lds + half * HALF_LDS; (void)htid; (void)ldsh;
  for (int rep = 0; rep < REP0; ++rep) {
  { FRESH_TID(); phase_prep(p, tid); }
  grid.sync();
  }
  for (int rep = 0; rep < REP1; ++rep) {
  {
    FRESH_TID();
    pg8::Gemm g; g.A = p.xb(); g.Bt = p.WtIn(); g.M = NTOK; g.N = 4096; g.K = 1024;
    pg8::StaticOrder S; S.init(g.M, g.N, (int)gridDim.x, (int)blockIdx.x);
    Epi1 E; E.p = p; E.tl = (u16*)(lds + pg8::STAGE_BYTES + (tid >> 6) * 4096);
    pg8::gemm_phase<Epi1>((LAS unsigned char*)lds, g, S, E);
  }
  grid.sync();
  }
  for (int rep = 0; rep < REP2; ++rep) {
  {
    FRESH_TID();
    for (int it0 = blockIdx.x * 2; it0 < 2080 + 2080; it0 += gridDim.x * 2) {
      const int it = it0 + half;
      int ht = htid; asm volatile("" : "+v"(ht));
      if (it < 2080) {
        const bool samp = it < 32;
        const int j = it - 32;
        const int c = 31 - (j >> 6);
        const int b = samp ? (it >> 2) : ((j & 63) >> 2);
        const int grp = samp ? (it & 3) : (c * 4 + (j & 3));
        idx_item(p, ldsh, ht, samp, b, grp);
      } else { for (int rkv = 0; rkv < REPKV; ++rkv) ret_kv_item(p, it - 2080, ht); }
    }
  }
  grid.sync();
  }
  for (int rep = 0; rep < REP3; ++rep) {
  {
    FRESH_TID();
    for (int it0 = blockIdx.x * 2; it0 < 2080 + 1536; it0 += gridDim.x * 2) {
      const int it = it0 + half;
      int ht = htid; asm volatile("" : "+v"(ht));
      if (it < 2080) {
        const bool samp = it < 32;
        const int j = it - 32;
        const int c = samp ? 0 : 31 - (j >> 6);
        const int b = samp ? (it >> 2) : ((j & 63) >> 2);
#ifndef REPATT
#define REPATT 1
#endif
#ifndef REPSCAN
#define REPSCAN 1
#endif
        for (int ra = 0; ra < REPATT; ++ra) attn_item(p, ldsh, ht, samp, b, c, (it >> 1) & 1, it & 1);
      } else { for (int rs = 0; rs < REPSCAN; ++rs) scan_item(p, it - 2080, ht); }
    }
  }
  grid.sync();
  }
  for (int rep = 0; rep < REP4; ++rep) {
  {
    FRESH_TID();
    for (int it0 = blockIdx.x * 2; it0 < 2080; it0 += gridDim.x * 2) { int ht = htid; asm volatile("" : "+v"(ht)); ret_out_item(p, ldsh, it0 + half, ht); }
  }
  grid.sync();
  }
  for (int rep = 0; rep < REP5; ++rep) {
  {
    pg8::Gemm g; g.A = p.mix(); g.Bt = p.WtOut(); g.M = NTOK; g.N = 1024; g.K = 1024;
    pg8::StaticOrder S; S.init(g.M, g.N, (int)gridDim.x, (int)blockIdx.x);
    Epi2 E; E.p = p;
    pg8::gemm_phase<Epi2>((LAS unsigned char*)lds, g, S, E);
  }
  grid.sync();
  }
  { FRESH_TID(); phase_final(p, tid); }
}

extern "C" void kernel_launch(void* const* d_in, const int* in_sizes, int n_in, void* d_out, int out_size, void* d_ws,
                              size_t ws_size, hipStream_t stream) {
  static int grid_blocks = 0;
  if (!grid_blocks) {
    int dev = 0, cus = 0, per_cu = 0;
    (void)hipGetDevice(&dev);
    (void)hipDeviceGetAttribute(&cus, hipDeviceAttributeMultiprocessorCount, dev);
    (void)hipOccupancyMaxActiveBlocksPerMultiprocessor(&per_cu, fwd_megakernel, 512, 0);
    if (per_cu < 1) per_cu = 1;
    if (per_cu > 1) per_cu = 1;
    grid_blocks = cus * per_cu;
  }
  Params p{};
  p.x_p = (const float*)d_in[0]; p.x_s = (const float*)d_in[1]; p.state_ret = (const float*)d_in[2];
  p.cache_k = (const float*)d_in[3]; p.cache_v = (const float*)d_in[4]; p.cache_kidx = (const float*)d_in[5];
  p.norm_g = (const float*)d_in[6]; p.w_in = (const float*)d_in[7]; p.ret_gn_g = (const float*)d_in[8];
  p.w_out = (const float*)d_in[9]; p.final_g = (const float*)d_in[10];
  p.out = (float*)d_out;
  p.ws = (unsigned char*)d_ws;
  void* args[] = {&p};
  hipError_t e = hipLaunchCooperativeKernel((void*)fwd_megakernel, dim3(grid_blocks), dim3(512), args, 0, stream);
  if (e != hipSuccess) fprintf(stderr, "cooperative launch failed: %s (grid %d)\n", hipGetErrorString(e), grid_blocks);
}
```

```cpp
#include <hip/hip_runtime.h>
#include <hip/hip_cooperative_groups.h>
#include <stdint.h>
#include <cstdio>
namespace cg = cooperative_groups;

typedef __attribute__((ext_vector_type(8))) short bf16x8;
typedef __attribute__((ext_vector_type(4))) short s16x4;
typedef __attribute__((ext_vector_type(16))) float f32x16;
typedef __attribute__((ext_vector_type(4))) float f32x4;
typedef unsigned short u16;
typedef unsigned long long u64;


#define DI __device__ __forceinline__
#define MFMA32(a, b, c) __builtin_amdgcn_mfma_f32_32x32x16_bf16((a), (b), (c), 0, 0, 0)
#define MFMA16(a, b, c) __builtin_amdgcn_mfma_f32_16x16x32_bf16((a), (b), (c), 0, 0, 0)

#define NTOK 33280
#define NPROMPT 32768
#define LDS_BYTES 163840
#define HALF_LDS 81920
#define LAS __attribute__((address_space(3)))
#define KPITCH 2116

struct Params {
  const float *x_p, *x_s, *state_ret, *cache_k, *cache_v, *cache_kidx, *norm_g, *w_in, *ret_gn_g, *w_out, *final_g;
  float* out;
  unsigned char* ws;
  DI u16* xb() const { return (u16*)(ws + 0ull); }
  DI float* kvT() const { return (float*)(ws + 0ull); }
  DI u16* WtIn() const { return (u16*)(ws + 136314880ull); }
  DI u16* WtOut() const { return (u16*)(ws + 144703488ull); }
  DI u16* qr() const { return (u16*)(ws + 146800640ull); }
  DI u16* kr() const { return (u16*)(ws + 180879360ull); }
  DI u16* sprevT() const { return (u16*)(ws + 214958080ull); }
  DI u16* qi() const { return (u16*)(ws + 214958080ull); }
  DI u16* krT() const { return (u16*)(ws + 249036800ull); }
  DI u16* vrT() const { return (u16*)(ws + 283115520ull); }
  DI u16* gate() const { return (u16*)(ws + 317194240ull); }
  DI u16* mix() const { return (u16*)(ws + 385351680ull); }
  DI u16* qa() const { return (u16*)(ws + 453509120ull); }
  DI u16* kaP() const { return (u16*)(ws + 487587840ull); }
  DI u16* kaS() const { return (u16*)(ws + 495976448ull); }
  DI u16* vaTP() const { return (u16*)(ws + 500301824ull); }
  DI u16* vaTS() const { return (u16*)(ws + 508690432ull); }
  DI u16* kiP() const { return (u16*)(ws + 513015808ull); }
  DI u16* kiS() const { return (u16*)(ws + 517210112ull); }
  DI float* rinv() const { return (float*)(ws + 519372800ull); }
  DI float* wi() const { return (float*)(ws + 519505920ull); }
  DI float* cosR() const { return (float*)(ws + 520570880ull); }
  DI float* sinR() const { return (float*)(ws + 521111552ull); }
  DI float* cosA() const { return (float*)(ws + 521652224ull); }
  DI float* sinA() const { return (float*)(ws + 521719808ull); }
  DI unsigned* bar() const { return (unsigned*)(ws + 530573312ull); }
  DI u64* maskbits() const { return (u64*)(ws + 521787392ull); }
};

#define OUT_Y 0
#define OUT_STP (34078720)
#define OUT_KP (OUT_STP + 1048576)
#define OUT_VP (OUT_KP + 4194304)
#define OUT_KIP (OUT_VP + 4194304)
#define OUT_STS (OUT_KIP + 2097152)
#define OUT_KS (OUT_STS + 524288)
#define OUT_VS (OUT_KS + 65536)
#define OUT_KIS (OUT_VS + 65536)

typedef __bf16 bf16x2_t __attribute__((ext_vector_type(2)));
typedef float f32x2_t __attribute__((ext_vector_type(2)));
typedef unsigned u32x4_t __attribute__((ext_vector_type(4)));
typedef unsigned u32x2_t __attribute__((ext_vector_type(2)));
DI unsigned pk2(float a, float b) { f32x2_t v = {a, b}; bf16x2_t r = __builtin_convertvector(v, bf16x2_t); return __builtin_bit_cast(unsigned, r); }
DI u16 f2bf(float x) { return (u16)(pk2(x, x) & 0xffffu); }
DI bf16x8 ldg8(const u16* p) { return *(const bf16x8*)p; }
DI s16x4 ldg4(const u16* p) { return *(const s16x4*)p; }
DI float siluf(float x) { return x / (1.f + __expf(-x)); }
DI int crow(int reg, int hh) { return (reg & 3) + 8 * (reg >> 2) + 4 * hh; }
DI const float* xrow(const Params& p, int g) { return g < NPROMPT ? p.x_p + (size_t)g * 1024 : p.x_s + (size_t)(g - NPROMPT) * 1024; }
DI float log2gamma(int h) { return log1pf(-exp2f(-5.f - (float)h)) * 1.4426950408889634f; }
DI bf16x8 pack8(float a0, float a1, float a2, float a3, float a4, float a5, float a6, float a7) {
  u32x4_t v = {pk2(a0, a1), pk2(a2, a3), pk2(a4, a5), pk2(a6, a7)};
  return __builtin_bit_cast(bf16x8, v);
}
DI s16x4 pack4(f32x4 v) { u32x2_t o = {pk2(v[0], v[1]), pk2(v[2], v[3])}; return __builtin_bit_cast(s16x4, o); }
DI int wave_sum(int v) {
  v += __builtin_amdgcn_update_dpp(0, v, 0xB1, 0xf, 0xf, false);
  v += __builtin_amdgcn_update_dpp(0, v, 0x4E, 0xf, 0xf, false);
  v += __builtin_amdgcn_update_dpp(0, v, 0x124, 0xf, 0xf, false);
  v += __builtin_amdgcn_update_dpp(0, v, 0x128, 0xf, 0xf, false);
  return __builtin_amdgcn_readlane(v, 0) + __builtin_amdgcn_readlane(v, 16) + __builtin_amdgcn_readlane(v, 32) + __builtin_amdgcn_readlane(v, 48);
}
DI f32x16 zero16() { f32x16 z; for (int i = 0; i < 16; ++i) z[i] = 0.f; return z; }

#define XB_TMO      128
#define XB_XCNT(j)  (256  + 64 * (j))
#define XB_XSUB(j)  (1280 + 64 * (j))
#define XB_XGEN(j)  (2304 + 64 * (j))
#define XB_TOP      3328
#define XB_TOPGEN   3392
#define XB_WG(i)    (3456 + 64 * (i))
#define XCD_BAR_WORDS (3456 + 64 * 256)
#define XB_SPIN_CAP (1u << 18)
DI unsigned xb_ld(unsigned* p) { return __hip_atomic_load(p, __ATOMIC_RELAXED, __HIP_MEMORY_SCOPE_AGENT); }
DI unsigned xb_add(unsigned* p, unsigned v) { return __hip_atomic_fetch_add(p, v, __ATOMIC_RELAXED, __HIP_MEMORY_SCOPE_AGENT); }
DI unsigned xb_xcc_id() { return (unsigned)__builtin_amdgcn_s_getreg((3 << 11) | 20) & 0xFu; }
#define XB_SPIN(cond, bar) do { unsigned _sp = 0; while (cond) { __builtin_amdgcn_s_sleep(1); \
    if ((++_sp & 255u) == 0u) { if (xb_ld(&(bar)[XB_TMO])) break; if (_sp > XB_SPIN_CAP) { atomicAdd(&(bar)[XB_TMO], 1u); break; } } } } while (0)
DI void xcd_barrier_complete(unsigned* bar, unsigned x, unsigned& nloc, unsigned& nx) {
  const unsigned G = gridDim.x * gridDim.y * gridDim.z;
  unsigned sum, cnt, mine, sp = 0u;
  for (;;) {
    sum = 0u; cnt = 0u; mine = 0u;
#pragma unroll
    for (unsigned j = 0; j < 16; ++j) { const unsigned c = xb_ld(&bar[XB_XCNT(j)]); sum += c; cnt += (c > 0u) ? 1u : 0u; mine = (j == x) ? c : mine; }
    if (sum == G) break;
    __builtin_amdgcn_s_sleep(1);
    if ((++sp & 255u) == 0u) { if (xb_ld(&bar[XB_TMO])) break; if (sp > XB_SPIN_CAP) { atomicAdd(&bar[XB_TMO], 1u); break; } }
  }
  nloc = mine > 0u ? mine : 1u; nx = cnt > 0u ? cnt : 1u;
}
DI void xcd_barrier(unsigned* bar) {
  asm volatile("s_waitcnt vmcnt(0)" ::: "memory");
  __syncthreads();
  if (threadIdx.x == 0) {
    __builtin_amdgcn_s_waitcnt(0);
    const unsigned x = xb_xcc_id();
    unsigned* slot = &bar[XB_WG(blockIdx.x)];
    unsigned nloc = xb_ld(slot), nx = xb_ld(slot + 1);
    if (nloc == 0u) { xcd_barrier_complete(bar, x, nloc, nx); __hip_atomic_store(slot, nloc, __ATOMIC_RELAXED, __HIP_MEMORY_SCOPE_AGENT); __hip_atomic_store(slot + 1, nx, __ATOMIC_RELAXED, __HIP_MEMORY_SCOPE_AGENT); }
    const unsigned old = xb_add(&bar[XB_XSUB(x)], 1u);
    const unsigned gen = old / nloc;
    if (old + 1u == (gen + 1u) * nloc) {
      __builtin_amdgcn_fence(__ATOMIC_RELEASE, "agent");
      asm volatile("s_waitcnt vmcnt(0)" ::: "memory");
      const unsigned og = xb_add(&bar[XB_TOP], 1u);
      const unsigned tg = og / nx;
      if (og + 1u == (tg + 1u) * nx) xb_add(&bar[XB_TOPGEN], 1u);
      else XB_SPIN(xb_ld(&bar[XB_TOPGEN]) == tg, bar);
      __builtin_amdgcn_fence(__ATOMIC_ACQUIRE, "agent");
      xb_add(&bar[XB_XGEN(x)], 1u);
      asm volatile("s_waitcnt vmcnt(0)" ::: "memory");
    } else {
      XB_SPIN(xb_ld(&bar[XB_XGEN(x)]) == gen, bar);
      __builtin_amdgcn_fence(__ATOMIC_ACQUIRE, "agent");
      asm volatile("s_waitcnt vmcnt(0)" ::: "memory");
    }
  }
  __syncthreads();
}

DI void phase_prep(const Params& p, int tid) {
  const int gt = blockIdx.x * 512 + tid, GT = gridDim.x * 512;
  const int lane = tid & 63;
  for (int row0 = (gt >> 6) * 2; row0 < NTOK; row0 += (GT >> 6) * 2) {
    f32x4 v[2][4];
#pragma unroll
    for (int rr = 0; rr < 2; ++rr) {
      const float* sp = xrow(p, row0 + rr);
#pragma unroll
      for (int i = 0; i < 4; ++i) v[rr][i] = *(const f32x4*)(sp + i * 256 + lane * 4);
    }
#pragma unroll
    for (int rr = 0; rr < 2; ++rr) {
      float ss = 0.f;
#pragma unroll
      for (int i = 0; i < 4; ++i) ss += v[rr][i][0] * v[rr][i][0] + v[rr][i][1] * v[rr][i][1] + v[rr][i][2] * v[rr][i][2] + v[rr][i][3] * v[rr][i][3];
#pragma unroll
      for (int o = 32; o >= 1; o >>= 1) ss += __shfl_xor(ss, o);
#pragma unroll
      for (int i = 0; i < 4; ++i) *(s16x4*)(p.xb() + (size_t)(row0 + rr) * 1024 + i * 256 + lane * 4) = pack4(v[rr][i]);
      if (lane == 0) p.rinv()[row0 + rr] = rsqrtf(ss * (1.f / 1024.f) + 1e-6f);
    }
  }
  for (int i = gt; i < 4096 * 128; i += GT) {
    int n = i & 4095, kg = i >> 12;
    int sc = n;
    if (n < 1024) { const int P = n & 127; sc = (n & ~127) + 64 * ((P >> 4) & 1) + 16 * (P >> 5) + (P & 15); }
    float a[8];
#pragma unroll
    for (int j = 0; j < 8; ++j) a[j] = (n < 3912) ? p.w_in[(size_t)(kg * 8 + j) * 3912 + sc] * p.norm_g[kg * 8 + j] : 0.f;
    *(bf16x8*)(p.WtIn() + (size_t)n * 1024 + kg * 8) = pack8(a[0], a[1], a[2], a[3], a[4], a[5], a[6], a[7]);
  }
  for (int i = gt; i < 1024 * 128; i += GT) {
    int n = i % 1024, kg = i / 1024;
    float a[8];
#pragma unroll
    for (int j = 0; j < 8; ++j) a[j] = p.w_out[(size_t)(kg * 8 + j) * 1024 + n];
    *(bf16x8*)(p.WtOut() + (size_t)n * 1024 + kg * 8) = pack8(a[0], a[1], a[2], a[3], a[4], a[5], a[6], a[7]);
  }
  for (int i = gt; i < XCD_BAR_WORDS; i += GT) p.bar()[i] = 0u;
  for (int i = gt; i < 2112 * 64; i += GT) {
    int pos = i >> 6, k = i & 63;
    float inv = powf(10000.f, -(float)k / 64.f);
    float ang = (float)pos * inv;
    p.cosR()[i] = cosf(ang); p.sinR()[i] = sinf(ang);
  }
  for (int i = gt; i < 2112 * 8; i += GT) {
    int pos = i >> 3, k = i & 7;
    float inv = powf(500000.f, -(float)k / 8.f);
    float ang = (float)pos * inv;
    p.cosA()[i] = cosf(ang); p.sinA()[i] = sinf(ang);
  }
  for (int i = gt; i < 8 * 2048 * 2 * 8; i += GT) {
    int dg = i & 7, kvh = (i >> 3) & 1, t = (i >> 4) & 2047, b = i >> 15;
    const float* s = p.cache_k + ((size_t)(b * 2048 + t) * 2 + kvh) * 64 + dg * 8;
    *(bf16x8*)(p.kaS() + ((size_t)(b * 2 + kvh) * 2112 + t) * 64 + dg * 8) = pack8(s[0], s[1], s[2], s[3], s[4], s[5], s[6], s[7]);
  }
  for (int i = gt; i < 8 * 2 * 256 * 64; i += GT) {
    int d = i & 63, tg = (i >> 6) & 255, kvh = (i >> 14) & 1, b = i >> 15;
    float a[8];
#pragma unroll
    for (int j = 0; j < 8; ++j) a[j] = p.cache_v[((size_t)(b * 2048 + tg * 8 + j) * 2 + kvh) * 64 + d];
    *(bf16x8*)(p.vaTS() + ((size_t)(b * 2 + kvh) * 64 + d) * 2112 + tg * 8) = pack8(a[0], a[1], a[2], a[3], a[4], a[5], a[6], a[7]);
  }
  for (int i = gt; i < 8 * 2048 * 8; i += GT) {
    int dg = i & 7, t = (i >> 3) & 2047, b = i >> 14;
    const float* s = p.cache_kidx + (size_t)(b * 2048 + t) * 64 + dg * 8;
    *(bf16x8*)(p.kiS() + ((size_t)b * 2112 + t) * 64 + dg * 8) = pack8(s[0], s[1], s[2], s[3], s[4], s[5], s[6], s[7]);
  }
}

namespace pg8 {
constexpr int BM = 256, BK = 64, HALF = 128, HTB = HALF * BK * 2, STAGE_BYTES = 8 * HTB, NXCD = 8, WGM = 8;
DI int lds_byte(int r, int c) { const int st = (r >> 4) * 2 + (c >> 5), rr = r & 15, cc = c & 31, ob = rr * 64 + cc * 2; return st * 1024 + (ob ^ (((ob >> 9) & 1) << 5)); }
DI void stage_rc(int b, int& R, int& C) { const int st = b / 1024, sb = b % 1024, swz = sb ^ (((sb >> 9) & 1) << 5); R = (st >> 1) * 16 + swz / 64; C = (st & 1) * 32 + (swz % 64) / 2; }
struct Unit { int pm, pn; };
struct Gemm { const u16* A; const u16* Bt; int M, N, K; };
struct StaticOrder {
  int nM, nN, nwg, G, c;
  DI void init(int M, int N, int G_, int c_) { nM = M / BM; nN = N / BM; nwg = nM * nN; G = G_; c = c_; }
  DI bool next(int i, Unit& u) const {
    const long L = (long)i * G + c; if (L >= nwg) return false;
    int wgid = (int)L; { const int q = nwg / NXCD, r = nwg % NXCD, xcd = wgid % NXCD, off = wgid / NXCD; wgid = (xcd < r ? xcd * (q + 1) : r * (q + 1) + (xcd - r) * q) + off; }
    const int nig = WGM * nN, gid = wgid / nig, fm = gid * WGM, gsz = (nM - fm) < WGM ? (nM - fm) : WGM;
    u.pm = fm + ((wgid % nig) % gsz); u.pn = (wgid % nig) / gsz; return true;
  }
};
template <class Epi>
DI void gemm_phase(LAS unsigned char* lds, const Gemm g, const StaticOrder& S, const Epi& E) {
  int tid = threadIdx.x; asm volatile("" : "+v"(tid));
  const int wid = __builtin_amdgcn_readfirstlane(tid >> 6), lane = tid & 63, wr = wid >> 2, wc = wid & 3, fr = lane & 15, fq = lane >> 4;
  const int K = g.K, nt = K / BK;
  unsigned voffA[2], voffB[2];
#pragma unroll
  for (int i = 0; i < 2; ++i) { int R, C; stage_rc(tid * 16 + i * 8192, R, C); voffA[i] = (unsigned)(R * K + C) * 2u; voffB[i] = voffA[i]; }
  const size_t kstep = (size_t)(BK * 2);
  const size_t hstep = (size_t)HALF * K * 2;
  const size_t tstep = 2 * hstep;
  const unsigned ldsw = (unsigned)wid * 1024u;
  const int aoff = lds_byte(wr * 64 + fr, fq * 8), boff = lds_byte(wc * 32 + fr, fq * 8);
#define PG8_SA(b, h) (((b) * 2 + (h)) * HTB)
#define PG8_SB(b, h) ((4 + (b) * 2 + (h)) * HTB)
#define PG8_STAGE(bufoff, gbase, voff) do { _Pragma("unroll") for (int _i = 0; _i < 2; ++_i) \
    __builtin_amdgcn_global_load_lds((const unsigned*)((const char*)(gbase) + (voff)[_i]), (LAS unsigned*)(lds + (bufoff) + ldsw + _i * 8192), 16, 0, 0); } while (0)
#define PG8_LDA(dst, b, h) do { _Pragma("unroll") for (int m = 0; m < 4; ++m) _Pragma("unroll") for (int k = 0; k < 2; ++k) dst[m][k] = *(const LAS bf16x8*)(lds + PG8_SA(b, h) + aoff + m * 2048 + k * 1024); } while (0)
#define PG8_LDB(dst, b, h) do { _Pragma("unroll") for (int n = 0; n < 2; ++n) _Pragma("unroll") for (int k = 0; k < 2; ++k) dst[n][k] = *(const LAS bf16x8*)(lds + PG8_SB(b, h) + boff + n * 2048 + k * 1024); } while (0)
#define PG8_MMA(ai, bj, At, Bt) do { __builtin_amdgcn_s_setprio(1); _Pragma("unroll") for (int m = 0; m < 4; ++m) _Pragma("unroll") for (int n = 0; n < 2; ++n) _Pragma("unroll") for (int k = 0; k < 2; ++k) \
    acc[ai][bj][m][n] = __builtin_amdgcn_mfma_f32_16x16x32_bf16(Bt[n][k], At[m][k], acc[ai][bj][m][n], 0, 0, 0); __builtin_amdgcn_s_setprio(0); } while (0)
#define PG8_WAIT_V(n) asm volatile("s_waitcnt vmcnt(" #n ")" ::: "memory")
#define PG8_WAIT_L(n) asm volatile("s_waitcnt lgkmcnt(" #n ")" ::: "memory")
#define PG8_BAR __builtin_amdgcn_s_barrier()
#define PG8_SCHED __builtin_amdgcn_sched_barrier(0)
  Unit cur, nxt; int ui = 0;
  if (!S.next(0, cur)) return;
  f32x4 acc[2][2][4][2];
#pragma unroll
  for (int a = 0; a < 2; ++a)
#pragma unroll
    for (int b = 0; b < 2; ++b)
#pragma unroll
      for (int m = 0; m < 4; ++m)
#pragma unroll
        for (int n = 0; n < 2; ++n) acc[a][b][m][n] = (f32x4){0.f, 0.f, 0.f, 0.f};
  bf16x8 At[4][2], B0[2][2], B1[2][2];
  const char* cA = (const char*)g.A + (size_t)cur.pm * tstep; const char* cB = (const char*)g.Bt + (size_t)cur.pn * tstep;
  PG8_STAGE(PG8_SB(0, 0), cB, voffB); PG8_STAGE(PG8_SA(0, 0), cA, voffA); PG8_STAGE(PG8_SB(0, 1), cB + hstep, voffB); PG8_STAGE(PG8_SA(0, 1), cA + hstep, voffA);
  if (wr == 1) PG8_BAR;
  PG8_WAIT_V(4); PG8_BAR;
  PG8_STAGE(PG8_SB(1, 0), cB + kstep, voffB); PG8_STAGE(PG8_SA(1, 0), cA + kstep, voffA); PG8_STAGE(PG8_SB(1, 1), cB + hstep + kstep, voffB);
  PG8_WAIT_V(6); PG8_BAR;
  for (;;) {
    const bool has_next = S.next(ui + 1, nxt);
    const char* nA = has_next ? (const char*)g.A + (size_t)nxt.pm * tstep : cA; const char* nB = has_next ? (const char*)g.Bt + (size_t)nxt.pn * tstep : cB;
#ifndef REPK
#define REPK 1
#endif
    for (int rk = 0; rk < REPK; ++rk) {
    const char* nA2 = (rk == REPK - 1) ? nA : cA; const char* nB2 = (rk == REPK - 1) ? nB : cB;
    for (int t = 0; t < nt; t += 2) {
      const bool last = (t == nt - 2);
      const char* a1 = cA + (size_t)(t + 1) * kstep;
      const char* a2 = last ? nA2 : cA + (size_t)(t + 2) * kstep; const char* b2 = last ? nB2 : cB + (size_t)(t + 2) * kstep;
      const char* a3 = a2 + kstep; const char* b3 = b2 + kstep;
      PG8_LDB(B0, 0, 0); PG8_SCHED; PG8_LDA(At, 0, 0); PG8_STAGE(PG8_SA(1, 1), a1 + hstep, voffA);
      PG8_WAIT_L(8); PG8_BAR; PG8_WAIT_L(0); PG8_MMA(0, 0, At, B0); PG8_BAR; PG8_SCHED;
      PG8_LDB(B1, 0, 1); PG8_STAGE(PG8_SB(0, 0), b2, voffB);
      PG8_BAR; PG8_WAIT_L(0); PG8_MMA(0, 1, At, B1); PG8_BAR;
      PG8_LDA(At, 0, 1); PG8_STAGE(PG8_SA(0, 0), a2, voffA);
      PG8_BAR; PG8_WAIT_L(0); PG8_MMA(1, 0, At, B0); PG8_BAR; PG8_SCHED;
      PG8_STAGE(PG8_SB(0, 1), b2 + hstep, voffB);
      PG8_WAIT_V(6); PG8_BAR; PG8_MMA(1, 1, At, B1); PG8_BAR;
      PG8_LDB(B0, 1, 0); PG8_SCHED; PG8_LDA(At, 1, 0); PG8_STAGE(PG8_SA(0, 1), a2 + hstep, voffA);
      PG8_WAIT_L(8); PG8_BAR; PG8_WAIT_L(0); PG8_MMA(0, 0, At, B0); PG8_BAR; PG8_SCHED;
      PG8_LDB(B1, 1, 1); PG8_STAGE(PG8_SB(1, 0), b3, voffB);
      PG8_BAR; PG8_WAIT_L(0); PG8_MMA(0, 1, At, B1); PG8_BAR;
      PG8_LDA(At, 1, 1); PG8_STAGE(PG8_SA(1, 0), a3, voffA);
      PG8_BAR; PG8_WAIT_L(0); PG8_MMA(1, 0, At, B0); PG8_BAR; PG8_SCHED;
      PG8_STAGE(PG8_SB(1, 1), b3 + hstep, voffB);
      PG8_WAIT_V(6); PG8_BAR; PG8_MMA(1, 1, At, B1); PG8_BAR;
    }
    }
    {
      Unit eu = cur; int ewr = wr, ewc = wc, efr = fr, efq = fq;
      asm volatile("" : "+s"(eu.pm), "+s"(eu.pn), "+s"(ewr), "+s"(ewc), "+v"(efr), "+v"(efq));
#ifndef REPEPI
#define REPEPI 1
#endif
      for (int re = 0; re < REPEPI; ++re) E(acc, eu, ewr, ewc, efr, efq, re);
    }
    if (!has_next) break;
#pragma unroll
    for (int a = 0; a < 2; ++a)
#pragma unroll
      for (int b = 0; b < 2; ++b)
#pragma unroll
        for (int m = 0; m < 4; ++m)
#pragma unroll
          for (int n = 0; n < 2; ++n) acc[a][b][m][n] = (f32x4){0.f, 0.f, 0.f, 0.f};
    cur = nxt; cA = nA; cB = nB; ++ui;
  }
  PG8_WAIT_V(0);
  if (wr == 0) PG8_BAR;
  PG8_BAR;
#undef PG8_SA
#undef PG8_SB
#undef PG8_STAGE
#undef PG8_LDA
#undef PG8_LDB
#undef PG8_MMA
#undef PG8_WAIT_V
#undef PG8_WAIT_L
#undef PG8_BAR
#undef PG8_SCHED
}
}


struct Epi1 {
  Params p; u16* tl;
  DI void flush_T(int lane, u16* dstbase, size_t fstride, const int* fmap_kind, int wc) const {}
  DI void operator()(f32x4 (&acc)[2][2][4][2], const pg8::Unit& u, int wr, int wc, int fr, int fq, int re) const {
#pragma unroll
    for (int ai = 0; ai < 2; ++ai)
#pragma unroll
      for (int m = 0; m < 4; ++m) {
        const float rv = re ? 1.f : (1.f / REPK) * p.rinv()[u.pm * 256 + ai * 128 + wr * 64 + 16 * m + fr];
#pragma unroll
        for (int bj = 0; bj < 2; ++bj)
#pragma unroll
          for (int n = 0; n < 2; ++n) acc[ai][bj][m][n] *= rv;
      }
    asm volatile("" ::: "memory");
    const bool samp = (u.pm * 256 >= NPROMPT);
#pragma unroll
    for (int bj = 0; bj < 2; ++bj) {
      const int blk = u.pn * 2 + bj;
      if (blk == 31) continue;
#pragma unroll
      for (int ai = 0; ai < 2; ++ai) {
        asm volatile("" : "+v"(fr), "+v"(fq));
        const int lane = fr + 16 * fq;
        const int P0 = 32 * wc + 4 * fq;
        const int R0 = u.pm * 256 + ai * 128 + wr * 64;
        int b, tb;
        if (!samp) { b = R0 >> 11; tb = R0 & 2047; } else { b = (R0 - NPROMPT) >> 6; tb = 0; }
        const int posb = samp ? 2048 : tb;
        const int T = samp ? 64 : 2048;
        if (blk < 8) {
          const int head = blk & 3;
          const int f0 = 16 * wc + 4 * fq;
          const float l2g = log2gamma(head);
#pragma unroll
          for (int m = 0; m < 4; ++m) {
            __builtin_amdgcn_sched_barrier(0);
            const int rr = 16 * m + fr, g = R0 + rr, pos = posb + rr;
            const f32x4 v0 = acc[ai][bj][m][0], v1 = acc[ai][bj][m][1];
            const f32x4 cs = *(const f32x4*)(p.cosR() + pos * 64 + f0), sn = *(const f32x4*)(p.sinR() + pos * 64 + f0);
            f32x4 o0 = v0 * cs - v1 * sn, o1 = v1 * cs + v0 * sn;
            if (blk < 4) {
              *(s16x4*)(p.qr() + (unsigned)g * 512 + head * 128 + f0) = pack4(o0);
              *(s16x4*)(p.qr() + (unsigned)g * 512 + head * 128 + 64 + f0) = pack4(o1);
            } else {
              o0 *= 0.08838834764831845f; o1 *= 0.08838834764831845f;
              *(s16x4*)(p.kr() + (unsigned)g * 512 + head * 128 + f0) = pack4(o0);
              *(s16x4*)(p.kr() + (unsigned)g * 512 + head * 128 + 64 + f0) = pack4(o1);
              const float dec = exp2f((float)(63 - (rr & 63)) * l2g);
#pragma unroll
              for (int j = 0; j < 4; ++j) {
                tl[(4 * fq + j) * 64 + rr] = f2bf(o0[j] * dec);
                tl[(16 + 4 * fq + j) * 64 + rr] = f2bf(o1[j] * dec);
              }
            }
          }
          if (blk >= 4) {
#pragma unroll
            for (int i = 0; i < 4; ++i) {
              const int id = lane + 64 * i, cp = id >> 3, tg = id & 7;
              const bf16x8 v = *(const bf16x8*)(tl + cp * 64 + tg * 8);
              const int f = 64 * (cp >> 4) + 16 * wc + (cp & 15);
              u16* dst = samp ? p.krT() + (unsigned)64 * 128 * 2048 + ((unsigned)(b * 4 + head) * 128 + f) * 64 + tg * 8
                              : p.krT() + ((unsigned)(b * 4 + head) * 128 + f) * 2048 + tb + tg * 8;
              *(bf16x8*)dst = v;
            }
          }
        } else if (blk < 12 || blk == 21) {
#pragma unroll
          for (int m = 0; m < 4; ++m) {
            __builtin_amdgcn_sched_barrier(0);
            const int rr = 16 * m + fr, g = R0 + rr;
#pragma unroll
            for (int n = 0; n < 2; ++n) {
              const f32x4 v = acc[ai][bj][m][n];
              if (blk == 21) {
                float* o = samp ? p.out + OUT_VS + (unsigned)(g - NPROMPT) * 128 + P0 + 16 * n : p.out + OUT_VP + (unsigned)g * 128 + P0 + 16 * n;
                *(f32x4*)o = v;
              }
#pragma unroll
              for (int j = 0; j < 4; ++j) tl[(16 * n + 4 * fq + j) * 64 + rr] = f2bf(v[j]);
            }
          }
#pragma unroll
          for (int i = 0; i < 4; ++i) {
            const int id = lane + 64 * i, cp = id >> 3, tg = id & 7;
            const bf16x8 v = *(const bf16x8*)(tl + cp * 64 + tg * 8);
            const int f = 32 * wc + cp;
            u16* dst;
            if (blk < 12) {
              const int head = blk & 3;
              dst = samp ? p.vrT() + (unsigned)64 * 128 * 2048 + ((unsigned)(b * 4 + head) * 128 + f) * 64 + tg * 8
                         : p.vrT() + ((unsigned)(b * 4 + head) * 128 + f) * 2048 + tb + tg * 8;
            } else {
              const int kvh = f >> 6, d = f & 63;
              dst = samp ? p.vaTS() + ((unsigned)(b * 2 + kvh) * 64 + d) * 2112 + 2048 + tg * 8
                         : p.vaTP() + ((unsigned)(b * 2 + kvh) * 64 + d) * 2048 + tb + tg * 8;
            }
            *(bf16x8*)dst = v;
          }
        } else if ((blk >= 12 && blk < 16) || (blk >= 22 && blk < 26)) {
          const int colbase = (blk < 16) ? (blk - 12) * 128 : 512 + (blk - 22) * 128;
#pragma unroll
          for (int m = 0; m < 4; ++m) {
            __builtin_amdgcn_sched_barrier(0);
            const int g = R0 + 16 * m + fr;
#pragma unroll
            for (int n = 0; n < 2; ++n) {
              f32x4 v = acc[ai][bj][m][n];
              v[0] = siluf(v[0]); v[1] = siluf(v[1]); v[2] = siluf(v[2]); v[3] = siluf(v[3]);
              *(s16x4*)(p.gate() + (unsigned)g * 1024 + colbase + P0 + 16 * n) = pack4(v);
            }
          }
        } else {
          const bool ropew = ((wc & 1) == 0) && !(blk == 30 && wc >= 2);
#pragma unroll
          for (int m = 0; m < 4; ++m) {
            __builtin_amdgcn_sched_barrier(0);
            const int rr = 16 * m + fr, g = R0 + rr, pos = posb + rr;
            f32x4 v0 = acc[ai][bj][m][0];
            const f32x4 v1 = acc[ai][bj][m][1];
            if (ropew) {
              f32x4 pr;
              pr[0] = __shfl_xor(v0[0], 32); pr[1] = __shfl_xor(v0[1], 32); pr[2] = __shfl_xor(v0[2], 32); pr[3] = __shfl_xor(v0[3], 32);
              const f32x4 cs = *(const f32x4*)(p.cosA() + pos * 8 + 4 * (fq & 1)), sn = *(const f32x4*)(p.sinA() + pos * 8 + 4 * (fq & 1));
              v0 = (fq < 2) ? v0 * cs - pr * sn : v0 * cs + pr * sn;
            }
            if (blk < 20) {
              const float sc = 0.125f * 1.4426950408889634f;
              *(s16x4*)(p.qa() + (unsigned)g * 512 + (blk - 16) * 128 + P0) = pack4(v0 * sc);
              *(s16x4*)(p.qa() + (unsigned)g * 512 + (blk - 16) * 128 + P0 + 16) = pack4(v1 * sc);
            } else if (blk == 20) {
              float* o = samp ? p.out + OUT_KS + (unsigned)(g - NPROMPT) * 128 + P0 : p.out + OUT_KP + (unsigned)g * 128 + P0;
              *(f32x4*)o = v0; *(f32x4*)(o + 16) = v1;
              const int kvh = wc >> 1, d = P0 & 63;
              u16* dst = samp ? p.kaS() + ((unsigned)(b * 2 + kvh) * 2112 + 2048 + rr) * 64 + d
                              : p.kaP() + ((unsigned)(b * 2 + kvh) * 2048 + tb + rr) * 64 + d;
              *(s16x4*)dst = pack4(v0); *(s16x4*)(dst + 16) = pack4(v1);
            } else if (blk < 30) {
              *(s16x4*)(p.qi() + (unsigned)g * 512 + (blk - 26) * 128 + P0) = pack4(v0);
              *(s16x4*)(p.qi() + (unsigned)g * 512 + (blk - 26) * 128 + P0 + 16) = pack4(v1);
            } else {
              if (wc < 2) {
                float* o = samp ? p.out + OUT_KIS + (unsigned)(g - NPROMPT) * 64 + P0 : p.out + OUT_KIP + (unsigned)g * 64 + P0;
                *(f32x4*)o = v0; *(f32x4*)(o + 16) = v1;
                u16* dst = samp ? p.kiS() + ((unsigned)b * 2112 + 2048 + rr) * 64 + P0 : p.kiP() + ((unsigned)b * 2048 + tb + rr) * 64 + P0;
                *(s16x4*)dst = pack4(v0); *(s16x4*)(dst + 16) = pack4(v1);
              } else if (wc == 2 && fq < 2) {
                *(f32x4*)(p.wi() + (unsigned)g * 8 + 4 * fq) = v0 * 0.044194173824159216f;
              }
            }
          }
        }
      }
    }
  }
};

DI unsigned hx_w(int row, int c8) { return (unsigned)(row * 256 + ((c8 ^ ((row & 15) << 1)) << 3)); }
DI unsigned hx_r(int row, int c16) { return (unsigned)(row * 256 + ((c16 ^ (row & 15)) << 4)); }
#define EPI_BAR() asm volatile("s_waitcnt lgkmcnt(0)\n\ts_barrier" ::: "memory")

struct Epi2 {
  Params p; unsigned char* hl;
  DI void operator()(f32x4 (&acc)[2][2][4][2], const pg8::Unit& u, int wr, int wc, int fr, int fq, int re) const {
    u16* z = p.gate();
    const int lane = fr + 16 * fq;
#pragma unroll
    for (int ai = 0; ai < 2; ++ai)
#pragma unroll
      for (int bj = 0; bj < 2; ++bj) {
#pragma unroll
        for (int m = 0; m < 4; ++m)
#pragma unroll
          for (int n = 0; n < 2; ++n)
            *(s16x4*)(hl + hx_w(16 * m + fr, 8 * wc + 4 * n + fq)) = pack4(acc[ai][bj][m][n] * (1.f / REPK));
        EPI_BAR();
        const unsigned R0 = u.pm * 256 + ai * 128 + wr * 64;
        const unsigned cb = u.pn * 256 + bj * 128;
#pragma unroll
        for (int i = 0; i < 4; ++i) {
          const int row = 16 * wc + 4 * i + (lane >> 4), c16 = lane & 15;
          const bf16x8 v = *(const bf16x8*)(hl + hx_r(row, c16));
          *(bf16x8*)(z + (R0 + row) * 1024u + cb + c16 * 8) = v;
        }
        EPI_BAR();
      }
  }
};

DI void ret_kv_item(const Params& p, int item, int tid) {
  const int lane = tid & 63, w = tid >> 6, r = lane & 31, hh = lane >> 5;
  const u16 *kT, *vT; int T, c;
  if (item < 2048) { const int bh = item >> 5; c = item & 31; T = 2048; kT = p.krT() + (size_t)bh * 128 * 2048; vT = p.vrT() + (size_t)bh * 128 * 2048; }
  else { const int bh = item - 2048; c = 0; T = 64; kT = p.krT() + (size_t)64 * 128 * 2048 + (size_t)bh * 128 * 64; vT = p.vrT() + (size_t)64 * 128 * 2048 + (size_t)bh * 128 * 64; }
  const int e0 = (w & 1) * 64, d0 = (w >> 1) * 64;
  f32x16 acc[2][2];
  acc[0][0] = zero16(); acc[0][1] = zero16(); acc[1][0] = zero16(); acc[1][1] = zero16();
#pragma unroll
  for (int ks = 0; ks < 4; ++ks) {
    bf16x8 a0 = ldg8(vT + (size_t)(e0 + r) * T + c * 64 + ks * 16 + hh * 8);
    bf16x8 a1 = ldg8(vT + (size_t)(e0 + 32 + r) * T + c * 64 + ks * 16 + hh * 8);
    bf16x8 b0 = ldg8(kT + (size_t)(d0 + r) * T + c * 64 + ks * 16 + hh * 8);
    bf16x8 b1 = ldg8(kT + (size_t)(d0 + 32 + r) * T + c * 64 + ks * 16 + hh * 8);
    acc[0][0] = MFMA32(a0, b0, acc[0][0]);
    acc[0][1] = MFMA32(a0, b1, acc[0][1]);
    acc[1][0] = MFMA32(a1, b0, acc[1][0]);
    acc[1][1] = MFMA32(a1, b1, acc[1][1]);
  }
  float* o = p.kvT() + (size_t)item * 16384;
#pragma unroll
  for (int a = 0; a < 2; ++a)
#pragma unroll
    for (int b = 0; b < 2; ++b)
#pragma unroll
      for (int i = 0; i < 16; ++i)
        o[(e0 + a * 32 + crow(i, hh)) * 128 + d0 + b * 32 + r] = acc[a][b][i];
}

template <int NS>
DI void select_query(const u16* krow, int nj, int lane, u64* dst) {
  unsigned key[NS];
#pragma unroll
  for (int j = 0; j < NS; ++j) { const unsigned k = krow[j * 64 + lane]; key[j] = (j < nj) ? k : 0u; }
  constexpr int NP = (NS + 1) / 2;
  unsigned pk[NP];
#pragma unroll
  for (int i = 0; i < NP; ++i) pk[i] = key[2 * i] | ((2 * i + 1 < NS ? key[2 * i + 1] : 0u) << 16);
  unsigned prefix = 0;
  int cntp = 0;
  const unsigned ones = 0x00010001u;
  for (int bit = 15; bit >= 0; --bit) {
    const unsigned cand = prefix | (1u << bit);
    const unsigned c1 = cand - 1u;
    const unsigned cv = c1 | (c1 << 16);
    unsigned acc0 = 0, acc1 = 0;
#pragma unroll
    for (int i = 0; i < NP; ++i) {
      unsigned d, m;
      asm("v_pk_sub_u16 %0, %1, %2 clamp" : "=v"(d) : "v"(pk[i]), "v"(cv));
      asm("v_pk_min_u16 %0, %1, %2" : "=v"(m) : "v"(d), "v"(ones));
      if (i & 1) acc1 += m; else acc0 += m;
    }
    const unsigned a = acc0 + acc1;
    const int cnt = wave_sum((int)((a & 0xffffu) + (a >> 16)));
    if (cnt >= 256) { prefix = cand; cntp = cnt; }
    if (cnt == 256) break;
  }
  int wlo = 0, whi = 0;
  if (cntp == 256) {
#pragma unroll
    for (int j = 0; j < NS; ++j) {
      const u64 sm = __ballot(key[j] >= prefix);
      if (lane == j) { wlo = (int)(unsigned)sm; whi = (int)(unsigned)(sm >> 32); }
    }
  } else {
    int cgt = 0;
#pragma unroll
    for (int j = 0; j < NS; ++j) cgt += (key[j] > prefix) ? 1 : 0;
    cgt = wave_sum(cgt);
    const int rneed = 256 - cgt;
    int running = 0;
    const u64 lt = (1ull << lane) - 1ull;
#pragma unroll
    for (int j = 0; j < NS; ++j) {
      const bool eq = key[j] == prefix;
      const u64 em = __ballot(eq);
      const int rank = running + __popcll(em & lt);
      const bool sel = (key[j] > prefix) || (eq && rank < rneed);
      const u64 sm = __ballot(sel);
      if (lane == j) { wlo = (int)(unsigned)sm; whi = (int)(unsigned)(sm >> 32); }
      running += __popcll(em);
    }
  }
  if (lane < nj) dst[lane] = ((u64)(unsigned)whi << 32) | (u64)(unsigned)wlo;
}

DI void idx_item(const Params& p, unsigned char* lds, int tid, bool samp, int b, int grp) {
  const int lane = tid & 63, w = tid >> 6;
  const int t0 = grp * 16;
  int L, g0; const u16* ki;
  if (!samp) { const int c = t0 >> 6; L = (c + 1) * 64; g0 = b * 2048 + t0; ki = p.kiP() + (size_t)b * 2048 * 64; }
  else { L = 2112; g0 = NPROMPT + b * 64 + t0; ki = p.kiS() + (size_t)b * 2112 * 64; }
  const int nj = L >> 6;
  if (L <= 256) {
    for (int qq = 0; qq < 4; ++qq) {
      const int q = w * 4 + qq;
      if (lane < nj) p.maskbits()[(size_t)(g0 + q) * 33 + lane] = ~0ull;
    }
    return;
  }
  u16* keys = (u16*)lds;
#ifndef REPMF
#define REPMF 1
#endif
#ifndef REPSEL
#define REPSEL 1
#endif
#ifndef REPKV
#define REPKV 1
#endif
  for (int rmf = 0; rmf < REPMF; ++rmf) {
    const int qn = lane & 15, quad = lane >> 4;
    bf16x8 qf[8][2];
    float wv[8];
#pragma unroll
    for (int h = 0; h < 8; ++h) {
      qf[h][0] = ldg8(p.qi() + (size_t)(g0 + qn) * 512 + h * 64 + quad * 8);
      qf[h][1] = ldg8(p.qi() + (size_t)(g0 + qn) * 512 + h * 64 + 32 + quad * 8);
      wv[h] = p.wi()[(size_t)(g0 + qn) * 8 + h];
    }
    bf16x8 A0[4], A1[4], N0[4], N1[4];
#pragma unroll
    for (int i = 0; i < 4; ++i) {
      const int kt = w + 4 * i;
      A0[i] = ldg8(ki + (size_t)(kt * 16 + qn) * 64 + quad * 8);
      A1[i] = ldg8(ki + (size_t)(kt * 16 + qn) * 64 + 32 + quad * 8);
    }
    for (int base = 0; base < nj; base += 4) {
#pragma unroll
      for (int i = 0; i < 4; ++i) {
        const int t = base + 4 + i;
        if (t < nj) {
          const int kt = w + 4 * t;
          N0[i] = ldg8(ki + (size_t)(kt * 16 + qn) * 64 + quad * 8);
          N1[i] = ldg8(ki + (size_t)(kt * 16 + qn) * 64 + 32 + quad * 8);
        }
      }
#pragma unroll
      for (int i = 0; i < 4; ++i) {
        const int t = base + i;
        if (t < nj) {
          const int kt = w + 4 * t;
          float idx[4] = {0.f, 0.f, 0.f, 0.f};
#pragma unroll
          for (int h = 0; h < 8; ++h) {
            f32x4 acc = {0.f, 0.f, 0.f, 0.f};
            acc = MFMA16(A0[i], qf[h][0], acc);
            acc = MFMA16(A1[i], qf[h][1], acc);
#pragma unroll
            for (int e = 0; e < 4; ++e) idx[e] += fmaxf(acc[e], 0.f) * wv[h];
          }
          s16x4 kv;
#pragma unroll
          for (int e = 0; e < 4; ++e) {
            _Float16 hv = (_Float16)idx[e];
            u16 bits = __builtin_bit_cast(u16, hv);
            kv[e] = (short)((bits & 0x8000) ? (u16)~bits : (u16)(bits | 0x8000));
          }
          *(s16x4*)(keys + qn * KPITCH + kt * 16 + quad * 4) = kv;
        }
      }
#pragma unroll
      for (int i = 0; i < 4; ++i) { A0[i] = N0[i]; A1[i] = N1[i]; }
    }
  }
  __syncthreads();
  for (int qq = 0; qq < 4 * REPSEL; ++qq) {
    const int q = w * 4 + (qq & 3);
    const u16* krow = keys + q * KPITCH;
    u64* dst = p.maskbits() + (size_t)(g0 + q) * 33;
    if (nj <= 8) select_query<8>(krow, nj, lane, dst);
    else if (nj <= 16) select_query<16>(krow, nj, lane, dst);
    else if (nj <= 24) select_query<24>(krow, nj, lane, dst);
    else select_query<33>(krow, nj, lane, dst);
  }
  __syncthreads();
}

DI void scan_item(const Params& p, int item, int tid) {
  if (item < 1024) {
    const int bh = item >> 4, slab = item & 15;
    const int idx = slab * 1024 + tid * 4;
    const int h = bh & 3;
    const float cd = exp2f(64.f * log2gamma(h));
    f32x4 s = {0.f, 0.f, 0.f, 0.f};
    for (int c = 0; c < 32; ++c) {
      const size_t base = (size_t)(bh * 32 + c) * 16384 + idx;
      s16x4 o = pack4(s);
      *(s16x4*)(p.sprevT() + base) = o;
      f32x4 kv = *(const f32x4*)(p.kvT() + base);
      s = s * cd + kv;
    }
    const int e = idx >> 7, d = idx & 127;
    float* o = p.out + OUT_STP + (size_t)bh * 16384;
#pragma unroll
    for (int j = 0; j < 4; ++j) o[(d + j) * 128 + e] = s[j];
  } else {
    const int it = item - 1024;
    const int bh = it >> 4, slab = it & 15;
    const int idx = slab * 1024 + tid * 4;
    const int h = bh & 3;
    const float cd = exp2f(64.f * log2gamma(h));
    const int e = idx >> 7, d = idx & 127;
    const float* s0 = p.state_ret + (size_t)bh * 16384;
    f32x4 s;
#pragma unroll
    for (int j = 0; j < 4; ++j) s[j] = s0[(d + j) * 128 + e];
    const size_t base = (size_t)(2048 + bh) * 16384 + idx;
    s16x4 o = pack4(s);
    *(s16x4*)(p.sprevT() + base) = o;
    f32x4 kv = *(const f32x4*)(p.kvT() + base);
    s = s * cd + kv;
    float* oo = p.out + OUT_STS + (size_t)bh * 16384;
#pragma unroll
    for (int j = 0; j < 4; ++j) oo[(d + j) * 128 + e] = s[j];
  }
}

DI void attn_item(const Params& p, unsigned char* lds, int tid, bool samp, int b, int c, int kvh, int qh) {
  const int lane = tid & 63, w = tid >> 6, r = lane & 31, hh = lane >> 5;
  const int T = samp ? 2112 : 2048;
  const int nkt = samp ? 33 : c + 1;
  const int g0 = (samp ? NPROMPT + b * 64 : b * 2048 + c * 64) + qh * 32;
  const u16* K = samp ? p.kaS() + (size_t)(b * 2 + kvh) * 2112 * 64 : p.kaP() + (size_t)(b * 2 + kvh) * 2048 * 64;
  const u16* VT = samp ? p.vaTS() + (size_t)(b * 2 + kvh) * 64 * 2112 : p.vaTP() + (size_t)(b * 2 + kvh) * 64 * 2048;
  const int head = kvh * 4 + w;
  u16* Ks = (u16*)lds;
  u16* Vs = Ks + 64 * 72;
  u64* mL = (u64*)(lds + 2 * 9216);
  for (int i = tid; i < 32 * 33; i += 256) mL[i] = p.maskbits()[(size_t)g0 * 33 + i];
  bf16x8 qf[4];
#pragma unroll
  for (int ks = 0; ks < 4; ++ks) qf[ks] = ldg8(p.qa() + (size_t)(g0 + r) * 512 + head * 64 + ks * 16 + hh * 8);
  f32x16 O[2];
  O[0] = zero16(); O[1] = zero16();
  float mrun = -1e30f, lrun = 0.f;
  const int lrow = tid >> 3, lch = tid & 7;
  bf16x8 pk0, pk1, pv0, pv1, nk0, nk1, nv0, nv1;
  pk0 = ldg8(K + (size_t)(lrow)*64 + lch * 8);
  pk1 = ldg8(K + (size_t)(lrow + 32) * 64 + lch * 8);
  pv0 = ldg8(VT + (size_t)(lrow)*T + lch * 8);
  pv1 = ldg8(VT + (size_t)(lrow + 32) * T + lch * 8);
  nk0 = pk0; nk1 = pk1; nv0 = pv0; nv1 = pv1;
  if (nkt > 1) {
    nk0 = ldg8(K + (size_t)(64 + lrow) * 64 + lch * 8);
    nk1 = ldg8(K + (size_t)(64 + lrow + 32) * 64 + lch * 8);
    nv0 = ldg8(VT + (size_t)(lrow)*T + 64 + lch * 8);
    nv1 = ldg8(VT + (size_t)(lrow + 32) * T + 64 + lch * 8);
  }
  for (int kt = 0; kt < nkt; ++kt) {
    __syncthreads();
    *(bf16x8*)(Ks + lrow * 72 + lch * 8) = pk0;
    *(bf16x8*)(Ks + (lrow + 32) * 72 + lch * 8) = pk1;
    *(bf16x8*)(Vs + lrow * 72 + lch * 8) = pv0;
    *(bf16x8*)(Vs + (lrow + 32) * 72 + lch * 8) = pv1;
    __syncthreads();
    pk0 = nk0; pk1 = nk1; pv0 = nv0; pv1 = nv1;
    if (kt + 2 < nkt) {
      nk0 = ldg8(K + (size_t)((kt + 2) * 64 + lrow) * 64 + lch * 8);
      nk1 = ldg8(K + (size_t)((kt + 2) * 64 + lrow + 32) * 64 + lch * 8);
      nv0 = ldg8(VT + (size_t)(lrow)*T + (kt + 2) * 64 + lch * 8);
      nv1 = ldg8(VT + (size_t)(lrow + 32) * T + (kt + 2) * 64 + lch * 8);
    }
    f32x16 S[2];
#pragma unroll
    for (int st = 0; st < 2; ++st) {
      S[st] = zero16();
#pragma unroll
      for (int ks = 0; ks < 4; ++ks) {
        bf16x8 kf = *(const bf16x8*)(Ks + (st * 32 + r) * 72 + ks * 16 + hh * 8);
        S[st] = MFMA32(kf, qf[ks], S[st]);
      }
    }
    const u64 W = mL[r * 33 + kt];
    const int wl = (int)(((unsigned)W) >> (4 * hh)), wh = (int)(((unsigned)(W >> 32)) >> (4 * hh));
    float mx = fmaxf(S[0][0], S[1][0]);
#pragma unroll
    for (int i = 1; i < 16; ++i) mx = fmaxf(mx, fmaxf(S[0][i], S[1][i]));
    mx = fmaxf(mx, __shfl_xor(mx, 32));
    const float mn = fmaxf(mrun, mx);
    const float alpha = __builtin_amdgcn_exp2f(mrun - mn);
    const bool resc = __any(mn != mrun);
    mrun = mn;
    float ls = 0.f;
#pragma unroll
    for (int st = 0; st < 2; ++st)
#pragma unroll
      for (int i = 0; i < 16; ++i) {
        const int keep = __builtin_amdgcn_sbfe(st ? wh : wl, (i & 3) + 8 * (i >> 2), 1);
        const float pvv = __int_as_float(__float_as_int(__builtin_amdgcn_exp2f(S[st][i] - mn)) & keep);
        S[st][i] = pvv;
        ls += pvv;
      }
    lrun = lrun * alpha + ls;
    if (resc) {
#pragma unroll
      for (int dt = 0; dt < 2; ++dt)
#pragma unroll
        for (int i = 0; i < 16; ++i) O[dt][i] *= alpha;
    }
#pragma unroll
    for (int st = 0; st < 2; ++st)
#pragma unroll
      for (int s2 = 0; s2 < 2; ++s2) {
        bf16x8 pf = pack8(S[st][8 * s2 + 0], S[st][8 * s2 + 1], S[st][8 * s2 + 2], S[st][8 * s2 + 3],
                          S[st][8 * s2 + 4], S[st][8 * s2 + 5], S[st][8 * s2 + 6], S[st][8 * s2 + 7]);
#pragma unroll
        for (int dt = 0; dt < 2; ++dt) {
          s16x4 lo = *(const s16x4*)(Vs + (dt * 32 + r) * 72 + st * 32 + 16 * s2 + 4 * hh);
          s16x4 hi = *(const s16x4*)(Vs + (dt * 32 + r) * 72 + st * 32 + 16 * s2 + 8 + 4 * hh);
          bf16x8 vf = __builtin_shufflevector(lo, hi, 0, 1, 2, 3, 4, 5, 6, 7);
          O[dt] = MFMA32(vf, pf, O[dt]);
        }
      }
  }
  {
    float lt = lrun + __shfl_xor(lrun, 32);
    const float inv = 1.f / lt;
    const u16* grow = p.gate() + (size_t)(g0 + r) * 1024 + 512 + head * 64;
    u16* mrow = p.mix() + (size_t)(g0 + r) * 1024 + 512 + head * 64;
#pragma unroll
    for (int dt = 0; dt < 2; ++dt)
#pragma unroll
      for (int q4 = 0; q4 < 4; ++q4) {
        const int d = dt * 32 + 8 * q4 + 4 * hh;
        s16x4 gv = *(const s16x4*)(grow + d);
        f32x4 of;
#pragma unroll
        for (int j = 0; j < 4; ++j) {
          const float gf = __uint_as_float(((unsigned)(u16)gv[j]) << 16);
          of[j] = O[dt][q4 * 4 + j] * inv * gf;
        }
        *(s16x4*)(mrow + d) = pack4(of);
      }
  }
  __syncthreads();
}

DI void ret_out_item(const Params& p, unsigned char* lds, int item, int tid) {
  const int lane = tid & 63, w = tid >> 6, r = lane & 31, hh = lane >> 5;
  int bh, c, T, g0; const u16* vT;
  if (item < 2048) { bh = item >> 5; c = item & 31; T = 2048; g0 = (bh >> 2) * 2048 + c * 64; vT = p.vrT() + (size_t)bh * 128 * 2048; }
  else { bh = item - 2048; c = 0; T = 64; g0 = NPROMPT + (bh >> 2) * 64; vT = p.vrT() + (size_t)64 * 128 * 2048 + (size_t)bh * 128 * 64; }
  const int h = bh & 3;
  const float l2g = log2gamma(h);
  const int nt = w & 1, eh = w >> 1;
  const int n = nt * 32 + r;
  bf16x8 qf[8];
#pragma unroll
  for (int ks = 0; ks < 8; ++ks) qf[ks] = ldg8(p.qr() + (size_t)(g0 + n) * 512 + h * 128 + ks * 16 + hh * 8);
  bf16x8 pf[2][2];
#pragma unroll
  for (int mt = 0; mt < 2; ++mt) {
    f32x16 S = zero16();
#pragma unroll
    for (int ks = 0; ks < 8; ++ks) {
      bf16x8 kf = ldg8(p.kr() + (size_t)(g0 + mt * 32 + r) * 512 + h * 128 + ks * 16 + hh * 8);
      S = MFMA32(kf, qf[ks], S);
    }
#pragma unroll
    for (int i = 0; i < 16; ++i) {
      const int m = mt * 32 + crow(i, hh);
      const int dd = n > m ? n - m : m - n;
      S[i] *= exp2f((float)dd * l2g);
    }
    pf[mt][0] = pack8(S[0], S[1], S[2], S[3], S[4], S[5], S[6], S[7]);
    pf[mt][1] = pack8(S[8], S[9], S[10], S[11], S[12], S[13], S[14], S[15]);
  }
  const float fs = exp2f((float)(n + 1) * l2g);
  const u16* sp = p.sprevT() + (size_t)item * 16384;
  f32x16 tot[2];
  float ss = 0.f;
#pragma unroll
  for (int et = 0; et < 2; ++et) {
    const int e = (2 * eh + et) * 32 + r;
    f32x16 Oi = zero16(), X = zero16();
#pragma unroll
    for (int mt = 0; mt < 2; ++mt)
#pragma unroll
      for (int s2 = 0; s2 < 2; ++s2) {
        const u16* vp = vT + (size_t)e * T + c * 64 + mt * 32 + 16 * s2 + 4 * hh;
        s16x4 lo = ldg4(vp), hi = ldg4(vp + 8);
        bf16x8 vf = __builtin_shufflevector(lo, hi, 0, 1, 2, 3, 4, 5, 6, 7);
        Oi = MFMA32(vf, pf[mt][s2], Oi);
      }
#pragma unroll
    for (int ks = 0; ks < 8; ++ks) {
      bf16x8 sf = ldg8(sp + (size_t)e * 128 + ks * 16 + hh * 8);
      X = MFMA32(sf, qf[ks], X);
    }
#pragma unroll
    for (int i = 0; i < 16; ++i) { const float t = Oi[i] + X[i] * fs; tot[et][i] = t; ss += t * t; }
  }
  ss += __shfl_xor(ss, 32);
  float* red = (float*)lds;
  __syncthreads();
  if (hh == 0) red[w * 32 + r] = ss;
  __syncthreads();
  const float tsum = red[w * 32 + r] + red[(w ^ 2) * 32 + r];
  const float rinv = rsqrtf(tsum * (1.f / 128.f) + 1e-6f);
  const u16* grow = p.gate() + (size_t)(g0 + n) * 1024 + h * 128;
  u16* mrow = p.mix() + (size_t)(g0 + n) * 1024 + h * 128;
#pragma unroll
  for (int et = 0; et < 2; ++et)
#pragma unroll
    for (int q4 = 0; q4 < 4; ++q4) {
      const int e = (2 * eh + et) * 32 + 8 * q4 + 4 * hh;
      s16x4 gv = *(const s16x4*)(grow + e);
      f32x4 gg = *(const f32x4*)(p.ret_gn_g + h * 128 + e);
      f32x4 of;
#pragma unroll
      for (int j = 0; j < 4; ++j) {
        const float gf = __uint_as_float(((unsigned)(u16)gv[j]) << 16);
        of[j] = tot[et][q4 * 4 + j] * rinv * gg[j] * gf;
      }
      *(s16x4*)(mrow + e) = pack4(of);
    }
}

DI void phase_final(const Params& p, int tid) {
  const int gt = blockIdx.x * 512 + tid, GT = gridDim.x * 512;
  const int lane = tid & 63;
  for (int row0 = (gt >> 6) * 2; row0 < NTOK; row0 += (GT >> 6) * 2) {
    f32x4 v[2][4];
    s16x4 zz[2][4];
#pragma unroll
    for (int rr = 0; rr < 2; ++rr) {
      const float* xr = xrow(p, row0 + rr);
      const u16* zr = p.gate() + (size_t)(row0 + rr) * 1024;
#pragma unroll
      for (int i = 0; i < 4; ++i) { v[rr][i] = *(const f32x4*)(xr + i * 256 + lane * 4); zz[rr][i] = *(const s16x4*)(zr + i * 256 + lane * 4); }
    }
    f32x4 g[4];
#pragma unroll
    for (int i = 0; i < 4; ++i) g[i] = *(const f32x4*)(p.final_g + i * 256 + lane * 4);
#pragma unroll
    for (int rr = 0; rr < 2; ++rr) {
      float ss = 0.f;
#pragma unroll
      for (int i = 0; i < 4; ++i) {
#pragma unroll
        for (int j = 0; j < 4; ++j) v[rr][i][j] += __uint_as_float(((unsigned)(u16)zz[rr][i][j]) << 16);
        ss += v[rr][i][0] * v[rr][i][0] + v[rr][i][1] * v[rr][i][1] + v[rr][i][2] * v[rr][i][2] + v[rr][i][3] * v[rr][i][3];
      }
#pragma unroll
      for (int o = 32; o >= 1; o >>= 1) ss += __shfl_xor(ss, o);
      const float rv = rsqrtf(ss * (1.f / 1024.f) + 1e-6f);
      float* y = p.out + OUT_Y + (size_t)(row0 + rr) * 1024;
#pragma unroll
      for (int i = 0; i < 4; ++i) *(f32x4*)(y + i * 256 + lane * 4) = v[rr][i] * rv * g[i];
    }
  }
}

#ifndef REP0
#define REP0 1
#endif
#ifndef REP1
#define REP1 1
#endif
#ifndef REP2
#define REP2 1
#endif
#ifndef REP3
#define REP3 1
#endif
#ifndef REP4
#define REP4 1
#endif
#ifndef REP5
#define REP5 1
#endif
__global__ void __launch_bounds__(512, 2) fwd_megakernel(Params p) {
  __shared__ __attribute__((aligned(16))) unsigned char lds[LDS_BYTES];
  cg::grid_group grid = cg::this_grid();
#define FRESH_TID() int tid = threadIdx.x; asm volatile("" : "+v"(tid)); const int half = tid >> 8, htid = tid & 255; unsigned char* ldsh = lds + half * HALF_LDS; (void)htid; (void)ldsh;
  for (int rep = 0; rep < REP0; ++rep) {
  { FRESH_TID(); phase_prep(p, tid); }
  grid.sync();
  if (rep == REP0 - 1 && threadIdx.x == 0) (void)xb_add(&p.bar()[XB_XCNT(xb_xcc_id())], 1u);
  }
  for (int rep = 0; rep < REP1; ++rep) {
  {
    FRESH_TID();
    pg8::Gemm g; g.A = p.xb(); g.Bt = p.WtIn(); g.M = NTOK; g.N = 4096; g.K = 1024;
    pg8::StaticOrder S; S.init(g.M, g.N, (int)gridDim.x, (int)blockIdx.x);
    Epi1 E; E.p = p; E.tl = (u16*)(lds + pg8::STAGE_BYTES + (tid >> 6) * 4096);
    pg8::gemm_phase<Epi1>((LAS unsigned char*)lds, g, S, E);
  }
  xcd_barrier(p.bar());
  }
  for (int rep = 0; rep < REP2; ++rep) {
  {
    FRESH_TID();
    for (int it0 = blockIdx.x * 2; it0 < 2080 + 2080; it0 += gridDim.x * 2) {
      const int it = it0 + half;
      int ht = htid; asm volatile("" : "+v"(ht));
      if (it < 2080) {
        const bool samp = it < 32;
        const int j = it - 32;
        const int c = 31 - (j >> 6);
        const int b = samp ? (it >> 2) : ((j & 63) >> 2);
        const int grp = samp ? (it & 3) : (c * 4 + (j & 3));
        idx_item(p, ldsh, ht, samp, b, grp);
      } else { for (int rkv = 0; rkv < REPKV; ++rkv) ret_kv_item(p, it - 2080, ht); }
    }
  }
  xcd_barrier(p.bar());
  }
  for (int rep = 0; rep < REP3; ++rep) {
  {
    FRESH_TID();
    for (int it0 = blockIdx.x * 2; it0 < 1056 + 1536; it0 += gridDim.x * 2) {
      const int it = it0 + half;
      int ht = htid; asm volatile("" : "+v"(ht));
      if (it < 1056) {
        const bool samp = it < 32;
        const int j = it - 32;
        int c = samp ? 0 : 31 - (j >> 6);
        int b = samp ? (it >> 2) : ((j & 63) >> 2);
        int kvh = (it >> 1) & 1;
        if (!samp && gridDim.x == 256) {
          const int jb = (j >> 1) & 255, rnd = j >> 9;
          const int xcd = jb & 7, ii = jb >> 3;
          b = 2 * xcd + (ii & 1); kvh = (ii >> 1) & 1; c = 31 - rnd * 8 - (ii >> 2);
        }
        attn_item(p, ldsh, ht, samp, b, c, kvh, it & 1);
      } else scan_item(p, it - 1056, ht);
    }
  }
  xcd_barrier(p.bar());
  }
  for (int rep = 0; rep < REP4; ++rep) {
  {
    FRESH_TID();
    for (int it0 = blockIdx.x * 2; it0 < 2080 + 1024; it0 += gridDim.x * 2) {
      const int it = it0 + half;
      int ht = htid; asm volatile("" : "+v"(ht));
      if (it < 2080) ret_out_item(p, ldsh, it, ht);
      else {
        const int ia = it - 2080 + 1056;
        const int j = ia - 32;
        int c = 31 - (j >> 6);
        int b = (j & 63) >> 2;
        int kvh = (ia >> 1) & 1;
        if (gridDim.x == 256) {
          const int jb = (j >> 1) & 255, rnd = j >> 9;
          const int xcd = jb & 7, ii = jb >> 3;
          b = 2 * xcd + (ii & 1); kvh = (ii >> 1) & 1; c = 31 - rnd * 8 - (ii >> 2);
        }
        attn_item(p, ldsh, ht, false, b, c, kvh, ia & 1);
      }
    }
  }
  xcd_barrier(p.bar());
  }
  for (int rep = 0; rep < REP5; ++rep) {
  {
    pg8::Gemm g; g.A = p.mix(); g.Bt = p.WtOut(); g.M = NTOK; g.N = 1024; g.K = 1024;
    pg8::StaticOrder S; S.init(g.M, g.N, (int)gridDim.x, (int)blockIdx.x);
    int tid2 = threadIdx.x; asm volatile("" : "+v"(tid2));
    Epi2 E; E.p = p; E.hl = lds + pg8::STAGE_BYTES + (tid2 >> 8) * 16384;
    pg8::gemm_phase<Epi2>((LAS unsigned char*)lds, g, S, E);
  }
  xcd_barrier(p.bar());
  }
  { FRESH_TID(); phase_final(p, tid); }
}

extern "C" void kernel_launch(void* const* d_in, const int* in_sizes, int n_in, void* d_out, int out_size, void* d_ws,
                              size_t ws_size, hipStream_t stream) {
  static int grid_blocks = 0;
  if (!grid_blocks) {
    int dev = 0, cus = 0, per_cu = 0;
    (void)hipGetDevice(&dev);
    (void)hipDeviceGetAttribute(&cus, hipDeviceAttributeMultiprocessorCount, dev);
    (void)hipOccupancyMaxActiveBlocksPerMultiprocessor(&per_cu, fwd_megakernel, 512, 0);
    if (per_cu < 1) per_cu = 1;
    if (per_cu > 1) per_cu = 1;
    grid_blocks = cus * per_cu;
  }
  Params p{};
  p.x_p = (const float*)d_in[0]; p.x_s = (const float*)d_in[1]; p.state_ret = (const float*)d_in[2];
  p.cache_k = (const float*)d_in[3]; p.cache_v = (const float*)d_in[4]; p.cache_kidx = (const float*)d_in[5];
  p.norm_g = (const float*)d_in[6]; p.w_in = (const float*)d_in[7]; p.ret_gn_g = (const float*)d_in[8];
  p.w_out = (const float*)d_in[9]; p.final_g = (const float*)d_in[10];
  p.out = (float*)d_out;
  p.ws = (unsigned char*)d_ws;
  void* args[] = {&p};
  hipError_t e = hipLaunchCooperativeKernel((void*)fwd_megakernel, dim3(grid_blocks), dim3(512), args, 0, stream);
  if (e != hipSuccess) fprintf(stderr, "cooperative launch failed: %s (grid %d)\n", hipGetErrorString(e), grid_blocks);
}
```

```cpp
#include <hip/hip_runtime.h>
#include <hip/hip_cooperative_groups.h>
#include <stdint.h>
#include <cstdio>
namespace cg = cooperative_groups;

typedef __attribute__((ext_vector_type(8))) short bf16x8;
typedef __attribute__((ext_vector_type(4))) short s16x4;
typedef __attribute__((ext_vector_type(16))) float f32x16;
typedef __attribute__((ext_vector_type(4))) float f32x4;
typedef unsigned short u16;
typedef unsigned long long u64;


#define DI __device__ __forceinline__
#define MFMA32(a, b, c) __builtin_amdgcn_mfma_f32_32x32x16_bf16((a), (b), (c), 0, 0, 0)
#define MFMA16(a, b, c) __builtin_amdgcn_mfma_f32_16x16x32_bf16((a), (b), (c), 0, 0, 0)

#define NTOK 33280
#define NPROMPT 32768
#define LDS_BYTES 163840
#define HALF_LDS 81920
#define LAS __attribute__((address_space(3)))
#define KPITCH 2116

struct Params {
  const float *x_p, *x_s, *state_ret, *cache_k, *cache_v, *cache_kidx, *norm_g, *w_in, *ret_gn_g, *w_out, *final_g;
  float* out;
  unsigned char* ws;
  DI u16* xb() const { return (u16*)(ws + 0ull); }
  DI float* kvT() const { return (float*)(ws + 0ull); }
  DI u16* WtIn() const { return (u16*)(ws + 136314880ull); }
  DI u16* WtOut() const { return (u16*)(ws + 144703488ull); }
  DI u16* qr() const { return (u16*)(ws + 146800640ull); }
  DI u16* kr() const { return (u16*)(ws + 180879360ull); }
  DI u16* sprevT() const { return (u16*)(ws + 214958080ull); }
  DI u16* qi() const { return (u16*)(ws + 214958080ull); }
  DI u16* krT() const { return (u16*)(ws + 249036800ull); }
  DI u16* vrT() const { return (u16*)(ws + 283115520ull); }
  DI u16* gate() const { return (u16*)(ws + 317194240ull); }
  DI u16* mix() const { return (u16*)(ws + 385351680ull); }
  DI u16* qa() const { return (u16*)(ws + 453509120ull); }
  DI u16* kaP() const { return (u16*)(ws + 487587840ull); }
  DI u16* kaS() const { return (u16*)(ws + 495976448ull); }
  DI u16* vaTP() const { return (u16*)(ws + 500301824ull); }
  DI u16* vaTS() const { return (u16*)(ws + 508690432ull); }
  DI u16* kiP() const { return (u16*)(ws + 513015808ull); }
  DI u16* kiS() const { return (u16*)(ws + 517210112ull); }
  DI float* rinv() const { return (float*)(ws + 519372800ull); }
  DI float* wi() const { return (float*)(ws + 519505920ull); }
  DI float* cosR() const { return (float*)(ws + 520570880ull); }
  DI float* sinR() const { return (float*)(ws + 521111552ull); }
  DI float* cosA() const { return (float*)(ws + 521652224ull); }
  DI float* sinA() const { return (float*)(ws + 521719808ull); }
  DI unsigned* bar() const { return (unsigned*)(ws + 530573312ull); }
  DI u64* maskbits() const { return (u64*)(ws + 521787392ull); }
};

#define OUT_Y 0
#define OUT_STP (34078720)
#define OUT_KP (OUT_STP + 1048576)
#define OUT_VP (OUT_KP + 4194304)
#define OUT_KIP (OUT_VP + 4194304)
#define OUT_STS (OUT_KIP + 2097152)
#define OUT_KS (OUT_STS + 524288)
#define OUT_VS (OUT_KS + 65536)
#define OUT_KIS (OUT_VS + 65536)

typedef __bf16 bf16x2_t __attribute__((ext_vector_type(2)));
typedef float f32x2_t __attribute__((ext_vector_type(2)));
typedef unsigned u32x4_t __attribute__((ext_vector_type(4)));
typedef unsigned u32x2_t __attribute__((ext_vector_type(2)));
DI unsigned pk2(float a, float b) { f32x2_t v = {a, b}; bf16x2_t r = __builtin_convertvector(v, bf16x2_t); return __builtin_bit_cast(unsigned, r); }
DI u16 f2bf(float x) { return (u16)(pk2(x, x) & 0xffffu); }
DI bf16x8 ldg8(const u16* p) { return *(const bf16x8*)p; }
DI s16x4 ldg4(const u16* p) { return *(const s16x4*)p; }
DI float siluf(float x) { return x / (1.f + __expf(-x)); }
DI int crow(int reg, int hh) { return (reg & 3) + 8 * (reg >> 2) + 4 * hh; }
DI const float* xrow(const Params& p, int g) { return g < NPROMPT ? p.x_p + (size_t)g * 1024 : p.x_s + (size_t)(g - NPROMPT) * 1024; }
DI float log2gamma(int h) { return log1pf(-exp2f(-5.f - (float)h)) * 1.4426950408889634f; }
DI bf16x8 pack8(float a0, float a1, float a2, float a3, float a4, float a5, float a6, float a7) {
  u32x4_t v = {pk2(a0, a1), pk2(a2, a3), pk2(a4, a5), pk2(a6, a7)};
  return __builtin_bit_cast(bf16x8, v);
}
DI s16x4 pack4(f32x4 v) { u32x2_t o = {pk2(v[0], v[1]), pk2(v[2], v[3])}; return __builtin_bit_cast(s16x4, o); }
DI int wave_sum(int v) {
  v += __builtin_amdgcn_update_dpp(0, v, 0xB1, 0xf, 0xf, false);
  v += __builtin_amdgcn_update_dpp(0, v, 0x4E, 0xf, 0xf, false);
  v += __builtin_amdgcn_update_dpp(0, v, 0x124, 0xf, 0xf, false);
  v += __builtin_amdgcn_update_dpp(0, v, 0x128, 0xf, 0xf, false);
  return __builtin_amdgcn_readlane(v, 0) + __builtin_amdgcn_readlane(v, 16) + __builtin_amdgcn_readlane(v, 32) + __builtin_amdgcn_readlane(v, 48);
}
DI f32x16 zero16() { f32x16 z; for (int i = 0; i < 16; ++i) z[i] = 0.f; return z; }

#define XB_TMO      128
#define XB_XCNT(j)  (256  + 64 * (j))
#define XB_XSUB(j)  (1280 + 64 * (j))
#define XB_XGEN(j)  (2304 + 64 * (j))
#define XB_TOP      3328
#define XB_TOPGEN   3392
#define XB_WG(i)    (3456 + 64 * (i))
#define XCD_BAR_WORDS (3456 + 64 * 256)
#define XB_SPIN_CAP (1u << 18)
DI unsigned xb_ld(unsigned* p) { return __hip_atomic_load(p, __ATOMIC_RELAXED, __HIP_MEMORY_SCOPE_AGENT); }
DI unsigned xb_add(unsigned* p, unsigned v) { return __hip_atomic_fetch_add(p, v, __ATOMIC_RELAXED, __HIP_MEMORY_SCOPE_AGENT); }
DI unsigned xb_xcc_id() { return (unsigned)__builtin_amdgcn_s_getreg((3 << 11) | 20) & 0xFu; }
#define XB_SPIN(cond, bar) do { unsigned _sp = 0; while (cond) { __builtin_amdgcn_s_sleep(1); \
    if ((++_sp & 255u) == 0u) { if (xb_ld(&(bar)[XB_TMO])) break; if (_sp > XB_SPIN_CAP) { atomicAdd(&(bar)[XB_TMO], 1u); break; } } } } while (0)
DI void xcd_barrier_complete(unsigned* bar, unsigned x, unsigned& nloc, unsigned& nx) {
  const unsigned G = gridDim.x * gridDim.y * gridDim.z;
  unsigned sum, cnt, mine, sp = 0u;
  for (;;) {
    sum = 0u; cnt = 0u; mine = 0u;
#pragma unroll
    for (unsigned j = 0; j < 16; ++j) { const unsigned c = xb_ld(&bar[XB_XCNT(j)]); sum += c; cnt += (c > 0u) ? 1u : 0u; mine = (j == x) ? c : mine; }
    if (sum == G) break;
    __builtin_amdgcn_s_sleep(1);
    if ((++sp & 255u) == 0u) { if (xb_ld(&bar[XB_TMO])) break; if (sp > XB_SPIN_CAP) { atomicAdd(&bar[XB_TMO], 1u); break; } }
  }
  nloc = mine > 0u ? mine : 1u; nx = cnt > 0u ? cnt : 1u;
}
DI void xcd_barrier(unsigned* bar) {
  asm volatile("s_waitcnt vmcnt(0)" ::: "memory");
  __syncthreads();
  if (threadIdx.x == 0) {
    __builtin_amdgcn_s_waitcnt(0);
    const unsigned x = xb_xcc_id();
    unsigned* slot = &bar[XB_WG(blockIdx.x)];
    unsigned nloc = xb_ld(slot), nx = xb_ld(slot + 1);
    if (nloc == 0u) { xcd_barrier_complete(bar, x, nloc, nx); __hip_atomic_store(slot, nloc, __ATOMIC_RELAXED, __HIP_MEMORY_SCOPE_AGENT); __hip_atomic_store(slot + 1, nx, __ATOMIC_RELAXED, __HIP_MEMORY_SCOPE_AGENT); }
    const unsigned old = xb_add(&bar[XB_XSUB(x)], 1u);
    const unsigned gen = old / nloc;
    if (old + 1u == (gen + 1u) * nloc) {
      __builtin_amdgcn_fence(__ATOMIC_RELEASE, "agent");
      asm volatile("s_waitcnt vmcnt(0)" ::: "memory");
      const unsigned og = xb_add(&bar[XB_TOP], 1u);
      const unsigned tg = og / nx;
      if (og + 1u == (tg + 1u) * nx) xb_add(&bar[XB_TOPGEN], 1u);
      else XB_SPIN(xb_ld(&bar[XB_TOPGEN]) == tg, bar);
      __builtin_amdgcn_fence(__ATOMIC_ACQUIRE, "agent");
      xb_add(&bar[XB_XGEN(x)], 1u);
      asm volatile("s_waitcnt vmcnt(0)" ::: "memory");
    } else {
      XB_SPIN(xb_ld(&bar[XB_XGEN(x)]) == gen, bar);
      __builtin_amdgcn_fence(__ATOMIC_ACQUIRE, "agent");
      asm volatile("s_waitcnt vmcnt(0)" ::: "memory");
    }
  }
  __syncthreads();
}

DI void phase_prep(const Params& p, int tid) {
  const int gt = blockIdx.x * 512 + tid, GT = gridDim.x * 512;
  const int lane = tid & 63;
  for (int row0 = (gt >> 6) * 2; row0 < NTOK; row0 += (GT >> 6) * 2) {
    f32x4 v[2][4];
#pragma unroll
    for (int rr = 0; rr < 2; ++rr) {
      const float* sp = xrow(p, row0 + rr);
#pragma unroll
      for (int i = 0; i < 4; ++i) v[rr][i] = *(const f32x4*)(sp + i * 256 + lane * 4);
    }
#pragma unroll
    for (int rr = 0; rr < 2; ++rr) {
      float ss = 0.f;
#pragma unroll
      for (int i = 0; i < 4; ++i) ss += v[rr][i][0] * v[rr][i][0] + v[rr][i][1] * v[rr][i][1] + v[rr][i][2] * v[rr][i][2] + v[rr][i][3] * v[rr][i][3];
#pragma unroll
      for (int o = 32; o >= 1; o >>= 1) ss += __shfl_xor(ss, o);
#pragma unroll
      for (int i = 0; i < 4; ++i) *(s16x4*)(p.xb() + (size_t)(row0 + rr) * 1024 + i * 256 + lane * 4) = pack4(v[rr][i]);
      if (lane == 0) p.rinv()[row0 + rr] = rsqrtf(ss * (1.f / 1024.f) + 1e-6f);
    }
  }
  for (int i = gt; i < 4096 * 128; i += GT) {
    int n = i & 4095, kg = i >> 12;
    int sc = n;
    if (n < 1024) { const int P = n & 127; sc = (n & ~127) + 64 * ((P >> 4) & 1) + 16 * (P >> 5) + (P & 15); }
    float a[8];
#pragma unroll
    for (int j = 0; j < 8; ++j) a[j] = (n < 3912) ? p.w_in[(size_t)(kg * 8 + j) * 3912 + sc] * p.norm_g[kg * 8 + j] : 0.f;
    *(bf16x8*)(p.WtIn() + (size_t)n * 1024 + kg * 8) = pack8(a[0], a[1], a[2], a[3], a[4], a[5], a[6], a[7]);
  }
  for (int i = gt; i < 1024 * 128; i += GT) {
    int n = i % 1024, kg = i / 1024;
    float a[8];
#pragma unroll
    for (int j = 0; j < 8; ++j) a[j] = p.w_out[(size_t)(kg * 8 + j) * 1024 + n];
    *(bf16x8*)(p.WtOut() + (size_t)n * 1024 + kg * 8) = pack8(a[0], a[1], a[2], a[3], a[4], a[5], a[6], a[7]);
  }
  for (int i = gt; i < 2112 * 64; i += GT) {
    int pos = i >> 6, k = i & 63;
    float inv = powf(10000.f, -(float)k / 64.f);
    float ang = (float)pos * inv;
    p.cosR()[i] = cosf(ang); p.sinR()[i] = sinf(ang);
  }
  for (int i = gt; i < 2112 * 8; i += GT) {
    int pos = i >> 3, k = i & 7;
    float inv = powf(500000.f, -(float)k / 8.f);
    float ang = (float)pos * inv;
    p.cosA()[i] = cosf(ang); p.sinA()[i] = sinf(ang);
  }
  for (int i = gt; i < 8 * 2048 * 2 * 8; i += GT) {
    int dg = i & 7, kvh = (i >> 3) & 1, t = (i >> 4) & 2047, b = i >> 15;
    const float* s = p.cache_k + ((size_t)(b * 2048 + t) * 2 + kvh) * 64 + dg * 8;
    *(bf16x8*)(p.kaS() + ((size_t)(b * 2 + kvh) * 2112 + t) * 64 + dg * 8) = pack8(s[0], s[1], s[2], s[3], s[4], s[5], s[6], s[7]);
  }
  for (int i = gt; i < 8 * 2 * 256 * 64; i += GT) {
    int d = i & 63, tg = (i >> 6) & 255, kvh = (i >> 14) & 1, b = i >> 15;
    float a[8];
#pragma unroll
    for (int j = 0; j < 8; ++j) a[j] = p.cache_v[((size_t)(b * 2048 + tg * 8 + j) * 2 + kvh) * 64 + d];
    *(bf16x8*)(p.vaTS() + ((size_t)(b * 2 + kvh) * 64 + d) * 2112 + tg * 8) = pack8(a[0], a[1], a[2], a[3], a[4], a[5], a[6], a[7]);
  }
  for (int i = gt; i < 8 * 2048 * 8; i += GT) {
    int dg = i & 7, t = (i >> 3) & 2047, b = i >> 14;
    const float* s = p.cache_kidx + (size_t)(b * 2048 + t) * 64 + dg * 8;
    *(bf16x8*)(p.kiS() + ((size_t)b * 2112 + t) * 64 + dg * 8) = pack8(s[0], s[1], s[2], s[3], s[4], s[5], s[6], s[7]);
  }
}

namespace pg8 {
constexpr int BM = 256, BK = 64, HALF = 128, HTB = HALF * BK * 2, STAGE_BYTES = 8 * HTB, NXCD = 8, WGM = 8;
DI int lds_byte(int r, int c) { const int st = (r >> 4) * 2 + (c >> 5), rr = r & 15, cc = c & 31, ob = rr * 64 + cc * 2; return st * 1024 + (ob ^ (((ob >> 9) & 1) << 5)); }
DI void stage_rc(int b, int& R, int& C) { const int st = b / 1024, sb = b % 1024, swz = sb ^ (((sb >> 9) & 1) << 5); R = (st >> 1) * 16 + swz / 64; C = (st & 1) * 32 + (swz % 64) / 2; }
struct Unit { int pm, pn; };
struct Gemm { const u16* A; const u16* Bt; int M, N, K; };
struct StaticOrder {
  int nM, nN, nwg, G, c; unsigned long long permtab;
  DI void init(int M, int N, int G_, int c_) { nM = M / BM; nN = N / BM; nwg = nM * nN; G = G_; c = c_; permtab = 0xFEDCBA9876543210ull; }
  DI bool next(int i, Unit& u) const {
    const long L = (long)i * G + c; if (L >= nwg) return false;
    int wgid = (int)L; { const int q = nwg / NXCD, r = nwg % NXCD, xcd = wgid % NXCD, off = wgid / NXCD; wgid = (xcd < r ? xcd * (q + 1) : r * (q + 1) + (xcd - r) * q) + off; }
    const int nig = WGM * nN, gid = wgid / nig, fm = gid * WGM, gsz = (nM - fm) < WGM ? (nM - fm) : WGM;
    u.pm = fm + ((wgid % nig) % gsz); u.pn = (int)((permtab >> (4 * ((wgid % nig) / gsz))) & 15ull); return true;
  }
};
template <class Epi>
DI void gemm_phase(LAS unsigned char* lds, const Gemm g, const StaticOrder& S, const Epi& E) {
  int tid = threadIdx.x; asm volatile("" : "+v"(tid));
  const int wid = __builtin_amdgcn_readfirstlane(tid >> 6), lane = tid & 63, wr = wid >> 2, wc = wid & 3, fr = lane & 15, fq = lane >> 4;
  const int K = g.K, nt = K / BK;
  unsigned voffA[2], voffB[2];
#pragma unroll
  for (int i = 0; i < 2; ++i) { int R, C; stage_rc(tid * 16 + i * 8192, R, C); voffA[i] = (unsigned)(R * K + C) * 2u; voffB[i] = voffA[i]; }
  const size_t kstep = (size_t)(BK * 2);
  const size_t hstep = (size_t)HALF * K * 2;
  const size_t tstep = 2 * hstep;
  const unsigned ldsw = (unsigned)wid * 1024u;
  const int aoff = lds_byte(wr * 64 + fr, fq * 8), boff = lds_byte(wc * 32 + fr, fq * 8);
#define PG8_SA(b, h) (((b) * 2 + (h)) * HTB)
#define PG8_SB(b, h) ((4 + (b) * 2 + (h)) * HTB)
#define PG8_STAGE(bufoff, gbase, voff) do { _Pragma("unroll") for (int _i = 0; _i < 2; ++_i) \
    __builtin_amdgcn_global_load_lds((const unsigned*)((const char*)(gbase) + (voff)[_i]), (LAS unsigned*)(lds + (bufoff) + ldsw + _i * 8192), 16, 0, 0); } while (0)
#define PG8_LDA(dst, b, h) do { _Pragma("unroll") for (int m = 0; m < 4; ++m) _Pragma("unroll") for (int k = 0; k < 2; ++k) dst[m][k] = *(const LAS bf16x8*)(lds + PG8_SA(b, h) + aoff + m * 2048 + k * 1024); } while (0)
#define PG8_LDB(dst, b, h) do { _Pragma("unroll") for (int n = 0; n < 2; ++n) _Pragma("unroll") for (int k = 0; k < 2; ++k) dst[n][k] = *(const LAS bf16x8*)(lds + PG8_SB(b, h) + boff + n * 2048 + k * 1024); } while (0)
#define PG8_MMA(ai, bj, At, Bt) do { __builtin_amdgcn_s_setprio(1); _Pragma("unroll") for (int m = 0; m < 4; ++m) _Pragma("unroll") for (int n = 0; n < 2; ++n) _Pragma("unroll") for (int k = 0; k < 2; ++k) \
    acc[ai][bj][m][n] = __builtin_amdgcn_mfma_f32_16x16x32_bf16(Bt[n][k], At[m][k], acc[ai][bj][m][n], 0, 0, 0); __builtin_amdgcn_s_setprio(0); } while (0)
#define PG8_WAIT_V(n) asm volatile("s_waitcnt vmcnt(" #n ")" ::: "memory")
#define PG8_WAIT_L(n) asm volatile("s_waitcnt lgkmcnt(" #n ")" ::: "memory")
#define PG8_BAR __builtin_amdgcn_s_barrier()
#define PG8_SCHED __builtin_amdgcn_sched_barrier(0)
  Unit cur, nxt; int ui = 0;
  if (!S.next(0, cur)) return;
  f32x4 acc[2][2][4][2];
#pragma unroll
  for (int a = 0; a < 2; ++a)
#pragma unroll
    for (int b = 0; b < 2; ++b)
#pragma unroll
      for (int m = 0; m < 4; ++m)
#pragma unroll
        for (int n = 0; n < 2; ++n) acc[a][b][m][n] = (f32x4){0.f, 0.f, 0.f, 0.f};
  bf16x8 At[4][2], B0[2][2], B1[2][2];
  const char* cA = (const char*)g.A + (size_t)cur.pm * tstep; const char* cB = (const char*)g.Bt + (size_t)cur.pn * tstep;
  PG8_STAGE(PG8_SB(0, 0), cB, voffB); PG8_STAGE(PG8_SA(0, 0), cA, voffA); PG8_STAGE(PG8_SB(0, 1), cB + hstep, voffB); PG8_STAGE(PG8_SA(0, 1), cA + hstep, voffA);
  if (wr == 1) PG8_BAR;
  PG8_WAIT_V(4); PG8_BAR;
  PG8_STAGE(PG8_SB(1, 0), cB + kstep, voffB); PG8_STAGE(PG8_SA(1, 0), cA + kstep, voffA); PG8_STAGE(PG8_SB(1, 1), cB + hstep + kstep, voffB);
  PG8_WAIT_V(6); PG8_BAR;
  for (;;) {
    const bool has_next = S.next(ui + 1, nxt);
    const char* nA = has_next ? (const char*)g.A + (size_t)nxt.pm * tstep : cA; const char* nB = has_next ? (const char*)g.Bt + (size_t)nxt.pn * tstep : cB;
#ifndef REPK
#define REPK 1
#endif
    for (int rk = 0; rk < REPK; ++rk) {
    const char* nA2 = (rk == REPK - 1) ? nA : cA; const char* nB2 = (rk == REPK - 1) ? nB : cB;
    for (int t = 0; t < nt; t += 2) {
      const bool last = (t == nt - 2);
      const char* a1 = cA + (size_t)(t + 1) * kstep;
      const char* a2 = last ? nA2 : cA + (size_t)(t + 2) * kstep; const char* b2 = last ? nB2 : cB + (size_t)(t + 2) * kstep;
      const char* a3 = a2 + kstep; const char* b3 = b2 + kstep;
      PG8_LDB(B0, 0, 0); PG8_SCHED; PG8_LDA(At, 0, 0); PG8_STAGE(PG8_SA(1, 1), a1 + hstep, voffA);
      PG8_WAIT_L(8); PG8_BAR; PG8_WAIT_L(0); PG8_MMA(0, 0, At, B0); PG8_BAR; PG8_SCHED;
      PG8_LDB(B1, 0, 1); PG8_STAGE(PG8_SB(0, 0), b2, voffB);
      PG8_BAR; PG8_WAIT_L(0); PG8_MMA(0, 1, At, B1); PG8_BAR;
      PG8_LDA(At, 0, 1); PG8_STAGE(PG8_SA(0, 0), a2, voffA);
      PG8_BAR; PG8_WAIT_L(0); PG8_MMA(1, 0, At, B0); PG8_BAR; PG8_SCHED;
      PG8_STAGE(PG8_SB(0, 1), b2 + hstep, voffB);
      PG8_WAIT_V(6); PG8_BAR; PG8_MMA(1, 1, At, B1); PG8_BAR;
      PG8_LDB(B0, 1, 0); PG8_SCHED; PG8_LDA(At, 1, 0); PG8_STAGE(PG8_SA(0, 1), a2 + hstep, voffA);
      PG8_WAIT_L(8); PG8_BAR; PG8_WAIT_L(0); PG8_MMA(0, 0, At, B0); PG8_BAR; PG8_SCHED;
      PG8_LDB(B1, 1, 1); PG8_STAGE(PG8_SB(1, 0), b3, voffB);
      PG8_BAR; PG8_WAIT_L(0); PG8_MMA(0, 1, At, B1); PG8_BAR;
      PG8_LDA(At, 1, 1); PG8_STAGE(PG8_SA(1, 0), a3, voffA);
      PG8_BAR; PG8_WAIT_L(0); PG8_MMA(1, 0, At, B0); PG8_BAR; PG8_SCHED;
      PG8_STAGE(PG8_SB(1, 1), b3 + hstep, voffB);
      PG8_WAIT_V(6); PG8_BAR; PG8_MMA(1, 1, At, B1); PG8_BAR;
    }
    }
    {
      Unit eu = cur; int ewr = wr, ewc = wc, efr = fr, efq = fq;
      asm volatile("" : "+s"(eu.pm), "+s"(eu.pn), "+s"(ewr), "+s"(ewc), "+v"(efr), "+v"(efq));
#ifndef REPEPI
#define REPEPI 1
#endif
      for (int re = 0; re < REPEPI; ++re) E(acc, eu, ewr, ewc, efr, efq, re);
    }
    if (!has_next) break;
#pragma unroll
    for (int a = 0; a < 2; ++a)
#pragma unroll
      for (int b = 0; b < 2; ++b)
#pragma unroll
        for (int m = 0; m < 4; ++m)
#pragma unroll
          for (int n = 0; n < 2; ++n) acc[a][b][m][n] = (f32x4){0.f, 0.f, 0.f, 0.f};
    cur = nxt; cA = nA; cB = nB; ++ui;
  }
  PG8_WAIT_V(0);
  if (wr == 0) PG8_BAR;
  PG8_BAR;
#undef PG8_SA
#undef PG8_SB
#undef PG8_STAGE
#undef PG8_LDA
#undef PG8_LDB
#undef PG8_MMA
#undef PG8_WAIT_V
#undef PG8_WAIT_L
#undef PG8_BAR
#undef PG8_SCHED
}
}


struct Epi1 {
  Params p; u16* tl;
  DI void flush_T(int lane, u16* dstbase, size_t fstride, const int* fmap_kind, int wc) const {}
  DI void operator()(f32x4 (&acc)[2][2][4][2], const pg8::Unit& u, int wr, int wc, int fr, int fq, int re) const {
#pragma unroll
    for (int ai = 0; ai < 2; ++ai)
#pragma unroll
      for (int m = 0; m < 4; ++m) {
        const float rv = re ? 1.f : (1.f / REPK) * p.rinv()[u.pm * 256 + ai * 128 + wr * 64 + 16 * m + fr];
#pragma unroll
        for (int bj = 0; bj < 2; ++bj)
#pragma unroll
          for (int n = 0; n < 2; ++n) acc[ai][bj][m][n] *= rv;
      }
    asm volatile("" ::: "memory");
    const bool samp = (u.pm * 256 >= NPROMPT);
#pragma unroll
    for (int bj = 0; bj < 2; ++bj) {
      const int blk = u.pn * 2 + bj;
      if (blk == 31) continue;
#pragma unroll
      for (int ai = 0; ai < 2; ++ai) {
        asm volatile("" : "+v"(fr), "+v"(fq));
        const int lane = fr + 16 * fq;
        const int P0 = 32 * wc + 4 * fq;
        const int R0 = u.pm * 256 + ai * 128 + wr * 64;
        int b, tb;
        if (!samp) { b = R0 >> 11; tb = R0 & 2047; } else { b = (R0 - NPROMPT) >> 6; tb = 0; }
        const int posb = samp ? 2048 : tb;
        const int T = samp ? 64 : 2048;
        if (blk < 8) {
          const int head = blk & 3;
          const int f0 = 16 * wc + 4 * fq;
          const float l2g = log2gamma(head);
#pragma unroll
          for (int m = 0; m < 4; ++m) {
            __builtin_amdgcn_sched_barrier(0);
            const int rr = 16 * m + fr, g = R0 + rr, pos = posb + rr;
            const f32x4 v0 = acc[ai][bj][m][0], v1 = acc[ai][bj][m][1];
            const f32x4 cs = *(const f32x4*)(p.cosR() + pos * 64 + f0), sn = *(const f32x4*)(p.sinR() + pos * 64 + f0);
            f32x4 o0 = v0 * cs - v1 * sn, o1 = v1 * cs + v0 * sn;
            if (blk < 4) {
              *(s16x4*)(p.qr() + (unsigned)g * 512 + head * 128 + f0) = pack4(o0);
              *(s16x4*)(p.qr() + (unsigned)g * 512 + head * 128 + 64 + f0) = pack4(o1);
            } else {
              o0 *= 0.08838834764831845f; o1 *= 0.08838834764831845f;
              *(s16x4*)(p.kr() + (unsigned)g * 512 + head * 128 + f0) = pack4(o0);
              *(s16x4*)(p.kr() + (unsigned)g * 512 + head * 128 + 64 + f0) = pack4(o1);
              const float dec = exp2f((float)(63 - (rr & 63)) * l2g);
#pragma unroll
              for (int j = 0; j < 4; ++j) {
                tl[(4 * fq + j) * 64 + rr] = f2bf(o0[j] * dec);
                tl[(16 + 4 * fq + j) * 64 + rr] = f2bf(o1[j] * dec);
              }
            }
          }
          if (blk >= 4) {
#pragma unroll
            for (int i = 0; i < 4; ++i) {
              const int id = lane + 64 * i, cp = id >> 3, tg = id & 7;
              const bf16x8 v = *(const bf16x8*)(tl + cp * 64 + tg * 8);
              const int f = 64 * (cp >> 4) + 16 * wc + (cp & 15);
              u16* dst = samp ? p.krT() + (unsigned)64 * 128 * 2048 + ((unsigned)(b * 4 + head) * 128 + f) * 64 + tg * 8
                              : p.krT() + ((unsigned)(b * 4 + head) * 128 + f) * 2048 + tb + tg * 8;
              *(bf16x8*)dst = v;
            }
          }
        } else if (blk < 12 || blk == 21) {
#pragma unroll
          for (int m = 0; m < 4; ++m) {
            __builtin_amdgcn_sched_barrier(0);
            const int rr = 16 * m + fr, g = R0 + rr;
#pragma unroll
            for (int n = 0; n < 2; ++n) {
              const f32x4 v = acc[ai][bj][m][n];
              if (blk == 21) {
                float* o = samp ? p.out + OUT_VS + (unsigned)(g - NPROMPT) * 128 + P0 + 16 * n : p.out + OUT_VP + (unsigned)g * 128 + P0 + 16 * n;
                *(f32x4*)o = v;
              }
#pragma unroll
              for (int j = 0; j < 4; ++j) tl[(16 * n + 4 * fq + j) * 64 + rr] = f2bf(v[j]);
            }
          }
#pragma unroll
          for (int i = 0; i < 4; ++i) {
            const int id = lane + 64 * i, cp = id >> 3, tg = id & 7;
            const bf16x8 v = *(const bf16x8*)(tl + cp * 64 + tg * 8);
            const int f = 32 * wc + cp;
            u16* dst;
            if (blk < 12) {
              const int head = blk & 3;
              dst = samp ? p.vrT() + (unsigned)64 * 128 * 2048 + ((unsigned)(b * 4 + head) * 128 + f) * 64 + tg * 8
                         : p.vrT() + ((unsigned)(b * 4 + head) * 128 + f) * 2048 + tb + tg * 8;
            } else {
              const int kvh = f >> 6, d = f & 63;
              dst = samp ? p.vaTS() + ((unsigned)(b * 2 + kvh) * 64 + d) * 2112 + 2048 + tg * 8
                         : p.vaTP() + ((unsigned)(b * 2 + kvh) * 64 + d) * 2048 + tb + tg * 8;
            }
            *(bf16x8*)dst = v;
          }
        } else if ((blk >= 12 && blk < 16) || (blk >= 22 && blk < 26)) {
          const int colbase = (blk < 16) ? (blk - 12) * 128 : 512 + (blk - 22) * 128;
#pragma unroll
          for (int m = 0; m < 4; ++m) {
            __builtin_amdgcn_sched_barrier(0);
            const int g = R0 + 16 * m + fr;
#pragma unroll
            for (int n = 0; n < 2; ++n) {
              f32x4 v = acc[ai][bj][m][n];
              v[0] = siluf(v[0]); v[1] = siluf(v[1]); v[2] = siluf(v[2]); v[3] = siluf(v[3]);
              *(s16x4*)(p.gate() + (unsigned)g * 1024 + colbase + P0 + 16 * n) = pack4(v);
            }
          }
        } else {
          const bool ropew = ((wc & 1) == 0) && !(blk == 30 && wc >= 2);
#pragma unroll
          for (int m = 0; m < 4; ++m) {
            __builtin_amdgcn_sched_barrier(0);
            const int rr = 16 * m + fr, g = R0 + rr, pos = posb + rr;
            f32x4 v0 = acc[ai][bj][m][0];
            const f32x4 v1 = acc[ai][bj][m][1];
            if (ropew) {
              f32x4 pr;
              pr[0] = __shfl_xor(v0[0], 32); pr[1] = __shfl_xor(v0[1], 32); pr[2] = __shfl_xor(v0[2], 32); pr[3] = __shfl_xor(v0[3], 32);
              const f32x4 cs = *(const f32x4*)(p.cosA() + pos * 8 + 4 * (fq & 1)), sn = *(const f32x4*)(p.sinA() + pos * 8 + 4 * (fq & 1));
              v0 = (fq < 2) ? v0 * cs - pr * sn : v0 * cs + pr * sn;
            }
            if (blk < 20) {
              const float sc = 0.125f * 1.4426950408889634f;
              *(s16x4*)(p.qa() + (unsigned)g * 512 + (blk - 16) * 128 + P0) = pack4(v0 * sc);
              *(s16x4*)(p.qa() + (unsigned)g * 512 + (blk - 16) * 128 + P0 + 16) = pack4(v1 * sc);
            } else if (blk == 20) {
              float* o = samp ? p.out + OUT_KS + (unsigned)(g - NPROMPT) * 128 + P0 : p.out + OUT_KP + (unsigned)g * 128 + P0;
              *(f32x4*)o = v0; *(f32x4*)(o + 16) = v1;
              const int kvh = wc >> 1, d = P0 & 63;
              u16* dst = samp ? p.kaS() + ((unsigned)(b * 2 + kvh) * 2112 + 2048 + rr) * 64 + d
                              : p.kaP() + ((unsigned)(b * 2 + kvh) * 2048 + tb + rr) * 64 + d;
              *(s16x4*)dst = pack4(v0); *(s16x4*)(dst + 16) = pack4(v1);
            } else if (blk < 30) {
              *(s16x4*)(p.qi() + (unsigned)g * 512 + (blk - 26) * 128 + P0) = pack4(v0);
              *(s16x4*)(p.qi() + (unsigned)g * 512 + (blk - 26) * 128 + P0 + 16) = pack4(v1);
            } else {
              if (wc < 2) {
                float* o = samp ? p.out + OUT_KIS + (unsigned)(g - NPROMPT) * 64 + P0 : p.out + OUT_KIP + (unsigned)g * 64 + P0;
                *(f32x4*)o = v0; *(f32x4*)(o + 16) = v1;
                u16* dst = samp ? p.kiS() + ((unsigned)b * 2112 + 2048 + rr) * 64 + P0 : p.kiP() + ((unsigned)b * 2048 + tb + rr) * 64 + P0;
                *(s16x4*)dst = pack4(v0); *(s16x4*)(dst + 16) = pack4(v1);
              } else if (wc == 2 && fq < 2) {
                *(f32x4*)(p.wi() + (unsigned)g * 8 + 4 * fq) = v0 * 0.044194173824159216f;
              }
            }
          }
        }
      }
    }
  }
};

DI unsigned hx_w(int row, int c8) { return (unsigned)(row * 256 + ((c8 ^ ((row & 15) << 1)) << 3)); }
DI unsigned hx_r(int row, int c16) { return (unsigned)(row * 256 + ((c16 ^ (row & 15)) << 4)); }
#define EPI_BAR() asm volatile("s_waitcnt lgkmcnt(0)\n\ts_barrier" ::: "memory")

struct Epi2 {
  Params p; unsigned char* hl;
  DI void operator()(f32x4 (&acc)[2][2][4][2], const pg8::Unit& u, int wr, int wc, int fr, int fq, int re) const {
    u16* z = p.gate();
    const int lane = fr + 16 * fq;
#pragma unroll
    for (int ai = 0; ai < 2; ++ai)
#pragma unroll
      for (int bj = 0; bj < 2; ++bj) {
#pragma unroll
        for (int m = 0; m < 4; ++m)
#pragma unroll
          for (int n = 0; n < 2; ++n)
            *(s16x4*)(hl + hx_w(16 * m + fr, 8 * wc + 4 * n + fq)) = pack4(acc[ai][bj][m][n] * (1.f / REPK));
        EPI_BAR();
        const unsigned R0 = u.pm * 256 + ai * 128 + wr * 64;
        const unsigned cb = u.pn * 256 + bj * 128;
#pragma unroll
        for (int i = 0; i < 4; ++i) {
          const int row = 16 * wc + 4 * i + (lane >> 4), c16 = lane & 15;
          const bf16x8 v = *(const bf16x8*)(hl + hx_r(row, c16));
          *(bf16x8*)(z + (R0 + row) * 1024u + cb + c16 * 8) = v;
        }
        EPI_BAR();
      }
  }
};

DI void ret_kv_item(const Params& p, int item, int tid) {
  const int lane = tid & 63, w = tid >> 6, r = lane & 31, hh = lane >> 5;
  const u16 *kT, *vT; int T, c;
  if (item < 2048) { const int bh = item >> 5; c = item & 31; T = 2048; kT = p.krT() + (size_t)bh * 128 * 2048; vT = p.vrT() + (size_t)bh * 128 * 2048; }
  else { const int bh = item - 2048; c = 0; T = 64; kT = p.krT() + (size_t)64 * 128 * 2048 + (size_t)bh * 128 * 64; vT = p.vrT() + (size_t)64 * 128 * 2048 + (size_t)bh * 128 * 64; }
  const int e0 = (w & 1) * 64, d0 = (w >> 1) * 64;
  f32x16 acc[2][2];
  acc[0][0] = zero16(); acc[0][1] = zero16(); acc[1][0] = zero16(); acc[1][1] = zero16();
#pragma unroll
  for (int ks = 0; ks < 4; ++ks) {
    bf16x8 a0 = ldg8(vT + (size_t)(e0 + r) * T + c * 64 + ks * 16 + hh * 8);
    bf16x8 a1 = ldg8(vT + (size_t)(e0 + 32 + r) * T + c * 64 + ks * 16 + hh * 8);
    bf16x8 b0 = ldg8(kT + (size_t)(d0 + r) * T + c * 64 + ks * 16 + hh * 8);
    bf16x8 b1 = ldg8(kT + (size_t)(d0 + 32 + r) * T + c * 64 + ks * 16 + hh * 8);
    acc[0][0] = MFMA32(a0, b0, acc[0][0]);
    acc[0][1] = MFMA32(a0, b1, acc[0][1]);
    acc[1][0] = MFMA32(a1, b0, acc[1][0]);
    acc[1][1] = MFMA32(a1, b1, acc[1][1]);
  }
  float* o = p.kvT() + (size_t)item * 16384;
#pragma unroll
  for (int a = 0; a < 2; ++a)
#pragma unroll
    for (int b = 0; b < 2; ++b)
#pragma unroll
      for (int i = 0; i < 16; ++i)
        o[(e0 + a * 32 + crow(i, hh)) * 128 + d0 + b * 32 + r] = acc[a][b][i];
}

template <int NS>
DI void select_query(const u16* krow, int nj, int lane, u64* dst) {
  unsigned key[NS];
#pragma unroll
  for (int j = 0; j < NS; ++j) { const unsigned k = krow[j * 64 + lane]; key[j] = (j < nj) ? k : 0u; }
  constexpr int NP = (NS + 1) / 2;
  unsigned pk[NP];
#pragma unroll
  for (int i = 0; i < NP; ++i) pk[i] = key[2 * i] | ((2 * i + 1 < NS ? key[2 * i + 1] : 0u) << 16);
  unsigned prefix = 0;
  int cntp = 0;
  const unsigned ones = 0x00010001u;
  for (int bit = 15; bit >= 0; --bit) {
    const unsigned cand = prefix | (1u << bit);
    const unsigned c1 = cand - 1u;
    const unsigned cv = c1 | (c1 << 16);
    unsigned acc0 = 0, acc1 = 0;
#pragma unroll
    for (int i = 0; i < NP; ++i) {
      unsigned d, m;
      asm("v_pk_sub_u16 %0, %1, %2 clamp" : "=v"(d) : "v"(pk[i]), "v"(cv));
      asm("v_pk_min_u16 %0, %1, %2" : "=v"(m) : "v"(d), "v"(ones));
      if (i & 1) acc1 += m; else acc0 += m;
    }
    const unsigned a = acc0 + acc1;
    const int cnt = wave_sum((int)((a & 0xffffu) + (a >> 16)));
    if (cnt >= 256) { prefix = cand; cntp = cnt; }
    if (cnt == 256) break;
  }
  int wlo = 0, whi = 0;
  if (cntp == 256) {
#pragma unroll
    for (int j = 0; j < NS; ++j) {
      const u64 sm = __ballot(key[j] >= prefix);
      if (lane == j) { wlo = (int)(unsigned)sm; whi = (int)(unsigned)(sm >> 32); }
    }
  } else {
    int cgt = 0;
#pragma unroll
    for (int j = 0; j < NS; ++j) cgt += (key[j] > prefix) ? 1 : 0;
    cgt = wave_sum(cgt);
    const int rneed = 256 - cgt;
    int running = 0;
    const u64 lt = (1ull << lane) - 1ull;
#pragma unroll
    for (int j = 0; j < NS; ++j) {
      const bool eq = key[j] == prefix;
      const u64 em = __ballot(eq);
      const int rank = running + __popcll(em & lt);
      const bool sel = (key[j] > prefix) || (eq && rank < rneed);
      const u64 sm = __ballot(sel);
      if (lane == j) { wlo = (int)(unsigned)sm; whi = (int)(unsigned)(sm >> 32); }
      running += __popcll(em);
    }
  }
  if (lane < nj) dst[lane] = ((u64)(unsigned)whi << 32) | (u64)(unsigned)wlo;
}

DI void idx_item(const Params& p, unsigned char* lds, int tid, bool samp, int b, int grp) {
  const int lane = tid & 63, w = tid >> 6;
  const int t0 = grp * 16;
  int L, g0; const u16* ki;
  if (!samp) { const int c = t0 >> 6; L = (c + 1) * 64; g0 = b * 2048 + t0; ki = p.kiP() + (size_t)b * 2048 * 64; }
  else { L = 2112; g0 = NPROMPT + b * 64 + t0; ki = p.kiS() + (size_t)b * 2112 * 64; }
  const int nj = L >> 6;
  if (L <= 256) {
    for (int qq = 0; qq < 4; ++qq) {
      const int q = w * 4 + qq;
      if (lane < nj) p.maskbits()[(size_t)(g0 + q) * 33 + lane] = ~0ull;
    }
    return;
  }
  u16* keys = (u16*)lds;
#ifndef REPMF
#define REPMF 1
#endif
#ifndef REPSEL
#define REPSEL 1
#endif
#ifndef REPKV
#define REPKV 1
#endif
  for (int rmf = 0; rmf < REPMF; ++rmf) {
    const int qn = lane & 15, quad = lane >> 4;
    bf16x8 qf[8][2];
    float wv[8];
#pragma unroll
    for (int h = 0; h < 8; ++h) {
      qf[h][0] = ldg8(p.qi() + (size_t)(g0 + qn) * 512 + h * 64 + quad * 8);
      qf[h][1] = ldg8(p.qi() + (size_t)(g0 + qn) * 512 + h * 64 + 32 + quad * 8);
      wv[h] = p.wi()[(size_t)(g0 + qn) * 8 + h];
    }
    bf16x8 A0[4], A1[4], N0[4], N1[4];
#pragma unroll
    for (int i = 0; i < 4; ++i) {
      const int kt = w + 4 * i;
      A0[i] = ldg8(ki + (size_t)(kt * 16 + qn) * 64 + quad * 8);
      A1[i] = ldg8(ki + (size_t)(kt * 16 + qn) * 64 + 32 + quad * 8);
    }
    for (int base = 0; base < nj; base += 4) {
#pragma unroll
      for (int i = 0; i < 4; ++i) {
        const int t = base + 4 + i;
        if (t < nj) {
          const int kt = w + 4 * t;
          N0[i] = ldg8(ki + (size_t)(kt * 16 + qn) * 64 + quad * 8);
          N1[i] = ldg8(ki + (size_t)(kt * 16 + qn) * 64 + 32 + quad * 8);
        }
      }
#pragma unroll
      for (int i = 0; i < 4; ++i) {
        const int t = base + i;
        if (t < nj) {
          const int kt = w + 4 * t;
          float idx[4] = {0.f, 0.f, 0.f, 0.f};
#pragma unroll
          for (int h = 0; h < 8; ++h) {
            f32x4 acc = {0.f, 0.f, 0.f, 0.f};
            acc = MFMA16(A0[i], qf[h][0], acc);
            acc = MFMA16(A1[i], qf[h][1], acc);
#pragma unroll
            for (int e = 0; e < 4; ++e) idx[e] += fmaxf(acc[e], 0.f) * wv[h];
          }
          s16x4 kv;
#pragma unroll
          for (int e = 0; e < 4; ++e) {
            _Float16 hv = (_Float16)idx[e];
            u16 bits = __builtin_bit_cast(u16, hv);
            kv[e] = (short)((bits & 0x8000) ? (u16)~bits : (u16)(bits | 0x8000));
          }
          *(s16x4*)(keys + qn * KPITCH + kt * 16 + quad * 4) = kv;
        }
      }
#pragma unroll
      for (int i = 0; i < 4; ++i) { A0[i] = N0[i]; A1[i] = N1[i]; }
    }
  }
  __syncthreads();
  for (int qq = 0; qq < 4 * REPSEL; ++qq) {
    const int q = w * 4 + (qq & 3);
    const u16* krow = keys + q * KPITCH;
    u64* dst = p.maskbits() + (size_t)(g0 + q) * 33;
    if (nj <= 8) select_query<8>(krow, nj, lane, dst);
    else if (nj <= 16) select_query<16>(krow, nj, lane, dst);
    else if (nj <= 24) select_query<24>(krow, nj, lane, dst);
    else select_query<33>(krow, nj, lane, dst);
  }
  __syncthreads();
}

DI void scan_item(const Params& p, int item, int tid) {
  if (item < 1024) {
    const int bh = item >> 4, slab = item & 15;
    const int idx = slab * 1024 + tid * 4;
    const int h = bh & 3;
    const float cd = exp2f(64.f * log2gamma(h));
    f32x4 s = {0.f, 0.f, 0.f, 0.f};
    for (int c = 0; c < 32; ++c) {
      const size_t base = (size_t)(bh * 32 + c) * 16384 + idx;
      s16x4 o = pack4(s);
      *(s16x4*)(p.sprevT() + base) = o;
      f32x4 kv = *(const f32x4*)(p.kvT() + base);
      s = s * cd + kv;
    }
    const int e = idx >> 7, d = idx & 127;
    float* o = p.out + OUT_STP + (size_t)bh * 16384;
#pragma unroll
    for (int j = 0; j < 4; ++j) o[(d + j) * 128 + e] = s[j];
  } else {
    const int it = item - 1024;
    const int bh = it >> 4, slab = it & 15;
    const int idx = slab * 1024 + tid * 4;
    const int h = bh & 3;
    const float cd = exp2f(64.f * log2gamma(h));
    const int e = idx >> 7, d = idx & 127;
    const float* s0 = p.state_ret + (size_t)bh * 16384;
    f32x4 s;
#pragma unroll
    for (int j = 0; j < 4; ++j) s[j] = s0[(d + j) * 128 + e];
    const size_t base = (size_t)(2048 + bh) * 16384 + idx;
    s16x4 o = pack4(s);
    *(s16x4*)(p.sprevT() + base) = o;
    f32x4 kv = *(const f32x4*)(p.kvT() + base);
    s = s * cd + kv;
    float* oo = p.out + OUT_STS + (size_t)bh * 16384;
#pragma unroll
    for (int j = 0; j < 4; ++j) oo[(d + j) * 128 + e] = s[j];
  }
}

DI void attn_item(const Params& p, unsigned char* lds, int tid, bool samp, int b, int c, int kvh, int qh) {
  const int lane = tid & 63, w = tid >> 6, r = lane & 31, hh = lane >> 5;
  const int T = samp ? 2112 : 2048;
  const int nkt = samp ? 33 : c + 1;
  const int g0 = (samp ? NPROMPT + b * 64 : b * 2048 + c * 64) + qh * 32;
  const u16* K = samp ? p.kaS() + (size_t)(b * 2 + kvh) * 2112 * 64 : p.kaP() + (size_t)(b * 2 + kvh) * 2048 * 64;
  const u16* VT = samp ? p.vaTS() + (size_t)(b * 2 + kvh) * 64 * 2112 : p.vaTP() + (size_t)(b * 2 + kvh) * 64 * 2048;
  const int head = kvh * 4 + w;
  u16* Ks = (u16*)lds;
  u16* Vs = Ks + 64 * 72;
  u64* mL = (u64*)(lds + 2 * 9216);
  for (int i = tid; i < 32 * 33; i += 256) mL[i] = p.maskbits()[(size_t)g0 * 33 + i];
  bf16x8 qf[4];
#pragma unroll
  for (int ks = 0; ks < 4; ++ks) qf[ks] = ldg8(p.qa() + (size_t)(g0 + r) * 512 + head * 64 + ks * 16 + hh * 8);
  f32x16 O[2];
  O[0] = zero16(); O[1] = zero16();
  float mrun = -1e30f, lrun = 0.f;
  const int lrow = tid >> 3, lch = tid & 7;
  bf16x8 pk0, pk1, pv0, pv1, nk0, nk1, nv0, nv1;
  pk0 = ldg8(K + (size_t)(lrow)*64 + lch * 8);
  pk1 = ldg8(K + (size_t)(lrow + 32) * 64 + lch * 8);
  pv0 = ldg8(VT + (size_t)(lrow)*T + lch * 8);
  pv1 = ldg8(VT + (size_t)(lrow + 32) * T + lch * 8);
  nk0 = pk0; nk1 = pk1; nv0 = pv0; nv1 = pv1;
  if (nkt > 1) {
    nk0 = ldg8(K + (size_t)(64 + lrow) * 64 + lch * 8);
    nk1 = ldg8(K + (size_t)(64 + lrow + 32) * 64 + lch * 8);
    nv0 = ldg8(VT + (size_t)(lrow)*T + 64 + lch * 8);
    nv1 = ldg8(VT + (size_t)(lrow + 32) * T + 64 + lch * 8);
  }
  for (int kt = 0; kt < nkt; ++kt) {
    __syncthreads();
    *(bf16x8*)(Ks + lrow * 72 + lch * 8) = pk0;
    *(bf16x8*)(Ks + (lrow + 32) * 72 + lch * 8) = pk1;
    *(bf16x8*)(Vs + lrow * 72 + lch * 8) = pv0;
    *(bf16x8*)(Vs + (lrow + 32) * 72 + lch * 8) = pv1;
    __syncthreads();
    pk0 = nk0; pk1 = nk1; pv0 = nv0; pv1 = nv1;
    if (kt + 2 < nkt) {
      nk0 = ldg8(K + (size_t)((kt + 2) * 64 + lrow) * 64 + lch * 8);
      nk1 = ldg8(K + (size_t)((kt + 2) * 64 + lrow + 32) * 64 + lch * 8);
      nv0 = ldg8(VT + (size_t)(lrow)*T + (kt + 2) * 64 + lch * 8);
      nv1 = ldg8(VT + (size_t)(lrow + 32) * T + (kt + 2) * 64 + lch * 8);
    }
    f32x16 S[2];
#pragma unroll
    for (int st = 0; st < 2; ++st) {
      S[st] = zero16();
#pragma unroll
      for (int ks = 0; ks < 4; ++ks) {
        bf16x8 kf = *(const bf16x8*)(Ks + (st * 32 + r) * 72 + ks * 16 + hh * 8);
        S[st] = MFMA32(kf, qf[ks], S[st]);
      }
    }
    const u64 W = mL[r * 33 + kt];
    const int wl = (int)(((unsigned)W) >> (4 * hh)), wh = (int)(((unsigned)(W >> 32)) >> (4 * hh));
    float mx = fmaxf(S[0][0], S[1][0]);
#pragma unroll
    for (int i = 1; i < 16; ++i) mx = fmaxf(mx, fmaxf(S[0][i], S[1][i]));
    mx = fmaxf(mx, __shfl_xor(mx, 32));
    const float mn = fmaxf(mrun, mx);
    const float alpha = __builtin_amdgcn_exp2f(mrun - mn);
    const bool resc = __any(mn != mrun);
    mrun = mn;
    float ls = 0.f;
#pragma unroll
    for (int st = 0; st < 2; ++st)
#pragma unroll
      for (int i = 0; i < 16; ++i) {
        const int keep = __builtin_amdgcn_sbfe(st ? wh : wl, (i & 3) + 8 * (i >> 2), 1);
        const float pvv = __int_as_float(__float_as_int(__builtin_amdgcn_exp2f(S[st][i] - mn)) & keep);
        S[st][i] = pvv;
        ls += pvv;
      }
    lrun = lrun * alpha + ls;
    if (resc) {
#pragma unroll
      for (int dt = 0; dt < 2; ++dt)
#pragma unroll
        for (int i = 0; i < 16; ++i) O[dt][i] *= alpha;
    }
#pragma unroll
    for (int st = 0; st < 2; ++st)
#pragma unroll
      for (int s2 = 0; s2 < 2; ++s2) {
        bf16x8 pf = pack8(S[st][8 * s2 + 0], S[st][8 * s2 + 1], S[st][8 * s2 + 2], S[st][8 * s2 + 3],
                          S[st][8 * s2 + 4], S[st][8 * s2 + 5], S[st][8 * s2 + 6], S[st][8 * s2 + 7]);
#pragma unroll
        for (int dt = 0; dt < 2; ++dt) {
          s16x4 lo = *(const s16x4*)(Vs + (dt * 32 + r) * 72 + st * 32 + 16 * s2 + 4 * hh);
          s16x4 hi = *(const s16x4*)(Vs + (dt * 32 + r) * 72 + st * 32 + 16 * s2 + 8 + 4 * hh);
          bf16x8 vf = __builtin_shufflevector(lo, hi, 0, 1, 2, 3, 4, 5, 6, 7);
          O[dt] = MFMA32(vf, pf, O[dt]);
        }
      }
  }
  {
    float lt = lrun + __shfl_xor(lrun, 32);
    const float inv = 1.f / lt;
    const u16* grow = p.gate() + (size_t)(g0 + r) * 1024 + 512 + head * 64;
    u16* mrow = p.mix() + (size_t)(g0 + r) * 1024 + 512 + head * 64;
#pragma unroll
    for (int dt = 0; dt < 2; ++dt)
#pragma unroll
      for (int q4 = 0; q4 < 4; ++q4) {
        const int d = dt * 32 + 8 * q4 + 4 * hh;
        s16x4 gv = *(const s16x4*)(grow + d);
        f32x4 of;
#pragma unroll
        for (int j = 0; j < 4; ++j) {
          const float gf = __uint_as_float(((unsigned)(u16)gv[j]) << 16);
          of[j] = O[dt][q4 * 4 + j] * inv * gf;
        }
        *(s16x4*)(mrow + d) = pack4(of);
      }
  }
  __syncthreads();
}

DI void ret_out_item(const Params& p, unsigned char* lds, int item, int tid) {
  const int lane = tid & 63, w = tid >> 6, r = lane & 31, hh = lane >> 5;
  int bh, c, T, g0; const u16* vT;
  if (item < 2048) { bh = item >> 5; c = item & 31; T = 2048; g0 = (bh >> 2) * 2048 + c * 64; vT = p.vrT() + (size_t)bh * 128 * 2048; }
  else { bh = item - 2048; c = 0; T = 64; g0 = NPROMPT + (bh >> 2) * 64; vT = p.vrT() + (size_t)64 * 128 * 2048 + (size_t)bh * 128 * 64; }
  const int h = bh & 3;
  const float l2g = log2gamma(h);
  const int nt = w & 1, eh = w >> 1;
  const int n = nt * 32 + r;
  bf16x8 qf[8];
#pragma unroll
  for (int ks = 0; ks < 8; ++ks) qf[ks] = ldg8(p.qr() + (size_t)(g0 + n) * 512 + h * 128 + ks * 16 + hh * 8);
  bf16x8 pf[2][2];
#pragma unroll
  for (int mt = 0; mt < 2; ++mt) {
    f32x16 S = zero16();
#pragma unroll
    for (int ks = 0; ks < 8; ++ks) {
      bf16x8 kf = ldg8(p.kr() + (size_t)(g0 + mt * 32 + r) * 512 + h * 128 + ks * 16 + hh * 8);
      S = MFMA32(kf, qf[ks], S);
    }
#pragma unroll
    for (int i = 0; i < 16; ++i) {
      const int m = mt * 32 + crow(i, hh);
      const int dd = n > m ? n - m : m - n;
      S[i] *= exp2f((float)dd * l2g);
    }
    pf[mt][0] = pack8(S[0], S[1], S[2], S[3], S[4], S[5], S[6], S[7]);
    pf[mt][1] = pack8(S[8], S[9], S[10], S[11], S[12], S[13], S[14], S[15]);
  }
  const float fs = exp2f((float)(n + 1) * l2g);
  const u16* sp = p.sprevT() + (size_t)item * 16384;
  f32x16 tot[2];
  float ss = 0.f;
#pragma unroll
  for (int et = 0; et < 2; ++et) {
    const int e = (2 * eh + et) * 32 + r;
    f32x16 Oi = zero16(), X = zero16();
#pragma unroll
    for (int mt = 0; mt < 2; ++mt)
#pragma unroll
      for (int s2 = 0; s2 < 2; ++s2) {
        const u16* vp = vT + (size_t)e * T + c * 64 + mt * 32 + 16 * s2 + 4 * hh;
        s16x4 lo = ldg4(vp), hi = ldg4(vp + 8);
        bf16x8 vf = __builtin_shufflevector(lo, hi, 0, 1, 2, 3, 4, 5, 6, 7);
        Oi = MFMA32(vf, pf[mt][s2], Oi);
      }
#pragma unroll
    for (int ks = 0; ks < 8; ++ks) {
      bf16x8 sf = ldg8(sp + (size_t)e * 128 + ks * 16 + hh * 8);
      X = MFMA32(sf, qf[ks], X);
    }
#pragma unroll
    for (int i = 0; i < 16; ++i) { const float t = Oi[i] + X[i] * fs; tot[et][i] = t; ss += t * t; }
  }
  ss += __shfl_xor(ss, 32);
  float* red = (float*)lds;
  __syncthreads();
  if (hh == 0) red[w * 32 + r] = ss;
  __syncthreads();
  const float tsum = red[w * 32 + r] + red[(w ^ 2) * 32 + r];
  const float rinv = rsqrtf(tsum * (1.f / 128.f) + 1e-6f);
  const u16* grow = p.gate() + (size_t)(g0 + n) * 1024 + h * 128;
  u16* mrow = p.mix() + (size_t)(g0 + n) * 1024 + h * 128;
#pragma unroll
  for (int et = 0; et < 2; ++et)
#pragma unroll
    for (int q4 = 0; q4 < 4; ++q4) {
      const int e = (2 * eh + et) * 32 + 8 * q4 + 4 * hh;
      s16x4 gv = *(const s16x4*)(grow + e);
      f32x4 gg = *(const f32x4*)(p.ret_gn_g + h * 128 + e);
      f32x4 of;
#pragma unroll
      for (int j = 0; j < 4; ++j) {
        const float gf = __uint_as_float(((unsigned)(u16)gv[j]) << 16);
        of[j] = tot[et][q4 * 4 + j] * rinv * gg[j] * gf;
      }
      *(s16x4*)(mrow + e) = pack4(of);
    }
}

DI void phase_final(const Params& p, int tid) {
  const int gt = blockIdx.x * 512 + tid, GT = gridDim.x * 512;
  const int lane = tid & 63;
  for (int row0 = (gt >> 6) * 2; row0 < NTOK; row0 += (GT >> 6) * 2) {
    f32x4 v[2][4];
    s16x4 zz[2][4];
#pragma unroll
    for (int rr = 0; rr < 2; ++rr) {
      const float* xr = xrow(p, row0 + rr);
      const u16* zr = p.gate() + (size_t)(row0 + rr) * 1024;
#pragma unroll
      for (int i = 0; i < 4; ++i) { v[rr][i] = *(const f32x4*)(xr + i * 256 + lane * 4); zz[rr][i] = *(const s16x4*)(zr + i * 256 + lane * 4); }
    }
    f32x4 g[4];
#pragma unroll
    for (int i = 0; i < 4; ++i) g[i] = *(const f32x4*)(p.final_g + i * 256 + lane * 4);
#pragma unroll
    for (int rr = 0; rr < 2; ++rr) {
      float ss = 0.f;
#pragma unroll
      for (int i = 0; i < 4; ++i) {
#pragma unroll
        for (int j = 0; j < 4; ++j) v[rr][i][j] += __uint_as_float(((unsigned)(u16)zz[rr][i][j]) << 16);
        ss += v[rr][i][0] * v[rr][i][0] + v[rr][i][1] * v[rr][i][1] + v[rr][i][2] * v[rr][i][2] + v[rr][i][3] * v[rr][i][3];
      }
#pragma unroll
      for (int o = 32; o >= 1; o >>= 1) ss += __shfl_xor(ss, o);
      const float rv = rsqrtf(ss * (1.f / 1024.f) + 1e-6f);
      float* y = p.out + OUT_Y + (size_t)(row0 + rr) * 1024;
#pragma unroll
      for (int i = 0; i < 4; ++i) *(f32x4*)(y + i * 256 + lane * 4) = v[rr][i] * rv * g[i];
    }
  }
}

#ifndef REP0
#define REP0 1
#endif
#ifndef REP1
#define REP1 1
#endif
#ifndef REP2
#define REP2 1
#endif
#ifndef REP3
#define REP3 1
#endif
#ifndef REP4
#define REP4 1
#endif
#ifndef REP5
#define REP5 1
#endif
__global__ void __launch_bounds__(512, 2) fwd_megakernel(Params p) {
  __shared__ __attribute__((aligned(16))) unsigned char lds[LDS_BYTES];
  cg::grid_group grid = cg::this_grid();
#define FRESH_TID() int tid = threadIdx.x; asm volatile("" : "+v"(tid)); const int half = tid >> 8, htid = tid & 255; unsigned char* ldsh = lds + half * HALF_LDS; (void)htid; (void)ldsh;
  if (p.out == nullptr) grid.sync();
  if (threadIdx.x == 0) (void)xb_add(&p.bar()[XB_XCNT(xb_xcc_id())], 1u);
  for (int rep = 0; rep < REP0; ++rep) {
  { FRESH_TID(); phase_prep(p, tid); }
  xcd_barrier(p.bar());
  }
  for (int rep = 0; rep < REP1; ++rep) {
  {
    FRESH_TID();
    pg8::Gemm g; g.A = p.xb(); g.Bt = p.WtIn(); g.M = NTOK; g.N = 4096; g.K = 1024;
    pg8::StaticOrder S; S.init(g.M, g.N, (int)gridDim.x, (int)blockIdx.x); S.permtab = 0xEFBCD87694105A32ull;
    Epi1 E; E.p = p; E.tl = (u16*)(lds + pg8::STAGE_BYTES + (tid >> 6) * 4096);
    pg8::gemm_phase<Epi1>((LAS unsigned char*)lds, g, S, E);
  }
  xcd_barrier(p.bar());
  }
  for (int rep = 0; rep < REP2; ++rep) {
  {
    FRESH_TID();
    for (int it0 = blockIdx.x * 2; it0 < 2080 + 2080; it0 += gridDim.x * 2) {
      const int it = it0 + half;
      int ht = htid; asm volatile("" : "+v"(ht));
      if (it < 2080) {
        const bool samp = it < 32;
        const int j = it - 32;
        const int c = 31 - (j >> 6);
        const int b = samp ? (it >> 2) : ((j & 63) >> 2);
        const int grp = samp ? (it & 3) : (c * 4 + (j & 3));
        idx_item(p, ldsh, ht, samp, b, grp);
      } else { for (int rkv = 0; rkv < REPKV; ++rkv) ret_kv_item(p, it - 2080, ht); }
    }
  }
  xcd_barrier(p.bar());
  }
  for (int rep = 0; rep < REP3; ++rep) {
  {
    FRESH_TID();
    for (int it0 = blockIdx.x * 2; it0 < 1056 + 1536; it0 += gridDim.x * 2) {
      const int it = it0 + half;
      int ht = htid; asm volatile("" : "+v"(ht));
      if (it < 1056) {
        const bool samp = it < 32;
        const int j = it - 32;
        int c = samp ? 0 : 31 - (j >> 6);
        int b = samp ? (it >> 2) : ((j & 63) >> 2);
        int kvh = (it >> 1) & 1;
        if (!samp && gridDim.x == 256) {
          const int jb = (j >> 1) & 255, rnd = j >> 9;
          const int xcd = jb & 7, ii = jb >> 3;
          b = 2 * xcd + (ii & 1); kvh = (ii >> 1) & 1; c = 31 - rnd * 8 - (ii >> 2);
        }
        attn_item(p, ldsh, ht, samp, b, c, kvh, it & 1);
      } else scan_item(p, it - 1056, ht);
    }
  }
  xcd_barrier(p.bar());
  }
  for (int rep = 0; rep < REP4; ++rep) {
  {
    FRESH_TID();
    for (int it0 = blockIdx.x * 2; it0 < 2080 + 1024; it0 += gridDim.x * 2) {
      const int it = it0 + half;
      int ht = htid; asm volatile("" : "+v"(ht));
      if (it < 2080) ret_out_item(p, ldsh, it, ht);
      else {
        const int ia = it - 2080 + 1056;
        const int j = ia - 32;
        int c = 31 - (j >> 6);
        int b = (j & 63) >> 2;
        int kvh = (ia >> 1) & 1;
        if (gridDim.x == 256) {
          const int jb = (j >> 1) & 255, rnd = j >> 9;
          const int xcd = jb & 7, ii = jb >> 3;
          b = 2 * xcd + (ii & 1); kvh = (ii >> 1) & 1; c = 31 - rnd * 8 - (ii >> 2);
        }
        attn_item(p, ldsh, ht, false, b, c, kvh, ia & 1);
      }
    }
  }
  xcd_barrier(p.bar());
  }
  for (int rep = 0; rep < REP5; ++rep) {
  {
    pg8::Gemm g; g.A = p.mix(); g.Bt = p.WtOut(); g.M = NTOK; g.N = 1024; g.K = 1024;
    pg8::StaticOrder S; S.init(g.M, g.N, (int)gridDim.x, (int)blockIdx.x);
    int tid2 = threadIdx.x; asm volatile("" : "+v"(tid2));
    Epi2 E; E.p = p; E.hl = lds + pg8::STAGE_BYTES + (tid2 >> 8) * 16384;
    pg8::gemm_phase<Epi2>((LAS unsigned char*)lds, g, S, E);
  }
  xcd_barrier(p.bar());
  }
  { FRESH_TID(); phase_final(p, tid); }
}

extern "C" void kernel_launch(void* const* d_in, const int* in_sizes, int n_in, void* d_out, int out_size, void* d_ws,
                              size_t ws_size, hipStream_t stream) {
  static int grid_blocks = 0;
  if (!grid_blocks) {
    int dev = 0, cus = 0, per_cu = 0;
    (void)hipGetDevice(&dev);
    (void)hipDeviceGetAttribute(&cus, hipDeviceAttributeMultiprocessorCount, dev);
    (void)hipOccupancyMaxActiveBlocksPerMultiprocessor(&per_cu, fwd_megakernel, 512, 0);
    if (per_cu < 1) per_cu = 1;
    if (per_cu > 1) per_cu = 1;
    grid_blocks = cus * per_cu;
  }
  Params p{};
  p.x_p = (const float*)d_in[0]; p.x_s = (const float*)d_in[1]; p.state_ret = (const float*)d_in[2];
  p.cache_k = (const float*)d_in[3]; p.cache_v = (const float*)d_in[4]; p.cache_kidx = (const float*)d_in[5];
  p.norm_g = (const float*)d_in[6]; p.w_in = (const float*)d_in[7]; p.ret_gn_g = (const float*)d_in[8];
  p.w_out = (const float*)d_in[9]; p.final_g = (const float*)d_in[10];
  p.out = (float*)d_out;
  p.ws = (unsigned char*)d_ws;
  (void)hipMemsetAsync((unsigned char*)d_ws + 530573312ull, 0, (size_t)XCD_BAR_WORDS * 4, stream);
  void* args[] = {&p};
  hipError_t e = hipLaunchCooperativeKernel((void*)fwd_megakernel, dim3(grid_blocks), dim3(512), args, 0, stream);
  if (e != hipSuccess) fprintf(stderr, "cooperative launch failed: %s (grid %d)\n", hipGetErrorString(e), grid_blocks);
}
```

```cpp
#include <hip/hip_runtime.h>
#include <hip/hip_cooperative_groups.h>
#include <stdint.h>
#include <cstdio>
namespace cg = cooperative_groups;

typedef __attribute__((ext_vector_type(8))) short bf16x8;
typedef __attribute__((ext_vector_type(4))) short s16x4;
typedef __attribute__((ext_vector_type(16))) float f32x16;
typedef __attribute__((ext_vector_type(4))) float f32x4;
typedef unsigned short u16;
typedef unsigned long long u64;


#define DI __device__ __forceinline__
#define MFMA32(a, b, c) __builtin_amdgcn_mfma_f32_32x32x16_bf16((a), (b), (c), 0, 0, 0)
#define MFMA16(a, b, c) __builtin_amdgcn_mfma_f32_16x16x32_bf16((a), (b), (c), 0, 0, 0)

#define NTOK 33280
#define NPROMPT 32768
#define LDS_BYTES 163840
#define HALF_LDS 81920
#define LAS __attribute__((address_space(3)))
#define KPITCH 2116

struct Params {
  const float *x_p, *x_s, *state_ret, *cache_k, *cache_v, *cache_kidx, *norm_g, *w_in, *ret_gn_g, *w_out, *final_g;
  float* out;
  unsigned char* ws;
  DI u16* xb() const { return (u16*)(ws + 0ull); }
  DI float* kvT() const { return (float*)(ws + 0ull); }
  DI u16* WtIn() const { return (u16*)(ws + 136314880ull); }
  DI u16* WtOut() const { return (u16*)(ws + 144703488ull); }
  DI u16* qr() const { return (u16*)(ws + 146800640ull); }
  DI u16* kr() const { return (u16*)(ws + 180879360ull); }
  DI u16* sprevT() const { return (u16*)(ws + 214958080ull); }
  DI u16* qi() const { return (u16*)(ws + 214958080ull); }
  DI u16* krT() const { return (u16*)(ws + 249036800ull); }
  DI u16* vrT() const { return (u16*)(ws + 283115520ull); }
  DI u16* gate() const { return (u16*)(ws + 317194240ull); }
  DI u16* mix() const { return (u16*)(ws + 385351680ull); }
  DI u16* qa() const { return (u16*)(ws + 453509120ull); }
  DI u16* kaP() const { return (u16*)(ws + 487587840ull); }
  DI u16* kaS() const { return (u16*)(ws + 495976448ull); }
  DI u16* vaTP() const { return (u16*)(ws + 500301824ull); }
  DI u16* vaTS() const { return (u16*)(ws + 508690432ull); }
  DI u16* kiP() const { return (u16*)(ws + 513015808ull); }
  DI u16* kiS() const { return (u16*)(ws + 517210112ull); }
  DI float* rinv() const { return (float*)(ws + 519372800ull); }
  DI float* wi() const { return (float*)(ws + 519505920ull); }
  DI float* cosR() const { return (float*)(ws + 520570880ull); }
  DI float* sinR() const { return (float*)(ws + 521111552ull); }
  DI float* cosA() const { return (float*)(ws + 521652224ull); }
  DI float* sinA() const { return (float*)(ws + 521719808ull); }
  DI unsigned* bar() const { return (unsigned*)(ws + 530573312ull); }
  DI u64* maskbits() const { return (u64*)(ws + 521787392ull); }
};

#define OUT_Y 0
#define OUT_STP (34078720)
#define OUT_KP (OUT_STP + 1048576)
#define OUT_VP (OUT_KP + 4194304)
#define OUT_KIP (OUT_VP + 4194304)
#define OUT_STS (OUT_KIP + 2097152)
#define OUT_KS (OUT_STS + 524288)
#define OUT_VS (OUT_KS + 65536)
#define OUT_KIS (OUT_VS + 65536)

typedef __bf16 bf16x2_t __attribute__((ext_vector_type(2)));
typedef float f32x2_t __attribute__((ext_vector_type(2)));
typedef unsigned u32x4_t __attribute__((ext_vector_type(4)));
typedef unsigned u32x2_t __attribute__((ext_vector_type(2)));
DI unsigned pk2(float a, float b) { f32x2_t v = {a, b}; bf16x2_t r = __builtin_convertvector(v, bf16x2_t); return __builtin_bit_cast(unsigned, r); }
DI u16 f2bf(float x) { return (u16)(pk2(x, x) & 0xffffu); }
DI bf16x8 ldg8(const u16* p) { return *(const bf16x8*)p; }
DI s16x4 ldg4(const u16* p) { return *(const s16x4*)p; }
DI float siluf(float x) { return x * __builtin_amdgcn_rcpf(1.f + __builtin_amdgcn_exp2f(-1.4426950408889634f * x)); }
DI int lane_id() { return (int)__builtin_amdgcn_mbcnt_hi(~0u, __builtin_amdgcn_mbcnt_lo(~0u, 0u)); }
DI int crow(int reg, int hh) { return (reg & 3) + 8 * (reg >> 2) + 4 * hh; }
DI const float* xrow(const Params& p, int g) { return g < NPROMPT ? p.x_p + (size_t)g * 1024 : p.x_s + (size_t)(g - NPROMPT) * 1024; }
DI float log2gamma(int h) { return log1pf(-exp2f(-5.f - (float)h)) * 1.4426950408889634f; }
DI bf16x8 pack8(float a0, float a1, float a2, float a3, float a4, float a5, float a6, float a7) {
  u32x4_t v = {pk2(a0, a1), pk2(a2, a3), pk2(a4, a5), pk2(a6, a7)};
  return __builtin_bit_cast(bf16x8, v);
}
DI s16x4 pack4(f32x4 v) { u32x2_t o = {pk2(v[0], v[1]), pk2(v[2], v[3])}; return __builtin_bit_cast(s16x4, o); }
DI int wave_sum(int v) {
  v += __builtin_amdgcn_update_dpp(0, v, 0xB1, 0xf, 0xf, false);
  v += __builtin_amdgcn_update_dpp(0, v, 0x4E, 0xf, 0xf, false);
  v += __builtin_amdgcn_update_dpp(0, v, 0x124, 0xf, 0xf, false);
  v += __builtin_amdgcn_update_dpp(0, v, 0x128, 0xf, 0xf, false);
  return __builtin_amdgcn_readlane(v, 0) + __builtin_amdgcn_readlane(v, 16) + __builtin_amdgcn_readlane(v, 32) + __builtin_amdgcn_readlane(v, 48);
}
DI f32x16 zero16() { f32x16 z; for (int i = 0; i < 16; ++i) z[i] = 0.f; return z; }

#define XB_TMO      128
#define XB_XCNT(j)  (256  + 64 * (j))
#define XB_XSUB(j)  (1280 + 64 * (j))
#define XB_XGEN(j)  (2304 + 64 * (j))
#define XB_TOP      3328
#define XB_TOPGEN   3392
#define XB_WG(i)    (3456 + 64 * (i))
#define XCD_BAR_WORDS (3456 + 64 * 256)
#define XB_SPIN_CAP (1u << 18)
DI unsigned xb_ld(unsigned* p) { return __hip_atomic_load(p, __ATOMIC_RELAXED, __HIP_MEMORY_SCOPE_AGENT); }
DI unsigned xb_add(unsigned* p, unsigned v) { return __hip_atomic_fetch_add(p, v, __ATOMIC_RELAXED, __HIP_MEMORY_SCOPE_AGENT); }
DI unsigned xb_xcc_id() { return (unsigned)__builtin_amdgcn_s_getreg((3 << 11) | 20) & 0xFu; }
#define XB_SPIN(cond, bar) do { unsigned _sp = 0; while (cond) { __builtin_amdgcn_s_sleep(1); \
    if ((++_sp & 255u) == 0u) { if (xb_ld(&(bar)[XB_TMO])) break; if (_sp > XB_SPIN_CAP) { atomicAdd(&(bar)[XB_TMO], 1u); break; } } } } while (0)
DI void xcd_barrier_complete(unsigned* bar, unsigned x, unsigned& nloc, unsigned& nx) {
  const unsigned G = gridDim.x * gridDim.y * gridDim.z;
  unsigned sum, cnt, mine, sp = 0u;
  for (;;) {
    sum = 0u; cnt = 0u; mine = 0u;
#pragma unroll
    for (unsigned j = 0; j < 16; ++j) { const unsigned c = xb_ld(&bar[XB_XCNT(j)]); sum += c; cnt += (c > 0u) ? 1u : 0u; mine = (j == x) ? c : mine; }
    if (sum == G) break;
    __builtin_amdgcn_s_sleep(1);
    if ((++sp & 255u) == 0u) { if (xb_ld(&bar[XB_TMO])) break; if (sp > XB_SPIN_CAP) { atomicAdd(&bar[XB_TMO], 1u); break; } }
  }
  nloc = mine > 0u ? mine : 1u; nx = cnt > 0u ? cnt : 1u;
}
DI void xcd_barrier(unsigned* bar, int wave_id) {
  asm volatile("s_waitcnt vmcnt(0)" ::: "memory");
  __syncthreads();
  if (wave_id == 0 && lane_id() == 0) {
    __builtin_amdgcn_s_waitcnt(0);
    const unsigned x = xb_xcc_id();
    unsigned* slot = &bar[XB_WG(blockIdx.x)];
    unsigned nloc = xb_ld(slot), nx = xb_ld(slot + 1);
    if (nloc == 0u) { xcd_barrier_complete(bar, x, nloc, nx); __hip_atomic_store(slot, nloc, __ATOMIC_RELAXED, __HIP_MEMORY_SCOPE_AGENT); __hip_atomic_store(slot + 1, nx, __ATOMIC_RELAXED, __HIP_MEMORY_SCOPE_AGENT); }
    const unsigned old = xb_add(&bar[XB_XSUB(x)], 1u);
    const unsigned gen = old / nloc;
    if (old + 1u == (gen + 1u) * nloc) {
      __builtin_amdgcn_fence(__ATOMIC_RELEASE, "agent");
      asm volatile("s_waitcnt vmcnt(0)" ::: "memory");
      const unsigned og = xb_add(&bar[XB_TOP], 1u);
      const unsigned tg = og / nx;
      if (og + 1u == (tg + 1u) * nx) xb_add(&bar[XB_TOPGEN], 1u);
      else XB_SPIN(xb_ld(&bar[XB_TOPGEN]) == tg, bar);
      __builtin_amdgcn_fence(__ATOMIC_ACQUIRE, "agent");
      xb_add(&bar[XB_XGEN(x)], 1u);
      asm volatile("s_waitcnt vmcnt(0)" ::: "memory");
    } else {
      XB_SPIN(xb_ld(&bar[XB_XGEN(x)]) == gen, bar);
      __builtin_amdgcn_fence(__ATOMIC_ACQUIRE, "agent");
      asm volatile("s_waitcnt vmcnt(0)" ::: "memory");
    }
  }
  __syncthreads();
}

DI void phase_prep(const Params& p, int tid) {
  const int gt = blockIdx.x * 512 + tid, GT = gridDim.x * 512;
  const int lane = tid & 63;
  for (int row0 = (gt >> 6) * 2; row0 < NTOK; row0 += (GT >> 6) * 2) {
    f32x4 v[2][4];
#pragma unroll
    for (int rr = 0; rr < 2; ++rr) {
      const float* sp = xrow(p, row0 + rr);
#pragma unroll
      for (int i = 0; i < 4; ++i) v[rr][i] = *(const f32x4*)(sp + i * 256 + lane * 4);
    }
#pragma unroll
    for (int rr = 0; rr < 2; ++rr) {
      float ss = 0.f;
#pragma unroll
      for (int i = 0; i < 4; ++i) ss += v[rr][i][0] * v[rr][i][0] + v[rr][i][1] * v[rr][i][1] + v[rr][i][2] * v[rr][i][2] + v[rr][i][3] * v[rr][i][3];
#pragma unroll
      for (int o = 32; o >= 1; o >>= 1) ss += __shfl_xor(ss, o);
#pragma unroll
      for (int i = 0; i < 4; ++i) *(s16x4*)(p.xb() + (size_t)(row0 + rr) * 1024 + i * 256 + lane * 4) = pack4(v[rr][i]);
      if (lane == 0) p.rinv()[row0 + rr] = rsqrtf(ss * (1.f / 1024.f) + 1e-6f);
    }
  }
  for (int i = gt; i < 4096 * 128; i += GT) {
    int n = i & 4095, kg = i >> 12;
    int sc = n;
    if (n < 1024) { const int P = n & 127; sc = (n & ~127) + 64 * ((P >> 4) & 1) + 16 * (P >> 5) + (P & 15); }
    float a[8];
#pragma unroll
    for (int j = 0; j < 8; ++j) a[j] = (n < 3912) ? p.w_in[(size_t)(kg * 8 + j) * 3912 + sc] * p.norm_g[kg * 8 + j] : 0.f;
    *(bf16x8*)(p.WtIn() + (size_t)n * 1024 + kg * 8) = pack8(a[0], a[1], a[2], a[3], a[4], a[5], a[6], a[7]);
  }
  for (int i = gt; i < 1024 * 128; i += GT) {
    int n = i % 1024, kg = i / 1024;
    float a[8];
#pragma unroll
    for (int j = 0; j < 8; ++j) a[j] = p.w_out[(size_t)(kg * 8 + j) * 1024 + n];
    *(bf16x8*)(p.WtOut() + (size_t)n * 1024 + kg * 8) = pack8(a[0], a[1], a[2], a[3], a[4], a[5], a[6], a[7]);
  }
  for (int i = gt; i < 2112 * 64; i += GT) {
    int pos = i >> 6, k = i & 63;
    float inv = powf(10000.f, -(float)k / 64.f);
    float ang = (float)pos * inv;
    p.cosR()[i] = cosf(ang); p.sinR()[i] = sinf(ang);
  }
  for (int i = gt; i < 2112 * 8; i += GT) {
    int pos = i >> 3, k = i & 7;
    float inv = powf(500000.f, -(float)k / 8.f);
    float ang = (float)pos * inv;
    p.cosA()[i] = cosf(ang); p.sinA()[i] = sinf(ang);
  }
  for (int i = gt; i < 8 * 2048 * 2 * 8; i += GT) {
    int dg = i & 7, kvh = (i >> 3) & 1, t = (i >> 4) & 2047, b = i >> 15;
    const float* s = p.cache_k + ((size_t)(b * 2048 + t) * 2 + kvh) * 64 + dg * 8;
    *(bf16x8*)(p.kaS() + ((size_t)(b * 2 + kvh) * 2112 + t) * 64 + dg * 8) = pack8(s[0], s[1], s[2], s[3], s[4], s[5], s[6], s[7]);
  }
  for (int i = gt; i < 8 * 2 * 256 * 64; i += GT) {
    int d = i & 63, tg = (i >> 6) & 255, kvh = (i >> 14) & 1, b = i >> 15;
    float a[8];
#pragma unroll
    for (int j = 0; j < 8; ++j) a[j] = p.cache_v[((size_t)(b * 2048 + tg * 8 + j) * 2 + kvh) * 64 + d];
    *(bf16x8*)(p.vaTS() + ((size_t)(b * 2 + kvh) * 64 + d) * 2112 + tg * 8) = pack8(a[0], a[1], a[2], a[3], a[4], a[5], a[6], a[7]);
  }
  for (int i = gt; i < 8 * 2048 * 8; i += GT) {
    int dg = i & 7, t = (i >> 3) & 2047, b = i >> 14;
    const float* s = p.cache_kidx + (size_t)(b * 2048 + t) * 64 + dg * 8;
    *(bf16x8*)(p.kiS() + ((size_t)b * 2112 + t) * 64 + dg * 8) = pack8(s[0], s[1], s[2], s[3], s[4], s[5], s[6], s[7]);
  }
}

namespace pg8 {
constexpr int BM = 256, BK = 64, HALF = 128, HTB = HALF * BK * 2, STAGE_BYTES = 8 * HTB, NXCD = 8, WGM = 8;
DI int lds_byte(int r, int c) { const int st = (r >> 4) * 2 + (c >> 5), rr = r & 15, cc = c & 31, ob = rr * 64 + cc * 2; return st * 1024 + (ob ^ (((ob >> 9) & 1) << 5)); }
DI void stage_rc(int b, int& R, int& C) { const int st = b / 1024, sb = b % 1024, swz = sb ^ (((sb >> 9) & 1) << 5); R = (st >> 1) * 16 + swz / 64; C = (st & 1) * 32 + (swz % 64) / 2; }
struct Unit { int pm, pn; };
struct Gemm { const u16* A; const u16* Bt; int M, N, K; };
struct StaticOrder {
  int nM, nN, nwg, G, c; unsigned long long permtab;
  DI void init(int M, int N, int G_, int c_) { nM = M / BM; nN = N / BM; nwg = nM * nN; G = G_; c = c_; permtab = 0xFEDCBA9876543210ull; }
  DI bool next(int i, Unit& u) const {
    const long L = (long)i * G + c; if (L >= nwg) return false;
    int wgid = (int)L; { const int q = nwg / NXCD, r = nwg % NXCD, xcd = wgid % NXCD, off = wgid / NXCD; wgid = (xcd < r ? xcd * (q + 1) : r * (q + 1) + (xcd - r) * q) + off; }
    const int nig = WGM * nN, gid = wgid / nig, fm = gid * WGM, gsz = (nM - fm) < WGM ? (nM - fm) : WGM;
    u.pm = fm + ((wgid % nig) % gsz); u.pn = (int)((permtab >> (4 * ((wgid % nig) / gsz))) & 15ull); return true;
  }
};
template <class Epi>
DI void gemm_phase(LAS unsigned char* lds, const Gemm g, const StaticOrder& S, const Epi& E, int wave_id) {
  const int wid = wave_id; int lane = lane_id(); asm volatile("" : "+v"(lane)); const int tid = wid * 64 + lane;
  const int wr = wid >> 2, wc = wid & 3, fr = lane & 15, fq = lane >> 4;
  const int K = g.K, nt = K / BK;
  unsigned voffA[2], voffB[2];
#pragma unroll
  for (int i = 0; i < 2; ++i) { int R, C; stage_rc(tid * 16 + i * 8192, R, C); voffA[i] = (unsigned)(R * K + C) * 2u; voffB[i] = voffA[i]; }
  const size_t kstep = (size_t)(BK * 2);
  const size_t hstep = (size_t)HALF * K * 2;
  const size_t tstep = 2 * hstep;
  const unsigned ldsw = (unsigned)wid * 1024u;
  const int aoff = lds_byte(wr * 64 + fr, fq * 8), boff = lds_byte(wc * 32 + fr, fq * 8);
#define PG8_SA(b, h) (((b) * 2 + (h)) * HTB)
#define PG8_SB(b, h) ((4 + (b) * 2 + (h)) * HTB)
#define PG8_STAGE(bufoff, gbase, voff) do { _Pragma("unroll") for (int _i = 0; _i < 2; ++_i) \
    __builtin_amdgcn_global_load_lds((const unsigned*)((const char*)(gbase) + (voff)[_i]), (LAS unsigned*)(lds + (bufoff) + ldsw + _i * 8192), 16, 0, 0); } while (0)
#define PG8_LDA(dst, b, h) do { _Pragma("unroll") for (int m = 0; m < 4; ++m) _Pragma("unroll") for (int k = 0; k < 2; ++k) dst[m][k] = *(const LAS bf16x8*)(lds + PG8_SA(b, h) + aoff + m * 2048 + k * 1024); } while (0)
#define PG8_LDB(dst, b, h) do { _Pragma("unroll") for (int n = 0; n < 2; ++n) _Pragma("unroll") for (int k = 0; k < 2; ++k) dst[n][k] = *(const LAS bf16x8*)(lds + PG8_SB(b, h) + boff + n * 2048 + k * 1024); } while (0)
#define PG8_MMA(ai, bj, At, Bt) do { __builtin_amdgcn_s_setprio(1); _Pragma("unroll") for (int m = 0; m < 4; ++m) _Pragma("unroll") for (int n = 0; n < 2; ++n) _Pragma("unroll") for (int k = 0; k < 2; ++k) \
    acc[ai][bj][m][n] = __builtin_amdgcn_mfma_f32_16x16x32_bf16(Bt[n][k], At[m][k], acc[ai][bj][m][n], 0, 0, 0); __builtin_amdgcn_s_setprio(0); } while (0)
#define PG8_WAIT_V(n) asm volatile("s_waitcnt vmcnt(" #n ")" ::: "memory")
#define PG8_WAIT_L(n) asm volatile("s_waitcnt lgkmcnt(" #n ")" ::: "memory")
#define PG8_BAR __builtin_amdgcn_s_barrier()
#define PG8_SCHED __builtin_amdgcn_sched_barrier(0)
  Unit cur, nxt; int ui = 0;
  if (!S.next(0, cur)) return;
  f32x4 acc[2][2][4][2];
#pragma unroll
  for (int a = 0; a < 2; ++a)
#pragma unroll
    for (int b = 0; b < 2; ++b)
#pragma unroll
      for (int m = 0; m < 4; ++m)
#pragma unroll
        for (int n = 0; n < 2; ++n) acc[a][b][m][n] = (f32x4){0.f, 0.f, 0.f, 0.f};
  bf16x8 At[4][2], B0[2][2], B1[2][2];
  const char* cA = (const char*)g.A + (size_t)cur.pm * tstep; const char* cB = (const char*)g.Bt + (size_t)cur.pn * tstep;
  PG8_STAGE(PG8_SB(0, 0), cB, voffB); PG8_STAGE(PG8_SA(0, 0), cA, voffA); PG8_STAGE(PG8_SB(0, 1), cB + hstep, voffB); PG8_STAGE(PG8_SA(0, 1), cA + hstep, voffA);
  if (wr == 1) PG8_BAR;
  PG8_WAIT_V(4); PG8_BAR;
  PG8_STAGE(PG8_SB(1, 0), cB + kstep, voffB); PG8_STAGE(PG8_SA(1, 0), cA + kstep, voffA); PG8_STAGE(PG8_SB(1, 1), cB + hstep + kstep, voffB);
  PG8_WAIT_V(6); PG8_BAR;
  for (;;) {
    const bool has_next = S.next(ui + 1, nxt);
    const char* nA = has_next ? (const char*)g.A + (size_t)nxt.pm * tstep : cA; const char* nB = has_next ? (const char*)g.Bt + (size_t)nxt.pn * tstep : cB;
#ifndef REPK
#define REPK 1
#endif
    for (int rk = 0; rk < REPK; ++rk) {
    const char* nA2 = (rk == REPK - 1) ? nA : cA; const char* nB2 = (rk == REPK - 1) ? nB : cB;
    for (int t = 0; t < nt; t += 2) {
      const bool last = (t == nt - 2);
      const char* a1 = cA + (size_t)(t + 1) * kstep;
      const char* a2 = last ? nA2 : cA + (size_t)(t + 2) * kstep; const char* b2 = last ? nB2 : cB + (size_t)(t + 2) * kstep;
      const char* a3 = a2 + kstep; const char* b3 = b2 + kstep;
      PG8_LDB(B0, 0, 0); PG8_SCHED; PG8_LDA(At, 0, 0); PG8_STAGE(PG8_SA(1, 1), a1 + hstep, voffA);
      PG8_WAIT_L(8); PG8_BAR; PG8_WAIT_L(0); PG8_MMA(0, 0, At, B0); PG8_BAR; PG8_SCHED;
      PG8_LDB(B1, 0, 1); PG8_STAGE(PG8_SB(0, 0), b2, voffB);
      PG8_BAR; PG8_WAIT_L(0); PG8_MMA(0, 1, At, B1); PG8_BAR;
      PG8_LDA(At, 0, 1); PG8_STAGE(PG8_SA(0, 0), a2, voffA);
      PG8_BAR; PG8_WAIT_L(0); PG8_MMA(1, 0, At, B0); PG8_BAR; PG8_SCHED;
      PG8_STAGE(PG8_SB(0, 1), b2 + hstep, voffB);
      PG8_WAIT_V(6); PG8_BAR; PG8_MMA(1, 1, At, B1); PG8_BAR;
      PG8_LDB(B0, 1, 0); PG8_SCHED; PG8_LDA(At, 1, 0); PG8_STAGE(PG8_SA(0, 1), a2 + hstep, voffA);
      PG8_WAIT_L(8); PG8_BAR; PG8_WAIT_L(0); PG8_MMA(0, 0, At, B0); PG8_BAR; PG8_SCHED;
      PG8_LDB(B1, 1, 1); PG8_STAGE(PG8_SB(1, 0), b3, voffB);
      PG8_BAR; PG8_WAIT_L(0); PG8_MMA(0, 1, At, B1); PG8_BAR;
      PG8_LDA(At, 1, 1); PG8_STAGE(PG8_SA(1, 0), a3, voffA);
      PG8_BAR; PG8_WAIT_L(0); PG8_MMA(1, 0, At, B0); PG8_BAR; PG8_SCHED;
      PG8_STAGE(PG8_SB(1, 1), b3 + hstep, voffB);
      PG8_WAIT_V(6); PG8_BAR; PG8_MMA(1, 1, At, B1); PG8_BAR;
    }
    }
    {
      Unit eu = cur; int ewr = wr, ewc = wc; int el = lane_id();
      asm volatile("" : "+s"(eu.pm), "+s"(eu.pn), "+s"(ewr), "+s"(ewc), "+v"(el));
      int efr = el & 15, efq = el >> 4;
#ifndef REPEPI
#define REPEPI 1
#endif
      for (int re = 0; re < REPEPI; ++re) E(acc, eu, ewr, ewc, efr, efq, re);
    }
    if (!has_next) break;
#pragma unroll
    for (int a = 0; a < 2; ++a)
#pragma unroll
      for (int b = 0; b < 2; ++b)
#pragma unroll
        for (int m = 0; m < 4; ++m)
#pragma unroll
          for (int n = 0; n < 2; ++n) acc[a][b][m][n] = (f32x4){0.f, 0.f, 0.f, 0.f};
    cur = nxt; cA = nA; cB = nB; ++ui;
  }
  PG8_WAIT_V(0);
  if (wr == 0) PG8_BAR;
  PG8_BAR;
#undef PG8_SA
#undef PG8_SB
#undef PG8_STAGE
#undef PG8_LDA
#undef PG8_LDB
#undef PG8_MMA
#undef PG8_WAIT_V
#undef PG8_WAIT_L
#undef PG8_BAR
#undef PG8_SCHED
}
}


DI unsigned hx_w(int row, int c8) { return (unsigned)(row * 256 + ((c8 ^ ((row & 15) << 1)) << 3)); }
DI unsigned hx_r(int row, int c16) { return (unsigned)(row * 256 + ((c16 ^ (row & 15)) << 4)); }
#define EPI_BAR() asm volatile("s_waitcnt lgkmcnt(0)\n\ts_barrier" ::: "memory")


struct Epi1 {
  Params p; LAS unsigned char* hl0;
  DI void load_tabs(f32x4 (&tc)[4], f32x4 (&ts)[4], int tclass, int R0, bool samp, int wc, int fr, int fq) const {
    const float* cb = (tclass == 1) ? p.cosR() : p.cosA();
    const float* sb = (tclass == 1) ? p.sinR() : p.sinA();
    const int pitch = (tclass == 1) ? 64 : 8;
    const int coff = (tclass == 1) ? (16 * wc + 4 * fq) : (4 * (fq & 1));
#pragma unroll
    for (int m = 0; m < 4; ++m) {
      const int rowg = R0 + 16 * m + fr;
      const int pos = samp ? 2048 + ((rowg - NPROMPT) & 63) : (rowg & 2047);
      tc[m] = *(const f32x4*)(cb + pos * pitch + coff);
      ts[m] = *(const f32x4*)(sb + pos * pitch + coff);
    }
  }
  template <int AI, int BJ>
  DI void compute(f32x4 (&acc)[2][2][4][2], const f32x4 (&tc)[4], const f32x4 (&ts)[4], int blk, int wc, int fq) const {
    if (blk < 8) {
#pragma unroll
      for (int m = 0; m < 4; ++m) {
        const f32x4 v0 = acc[AI][BJ][m][0], v1 = acc[AI][BJ][m][1];
        f32x4 o0 = v0 * tc[m] - v1 * ts[m], o1 = v1 * tc[m] + v0 * ts[m];
        if (blk >= 4) { o0 *= 0.08838834764831845f; o1 *= 0.08838834764831845f; }
        acc[AI][BJ][m][0] = o0; acc[AI][BJ][m][1] = o1;
      }
    } else if ((blk >= 12 && blk < 16) || (blk >= 22 && blk < 26)) {
#pragma unroll
      for (int m = 0; m < 4; ++m)
#pragma unroll
        for (int n = 0; n < 2; ++n) {
          f32x4 v = acc[AI][BJ][m][n];
          v[0] = siluf(v[0]); v[1] = siluf(v[1]); v[2] = siluf(v[2]); v[3] = siluf(v[3]);
          acc[AI][BJ][m][n] = v;
        }
    } else if ((blk >= 8 && blk < 12) || blk == 21 || blk == 31) {
    } else {
      const bool ropew = ((wc & 1) == 0) && !(blk == 30 && wc >= 2);
      if (ropew) {
#pragma unroll
        for (int m = 0; m < 4; ++m) {
          const f32x4 v0 = acc[AI][BJ][m][0];
          f32x4 pr;
          pr[0] = __shfl_xor(v0[0], 32); pr[1] = __shfl_xor(v0[1], 32); pr[2] = __shfl_xor(v0[2], 32); pr[3] = __shfl_xor(v0[3], 32);
          acc[AI][BJ][m][0] = (fq < 2) ? v0 * tc[m] - pr * ts[m] : v0 * tc[m] + pr * ts[m];
        }
      }
      if (blk < 20) {
        const float sc = 0.125f * 1.4426950408889634f;
#pragma unroll
        for (int m = 0; m < 4; ++m) { acc[AI][BJ][m][0] *= sc; acc[AI][BJ][m][1] *= sc; }
      }
    }
  }
  template <int AI, int BJ>
  DI void emit(f32x4 (&acc)[2][2][4][2], const pg8::Unit& u, int blk, bool samp, int wr, int wc, int fr, int fq) const {
    if (blk == 31) return;
    LAS unsigned char* hl = hl0 + wr * 16384;
    asm volatile("" : "+v"(fr), "+v"(fq));
    const int lane = fr + 16 * fq;
    const int P0 = 32 * wc + 4 * fq;
    const int R0 = u.pm * 256 + AI * 128 + wr * 64;
    int b, tb;
    if (!samp) { b = R0 >> 11; tb = R0 & 2047; } else { b = (R0 - NPROMPT) >> 6; tb = 0; }
    const bool retk = blk < 8;
    const bool hasT = (blk >= 4 && blk < 12) || blk == 21;
    const bool hasN = !(blk >= 8 && blk < 12) && blk != 21;
    if (blk == 20 || blk == 21) {
      float* ob = samp ? p.out + (blk == 20 ? OUT_KS : OUT_VS) + (unsigned)(R0 - NPROMPT) * 128u : p.out + (blk == 20 ? OUT_KP : OUT_VP) + (unsigned)R0 * 128u;
#pragma unroll
      for (int m = 0; m < 4; ++m) {
        float* o2 = ob + (unsigned)(16 * m + fr) * 128u + P0;
        *(f32x4*)o2 = acc[AI][BJ][m][0]; *(f32x4*)(o2 + 16) = acc[AI][BJ][m][1];
      }
    } else if (blk == 30) {
      float* ob = samp ? p.out + OUT_KIS + (unsigned)(R0 - NPROMPT) * 64u : p.out + OUT_KIP + (unsigned)R0 * 64u;
      float* wb = p.wi() + (unsigned)R0 * 8u;
#pragma unroll
      for (int m = 0; m < 4; ++m) {
        if (wc < 2) {
          float* o2 = ob + (unsigned)(16 * m + fr) * 64u + P0;
          *(f32x4*)o2 = acc[AI][BJ][m][0]; *(f32x4*)(o2 + 16) = acc[AI][BJ][m][1];
        } else if (wc == 2 && fq < 2) {
          *(f32x4*)(wb + (unsigned)(16 * m + fr) * 8u + 4 * fq) = acc[AI][BJ][m][0] * 0.044194173824159216f;
        }
      }
    }
    if (hasN) {
#pragma unroll
      for (int m = 0; m < 4; ++m)
#pragma unroll
        for (int n = 0; n < 2; ++n) {
          const int c8 = retk ? (16 * n + 4 * wc + fq) : (8 * wc + 4 * n + fq);
          *(LAS s16x4*)(hl + hx_w(16 * m + fr, c8)) = pack4(acc[AI][BJ][m][n]);
        }
      u16* nb; unsigned pitch = 512u, hstr = 0u, cm = 15u;
      if (blk < 4) nb = p.qr() + (unsigned)R0 * 512u + (blk & 3) * 128;
      else if (blk < 8) nb = p.kr() + (unsigned)R0 * 512u + (blk & 3) * 128;
      else if (blk < 16) { nb = p.gate() + (unsigned)R0 * 1024u + (blk - 12) * 128; pitch = 1024u; }
      else if (blk < 20) nb = p.qa() + (unsigned)R0 * 512u + (blk - 16) * 128;
      else if (blk == 20) { nb = samp ? p.kaS() + ((unsigned)(b * 2) * 2112u + 2048u) * 64u : p.kaP() + ((unsigned)(b * 2) * 2048u + tb) * 64u; pitch = 64u; hstr = samp ? 2112u * 64u : 2048u * 64u; cm = 7u; }
      else if (blk < 26) { nb = p.gate() + (unsigned)R0 * 1024u + 512 + (blk - 22) * 128; pitch = 1024u; }
      else if (blk < 30) nb = p.qi() + (unsigned)R0 * 512u + (blk - 26) * 128;
      else { nb = samp ? p.kiS() + ((unsigned)b * 2112u + 2048u) * 64u : p.kiP() + ((unsigned)b * 2048u + tb) * 64u; pitch = 64u; cm = 7u; }
      EPI_BAR();
      const unsigned c16 = lane & 15;
      const unsigned loff = (c16 >> 3) * hstr + (c16 & cm) * 8u;
#pragma unroll
      for (int i = 0; i < 4; ++i) {
        const int row = 16 * wc + 4 * i + (lane >> 4);
        const bf16x8 v = *(const LAS bf16x8*)(hl + hx_r(row, c16));
        if (blk != 30 || c16 < 8) *(bf16x8*)(nb + (unsigned)row * pitch + loff) = v;
      }
      EPI_BAR();
    }
    if (hasT) {
      const float l2g = log2gamma(blk & 3);
#pragma unroll
      for (int m = 0; m < 4; ++m) {
        const int tok = 16 * m + fr;
        const float dec = (blk < 8) ? exp2f((float)(63 - tok) * l2g) : 1.f;
#pragma unroll
        for (int n = 0; n < 2; ++n) {
          const int fb = retk ? (64 * n + 16 * wc + 4 * fq) : (32 * wc + 16 * n + 4 * fq);
#pragma unroll
          for (int j = 0; j < 4; ++j) {
            const int f = fb + j;
            *(LAS u16*)(hl + f * 128 + ((((tok >> 3) ^ (f >> 2)) & 7) << 4) + (tok & 7) * 2) = f2bf(acc[AI][BJ][m][n][j] * dec);
          }
        }
      }
      u16* tbp; unsigned fstr;
      if (blk < 12) {
        u16* base = (blk < 8) ? p.krT() : p.vrT();
        const unsigned bh = (unsigned)(b * 4 + (blk & 3)) * 128u;
        tbp = samp ? base + 64u * 128u * 2048u + bh * 64u : base + bh * 2048u + tb;
        fstr = samp ? 64u : 2048u;
      } else {
        tbp = samp ? p.vaTS() + (unsigned)b * 128u * 2112u + 2048u : p.vaTP() + (unsigned)b * 128u * 2048u + tb;
        fstr = samp ? 2112u : 2048u;
      }
      EPI_BAR();
#pragma unroll
      for (int i = 0; i < 4; ++i) {
        const int f = 32 * wc + 8 * i + (lane >> 3), ch = lane & 7;
        const bf16x8 v = *(const LAS bf16x8*)(hl + f * 128 + (((ch ^ (f >> 2)) & 7) << 4));
        *(bf16x8*)(tbp + (unsigned)f * fstr + ch * 8) = v;
      }
      EPI_BAR();
    }
  }
  DI void operator()(f32x4 (&acc)[2][2][4][2], const pg8::Unit& u, int wr, int wc, int fr, int fq, int re) const {
    const bool samp = (u.pm * 256 >= NPROMPT);
    const int tclass = (u.pn < 4) ? 1 : ((u.pn == 8 || u.pn == 9 || u.pn == 10 || u.pn >= 13) ? 2 : 0);
    const int blk0 = u.pn * 2, blk1 = u.pn * 2 + 1;
    float rvv[2][4];
#pragma unroll
    for (int ai = 0; ai < 2; ++ai)
#pragma unroll
      for (int m = 0; m < 4; ++m) rvv[ai][m] = (1.f / REPK) * p.rinv()[u.pm * 256 + ai * 128 + wr * 64 + 16 * m + fr];
    f32x4 tc[4], ts[4];
    load_tabs(tc, ts, tclass, u.pm * 256 + wr * 64, samp, wc, fr, fq);
#pragma unroll
    for (int ai = 0; ai < 2; ++ai)
#pragma unroll
      for (int m = 0; m < 4; ++m)
#pragma unroll
        for (int bj = 0; bj < 2; ++bj)
#pragma unroll
          for (int n = 0; n < 2; ++n) acc[ai][bj][m][n] *= rvv[ai][m];
    compute<0, 0>(acc, tc, ts, blk0, wc, fq);
    compute<0, 1>(acc, tc, ts, blk1, wc, fq);
    load_tabs(tc, ts, tclass, u.pm * 256 + 128 + wr * 64, samp, wc, fr, fq);
    compute<1, 0>(acc, tc, ts, blk0, wc, fq);
    compute<1, 1>(acc, tc, ts, blk1, wc, fq);
    emit<0, 0>(acc, u, blk0, samp, wr, wc, fr, fq);
    emit<0, 1>(acc, u, blk1, samp, wr, wc, fr, fq);
    emit<1, 0>(acc, u, blk0, samp, wr, wc, fr, fq);
    emit<1, 1>(acc, u, blk1, samp, wr, wc, fr, fq);
  }
};

struct Epi2 {
  Params p; unsigned char* hl;
  DI void operator()(f32x4 (&acc)[2][2][4][2], const pg8::Unit& u, int wr, int wc, int fr, int fq, int re) const {
    u16* z = p.gate();
    const int lane = fr + 16 * fq;
#pragma unroll
    for (int ai = 0; ai < 2; ++ai)
#pragma unroll
      for (int bj = 0; bj < 2; ++bj) {
#pragma unroll
        for (int m = 0; m < 4; ++m)
#pragma unroll
          for (int n = 0; n < 2; ++n)
            *(s16x4*)(hl + hx_w(16 * m + fr, 8 * wc + 4 * n + fq)) = pack4(acc[ai][bj][m][n] * (1.f / REPK));
        EPI_BAR();
        const unsigned R0 = u.pm * 256 + ai * 128 + wr * 64;
        const unsigned cb = u.pn * 256 + bj * 128;
#pragma unroll
        for (int i = 0; i < 4; ++i) {
          const int row = 16 * wc + 4 * i + (lane >> 4), c16 = lane & 15;
          const bf16x8 v = *(const bf16x8*)(hl + hx_r(row, c16));
          *(bf16x8*)(z + (R0 + row) * 1024u + cb + c16 * 8) = v;
        }
        EPI_BAR();
      }
  }
};

DI void ret_kv_item(const Params& p, int item, int tid) {
  const int lane = tid & 63, w = tid >> 6, r = lane & 31, hh = lane >> 5;
  const u16 *kT, *vT; int T, c;
  if (item < 2048) { const int bh = item >> 5; c = item & 31; T = 2048; kT = p.krT() + (size_t)bh * 128 * 2048; vT = p.vrT() + (size_t)bh * 128 * 2048; }
  else { const int bh = item - 2048; c = 0; T = 64; kT = p.krT() + (size_t)64 * 128 * 2048 + (size_t)bh * 128 * 64; vT = p.vrT() + (size_t)64 * 128 * 2048 + (size_t)bh * 128 * 64; }
  const int e0 = (w & 1) * 64, d0 = (w >> 1) * 64;
  f32x16 acc[2][2];
  acc[0][0] = zero16(); acc[0][1] = zero16(); acc[1][0] = zero16(); acc[1][1] = zero16();
#pragma unroll
  for (int ks = 0; ks < 4; ++ks) {
    bf16x8 a0 = ldg8(vT + (size_t)(e0 + r) * T + c * 64 + ks * 16 + hh * 8);
    bf16x8 a1 = ldg8(vT + (size_t)(e0 + 32 + r) * T + c * 64 + ks * 16 + hh * 8);
    bf16x8 b0 = ldg8(kT + (size_t)(d0 + r) * T + c * 64 + ks * 16 + hh * 8);
    bf16x8 b1 = ldg8(kT + (size_t)(d0 + 32 + r) * T + c * 64 + ks * 16 + hh * 8);
    acc[0][0] = MFMA32(a0, b0, acc[0][0]);
    acc[0][1] = MFMA32(a0, b1, acc[0][1]);
    acc[1][0] = MFMA32(a1, b0, acc[1][0]);
    acc[1][1] = MFMA32(a1, b1, acc[1][1]);
  }
  float* o = p.kvT() + (size_t)item * 16384;
#pragma unroll
  for (int a = 0; a < 2; ++a)
#pragma unroll
    for (int b = 0; b < 2; ++b)
#pragma unroll
      for (int i = 0; i < 16; ++i)
        o[(e0 + a * 32 + crow(i, hh)) * 128 + d0 + b * 32 + r] = acc[a][b][i];
}

template <int NS>
DI void select_query(const u16* krow, int nj, int lane, u64* dst) {
  unsigned key[NS];
#pragma unroll
  for (int j = 0; j < NS; ++j) { const unsigned k = krow[j * 64 + lane]; key[j] = (j < nj) ? k : 0u; }
  constexpr int NP = (NS + 1) / 2;
  unsigned pk[NP];
#pragma unroll
  for (int i = 0; i < NP; ++i) pk[i] = key[2 * i] | ((2 * i + 1 < NS ? key[2 * i + 1] : 0u) << 16);
  unsigned prefix = 0;
  int cntp = 0;
  const unsigned ones = 0x00010001u;
  for (int bit = 15; bit >= 0; --bit) {
    const unsigned cand = prefix | (1u << bit);
    const unsigned c1 = cand - 1u;
    const unsigned cv = c1 | (c1 << 16);
    unsigned acc0 = 0, acc1 = 0;
#pragma unroll
    for (int i = 0; i < NP; ++i) {
      unsigned d, m;
      asm("v_pk_sub_u16 %0, %1, %2 clamp" : "=v"(d) : "v"(pk[i]), "v"(cv));
      asm("v_pk_min_u16 %0, %1, %2" : "=v"(m) : "v"(d), "v"(ones));
      if (i & 1) acc1 += m; else acc0 += m;
    }
    const unsigned a = acc0 + acc1;
    const int cnt = wave_sum((int)((a & 0xffffu) + (a >> 16)));
    if (cnt >= 256) { prefix = cand; cntp = cnt; }
    if (cnt == 256) break;
  }
  int wlo = 0, whi = 0;
  if (cntp == 256) {
#pragma unroll
    for (int j = 0; j < NS; ++j) {
      const u64 sm = __ballot(key[j] >= prefix);
      if (lane == j) { wlo = (int)(unsigned)sm; whi = (int)(unsigned)(sm >> 32); }
    }
  } else {
    int cgt = 0;
#pragma unroll
    for (int j = 0; j < NS; ++j) cgt += (key[j] > prefix) ? 1 : 0;
    cgt = wave_sum(cgt);
    const int rneed = 256 - cgt;
    int running = 0;
    const u64 lt = (1ull << lane) - 1ull;
#pragma unroll
    for (int j = 0; j < NS; ++j) {
      const bool eq = key[j] == prefix;
      const u64 em = __ballot(eq);
      const int rank = running + __popcll(em & lt);
      const bool sel = (key[j] > prefix) || (eq && rank < rneed);
      const u64 sm = __ballot(sel);
      if (lane == j) { wlo = (int)(unsigned)sm; whi = (int)(unsigned)(sm >> 32); }
      running += __popcll(em);
    }
  }
  if (lane < nj) dst[lane] = ((u64)(unsigned)whi << 32) | (u64)(unsigned)wlo;
}

DI void idx_item(const Params& p, unsigned char* lds, int tid, bool samp, int b, int grp) {
  const int lane = tid & 63, w = tid >> 6;
  const int t0 = grp * 16;
  int L, g0; const u16* ki;
  if (!samp) { const int c = t0 >> 6; L = (c + 1) * 64; g0 = b * 2048 + t0; ki = p.kiP() + (size_t)b * 2048 * 64; }
  else { L = 2112; g0 = NPROMPT + b * 64 + t0; ki = p.kiS() + (size_t)b * 2112 * 64; }
  const int nj = L >> 6;
  if (L <= 256) {
    for (int qq = 0; qq < 4; ++qq) {
      const int q = w * 4 + qq;
      if (lane < nj) p.maskbits()[(size_t)(g0 + q) * 33 + lane] = ~0ull;
    }
    return;
  }
  u16* keys = (u16*)lds;
#ifndef REPMF
#define REPMF 1
#endif
#ifndef REPSEL
#define REPSEL 1
#endif
#ifndef REPKV
#define REPKV 1
#endif
  for (int rmf = 0; rmf < REPMF; ++rmf) {
    const int qn = lane & 15, quad = lane >> 4;
    bf16x8 qf[8][2];
    float wv[8];
#pragma unroll
    for (int h = 0; h < 8; ++h) {
      qf[h][0] = ldg8(p.qi() + (size_t)(g0 + qn) * 512 + h * 64 + quad * 8);
      qf[h][1] = ldg8(p.qi() + (size_t)(g0 + qn) * 512 + h * 64 + 32 + quad * 8);
      wv[h] = p.wi()[(size_t)(g0 + qn) * 8 + h];
    }
    bf16x8 A0[4], A1[4], N0[4], N1[4];
#pragma unroll
    for (int i = 0; i < 4; ++i) {
      const int kt = w + 4 * i;
      A0[i] = ldg8(ki + (size_t)(kt * 16 + qn) * 64 + quad * 8);
      A1[i] = ldg8(ki + (size_t)(kt * 16 + qn) * 64 + 32 + quad * 8);
    }
    for (int base = 0; base < nj; base += 4) {
#pragma unroll
      for (int i = 0; i < 4; ++i) {
        const int t = min(base + 4 + i, nj - 1);
        const int kt = w + 4 * t;
        N0[i] = ldg8(ki + (size_t)(kt * 16 + qn) * 64 + quad * 8);
        N1[i] = ldg8(ki + (size_t)(kt * 16 + qn) * 64 + 32 + quad * 8);
      }
#pragma unroll
      for (int i = 0; i < 4; ++i) {
        const int t = base + i;
        if (t < nj) {
          const int kt = w + 4 * t;
          float idx[4] = {0.f, 0.f, 0.f, 0.f};
#pragma unroll
          for (int h = 0; h < 8; ++h) {
            f32x4 acc = {0.f, 0.f, 0.f, 0.f};
            acc = MFMA16(A0[i], qf[h][0], acc);
            acc = MFMA16(A1[i], qf[h][1], acc);
#pragma unroll
            for (int e = 0; e < 4; ++e) idx[e] += fmaxf(acc[e], 0.f) * wv[h];
          }
          s16x4 kv;
#pragma unroll
          for (int e = 0; e < 4; ++e) {
            _Float16 hv = (_Float16)idx[e];
            u16 bits = __builtin_bit_cast(u16, hv);
            kv[e] = (short)((bits & 0x8000) ? (u16)~bits : (u16)(bits | 0x8000));
          }
          *(s16x4*)(keys + qn * KPITCH + kt * 16 + quad * 4) = kv;
        }
      }
#pragma unroll
      for (int i = 0; i < 4; ++i) { A0[i] = N0[i]; A1[i] = N1[i]; }
    }
  }
  __syncthreads();
  for (int qq = 0; qq < 4 * REPSEL; ++qq) {
    const int q = w * 4 + (qq & 3);
    const u16* krow = keys + q * KPITCH;
    u64* dst = p.maskbits() + (size_t)(g0 + q) * 33;
    if (nj <= 8) select_query<8>(krow, nj, lane, dst);
    else if (nj <= 16) select_query<16>(krow, nj, lane, dst);
    else if (nj <= 24) select_query<24>(krow, nj, lane, dst);
    else select_query<33>(krow, nj, lane, dst);
  }
  __syncthreads();
}

DI void scan_item(const Params& p, int item, int tid) {
  if (item < 1024) {
    const int bh = item >> 4, slab = item & 15;
    const int idx = slab * 1024 + tid * 4;
    const int h = bh & 3;
    const float cd = exp2f(64.f * log2gamma(h));
    f32x4 s = {0.f, 0.f, 0.f, 0.f};
    for (int c0 = 0; c0 < 32; c0 += 8) {
      f32x4 kvb[8];
#pragma unroll
      for (int i = 0; i < 8; ++i) kvb[i] = *(const f32x4*)(p.kvT() + (size_t)(bh * 32 + c0 + i) * 16384 + idx);
#pragma unroll
      for (int i = 0; i < 8; ++i) {
        *(s16x4*)(p.sprevT() + (size_t)(bh * 32 + c0 + i) * 16384 + idx) = pack4(s);
        s = s * cd + kvb[i];
      }
    }
    const int e = idx >> 7, d = idx & 127;
    float* o = p.out + OUT_STP + (size_t)bh * 16384;
#pragma unroll
    for (int j = 0; j < 4; ++j) o[(d + j) * 128 + e] = s[j];
  } else {
    const int it = item - 1024;
    const int bh = it >> 4, slab = it & 15;
    const int idx = slab * 1024 + tid * 4;
    const int h = bh & 3;
    const float cd = exp2f(64.f * log2gamma(h));
    const int e = idx >> 7, d = idx & 127;
    const float* s0 = p.state_ret + (size_t)bh * 16384;
    f32x4 s;
#pragma unroll
    for (int j = 0; j < 4; ++j) s[j] = s0[(d + j) * 128 + e];
    const size_t base = (size_t)(2048 + bh) * 16384 + idx;
    s16x4 o = pack4(s);
    *(s16x4*)(p.sprevT() + base) = o;
    f32x4 kv = *(const f32x4*)(p.kvT() + base);
    s = s * cd + kv;
    float* oo = p.out + OUT_STS + (size_t)bh * 16384;
#pragma unroll
    for (int j = 0; j < 4; ++j) oo[(d + j) * 128 + e] = s[j];
  }
}

DI void attn_item(const Params& p, unsigned char* lds, int tid, bool samp, int b, int c, int kvh, int qh) {
  const int lane = tid & 63, w = tid >> 6, r = lane & 31, hh = lane >> 5;
  const int T = samp ? 2112 : 2048;
  const int nkt = samp ? 33 : c + 1;
  const int g0 = (samp ? NPROMPT + b * 64 : b * 2048 + c * 64) + qh * 32;
  const u16* K = samp ? p.kaS() + (size_t)(b * 2 + kvh) * 2112 * 64 : p.kaP() + (size_t)(b * 2 + kvh) * 2048 * 64;
  const u16* VT = samp ? p.vaTS() + (size_t)(b * 2 + kvh) * 64 * 2112 : p.vaTP() + (size_t)(b * 2 + kvh) * 64 * 2048;
  const int head = kvh * 4 + w;
  u16* Ks = (u16*)lds;
  u16* Vs = Ks + 64 * 72;
  u64* mL = (u64*)(lds + 2 * 9216);
  for (int i = tid; i < 32 * 33; i += 256) mL[i] = p.maskbits()[(size_t)g0 * 33 + i];
  bf16x8 qf[4];
#pragma unroll
  for (int ks = 0; ks < 4; ++ks) qf[ks] = ldg8(p.qa() + (size_t)(g0 + r) * 512 + head * 64 + ks * 16 + hh * 8);
  f32x16 O[2];
  O[0] = zero16(); O[1] = zero16();
  float mrun = -1e30f, lrun = 0.f;
  const int lrow = tid >> 3, lch = tid & 7;
  bf16x8 pk0, pk1, pv0, pv1, nk0, nk1, nv0, nv1;
  pk0 = ldg8(K + (size_t)(lrow)*64 + lch * 8);
  pk1 = ldg8(K + (size_t)(lrow + 32) * 64 + lch * 8);
  pv0 = ldg8(VT + (size_t)(lrow)*T + lch * 8);
  pv1 = ldg8(VT + (size_t)(lrow + 32) * T + lch * 8);
  nk0 = pk0; nk1 = pk1; nv0 = pv0; nv1 = pv1;
  if (nkt > 1) {
    nk0 = ldg8(K + (size_t)(64 + lrow) * 64 + lch * 8);
    nk1 = ldg8(K + (size_t)(64 + lrow + 32) * 64 + lch * 8);
    nv0 = ldg8(VT + (size_t)(lrow)*T + 64 + lch * 8);
    nv1 = ldg8(VT + (size_t)(lrow + 32) * T + 64 + lch * 8);
  }
  for (int kt = 0; kt < nkt; ++kt) {
    __syncthreads();
    *(bf16x8*)(Ks + lrow * 72 + lch * 8) = pk0;
    *(bf16x8*)(Ks + (lrow + 32) * 72 + lch * 8) = pk1;
    *(bf16x8*)(Vs + lrow * 72 + lch * 8) = pv0;
    *(bf16x8*)(Vs + (lrow + 32) * 72 + lch * 8) = pv1;
    __syncthreads();
    pk0 = nk0; pk1 = nk1; pv0 = nv0; pv1 = nv1;
    if (kt + 2 < nkt) {
      nk0 = ldg8(K + (size_t)((kt + 2) * 64 + lrow) * 64 + lch * 8);
      nk1 = ldg8(K + (size_t)((kt + 2) * 64 + lrow + 32) * 64 + lch * 8);
      nv0 = ldg8(VT + (size_t)(lrow)*T + (kt + 2) * 64 + lch * 8);
      nv1 = ldg8(VT + (size_t)(lrow + 32) * T + (kt + 2) * 64 + lch * 8);
    }
    f32x16 S[2];
#pragma unroll
    for (int st = 0; st < 2; ++st) {
      S[st] = zero16();
#pragma unroll
      for (int ks = 0; ks < 4; ++ks) {
        bf16x8 kf = *(const bf16x8*)(Ks + (st * 32 + r) * 72 + ks * 16 + hh * 8);
        S[st] = MFMA32(kf, qf[ks], S[st]);
      }
    }
    const u64 W = mL[r * 33 + kt];
    const int wl = (int)(((unsigned)W) >> (4 * hh)), wh = (int)(((unsigned)(W >> 32)) >> (4 * hh));
    float mx = fmaxf(S[0][0], S[1][0]);
#pragma unroll
    for (int i = 1; i < 16; ++i) mx = fmaxf(mx, fmaxf(S[0][i], S[1][i]));
    mx = fmaxf(mx, __shfl_xor(mx, 32));
    const float mn = fmaxf(mrun, mx);
    const float alpha = __builtin_amdgcn_exp2f(mrun - mn);
    const bool resc = __any(mn != mrun);
    mrun = mn;
    float ls = 0.f;
#pragma unroll
    for (int st = 0; st < 2; ++st)
#pragma unroll
      for (int i = 0; i < 16; ++i) {
        const int keep = __builtin_amdgcn_sbfe(st ? wh : wl, (i & 3) + 8 * (i >> 2), 1);
        const float pvv = __int_as_float(__float_as_int(__builtin_amdgcn_exp2f(S[st][i] - mn)) & keep);
        S[st][i] = pvv;
        ls += pvv;
      }
    lrun = lrun * alpha + ls;
    if (resc) {
#pragma unroll
      for (int dt = 0; dt < 2; ++dt)
#pragma unroll
        for (int i = 0; i < 16; ++i) O[dt][i] *= alpha;
    }
#pragma unroll
    for (int st = 0; st < 2; ++st)
#pragma unroll
      for (int s2 = 0; s2 < 2; ++s2) {
        bf16x8 pf = pack8(S[st][8 * s2 + 0], S[st][8 * s2 + 1], S[st][8 * s2 + 2], S[st][8 * s2 + 3],
                          S[st][8 * s2 + 4], S[st][8 * s2 + 5], S[st][8 * s2 + 6], S[st][8 * s2 + 7]);
#pragma unroll
        for (int dt = 0; dt < 2; ++dt) {
          s16x4 lo = *(const s16x4*)(Vs + (dt * 32 + r) * 72 + st * 32 + 16 * s2 + 4 * hh);
          s16x4 hi = *(const s16x4*)(Vs + (dt * 32 + r) * 72 + st * 32 + 16 * s2 + 8 + 4 * hh);
          bf16x8 vf = __builtin_shufflevector(lo, hi, 0, 1, 2, 3, 4, 5, 6, 7);
          O[dt] = MFMA32(vf, pf, O[dt]);
        }
      }
  }
  {
    float lt = lrun + __shfl_xor(lrun, 32);
    const float inv = 1.f / lt;
    const u16* grow = p.gate() + (size_t)(g0 + r) * 1024 + 512 + head * 64;
    u16* mrow = p.mix() + (size_t)(g0 + r) * 1024 + 512 + head * 64;
    s16x4 gvv[2][4];
#pragma unroll
    for (int dt = 0; dt < 2; ++dt)
#pragma unroll
      for (int q4 = 0; q4 < 4; ++q4) gvv[dt][q4] = *(const s16x4*)(grow + dt * 32 + 8 * q4 + 4 * hh);
#pragma unroll
    for (int dt = 0; dt < 2; ++dt)
#pragma unroll
      for (int q4 = 0; q4 < 4; ++q4) {
        const int d = dt * 32 + 8 * q4 + 4 * hh;
        f32x4 of;
#pragma unroll
        for (int j = 0; j < 4; ++j) {
          const float gf = __uint_as_float(((unsigned)(u16)gvv[dt][q4][j]) << 16);
          of[j] = O[dt][q4 * 4 + j] * inv * gf;
        }
        *(s16x4*)(mrow + d) = pack4(of);
      }
  }
  __syncthreads();
}

DI void ret_out_item(const Params& p, unsigned char* lds, int item, int tid) {
  const int lane = tid & 63, w = tid >> 6, r = lane & 31, hh = lane >> 5;
  int bh, c, T, g0; const u16* vT;
  if (item < 2048) { bh = item >> 5; c = item & 31; T = 2048; g0 = (bh >> 2) * 2048 + c * 64; vT = p.vrT() + (size_t)bh * 128 * 2048; }
  else { bh = item - 2048; c = 0; T = 64; g0 = NPROMPT + (bh >> 2) * 64; vT = p.vrT() + (size_t)64 * 128 * 2048 + (size_t)bh * 128 * 64; }
  const int h = bh & 3;
  const float l2g = log2gamma(h);
  const int nt = w & 1, eh = w >> 1;
  const int n = nt * 32 + r;
  bf16x8 qf[8];
#pragma unroll
  for (int ks = 0; ks < 8; ++ks) qf[ks] = ldg8(p.qr() + (size_t)(g0 + n) * 512 + h * 128 + ks * 16 + hh * 8);
  bf16x8 pf[2][2];
#pragma unroll
  for (int mt = 0; mt < 2; ++mt) {
    f32x16 S = zero16();
#pragma unroll
    for (int ks = 0; ks < 8; ++ks) {
      bf16x8 kf = ldg8(p.kr() + (size_t)(g0 + mt * 32 + r) * 512 + h * 128 + ks * 16 + hh * 8);
      S = MFMA32(kf, qf[ks], S);
    }
#pragma unroll
    for (int i = 0; i < 16; ++i) {
      const int m = mt * 32 + crow(i, hh);
      const int dd = n > m ? n - m : m - n;
      S[i] *= exp2f((float)dd * l2g);
    }
    pf[mt][0] = pack8(S[0], S[1], S[2], S[3], S[4], S[5], S[6], S[7]);
    pf[mt][1] = pack8(S[8], S[9], S[10], S[11], S[12], S[13], S[14], S[15]);
  }
  const float fs = exp2f((float)(n + 1) * l2g);
  const u16* sp = p.sprevT() + (size_t)item * 16384;
  f32x16 tot[2];
  float ss = 0.f;
#pragma unroll
  for (int et = 0; et < 2; ++et) {
    const int e = (2 * eh + et) * 32 + r;
    f32x16 Oi = zero16(), X = zero16();
#pragma unroll
    for (int mt = 0; mt < 2; ++mt)
#pragma unroll
      for (int s2 = 0; s2 < 2; ++s2) {
        const u16* vp = vT + (size_t)e * T + c * 64 + mt * 32 + 16 * s2 + 4 * hh;
        s16x4 lo = ldg4(vp), hi = ldg4(vp + 8);
        bf16x8 vf = __builtin_shufflevector(lo, hi, 0, 1, 2, 3, 4, 5, 6, 7);
        Oi = MFMA32(vf, pf[mt][s2], Oi);
      }
#pragma unroll
    for (int ks = 0; ks < 8; ++ks) {
      bf16x8 sf = ldg8(sp + (size_t)e * 128 + ks * 16 + hh * 8);
      X = MFMA32(sf, qf[ks], X);
    }
#pragma unroll
    for (int i = 0; i < 16; ++i) { const float t = Oi[i] + X[i] * fs; tot[et][i] = t; ss += t * t; }
  }
  ss += __shfl_xor(ss, 32);
  float* red = (float*)lds;
  __syncthreads();
  if (hh == 0) red[w * 32 + r] = ss;
  __syncthreads();
  const float tsum = red[w * 32 + r] + red[(w ^ 2) * 32 + r];
  const float rinv = rsqrtf(tsum * (1.f / 128.f) + 1e-6f);
  const u16* grow = p.gate() + (size_t)(g0 + n) * 1024 + h * 128;
  u16* mrow = p.mix() + (size_t)(g0 + n) * 1024 + h * 128;
  s16x4 gvv[2][4];
  f32x4 ggv[2][4];
#pragma unroll
  for (int et = 0; et < 2; ++et)
#pragma unroll
    for (int q4 = 0; q4 < 4; ++q4) {
      const int e = (2 * eh + et) * 32 + 8 * q4 + 4 * hh;
      gvv[et][q4] = *(const s16x4*)(grow + e);
      ggv[et][q4] = *(const f32x4*)(p.ret_gn_g + h * 128 + e);
    }
#pragma unroll
  for (int et = 0; et < 2; ++et)
#pragma unroll
    for (int q4 = 0; q4 < 4; ++q4) {
      const int e = (2 * eh + et) * 32 + 8 * q4 + 4 * hh;
      f32x4 of;
#pragma unroll
      for (int j = 0; j < 4; ++j) {
        const float gf = __uint_as_float(((unsigned)(u16)gvv[et][q4][j]) << 16);
        of[j] = tot[et][q4 * 4 + j] * rinv * ggv[et][q4][j] * gf;
      }
      *(s16x4*)(mrow + e) = pack4(of);
    }
}

DI void phase_final(const Params& p, int tid) {
  const int gt = blockIdx.x * 512 + tid, GT = gridDim.x * 512;
  const int lane = tid & 63;
  for (int row0 = (gt >> 6) * 2; row0 < NTOK; row0 += (GT >> 6) * 2) {
    f32x4 v[2][4];
    s16x4 zz[2][4];
#pragma unroll
    for (int rr = 0; rr < 2; ++rr) {
      const float* xr = xrow(p, row0 + rr);
      const u16* zr = p.gate() + (size_t)(row0 + rr) * 1024;
#pragma unroll
      for (int i = 0; i < 4; ++i) { v[rr][i] = *(const f32x4*)(xr + i * 256 + lane * 4); zz[rr][i] = *(const s16x4*)(zr + i * 256 + lane * 4); }
    }
    f32x4 g[4];
#pragma unroll
    for (int i = 0; i < 4; ++i) g[i] = *(const f32x4*)(p.final_g + i * 256 + lane * 4);
#pragma unroll
    for (int rr = 0; rr < 2; ++rr) {
      float ss = 0.f;
#pragma unroll
      for (int i = 0; i < 4; ++i) {
#pragma unroll
        for (int j = 0; j < 4; ++j) v[rr][i][j] += __uint_as_float(((unsigned)(u16)zz[rr][i][j]) << 16);
        ss += v[rr][i][0] * v[rr][i][0] + v[rr][i][1] * v[rr][i][1] + v[rr][i][2] * v[rr][i][2] + v[rr][i][3] * v[rr][i][3];
      }
#pragma unroll
      for (int o = 32; o >= 1; o >>= 1) ss += __shfl_xor(ss, o);
      const float rv = rsqrtf(ss * (1.f / 1024.f) + 1e-6f);
      float* y = p.out + OUT_Y + (size_t)(row0 + rr) * 1024;
#pragma unroll
      for (int i = 0; i < 4; ++i) *(f32x4*)(y + i * 256 + lane * 4) = v[rr][i] * rv * g[i];
    }
  }
}

#ifndef REP0
#define REP0 1
#endif
#ifndef REP1
#define REP1 1
#endif
#ifndef REP2
#define REP2 1
#endif
#ifndef REP3
#define REP3 1
#endif
#ifndef REP4
#define REP4 1
#endif
#ifndef REP5
#define REP5 1
#endif
__global__ void __launch_bounds__(512, 2) fwd_megakernel(Params p) {
  __shared__ __attribute__((aligned(16))) unsigned char lds[LDS_BYTES];
  cg::grid_group grid = cg::this_grid();
  const int wave_id = __builtin_amdgcn_readfirstlane((int)threadIdx.x >> 6);
#define FRESH_TID() int tid = wave_id * 64 + lane_id(); asm volatile("" : "+v"(tid)); const int half = tid >> 8, htid = tid & 255; unsigned char* ldsh = lds + half * HALF_LDS; (void)htid; (void)ldsh;
  if (p.out == nullptr) grid.sync();
  if (wave_id == 0 && lane_id() == 0) (void)xb_add(&p.bar()[XB_XCNT(xb_xcc_id())], 1u);
  for (int rep = 0; rep < REP0; ++rep) {
  { FRESH_TID(); phase_prep(p, tid); }
  xcd_barrier(p.bar(), wave_id);
  }
  for (int rep = 0; rep < REP1; ++rep) {
  {
    FRESH_TID();
    pg8::Gemm g; g.A = p.xb(); g.Bt = p.WtIn(); g.M = NTOK; g.N = 4096; g.K = 1024;
    pg8::StaticOrder S; S.init(g.M, g.N, (int)gridDim.x, (int)blockIdx.x); S.permtab = 0xEFBCD87694105A32ull;
    Epi1 E; E.p = p; E.hl0 = (LAS unsigned char*)lds + pg8::STAGE_BYTES;
    pg8::gemm_phase<Epi1>((LAS unsigned char*)lds, g, S, E, wave_id);
  }
  xcd_barrier(p.bar(), wave_id);
  }
  for (int rep = 0; rep < REP2; ++rep) {
  {
    FRESH_TID();
    for (int it0 = blockIdx.x * 2; it0 < 2080 + 2080; it0 += gridDim.x * 2) {
      const int it = it0 + half;
      int ht = htid; asm volatile("" : "+v"(ht));
      if (it < 2080) {
        const bool samp = it < 32;
        const int j = it - 32;
        const int c = 31 - (j >> 6);
        const int b = samp ? (it >> 2) : ((j & 63) >> 2);
        const int grp = samp ? (it & 3) : (c * 4 + (j & 3));
        idx_item(p, ldsh, ht, samp, b, grp);
      } else { for (int rkv = 0; rkv < REPKV; ++rkv) ret_kv_item(p, it - 2080, ht); }
    }
  }
  xcd_barrier(p.bar(), wave_id);
  }
  for (int rep = 0; rep < REP3; ++rep) {
  {
    FRESH_TID();
    for (int it0 = blockIdx.x * 2; it0 < 1056 + 1536; it0 += gridDim.x * 2) {
      const int it = it0 + half;
      int ht = htid; asm volatile("" : "+v"(ht));
      if (it < 1056) {
        const bool samp = it < 32;
        const int j = it - 32;
        int c = samp ? 0 : 31 - (j >> 6);
        int b = samp ? (it >> 2) : ((j & 63) >> 2);
        int kvh = (it >> 1) & 1;
        if (!samp && gridDim.x == 256) {
          const int jb = (j >> 1) & 255, rnd = j >> 9;
          const int xcd = jb & 7, ii = jb >> 3;
          b = 2 * xcd + (ii & 1); kvh = (ii >> 1) & 1; c = 31 - rnd * 8 - (ii >> 2);
        }
        attn_item(p, ldsh, ht, samp, b, c, kvh, it & 1);
      } else scan_item(p, it - 1056, ht);
    }
  }
  xcd_barrier(p.bar(), wave_id);
  }
  for (int rep = 0; rep < REP4; ++rep) {
  {
    FRESH_TID();
    for (int it0 = blockIdx.x * 2; it0 < 2080 + 1024; it0 += gridDim.x * 2) {
      const int it = it0 + half;
      int ht = htid; asm volatile("" : "+v"(ht));
      if (it < 2080) ret_out_item(p, ldsh, it, ht);
      else {
        const int ia = it - 2080 + 1056;
        const int j = ia - 32;
        int c = 31 - (j >> 6);
        int b = (j & 63) >> 2;
        int kvh = (ia >> 1) & 1;
        if (gridDim.x == 256) {
          const int jb = (j >> 1) & 255, rnd = j >> 9;
          const int xcd = jb & 7, ii = jb >> 3;
          b = 2 * xcd + (ii & 1); kvh = (ii >> 1) & 1; c = 31 - rnd * 8 - (ii >> 2);
        }
        attn_item(p, ldsh, ht, false, b, c, kvh, ia & 1);
      }
    }
  }
  xcd_barrier(p.bar(), wave_id);
  }
  for (int rep = 0; rep < REP5; ++rep) {
  {
    pg8::Gemm g; g.A = p.mix(); g.Bt = p.WtOut(); g.M = NTOK; g.N = 1024; g.K = 1024;
    pg8::StaticOrder S; S.init(g.M, g.N, (int)gridDim.x, (int)blockIdx.x);
    Epi2 E; E.p = p; E.hl = lds + pg8::STAGE_BYTES + (wave_id >> 2) * 16384;
    pg8::gemm_phase<Epi2>((LAS unsigned char*)lds, g, S, E, wave_id);
  }
  xcd_barrier(p.bar(), wave_id);
  }
  { FRESH_TID(); phase_final(p, tid); }
}

extern "C" void kernel_launch(void* const* d_in, const int* in_sizes, int n_in, void* d_out, int out_size, void* d_ws,
                              size_t ws_size, hipStream_t stream) {
  static int grid_blocks = 0;
  if (!grid_blocks) {
    int dev = 0, cus = 0, per_cu = 0;
    (void)hipGetDevice(&dev);
    (void)hipDeviceGetAttribute(&cus, hipDeviceAttributeMultiprocessorCount, dev);
    (void)hipOccupancyMaxActiveBlocksPerMultiprocessor(&per_cu, fwd_megakernel, 512, 0);
    if (per_cu < 1) per_cu = 1;
    if (per_cu > 1) per_cu = 1;
    grid_blocks = cus * per_cu;
  }
  Params p{};
  p.x_p = (const float*)d_in[0]; p.x_s = (const float*)d_in[1]; p.state_ret = (const float*)d_in[2];
  p.cache_k = (const float*)d_in[3]; p.cache_v = (const float*)d_in[4]; p.cache_kidx = (const float*)d_in[5];
  p.norm_g = (const float*)d_in[6]; p.w_in = (const float*)d_in[7]; p.ret_gn_g = (const float*)d_in[8];
  p.w_out = (const float*)d_in[9]; p.final_g = (const float*)d_in[10];
  p.out = (float*)d_out;
  p.ws = (unsigned char*)d_ws;
  (void)hipMemsetAsync((unsigned char*)d_ws + 530573312ull, 0, (size_t)XCD_BAR_WORDS * 4, stream);
  void* args[] = {&p};
  hipError_t e = hipLaunchCooperativeKernel((void*)fwd_megakernel, dim3(grid_blocks), dim3(512), args, 0, stream);
  if (e != hipSuccess) fprintf(stderr, "cooperative launch failed: %s (grid %d)\n", hipGetErrorString(e), grid_blocks);
}
```

```cpp
#include <hip/hip_runtime.h>
#include <hip/hip_cooperative_groups.h>
#include <stdint.h>
#include <cstdio>
namespace cg = cooperative_groups;

typedef __attribute__((ext_vector_type(8))) short bf16x8;
typedef __attribute__((ext_vector_type(4))) short s16x4;
typedef __attribute__((ext_vector_type(16))) float f32x16;
typedef __attribute__((ext_vector_type(4))) float f32x4;
typedef unsigned short u16;
typedef unsigned long long u64;


#define DI __device__ __forceinline__
#define MFMA32(a, b, c) __builtin_amdgcn_mfma_f32_32x32x16_bf16((a), (b), (c), 0, 0, 0)
#define MFMA16(a, b, c) __builtin_amdgcn_mfma_f32_16x16x32_bf16((a), (b), (c), 0, 0, 0)

#define NTOK 33280
#define NPROMPT 32768
#define LDS_BYTES 163840
#define HALF_LDS 81920
#define LAS __attribute__((address_space(3)))
#define KPITCH 2116

struct Params {
  const float *x_p, *x_s, *state_ret, *cache_k, *cache_v, *cache_kidx, *norm_g, *w_in, *ret_gn_g, *w_out, *final_g;
  float* out;
  unsigned char* ws;
  DI u16* xb() const { return (u16*)(ws + 0ull); }
  DI float* kvT() const { return (float*)(ws + 0ull); }
  DI u16* WtIn() const { return (u16*)(ws + 136314880ull); }
  DI u16* WtOut() const { return (u16*)(ws + 144703488ull); }
  DI u16* qr() const { return (u16*)(ws + 146800640ull); }
  DI u16* kr() const { return (u16*)(ws + 180879360ull); }
  DI u16* sprevT() const { return (u16*)(ws + 214958080ull); }
  DI u16* qi() const { return (u16*)(ws + 214958080ull); }
  DI u16* krT() const { return (u16*)(ws + 249036800ull); }
  DI u16* vrT() const { return (u16*)(ws + 283115520ull); }
  DI u16* gate() const { return (u16*)(ws + 317194240ull); }
  DI u16* mix() const { return (u16*)(ws + 385351680ull); }
  DI u16* qa() const { return (u16*)(ws + 453509120ull); }
  DI u16* kaP() const { return (u16*)(ws + 487587840ull); }
  DI u16* kaS() const { return (u16*)(ws + 495976448ull); }
  DI u16* vaTP() const { return (u16*)(ws + 500301824ull); }
  DI u16* vaTS() const { return (u16*)(ws + 508690432ull); }
  DI u16* kiP() const { return (u16*)(ws + 513015808ull); }
  DI u16* kiS() const { return (u16*)(ws + 517210112ull); }
  DI float* rinv() const { return (float*)(ws + 519372800ull); }
  DI float* wi() const { return (float*)(ws + 519505920ull); }
  DI float* cosR() const { return (float*)(ws + 520570880ull); }
  DI float* sinR() const { return (float*)(ws + 521111552ull); }
  DI float* cosA() const { return (float*)(ws + 521652224ull); }
  DI float* sinA() const { return (float*)(ws + 521719808ull); }
  DI unsigned* bar() const { return (unsigned*)(ws + 530573312ull); }
  DI u64* maskbits() const { return (u64*)(ws + 521787392ull); }
};

#define OUT_Y 0
#define OUT_STP (34078720)
#define OUT_KP (OUT_STP + 1048576)
#define OUT_VP (OUT_KP + 4194304)
#define OUT_KIP (OUT_VP + 4194304)
#define OUT_STS (OUT_KIP + 2097152)
#define OUT_KS (OUT_STS + 524288)
#define OUT_VS (OUT_KS + 65536)
#define OUT_KIS (OUT_VS + 65536)

typedef __bf16 bf16x2_t __attribute__((ext_vector_type(2)));
typedef float f32x2_t __attribute__((ext_vector_type(2)));
typedef unsigned u32x4_t __attribute__((ext_vector_type(4)));
typedef unsigned u32x2_t __attribute__((ext_vector_type(2)));
DI unsigned pk2(float a, float b) { f32x2_t v = {a, b}; bf16x2_t r = __builtin_convertvector(v, bf16x2_t); return __builtin_bit_cast(unsigned, r); }
DI u16 f2bf(float x) { return (u16)(pk2(x, x) & 0xffffu); }
DI bf16x8 ldg8(const u16* p) { return *(const bf16x8*)p; }
DI s16x4 ldg4(const u16* p) { return *(const s16x4*)p; }
DI float siluf(float x) { return x * __builtin_amdgcn_rcpf(1.f + __builtin_amdgcn_exp2f(-1.4426950408889634f * x)); }
DI int lane_id() { return (int)__builtin_amdgcn_mbcnt_hi(~0u, __builtin_amdgcn_mbcnt_lo(~0u, 0u)); }
DI int crow(int reg, int hh) { return (reg & 3) + 8 * (reg >> 2) + 4 * hh; }
DI const float* xrow(const Params& p, int g) { return g < NPROMPT ? p.x_p + (size_t)g * 1024 : p.x_s + (size_t)(g - NPROMPT) * 1024; }
DI float log2gamma(int h) { return log1pf(-exp2f(-5.f - (float)h)) * 1.4426950408889634f; }
DI bf16x8 pack8(float a0, float a1, float a2, float a3, float a4, float a5, float a6, float a7) {
  u32x4_t v = {pk2(a0, a1), pk2(a2, a3), pk2(a4, a5), pk2(a6, a7)};
  return __builtin_bit_cast(bf16x8, v);
}
DI s16x4 pack4(f32x4 v) { u32x2_t o = {pk2(v[0], v[1]), pk2(v[2], v[3])}; return __builtin_bit_cast(s16x4, o); }
DI int wave_sum(int v) {
  v += __builtin_amdgcn_update_dpp(0, v, 0xB1, 0xf, 0xf, false);
  v += __builtin_amdgcn_update_dpp(0, v, 0x4E, 0xf, 0xf, false);
  v += __builtin_amdgcn_update_dpp(0, v, 0x124, 0xf, 0xf, false);
  v += __builtin_amdgcn_update_dpp(0, v, 0x128, 0xf, 0xf, false);
  return __builtin_amdgcn_readlane(v, 0) + __builtin_amdgcn_readlane(v, 16) + __builtin_amdgcn_readlane(v, 32) + __builtin_amdgcn_readlane(v, 48);
}
DI f32x16 zero16() { f32x16 z; for (int i = 0; i < 16; ++i) z[i] = 0.f; return z; }

#define XB_TMO      128
#define XB_XCNT(j)  (256  + 64 * (j))
#define XB_XSUB(j)  (1280 + 64 * (j))
#define XB_XGEN(j)  (2304 + 64 * (j))
#define XB_TOP      3328
#define XB_TOPGEN   3392
#define XB_WG(i)    (3456 + 64 * (i))
#define XCD_BAR_WORDS (3456 + 64 * 256)
#define XB_SPIN_CAP (1u << 18)
DI unsigned xb_ld(unsigned* p) { return __hip_atomic_load(p, __ATOMIC_RELAXED, __HIP_MEMORY_SCOPE_AGENT); }
DI unsigned xb_add(unsigned* p, unsigned v) { return __hip_atomic_fetch_add(p, v, __ATOMIC_RELAXED, __HIP_MEMORY_SCOPE_AGENT); }
DI unsigned xb_xcc_id() { return (unsigned)__builtin_amdgcn_s_getreg((3 << 11) | 20) & 0xFu; }
#define XB_SPIN(cond, bar) do { unsigned _sp = 0; while (cond) { __builtin_amdgcn_s_sleep(1); \
    if ((++_sp & 255u) == 0u) { if (xb_ld(&(bar)[XB_TMO])) break; if (_sp > XB_SPIN_CAP) { atomicAdd(&(bar)[XB_TMO], 1u); break; } } } } while (0)
DI void xcd_barrier(unsigned* bar, int wave_id) {
  asm volatile("s_waitcnt vmcnt(0)" ::: "memory");
  __syncthreads();
  if (wave_id == 0) {
    const int lane = lane_id();
    const unsigned x = xb_xcc_id();
    unsigned* slot = &bar[XB_WG(blockIdx.x)];
    unsigned nloc = 0u, nx = 0u;
    if (lane < 2) nloc = xb_ld(slot + lane);
    nx = (unsigned)__builtin_amdgcn_readlane((int)nloc, 1);
    nloc = (unsigned)__builtin_amdgcn_readlane((int)nloc, 0);
    if (nloc == 0u) {
      const unsigned G = gridDim.x * gridDim.y * gridDim.z;
      unsigned sp = 0u, c = 0u;
      for (;;) {
        c = (lane < 16) ? xb_ld(&bar[XB_XCNT(lane)]) : 0u;
        const unsigned sum = (unsigned)wave_sum((int)c);
        if (sum == G) break;
        __builtin_amdgcn_s_sleep(1);
        if ((++sp & 255u) == 0u) { if (xb_ld(&bar[XB_TMO])) break; if (sp > XB_SPIN_CAP) { if (lane == 0) atomicAdd(&bar[XB_TMO], 1u); break; } }
      }
      nx = (unsigned)__popcll(__ballot(c > 0u));
      nloc = (unsigned)__builtin_amdgcn_readlane((int)c, (int)x);
      nloc = nloc > 0u ? nloc : 1u; nx = nx > 0u ? nx : 1u;
      if (lane == 0) { __hip_atomic_store(slot, nloc, __ATOMIC_RELAXED, __HIP_MEMORY_SCOPE_AGENT); __hip_atomic_store(slot + 1, nx, __ATOMIC_RELAXED, __HIP_MEMORY_SCOPE_AGENT); }
    }
    if (lane == 0) {
      __builtin_amdgcn_s_waitcnt(0);
      const unsigned old = xb_add(&bar[XB_XSUB(x)], 1u);
      const unsigned gen = old / nloc;
      if (old + 1u == (gen + 1u) * nloc) {
        __builtin_amdgcn_fence(__ATOMIC_RELEASE, "agent");
        asm volatile("s_waitcnt vmcnt(0)" ::: "memory");
        const unsigned og = xb_add(&bar[XB_TOP], 1u);
        const unsigned tg = og / nx;
        if (og + 1u == (tg + 1u) * nx) xb_add(&bar[XB_TOPGEN], 1u);
        else XB_SPIN(xb_ld(&bar[XB_TOPGEN]) == tg, bar);
        __builtin_amdgcn_fence(__ATOMIC_ACQUIRE, "agent");
        xb_add(&bar[XB_XGEN(x)], 1u);
        asm volatile("s_waitcnt vmcnt(0)" ::: "memory");
      } else {
        XB_SPIN(xb_ld(&bar[XB_XGEN(x)]) == gen, bar);
        __builtin_amdgcn_fence(__ATOMIC_ACQUIRE, "agent");
        asm volatile("s_waitcnt vmcnt(0)" ::: "memory");
      }
    }
  }
  __syncthreads();
}

DI void phase_prep(const Params& p, int tid) {
  const int gt = blockIdx.x * 512 + tid, GT = gridDim.x * 512;
  const int lane = tid & 63;
  for (int row0 = (gt >> 6) * 2; row0 < NTOK; row0 += (GT >> 6) * 2) {
    f32x4 v[2][4];
#pragma unroll
    for (int rr = 0; rr < 2; ++rr) {
      const float* sp = xrow(p, row0 + rr);
#pragma unroll
      for (int i = 0; i < 4; ++i) v[rr][i] = *(const f32x4*)(sp + i * 256 + lane * 4);
    }
#pragma unroll
    for (int rr = 0; rr < 2; ++rr) {
      float ss = 0.f;
#pragma unroll
      for (int i = 0; i < 4; ++i) ss += v[rr][i][0] * v[rr][i][0] + v[rr][i][1] * v[rr][i][1] + v[rr][i][2] * v[rr][i][2] + v[rr][i][3] * v[rr][i][3];
#pragma unroll
      for (int o = 32; o >= 1; o >>= 1) ss += __shfl_xor(ss, o);
#pragma unroll
      for (int i = 0; i < 4; ++i) *(s16x4*)(p.xb() + (size_t)(row0 + rr) * 1024 + i * 256 + lane * 4) = pack4(v[rr][i]);
      if (lane == 0) p.rinv()[row0 + rr] = rsqrtf(ss * (1.f / 1024.f) + 1e-6f);
    }
  }
  for (int i = gt; i < 4096 * 128; i += GT) {
    int n = i & 4095, kg = i >> 12;
    int sc = n;
    if (n < 1024) { const int P = n & 127; sc = (n & ~127) + 64 * ((P >> 4) & 1) + 16 * (P >> 5) + (P & 15); }
    float a[8];
    const float vmask = (n < 3912) ? 1.f : 0.f; const int scc = (sc < 3912) ? sc : 3911;
#pragma unroll
    for (int j = 0; j < 8; ++j) a[j] = p.w_in[(size_t)(kg * 8 + j) * 3912 + scc] * p.norm_g[kg * 8 + j] * vmask;
    *(bf16x8*)(p.WtIn() + (size_t)n * 1024 + kg * 8) = pack8(a[0], a[1], a[2], a[3], a[4], a[5], a[6], a[7]);
  }
  for (int i = gt; i < 1024 * 128; i += GT) {
    int n = i % 1024, kg = i / 1024;
    float a[8];
#pragma unroll
    for (int j = 0; j < 8; ++j) a[j] = p.w_out[(size_t)(kg * 8 + j) * 1024 + n];
    *(bf16x8*)(p.WtOut() + (size_t)n * 1024 + kg * 8) = pack8(a[0], a[1], a[2], a[3], a[4], a[5], a[6], a[7]);
  }
  for (int i = gt; i < 2112 * 64; i += GT) {
    int pos = i >> 6, k = i & 63;
    float inv = powf(10000.f, -(float)k / 64.f);
    float ang = (float)pos * inv;
    p.cosR()[i] = cosf(ang); p.sinR()[i] = sinf(ang);
  }
  for (int i = gt; i < 2112 * 8; i += GT) {
    int pos = i >> 3, k = i & 7;
    float inv = powf(500000.f, -(float)k / 8.f);
    float ang = (float)pos * inv;
    p.cosA()[i] = cosf(ang); p.sinA()[i] = sinf(ang);
  }
  for (int i = gt; i < 8 * 2048 * 2 * 8; i += GT) {
    int dg = i & 7, kvh = (i >> 3) & 1, t = (i >> 4) & 2047, b = i >> 15;
    const float* s = p.cache_k + ((size_t)(b * 2048 + t) * 2 + kvh) * 64 + dg * 8;
    *(bf16x8*)(p.kaS() + ((size_t)(b * 2 + kvh) * 2112 + t) * 64 + dg * 8) = pack8(s[0], s[1], s[2], s[3], s[4], s[5], s[6], s[7]);
  }
  for (int i = gt; i < 8 * 2 * 256 * 64; i += GT) {
    int d = i & 63, tg = (i >> 6) & 255, kvh = (i >> 14) & 1, b = i >> 15;
    float a[8];
#pragma unroll
    for (int j = 0; j < 8; ++j) a[j] = p.cache_v[((size_t)(b * 2048 + tg * 8 + j) * 2 + kvh) * 64 + d];
    *(bf16x8*)(p.vaTS() + ((size_t)(b * 2 + kvh) * 64 + d) * 2112 + tg * 8) = pack8(a[0], a[1], a[2], a[3], a[4], a[5], a[6], a[7]);
  }
  for (int i = gt; i < 8 * 2048 * 8; i += GT) {
    int dg = i & 7, t = (i >> 3) & 2047, b = i >> 14;
    const float* s = p.cache_kidx + (size_t)(b * 2048 + t) * 64 + dg * 8;
    *(bf16x8*)(p.kiS() + ((size_t)b * 2112 + t) * 64 + dg * 8) = pack8(s[0], s[1], s[2], s[3], s[4], s[5], s[6], s[7]);
  }
}

namespace pg8 {
constexpr int BM = 256, BK = 64, HALF = 128, HTB = HALF * BK * 2, STAGE_BYTES = 8 * HTB, NXCD = 8, WGM = 8;
DI int lds_byte(int r, int c) { const int st = (r >> 4) * 2 + (c >> 5), rr = r & 15, cc = c & 31, ob = rr * 64 + cc * 2; return st * 1024 + (ob ^ (((ob >> 9) & 1) << 5)); }
DI void stage_rc(int b, int& R, int& C) { const int st = b / 1024, sb = b % 1024, swz = sb ^ (((sb >> 9) & 1) << 5); R = (st >> 1) * 16 + swz / 64; C = (st & 1) * 32 + (swz % 64) / 2; }
struct Unit { int pm, pn; };
struct Gemm { const u16* A; const u16* Bt; int M, N, K; };
struct StaticOrder {
  int nM, nN, nwg, G, c; unsigned long long permtab;
  DI void init(int M, int N, int G_, int c_) { nM = M / BM; nN = N / BM; nwg = nM * nN; G = G_; c = c_; permtab = 0xFEDCBA9876543210ull; }
  DI bool next(int i, Unit& u) const {
    const long L = (long)i * G + c; if (L >= nwg) return false;
    int wgid = (int)L; { const int q = nwg / NXCD, r = nwg % NXCD, xcd = wgid % NXCD, off = wgid / NXCD; wgid = (xcd < r ? xcd * (q + 1) : r * (q + 1) + (xcd - r) * q) + off; }
    const int nig = WGM * nN, gid = wgid / nig, fm = gid * WGM, gsz = (nM - fm) < WGM ? (nM - fm) : WGM;
    u.pm = fm + ((wgid % nig) % gsz); u.pn = (int)((permtab >> (4 * ((wgid % nig) / gsz))) & 15ull); return true;
  }
};
template <class Epi>
DI void gemm_phase(LAS unsigned char* lds, const Gemm g, const StaticOrder& S, const Epi& E, int wave_id) {
  const int wid = wave_id; int lane = lane_id(); asm volatile("" : "+v"(lane)); const int tid = wid * 64 + lane;
  const int wr = wid >> 2, wc = wid & 3, fr = lane & 15, fq = lane >> 4;
  const int K = g.K, nt = K / BK;
  unsigned voffA[2], voffB[2];
#pragma unroll
  for (int i = 0; i < 2; ++i) { int R, C; stage_rc(tid * 16 + i * 8192, R, C); voffA[i] = (unsigned)(R * K + C) * 2u; voffB[i] = voffA[i]; }
  const size_t kstep = (size_t)(BK * 2);
  const size_t hstep = (size_t)HALF * K * 2;
  const size_t tstep = 2 * hstep;
  const unsigned ldsw = (unsigned)wid * 1024u;
  const int aoff = lds_byte(wr * 64 + fr, fq * 8), boff = lds_byte(wc * 32 + fr, fq * 8);
#define PG8_SA(b, h) (((b) * 2 + (h)) * HTB)
#define PG8_SB(b, h) ((4 + (b) * 2 + (h)) * HTB)
#define PG8_STAGE(bufoff, gbase, voff) do { _Pragma("unroll") for (int _i = 0; _i < 2; ++_i) \
    __builtin_amdgcn_global_load_lds((const unsigned*)((const char*)(gbase) + (voff)[_i]), (LAS unsigned*)(lds + (bufoff) + ldsw + _i * 8192), 16, 0, 0); } while (0)
#define PG8_LDA(dst, b, h) do { _Pragma("unroll") for (int m = 0; m < 4; ++m) _Pragma("unroll") for (int k = 0; k < 2; ++k) dst[m][k] = *(const LAS bf16x8*)(lds + PG8_SA(b, h) + aoff + m * 2048 + k * 1024); } while (0)
#define PG8_LDB(dst, b, h) do { _Pragma("unroll") for (int n = 0; n < 2; ++n) _Pragma("unroll") for (int k = 0; k < 2; ++k) dst[n][k] = *(const LAS bf16x8*)(lds + PG8_SB(b, h) + boff + n * 2048 + k * 1024); } while (0)
#define PG8_MMA(ai, bj, At, Bt) do { __builtin_amdgcn_s_setprio(1); _Pragma("unroll") for (int m = 0; m < 4; ++m) _Pragma("unroll") for (int n = 0; n < 2; ++n) _Pragma("unroll") for (int k = 0; k < 2; ++k) \
    acc[ai][bj][m][n] = __builtin_amdgcn_mfma_f32_16x16x32_bf16(Bt[n][k], At[m][k], acc[ai][bj][m][n], 0, 0, 0); __builtin_amdgcn_s_setprio(0); } while (0)
#define PG8_WAIT_V(n) asm volatile("s_waitcnt vmcnt(" #n ")" ::: "memory")
#define PG8_WAIT_L(n) asm volatile("s_waitcnt lgkmcnt(" #n ")" ::: "memory")
#define PG8_BAR __builtin_amdgcn_s_barrier()
#define PG8_SCHED __builtin_amdgcn_sched_barrier(0)
  Unit cur, nxt; int ui = 0;
  if (!S.next(0, cur)) return;
  f32x4 acc[2][2][4][2];
#pragma unroll
  for (int a = 0; a < 2; ++a)
#pragma unroll
    for (int b = 0; b < 2; ++b)
#pragma unroll
      for (int m = 0; m < 4; ++m)
#pragma unroll
        for (int n = 0; n < 2; ++n) acc[a][b][m][n] = (f32x4){0.f, 0.f, 0.f, 0.f};
  bf16x8 At[4][2], B0[2][2], B1[2][2];
  const char* cA = (const char*)g.A + (size_t)cur.pm * tstep; const char* cB = (const char*)g.Bt + (size_t)cur.pn * tstep;
  PG8_STAGE(PG8_SB(0, 0), cB, voffB); PG8_STAGE(PG8_SA(0, 0), cA, voffA); PG8_STAGE(PG8_SB(0, 1), cB + hstep, voffB); PG8_STAGE(PG8_SA(0, 1), cA + hstep, voffA);
  if (wr == 1) PG8_BAR;
  PG8_WAIT_V(4); PG8_BAR;
  PG8_STAGE(PG8_SB(1, 0), cB + kstep, voffB); PG8_STAGE(PG8_SA(1, 0), cA + kstep, voffA); PG8_STAGE(PG8_SB(1, 1), cB + hstep + kstep, voffB);
  PG8_WAIT_V(6); PG8_BAR;
  for (;;) {
    const bool has_next = S.next(ui + 1, nxt);
    const char* nA = has_next ? (const char*)g.A + (size_t)nxt.pm * tstep : cA; const char* nB = has_next ? (const char*)g.Bt + (size_t)nxt.pn * tstep : cB;
#ifndef REPK
#define REPK 1
#endif
    for (int rk = 0; rk < REPK; ++rk) {
    const char* nA2 = (rk == REPK - 1) ? nA : cA; const char* nB2 = (rk == REPK - 1) ? nB : cB;
    for (int t = 0; t < nt; t += 2) {
      const bool last = (t == nt - 2);
      const char* a1 = cA + (size_t)(t + 1) * kstep;
      const char* a2 = last ? nA2 : cA + (size_t)(t + 2) * kstep; const char* b2 = last ? nB2 : cB + (size_t)(t + 2) * kstep;
      const char* a3 = a2 + kstep; const char* b3 = b2 + kstep;
      PG8_LDB(B0, 0, 0); PG8_SCHED; PG8_LDA(At, 0, 0); PG8_STAGE(PG8_SA(1, 1), a1 + hstep, voffA);
      PG8_WAIT_L(8); PG8_BAR; PG8_WAIT_L(0); PG8_MMA(0, 0, At, B0); PG8_BAR; PG8_SCHED;
      PG8_LDB(B1, 0, 1); PG8_STAGE(PG8_SB(0, 0), b2, voffB);
      PG8_BAR; PG8_WAIT_L(0); PG8_MMA(0, 1, At, B1); PG8_BAR;
      PG8_LDA(At, 0, 1); PG8_STAGE(PG8_SA(0, 0), a2, voffA);
      PG8_BAR; PG8_WAIT_L(0); PG8_MMA(1, 0, At, B0); PG8_BAR; PG8_SCHED;
      PG8_STAGE(PG8_SB(0, 1), b2 + hstep, voffB);
      PG8_WAIT_V(6); PG8_BAR; PG8_MMA(1, 1, At, B1); PG8_BAR;
      PG8_LDB(B0, 1, 0); PG8_SCHED; PG8_LDA(At, 1, 0); PG8_STAGE(PG8_SA(0, 1), a2 + hstep, voffA);
      PG8_WAIT_L(8); PG8_BAR; PG8_WAIT_L(0); PG8_MMA(0, 0, At, B0); PG8_BAR; PG8_SCHED;
      PG8_LDB(B1, 1, 1); PG8_STAGE(PG8_SB(1, 0), b3, voffB);
      PG8_BAR; PG8_WAIT_L(0); PG8_MMA(0, 1, At, B1); PG8_BAR;
      PG8_LDA(At, 1, 1); PG8_STAGE(PG8_SA(1, 0), a3, voffA);
      PG8_BAR; PG8_WAIT_L(0); PG8_MMA(1, 0, At, B0); PG8_BAR; PG8_SCHED;
      PG8_STAGE(PG8_SB(1, 1), b3 + hstep, voffB);
      PG8_WAIT_V(6); PG8_BAR; PG8_MMA(1, 1, At, B1); PG8_BAR;
    }
    }
    {
      Unit eu = cur; int ewr = wr, ewc = wc; int el = lane_id();
      asm volatile("" : "+s"(eu.pm), "+s"(eu.pn), "+s"(ewr), "+s"(ewc), "+v"(el));
      int efr = el & 15, efq = el >> 4;
#ifndef REPEPI
#define REPEPI 1
#endif
      for (int re = 0; re < REPEPI; ++re) E(acc, eu, ewr, ewc, efr, efq, re);
    }
    if (!has_next) break;
#pragma unroll
    for (int a = 0; a < 2; ++a)
#pragma unroll
      for (int b = 0; b < 2; ++b)
#pragma unroll
        for (int m = 0; m < 4; ++m)
#pragma unroll
          for (int n = 0; n < 2; ++n) acc[a][b][m][n] = (f32x4){0.f, 0.f, 0.f, 0.f};
    cur = nxt; cA = nA; cB = nB; ++ui;
  }
  PG8_WAIT_V(0);
  if (wr == 0) PG8_BAR;
  PG8_BAR;
#undef PG8_SA
#undef PG8_SB
#undef PG8_STAGE
#undef PG8_LDA
#undef PG8_LDB
#undef PG8_MMA
#undef PG8_WAIT_V
#undef PG8_WAIT_L
#undef PG8_BAR
#undef PG8_SCHED
}
}


DI unsigned hx_w(int row, int c8) { return (unsigned)(row * 256 + ((c8 ^ ((row & 15) << 1)) << 3)); }
DI unsigned hx_r(int row, int c16) { return (unsigned)(row * 256 + ((c16 ^ (row & 15)) << 4)); }
#define EPI_BAR() asm volatile("s_waitcnt lgkmcnt(0)\n\ts_barrier" ::: "memory")


struct Epi1 {
  Params p; LAS unsigned char* hl0;
  DI void load_tabs(f32x4 (&tc)[4], f32x4 (&ts)[4], int tclass, int R0, bool samp, int wc, int fr, int fq) const {
    const float* cb = (tclass == 1) ? p.cosR() : p.cosA();
    const float* sb = (tclass == 1) ? p.sinR() : p.sinA();
    const int pitch = (tclass == 1) ? 64 : 8;
    const int coff = (tclass == 1) ? (16 * wc + 4 * fq) : (4 * (fq & 1));
#pragma unroll
    for (int m = 0; m < 4; ++m) {
      const int rowg = R0 + 16 * m + fr;
      const int pos = samp ? 2048 + ((rowg - NPROMPT) & 63) : (rowg & 2047);
      tc[m] = *(const f32x4*)(cb + pos * pitch + coff);
      ts[m] = *(const f32x4*)(sb + pos * pitch + coff);
    }
  }
  template <int AI, int BJ>
  DI void compute(f32x4 (&acc)[2][2][4][2], const f32x4 (&tc)[4], const f32x4 (&ts)[4], int blk, int wc, int fq) const {
    if (blk < 8) {
#pragma unroll
      for (int m = 0; m < 4; ++m) {
        const f32x4 v0 = acc[AI][BJ][m][0], v1 = acc[AI][BJ][m][1];
        f32x4 o0 = v0 * tc[m] - v1 * ts[m], o1 = v1 * tc[m] + v0 * ts[m];
        if (blk >= 4) { o0 *= 0.08838834764831845f; o1 *= 0.08838834764831845f; }
        acc[AI][BJ][m][0] = o0; acc[AI][BJ][m][1] = o1;
      }
    } else if ((blk >= 12 && blk < 16) || (blk >= 22 && blk < 26)) {
#pragma unroll
      for (int m = 0; m < 4; ++m)
#pragma unroll
        for (int n = 0; n < 2; ++n) {
          f32x4 v = acc[AI][BJ][m][n];
          v[0] = siluf(v[0]); v[1] = siluf(v[1]); v[2] = siluf(v[2]); v[3] = siluf(v[3]);
          acc[AI][BJ][m][n] = v;
        }
    } else if ((blk >= 8 && blk < 12) || blk == 21 || blk == 31) {
    } else {
      const bool ropew = ((wc & 1) == 0) && !(blk == 30 && wc >= 2);
      if (ropew) {
#pragma unroll
        for (int m = 0; m < 4; ++m) {
          const f32x4 v0 = acc[AI][BJ][m][0];
          f32x4 pr;
          pr[0] = __shfl_xor(v0[0], 32); pr[1] = __shfl_xor(v0[1], 32); pr[2] = __shfl_xor(v0[2], 32); pr[3] = __shfl_xor(v0[3], 32);
          acc[AI][BJ][m][0] = (fq < 2) ? v0 * tc[m] - pr * ts[m] : v0 * tc[m] + pr * ts[m];
        }
      }
      if (blk < 20) {
        const float sc = 0.125f * 1.4426950408889634f;
#pragma unroll
        for (int m = 0; m < 4; ++m) { acc[AI][BJ][m][0] *= sc; acc[AI][BJ][m][1] *= sc; }
      }
    }
  }
  template <int AI, int BJ>
  DI void emit(f32x4 (&acc)[2][2][4][2], const pg8::Unit& u, int blk, bool samp, int wr, int wc, int fr, int fq) const {
    if (blk == 31) return;
    LAS unsigned char* hl = hl0 + wr * 16384;
    asm volatile("" : "+v"(fr), "+v"(fq));
    const int lane = fr + 16 * fq;
    const int P0 = 32 * wc + 4 * fq;
    const int R0 = u.pm * 256 + AI * 128 + wr * 64;
    int b, tb;
    if (!samp) { b = R0 >> 11; tb = R0 & 2047; } else { b = (R0 - NPROMPT) >> 6; tb = 0; }
    const bool retk = blk < 8;
    const bool hasT = (blk >= 4 && blk < 12) || blk == 21;
    const bool hasN = !(blk >= 8 && blk < 12) && blk != 21;
    if (blk == 20 || blk == 21) {
      float* ob = samp ? p.out + (blk == 20 ? OUT_KS : OUT_VS) + (unsigned)(R0 - NPROMPT) * 128u : p.out + (blk == 20 ? OUT_KP : OUT_VP) + (unsigned)R0 * 128u;
#pragma unroll
      for (int m = 0; m < 4; ++m) {
        float* o2 = ob + (unsigned)(16 * m + fr) * 128u + P0;
        *(f32x4*)o2 = acc[AI][BJ][m][0]; *(f32x4*)(o2 + 16) = acc[AI][BJ][m][1];
      }
    } else if (blk == 30) {
      float* ob = samp ? p.out + OUT_KIS + (unsigned)(R0 - NPROMPT) * 64u : p.out + OUT_KIP + (unsigned)R0 * 64u;
      float* wb = p.wi() + (unsigned)R0 * 8u;
#pragma unroll
      for (int m = 0; m < 4; ++m) {
        if (wc < 2) {
          float* o2 = ob + (unsigned)(16 * m + fr) * 64u + P0;
          *(f32x4*)o2 = acc[AI][BJ][m][0]; *(f32x4*)(o2 + 16) = acc[AI][BJ][m][1];
        } else if (wc == 2 && fq < 2) {
          *(f32x4*)(wb + (unsigned)(16 * m + fr) * 8u + 4 * fq) = acc[AI][BJ][m][0] * 0.044194173824159216f;
        }
      }
    }
    if (hasN) {
#pragma unroll
      for (int m = 0; m < 4; ++m)
#pragma unroll
        for (int n = 0; n < 2; ++n) {
          const int c8 = retk ? (16 * n + 4 * wc + fq) : (8 * wc + 4 * n + fq);
          *(LAS s16x4*)(hl + hx_w(16 * m + fr, c8)) = pack4(acc[AI][BJ][m][n]);
        }
      u16* nb; unsigned pitch = 512u, hstr = 0u, cm = 15u;
      if (blk < 4) nb = p.qr() + (unsigned)R0 * 512u + (blk & 3) * 128;
      else if (blk < 8) nb = p.kr() + (unsigned)R0 * 512u + (blk & 3) * 128;
      else if (blk < 16) { nb = p.gate() + (unsigned)R0 * 1024u + (blk - 12) * 128; pitch = 1024u; }
      else if (blk < 20) nb = p.qa() + (unsigned)R0 * 512u + (blk - 16) * 128;
      else if (blk == 20) { nb = samp ? p.kaS() + ((unsigned)(b * 2) * 2112u + 2048u) * 64u : p.kaP() + ((unsigned)(b * 2) * 2048u + tb) * 64u; pitch = 64u; hstr = samp ? 2112u * 64u : 2048u * 64u; cm = 7u; }
      else if (blk < 26) { nb = p.gate() + (unsigned)R0 * 1024u + 512 + (blk - 22) * 128; pitch = 1024u; }
      else if (blk < 30) nb = p.qi() + (unsigned)R0 * 512u + (blk - 26) * 128;
      else { nb = samp ? p.kiS() + ((unsigned)b * 2112u + 2048u) * 64u : p.kiP() + ((unsigned)b * 2048u + tb) * 64u; pitch = 64u; cm = 7u; }
      EPI_BAR();
      const unsigned c16 = lane & 15;
      const unsigned loff = (c16 >> 3) * hstr + (c16 & cm) * 8u;
#pragma unroll
      for (int i = 0; i < 4; ++i) {
        const int row = 16 * wc + 4 * i + (lane >> 4);
        const bf16x8 v = *(const LAS bf16x8*)(hl + hx_r(row, c16));
        if (blk != 30 || c16 < 8) *(bf16x8*)(nb + (unsigned)row * pitch + loff) = v;
      }
      EPI_BAR();
    }
    if (hasT) {
      const float l2g = log2gamma(blk & 3);
#pragma unroll
      for (int m = 0; m < 4; ++m) {
        const int tok = 16 * m + fr;
        const float dec = (blk < 8) ? exp2f((float)(63 - tok) * l2g) : 1.f;
#pragma unroll
        for (int n = 0; n < 2; ++n) {
          const int fb = retk ? (64 * n + 16 * wc + 4 * fq) : (32 * wc + 16 * n + 4 * fq);
#pragma unroll
          for (int j = 0; j < 4; ++j) {
            const int f = fb + j;
            *(LAS u16*)(hl + f * 128 + ((((tok >> 3) ^ (f >> 2)) & 7) << 4) + (tok & 7) * 2) = f2bf(acc[AI][BJ][m][n][j] * dec);
          }
        }
      }
      u16* tbp; unsigned fstr;
      if (blk < 12) {
        u16* base = (blk < 8) ? p.krT() : p.vrT();
        const unsigned bh = (unsigned)(b * 4 + (blk & 3)) * 128u;
        tbp = samp ? base + 64u * 128u * 2048u + bh * 64u : base + bh * 2048u + tb;
        fstr = samp ? 64u : 2048u;
      } else {
        tbp = samp ? p.vaTS() + (unsigned)b * 128u * 2112u + 2048u : p.vaTP() + (unsigned)b * 128u * 2048u + tb;
        fstr = samp ? 2112u : 2048u;
      }
      EPI_BAR();
#pragma unroll
      for (int i = 0; i < 4; ++i) {
        const int f = 32 * wc + 8 * i + (lane >> 3), ch = lane & 7;
        const bf16x8 v = *(const LAS bf16x8*)(hl + f * 128 + (((ch ^ (f >> 2)) & 7) << 4));
        *(bf16x8*)(tbp + (unsigned)f * fstr + ch * 8) = v;
      }
      EPI_BAR();
    }
  }
  DI void operator()(f32x4 (&acc)[2][2][4][2], const pg8::Unit& u, int wr, int wc, int fr, int fq, int re) const {
    const bool samp = (u.pm * 256 >= NPROMPT);
    const int tclass = (u.pn < 4) ? 1 : ((u.pn == 8 || u.pn == 9 || u.pn == 10 || u.pn >= 13) ? 2 : 0);
    const int blk0 = u.pn * 2, blk1 = u.pn * 2 + 1;
    float rvv[2][4];
#pragma unroll
    for (int ai = 0; ai < 2; ++ai)
#pragma unroll
      for (int m = 0; m < 4; ++m) rvv[ai][m] = (1.f / REPK) * p.rinv()[u.pm * 256 + ai * 128 + wr * 64 + 16 * m + fr];
    f32x4 tc[4], ts[4];
    load_tabs(tc, ts, tclass, u.pm * 256 + wr * 64, samp, wc, fr, fq);
#pragma unroll
    for (int ai = 0; ai < 2; ++ai)
#pragma unroll
      for (int m = 0; m < 4; ++m)
#pragma unroll
        for (int bj = 0; bj < 2; ++bj)
#pragma unroll
          for (int n = 0; n < 2; ++n) acc[ai][bj][m][n] *= rvv[ai][m];
    compute<0, 0>(acc, tc, ts, blk0, wc, fq);
    compute<0, 1>(acc, tc, ts, blk1, wc, fq);
    load_tabs(tc, ts, tclass, u.pm * 256 + 128 + wr * 64, samp, wc, fr, fq);
    compute<1, 0>(acc, tc, ts, blk0, wc, fq);
    compute<1, 1>(acc, tc, ts, blk1, wc, fq);
    emit<0, 0>(acc, u, blk0, samp, wr, wc, fr, fq);
    emit<0, 1>(acc, u, blk1, samp, wr, wc, fr, fq);
    emit<1, 0>(acc, u, blk0, samp, wr, wc, fr, fq);
    emit<1, 1>(acc, u, blk1, samp, wr, wc, fr, fq);
  }
};

struct Epi2 {
  Params p; unsigned char* hl;
  DI void operator()(f32x4 (&acc)[2][2][4][2], const pg8::Unit& u, int wr, int wc, int fr, int fq, int re) const {
    u16* z = p.gate();
    const int lane = fr + 16 * fq;
#pragma unroll
    for (int ai = 0; ai < 2; ++ai)
#pragma unroll
      for (int bj = 0; bj < 2; ++bj) {
#pragma unroll
        for (int m = 0; m < 4; ++m)
#pragma unroll
          for (int n = 0; n < 2; ++n)
            *(s16x4*)(hl + hx_w(16 * m + fr, 8 * wc + 4 * n + fq)) = pack4(acc[ai][bj][m][n] * (1.f / REPK));
        EPI_BAR();
        const unsigned R0 = u.pm * 256 + ai * 128 + wr * 64;
        const unsigned cb = u.pn * 256 + bj * 128;
#pragma unroll
        for (int i = 0; i < 4; ++i) {
          const int row = 16 * wc + 4 * i + (lane >> 4), c16 = lane & 15;
          const bf16x8 v = *(const bf16x8*)(hl + hx_r(row, c16));
          *(bf16x8*)(z + (R0 + row) * 1024u + cb + c16 * 8) = v;
        }
        EPI_BAR();
      }
  }
};

DI void ret_kv_item(const Params& p, int item, int tid) {
  const int lane = tid & 63, w = tid >> 6, r = lane & 31, hh = lane >> 5;
  const u16 *kT, *vT; int T, c;
  if (item < 2048) { const int bh = item >> 5; c = item & 31; T = 2048; kT = p.krT() + (size_t)bh * 128 * 2048; vT = p.vrT() + (size_t)bh * 128 * 2048; }
  else { const int bh = item - 2048; c = 0; T = 64; kT = p.krT() + (size_t)64 * 128 * 2048 + (size_t)bh * 128 * 64; vT = p.vrT() + (size_t)64 * 128 * 2048 + (size_t)bh * 128 * 64; }
  const int e0 = (w & 1) * 64, d0 = (w >> 1) * 64;
  f32x16 acc[2][2];
  acc[0][0] = zero16(); acc[0][1] = zero16(); acc[1][0] = zero16(); acc[1][1] = zero16();
#pragma unroll
  for (int ks = 0; ks < 4; ++ks) {
    bf16x8 a0 = ldg8(vT + (size_t)(e0 + r) * T + c * 64 + ks * 16 + hh * 8);
    bf16x8 a1 = ldg8(vT + (size_t)(e0 + 32 + r) * T + c * 64 + ks * 16 + hh * 8);
    bf16x8 b0 = ldg8(kT + (size_t)(d0 + r) * T + c * 64 + ks * 16 + hh * 8);
    bf16x8 b1 = ldg8(kT + (size_t)(d0 + 32 + r) * T + c * 64 + ks * 16 + hh * 8);
    acc[0][0] = MFMA32(a0, b0, acc[0][0]);
    acc[0][1] = MFMA32(a0, b1, acc[0][1]);
    acc[1][0] = MFMA32(a1, b0, acc[1][0]);
    acc[1][1] = MFMA32(a1, b1, acc[1][1]);
  }
  float* o = p.kvT() + (size_t)item * 16384;
#pragma unroll
  for (int a = 0; a < 2; ++a)
#pragma unroll
    for (int b = 0; b < 2; ++b)
#pragma unroll
      for (int i = 0; i < 16; ++i)
        o[(e0 + a * 32 + crow(i, hh)) * 128 + d0 + b * 32 + r] = acc[a][b][i];
}

template <int NS>
DI void select_query(const u16* krow, int nj, int lane, u64* dst) {
  unsigned key[NS];
#pragma unroll
  for (int j = 0; j < NS; ++j) { const unsigned k = krow[j * 64 + lane]; key[j] = (j < nj) ? k : 0u; }
  constexpr int NP = (NS + 1) / 2;
  unsigned pk[NP];
#pragma unroll
  for (int i = 0; i < NP; ++i) pk[i] = key[2 * i] | ((2 * i + 1 < NS ? key[2 * i + 1] : 0u) << 16);
  unsigned prefix = 0;
  int cntp = 0;
  const unsigned ones = 0x00010001u;
  for (int bit = 15; bit >= 0; --bit) {
    const unsigned cand = prefix | (1u << bit);
    const unsigned c1 = cand - 1u;
    const unsigned cv = c1 | (c1 << 16);
    unsigned acc0 = 0, acc1 = 0;
#pragma unroll
    for (int i = 0; i < NP; ++i) {
      unsigned d, m;
      asm("v_pk_sub_u16 %0, %1, %2 clamp" : "=v"(d) : "v"(pk[i]), "v"(cv));
      asm("v_pk_min_u16 %0, %1, %2" : "=v"(m) : "v"(d), "v"(ones));
      if (i & 1) acc1 += m; else acc0 += m;
    }
    const unsigned a = acc0 + acc1;
    const int cnt = wave_sum((int)((a & 0xffffu) + (a >> 16)));
    if (cnt >= 256) { prefix = cand; cntp = cnt; }
    if (cnt == 256) break;
  }
  int wlo = 0, whi = 0;
  if (cntp == 256) {
#pragma unroll
    for (int j = 0; j < NS; ++j) {
      const u64 sm = __ballot(key[j] >= prefix);
      if (lane == j) { wlo = (int)(unsigned)sm; whi = (int)(unsigned)(sm >> 32); }
    }
  } else {
    int cgt = 0;
#pragma unroll
    for (int j = 0; j < NS; ++j) cgt += (key[j] > prefix) ? 1 : 0;
    cgt = wave_sum(cgt);
    const int rneed = 256 - cgt;
    int running = 0;
    const u64 lt = (1ull << lane) - 1ull;
#pragma unroll
    for (int j = 0; j < NS; ++j) {
      const bool eq = key[j] == prefix;
      const u64 em = __ballot(eq);
      const int rank = running + __popcll(em & lt);
      const bool sel = (key[j] > prefix) || (eq && rank < rneed);
      const u64 sm = __ballot(sel);
      if (lane == j) { wlo = (int)(unsigned)sm; whi = (int)(unsigned)(sm >> 32); }
      running += __popcll(em);
    }
  }
  if (lane < nj) dst[lane] = ((u64)(unsigned)whi << 32) | (u64)(unsigned)wlo;
}

DI void idx_item(const Params& p, unsigned char* lds, int tid, bool samp, int b, int grp) {
  const int lane = tid & 63, w = tid >> 6;
  const int t0 = grp * 16;
  int L, g0; const u16* ki;
  if (!samp) { const int c = t0 >> 6; L = (c + 1) * 64; g0 = b * 2048 + t0; ki = p.kiP() + (size_t)b * 2048 * 64; }
  else { L = 2112; g0 = NPROMPT + b * 64 + t0; ki = p.kiS() + (size_t)b * 2112 * 64; }
  const int nj = L >> 6;
  if (L <= 256) {
    for (int qq = 0; qq < 4; ++qq) {
      const int q = w * 4 + qq;
      if (lane < nj) p.maskbits()[(size_t)(g0 + q) * 33 + lane] = ~0ull;
    }
    return;
  }
  u16* keys = (u16*)lds;
#ifndef REPMF
#define REPMF 1
#endif
#ifndef REPSEL
#define REPSEL 1
#endif
#ifndef REPKV
#define REPKV 1
#endif
  for (int rmf = 0; rmf < REPMF; ++rmf) {
    const int qn = lane & 15, quad = lane >> 4;
    bf16x8 qf[8][2];
    float wv[8];
#pragma unroll
    for (int h = 0; h < 8; ++h) {
      qf[h][0] = ldg8(p.qi() + (size_t)(g0 + qn) * 512 + h * 64 + quad * 8);
      qf[h][1] = ldg8(p.qi() + (size_t)(g0 + qn) * 512 + h * 64 + 32 + quad * 8);
      wv[h] = p.wi()[(size_t)(g0 + qn) * 8 + h];
    }
    bf16x8 A0[4], A1[4], N0[4], N1[4];
#pragma unroll
    for (int i = 0; i < 4; ++i) {
      const int kt = w + 4 * i;
      A0[i] = ldg8(ki + (size_t)(kt * 16 + qn) * 64 + quad * 8);
      A1[i] = ldg8(ki + (size_t)(kt * 16 + qn) * 64 + 32 + quad * 8);
    }
    for (int base = 0; base < nj; base += 4) {
#pragma unroll
      for (int i = 0; i < 4; ++i) {
        const int t = min(base + 4 + i, nj - 1);
        const int kt = w + 4 * t;
        N0[i] = ldg8(ki + (size_t)(kt * 16 + qn) * 64 + quad * 8);
        N1[i] = ldg8(ki + (size_t)(kt * 16 + qn) * 64 + 32 + quad * 8);
      }
#pragma unroll
      for (int i = 0; i < 4; ++i) {
        const int t = base + i;
        if (t < nj) {
          const int kt = w + 4 * t;
          float idx[4] = {0.f, 0.f, 0.f, 0.f};
#pragma unroll
          for (int h = 0; h < 8; ++h) {
            f32x4 acc = {0.f, 0.f, 0.f, 0.f};
            acc = MFMA16(A0[i], qf[h][0], acc);
            acc = MFMA16(A1[i], qf[h][1], acc);
#pragma unroll
            for (int e = 0; e < 4; ++e) idx[e] += fmaxf(acc[e], 0.f) * wv[h];
          }
          s16x4 kv;
#pragma unroll
          for (int e = 0; e < 4; ++e) {
            _Float16 hv = (_Float16)idx[e];
            u16 bits = __builtin_bit_cast(u16, hv);
            kv[e] = (short)((bits & 0x8000) ? (u16)~bits : (u16)(bits | 0x8000));
          }
          *(s16x4*)(keys + qn * KPITCH + kt * 16 + quad * 4) = kv;
        }
      }
#pragma unroll
      for (int i = 0; i < 4; ++i) { A0[i] = N0[i]; A1[i] = N1[i]; }
    }
  }
  __syncthreads();
  for (int qq = 0; qq < 4 * REPSEL; ++qq) {
    const int q = w * 4 + (qq & 3);
    const u16* krow = keys + q * KPITCH;
    u64* dst = p.maskbits() + (size_t)(g0 + q) * 33;
    if (nj <= 8) select_query<8>(krow, nj, lane, dst);
    else if (nj <= 16) select_query<16>(krow, nj, lane, dst);
    else if (nj <= 24) select_query<24>(krow, nj, lane, dst);
    else select_query<33>(krow, nj, lane, dst);
  }
  __syncthreads();
}

DI void scan_item(const Params& p, int item, int tid) {
  if (item < 1024) {
    const int bh = item >> 4, slab = item & 15;
    const int idx = slab * 1024 + tid * 4;
    const int h = bh & 3;
    const float cd = exp2f(64.f * log2gamma(h));
    f32x4 s = {0.f, 0.f, 0.f, 0.f};
    for (int c0 = 0; c0 < 32; c0 += 8) {
      f32x4 kvb[8];
#pragma unroll
      for (int i = 0; i < 8; ++i) kvb[i] = *(const f32x4*)(p.kvT() + (size_t)(bh * 32 + c0 + i) * 16384 + idx);
#pragma unroll
      for (int i = 0; i < 8; ++i) {
        *(s16x4*)(p.sprevT() + (size_t)(bh * 32 + c0 + i) * 16384 + idx) = pack4(s);
        s = s * cd + kvb[i];
      }
    }
    const int e = idx >> 7, d = idx & 127;
    float* o = p.out + OUT_STP + (size_t)bh * 16384;
#pragma unroll
    for (int j = 0; j < 4; ++j) o[(d + j) * 128 + e] = s[j];
  } else {
    const int it = item - 1024;
    const int bh = it >> 4, slab = it & 15;
    const int idx = slab * 1024 + tid * 4;
    const int h = bh & 3;
    const float cd = exp2f(64.f * log2gamma(h));
    const int e = idx >> 7, d = idx & 127;
    const float* s0 = p.state_ret + (size_t)bh * 16384;
    f32x4 s;
#pragma unroll
    for (int j = 0; j < 4; ++j) s[j] = s0[(d + j) * 128 + e];
    const size_t base = (size_t)(2048 + bh) * 16384 + idx;
    s16x4 o = pack4(s);
    *(s16x4*)(p.sprevT() + base) = o;
    f32x4 kv = *(const f32x4*)(p.kvT() + base);
    s = s * cd + kv;
    float* oo = p.out + OUT_STS + (size_t)bh * 16384;
#pragma unroll
    for (int j = 0; j < 4; ++j) oo[(d + j) * 128 + e] = s[j];
  }
}

DI void attn_item(const Params& p, unsigned char* lds, int tid, bool samp, int b, int c, int kvh, int qh) {
  const int lane = tid & 63, w = tid >> 6, r = lane & 31, hh = lane >> 5;
  const int T = samp ? 2112 : 2048;
  const int nkt = samp ? 33 : c + 1;
  const int g0 = (samp ? NPROMPT + b * 64 : b * 2048 + c * 64) + qh * 32;
  const u16* K = samp ? p.kaS() + (size_t)(b * 2 + kvh) * 2112 * 64 : p.kaP() + (size_t)(b * 2 + kvh) * 2048 * 64;
  const u16* VT = samp ? p.vaTS() + (size_t)(b * 2 + kvh) * 64 * 2112 : p.vaTP() + (size_t)(b * 2 + kvh) * 64 * 2048;
  const int head = kvh * 4 + w;
  u16* Ks = (u16*)lds;
  u16* Vs = Ks + 64 * 72;
  u64* mL = (u64*)(lds + 2 * 9216);
  {
    u64 mv[5];
#pragma unroll
    for (int i = 0; i < 5; ++i) { const int ix = tid + 256 * i; mv[i] = p.maskbits()[(size_t)g0 * 33 + (ix < 32 * 33 ? ix : 32 * 33 - 1)]; }
#pragma unroll
    for (int i = 0; i < 5; ++i) { const int ix = tid + 256 * i; if (ix < 32 * 33) mL[ix] = mv[i]; }
  }
  bf16x8 qf[4];
#pragma unroll
  for (int ks = 0; ks < 4; ++ks) qf[ks] = ldg8(p.qa() + (size_t)(g0 + r) * 512 + head * 64 + ks * 16 + hh * 8);
  f32x16 O[2];
  O[0] = zero16(); O[1] = zero16();
  float mrun = -1e30f, lrun = 0.f;
  const int lrow = tid >> 3, lch = tid & 7;
  bf16x8 pk0, pk1, pv0, pv1, nk0, nk1, nv0, nv1;
  pk0 = ldg8(K + (size_t)(lrow)*64 + lch * 8);
  pk1 = ldg8(K + (size_t)(lrow + 32) * 64 + lch * 8);
  pv0 = ldg8(VT + (size_t)(lrow)*T + lch * 8);
  pv1 = ldg8(VT + (size_t)(lrow + 32) * T + lch * 8);
  nk0 = pk0; nk1 = pk1; nv0 = pv0; nv1 = pv1;
  if (nkt > 1) {
    nk0 = ldg8(K + (size_t)(64 + lrow) * 64 + lch * 8);
    nk1 = ldg8(K + (size_t)(64 + lrow + 32) * 64 + lch * 8);
    nv0 = ldg8(VT + (size_t)(lrow)*T + 64 + lch * 8);
    nv1 = ldg8(VT + (size_t)(lrow + 32) * T + 64 + lch * 8);
  }
  for (int kt = 0; kt < nkt; ++kt) {
    __syncthreads();
    *(bf16x8*)(Ks + lrow * 72 + lch * 8) = pk0;
    *(bf16x8*)(Ks + (lrow + 32) * 72 + lch * 8) = pk1;
    *(bf16x8*)(Vs + lrow * 72 + lch * 8) = pv0;
    *(bf16x8*)(Vs + (lrow + 32) * 72 + lch * 8) = pv1;
    __syncthreads();
    pk0 = nk0; pk1 = nk1; pv0 = nv0; pv1 = nv1;
    if (kt + 2 < nkt) {
      nk0 = ldg8(K + (size_t)((kt + 2) * 64 + lrow) * 64 + lch * 8);
      nk1 = ldg8(K + (size_t)((kt + 2) * 64 + lrow + 32) * 64 + lch * 8);
      nv0 = ldg8(VT + (size_t)(lrow)*T + (kt + 2) * 64 + lch * 8);
      nv1 = ldg8(VT + (size_t)(lrow + 32) * T + (kt + 2) * 64 + lch * 8);
    }
    f32x16 S[2];
#pragma unroll
    for (int st = 0; st < 2; ++st) {
      S[st] = zero16();
#pragma unroll
      for (int ks = 0; ks < 4; ++ks) {
        bf16x8 kf = *(const bf16x8*)(Ks + (st * 32 + r) * 72 + ks * 16 + hh * 8);
        S[st] = MFMA32(kf, qf[ks], S[st]);
      }
    }
    const u64 W = mL[r * 33 + kt];
    const int wl = (int)(((unsigned)W) >> (4 * hh)), wh = (int)(((unsigned)(W >> 32)) >> (4 * hh));
    float mx = fmaxf(S[0][0], S[1][0]);
#pragma unroll
    for (int i = 1; i < 16; ++i) mx = fmaxf(mx, fmaxf(S[0][i], S[1][i]));
    mx = fmaxf(mx, __shfl_xor(mx, 32));
    const float mn = fmaxf(mrun, mx);
    const float alpha = __builtin_amdgcn_exp2f(mrun - mn);
    const bool resc = __any(mn != mrun);
    mrun = mn;
    float ls = 0.f;
#pragma unroll
    for (int st = 0; st < 2; ++st)
#pragma unroll
      for (int i = 0; i < 16; ++i) {
        const int keep = __builtin_amdgcn_sbfe(st ? wh : wl, (i & 3) + 8 * (i >> 2), 1);
        const float pvv = __int_as_float(__float_as_int(__builtin_amdgcn_exp2f(S[st][i] - mn)) & keep);
        S[st][i] = pvv;
        ls += pvv;
      }
    lrun = lrun * alpha + ls;
    if (resc) {
#pragma unroll
      for (int dt = 0; dt < 2; ++dt)
#pragma unroll
        for (int i = 0; i < 16; ++i) O[dt][i] *= alpha;
    }
#pragma unroll
    for (int st = 0; st < 2; ++st)
#pragma unroll
      for (int s2 = 0; s2 < 2; ++s2) {
        bf16x8 pf = pack8(S[st][8 * s2 + 0], S[st][8 * s2 + 1], S[st][8 * s2 + 2], S[st][8 * s2 + 3],
                          S[st][8 * s2 + 4], S[st][8 * s2 + 5], S[st][8 * s2 + 6], S[st][8 * s2 + 7]);
#pragma unroll
        for (int dt = 0; dt < 2; ++dt) {
          s16x4 lo = *(const s16x4*)(Vs + (dt * 32 + r) * 72 + st * 32 + 16 * s2 + 4 * hh);
          s16x4 hi = *(const s16x4*)(Vs + (dt * 32 + r) * 72 + st * 32 + 16 * s2 + 8 + 4 * hh);
          bf16x8 vf = __builtin_shufflevector(lo, hi, 0, 1, 2, 3, 4, 5, 6, 7);
          O[dt] = MFMA32(vf, pf, O[dt]);
        }
      }
  }
  {
    float lt = lrun + __shfl_xor(lrun, 32);
    const float inv = 1.f / lt;
    const u16* grow = p.gate() + (size_t)(g0 + r) * 1024 + 512 + head * 64;
    u16* mrow = p.mix() + (size_t)(g0 + r) * 1024 + 512 + head * 64;
    s16x4 gvv[2][4];
#pragma unroll
    for (int dt = 0; dt < 2; ++dt)
#pragma unroll
      for (int q4 = 0; q4 < 4; ++q4) gvv[dt][q4] = *(const s16x4*)(grow + dt * 32 + 8 * q4 + 4 * hh);
#pragma unroll
    for (int dt = 0; dt < 2; ++dt)
#pragma unroll
      for (int q4 = 0; q4 < 4; ++q4) {
        const int d = dt * 32 + 8 * q4 + 4 * hh;
        f32x4 of;
#pragma unroll
        for (int j = 0; j < 4; ++j) {
          const float gf = __uint_as_float(((unsigned)(u16)gvv[dt][q4][j]) << 16);
          of[j] = O[dt][q4 * 4 + j] * inv * gf;
        }
        *(s16x4*)(mrow + d) = pack4(of);
      }
  }
  __syncthreads();
}

DI void ret_out_item(const Params& p, unsigned char* lds, int item, int tid) {
  const int lane = tid & 63, w = tid >> 6, r = lane & 31, hh = lane >> 5;
  int bh, c, T, g0; const u16* vT;
  if (item < 2048) { bh = item >> 5; c = item & 31; T = 2048; g0 = (bh >> 2) * 2048 + c * 64; vT = p.vrT() + (size_t)bh * 128 * 2048; }
  else { bh = item - 2048; c = 0; T = 64; g0 = NPROMPT + (bh >> 2) * 64; vT = p.vrT() + (size_t)64 * 128 * 2048 + (size_t)bh * 128 * 64; }
  const int h = bh & 3;
  const float l2g = log2gamma(h);
  const int nt = w & 1, eh = w >> 1;
  const int n = nt * 32 + r;
  bf16x8 qf[8], kf[8];
#pragma unroll
  for (int ks = 0; ks < 8; ++ks) qf[ks] = ldg8(p.qr() + (size_t)(g0 + n) * 512 + h * 128 + ks * 16 + hh * 8);
#pragma unroll
  for (int ks = 0; ks < 8; ++ks) kf[ks] = ldg8(p.kr() + (size_t)(g0 + r) * 512 + h * 128 + ks * 16 + hh * 8);
  __builtin_amdgcn_sched_barrier(0);
  bf16x8 pf[2][2];
#pragma unroll
  for (int mt = 0; mt < 2; ++mt) {
    f32x16 S = zero16();
#pragma unroll
    for (int ks = 0; ks < 8; ++ks) S = MFMA32(kf[ks], qf[ks], S);
    if (mt == 0) {
#pragma unroll
      for (int ks = 0; ks < 8; ++ks) kf[ks] = ldg8(p.kr() + (size_t)(g0 + 32 + r) * 512 + h * 128 + ks * 16 + hh * 8);
      __builtin_amdgcn_sched_barrier(0);
    }
#pragma unroll
    for (int i = 0; i < 16; ++i) {
      const int m = mt * 32 + crow(i, hh);
      const int dd = n > m ? n - m : m - n;
      S[i] *= exp2f((float)dd * l2g);
    }
    pf[mt][0] = pack8(S[0], S[1], S[2], S[3], S[4], S[5], S[6], S[7]);
    pf[mt][1] = pack8(S[8], S[9], S[10], S[11], S[12], S[13], S[14], S[15]);
  }
  const float fs = exp2f((float)(n + 1) * l2g);
  const u16* sp = p.sprevT() + (size_t)item * 16384;
  f32x16 tot[2];
  float ss = 0.f;
  s16x4 vlo[2][2][2], vhi[2][2][2];
#pragma unroll
  for (int et = 0; et < 2; ++et)
#pragma unroll
    for (int mt = 0; mt < 2; ++mt)
#pragma unroll
      for (int s2 = 0; s2 < 2; ++s2) {
        const u16* vp = vT + (size_t)((2 * eh + et) * 32 + r) * T + c * 64 + mt * 32 + 16 * s2 + 4 * hh;
        vlo[et][mt][s2] = ldg4(vp); vhi[et][mt][s2] = ldg4(vp + 8);
      }
  __builtin_amdgcn_sched_barrier(0);
#pragma unroll
  for (int et = 0; et < 2; ++et) {
    const int e = (2 * eh + et) * 32 + r;
    bf16x8 sf[8];
#pragma unroll
    for (int ks = 0; ks < 8; ++ks) sf[ks] = ldg8(sp + (size_t)e * 128 + ks * 16 + hh * 8);
    __builtin_amdgcn_sched_barrier(0);
    f32x16 Oi = zero16(), X = zero16();
#pragma unroll
    for (int mt = 0; mt < 2; ++mt)
#pragma unroll
      for (int s2 = 0; s2 < 2; ++s2) {
        bf16x8 vf = __builtin_shufflevector(vlo[et][mt][s2], vhi[et][mt][s2], 0, 1, 2, 3, 4, 5, 6, 7);
        Oi = MFMA32(vf, pf[mt][s2], Oi);
      }
#pragma unroll
    for (int ks = 0; ks < 8; ++ks) X = MFMA32(sf[ks], qf[ks], X);
#pragma unroll
    for (int i = 0; i < 16; ++i) { const float t = Oi[i] + X[i] * fs; tot[et][i] = t; ss += t * t; }
  }
  ss += __shfl_xor(ss, 32);
  float* red = (float*)lds;
  __syncthreads();
  if (hh == 0) red[w * 32 + r] = ss;
  __syncthreads();
  const float tsum = red[w * 32 + r] + red[(w ^ 2) * 32 + r];
  const float rinv = rsqrtf(tsum * (1.f / 128.f) + 1e-6f);
  const u16* grow = p.gate() + (size_t)(g0 + n) * 1024 + h * 128;
  u16* mrow = p.mix() + (size_t)(g0 + n) * 1024 + h * 128;
  s16x4 gvv[2][4];
  f32x4 ggv[2][4];
#pragma unroll
  for (int et = 0; et < 2; ++et)
#pragma unroll
    for (int q4 = 0; q4 < 4; ++q4) {
      const int e = (2 * eh + et) * 32 + 8 * q4 + 4 * hh;
      gvv[et][q4] = *(const s16x4*)(grow + e);
      ggv[et][q4] = *(const f32x4*)(p.ret_gn_g + h * 128 + e);
    }
#pragma unroll
  for (int et = 0; et < 2; ++et)
#pragma unroll
    for (int q4 = 0; q4 < 4; ++q4) {
      const int e = (2 * eh + et) * 32 + 8 * q4 + 4 * hh;
      f32x4 of;
#pragma unroll
      for (int j = 0; j < 4; ++j) {
        const float gf = __uint_as_float(((unsigned)(u16)gvv[et][q4][j]) << 16);
        of[j] = tot[et][q4 * 4 + j] * rinv * ggv[et][q4][j] * gf;
      }
      *(s16x4*)(mrow + e) = pack4(of);
    }
}

DI void phase_final(const Params& p, int tid) {
  const int gt = blockIdx.x * 512 + tid, GT = gridDim.x * 512;
  const int lane = tid & 63;
  for (int row0 = (gt >> 6) * 2; row0 < NTOK; row0 += (GT >> 6) * 2) {
    f32x4 v[2][4];
    s16x4 zz[2][4];
#pragma unroll
    for (int rr = 0; rr < 2; ++rr) {
      const float* xr = xrow(p, row0 + rr);
      const u16* zr = p.gate() + (size_t)(row0 + rr) * 1024;
#pragma unroll
      for (int i = 0; i < 4; ++i) { v[rr][i] = *(const f32x4*)(xr + i * 256 + lane * 4); zz[rr][i] = *(const s16x4*)(zr + i * 256 + lane * 4); }
    }
    f32x4 g[4];
#pragma unroll
    for (int i = 0; i < 4; ++i) g[i] = *(const f32x4*)(p.final_g + i * 256 + lane * 4);
#pragma unroll
    for (int rr = 0; rr < 2; ++rr) {
      float ss = 0.f;
#pragma unroll
      for (int i = 0; i < 4; ++i) {
#pragma unroll
        for (int j = 0; j < 4; ++j) v[rr][i][j] += __uint_as_float(((unsigned)(u16)zz[rr][i][j]) << 16);
        ss += v[rr][i][0] * v[rr][i][0] + v[rr][i][1] * v[rr][i][1] + v[rr][i][2] * v[rr][i][2] + v[rr][i][3] * v[rr][i][3];
      }
#pragma unroll
      for (int o = 32; o >= 1; o >>= 1) ss += __shfl_xor(ss, o);
      const float rv = rsqrtf(ss * (1.f / 1024.f) + 1e-6f);
      float* y = p.out + OUT_Y + (size_t)(row0 + rr) * 1024;
#pragma unroll
      for (int i = 0; i < 4; ++i) *(f32x4*)(y + i * 256 + lane * 4) = v[rr][i] * rv * g[i];
    }
  }
}

#ifndef REP0
#define REP0 1
#endif
#ifndef REP1
#define REP1 1
#endif
#ifndef REP2
#define REP2 1
#endif
#ifndef REP3
#define REP3 1
#endif
#ifndef REP4
#define REP4 1
#endif
#ifndef REP5
#define REP5 1
#endif
__global__ void __launch_bounds__(512, 2) fwd_megakernel(Params p) {
  __shared__ __attribute__((aligned(16))) unsigned char lds[LDS_BYTES];
  cg::grid_group grid = cg::this_grid();
  const int wave_id = __builtin_amdgcn_readfirstlane((int)threadIdx.x >> 6);
#define FRESH_TID() int tid = wave_id * 64 + lane_id(); asm volatile("" : "+v"(tid)); const int half = tid >> 8, htid = tid & 255; unsigned char* ldsh = lds + half * HALF_LDS; (void)htid; (void)ldsh;
  if (p.out == nullptr) grid.sync();
  if (wave_id == 0 && lane_id() == 0) (void)xb_add(&p.bar()[XB_XCNT(xb_xcc_id())], 1u);
  for (int rep = 0; rep < REP0; ++rep) {
  { FRESH_TID(); phase_prep(p, tid); }
  xcd_barrier(p.bar(), wave_id);
  }
  for (int rep = 0; rep < REP1; ++rep) {
  {
    FRESH_TID();
    pg8::Gemm g; g.A = p.xb(); g.Bt = p.WtIn(); g.M = NTOK; g.N = 4096; g.K = 1024;
    pg8::StaticOrder S; S.init(g.M, g.N, (int)gridDim.x, (int)blockIdx.x); S.permtab = 0xEFBCD87694105A32ull;
    Epi1 E; E.p = p; E.hl0 = (LAS unsigned char*)lds + pg8::STAGE_BYTES;
    pg8::gemm_phase<Epi1>((LAS unsigned char*)lds, g, S, E, wave_id);
  }
  xcd_barrier(p.bar(), wave_id);
  }
  for (int rep = 0; rep < REP2; ++rep) {
  {
    FRESH_TID();
    for (int it0 = blockIdx.x * 2; it0 < 2080 + 2080; it0 += gridDim.x * 2) {
      const int it = it0 + half;
      int ht = htid; asm volatile("" : "+v"(ht));
      if (it < 2080) {
        const bool samp = it < 32;
        const int j = it - 32;
        const int c = 31 - (j >> 6);
        const int b = samp ? (it >> 2) : ((j & 63) >> 2);
        const int grp = samp ? (it & 3) : (c * 4 + (j & 3));
        idx_item(p, ldsh, ht, samp, b, grp);
      } else { for (int rkv = 0; rkv < REPKV; ++rkv) ret_kv_item(p, it - 2080, ht); }
    }
  }
  xcd_barrier(p.bar(), wave_id);
  }
  for (int rep = 0; rep < REP3; ++rep) {
  {
    FRESH_TID();
    for (int it0 = blockIdx.x * 2; it0 < 1056 + 1536; it0 += gridDim.x * 2) {
      const int it = it0 + half;
      int ht = htid; asm volatile("" : "+v"(ht));
      if (it < 1056) {
        const bool samp = it < 32;
        const int j = it - 32;
        int c = samp ? 0 : 31 - (j >> 6);
        int b = samp ? (it >> 2) : ((j & 63) >> 2);
        int kvh = (it >> 1) & 1;
        if (!samp && gridDim.x == 256) {
          const int jb = (j >> 1) & 255, rnd = j >> 9;
          const int xcd = jb & 7, ii = jb >> 3;
          b = 2 * xcd + (ii & 1); kvh = (ii >> 1) & 1; c = 31 - rnd * 8 - (ii >> 2);
        }
        attn_item(p, ldsh, ht, samp, b, c, kvh, it & 1);
      } else scan_item(p, it - 1056, ht);
    }
  }
  xcd_barrier(p.bar(), wave_id);
  }
  for (int rep = 0; rep < REP4; ++rep) {
  {
    FRESH_TID();
    for (int it0 = blockIdx.x * 2; it0 < 2080 + 1024; it0 += gridDim.x * 2) {
      const int it = it0 + half;
      int ht = htid; asm volatile("" : "+v"(ht));
      if (it < 2080) ret_out_item(p, ldsh, it, ht);
      else {
        const int ia = it - 2080 + 1056;
        const int j = ia - 32;
        int c = 31 - (j >> 6);
        int b = (j & 63) >> 2;
        int kvh = (ia >> 1) & 1;
        if (gridDim.x == 256) {
          const int jb = (j >> 1) & 255, rnd = j >> 9;
          const int xcd = jb & 7, ii = jb >> 3;
          b = 2 * xcd + (ii & 1); kvh = (ii >> 1) & 1; c = 31 - rnd * 8 - (ii >> 2);
        }
        attn_item(p, ldsh, ht, false, b, c, kvh, ia & 1);
      }
    }
  }
  xcd_barrier(p.bar(), wave_id);
  }
  for (int rep = 0; rep < REP5; ++rep) {
  {
    pg8::Gemm g; g.A = p.mix(); g.Bt = p.WtOut(); g.M = NTOK; g.N = 1024; g.K = 1024;
    pg8::StaticOrder S; S.init(g.M, g.N, (int)gridDim.x, (int)blockIdx.x);
    Epi2 E; E.p = p; E.hl = lds + pg8::STAGE_BYTES + (wave_id >> 2) * 16384;
    pg8::gemm_phase<Epi2>((LAS unsigned char*)lds, g, S, E, wave_id);
  }
  xcd_barrier(p.bar(), wave_id);
  }
  { FRESH_TID(); phase_final(p, tid); }
}

extern "C" void kernel_launch(void* const* d_in, const int* in_sizes, int n_in, void* d_out, int out_size, void* d_ws,
                              size_t ws_size, hipStream_t stream) {
  static int grid_blocks = 0;
  if (!grid_blocks) {
    int dev = 0, cus = 0, per_cu = 0;
    (void)hipGetDevice(&dev);
    (void)hipDeviceGetAttribute(&cus, hipDeviceAttributeMultiprocessorCount, dev);
    (void)hipOccupancyMaxActiveBlocksPerMultiprocessor(&per_cu, fwd_megakernel, 512, 0);
    if (per_cu < 1) per_cu = 1;
    if (per_cu > 1) per_cu = 1;
    grid_blocks = cus * per_cu;
  }
  Params p{};
  p.x_p = (const float*)d_in[0]; p.x_s = (const float*)d_in[1]; p.state_ret = (const float*)d_in[2];
  p.cache_k = (const float*)d_in[3]; p.cache_v = (const float*)d_in[4]; p.cache_kidx = (const float*)d_in[5];
  p.norm_g = (const float*)d_in[6]; p.w_in = (const float*)d_in[7]; p.ret_gn_g = (const float*)d_in[8];
  p.w_out = (const float*)d_in[9]; p.final_g = (const float*)d_in[10];
  p.out = (float*)d_out;
  p.ws = (unsigned char*)d_ws;
  (void)hipMemsetAsync((unsigned char*)d_ws + 530573312ull, 0, (size_t)XCD_BAR_WORDS * 4, stream);
  void* args[] = {&p};
  hipError_t e = hipLaunchCooperativeKernel((void*)fwd_megakernel, dim3(grid_blocks), dim3(512), args, 0, stream);
  if (e != hipSuccess) fprintf(stderr, "cooperative launch failed: %s (grid %d)\n", hipGetErrorString(e), grid_blocks);
}
```

```cpp
#include <hip/hip_runtime.h>
#include <hip/hip_cooperative_groups.h>
#include <stdint.h>
#include <cstdio>
namespace cg = cooperative_groups;

typedef __attribute__((ext_vector_type(8))) short bf16x8;
typedef __attribute__((ext_vector_type(4))) short s16x4;
typedef __attribute__((ext_vector_type(16))) float f32x16;
typedef __attribute__((ext_vector_type(4))) float f32x4;
typedef unsigned short u16;
typedef unsigned long long u64;


#define DI __device__ __forceinline__
#define MFMA32(a, b, c) __builtin_amdgcn_mfma_f32_32x32x16_bf16((a), (b), (c), 0, 0, 0)
#define MFMA16(a, b, c) __builtin_amdgcn_mfma_f32_16x16x32_bf16((a), (b), (c), 0, 0, 0)

#define NTOK 33280
#define NPROMPT 32768
#define LDS_BYTES 163840
#define HALF_LDS 81920
#define LAS __attribute__((address_space(3)))
#define KPITCH 2116

struct Params {
  const float *x_p, *x_s, *state_ret, *cache_k, *cache_v, *cache_kidx, *norm_g, *w_in, *ret_gn_g, *w_out, *final_g;
  float* out;
  unsigned char* ws;
  DI u16* xb() const { return (u16*)(ws + 0ull); }
  DI float* kvT() const { return (float*)(ws + 0ull); }
  DI u16* WtIn() const { return (u16*)(ws + 136314880ull); }
  DI u16* WtOut() const { return (u16*)(ws + 144703488ull); }
  DI u16* qr() const { return (u16*)(ws + 146800640ull); }
  DI u16* kr() const { return (u16*)(ws + 180879360ull); }
  DI u16* sprevT() const { return (u16*)(ws + 214958080ull); }
  DI u16* qi() const { return (u16*)(ws + 214958080ull); }
  DI u16* krT() const { return (u16*)(ws + 249036800ull); }
  DI u16* vrT() const { return (u16*)(ws + 283115520ull); }
  DI u16* gate() const { return (u16*)(ws + 317194240ull); }
  DI u16* mix() const { return (u16*)(ws + 385351680ull); }
  DI u16* qa() const { return (u16*)(ws + 453509120ull); }
  DI u16* kaP() const { return (u16*)(ws + 487587840ull); }
  DI u16* kaS() const { return (u16*)(ws + 495976448ull); }
  DI u16* vaTP() const { return (u16*)(ws + 500301824ull); }
  DI u16* vaTS() const { return (u16*)(ws + 508690432ull); }
  DI u16* kiP() const { return (u16*)(ws + 513015808ull); }
  DI u16* kiS() const { return (u16*)(ws + 517210112ull); }
  DI float* rinv() const { return (float*)(ws + 519372800ull); }
  DI float* wi() const { return (float*)(ws + 519505920ull); }
  DI float* cosR() const { return (float*)(ws + 520570880ull); }
  DI float* sinR() const { return (float*)(ws + 521111552ull); }
  DI float* cosA() const { return (float*)(ws + 521652224ull); }
  DI float* sinA() const { return (float*)(ws + 521719808ull); }
  DI unsigned* bar() const { return (unsigned*)(ws + 530573312ull); }
  DI u64* maskbits() const { return (u64*)(ws + 521787392ull); }
};

#define OUT_Y 0
#define OUT_STP (34078720)
#define OUT_KP (OUT_STP + 1048576)
#define OUT_VP (OUT_KP + 4194304)
#define OUT_KIP (OUT_VP + 4194304)
#define OUT_STS (OUT_KIP + 2097152)
#define OUT_KS (OUT_STS + 524288)
#define OUT_VS (OUT_KS + 65536)
#define OUT_KIS (OUT_VS + 65536)

typedef __bf16 bf16x2_t __attribute__((ext_vector_type(2)));
typedef float f32x2_t __attribute__((ext_vector_type(2)));
typedef unsigned u32x4_t __attribute__((ext_vector_type(4)));
typedef unsigned u32x2_t __attribute__((ext_vector_type(2)));
DI unsigned pk2(float a, float b) { f32x2_t v = {a, b}; bf16x2_t r = __builtin_convertvector(v, bf16x2_t); return __builtin_bit_cast(unsigned, r); }
DI u16 f2bf(float x) { return (u16)(pk2(x, x) & 0xffffu); }
DI bf16x8 ldg8(const u16* p) { return *(const bf16x8*)p; }
DI s16x4 ldg4(const u16* p) { return *(const s16x4*)p; }
DI float siluf(float x) { return x * __builtin_amdgcn_rcpf(1.f + __builtin_amdgcn_exp2f(-1.4426950408889634f * x)); }
DI int lane_id() { return (int)__builtin_amdgcn_mbcnt_hi(~0u, __builtin_amdgcn_mbcnt_lo(~0u, 0u)); }
DI int crow(int reg, int hh) { return (reg & 3) + 8 * (reg >> 2) + 4 * hh; }
DI const float* xrow(const Params& p, int g) { return g < NPROMPT ? p.x_p + (size_t)g * 1024 : p.x_s + (size_t)(g - NPROMPT) * 1024; }
DI float log2gamma(int h) { return log1pf(-exp2f(-5.f - (float)h)) * 1.4426950408889634f; }
DI bf16x8 pack8(float a0, float a1, float a2, float a3, float a4, float a5, float a6, float a7) {
  u32x4_t v = {pk2(a0, a1), pk2(a2, a3), pk2(a4, a5), pk2(a6, a7)};
  return __builtin_bit_cast(bf16x8, v);
}
DI s16x4 pack4(f32x4 v) { u32x2_t o = {pk2(v[0], v[1]), pk2(v[2], v[3])}; return __builtin_bit_cast(s16x4, o); }
DI int wave_sum(int v) {
  v += __builtin_amdgcn_update_dpp(0, v, 0xB1, 0xf, 0xf, false);
  v += __builtin_amdgcn_update_dpp(0, v, 0x4E, 0xf, 0xf, false);
  v += __builtin_amdgcn_update_dpp(0, v, 0x124, 0xf, 0xf, false);
  v += __builtin_amdgcn_update_dpp(0, v, 0x128, 0xf, 0xf, false);
  return __builtin_amdgcn_readlane(v, 0) + __builtin_amdgcn_readlane(v, 16) + __builtin_amdgcn_readlane(v, 32) + __builtin_amdgcn_readlane(v, 48);
}
DI f32x16 zero16() { f32x16 z; for (int i = 0; i < 16; ++i) z[i] = 0.f; return z; }

#define XB_TMO      128
#define XB_XCNT(j)  (256  + 64 * (j))
#define XB_XSUB(j)  (1280 + 64 * (j))
#define XB_XGEN(j)  (2304 + 64 * (j))
#define XB_TOP      3328
#define XB_TOPGEN   3392
#define XB_WG(i)    (3456 + 64 * (i))
#define XCD_BAR_WORDS (3456 + 64 * 256)
#define XB_SPIN_CAP (1u << 18)
DI unsigned xb_ld(unsigned* p) { return __hip_atomic_load(p, __ATOMIC_RELAXED, __HIP_MEMORY_SCOPE_AGENT); }
DI unsigned xb_add(unsigned* p, unsigned v) { return __hip_atomic_fetch_add(p, v, __ATOMIC_RELAXED, __HIP_MEMORY_SCOPE_AGENT); }
DI unsigned xb_xcc_id() { return (unsigned)__builtin_amdgcn_s_getreg((3 << 11) | 20) & 0xFu; }
#define XB_SPIN(cond, bar) do { unsigned _sp = 0; while (cond) { __builtin_amdgcn_s_sleep(1); \
    if ((++_sp & 255u) == 0u) { if (xb_ld(&(bar)[XB_TMO])) break; if (_sp > XB_SPIN_CAP) { atomicAdd(&(bar)[XB_TMO], 1u); break; } } } } while (0)
DI void xcd_barrier(unsigned* bar, int wave_id) {
  asm volatile("s_waitcnt vmcnt(0)" ::: "memory");
  __syncthreads();
  if (wave_id == 0) {
    const int lane = lane_id();
    const unsigned x = xb_xcc_id();
    unsigned* slot = &bar[XB_WG(blockIdx.x)];
    unsigned nloc = 0u, nx = 0u;
    if (lane < 2) nloc = xb_ld(slot + lane);
    nx = (unsigned)__builtin_amdgcn_readlane((int)nloc, 1);
    nloc = (unsigned)__builtin_amdgcn_readlane((int)nloc, 0);
    if (nloc == 0u) {
      const unsigned G = gridDim.x * gridDim.y * gridDim.z;
      unsigned sp = 0u, c = 0u;
      for (;;) {
        c = (lane < 16) ? xb_ld(&bar[XB_XCNT(lane)]) : 0u;
        const unsigned sum = (unsigned)wave_sum((int)c);
        if (sum == G) break;
        __builtin_amdgcn_s_sleep(1);
        if ((++sp & 255u) == 0u) { if (xb_ld(&bar[XB_TMO])) break; if (sp > XB_SPIN_CAP) { if (lane == 0) atomicAdd(&bar[XB_TMO], 1u); break; } }
      }
      nx = (unsigned)__popcll(__ballot(c > 0u));
      nloc = (unsigned)__builtin_amdgcn_readlane((int)c, (int)x);
      nloc = nloc > 0u ? nloc : 1u; nx = nx > 0u ? nx : 1u;
      if (lane == 0) { __hip_atomic_store(slot, nloc, __ATOMIC_RELAXED, __HIP_MEMORY_SCOPE_AGENT); __hip_atomic_store(slot + 1, nx, __ATOMIC_RELAXED, __HIP_MEMORY_SCOPE_AGENT); }
    }
    if (lane == 0) {
      __builtin_amdgcn_s_waitcnt(0);
      const unsigned old = xb_add(&bar[XB_XSUB(x)], 1u);
      const unsigned gen = old / nloc;
      if (old + 1u == (gen + 1u) * nloc) {
        __builtin_amdgcn_fence(__ATOMIC_RELEASE, "agent");
        asm volatile("s_waitcnt vmcnt(0)" ::: "memory");
        const unsigned og = xb_add(&bar[XB_TOP], 1u);
        const unsigned tg = og / nx;
        if (og + 1u == (tg + 1u) * nx) xb_add(&bar[XB_TOPGEN], 1u);
        else XB_SPIN(xb_ld(&bar[XB_TOPGEN]) == tg, bar);
        __builtin_amdgcn_fence(__ATOMIC_ACQUIRE, "agent");
        xb_add(&bar[XB_XGEN(x)], 1u);
        asm volatile("s_waitcnt vmcnt(0)" ::: "memory");
      } else {
        XB_SPIN(xb_ld(&bar[XB_XGEN(x)]) == gen, bar);
        __builtin_amdgcn_fence(__ATOMIC_ACQUIRE, "agent");
        asm volatile("s_waitcnt vmcnt(0)" ::: "memory");
      }
    }
  }
  __syncthreads();
}

DI void phase_prep(const Params& p, int tid) {
  const int gt = blockIdx.x * 512 + tid, GT = gridDim.x * 512;
  const int lane = tid & 63;
  for (int row0 = (gt >> 6) * 2; row0 < NTOK; row0 += (GT >> 6) * 2) {
    f32x4 v[2][4];
#pragma unroll
    for (int rr = 0; rr < 2; ++rr) {
      const float* sp = xrow(p, row0 + rr);
#pragma unroll
      for (int i = 0; i < 4; ++i) v[rr][i] = *(const f32x4*)(sp + i * 256 + lane * 4);
    }
#pragma unroll
    for (int rr = 0; rr < 2; ++rr) {
      float ss = 0.f;
#pragma unroll
      for (int i = 0; i < 4; ++i) ss += v[rr][i][0] * v[rr][i][0] + v[rr][i][1] * v[rr][i][1] + v[rr][i][2] * v[rr][i][2] + v[rr][i][3] * v[rr][i][3];
#pragma unroll
      for (int o = 32; o >= 1; o >>= 1) ss += __shfl_xor(ss, o);
#pragma unroll
      for (int i = 0; i < 4; ++i) *(s16x4*)(p.xb() + (size_t)(row0 + rr) * 1024 + i * 256 + lane * 4) = pack4(v[rr][i]);
      if (lane == 0) p.rinv()[row0 + rr] = rsqrtf(ss * (1.f / 1024.f) + 1e-6f);
    }
  }
  for (int i = gt; i < 4096 * 128; i += GT) {
    int n = i & 4095, kg = i >> 12;
    int sc = n;
    if (n < 1024) { const int P = n & 127; sc = (n & ~127) + 64 * ((P >> 4) & 1) + 16 * (P >> 5) + (P & 15); }
    float a[8];
    const float vmask = (n < 3912) ? 1.f : 0.f; const int scc = (sc < 3912) ? sc : 3911;
#pragma unroll
    for (int j = 0; j < 8; ++j) a[j] = p.w_in[(size_t)(kg * 8 + j) * 3912 + scc] * p.norm_g[kg * 8 + j] * vmask;
    *(bf16x8*)(p.WtIn() + (size_t)n * 1024 + kg * 8) = pack8(a[0], a[1], a[2], a[3], a[4], a[5], a[6], a[7]);
  }
  for (int i = gt; i < 1024 * 128; i += GT) {
    int n = i % 1024, kg = i / 1024;
    float a[8];
#pragma unroll
    for (int j = 0; j < 8; ++j) a[j] = p.w_out[(size_t)(kg * 8 + j) * 1024 + n];
    *(bf16x8*)(p.WtOut() + (size_t)n * 1024 + kg * 8) = pack8(a[0], a[1], a[2], a[3], a[4], a[5], a[6], a[7]);
  }
  for (int i = gt; i < 2112 * 64; i += GT) {
    int pos = i >> 6, k = i & 63;
    float inv = powf(10000.f, -(float)k / 64.f);
    float ang = (float)pos * inv;
    p.cosR()[i] = cosf(ang); p.sinR()[i] = sinf(ang);
  }
  for (int i = gt; i < 2112 * 8; i += GT) {
    int pos = i >> 3, k = i & 7;
    float inv = powf(500000.f, -(float)k / 8.f);
    float ang = (float)pos * inv;
    p.cosA()[i] = cosf(ang); p.sinA()[i] = sinf(ang);
  }
  for (int i = gt; i < 8 * 2048 * 2 * 8; i += GT) {
    int dg = i & 7, kvh = (i >> 3) & 1, t = (i >> 4) & 2047, b = i >> 15;
    const float* s = p.cache_k + ((size_t)(b * 2048 + t) * 2 + kvh) * 64 + dg * 8;
    *(bf16x8*)(p.kaS() + ((size_t)(b * 2 + kvh) * 2112 + t) * 64 + dg * 8) = pack8(s[0], s[1], s[2], s[3], s[4], s[5], s[6], s[7]);
  }
  for (int i = gt; i < 8 * 2 * 256 * 64; i += GT) {
    int d = i & 63, tg = (i >> 6) & 255, kvh = (i >> 14) & 1, b = i >> 15;
    float a[8];
#pragma unroll
    for (int j = 0; j < 8; ++j) a[j] = p.cache_v[((size_t)(b * 2048 + tg * 8 + j) * 2 + kvh) * 64 + d];
    *(bf16x8*)(p.vaTS() + ((size_t)(b * 2 + kvh) * 64 + d) * 2112 + tg * 8) = pack8(a[0], a[1], a[2], a[3], a[4], a[5], a[6], a[7]);
  }
  for (int i = gt; i < 8 * 2048 * 8; i += GT) {
    int dg = i & 7, t = (i >> 3) & 2047, b = i >> 14;
    const float* s = p.cache_kidx + (size_t)(b * 2048 + t) * 64 + dg * 8;
    *(bf16x8*)(p.kiS() + ((size_t)b * 2112 + t) * 64 + dg * 8) = pack8(s[0], s[1], s[2], s[3], s[4], s[5], s[6], s[7]);
  }
}

namespace pg8 {
constexpr int BM = 256, BK = 64, HALF = 128, HTB = HALF * BK * 2, STAGE_BYTES = 8 * HTB, NXCD = 8, WGM = 8;
DI int lds_byte(int r, int c) { const int st = (r >> 4) * 2 + (c >> 5), rr = r & 15, cc = c & 31, ob = rr * 64 + cc * 2; return st * 1024 + (ob ^ (((ob >> 9) & 1) << 5)); }
DI void stage_rc(int b, int& R, int& C) { const int st = b / 1024, sb = b % 1024, swz = sb ^ (((sb >> 9) & 1) << 5); R = (st >> 1) * 16 + swz / 64; C = (st & 1) * 32 + (swz % 64) / 2; }
struct Unit { int pm, pn; };
struct Gemm { const u16* A; const u16* Bt; int M, N, K; };
struct StaticOrder {
  int nM, nN, nwg, G, c, padtile; unsigned long long permtab;
  DI void init(int M, int N, int G_, int c_) { nM = M / BM; nN = N / BM; nwg = nM * nN; G = G_; c = c_; permtab = 0xFEDCBA9876543210ull; padtile = -1; }
  DI void map(int L, Unit& u) const {
    int wgid = L; { const int q = nwg / NXCD, r = nwg % NXCD, xcd = wgid % NXCD, off = wgid / NXCD; wgid = (xcd < r ? xcd * (q + 1) : r * (q + 1) + (xcd - r) * q) + off; }
    const int nig = WGM * nN, gid = wgid / nig, fm = gid * WGM, gsz = (nM - fm) < WGM ? (nM - fm) : WGM;
    u.pm = fm + ((wgid % nig) % gsz); u.pn = (int)((permtab >> (4 * ((wgid % nig) / gsz))) & 15ull);
  }
  DI bool next(int i, Unit& u) const {
    const long Ll = (long)i * G + c; if (Ll >= nwg) return false;
    const int L = (int)Ll;
    if (padtile < 0) { map(L, u); return true; }
    const int tail = nwg % G, base = nwg - tail;
    if (L >= base) { u.pm = L - base; u.pn = padtile; return true; }
    map(L, u);
    for (int it = 0; it < 64 && u.pn == padtile && u.pm < tail; ++it) map(base + u.pm, u);
    return true;
  }
};
template <class Epi>
DI void gemm_phase(LAS unsigned char* lds, const Gemm g, const StaticOrder& S, const Epi& E, int wave_id) {
  const int wid = wave_id; int lane = lane_id(); asm volatile("" : "+v"(lane)); const int tid = wid * 64 + lane;
  const int wr = wid >> 2, wc = wid & 3, fr = lane & 15, fq = lane >> 4;
  const int K = g.K, nt = K / BK;
  unsigned voffA[2], voffB[2];
#pragma unroll
  for (int i = 0; i < 2; ++i) { int R, C; stage_rc(tid * 16 + i * 8192, R, C); voffA[i] = (unsigned)(R * K + C) * 2u; voffB[i] = voffA[i]; }
  const size_t kstep = (size_t)(BK * 2);
  const size_t hstep = (size_t)HALF * K * 2;
  const size_t tstep = 2 * hstep;
  const unsigned ldsw = (unsigned)wid * 1024u;
  const int aoff = lds_byte(wr * 64 + fr, fq * 8), boff = lds_byte(wc * 32 + fr, fq * 8);
#define PG8_SA(b, h) (((b) * 2 + (h)) * HTB)
#define PG8_SB(b, h) ((4 + (b) * 2 + (h)) * HTB)
#define PG8_STAGE(bufoff, gbase, voff) do { _Pragma("unroll") for (int _i = 0; _i < 2; ++_i) \
    __builtin_amdgcn_global_load_lds((const unsigned*)((const char*)(gbase) + (voff)[_i]), (LAS unsigned*)(lds + (bufoff) + ldsw + _i * 8192), 16, 0, 0); } while (0)
#define PG8_LDA(dst, b, h) do { _Pragma("unroll") for (int m = 0; m < 4; ++m) _Pragma("unroll") for (int k = 0; k < 2; ++k) dst[m][k] = *(const LAS bf16x8*)(lds + PG8_SA(b, h) + aoff + m * 2048 + k * 1024); } while (0)
#define PG8_LDB(dst, b, h) do { _Pragma("unroll") for (int n = 0; n < 2; ++n) _Pragma("unroll") for (int k = 0; k < 2; ++k) dst[n][k] = *(const LAS bf16x8*)(lds + PG8_SB(b, h) + boff + n * 2048 + k * 1024); } while (0)
#define PG8_MMA(ai, bj, At, Bt) do { __builtin_amdgcn_s_setprio(1); _Pragma("unroll") for (int m = 0; m < 4; ++m) _Pragma("unroll") for (int n = 0; n < 2; ++n) _Pragma("unroll") for (int k = 0; k < 2; ++k) \
    acc[ai][bj][m][n] = __builtin_amdgcn_mfma_f32_16x16x32_bf16(Bt[n][k], At[m][k], acc[ai][bj][m][n], 0, 0, 0); __builtin_amdgcn_s_setprio(0); } while (0)
#define PG8_WAIT_V(n) asm volatile("s_waitcnt vmcnt(" #n ")" ::: "memory")
#define PG8_WAIT_L(n) asm volatile("s_waitcnt lgkmcnt(" #n ")" ::: "memory")
#define PG8_BAR __builtin_amdgcn_s_barrier()
#define PG8_SCHED __builtin_amdgcn_sched_barrier(0)
  Unit cur, nxt; int ui = 0;
  if (!S.next(0, cur)) return;
  f32x4 acc[2][2][4][2];
#pragma unroll
  for (int a = 0; a < 2; ++a)
#pragma unroll
    for (int b = 0; b < 2; ++b)
#pragma unroll
      for (int m = 0; m < 4; ++m)
#pragma unroll
        for (int n = 0; n < 2; ++n) acc[a][b][m][n] = (f32x4){0.f, 0.f, 0.f, 0.f};
  bf16x8 At[4][2], B0[2][2], B1[2][2];
  const char* cA = (const char*)g.A + (size_t)cur.pm * tstep; const char* cB = (const char*)g.Bt + (size_t)cur.pn * tstep;
  PG8_STAGE(PG8_SB(0, 0), cB, voffB); PG8_STAGE(PG8_SA(0, 0), cA, voffA); PG8_STAGE(PG8_SB(0, 1), cB + hstep, voffB); PG8_STAGE(PG8_SA(0, 1), cA + hstep, voffA);
  if (wr == 1) PG8_BAR;
  PG8_WAIT_V(4); PG8_BAR;
  PG8_STAGE(PG8_SB(1, 0), cB + kstep, voffB); PG8_STAGE(PG8_SA(1, 0), cA + kstep, voffA); PG8_STAGE(PG8_SB(1, 1), cB + hstep + kstep, voffB);
  PG8_WAIT_V(6); PG8_BAR;
  for (;;) {
    const bool has_next = S.next(ui + 1, nxt);
    const char* nA = has_next ? (const char*)g.A + (size_t)nxt.pm * tstep : cA; const char* nB = has_next ? (const char*)g.Bt + (size_t)nxt.pn * tstep : cB;
#ifndef REPK
#define REPK 1
#endif
    const bool skip1 = (S.padtile >= 0) && (cur.pn == S.padtile);
    for (int rk = 0; rk < REPK; ++rk) {
    const char* nA2 = (rk == REPK - 1) ? nA : cA; const char* nB2 = (rk == REPK - 1) ? nB : cB;
    for (int t = 0; t < nt; t += 2) {
      const bool last = (t == nt - 2);
      const char* a1 = cA + (size_t)(t + 1) * kstep;
      const char* a2 = last ? nA2 : cA + (size_t)(t + 2) * kstep; const char* b2 = last ? nB2 : cB + (size_t)(t + 2) * kstep;
      const char* a3 = a2 + kstep; const char* b3 = b2 + kstep;
      PG8_LDB(B0, 0, 0); PG8_SCHED; PG8_LDA(At, 0, 0); PG8_STAGE(PG8_SA(1, 1), a1 + hstep, voffA);
      PG8_WAIT_L(8); PG8_BAR; PG8_WAIT_L(0); PG8_MMA(0, 0, At, B0); PG8_BAR; PG8_SCHED;
      PG8_LDB(B1, 0, 1); PG8_STAGE(PG8_SB(0, 0), b2, voffB);
      PG8_BAR; PG8_WAIT_L(0); if (!skip1) PG8_MMA(0, 1, At, B1); PG8_BAR;
      PG8_LDA(At, 0, 1); PG8_STAGE(PG8_SA(0, 0), a2, voffA);
      PG8_BAR; PG8_WAIT_L(0); PG8_MMA(1, 0, At, B0); PG8_BAR; PG8_SCHED;
      PG8_STAGE(PG8_SB(0, 1), b2 + hstep, voffB);
      PG8_WAIT_V(6); PG8_BAR; if (!skip1) PG8_MMA(1, 1, At, B1); PG8_BAR;
      PG8_LDB(B0, 1, 0); PG8_SCHED; PG8_LDA(At, 1, 0); PG8_STAGE(PG8_SA(0, 1), a2 + hstep, voffA);
      PG8_WAIT_L(8); PG8_BAR; PG8_WAIT_L(0); PG8_MMA(0, 0, At, B0); PG8_BAR; PG8_SCHED;
      PG8_LDB(B1, 1, 1); PG8_STAGE(PG8_SB(1, 0), b3, voffB);
      PG8_BAR; PG8_WAIT_L(0); if (!skip1) PG8_MMA(0, 1, At, B1); PG8_BAR;
      PG8_LDA(At, 1, 1); PG8_STAGE(PG8_SA(1, 0), a3, voffA);
      PG8_BAR; PG8_WAIT_L(0); PG8_MMA(1, 0, At, B0); PG8_BAR; PG8_SCHED;
      PG8_STAGE(PG8_SB(1, 1), b3 + hstep, voffB);
      PG8_WAIT_V(6); PG8_BAR; if (!skip1) PG8_MMA(1, 1, At, B1); PG8_BAR;
    }
    }
    {
      Unit eu = cur; int ewr = wr, ewc = wc; int el = lane_id();
      asm volatile("" : "+s"(eu.pm), "+s"(eu.pn), "+s"(ewr), "+s"(ewc), "+v"(el));
      int efr = el & 15, efq = el >> 4;
#ifndef REPEPI
#define REPEPI 1
#endif
      for (int re = 0; re < REPEPI; ++re) E(acc, eu, ewr, ewc, efr, efq, re);
    }
    if (!has_next) break;
#pragma unroll
    for (int a = 0; a < 2; ++a)
#pragma unroll
      for (int b = 0; b < 2; ++b)
#pragma unroll
        for (int m = 0; m < 4; ++m)
#pragma unroll
          for (int n = 0; n < 2; ++n) acc[a][b][m][n] = (f32x4){0.f, 0.f, 0.f, 0.f};
    cur = nxt; cA = nA; cB = nB; ++ui;
  }
  PG8_WAIT_V(0);
  if (wr == 0) PG8_BAR;
  PG8_BAR;
#undef PG8_SA
#undef PG8_SB
#undef PG8_STAGE
#undef PG8_LDA
#undef PG8_LDB
#undef PG8_MMA
#undef PG8_WAIT_V
#undef PG8_WAIT_L
#undef PG8_BAR
#undef PG8_SCHED
}
}


DI unsigned hx_w(int row, int c8) { return (unsigned)(row * 256 + ((c8 ^ ((row & 15) << 1)) << 3)); }
DI unsigned hx_r(int row, int c16) { return (unsigned)(row * 256 + ((c16 ^ (row & 15)) << 4)); }
#define EPI_BAR() asm volatile("s_waitcnt lgkmcnt(0)\n\ts_barrier" ::: "memory")


struct Epi1 {
  Params p; LAS unsigned char* hl0;
  DI void load_tabs(f32x4 (&tc)[4], f32x4 (&ts)[4], int tclass, int R0, bool samp, int wc, int fr, int fq) const {
    const float* cb = (tclass == 1) ? p.cosR() : p.cosA();
    const float* sb = (tclass == 1) ? p.sinR() : p.sinA();
    const int pitch = (tclass == 1) ? 64 : 8;
    const int coff = (tclass == 1) ? (16 * wc + 4 * fq) : (4 * (fq & 1));
#pragma unroll
    for (int m = 0; m < 4; ++m) {
      const int rowg = R0 + 16 * m + fr;
      const int pos = samp ? 2048 + ((rowg - NPROMPT) & 63) : (rowg & 2047);
      tc[m] = *(const f32x4*)(cb + pos * pitch + coff);
      ts[m] = *(const f32x4*)(sb + pos * pitch + coff);
    }
  }
  template <int AI, int BJ>
  DI void compute(f32x4 (&acc)[2][2][4][2], const f32x4 (&tc)[4], const f32x4 (&ts)[4], int blk, int wc, int fq) const {
    if (blk < 8) {
#pragma unroll
      for (int m = 0; m < 4; ++m) {
        const f32x4 v0 = acc[AI][BJ][m][0], v1 = acc[AI][BJ][m][1];
        f32x4 o0 = v0 * tc[m] - v1 * ts[m], o1 = v1 * tc[m] + v0 * ts[m];
        if (blk >= 4) { o0 *= 0.08838834764831845f; o1 *= 0.08838834764831845f; }
        acc[AI][BJ][m][0] = o0; acc[AI][BJ][m][1] = o1;
      }
    } else if ((blk >= 12 && blk < 16) || (blk >= 22 && blk < 26)) {
#pragma unroll
      for (int m = 0; m < 4; ++m)
#pragma unroll
        for (int n = 0; n < 2; ++n) {
          f32x4 v = acc[AI][BJ][m][n];
          v[0] = siluf(v[0]); v[1] = siluf(v[1]); v[2] = siluf(v[2]); v[3] = siluf(v[3]);
          acc[AI][BJ][m][n] = v;
        }
    } else if ((blk >= 8 && blk < 12) || blk == 21 || blk == 31) {
    } else {
      const bool ropew = ((wc & 1) == 0) && !(blk == 30 && wc >= 2);
      if (ropew) {
#pragma unroll
        for (int m = 0; m < 4; ++m) {
          const f32x4 v0 = acc[AI][BJ][m][0];
          f32x4 pr;
          pr[0] = __shfl_xor(v0[0], 32); pr[1] = __shfl_xor(v0[1], 32); pr[2] = __shfl_xor(v0[2], 32); pr[3] = __shfl_xor(v0[3], 32);
          acc[AI][BJ][m][0] = (fq < 2) ? v0 * tc[m] - pr * ts[m] : v0 * tc[m] + pr * ts[m];
        }
      }
      if (blk < 20) {
        const float sc = 0.125f * 1.4426950408889634f;
#pragma unroll
        for (int m = 0; m < 4; ++m) { acc[AI][BJ][m][0] *= sc; acc[AI][BJ][m][1] *= sc; }
      }
    }
  }
  template <int AI, int BJ>
  DI void emit(f32x4 (&acc)[2][2][4][2], const pg8::Unit& u, int blk, bool samp, int wr, int wc, int fr, int fq) const {
    if (blk == 31) return;
    LAS unsigned char* hl = hl0 + wr * 16384;
    asm volatile("" : "+v"(fr), "+v"(fq));
    const int lane = fr + 16 * fq;
    const int P0 = 32 * wc + 4 * fq;
    const int R0 = u.pm * 256 + AI * 128 + wr * 64;
    int b, tb;
    if (!samp) { b = R0 >> 11; tb = R0 & 2047; } else { b = (R0 - NPROMPT) >> 6; tb = 0; }
    const bool retk = blk < 8;
    const bool hasT = (blk >= 4 && blk < 12) || blk == 21;
    const bool hasN = !(blk >= 8 && blk < 12) && blk != 21;
    if (blk == 20 || blk == 21) {
      float* ob = samp ? p.out + (blk == 20 ? OUT_KS : OUT_VS) + (unsigned)(R0 - NPROMPT) * 128u : p.out + (blk == 20 ? OUT_KP : OUT_VP) + (unsigned)R0 * 128u;
#pragma unroll
      for (int m = 0; m < 4; ++m) {
        float* o2 = ob + (unsigned)(16 * m + fr) * 128u + P0;
        *(f32x4*)o2 = acc[AI][BJ][m][0]; *(f32x4*)(o2 + 16) = acc[AI][BJ][m][1];
      }
    } else if (blk == 30) {
      float* ob = samp ? p.out + OUT_KIS + (unsigned)(R0 - NPROMPT) * 64u : p.out + OUT_KIP + (unsigned)R0 * 64u;
      float* wb = p.wi() + (unsigned)R0 * 8u;
#pragma unroll
      for (int m = 0; m < 4; ++m) {
        if (wc < 2) {
          float* o2 = ob + (unsigned)(16 * m + fr) * 64u + P0;
          *(f32x4*)o2 = acc[AI][BJ][m][0]; *(f32x4*)(o2 + 16) = acc[AI][BJ][m][1];
        } else if (wc == 2 && fq < 2) {
          *(f32x4*)(wb + (unsigned)(16 * m + fr) * 8u + 4 * fq) = acc[AI][BJ][m][0] * 0.044194173824159216f;
        }
      }
    }
    if (hasN) {
#pragma unroll
      for (int m = 0; m < 4; ++m)
#pragma unroll
        for (int n = 0; n < 2; ++n) {
          const int c8 = retk ? (16 * n + 4 * wc + fq) : (8 * wc + 4 * n + fq);
          *(LAS s16x4*)(hl + hx_w(16 * m + fr, c8)) = pack4(acc[AI][BJ][m][n]);
        }
      u16* nb; unsigned pitch = 512u, hstr = 0u, cm = 15u;
      if (blk < 4) nb = p.qr() + (unsigned)R0 * 512u + (blk & 3) * 128;
      else if (blk < 8) nb = p.kr() + (unsigned)R0 * 512u + (blk & 3) * 128;
      else if (blk < 16) { nb = p.gate() + (unsigned)R0 * 1024u + (blk - 12) * 128; pitch = 1024u; }
      else if (blk < 20) nb = p.qa() + (unsigned)R0 * 512u + (blk - 16) * 128;
      else if (blk == 20) { nb = samp ? p.kaS() + ((unsigned)(b * 2) * 2112u + 2048u) * 64u : p.kaP() + ((unsigned)(b * 2) * 2048u + tb) * 64u; pitch = 64u; hstr = samp ? 2112u * 64u : 2048u * 64u; cm = 7u; }
      else if (blk < 26) { nb = p.gate() + (unsigned)R0 * 1024u + 512 + (blk - 22) * 128; pitch = 1024u; }
      else if (blk < 30) nb = p.qi() + (unsigned)R0 * 512u + (blk - 26) * 128;
      else { nb = samp ? p.kiS() + ((unsigned)b * 2112u + 2048u) * 64u : p.kiP() + ((unsigned)b * 2048u + tb) * 64u; pitch = 64u; cm = 7u; }
      EPI_BAR();
      const unsigned c16 = lane & 15;
      const unsigned loff = (c16 >> 3) * hstr + (c16 & cm) * 8u;
#pragma unroll
      for (int i = 0; i < 4; ++i) {
        const int row = 16 * wc + 4 * i + (lane >> 4);
        const bf16x8 v = *(const LAS bf16x8*)(hl + hx_r(row, c16));
        if (blk != 30 || c16 < 8) *(bf16x8*)(nb + (unsigned)row * pitch + loff) = v;
      }
      EPI_BAR();
    }
    if (hasT) {
      const float l2g = log2gamma(blk & 3);
#pragma unroll
      for (int m = 0; m < 4; ++m) {
        const int tok = 16 * m + fr;
        const float dec = (blk < 8) ? exp2f((float)(63 - tok) * l2g) : 1.f;
#pragma unroll
        for (int n = 0; n < 2; ++n) {
          const int fb = retk ? (64 * n + 16 * wc + 4 * fq) : (32 * wc + 16 * n + 4 * fq);
#pragma unroll
          for (int j = 0; j < 4; ++j) {
            const int f = fb + j;
            *(LAS u16*)(hl + f * 128 + ((((tok >> 3) ^ (f >> 2)) & 7) << 4) + (tok & 7) * 2) = f2bf(acc[AI][BJ][m][n][j] * dec);
          }
        }
      }
      u16* tbp; unsigned fstr;
      if (blk < 12) {
        u16* base = (blk < 8) ? p.krT() : p.vrT();
        const unsigned bh = (unsigned)(b * 4 + (blk & 3)) * 128u;
        tbp = samp ? base + 64u * 128u * 2048u + bh * 64u : base + bh * 2048u + tb;
        fstr = samp ? 64u : 2048u;
      } else {
        tbp = samp ? p.vaTS() + (unsigned)b * 128u * 2112u + 2048u : p.vaTP() + (unsigned)b * 128u * 2048u + tb;
        fstr = samp ? 2112u : 2048u;
      }
      EPI_BAR();
#pragma unroll
      for (int i = 0; i < 4; ++i) {
        const int f = 32 * wc + 8 * i + (lane >> 3), ch = lane & 7;
        const bf16x8 v = *(const LAS bf16x8*)(hl + f * 128 + (((ch ^ (f >> 2)) & 7) << 4));
        *(bf16x8*)(tbp + (unsigned)f * fstr + ch * 8) = v;
      }
      EPI_BAR();
    }
  }
  DI void operator()(f32x4 (&acc)[2][2][4][2], const pg8::Unit& u, int wr, int wc, int fr, int fq, int re) const {
    const bool samp = (u.pm * 256 >= NPROMPT);
    const int tclass = (u.pn < 4) ? 1 : ((u.pn == 8 || u.pn == 9 || u.pn == 10 || u.pn >= 13) ? 2 : 0);
    const int blk0 = u.pn * 2, blk1 = u.pn * 2 + 1;
    float rvv[2][4];
#pragma unroll
    for (int ai = 0; ai < 2; ++ai)
#pragma unroll
      for (int m = 0; m < 4; ++m) rvv[ai][m] = (1.f / REPK) * p.rinv()[u.pm * 256 + ai * 128 + wr * 64 + 16 * m + fr];
    f32x4 tc[4], ts[4];
    load_tabs(tc, ts, tclass, u.pm * 256 + wr * 64, samp, wc, fr, fq);
#pragma unroll
    for (int ai = 0; ai < 2; ++ai)
#pragma unroll
      for (int m = 0; m < 4; ++m)
#pragma unroll
        for (int bj = 0; bj < 2; ++bj)
#pragma unroll
          for (int n = 0; n < 2; ++n) acc[ai][bj][m][n] *= rvv[ai][m];
    compute<0, 0>(acc, tc, ts, blk0, wc, fq);
    compute<0, 1>(acc, tc, ts, blk1, wc, fq);
    load_tabs(tc, ts, tclass, u.pm * 256 + 128 + wr * 64, samp, wc, fr, fq);
    compute<1, 0>(acc, tc, ts, blk0, wc, fq);
    compute<1, 1>(acc, tc, ts, blk1, wc, fq);
    emit<0, 0>(acc, u, blk0, samp, wr, wc, fr, fq);
    emit<0, 1>(acc, u, blk1, samp, wr, wc, fr, fq);
    emit<1, 0>(acc, u, blk0, samp, wr, wc, fr, fq);
    emit<1, 1>(acc, u, blk1, samp, wr, wc, fr, fq);
  }
};

struct Epi2 {
  Params p; unsigned char* hl;
  DI void operator()(f32x4 (&acc)[2][2][4][2], const pg8::Unit& u, int wr, int wc, int fr, int fq, int re) const {
    u16* z = p.gate();
    const int lane = fr + 16 * fq;
#pragma unroll
    for (int ai = 0; ai < 2; ++ai)
#pragma unroll
      for (int bj = 0; bj < 2; ++bj) {
#pragma unroll
        for (int m = 0; m < 4; ++m)
#pragma unroll
          for (int n = 0; n < 2; ++n)
            *(s16x4*)(hl + hx_w(16 * m + fr, 8 * wc + 4 * n + fq)) = pack4(acc[ai][bj][m][n] * (1.f / REPK));
        EPI_BAR();
        const unsigned R0 = u.pm * 256 + ai * 128 + wr * 64;
        const unsigned cb = u.pn * 256 + bj * 128;
#pragma unroll
        for (int i = 0; i < 4; ++i) {
          const int row = 16 * wc + 4 * i + (lane >> 4), c16 = lane & 15;
          const bf16x8 v = *(const bf16x8*)(hl + hx_r(row, c16));
          *(bf16x8*)(z + (R0 + row) * 1024u + cb + c16 * 8) = v;
        }
        EPI_BAR();
      }
  }
};

DI void ret_kv_item(const Params& p, int item, int tid) {
  const int lane = tid & 63, w = tid >> 6, r = lane & 31, hh = lane >> 5;
  const u16 *kT, *vT; int T, c;
  if (item < 2048) { const int bh = item >> 5; c = item & 31; T = 2048; kT = p.krT() + (size_t)bh * 128 * 2048; vT = p.vrT() + (size_t)bh * 128 * 2048; }
  else { const int bh = item - 2048; c = 0; T = 64; kT = p.krT() + (size_t)64 * 128 * 2048 + (size_t)bh * 128 * 64; vT = p.vrT() + (size_t)64 * 128 * 2048 + (size_t)bh * 128 * 64; }
  const int e0 = (w & 1) * 64, d0 = (w >> 1) * 64;
  f32x16 acc[2][2];
  acc[0][0] = zero16(); acc[0][1] = zero16(); acc[1][0] = zero16(); acc[1][1] = zero16();
#pragma unroll
  for (int ks = 0; ks < 4; ++ks) {
    bf16x8 a0 = ldg8(vT + (size_t)(e0 + r) * T + c * 64 + ks * 16 + hh * 8);
    bf16x8 a1 = ldg8(vT + (size_t)(e0 + 32 + r) * T + c * 64 + ks * 16 + hh * 8);
    bf16x8 b0 = ldg8(kT + (size_t)(d0 + r) * T + c * 64 + ks * 16 + hh * 8);
    bf16x8 b1 = ldg8(kT + (size_t)(d0 + 32 + r) * T + c * 64 + ks * 16 + hh * 8);
    acc[0][0] = MFMA32(a0, b0, acc[0][0]);
    acc[0][1] = MFMA32(a0, b1, acc[0][1]);
    acc[1][0] = MFMA32(a1, b0, acc[1][0]);
    acc[1][1] = MFMA32(a1, b1, acc[1][1]);
  }
  u16* o = (u16*)p.kvT() + (size_t)item * 16384;
#pragma unroll
  for (int a = 0; a < 2; ++a)
#pragma unroll
    for (int b = 0; b < 2; ++b)
#pragma unroll
      for (int i = 0; i < 16; ++i)
        o[(e0 + a * 32 + crow(i, hh)) * 128 + d0 + b * 32 + r] = f2bf(acc[a][b][i]);
}

template <int NS>
DI void select_query(const u16* krow, int nj, int lane, u64* dst) {
  unsigned key[NS];
#pragma unroll
  for (int j = 0; j < NS; ++j) { const unsigned k = krow[j * 64 + lane]; key[j] = (j < nj) ? k : 0u; }
  constexpr int NP = (NS + 1) / 2;
  unsigned pk[NP];
#pragma unroll
  for (int i = 0; i < NP; ++i) pk[i] = key[2 * i] | ((2 * i + 1 < NS ? key[2 * i + 1] : 0u) << 16);
  unsigned prefix = 0;
  int cntp = 0;
  const unsigned ones = 0x00010001u;
  for (int bit = 15; bit >= 0; --bit) {
    const unsigned cand = prefix | (1u << bit);
    const unsigned c1 = cand - 1u;
    const unsigned cv = c1 | (c1 << 16);
    unsigned acc0 = 0, acc1 = 0;
#pragma unroll
    for (int i = 0; i < NP; ++i) {
      unsigned d, m;
      asm("v_pk_sub_u16 %0, %1, %2 clamp" : "=v"(d) : "v"(pk[i]), "v"(cv));
      asm("v_pk_min_u16 %0, %1, %2" : "=v"(m) : "v"(d), "v"(ones));
      if (i & 1) acc1 += m; else acc0 += m;
    }
    const unsigned a = acc0 + acc1;
    const int cnt = wave_sum((int)((a & 0xffffu) + (a >> 16)));
    if (cnt >= 256) { prefix = cand; cntp = cnt; }
    if (cnt == 256) break;
  }
  int wlo = 0, whi = 0;
  if (cntp == 256) {
#pragma unroll
    for (int j = 0; j < NS; ++j) {
      const u64 sm = __ballot(key[j] >= prefix);
      if (lane == j) { wlo = (int)(unsigned)sm; whi = (int)(unsigned)(sm >> 32); }
    }
  } else {
    int cgt = 0;
#pragma unroll
    for (int j = 0; j < NS; ++j) cgt += (key[j] > prefix) ? 1 : 0;
    cgt = wave_sum(cgt);
    const int rneed = 256 - cgt;
    int running = 0;
    const u64 lt = (1ull << lane) - 1ull;
#pragma unroll
    for (int j = 0; j < NS; ++j) {
      const bool eq = key[j] == prefix;
      const u64 em = __ballot(eq);
      const int rank = running + __popcll(em & lt);
      const bool sel = (key[j] > prefix) || (eq && rank < rneed);
      const u64 sm = __ballot(sel);
      if (lane == j) { wlo = (int)(unsigned)sm; whi = (int)(unsigned)(sm >> 32); }
      running += __popcll(em);
    }
  }
  if (lane < nj) dst[lane] = ((u64)(unsigned)whi << 32) | (u64)(unsigned)wlo;
}

DI void idx_item(const Params& p, unsigned char* lds, int tid, bool samp, int b, int grp) {
  const int lane = tid & 63, w = tid >> 6;
  const int t0 = grp * 16;
  int L, g0; const u16* ki;
  if (!samp) { const int c = t0 >> 6; L = (c + 1) * 64; g0 = b * 2048 + t0; ki = p.kiP() + (size_t)b * 2048 * 64; }
  else { L = 2112; g0 = NPROMPT + b * 64 + t0; ki = p.kiS() + (size_t)b * 2112 * 64; }
  const int nj = L >> 6;
  if (L <= 256) {
    for (int qq = 0; qq < 4; ++qq) {
      const int q = w * 4 + qq;
      if (lane < nj) p.maskbits()[(size_t)(g0 + q) * 33 + lane] = ~0ull;
    }
    return;
  }
  u16* keys = (u16*)lds;
#ifndef REPMF
#define REPMF 1
#endif
#ifndef REPSEL
#define REPSEL 1
#endif
#ifndef REPKV
#define REPKV 1
#endif
  for (int rmf = 0; rmf < REPMF; ++rmf) {
    const int qn = lane & 15, quad = lane >> 4;
    bf16x8 qf[8][2];
    float wv[8];
#pragma unroll
    for (int h = 0; h < 8; ++h) {
      qf[h][0] = ldg8(p.qi() + (size_t)(g0 + qn) * 512 + h * 64 + quad * 8);
      qf[h][1] = ldg8(p.qi() + (size_t)(g0 + qn) * 512 + h * 64 + 32 + quad * 8);
      wv[h] = p.wi()[(size_t)(g0 + qn) * 8 + h];
    }
    bf16x8 A0[4], A1[4], N0[4], N1[4];
#pragma unroll
    for (int i = 0; i < 4; ++i) {
      const int kt = w + 4 * i;
      A0[i] = ldg8(ki + (size_t)(kt * 16 + qn) * 64 + quad * 8);
      A1[i] = ldg8(ki + (size_t)(kt * 16 + qn) * 64 + 32 + quad * 8);
    }
    for (int base = 0; base < nj; base += 4) {
#pragma unroll
      for (int i = 0; i < 4; ++i) {
        const int t = min(base + 4 + i, nj - 1);
        const int kt = w + 4 * t;
        N0[i] = ldg8(ki + (size_t)(kt * 16 + qn) * 64 + quad * 8);
        N1[i] = ldg8(ki + (size_t)(kt * 16 + qn) * 64 + 32 + quad * 8);
      }
#pragma unroll
      for (int i = 0; i < 4; ++i) {
        const int t = base + i;
        if (t < nj) {
          const int kt = w + 4 * t;
          float idx[4] = {0.f, 0.f, 0.f, 0.f};
#pragma unroll
          for (int h = 0; h < 8; ++h) {
            f32x4 acc = {0.f, 0.f, 0.f, 0.f};
            acc = MFMA16(A0[i], qf[h][0], acc);
            acc = MFMA16(A1[i], qf[h][1], acc);
#pragma unroll
            for (int e = 0; e < 4; ++e) idx[e] += fmaxf(acc[e], 0.f) * wv[h];
          }
          s16x4 kv;
#pragma unroll
          for (int e = 0; e < 4; ++e) {
            _Float16 hv = (_Float16)idx[e];
            u16 bits = __builtin_bit_cast(u16, hv);
            kv[e] = (short)((bits & 0x8000) ? (u16)~bits : (u16)(bits | 0x8000));
          }
          *(s16x4*)(keys + qn * KPITCH + kt * 16 + quad * 4) = kv;
        }
      }
#pragma unroll
      for (int i = 0; i < 4; ++i) { A0[i] = N0[i]; A1[i] = N1[i]; }
    }
  }
  __syncthreads();
  for (int qq = 0; qq < 4 * REPSEL; ++qq) {
    const int q = w * 4 + (qq & 3);
    const u16* krow = keys + q * KPITCH;
    u64* dst = p.maskbits() + (size_t)(g0 + q) * 33;
    if (nj <= 8) select_query<8>(krow, nj, lane, dst);
    else if (nj <= 16) select_query<16>(krow, nj, lane, dst);
    else if (nj <= 24) select_query<24>(krow, nj, lane, dst);
    else select_query<33>(krow, nj, lane, dst);
  }
  __syncthreads();
}

DI void scan_item(const Params& p, int item, int tid) {
  if (item < 1024) {
    const int bh = item >> 4, slab = item & 15;
    const int idx = slab * 1024 + tid * 4;
    const int h = bh & 3;
    const float cd = exp2f(64.f * log2gamma(h));
    f32x4 s = {0.f, 0.f, 0.f, 0.f};
    for (int c0 = 0; c0 < 32; c0 += 8) {
      f32x4 kvb[8];
#pragma unroll
      for (int i = 0; i < 8; ++i) {
        const s16x4 kk = *(const s16x4*)((const u16*)p.kvT() + (size_t)(bh * 32 + c0 + i) * 16384 + idx);
#pragma unroll
        for (int j = 0; j < 4; ++j) kvb[i][j] = __uint_as_float(((unsigned)(u16)kk[j]) << 16);
      }
#pragma unroll
      for (int i = 0; i < 8; ++i) {
        *(s16x4*)(p.sprevT() + (size_t)(bh * 32 + c0 + i) * 16384 + idx) = pack4(s);
        s = s * cd + kvb[i];
      }
    }
    const int e = idx >> 7, d = idx & 127;
    float* o = p.out + OUT_STP + (size_t)bh * 16384;
#pragma unroll
    for (int j = 0; j < 4; ++j) o[(d + j) * 128 + e] = s[j];
  } else {
    const int it = item - 1024;
    const int bh = it >> 4, slab = it & 15;
    const int idx = slab * 1024 + tid * 4;
    const int h = bh & 3;
    const float cd = exp2f(64.f * log2gamma(h));
    const int e = idx >> 7, d = idx & 127;
    const float* s0 = p.state_ret + (size_t)bh * 16384;
    f32x4 s;
#pragma unroll
    for (int j = 0; j < 4; ++j) s[j] = s0[(d + j) * 128 + e];
    const size_t base = (size_t)(2048 + bh) * 16384 + idx;
    s16x4 o = pack4(s);
    *(s16x4*)(p.sprevT() + base) = o;
    const s16x4 kk = *(const s16x4*)((const u16*)p.kvT() + base);
    f32x4 kv;
#pragma unroll
    for (int j = 0; j < 4; ++j) kv[j] = __uint_as_float(((unsigned)(u16)kk[j]) << 16);
    s = s * cd + kv;
    float* oo = p.out + OUT_STS + (size_t)bh * 16384;
#pragma unroll
    for (int j = 0; j < 4; ++j) oo[(d + j) * 128 + e] = s[j];
  }
}

DI void attn_item(const Params& p, unsigned char* lds, int tid, bool samp, int b, int c, int kvh, int qh) {
  const int lane = tid & 63, w = tid >> 6, r = lane & 31, hh = lane >> 5;
  const int T = samp ? 2112 : 2048;
  const int nkt = samp ? 33 : c + 1;
  const int g0 = (samp ? NPROMPT + b * 64 : b * 2048 + c * 64) + qh * 32;
  const u16* K = samp ? p.kaS() + (size_t)(b * 2 + kvh) * 2112 * 64 : p.kaP() + (size_t)(b * 2 + kvh) * 2048 * 64;
  const u16* VT = samp ? p.vaTS() + (size_t)(b * 2 + kvh) * 64 * 2112 : p.vaTP() + (size_t)(b * 2 + kvh) * 64 * 2048;
  const int head = kvh * 4 + w;
  u16* Ks = (u16*)lds;
  u16* Vs = Ks + 64 * 72;
  u64* mL = (u64*)(lds + 2 * 9216);
  {
    u64 mv[5];
#pragma unroll
    for (int i = 0; i < 5; ++i) { const int ix = tid + 256 * i; mv[i] = p.maskbits()[(size_t)g0 * 33 + (ix < 32 * 33 ? ix : 32 * 33 - 1)]; }
#pragma unroll
    for (int i = 0; i < 5; ++i) { const int ix = tid + 256 * i; if (ix < 32 * 33) mL[ix] = mv[i]; }
  }
  bf16x8 qf[4];
#pragma unroll
  for (int ks = 0; ks < 4; ++ks) qf[ks] = ldg8(p.qa() + (size_t)(g0 + r) * 512 + head * 64 + ks * 16 + hh * 8);
  f32x16 O[2];
  O[0] = zero16(); O[1] = zero16();
  float mrun = -1e30f, lrun = 0.f;
  const int lrow = tid >> 3, lch = tid & 7;
  bf16x8 pk0, pk1, pv0, pv1, nk0, nk1, nv0, nv1;
  pk0 = ldg8(K + (size_t)(lrow)*64 + lch * 8);
  pk1 = ldg8(K + (size_t)(lrow + 32) * 64 + lch * 8);
  pv0 = ldg8(VT + (size_t)(lrow)*T + lch * 8);
  pv1 = ldg8(VT + (size_t)(lrow + 32) * T + lch * 8);
  nk0 = pk0; nk1 = pk1; nv0 = pv0; nv1 = pv1;
  if (nkt > 1) {
    nk0 = ldg8(K + (size_t)(64 + lrow) * 64 + lch * 8);
    nk1 = ldg8(K + (size_t)(64 + lrow + 32) * 64 + lch * 8);
    nv0 = ldg8(VT + (size_t)(lrow)*T + 64 + lch * 8);
    nv1 = ldg8(VT + (size_t)(lrow + 32) * T + 64 + lch * 8);
  }
  for (int kt = 0; kt < nkt; ++kt) {
    __syncthreads();
    *(bf16x8*)(Ks + lrow * 72 + lch * 8) = pk0;
    *(bf16x8*)(Ks + (lrow + 32) * 72 + lch * 8) = pk1;
    *(bf16x8*)(Vs + lrow * 72 + lch * 8) = pv0;
    *(bf16x8*)(Vs + (lrow + 32) * 72 + lch * 8) = pv1;
    __syncthreads();
    pk0 = nk0; pk1 = nk1; pv0 = nv0; pv1 = nv1;
    if (kt + 2 < nkt) {
      nk0 = ldg8(K + (size_t)((kt + 2) * 64 + lrow) * 64 + lch * 8);
      nk1 = ldg8(K + (size_t)((kt + 2) * 64 + lrow + 32) * 64 + lch * 8);
      nv0 = ldg8(VT + (size_t)(lrow)*T + (kt + 2) * 64 + lch * 8);
      nv1 = ldg8(VT + (size_t)(lrow + 32) * T + (kt + 2) * 64 + lch * 8);
    }
    f32x16 S[2];
#pragma unroll
    for (int st = 0; st < 2; ++st) {
      S[st] = zero16();
#pragma unroll
      for (int ks = 0; ks < 4; ++ks) {
        bf16x8 kf = *(const bf16x8*)(Ks + (st * 32 + r) * 72 + ks * 16 + hh * 8);
        S[st] = MFMA32(kf, qf[ks], S[st]);
      }
    }
    const u64 W = mL[r * 33 + kt];
    const int wl = (int)(((unsigned)W) >> (4 * hh)), wh = (int)(((unsigned)(W >> 32)) >> (4 * hh));
    float mx = fmaxf(S[0][0], S[1][0]);
#pragma unroll
    for (int i = 1; i < 16; ++i) mx = fmaxf(mx, fmaxf(S[0][i], S[1][i]));
    mx = fmaxf(mx, __shfl_xor(mx, 32));
    const float mn = fmaxf(mrun, mx);
    const float alpha = __builtin_amdgcn_exp2f(mrun - mn);
    const bool resc = __any(mn != mrun);
    mrun = mn;
    float ls = 0.f;
#pragma unroll
    for (int st = 0; st < 2; ++st)
#pragma unroll
      for (int i = 0; i < 16; ++i) {
        const int keep = __builtin_amdgcn_sbfe(st ? wh : wl, (i & 3) + 8 * (i >> 2), 1);
        const float pvv = __int_as_float(__float_as_int(__builtin_amdgcn_exp2f(S[st][i] - mn)) & keep);
        S[st][i] = pvv;
        ls += pvv;
      }
    lrun = lrun * alpha + ls;
    if (resc) {
#pragma unroll
      for (int dt = 0; dt < 2; ++dt)
#pragma unroll
        for (int i = 0; i < 16; ++i) O[dt][i] *= alpha;
    }
#pragma unroll
    for (int st = 0; st < 2; ++st)
#pragma unroll
      for (int s2 = 0; s2 < 2; ++s2) {
        bf16x8 pf = pack8(S[st][8 * s2 + 0], S[st][8 * s2 + 1], S[st][8 * s2 + 2], S[st][8 * s2 + 3],
                          S[st][8 * s2 + 4], S[st][8 * s2 + 5], S[st][8 * s2 + 6], S[st][8 * s2 + 7]);
#pragma unroll
        for (int dt = 0; dt < 2; ++dt) {
          s16x4 lo = *(const s16x4*)(Vs + (dt * 32 + r) * 72 + st * 32 + 16 * s2 + 4 * hh);
          s16x4 hi = *(const s16x4*)(Vs + (dt * 32 + r) * 72 + st * 32 + 16 * s2 + 8 + 4 * hh);
          bf16x8 vf = __builtin_shufflevector(lo, hi, 0, 1, 2, 3, 4, 5, 6, 7);
          O[dt] = MFMA32(vf, pf, O[dt]);
        }
      }
  }
  {
    float lt = lrun + __shfl_xor(lrun, 32);
    const float inv = 1.f / fmaxf(lt, 1e-30f);
    const u16* grow = p.gate() + (size_t)(g0 + r) * 1024 + 512 + head * 64;
    u16* mrow = p.mix() + (size_t)(g0 + r) * 1024 + 512 + head * 64;
    s16x4 gvv[2][4];
#pragma unroll
    for (int dt = 0; dt < 2; ++dt)
#pragma unroll
      for (int q4 = 0; q4 < 4; ++q4) gvv[dt][q4] = *(const s16x4*)(grow + dt * 32 + 8 * q4 + 4 * hh);
#pragma unroll
    for (int dt = 0; dt < 2; ++dt)
#pragma unroll
      for (int q4 = 0; q4 < 4; ++q4) {
        const int d = dt * 32 + 8 * q4 + 4 * hh;
        f32x4 of;
#pragma unroll
        for (int j = 0; j < 4; ++j) {
          const float gf = __uint_as_float(((unsigned)(u16)gvv[dt][q4][j]) << 16);
          of[j] = O[dt][q4 * 4 + j] * inv * gf;
        }
        *(s16x4*)(mrow + d) = pack4(of);
      }
  }
  __syncthreads();
}

DI void ret_out_item(const Params& p, unsigned char* lds, int item, int tid) {
  const int lane = tid & 63, w = tid >> 6, r = lane & 31, hh = lane >> 5;
  int bh, c, T, g0; const u16* vT;
  if (item < 2048) { bh = item >> 5; c = item & 31; T = 2048; g0 = (bh >> 2) * 2048 + c * 64; vT = p.vrT() + (size_t)bh * 128 * 2048; }
  else { bh = item - 2048; c = 0; T = 64; g0 = NPROMPT + (bh >> 2) * 64; vT = p.vrT() + (size_t)64 * 128 * 2048 + (size_t)bh * 128 * 64; }
  const int h = bh & 3;
  const float l2g = log2gamma(h);
  const int nt = w & 1, eh = w >> 1;
  const int n = nt * 32 + r;
  bf16x8 qf[8], kf[8];
#pragma unroll
  for (int ks = 0; ks < 8; ++ks) qf[ks] = ldg8(p.qr() + (size_t)(g0 + n) * 512 + h * 128 + ks * 16 + hh * 8);
#pragma unroll
  for (int ks = 0; ks < 8; ++ks) kf[ks] = ldg8(p.kr() + (size_t)(g0 + r) * 512 + h * 128 + ks * 16 + hh * 8);
  __builtin_amdgcn_sched_barrier(0);
  bf16x8 pf[2][2];
#pragma unroll
  for (int mt = 0; mt < 2; ++mt) {
    f32x16 S = zero16();
#pragma unroll
    for (int ks = 0; ks < 8; ++ks) S = MFMA32(kf[ks], qf[ks], S);
    if (mt == 0) {
#pragma unroll
      for (int ks = 0; ks < 8; ++ks) kf[ks] = ldg8(p.kr() + (size_t)(g0 + 32 + r) * 512 + h * 128 + ks * 16 + hh * 8);
      __builtin_amdgcn_sched_barrier(0);
    }
#pragma unroll
    for (int i = 0; i < 16; ++i) {
      const int m = mt * 32 + crow(i, hh);
      const int dd = n > m ? n - m : m - n;
      S[i] *= exp2f((float)dd * l2g);
    }
    pf[mt][0] = pack8(S[0], S[1], S[2], S[3], S[4], S[5], S[6], S[7]);
    pf[mt][1] = pack8(S[8], S[9], S[10], S[11], S[12], S[13], S[14], S[15]);
  }
  const float fs = exp2f((float)(n + 1) * l2g);
  const u16* sp = p.sprevT() + (size_t)item * 16384;
  f32x16 tot[2];
  float ss = 0.f;
  s16x4 vlo[2][2][2], vhi[2][2][2];
#pragma unroll
  for (int et = 0; et < 2; ++et)
#pragma unroll
    for (int mt = 0; mt < 2; ++mt)
#pragma unroll
      for (int s2 = 0; s2 < 2; ++s2) {
        const u16* vp = vT + (size_t)((2 * eh + et) * 32 + r) * T + c * 64 + mt * 32 + 16 * s2 + 4 * hh;
        vlo[et][mt][s2] = ldg4(vp); vhi[et][mt][s2] = ldg4(vp + 8);
      }
  __builtin_amdgcn_sched_barrier(0);
#pragma unroll
  for (int et = 0; et < 2; ++et) {
    const int e = (2 * eh + et) * 32 + r;
    bf16x8 sf[8];
#pragma unroll
    for (int ks = 0; ks < 8; ++ks) sf[ks] = ldg8(sp + (size_t)e * 128 + ks * 16 + hh * 8);
    __builtin_amdgcn_sched_barrier(0);
    f32x16 Oi = zero16(), X = zero16();
#pragma unroll
    for (int mt = 0; mt < 2; ++mt)
#pragma unroll
      for (int s2 = 0; s2 < 2; ++s2) {
        bf16x8 vf = __builtin_shufflevector(vlo[et][mt][s2], vhi[et][mt][s2], 0, 1, 2, 3, 4, 5, 6, 7);
        Oi = MFMA32(vf, pf[mt][s2], Oi);
      }
#pragma unroll
    for (int ks = 0; ks < 8; ++ks) X = MFMA32(sf[ks], qf[ks], X);
#pragma unroll
    for (int i = 0; i < 16; ++i) { const float t = Oi[i] + X[i] * fs; tot[et][i] = t; ss += t * t; }
  }
  ss += __shfl_xor(ss, 32);
  float* red = (float*)lds;
  __syncthreads();
  if (hh == 0) red[w * 32 + r] = ss;
  __syncthreads();
  const float tsum = red[w * 32 + r] + red[(w ^ 2) * 32 + r];
  const float rinv = rsqrtf(tsum * (1.f / 128.f) + 1e-6f);
  const u16* grow = p.gate() + (size_t)(g0 + n) * 1024 + h * 128;
  u16* mrow = p.mix() + (size_t)(g0 + n) * 1024 + h * 128;
  s16x4 gvv[2][4];
  f32x4 ggv[2][4];
#pragma unroll
  for (int et = 0; et < 2; ++et)
#pragma unroll
    for (int q4 = 0; q4 < 4; ++q4) {
      const int e = (2 * eh + et) * 32 + 8 * q4 + 4 * hh;
      gvv[et][q4] = *(const s16x4*)(grow + e);
      ggv[et][q4] = *(const f32x4*)(p.ret_gn_g + h * 128 + e);
    }
#pragma unroll
  for (int et = 0; et < 2; ++et)
#pragma unroll
    for (int q4 = 0; q4 < 4; ++q4) {
      const int e = (2 * eh + et) * 32 + 8 * q4 + 4 * hh;
      f32x4 of;
#pragma unroll
      for (int j = 0; j < 4; ++j) {
        const float gf = __uint_as_float(((unsigned)(u16)gvv[et][q4][j]) << 16);
        of[j] = tot[et][q4 * 4 + j] * rinv * ggv[et][q4][j] * gf;
      }
      *(s16x4*)(mrow + e) = pack4(of);
    }
}

DI void phase_final(const Params& p, int tid) {
  const int gt = blockIdx.x * 512 + tid, GT = gridDim.x * 512;
  const int lane = tid & 63;
  for (int row0 = (gt >> 6) * 2; row0 < NTOK; row0 += (GT >> 6) * 2) {
    f32x4 v[2][4];
    s16x4 zz[2][4];
#pragma unroll
    for (int rr = 0; rr < 2; ++rr) {
      const float* xr = xrow(p, row0 + rr);
      const u16* zr = p.gate() + (size_t)(row0 + rr) * 1024;
#pragma unroll
      for (int i = 0; i < 4; ++i) { v[rr][i] = *(const f32x4*)(xr + i * 256 + lane * 4); zz[rr][i] = *(const s16x4*)(zr + i * 256 + lane * 4); }
    }
    f32x4 g[4];
#pragma unroll
    for (int i = 0; i < 4; ++i) g[i] = *(const f32x4*)(p.final_g + i * 256 + lane * 4);
#pragma unroll
    for (int rr = 0; rr < 2; ++rr) {
      float ss = 0.f;
#pragma unroll
      for (int i = 0; i < 4; ++i) {
#pragma unroll
        for (int j = 0; j < 4; ++j) v[rr][i][j] += __uint_as_float(((unsigned)(u16)zz[rr][i][j]) << 16);
        ss += v[rr][i][0] * v[rr][i][0] + v[rr][i][1] * v[rr][i][1] + v[rr][i][2] * v[rr][i][2] + v[rr][i][3] * v[rr][i][3];
      }
#pragma unroll
      for (int o = 32; o >= 1; o >>= 1) ss += __shfl_xor(ss, o);
      const float rv = rsqrtf(ss * (1.f / 1024.f) + 1e-6f);
      float* y = p.out + OUT_Y + (size_t)(row0 + rr) * 1024;
#pragma unroll
      for (int i = 0; i < 4; ++i) *(f32x4*)(y + i * 256 + lane * 4) = v[rr][i] * rv * g[i];
    }
  }
}

#ifndef REP0
#define REP0 1
#endif
#ifndef REP1
#define REP1 1
#endif
#ifndef REP2
#define REP2 1
#endif
#ifndef REP3
#define REP3 1
#endif
#ifndef REP4
#define REP4 1
#endif
#ifndef REP5
#define REP5 1
#endif
__global__ void __launch_bounds__(512, 2) fwd_megakernel(Params p) {
  __shared__ __attribute__((aligned(16))) unsigned char lds[LDS_BYTES];
  cg::grid_group grid = cg::this_grid();
  const int wave_id = __builtin_amdgcn_readfirstlane((int)threadIdx.x >> 6);
#define FRESH_TID() int tid = wave_id * 64 + lane_id(); asm volatile("" : "+v"(tid)); const int half = tid >> 8, htid = tid & 255; unsigned char* ldsh = lds + half * HALF_LDS; (void)htid; (void)ldsh;
  if (p.out == nullptr) grid.sync();
  if (wave_id == 0 && lane_id() == 0) (void)xb_add(&p.bar()[XB_XCNT(xb_xcc_id())], 1u);
  for (int rep = 0; rep < REP0; ++rep) {
  { FRESH_TID(); phase_prep(p, tid); }
  xcd_barrier(p.bar(), wave_id);
  }
  for (int rep = 0; rep < REP1; ++rep) {
  {
    FRESH_TID();
    pg8::Gemm g; g.A = p.xb(); g.Bt = p.WtIn(); g.M = NTOK; g.N = 4096; g.K = 1024;
    pg8::StaticOrder S; S.init(g.M, g.N, (int)gridDim.x, (int)blockIdx.x); S.permtab = 0xEFBCD87694105A32ull; S.padtile = 15;
    Epi1 E; E.p = p; E.hl0 = (LAS unsigned char*)lds + pg8::STAGE_BYTES;
    pg8::gemm_phase<Epi1>((LAS unsigned char*)lds, g, S, E, wave_id);
  }
  xcd_barrier(p.bar(), wave_id);
  }
  for (int rep = 0; rep < REP2; ++rep) {
  {
    FRESH_TID();
    for (int it0 = blockIdx.x * 2; it0 < 2080 + 2080; it0 += gridDim.x * 2) {
      const int it = it0 + half;
      int ht = htid; asm volatile("" : "+v"(ht));
      if (it < 2080) {
        const bool samp = it < 32;
        const int j = it - 32;
        const int c = 31 - (j >> 6);
        const int b = samp ? (it >> 2) : ((j & 63) >> 2);
        const int grp = samp ? (it & 3) : (c * 4 + (j & 3));
        idx_item(p, ldsh, ht, samp, b, grp);
      } else { for (int rkv = 0; rkv < REPKV; ++rkv) ret_kv_item(p, it - 2080, ht); }
    }
  }
  xcd_barrier(p.bar(), wave_id);
  }
  for (int rep = 0; rep < REP3; ++rep) {
  {
    FRESH_TID();
    for (int it0 = blockIdx.x * 2; it0 < 1056 + 1536; it0 += gridDim.x * 2) {
      const int it = it0 + half;
      int ht = htid; asm volatile("" : "+v"(ht));
      if (it < 1056) {
        const bool samp = it < 32;
        const int j = it - 32;
        int c = samp ? 0 : 31 - (j >> 6);
        int b = samp ? (it >> 2) : ((j & 63) >> 2);
        int kvh = (it >> 1) & 1;
        if (!samp && gridDim.x == 256) {
          const int jb = (j >> 1) & 255, rnd = j >> 9;
          const int xcd = jb & 7, ii = jb >> 3;
          b = 2 * xcd + (ii & 1); kvh = (ii >> 1) & 1; c = 31 - rnd * 8 - (ii >> 2);
        }
        attn_item(p, ldsh, ht, samp, b, c, kvh, it & 1);
      } else scan_item(p, it - 1056, ht);
    }
  }
  xcd_barrier(p.bar(), wave_id);
  }
  for (int rep = 0; rep < REP4; ++rep) {
  {
    FRESH_TID();
    for (int it0 = blockIdx.x * 2; it0 < 2080 + 1024; it0 += gridDim.x * 2) {
      const int it = it0 + half;
      int ht = htid; asm volatile("" : "+v"(ht));
      if (it < 2080) ret_out_item(p, ldsh, it, ht);
      else {
        const int ia = it - 2080 + 1056;
        const int j = ia - 32;
        int c = 31 - (j >> 6);
        int b = (j & 63) >> 2;
        int kvh = (ia >> 1) & 1;
        if (gridDim.x == 256) {
          const int jb = (j >> 1) & 255, rnd = j >> 9;
          const int xcd = jb & 7, ii = jb >> 3;
          b = 2 * xcd + (ii & 1); kvh = (ii >> 1) & 1; c = 31 - rnd * 8 - (ii >> 2);
        }
        attn_item(p, ldsh, ht, false, b, c, kvh, ia & 1);
      }
    }
  }
  xcd_barrier(p.bar(), wave_id);
  }
  for (int rep = 0; rep < REP5; ++rep) {
  {
    pg8::Gemm g; g.A = p.mix(); g.Bt = p.WtOut(); g.M = NTOK; g.N = 1024; g.K = 1024;
    pg8::StaticOrder S; S.init(g.M, g.N, (int)gridDim.x, (int)blockIdx.x);
    Epi2 E; E.p = p; E.hl = lds + pg8::STAGE_BYTES + (wave_id >> 2) * 16384;
    pg8::gemm_phase<Epi2>((LAS unsigned char*)lds, g, S, E, wave_id);
  }
  xcd_barrier(p.bar(), wave_id);
  }
  { FRESH_TID(); phase_final(p, tid); }
}

extern "C" void kernel_launch(void* const* d_in, const int* in_sizes, int n_in, void* d_out, int out_size, void* d_ws,
                              size_t ws_size, hipStream_t stream) {
  static int grid_blocks = 0;
  if (!grid_blocks) {
    int dev = 0, cus = 0, per_cu = 0;
    (void)hipGetDevice(&dev);
    (void)hipDeviceGetAttribute(&cus, hipDeviceAttributeMultiprocessorCount, dev);
    (void)hipOccupancyMaxActiveBlocksPerMultiprocessor(&per_cu, fwd_megakernel, 512, 0);
    if (per_cu < 1) per_cu = 1;
    if (per_cu > 1) per_cu = 1;
    grid_blocks = cus * per_cu;
  }
  Params p{};
  p.x_p = (const float*)d_in[0]; p.x_s = (const float*)d_in[1]; p.state_ret = (const float*)d_in[2];
  p.cache_k = (const float*)d_in[3]; p.cache_v = (const float*)d_in[4]; p.cache_kidx = (const float*)d_in[5];
  p.norm_g = (const float*)d_in[6]; p.w_in = (const float*)d_in[7]; p.ret_gn_g = (const float*)d_in[8];
  p.w_out = (const float*)d_in[9]; p.final_g = (const float*)d_in[10];
  p.out = (float*)d_out;
  p.ws = (unsigned char*)d_ws;
  (void)hipMemsetAsync((unsigned char*)d_ws + 530573312ull, 0, (size_t)XCD_BAR_WORDS * 4, stream);
  void* args[] = {&p};
  hipError_t e = hipLaunchCooperativeKernel((void*)fwd_megakernel, dim3(grid_blocks), dim3(512), args, 0, stream);
  if (e != hipSuccess) fprintf(stderr, "cooperative launch failed: %s (grid %d)\n", hipGetErrorString(e), grid_blocks);
}
```

```cpp
#include <hip/hip_runtime.h>
#include <hip/hip_cooperative_groups.h>
#include <stdint.h>
#include <cstdio>
namespace cg = cooperative_groups;

typedef __attribute__((ext_vector_type(8))) short bf16x8;
typedef __attribute__((ext_vector_type(4))) short s16x4;
typedef __attribute__((ext_vector_type(16))) float f32x16;
typedef __attribute__((ext_vector_type(4))) float f32x4;
typedef unsigned short u16;
typedef unsigned long long u64;


#define DI __device__ __forceinline__
#define MFMA32(a, b, c) __builtin_amdgcn_mfma_f32_32x32x16_bf16((a), (b), (c), 0, 0, 0)
#define MFMA16(a, b, c) __builtin_amdgcn_mfma_f32_16x16x32_bf16((a), (b), (c), 0, 0, 0)

#define NTOK 33280
#define NPROMPT 32768
#define LDS_BYTES 163840
#define HALF_LDS 81920
#define LAS __attribute__((address_space(3)))
#define KPITCH 2116

struct Params {
  const float *x_p, *x_s, *state_ret, *cache_k, *cache_v, *cache_kidx, *norm_g, *w_in, *ret_gn_g, *w_out, *final_g;
  float* out;
  unsigned char* ws;
  DI u16* xb() const { return (u16*)(ws + 0ull); }
  DI float* kvT() const { return (float*)(ws + 0ull); }
  DI u16* WtIn() const { return (u16*)(ws + 136314880ull); }
  DI u16* WtOut() const { return (u16*)(ws + 144703488ull); }
  DI u16* qr() const { return (u16*)(ws + 146800640ull); }
  DI u16* kr() const { return (u16*)(ws + 180879360ull); }
  DI u16* sprevT() const { return (u16*)(ws + 214958080ull); }
  DI u16* qi() const { return (u16*)(ws + 214958080ull); }
  DI u16* krT() const { return (u16*)(ws + 249036800ull); }
  DI u16* vrT() const { return (u16*)(ws + 283115520ull); }
  DI u16* gate() const { return (u16*)(ws + 317194240ull); }
  DI u16* mix() const { return (u16*)(ws + 385351680ull); }
  DI u16* qa() const { return (u16*)(ws + 453509120ull); }
  DI u16* kaP() const { return (u16*)(ws + 487587840ull); }
  DI u16* kaS() const { return (u16*)(ws + 495976448ull); }
  DI u16* vaTP() const { return (u16*)(ws + 500301824ull); }
  DI u16* vaTS() const { return (u16*)(ws + 508690432ull); }
  DI u16* kiP() const { return (u16*)(ws + 513015808ull); }
  DI u16* kiS() const { return (u16*)(ws + 517210112ull); }
  DI float* rinv() const { return (float*)(ws + 519372800ull); }
  DI float* wi() const { return (float*)(ws + 519505920ull); }
  DI float* cosR() const { return (float*)(ws + 520570880ull); }
  DI float* sinR() const { return (float*)(ws + 521111552ull); }
  DI float* cosA() const { return (float*)(ws + 521652224ull); }
  DI float* sinA() const { return (float*)(ws + 521719808ull); }
  DI unsigned* bar() const { return (unsigned*)(ws + 530573312ull); }
  DI u64* maskbits() const { return (u64*)(ws + 521787392ull); }
};

#define OUT_Y 0
#define OUT_STP (34078720)
#define OUT_KP (OUT_STP + 1048576)
#define OUT_VP (OUT_KP + 4194304)
#define OUT_KIP (OUT_VP + 4194304)
#define OUT_STS (OUT_KIP + 2097152)
#define OUT_KS (OUT_STS + 524288)
#define OUT_VS (OUT_KS + 65536)
#define OUT_KIS (OUT_VS + 65536)

typedef __bf16 bf16x2_t __attribute__((ext_vector_type(2)));
typedef float f32x2_t __attribute__((ext_vector_type(2)));
typedef unsigned u32x4_t __attribute__((ext_vector_type(4)));
typedef unsigned u32x2_t __attribute__((ext_vector_type(2)));
DI unsigned pk2(float a, float b) { f32x2_t v = {a, b}; bf16x2_t r = __builtin_convertvector(v, bf16x2_t); return __builtin_bit_cast(unsigned, r); }
DI u16 f2bf(float x) { return (u16)(pk2(x, x) & 0xffffu); }
DI bf16x8 ldg8(const u16* p) { return *(const bf16x8*)p; }
DI s16x4 ldg4(const u16* p) { return *(const s16x4*)p; }
DI float siluf(float x) { return x * __builtin_amdgcn_rcpf(1.f + __builtin_amdgcn_exp2f(-1.4426950408889634f * x)); }
DI int lane_id() { return (int)__builtin_amdgcn_mbcnt_hi(~0u, __builtin_amdgcn_mbcnt_lo(~0u, 0u)); }
DI int crow(int reg, int hh) { return (reg & 3) + 8 * (reg >> 2) + 4 * hh; }
DI const float* xrow(const Params& p, int g) { return g < NPROMPT ? p.x_p + (size_t)g * 1024 : p.x_s + (size_t)(g - NPROMPT) * 1024; }
DI float log2gamma(int h) { return log1pf(-exp2f(-5.f - (float)h)) * 1.4426950408889634f; }
DI bf16x8 pack8(float a0, float a1, float a2, float a3, float a4, float a5, float a6, float a7) {
  u32x4_t v = {pk2(a0, a1), pk2(a2, a3), pk2(a4, a5), pk2(a6, a7)};
  return __builtin_bit_cast(bf16x8, v);
}
DI s16x4 pack4(f32x4 v) { u32x2_t o = {pk2(v[0], v[1]), pk2(v[2], v[3])}; return __builtin_bit_cast(s16x4, o); }
DI int wave_sum(int v) {
  v += __builtin_amdgcn_update_dpp(0, v, 0xB1, 0xf, 0xf, false);
  v += __builtin_amdgcn_update_dpp(0, v, 0x4E, 0xf, 0xf, false);
  v += __builtin_amdgcn_update_dpp(0, v, 0x124, 0xf, 0xf, false);
  v += __builtin_amdgcn_update_dpp(0, v, 0x128, 0xf, 0xf, false);
  return __builtin_amdgcn_readlane(v, 0) + __builtin_amdgcn_readlane(v, 16) + __builtin_amdgcn_readlane(v, 32) + __builtin_amdgcn_readlane(v, 48);
}
DI f32x16 zero16() { f32x16 z; for (int i = 0; i < 16; ++i) z[i] = 0.f; return z; }

#define XB_TMO      128
#define XB_XCNT(j)  (256  + 64 * (j))
#define XB_XSUB(j)  (1280 + 64 * (j))
#define XB_XGEN(j)  (2304 + 64 * (j))
#define XB_TOP      3328
#define XB_TOPGEN   3392
#define XB_WG(i)    (3456 + 64 * (i))
#define XCD_BAR_WORDS (3456 + 64 * 256)
#define XB_SPIN_CAP (1u << 18)
DI unsigned xb_ld(unsigned* p) { return __hip_atomic_load(p, __ATOMIC_RELAXED, __HIP_MEMORY_SCOPE_AGENT); }
DI unsigned xb_add(unsigned* p, unsigned v) { return __hip_atomic_fetch_add(p, v, __ATOMIC_RELAXED, __HIP_MEMORY_SCOPE_AGENT); }
DI unsigned xb_xcc_id() { return (unsigned)__builtin_amdgcn_s_getreg((3 << 11) | 20) & 0xFu; }
#define XB_SPIN(cond, bar) do { unsigned _sp = 0; while (cond) { __builtin_amdgcn_s_sleep(1); \
    if ((++_sp & 255u) == 0u) { if (xb_ld(&(bar)[XB_TMO])) break; if (_sp > XB_SPIN_CAP) { atomicAdd(&(bar)[XB_TMO], 1u); break; } } } } while (0)
DI void xcd_barrier(unsigned* bar, int wave_id) {
  asm volatile("s_waitcnt vmcnt(0)" ::: "memory");
  __syncthreads();
  if (wave_id == 0) {
    const int lane = lane_id();
    const unsigned x = xb_xcc_id();
    unsigned* slot = &bar[XB_WG(blockIdx.x)];
    unsigned nloc = 0u, nx = 0u;
    if (lane < 2) nloc = xb_ld(slot + lane);
    nx = (unsigned)__builtin_amdgcn_readlane((int)nloc, 1);
    nloc = (unsigned)__builtin_amdgcn_readlane((int)nloc, 0);
    if (nloc == 0u) {
      const unsigned G = gridDim.x * gridDim.y * gridDim.z;
      unsigned sp = 0u, c = 0u;
      for (;;) {
        c = (lane < 16) ? xb_ld(&bar[XB_XCNT(lane)]) : 0u;
        const unsigned sum = (unsigned)wave_sum((int)c);
        if (sum == G) break;
        __builtin_amdgcn_s_sleep(1);
        if ((++sp & 255u) == 0u) { if (xb_ld(&bar[XB_TMO])) break; if (sp > XB_SPIN_CAP) { if (lane == 0) atomicAdd(&bar[XB_TMO], 1u); break; } }
      }
      nx = (unsigned)__popcll(__ballot(c > 0u));
      nloc = (unsigned)__builtin_amdgcn_readlane((int)c, (int)x);
      nloc = nloc > 0u ? nloc : 1u; nx = nx > 0u ? nx : 1u;
      if (lane == 0) { __hip_atomic_store(slot, nloc, __ATOMIC_RELAXED, __HIP_MEMORY_SCOPE_AGENT); __hip_atomic_store(slot + 1, nx, __ATOMIC_RELAXED, __HIP_MEMORY_SCOPE_AGENT); }
    }
    if (lane == 0) {
      __builtin_amdgcn_s_waitcnt(0);
      const unsigned old = xb_add(&bar[XB_XSUB(x)], 1u);
      const unsigned gen = old / nloc;
      if (old + 1u == (gen + 1u) * nloc) {
        __builtin_amdgcn_fence(__ATOMIC_RELEASE, "agent");
        asm volatile("s_waitcnt vmcnt(0)" ::: "memory");
        const unsigned og = xb_add(&bar[XB_TOP], 1u);
        const unsigned tg = og / nx;
        if (og + 1u == (tg + 1u) * nx) xb_add(&bar[XB_TOPGEN], 1u);
        else XB_SPIN(xb_ld(&bar[XB_TOPGEN]) == tg, bar);
        __builtin_amdgcn_fence(__ATOMIC_ACQUIRE, "agent");
        xb_add(&bar[XB_XGEN(x)], 1u);
        asm volatile("s_waitcnt vmcnt(0)" ::: "memory");
      } else {
        XB_SPIN(xb_ld(&bar[XB_XGEN(x)]) == gen, bar);
        __builtin_amdgcn_fence(__ATOMIC_ACQUIRE, "agent");
        asm volatile("s_waitcnt vmcnt(0)" ::: "memory");
      }
    }
  }
  __syncthreads();
}

DI void phase_prep(const Params& p, int tid) {
  const int gt = blockIdx.x * 512 + tid, GT = gridDim.x * 512;
  const int lane = tid & 63;
  for (int row0 = (gt >> 6) * 2; row0 < NTOK; row0 += (GT >> 6) * 2) {
    f32x4 v[2][4];
#pragma unroll
    for (int rr = 0; rr < 2; ++rr) {
      const float* sp = xrow(p, row0 + rr);
#pragma unroll
      for (int i = 0; i < 4; ++i) v[rr][i] = *(const f32x4*)(sp + i * 256 + lane * 4);
    }
#pragma unroll
    for (int rr = 0; rr < 2; ++rr) {
      float ss = 0.f;
#pragma unroll
      for (int i = 0; i < 4; ++i) ss += v[rr][i][0] * v[rr][i][0] + v[rr][i][1] * v[rr][i][1] + v[rr][i][2] * v[rr][i][2] + v[rr][i][3] * v[rr][i][3];
#pragma unroll
      for (int o = 32; o >= 1; o >>= 1) ss += __shfl_xor(ss, o);
#pragma unroll
      for (int i = 0; i < 4; ++i) *(s16x4*)(p.xb() + (size_t)(row0 + rr) * 1024 + i * 256 + lane * 4) = pack4(v[rr][i]);
      if (lane == 0) p.rinv()[row0 + rr] = rsqrtf(ss * (1.f / 1024.f) + 1e-6f);
    }
  }
  for (int i = gt; i < 4096 * 128; i += GT) {
    int n = i & 4095, kg = i >> 12;
    int sc = n;
    if (n < 1024) { const int P = n & 127; sc = (n & ~127) + 64 * ((P >> 4) & 1) + 16 * (P >> 5) + (P & 15); }
    float a[8];
    const float vmask = (n < 3912) ? 1.f : 0.f; const int scc = (sc < 3912) ? sc : 3911;
#pragma unroll
    for (int j = 0; j < 8; ++j) a[j] = p.w_in[(size_t)(kg * 8 + j) * 3912 + scc] * p.norm_g[kg * 8 + j] * vmask;
    *(bf16x8*)(p.WtIn() + (size_t)n * 1024 + kg * 8) = pack8(a[0], a[1], a[2], a[3], a[4], a[5], a[6], a[7]);
  }
  for (int i = gt; i < 1024 * 128; i += GT) {
    int n = i % 1024, kg = i / 1024;
    float a[8];
#pragma unroll
    for (int j = 0; j < 8; ++j) a[j] = p.w_out[(size_t)(kg * 8 + j) * 1024 + n];
    *(bf16x8*)(p.WtOut() + (size_t)n * 1024 + kg * 8) = pack8(a[0], a[1], a[2], a[3], a[4], a[5], a[6], a[7]);
  }
  for (int i = gt; i < 2112 * 64; i += GT) {
    int pos = i >> 6, k = i & 63;
    float inv = powf(10000.f, -(float)k / 64.f);
    float ang = (float)pos * inv;
    p.cosR()[i] = cosf(ang); p.sinR()[i] = sinf(ang);
  }
  for (int i = gt; i < 2112 * 8; i += GT) {
    int pos = i >> 3, k = i & 7;
    float inv = powf(500000.f, -(float)k / 8.f);
    float ang = (float)pos * inv;
    p.cosA()[i] = cosf(ang); p.sinA()[i] = sinf(ang);
  }
  for (int i = gt; i < 8 * 2048 * 2 * 8; i += GT) {
    int dg = i & 7, kvh = (i >> 3) & 1, t = (i >> 4) & 2047, b = i >> 15;
    const float* s = p.cache_k + ((size_t)(b * 2048 + t) * 2 + kvh) * 64 + dg * 8;
    *(bf16x8*)(p.kaS() + ((size_t)(b * 2 + kvh) * 2112 + t) * 64 + dg * 8) = pack8(s[0], s[1], s[2], s[3], s[4], s[5], s[6], s[7]);
  }
  for (int i = gt; i < 8 * 2 * 256 * 64; i += GT) {
    int d = i & 63, tg = (i >> 6) & 255, kvh = (i >> 14) & 1, b = i >> 15;
    float a[8];
#pragma unroll
    for (int j = 0; j < 8; ++j) a[j] = p.cache_v[((size_t)(b * 2048 + tg * 8 + j) * 2 + kvh) * 64 + d];
    *(bf16x8*)(p.vaTS() + ((size_t)(b * 2 + kvh) * 64 + d) * 2112 + tg * 8) = pack8(a[0], a[1], a[2], a[3], a[4], a[5], a[6], a[7]);
  }
  for (int i = gt; i < 8 * 2048 * 8; i += GT) {
    int dg = i & 7, t = (i >> 3) & 2047, b = i >> 14;
    const float* s = p.cache_kidx + (size_t)(b * 2048 + t) * 64 + dg * 8;
    *(bf16x8*)(p.kiS() + ((size_t)b * 2112 + t) * 64 + dg * 8) = pack8(s[0], s[1], s[2], s[3], s[4], s[5], s[6], s[7]);
  }
}

namespace pg8 {
constexpr int BM = 256, BK = 64, HALF = 128, HTB = HALF * BK * 2, STAGE_BYTES = 8 * HTB, NXCD = 8, WGM = 8;
DI int lds_byte(int r, int c) { const int st = (r >> 4) * 2 + (c >> 5), rr = r & 15, cc = c & 31, ob = rr * 64 + cc * 2; return st * 1024 + (ob ^ (((ob >> 9) & 1) << 5)); }
DI void stage_rc(int b, int& R, int& C) { const int st = b / 1024, sb = b % 1024, swz = sb ^ (((sb >> 9) & 1) << 5); R = (st >> 1) * 16 + swz / 64; C = (st & 1) * 32 + (swz % 64) / 2; }
struct Unit { int pm, pn; };
struct Gemm { const u16* A; const u16* Bt; int M, N, K; };
struct StaticOrder {
  int nM, nN, nwg, G, c, padtile; unsigned long long permtab;
  DI void init(int M, int N, int G_, int c_) { nM = M / BM; nN = N / BM; nwg = nM * nN; G = G_; c = c_; permtab = 0xFEDCBA9876543210ull; padtile = -1; }
  DI void map(int L, Unit& u) const {
    int wgid = L; { const int q = nwg / NXCD, r = nwg % NXCD, xcd = wgid % NXCD, off = wgid / NXCD; wgid = (xcd < r ? xcd * (q + 1) : r * (q + 1) + (xcd - r) * q) + off; }
    const int nig = WGM * nN, gid = wgid / nig, fm = gid * WGM, gsz = (nM - fm) < WGM ? (nM - fm) : WGM;
    u.pm = fm + ((wgid % nig) % gsz); u.pn = (int)((permtab >> (4 * ((wgid % nig) / gsz))) & 15ull);
  }
  DI bool next(int i, Unit& u) const {
    const long Ll = (long)i * G + c; if (Ll >= nwg) return false;
    const int L = (int)Ll;
    if (padtile < 0) { map(L, u); return true; }
    const int tail = nwg % G, base = nwg - tail;
    if (L >= base) { u.pm = L - base; u.pn = padtile; return true; }
    map(L, u);
    for (int it = 0; it < 64 && u.pn == padtile && u.pm < tail; ++it) map(base + u.pm, u);
    return true;
  }
};
template <class Epi>
DI void gemm_phase(LAS unsigned char* lds, const Gemm g, const StaticOrder& S, const Epi& E, int wave_id) {
  const int wid = wave_id; int lane = lane_id(); asm volatile("" : "+v"(lane)); const int tid = wid * 64 + lane;
  const int wr = wid >> 2, wc = wid & 3, fr = lane & 15, fq = lane >> 4;
  const int K = g.K, nt = K / BK;
  unsigned voffA[2], voffB[2];
#pragma unroll
  for (int i = 0; i < 2; ++i) { int R, C; stage_rc(tid * 16 + i * 8192, R, C); voffA[i] = (unsigned)(R * K + C) * 2u; voffB[i] = voffA[i]; }
  const size_t kstep = (size_t)(BK * 2);
  const size_t hstep = (size_t)HALF * K * 2;
  const size_t tstep = 2 * hstep;
  const unsigned ldsw = (unsigned)wid * 1024u;
  const int aoff = lds_byte(wr * 64 + fr, fq * 8), boff = lds_byte(wc * 32 + fr, fq * 8);
#define PG8_SA(b, h) (((b) * 2 + (h)) * HTB)
#define PG8_SB(b, h) ((4 + (b) * 2 + (h)) * HTB)
#define PG8_STAGE(bufoff, gbase, voff) do { _Pragma("unroll") for (int _i = 0; _i < 2; ++_i) \
    __builtin_amdgcn_global_load_lds((const unsigned*)((const char*)(gbase) + (voff)[_i]), (LAS unsigned*)(lds + (bufoff) + ldsw + _i * 8192), 16, 0, 0); } while (0)
#define PG8_LDA(dst, b, h) do { _Pragma("unroll") for (int m = 0; m < 4; ++m) _Pragma("unroll") for (int k = 0; k < 2; ++k) dst[m][k] = *(const LAS bf16x8*)(lds + PG8_SA(b, h) + aoff + m * 2048 + k * 1024); } while (0)
#define PG8_LDB(dst, b, h) do { _Pragma("unroll") for (int n = 0; n < 2; ++n) _Pragma("unroll") for (int k = 0; k < 2; ++k) dst[n][k] = *(const LAS bf16x8*)(lds + PG8_SB(b, h) + boff + n * 2048 + k * 1024); } while (0)
#define PG8_MMA(ai, bj, At, Bt) do { __builtin_amdgcn_s_setprio(1); _Pragma("unroll") for (int m = 0; m < 4; ++m) _Pragma("unroll") for (int n = 0; n < 2; ++n) _Pragma("unroll") for (int k = 0; k < 2; ++k) \
    acc[ai][bj][m][n] = __builtin_amdgcn_mfma_f32_16x16x32_bf16(Bt[n][k], At[m][k], acc[ai][bj][m][n], 0, 0, 0); __builtin_amdgcn_s_setprio(0); } while (0)
#define PG8_WAIT_V(n) asm volatile("s_waitcnt vmcnt(" #n ")" ::: "memory")
#define PG8_WAIT_L(n) asm volatile("s_waitcnt lgkmcnt(" #n ")" ::: "memory")
#define PG8_BAR __builtin_amdgcn_s_barrier()
#define PG8_SCHED __builtin_amdgcn_sched_barrier(0)
  Unit cur, nxt; int ui = 0;
  if (!S.next(0, cur)) return;
  f32x4 acc[2][2][4][2];
#pragma unroll
  for (int a = 0; a < 2; ++a)
#pragma unroll
    for (int b = 0; b < 2; ++b)
#pragma unroll
      for (int m = 0; m < 4; ++m)
#pragma unroll
        for (int n = 0; n < 2; ++n) acc[a][b][m][n] = (f32x4){0.f, 0.f, 0.f, 0.f};
  bf16x8 At[4][2], B0[2][2], B1[2][2];
  const char* cA = (const char*)g.A + (size_t)cur.pm * tstep; const char* cB = (const char*)g.Bt + (size_t)cur.pn * tstep;
  PG8_STAGE(PG8_SB(0, 0), cB, voffB); PG8_STAGE(PG8_SA(0, 0), cA, voffA); PG8_STAGE(PG8_SB(0, 1), cB + hstep, voffB); PG8_STAGE(PG8_SA(0, 1), cA + hstep, voffA);
  if (wr == 1) PG8_BAR;
  PG8_WAIT_V(4); PG8_BAR;
  PG8_STAGE(PG8_SB(1, 0), cB + kstep, voffB); PG8_STAGE(PG8_SA(1, 0), cA + kstep, voffA); PG8_STAGE(PG8_SB(1, 1), cB + hstep + kstep, voffB);
  PG8_WAIT_V(6); PG8_BAR;
  for (;;) {
    const bool has_next = S.next(ui + 1, nxt);
    const char* nA = has_next ? (const char*)g.A + (size_t)nxt.pm * tstep : cA; const char* nB = has_next ? (const char*)g.Bt + (size_t)nxt.pn * tstep : cB;
#ifndef REPK
#define REPK 1
#endif
    const bool skip1 = (S.padtile >= 0) && (cur.pn == S.padtile);
    for (int rk = 0; rk < REPK; ++rk) {
    const char* nA2 = (rk == REPK - 1) ? nA : cA; const char* nB2 = (rk == REPK - 1) ? nB : cB;
    for (int t = 0; t < nt; t += 2) {
      const bool last = (t == nt - 2);
      const char* a1 = cA + (size_t)(t + 1) * kstep;
      const char* a2 = last ? nA2 : cA + (size_t)(t + 2) * kstep; const char* b2 = last ? nB2 : cB + (size_t)(t + 2) * kstep;
      const char* a3 = a2 + kstep; const char* b3 = b2 + kstep;
      PG8_LDB(B0, 0, 0); PG8_SCHED; PG8_LDA(At, 0, 0); PG8_STAGE(PG8_SA(1, 1), a1 + hstep, voffA);
      PG8_WAIT_L(8); PG8_BAR; PG8_WAIT_L(0); PG8_MMA(0, 0, At, B0); PG8_BAR; PG8_SCHED;
      PG8_LDB(B1, 0, 1); PG8_STAGE(PG8_SB(0, 0), b2, voffB);
      PG8_BAR; PG8_WAIT_L(0); if (!skip1) PG8_MMA(0, 1, At, B1); PG8_BAR;
      PG8_LDA(At, 0, 1); PG8_STAGE(PG8_SA(0, 0), a2, voffA);
      PG8_BAR; PG8_WAIT_L(0); PG8_MMA(1, 0, At, B0); PG8_BAR; PG8_SCHED;
      PG8_STAGE(PG8_SB(0, 1), b2 + hstep, voffB);
      PG8_WAIT_V(6); PG8_BAR; if (!skip1) PG8_MMA(1, 1, At, B1); PG8_BAR;
      PG8_LDB(B0, 1, 0); PG8_SCHED; PG8_LDA(At, 1, 0); PG8_STAGE(PG8_SA(0, 1), a2 + hstep, voffA);
      PG8_WAIT_L(8); PG8_BAR; PG8_WAIT_L(0); PG8_MMA(0, 0, At, B0); PG8_BAR; PG8_SCHED;
      PG8_LDB(B1, 1, 1); PG8_STAGE(PG8_SB(1, 0), b3, voffB);
      PG8_BAR; PG8_WAIT_L(0); if (!skip1) PG8_MMA(0, 1, At, B1); PG8_BAR;
      PG8_LDA(At, 1, 1); PG8_STAGE(PG8_SA(1, 0), a3, voffA);
      PG8_BAR; PG8_WAIT_L(0); PG8_MMA(1, 0, At, B0); PG8_BAR; PG8_SCHED;
      PG8_STAGE(PG8_SB(1, 1), b3 + hstep, voffB);
      PG8_WAIT_V(6); PG8_BAR; if (!skip1) PG8_MMA(1, 1, At, B1); PG8_BAR;
    }
    }
    {
      Unit eu = cur; int ewr = wr, ewc = wc; int el = lane_id();
      asm volatile("" : "+s"(eu.pm), "+s"(eu.pn), "+s"(ewr), "+s"(ewc), "+v"(el));
      int efr = el & 15, efq = el >> 4;
#ifndef REPEPI
#define REPEPI 1
#endif
      for (int re = 0; re < REPEPI; ++re) E(acc, eu, ewr, ewc, efr, efq, re);
    }
    if (!has_next) break;
#pragma unroll
    for (int a = 0; a < 2; ++a)
#pragma unroll
      for (int b = 0; b < 2; ++b)
#pragma unroll
        for (int m = 0; m < 4; ++m)
#pragma unroll
          for (int n = 0; n < 2; ++n) acc[a][b][m][n] = (f32x4){0.f, 0.f, 0.f, 0.f};
    cur = nxt; cA = nA; cB = nB; ++ui;
  }
  PG8_WAIT_V(0);
  if (wr == 0) PG8_BAR;
  PG8_BAR;
#undef PG8_SA
#undef PG8_SB
#undef PG8_STAGE
#undef PG8_LDA
#undef PG8_LDB
#undef PG8_MMA
#undef PG8_WAIT_V
#undef PG8_WAIT_L
#undef PG8_BAR
#undef PG8_SCHED
}
}


DI unsigned hx_w(int row, int c8) { return (unsigned)(row * 256 + ((c8 ^ ((row & 15) << 1)) << 3)); }
DI unsigned hx_r(int row, int c16) { return (unsigned)(row * 256 + ((c16 ^ (row & 15)) << 4)); }
#define EPI_BAR() asm volatile("s_waitcnt lgkmcnt(0)\n\ts_barrier" ::: "memory")


struct Epi1 {
  Params p; LAS unsigned char* hl0;
  DI void load_tabs(f32x4 (&tc)[4], f32x4 (&ts)[4], int tclass, int R0, bool samp, int wc, int fr, int fq) const {
    const float* cb = (tclass == 1) ? p.cosR() : p.cosA();
    const float* sb = (tclass == 1) ? p.sinR() : p.sinA();
    const int pitch = (tclass == 1) ? 64 : 8;
    const int coff = (tclass == 1) ? (16 * wc + 4 * fq) : (4 * (fq & 1));
#pragma unroll
    for (int m = 0; m < 4; ++m) {
      const int rowg = R0 + 16 * m + fr;
      const int pos = samp ? 2048 + ((rowg - NPROMPT) & 63) : (rowg & 2047);
      tc[m] = *(const f32x4*)(cb + pos * pitch + coff);
      ts[m] = *(const f32x4*)(sb + pos * pitch + coff);
    }
  }
  template <int AI, int BJ>
  DI void compute(f32x4 (&acc)[2][2][4][2], const f32x4 (&tc)[4], const f32x4 (&ts)[4], int blk, int wc, int fq) const {
    if (blk < 8) {
#pragma unroll
      for (int m = 0; m < 4; ++m) {
        const f32x4 v0 = acc[AI][BJ][m][0], v1 = acc[AI][BJ][m][1];
        f32x4 o0 = v0 * tc[m] - v1 * ts[m], o1 = v1 * tc[m] + v0 * ts[m];
        if (blk >= 4) { o0 *= 0.08838834764831845f; o1 *= 0.08838834764831845f; }
        acc[AI][BJ][m][0] = o0; acc[AI][BJ][m][1] = o1;
      }
    } else if ((blk >= 12 && blk < 16) || (blk >= 22 && blk < 26)) {
#pragma unroll
      for (int m = 0; m < 4; ++m)
#pragma unroll
        for (int n = 0; n < 2; ++n) {
          f32x4 v = acc[AI][BJ][m][n];
          v[0] = siluf(v[0]); v[1] = siluf(v[1]); v[2] = siluf(v[2]); v[3] = siluf(v[3]);
          acc[AI][BJ][m][n] = v;
        }
    } else if ((blk >= 8 && blk < 12) || blk == 21 || blk == 31) {
    } else {
      const bool ropew = ((wc & 1) == 0) && !(blk == 30 && wc >= 2);
      if (ropew) {
#pragma unroll
        for (int m = 0; m < 4; ++m) {
          const f32x4 v0 = acc[AI][BJ][m][0];
          f32x4 pr;
          pr[0] = __shfl_xor(v0[0], 32); pr[1] = __shfl_xor(v0[1], 32); pr[2] = __shfl_xor(v0[2], 32); pr[3] = __shfl_xor(v0[3], 32);
          acc[AI][BJ][m][0] = (fq < 2) ? v0 * tc[m] - pr * ts[m] : v0 * tc[m] + pr * ts[m];
        }
      }
      if (blk < 20) {
        const float sc = 0.125f * 1.4426950408889634f;
#pragma unroll
        for (int m = 0; m < 4; ++m) { acc[AI][BJ][m][0] *= sc; acc[AI][BJ][m][1] *= sc; }
      }
    }
  }
  template <int AI, int BJ>
  DI void emit(f32x4 (&acc)[2][2][4][2], const pg8::Unit& u, int blk, bool samp, int wr, int wc, int fr, int fq) const {
    if (blk == 31) return;
    LAS unsigned char* hl = hl0 + wr * 16384;
    asm volatile("" : "+v"(fr), "+v"(fq));
    const int lane = fr + 16 * fq;
    const int P0 = 32 * wc + 4 * fq;
    const int R0 = u.pm * 256 + AI * 128 + wr * 64;
    int b, tb;
    if (!samp) { b = R0 >> 11; tb = R0 & 2047; } else { b = (R0 - NPROMPT) >> 6; tb = 0; }
    const bool retk = blk < 8;
    const bool hasT = (blk >= 4 && blk < 12) || blk == 21;
    const bool hasN = !(blk >= 8 && blk < 12) && blk != 21;
    if (blk == 20 || blk == 21) {
      float* ob = samp ? p.out + (blk == 20 ? OUT_KS : OUT_VS) + (unsigned)(R0 - NPROMPT) * 128u : p.out + (blk == 20 ? OUT_KP : OUT_VP) + (unsigned)R0 * 128u;
#pragma unroll
      for (int m = 0; m < 4; ++m) {
        float* o2 = ob + (unsigned)(16 * m + fr) * 128u + P0;
        *(f32x4*)o2 = acc[AI][BJ][m][0]; *(f32x4*)(o2 + 16) = acc[AI][BJ][m][1];
      }
    } else if (blk == 30) {
      float* ob = samp ? p.out + OUT_KIS + (unsigned)(R0 - NPROMPT) * 64u : p.out + OUT_KIP + (unsigned)R0 * 64u;
      float* wb = p.wi() + (unsigned)R0 * 8u;
#pragma unroll
      for (int m = 0; m < 4; ++m) {
        if (wc < 2) {
          float* o2 = ob + (unsigned)(16 * m + fr) * 64u + P0;
          *(f32x4*)o2 = acc[AI][BJ][m][0]; *(f32x4*)(o2 + 16) = acc[AI][BJ][m][1];
        } else if (wc == 2 && fq < 2) {
          *(f32x4*)(wb + (unsigned)(16 * m + fr) * 8u + 4 * fq) = acc[AI][BJ][m][0] * 0.044194173824159216f;
        }
      }
    }
    if (hasN) {
#pragma unroll
      for (int m = 0; m < 4; ++m)
#pragma unroll
        for (int n = 0; n < 2; ++n) {
          const int c8 = retk ? (16 * n + 4 * wc + fq) : (8 * wc + 4 * n + fq);
          *(LAS s16x4*)(hl + hx_w(16 * m + fr, c8)) = pack4(acc[AI][BJ][m][n]);
        }
      u16* nb; unsigned pitch = 512u, hstr = 0u, cm = 15u;
      if (blk < 4) nb = p.qr() + (unsigned)R0 * 512u + (blk & 3) * 128;
      else if (blk < 8) nb = p.kr() + (unsigned)R0 * 512u + (blk & 3) * 128;
      else if (blk < 16) { nb = p.gate() + (unsigned)R0 * 1024u + (blk - 12) * 128; pitch = 1024u; }
      else if (blk < 20) nb = p.qa() + (unsigned)R0 * 512u + (blk - 16) * 128;
      else if (blk == 20) { nb = samp ? p.kaS() + ((unsigned)(b * 2) * 2112u + 2048u) * 64u : p.kaP() + ((unsigned)(b * 2) * 2048u + tb) * 64u; pitch = 64u; hstr = samp ? 2112u * 64u : 2048u * 64u; cm = 7u; }
      else if (blk < 26) { nb = p.gate() + (unsigned)R0 * 1024u + 512 + (blk - 22) * 128; pitch = 1024u; }
      else if (blk < 30) nb = p.qi() + (unsigned)R0 * 512u + (blk - 26) * 128;
      else { nb = samp ? p.kiS() + ((unsigned)b * 2112u + 2048u) * 64u : p.kiP() + ((unsigned)b * 2048u + tb) * 64u; pitch = 64u; cm = 7u; }
      EPI_BAR();
      const unsigned c16 = lane & 15;
      const unsigned loff = (c16 >> 3) * hstr + (c16 & cm) * 8u;
#pragma unroll
      for (int i = 0; i < 4; ++i) {
        const int row = 16 * wc + 4 * i + (lane >> 4);
        const bf16x8 v = *(const LAS bf16x8*)(hl + hx_r(row, c16));
        if (blk != 30 || c16 < 8) *(bf16x8*)(nb + (unsigned)row * pitch + loff) = v;
      }
      EPI_BAR();
    }
    if (hasT) {
      const float l2g = log2gamma(blk & 3);
#pragma unroll
      for (int m = 0; m < 4; ++m) {
        const int tok = 16 * m + fr;
        const float dec = (blk < 8) ? exp2f((float)(63 - tok) * l2g) : 1.f;
#pragma unroll
        for (int n = 0; n < 2; ++n) {
          const int fb = retk ? (64 * n + 16 * wc + 4 * fq) : (32 * wc + 16 * n + 4 * fq);
#pragma unroll
          for (int j = 0; j < 4; ++j) {
            const int f = fb + j;
            *(LAS u16*)(hl + f * 128 + ((((tok >> 3) ^ (f >> 2)) & 7) << 4) + (tok & 7) * 2) = f2bf(acc[AI][BJ][m][n][j] * dec);
          }
        }
      }
      u16* tbp; unsigned fstr;
      if (blk < 12) {
        u16* base = (blk < 8) ? p.krT() : p.vrT();
        const unsigned bh = (unsigned)(b * 4 + (blk & 3)) * 128u;
        tbp = samp ? base + 64u * 128u * 2048u + bh * 64u : base + bh * 2048u + tb;
        fstr = samp ? 64u : 2048u;
      } else {
        tbp = samp ? p.vaTS() + (unsigned)b * 128u * 2112u + 2048u : p.vaTP() + (unsigned)b * 128u * 2048u + tb;
        fstr = samp ? 2112u : 2048u;
      }
      EPI_BAR();
#pragma unroll
      for (int i = 0; i < 4; ++i) {
        const int f = 32 * wc + 8 * i + (lane >> 3), ch = lane & 7;
        const bf16x8 v = *(const LAS bf16x8*)(hl + f * 128 + (((ch ^ (f >> 2)) & 7) << 4));
        *(bf16x8*)(tbp + (unsigned)f * fstr + ch * 8) = v;
      }
      EPI_BAR();
    }
  }
  DI void operator()(f32x4 (&acc)[2][2][4][2], const pg8::Unit& u, int wr, int wc, int fr, int fq, int re) const {
    const bool samp = (u.pm * 256 >= NPROMPT);
    const int tclass = (u.pn < 4) ? 1 : ((u.pn == 8 || u.pn == 9 || u.pn == 10 || u.pn >= 13) ? 2 : 0);
    const int blk0 = u.pn * 2, blk1 = u.pn * 2 + 1;
    float rvv[2][4];
#pragma unroll
    for (int ai = 0; ai < 2; ++ai)
#pragma unroll
      for (int m = 0; m < 4; ++m) rvv[ai][m] = (1.f / REPK) * p.rinv()[u.pm * 256 + ai * 128 + wr * 64 + 16 * m + fr];
    f32x4 tc[4], ts[4];
    load_tabs(tc, ts, tclass, u.pm * 256 + wr * 64, samp, wc, fr, fq);
#pragma unroll
    for (int ai = 0; ai < 2; ++ai)
#pragma unroll
      for (int m = 0; m < 4; ++m)
#pragma unroll
        for (int bj = 0; bj < 2; ++bj)
#pragma unroll
          for (int n = 0; n < 2; ++n) acc[ai][bj][m][n] *= rvv[ai][m];
    compute<0, 0>(acc, tc, ts, blk0, wc, fq);
    compute<0, 1>(acc, tc, ts, blk1, wc, fq);
    load_tabs(tc, ts, tclass, u.pm * 256 + 128 + wr * 64, samp, wc, fr, fq);
    compute<1, 0>(acc, tc, ts, blk0, wc, fq);
    compute<1, 1>(acc, tc, ts, blk1, wc, fq);
    emit<0, 0>(acc, u, blk0, samp, wr, wc, fr, fq);
    emit<0, 1>(acc, u, blk1, samp, wr, wc, fr, fq);
    emit<1, 0>(acc, u, blk0, samp, wr, wc, fr, fq);
    emit<1, 1>(acc, u, blk1, samp, wr, wc, fr, fq);
  }
};

struct Epi2 {
  Params p; unsigned char* hl;
  DI void operator()(f32x4 (&acc)[2][2][4][2], const pg8::Unit& u, int wr, int wc, int fr, int fq, int re) const {
    u16* z = p.gate();
    const int lane = fr + 16 * fq;
#pragma unroll
    for (int ai = 0; ai < 2; ++ai)
#pragma unroll
      for (int bj = 0; bj < 2; ++bj) {
#pragma unroll
        for (int m = 0; m < 4; ++m)
#pragma unroll
          for (int n = 0; n < 2; ++n)
            *(s16x4*)(hl + hx_w(16 * m + fr, 8 * wc + 4 * n + fq)) = pack4(acc[ai][bj][m][n] * (1.f / REPK));
        EPI_BAR();
        const unsigned R0 = u.pm * 256 + ai * 128 + wr * 64;
        const unsigned cb = u.pn * 256 + bj * 128;
#pragma unroll
        for (int i = 0; i < 4; ++i) {
          const int row = 16 * wc + 4 * i + (lane >> 4), c16 = lane & 15;
          const bf16x8 v = *(const bf16x8*)(hl + hx_r(row, c16));
          *(bf16x8*)(z + (R0 + row) * 1024u + cb + c16 * 8) = v;
        }
        EPI_BAR();
      }
  }
};

DI void ret_kv_item(const Params& p, int item, int tid) {
  const int lane = tid & 63, w = tid >> 6, r = lane & 31, hh = lane >> 5;
  const u16 *kT, *vT; int T, c;
  if (item < 2048) { const int bh = item >> 5; c = item & 31; T = 2048; kT = p.krT() + (size_t)bh * 128 * 2048; vT = p.vrT() + (size_t)bh * 128 * 2048; }
  else { const int bh = item - 2048; c = 0; T = 64; kT = p.krT() + (size_t)64 * 128 * 2048 + (size_t)bh * 128 * 64; vT = p.vrT() + (size_t)64 * 128 * 2048 + (size_t)bh * 128 * 64; }
  const int e0 = (w & 1) * 64, d0 = (w >> 1) * 64;
  f32x16 acc[2][2];
  acc[0][0] = zero16(); acc[0][1] = zero16(); acc[1][0] = zero16(); acc[1][1] = zero16();
#pragma unroll
  for (int ks = 0; ks < 4; ++ks) {
    bf16x8 a0 = ldg8(vT + (size_t)(e0 + r) * T + c * 64 + ks * 16 + hh * 8);
    bf16x8 a1 = ldg8(vT + (size_t)(e0 + 32 + r) * T + c * 64 + ks * 16 + hh * 8);
    bf16x8 b0 = ldg8(kT + (size_t)(d0 + r) * T + c * 64 + ks * 16 + hh * 8);
    bf16x8 b1 = ldg8(kT + (size_t)(d0 + 32 + r) * T + c * 64 + ks * 16 + hh * 8);
    acc[0][0] = MFMA32(a0, b0, acc[0][0]);
    acc[0][1] = MFMA32(a0, b1, acc[0][1]);
    acc[1][0] = MFMA32(a1, b0, acc[1][0]);
    acc[1][1] = MFMA32(a1, b1, acc[1][1]);
  }
  u16* o = (u16*)p.kvT() + (size_t)item * 16384;
#pragma unroll
  for (int a = 0; a < 2; ++a)
#pragma unroll
    for (int b = 0; b < 2; ++b)
#pragma unroll
      for (int i = 0; i < 16; ++i)
        o[(e0 + a * 32 + crow(i, hh)) * 128 + d0 + b * 32 + r] = f2bf(acc[a][b][i]);
}

template <int NS>
DI void select_query(const u16* krow, int nj, int lane, u64* dst) {
  unsigned key[NS];
#pragma unroll
  for (int j = 0; j < NS; ++j) { const unsigned k = krow[j * 64 + lane]; key[j] = (j < nj) ? k : 0u; }
  constexpr int NP = (NS + 1) / 2;
  unsigned pk[NP];
#pragma unroll
  for (int i = 0; i < NP; ++i) pk[i] = key[2 * i] | ((2 * i + 1 < NS ? key[2 * i + 1] : 0u) << 16);
  unsigned prefix = 0;
  int cntp = 0;
  const unsigned ones = 0x00010001u;
  for (int bit = 15; bit >= 0; --bit) {
    const unsigned cand = prefix | (1u << bit);
    const unsigned c1 = cand - 1u;
    const unsigned cv = c1 | (c1 << 16);
    unsigned acc0 = 0, acc1 = 0;
#pragma unroll
    for (int i = 0; i < NP; ++i) {
      unsigned d, m;
      asm("v_pk_sub_u16 %0, %1, %2 clamp" : "=v"(d) : "v"(pk[i]), "v"(cv));
      asm("v_pk_min_u16 %0, %1, %2" : "=v"(m) : "v"(d), "v"(ones));
      if (i & 1) acc1 += m; else acc0 += m;
    }
    const unsigned a = acc0 + acc1;
    const int cnt = wave_sum((int)((a & 0xffffu) + (a >> 16)));
    if (cnt >= 256) { prefix = cand; cntp = cnt; }
    if (cnt == 256) break;
  }
  int wlo = 0, whi = 0;
  if (cntp == 256) {
#pragma unroll
    for (int j = 0; j < NS; ++j) {
      const u64 sm = __ballot(key[j] >= prefix);
      if (lane == j) { wlo = (int)(unsigned)sm; whi = (int)(unsigned)(sm >> 32); }
    }
  } else {
    int cgt = 0;
#pragma unroll
    for (int j = 0; j < NS; ++j) cgt += (key[j] > prefix) ? 1 : 0;
    cgt = wave_sum(cgt);
    const int rneed = 256 - cgt;
    int running = 0;
    const u64 lt = (1ull << lane) - 1ull;
#pragma unroll
    for (int j = 0; j < NS; ++j) {
      const bool eq = key[j] == prefix;
      const u64 em = __ballot(eq);
      const int rank = running + __popcll(em & lt);
      const bool sel = (key[j] > prefix) || (eq && rank < rneed);
      const u64 sm = __ballot(sel);
      if (lane == j) { wlo = (int)(unsigned)sm; whi = (int)(unsigned)(sm >> 32); }
      running += __popcll(em);
    }
  }
  if (lane < nj) dst[lane] = ((u64)(unsigned)whi << 32) | (u64)(unsigned)wlo;
}

DI void idx_item(const Params& p, unsigned char* lds, int tid, bool samp, int b, int grp) {
  const int lane = tid & 63, w = tid >> 6;
  const int t0 = grp * 16;
  int L, g0; const u16* ki;
  if (!samp) { const int c = t0 >> 6; L = (c + 1) * 64; g0 = b * 2048 + t0; ki = p.kiP() + (size_t)b * 2048 * 64; }
  else { L = 2112; g0 = NPROMPT + b * 64 + t0; ki = p.kiS() + (size_t)b * 2112 * 64; }
  const int nj = L >> 6;
  if (L <= 256) {
    for (int qq = 0; qq < 4; ++qq) {
      const int q = w * 4 + qq;
      if (lane < nj) p.maskbits()[(size_t)(g0 + q) * 33 + lane] = ~0ull;
    }
    return;
  }
  u16* keys = (u16*)lds;
#ifndef REPMF
#define REPMF 1
#endif
#ifndef REPSEL
#define REPSEL 1
#endif
#ifndef REPKV
#define REPKV 1
#endif
  for (int rmf = 0; rmf < REPMF; ++rmf) {
    const int qn = lane & 15, quad = lane >> 4;
    bf16x8 qf[8][2];
    float wv[8];
#pragma unroll
    for (int h = 0; h < 8; ++h) {
      qf[h][0] = ldg8(p.qi() + (size_t)(g0 + qn) * 512 + h * 64 + quad * 8);
      qf[h][1] = ldg8(p.qi() + (size_t)(g0 + qn) * 512 + h * 64 + 32 + quad * 8);
      wv[h] = p.wi()[(size_t)(g0 + qn) * 8 + h];
    }
    bf16x8 A0[4], A1[4], N0[4], N1[4];
#pragma unroll
    for (int i = 0; i < 4; ++i) {
      const int kt = w + 4 * i;
      A0[i] = ldg8(ki + (size_t)(kt * 16 + qn) * 64 + quad * 8);
      A1[i] = ldg8(ki + (size_t)(kt * 16 + qn) * 64 + 32 + quad * 8);
    }
    for (int base = 0; base < nj; base += 4) {
#pragma unroll
      for (int i = 0; i < 4; ++i) {
        const int t = min(base + 4 + i, nj - 1);
        const int kt = w + 4 * t;
        N0[i] = ldg8(ki + (size_t)(kt * 16 + qn) * 64 + quad * 8);
        N1[i] = ldg8(ki + (size_t)(kt * 16 + qn) * 64 + 32 + quad * 8);
      }
#pragma unroll
      for (int i = 0; i < 4; ++i) {
        const int t = base + i;
        if (t < nj) {
          const int kt = w + 4 * t;
          float idx[4] = {0.f, 0.f, 0.f, 0.f};
#pragma unroll
          for (int h = 0; h < 8; ++h) {
            f32x4 acc = {0.f, 0.f, 0.f, 0.f};
            acc = MFMA16(A0[i], qf[h][0], acc);
            acc = MFMA16(A1[i], qf[h][1], acc);
#pragma unroll
            for (int e = 0; e < 4; ++e) idx[e] += fmaxf(acc[e], 0.f) * wv[h];
          }
          s16x4 kv;
#pragma unroll
          for (int e = 0; e < 4; ++e) {
            _Float16 hv = (_Float16)idx[e];
            u16 bits = __builtin_bit_cast(u16, hv);
            kv[e] = (short)((bits & 0x8000) ? (u16)~bits : (u16)(bits | 0x8000));
          }
          *(s16x4*)(keys + qn * KPITCH + kt * 16 + quad * 4) = kv;
        }
      }
#pragma unroll
      for (int i = 0; i < 4; ++i) { A0[i] = N0[i]; A1[i] = N1[i]; }
    }
  }
  __syncthreads();
  for (int qq = 0; qq < 4 * REPSEL; ++qq) {
    const int q = w * 4 + (qq & 3);
    const u16* krow = keys + q * KPITCH;
    u64* dst = p.maskbits() + (size_t)(g0 + q) * 33;
    if (nj <= 8) select_query<8>(krow, nj, lane, dst);
    else if (nj <= 16) select_query<16>(krow, nj, lane, dst);
    else if (nj <= 24) select_query<24>(krow, nj, lane, dst);
    else select_query<33>(krow, nj, lane, dst);
  }
  __syncthreads();
}

DI void scan_item(const Params& p, int item, int tid) {
  if (item < 1024) {
    const int bh = item >> 4, slab = item & 15;
    const int idx = slab * 1024 + tid * 4;
    const int h = bh & 3;
    const float cd = exp2f(64.f * log2gamma(h));
    f32x4 s = {0.f, 0.f, 0.f, 0.f};
    for (int c0 = 0; c0 < 32; c0 += 8) {
      f32x4 kvb[8];
#pragma unroll
      for (int i = 0; i < 8; ++i) {
        const s16x4 kk = *(const s16x4*)((const u16*)p.kvT() + (size_t)(bh * 32 + c0 + i) * 16384 + idx);
#pragma unroll
        for (int j = 0; j < 4; ++j) kvb[i][j] = __uint_as_float(((unsigned)(u16)kk[j]) << 16);
      }
#pragma unroll
      for (int i = 0; i < 8; ++i) {
        *(s16x4*)(p.sprevT() + (size_t)(bh * 32 + c0 + i) * 16384 + idx) = pack4(s);
        s = s * cd + kvb[i];
      }
    }
    const int e = idx >> 7, d = idx & 127;
    float* o = p.out + OUT_STP + (size_t)bh * 16384;
#pragma unroll
    for (int j = 0; j < 4; ++j) o[(d + j) * 128 + e] = s[j];
  } else {
    const int it = item - 1024;
    const int bh = it >> 4, slab = it & 15;
    const int idx = slab * 1024 + tid * 4;
    const int h = bh & 3;
    const float cd = exp2f(64.f * log2gamma(h));
    const int e = idx >> 7, d = idx & 127;
    const float* s0 = p.state_ret + (size_t)bh * 16384;
    f32x4 s;
#pragma unroll
    for (int j = 0; j < 4; ++j) s[j] = s0[(d + j) * 128 + e];
    const size_t base = (size_t)(2048 + bh) * 16384 + idx;
    s16x4 o = pack4(s);
    *(s16x4*)(p.sprevT() + base) = o;
    const s16x4 kk = *(const s16x4*)((const u16*)p.kvT() + base);
    f32x4 kv;
#pragma unroll
    for (int j = 0; j < 4; ++j) kv[j] = __uint_as_float(((unsigned)(u16)kk[j]) << 16);
    s = s * cd + kv;
    float* oo = p.out + OUT_STS + (size_t)bh * 16384;
#pragma unroll
    for (int j = 0; j < 4; ++j) oo[(d + j) * 128 + e] = s[j];
  }
}

DI void attn_item(const Params& p, unsigned char* lds, int tid, bool samp, int b, int c, int kvh, int qh, unsigned char* lds_blk, int tid512) {
  const int lane = tid & 63, w = tid >> 6, r = lane & 31, hh = lane >> 5;
  const int T = samp ? 2112 : 2048;
  const int nkt = samp ? 33 : c + 1;
  const int g0 = (samp ? NPROMPT + b * 64 : b * 2048 + c * 64) + qh * 32;
  const u16* K = samp ? p.kaS() + (size_t)(b * 2 + kvh) * 2112 * 64 : p.kaP() + (size_t)(b * 2 + kvh) * 2048 * 64;
  const u16* VT = samp ? p.vaTS() + (size_t)(b * 2 + kvh) * 64 * 2112 : p.vaTP() + (size_t)(b * 2 + kvh) * 64 * 2048;
  const int head = kvh * 4 + w;
  u16* Ks = (u16*)(lds_blk + 2 * HALF_LDS - 2 * 9216);
  u16* Vs = Ks + 64 * 72;
  u64* mL = (u64*)lds;
  {
    u64 mv[5];
#pragma unroll
    for (int i = 0; i < 5; ++i) { const int ix = tid + 256 * i; mv[i] = p.maskbits()[(size_t)g0 * 33 + (ix < 32 * 33 ? ix : 32 * 33 - 1)]; }
#pragma unroll
    for (int i = 0; i < 5; ++i) { const int ix = tid + 256 * i; if (ix < 32 * 33) mL[ix] = mv[i]; }
  }
  bf16x8 qf[4];
#pragma unroll
  for (int ks = 0; ks < 4; ++ks) qf[ks] = ldg8(p.qa() + (size_t)(g0 + r) * 512 + head * 64 + ks * 16 + hh * 8);
  f32x16 O[2];
  O[0] = zero16(); O[1] = zero16();
  float mrun = -1e30f, lrun = 0.f;
  const int lrow = tid512 >> 3, lch = tid512 & 7;
  bf16x8 pk0, pv0, nk0, nv0;
  pk0 = ldg8(K + (size_t)(lrow)*64 + lch * 8);
  pv0 = ldg8(VT + (size_t)(lrow)*T + lch * 8);
  nk0 = pk0; nv0 = pv0;
  if (nkt > 1) {
    nk0 = ldg8(K + (size_t)(64 + lrow) * 64 + lch * 8);
    nv0 = ldg8(VT + (size_t)(lrow)*T + 64 + lch * 8);
  }
  for (int kt = 0; kt < nkt; ++kt) {
    __syncthreads();
    *(bf16x8*)(Ks + lrow * 72 + lch * 8) = pk0;
    *(bf16x8*)(Vs + lrow * 72 + lch * 8) = pv0;
    __syncthreads();
    pk0 = nk0; pv0 = nv0;
    if (kt + 2 < nkt) {
      nk0 = ldg8(K + (size_t)((kt + 2) * 64 + lrow) * 64 + lch * 8);
      nv0 = ldg8(VT + (size_t)(lrow)*T + (kt + 2) * 64 + lch * 8);
    }
    f32x16 S[2];
#pragma unroll
    for (int st = 0; st < 2; ++st) {
      S[st] = zero16();
#pragma unroll
      for (int ks = 0; ks < 4; ++ks) {
        bf16x8 kf = *(const bf16x8*)(Ks + (st * 32 + r) * 72 + ks * 16 + hh * 8);
        S[st] = MFMA32(kf, qf[ks], S[st]);
      }
    }
    const u64 W = mL[r * 33 + kt];
    const int wl = (int)(((unsigned)W) >> (4 * hh)), wh = (int)(((unsigned)(W >> 32)) >> (4 * hh));
    float mx = fmaxf(S[0][0], S[1][0]);
#pragma unroll
    for (int i = 1; i < 16; ++i) mx = fmaxf(mx, fmaxf(S[0][i], S[1][i]));
    mx = fmaxf(mx, __shfl_xor(mx, 32));
    const float mn = fmaxf(mrun, mx);
    const float alpha = __builtin_amdgcn_exp2f(mrun - mn);
    const bool resc = __any(mn != mrun);
    mrun = mn;
    float ls = 0.f;
#pragma unroll
    for (int st = 0; st < 2; ++st)
#pragma unroll
      for (int i = 0; i < 16; ++i) {
        const int keep = __builtin_amdgcn_sbfe(st ? wh : wl, (i & 3) + 8 * (i >> 2), 1);
        const float pvv = __int_as_float(__float_as_int(__builtin_amdgcn_exp2f(S[st][i] - mn)) & keep);
        S[st][i] = pvv;
        ls += pvv;
      }
    lrun = lrun * alpha + ls;
    if (resc) {
#pragma unroll
      for (int dt = 0; dt < 2; ++dt)
#pragma unroll
        for (int i = 0; i < 16; ++i) O[dt][i] *= alpha;
    }
#pragma unroll
    for (int st = 0; st < 2; ++st)
#pragma unroll
      for (int s2 = 0; s2 < 2; ++s2) {
        bf16x8 pf = pack8(S[st][8 * s2 + 0], S[st][8 * s2 + 1], S[st][8 * s2 + 2], S[st][8 * s2 + 3],
                          S[st][8 * s2 + 4], S[st][8 * s2 + 5], S[st][8 * s2 + 6], S[st][8 * s2 + 7]);
#pragma unroll
        for (int dt = 0; dt < 2; ++dt) {
          s16x4 lo = *(const s16x4*)(Vs + (dt * 32 + r) * 72 + st * 32 + 16 * s2 + 4 * hh);
          s16x4 hi = *(const s16x4*)(Vs + (dt * 32 + r) * 72 + st * 32 + 16 * s2 + 8 + 4 * hh);
          bf16x8 vf = __builtin_shufflevector(lo, hi, 0, 1, 2, 3, 4, 5, 6, 7);
          O[dt] = MFMA32(vf, pf, O[dt]);
        }
      }
  }
  {
    float lt = lrun + __shfl_xor(lrun, 32);
    const float inv = 1.f / fmaxf(lt, 1e-30f);
    const u16* grow = p.gate() + (size_t)(g0 + r) * 1024 + 512 + head * 64;
    u16* mrow = p.mix() + (size_t)(g0 + r) * 1024 + 512 + head * 64;
    s16x4 gvv[2][4];
#pragma unroll
    for (int dt = 0; dt < 2; ++dt)
#pragma unroll
      for (int q4 = 0; q4 < 4; ++q4) gvv[dt][q4] = *(const s16x4*)(grow + dt * 32 + 8 * q4 + 4 * hh);
#pragma unroll
    for (int dt = 0; dt < 2; ++dt)
#pragma unroll
      for (int q4 = 0; q4 < 4; ++q4) {
        const int d = dt * 32 + 8 * q4 + 4 * hh;
        f32x4 of;
#pragma unroll
        for (int j = 0; j < 4; ++j) {
          const float gf = __uint_as_float(((unsigned)(u16)gvv[dt][q4][j]) << 16);
          of[j] = O[dt][q4 * 4 + j] * inv * gf;
        }
        *(s16x4*)(mrow + d) = pack4(of);
      }
  }
  __syncthreads();
}

DI void ret_out_item(const Params& p, unsigned char* lds, int item, int tid) {
  const int lane = tid & 63, w = tid >> 6, r = lane & 31, hh = lane >> 5;
  int bh, c, T, g0; const u16* vT;
  if (item < 2048) { bh = item >> 5; c = item & 31; T = 2048; g0 = (bh >> 2) * 2048 + c * 64; vT = p.vrT() + (size_t)bh * 128 * 2048; }
  else { bh = item - 2048; c = 0; T = 64; g0 = NPROMPT + (bh >> 2) * 64; vT = p.vrT() + (size_t)64 * 128 * 2048 + (size_t)bh * 128 * 64; }
  const int h = bh & 3;
  const float l2g = log2gamma(h);
  const int nt = w & 1, eh = w >> 1;
  const int n = nt * 32 + r;
  bf16x8 qf[8], kf[8];
#pragma unroll
  for (int ks = 0; ks < 8; ++ks) qf[ks] = ldg8(p.qr() + (size_t)(g0 + n) * 512 + h * 128 + ks * 16 + hh * 8);
#pragma unroll
  for (int ks = 0; ks < 8; ++ks) kf[ks] = ldg8(p.kr() + (size_t)(g0 + r) * 512 + h * 128 + ks * 16 + hh * 8);
  __builtin_amdgcn_sched_barrier(0);
  bf16x8 pf[2][2];
#pragma unroll
  for (int mt = 0; mt < 2; ++mt) {
    f32x16 S = zero16();
#pragma unroll
    for (int ks = 0; ks < 8; ++ks) S = MFMA32(kf[ks], qf[ks], S);
    if (mt == 0) {
#pragma unroll
      for (int ks = 0; ks < 8; ++ks) kf[ks] = ldg8(p.kr() + (size_t)(g0 + 32 + r) * 512 + h * 128 + ks * 16 + hh * 8);
      __builtin_amdgcn_sched_barrier(0);
    }
#pragma unroll
    for (int i = 0; i < 16; ++i) {
      const int m = mt * 32 + crow(i, hh);
      const int dd = n > m ? n - m : m - n;
      S[i] *= exp2f((float)dd * l2g);
    }
    pf[mt][0] = pack8(S[0], S[1], S[2], S[3], S[4], S[5], S[6], S[7]);
    pf[mt][1] = pack8(S[8], S[9], S[10], S[11], S[12], S[13], S[14], S[15]);
  }
  const float fs = exp2f((float)(n + 1) * l2g);
  const u16* sp = p.sprevT() + (size_t)item * 16384;
  f32x16 tot[2];
  float ss = 0.f;
  s16x4 vlo[2][2][2], vhi[2][2][2];
#pragma unroll
  for (int et = 0; et < 2; ++et)
#pragma unroll
    for (int mt = 0; mt < 2; ++mt)
#pragma unroll
      for (int s2 = 0; s2 < 2; ++s2) {
        const u16* vp = vT + (size_t)((2 * eh + et) * 32 + r) * T + c * 64 + mt * 32 + 16 * s2 + 4 * hh;
        vlo[et][mt][s2] = ldg4(vp); vhi[et][mt][s2] = ldg4(vp + 8);
      }
  __builtin_amdgcn_sched_barrier(0);
#pragma unroll
  for (int et = 0; et < 2; ++et) {
    const int e = (2 * eh + et) * 32 + r;
    bf16x8 sf[8];
#pragma unroll
    for (int ks = 0; ks < 8; ++ks) sf[ks] = ldg8(sp + (size_t)e * 128 + ks * 16 + hh * 8);
    __builtin_amdgcn_sched_barrier(0);
    f32x16 Oi = zero16(), X = zero16();
#pragma unroll
    for (int mt = 0; mt < 2; ++mt)
#pragma unroll
      for (int s2 = 0; s2 < 2; ++s2) {
        bf16x8 vf = __builtin_shufflevector(vlo[et][mt][s2], vhi[et][mt][s2], 0, 1, 2, 3, 4, 5, 6, 7);
        Oi = MFMA32(vf, pf[mt][s2], Oi);
      }
#pragma unroll
    for (int ks = 0; ks < 8; ++ks) X = MFMA32(sf[ks], qf[ks], X);
#pragma unroll
    for (int i = 0; i < 16; ++i) { const float t = Oi[i] + X[i] * fs; tot[et][i] = t; ss += t * t; }
  }
  ss += __shfl_xor(ss, 32);
  float* red = (float*)lds;
  __syncthreads();
  if (hh == 0) red[w * 32 + r] = ss;
  __syncthreads();
  const float tsum = red[w * 32 + r] + red[(w ^ 2) * 32 + r];
  const float rinv = rsqrtf(tsum * (1.f / 128.f) + 1e-6f);
  const u16* grow = p.gate() + (size_t)(g0 + n) * 1024 + h * 128;
  u16* mrow = p.mix() + (size_t)(g0 + n) * 1024 + h * 128;
  s16x4 gvv[2][4];
  f32x4 ggv[2][4];
#pragma unroll
  for (int et = 0; et < 2; ++et)
#pragma unroll
    for (int q4 = 0; q4 < 4; ++q4) {
      const int e = (2 * eh + et) * 32 + 8 * q4 + 4 * hh;
      gvv[et][q4] = *(const s16x4*)(grow + e);
      ggv[et][q4] = *(const f32x4*)(p.ret_gn_g + h * 128 + e);
    }
#pragma unroll
  for (int et = 0; et < 2; ++et)
#pragma unroll
    for (int q4 = 0; q4 < 4; ++q4) {
      const int e = (2 * eh + et) * 32 + 8 * q4 + 4 * hh;
      f32x4 of;
#pragma unroll
      for (int j = 0; j < 4; ++j) {
        const float gf = __uint_as_float(((unsigned)(u16)gvv[et][q4][j]) << 16);
        of[j] = tot[et][q4 * 4 + j] * rinv * ggv[et][q4][j] * gf;
      }
      *(s16x4*)(mrow + e) = pack4(of);
    }
}

DI void phase_final(const Params& p, int tid) {
  const int gt = blockIdx.x * 512 + tid, GT = gridDim.x * 512;
  const int lane = tid & 63;
  for (int row0 = (gt >> 6) * 2; row0 < NTOK; row0 += (GT >> 6) * 2) {
    f32x4 v[2][4];
    s16x4 zz[2][4];
#pragma unroll
    for (int rr = 0; rr < 2; ++rr) {
      const float* xr = xrow(p, row0 + rr);
      const u16* zr = p.gate() + (size_t)(row0 + rr) * 1024;
#pragma unroll
      for (int i = 0; i < 4; ++i) { v[rr][i] = *(const f32x4*)(xr + i * 256 + lane * 4); zz[rr][i] = *(const s16x4*)(zr + i * 256 + lane * 4); }
    }
    f32x4 g[4];
#pragma unroll
    for (int i = 0; i < 4; ++i) g[i] = *(const f32x4*)(p.final_g + i * 256 + lane * 4);
#pragma unroll
    for (int rr = 0; rr < 2; ++rr) {
      float ss = 0.f;
#pragma unroll
      for (int i = 0; i < 4; ++i) {
#pragma unroll
        for (int j = 0; j < 4; ++j) v[rr][i][j] += __uint_as_float(((unsigned)(u16)zz[rr][i][j]) << 16);
        ss += v[rr][i][0] * v[rr][i][0] + v[rr][i][1] * v[rr][i][1] + v[rr][i][2] * v[rr][i][2] + v[rr][i][3] * v[rr][i][3];
      }
#pragma unroll
      for (int o = 32; o >= 1; o >>= 1) ss += __shfl_xor(ss, o);
      const float rv = rsqrtf(ss * (1.f / 1024.f) + 1e-6f);
      float* y = p.out + OUT_Y + (size_t)(row0 + rr) * 1024;
#pragma unroll
      for (int i = 0; i < 4; ++i) *(f32x4*)(y + i * 256 + lane * 4) = v[rr][i] * rv * g[i];
    }
  }
}

#ifndef REP0
#define REP0 1
#endif
#ifndef REP1
#define REP1 1
#endif
#ifndef REP2
#define REP2 1
#endif
#ifndef REP3
#define REP3 1
#endif
#ifndef REP4
#define REP4 1
#endif
#ifndef REP5
#define REP5 1
#endif
__global__ void __launch_bounds__(512, 2) fwd_megakernel(Params p) {
  __shared__ __attribute__((aligned(16))) unsigned char lds[LDS_BYTES];
  cg::grid_group grid = cg::this_grid();
  const int wave_id = __builtin_amdgcn_readfirstlane((int)threadIdx.x >> 6);
#define FRESH_TID() int tid = wave_id * 64 + lane_id(); asm volatile("" : "+v"(tid)); const int half = tid >> 8, htid = tid & 255; unsigned char* ldsh = lds + half * HALF_LDS; (void)htid; (void)ldsh;
  if (p.out == nullptr) grid.sync();
  if (wave_id == 0 && lane_id() == 0) (void)xb_add(&p.bar()[XB_XCNT(xb_xcc_id())], 1u);
  for (int rep = 0; rep < REP0; ++rep) {
  { FRESH_TID(); phase_prep(p, tid); }
  xcd_barrier(p.bar(), wave_id);
  }
  for (int rep = 0; rep < REP1; ++rep) {
  {
    FRESH_TID();
    pg8::Gemm g; g.A = p.xb(); g.Bt = p.WtIn(); g.M = NTOK; g.N = 4096; g.K = 1024;
    pg8::StaticOrder S; S.init(g.M, g.N, (int)gridDim.x, (int)blockIdx.x); S.permtab = 0xEFBCD87694105A32ull; S.padtile = 15;
    Epi1 E; E.p = p; E.hl0 = (LAS unsigned char*)lds + pg8::STAGE_BYTES;
    pg8::gemm_phase<Epi1>((LAS unsigned char*)lds, g, S, E, wave_id);
  }
  xcd_barrier(p.bar(), wave_id);
  }
  for (int rep = 0; rep < REP2; ++rep) {
  {
    FRESH_TID();
    for (int it0 = blockIdx.x * 2; it0 < 2080 + 2080; it0 += gridDim.x * 2) {
      const int it = it0 + half;
      int ht = htid; asm volatile("" : "+v"(ht));
      if (it < 2080) {
        const bool samp = it < 32;
        const int j = it - 32;
        const int c = 31 - (j >> 6);
        const int b = samp ? (it >> 2) : ((j & 63) >> 2);
        const int grp = samp ? (it & 3) : (c * 4 + (j & 3));
        idx_item(p, ldsh, ht, samp, b, grp);
      } else { for (int rkv = 0; rkv < REPKV; ++rkv) ret_kv_item(p, it - 2080, ht); }
    }
  }
  xcd_barrier(p.bar(), wave_id);
  }
  for (int rep = 0; rep < REP3; ++rep) {
  {
    FRESH_TID();
    for (int it0 = blockIdx.x * 2; it0 < 1056 + 1536; it0 += gridDim.x * 2) {
      const int it = it0 + half;
      int ht = htid; asm volatile("" : "+v"(ht));
      if (it < 1056) {
        const bool samp = it < 32;
        const int j = it - 32;
        int c = samp ? 0 : 31 - (j >> 6);
        int b = samp ? (it >> 2) : ((j & 63) >> 2);
        int kvh = (it >> 1) & 1;
        if (!samp && gridDim.x == 256) {
          const int jb = (j >> 1) & 255, rnd = j >> 9;
          const int xcd = jb & 7, ii = jb >> 3;
          b = 2 * xcd + (ii & 1); kvh = (ii >> 1) & 1; c = 31 - rnd * 8 - (ii >> 2);
        }
        attn_item(p, ldsh, ht, samp, b, c, kvh, it & 1, lds, tid);
      } else scan_item(p, it - 1056, ht);
    }
  }
  xcd_barrier(p.bar(), wave_id);
  }
  for (int rep = 0; rep < REP4; ++rep) {
  {
    FRESH_TID();
    for (int it0 = blockIdx.x * 2; it0 < 2080 + 1024; it0 += gridDim.x * 2) {
      const int it = it0 + half;
      int ht = htid; asm volatile("" : "+v"(ht));
      if (it < 2080) ret_out_item(p, ldsh, it, ht);
      else {
        const int ia = it - 2080 + 1056;
        const int j = ia - 32;
        int c = 31 - (j >> 6);
        int b = (j & 63) >> 2;
        int kvh = (ia >> 1) & 1;
        if (gridDim.x == 256) {
          const int jb = (j >> 1) & 255, rnd = j >> 9;
          const int xcd = jb & 7, ii = jb >> 3;
          b = 2 * xcd + (ii & 1); kvh = (ii >> 1) & 1; c = 31 - rnd * 8 - (ii >> 2);
        }
        attn_item(p, ldsh, ht, false, b, c, kvh, ia & 1, lds, tid);
      }
    }
  }
  xcd_barrier(p.bar(), wave_id);
  }
  for (int rep = 0; rep < REP5; ++rep) {
  {
    pg8::Gemm g; g.A = p.mix(); g.Bt = p.WtOut(); g.M = NTOK; g.N = 1024; g.K = 1024;
    pg8::StaticOrder S; S.init(g.M, g.N, (int)gridDim.x, (int)blockIdx.x);
    Epi2 E; E.p = p; E.hl = lds + pg8::STAGE_BYTES + (wave_id >> 2) * 16384;
    pg8::gemm_phase<Epi2>((LAS unsigned char*)lds, g, S, E, wave_id);
  }
  xcd_barrier(p.bar(), wave_id);
  }
  { FRESH_TID(); phase_final(p, tid); }
}

extern "C" void kernel_launch(void* const* d_in, const int* in_sizes, int n_in, void* d_out, int out_size, void* d_ws,
                              size_t ws_size, hipStream_t stream) {
  static int grid_blocks = 0;
  if (!grid_blocks) {
    int dev = 0, cus = 0, per_cu = 0;
    (void)hipGetDevice(&dev);
    (void)hipDeviceGetAttribute(&cus, hipDeviceAttributeMultiprocessorCount, dev);
    (void)hipOccupancyMaxActiveBlocksPerMultiprocessor(&per_cu, fwd_megakernel, 512, 0);
    if (per_cu < 1) per_cu = 1;
    if (per_cu > 1) per_cu = 1;
    grid_blocks = cus * per_cu;
  }
  Params p{};
  p.x_p = (const float*)d_in[0]; p.x_s = (const float*)d_in[1]; p.state_ret = (const float*)d_in[2];
  p.cache_k = (const float*)d_in[3]; p.cache_v = (const float*)d_in[4]; p.cache_kidx = (const float*)d_in[5];
  p.norm_g = (const float*)d_in[6]; p.w_in = (const float*)d_in[7]; p.ret_gn_g = (const float*)d_in[8];
  p.w_out = (const float*)d_in[9]; p.final_g = (const float*)d_in[10];
  p.out = (float*)d_out;
  p.ws = (unsigned char*)d_ws;
  (void)hipMemsetAsync((unsigned char*)d_ws + 530573312ull, 0, (size_t)XCD_BAR_WORDS * 4, stream);
  void* args[] = {&p};
  hipError_t e = hipLaunchCooperativeKernel((void*)fwd_megakernel, dim3(grid_blocks), dim3(512), args, 0, stream);
  if (e != hipSuccess) fprintf(stderr, "cooperative launch failed: %s (grid %d)\n", hipGetErrorString(e), grid_blocks);
}
```

```cpp
#include <hip/hip_runtime.h>
#include <hip/hip_cooperative_groups.h>
#include <stdint.h>
#include <cstdio>
namespace cg = cooperative_groups;

typedef __attribute__((ext_vector_type(8))) short bf16x8;
typedef __attribute__((ext_vector_type(4))) short s16x4;
typedef __attribute__((ext_vector_type(16))) float f32x16;
typedef __attribute__((ext_vector_type(4))) float f32x4;
typedef unsigned short u16;
typedef unsigned long long u64;


#define DI __device__ __forceinline__
#define MFMA32(a, b, c) __builtin_amdgcn_mfma_f32_32x32x16_bf16((a), (b), (c), 0, 0, 0)
#define MFMA16(a, b, c) __builtin_amdgcn_mfma_f32_16x16x32_bf16((a), (b), (c), 0, 0, 0)

#define NTOK 33280
#define NPROMPT 32768
#define LDS_BYTES 163840
#define HALF_LDS 81920
#define LAS __attribute__((address_space(3)))
#define KPITCH 2116

struct Params {
  const float *x_p, *x_s, *state_ret, *cache_k, *cache_v, *cache_kidx, *norm_g, *w_in, *ret_gn_g, *w_out, *final_g;
  float* out;
  unsigned char* ws;
  DI u16* xb() const { return (u16*)(ws + 0ull); }
  DI float* kvT() const { return (float*)(ws + 0ull); }
  DI u16* WtIn() const { return (u16*)(ws + 136314880ull); }
  DI u16* WtOut() const { return (u16*)(ws + 144703488ull); }
  DI u16* qr() const { return (u16*)(ws + 146800640ull); }
  DI u16* kr() const { return (u16*)(ws + 180879360ull); }
  DI u16* sprevT() const { return (u16*)(ws + 214958080ull); }
  DI u16* qi() const { return (u16*)(ws + 214958080ull); }
  DI u16* krT() const { return (u16*)(ws + 249036800ull); }
  DI u16* vrT() const { return (u16*)(ws + 283115520ull); }
  DI u16* gate() const { return (u16*)(ws + 317194240ull); }
  DI u16* mix() const { return (u16*)(ws + 385351680ull); }
  DI u16* qa() const { return (u16*)(ws + 453509120ull); }
  DI u16* kaP() const { return (u16*)(ws + 487587840ull); }
  DI u16* kaS() const { return (u16*)(ws + 495976448ull); }
  DI u16* vaTP() const { return (u16*)(ws + 500301824ull); }
  DI u16* vaTS() const { return (u16*)(ws + 508690432ull); }
  DI u16* kiP() const { return (u16*)(ws + 513015808ull); }
  DI u16* kiS() const { return (u16*)(ws + 517210112ull); }
  DI float* rinv() const { return (float*)(ws + 519372800ull); }
  DI float* wi() const { return (float*)(ws + 519505920ull); }
  DI float* cosR() const { return (float*)(ws + 520570880ull); }
  DI float* sinR() const { return (float*)(ws + 521111552ull); }
  DI float* cosA() const { return (float*)(ws + 521652224ull); }
  DI float* sinA() const { return (float*)(ws + 521719808ull); }
  DI unsigned* bar() const { return (unsigned*)(ws + 530573312ull); }
  DI u64* maskbits() const { return (u64*)(ws + 521787392ull); }
};

#define OUT_Y 0
#define OUT_STP (34078720)
#define OUT_KP (OUT_STP + 1048576)
#define OUT_VP (OUT_KP + 4194304)
#define OUT_KIP (OUT_VP + 4194304)
#define OUT_STS (OUT_KIP + 2097152)
#define OUT_KS (OUT_STS + 524288)
#define OUT_VS (OUT_KS + 65536)
#define OUT_KIS (OUT_VS + 65536)

typedef __bf16 bf16x2_t __attribute__((ext_vector_type(2)));
typedef float f32x2_t __attribute__((ext_vector_type(2)));
typedef unsigned u32x4_t __attribute__((ext_vector_type(4)));
typedef unsigned u32x2_t __attribute__((ext_vector_type(2)));
DI unsigned pk2(float a, float b) { f32x2_t v = {a, b}; bf16x2_t r = __builtin_convertvector(v, bf16x2_t); return __builtin_bit_cast(unsigned, r); }
DI u16 f2bf(float x) { return (u16)(pk2(x, x) & 0xffffu); }
DI bf16x8 ldg8(const u16* p) { return *(const bf16x8*)p; }
DI s16x4 ldg4(const u16* p) { return *(const s16x4*)p; }
DI float siluf(float x) { return x * __builtin_amdgcn_rcpf(1.f + __builtin_amdgcn_exp2f(-1.4426950408889634f * x)); }
DI int lane_id() { return (int)__builtin_amdgcn_mbcnt_hi(~0u, __builtin_amdgcn_mbcnt_lo(~0u, 0u)); }
DI int crow(int reg, int hh) { return (reg & 3) + 8 * (reg >> 2) + 4 * hh; }
DI const float* xrow(const Params& p, int g) { return g < NPROMPT ? p.x_p + (size_t)g * 1024 : p.x_s + (size_t)(g - NPROMPT) * 1024; }
DI float log2gamma(int h) { return log1pf(-exp2f(-5.f - (float)h)) * 1.4426950408889634f; }
DI bf16x8 pack8(float a0, float a1, float a2, float a3, float a4, float a5, float a6, float a7) {
  u32x4_t v = {pk2(a0, a1), pk2(a2, a3), pk2(a4, a5), pk2(a6, a7)};
  return __builtin_bit_cast(bf16x8, v);
}
DI s16x4 pack4(f32x4 v) { u32x2_t o = {pk2(v[0], v[1]), pk2(v[2], v[3])}; return __builtin_bit_cast(s16x4, o); }
DI int wave_sum(int v) {
  v += __builtin_amdgcn_update_dpp(0, v, 0xB1, 0xf, 0xf, false);
  v += __builtin_amdgcn_update_dpp(0, v, 0x4E, 0xf, 0xf, false);
  v += __builtin_amdgcn_update_dpp(0, v, 0x124, 0xf, 0xf, false);
  v += __builtin_amdgcn_update_dpp(0, v, 0x128, 0xf, 0xf, false);
  return __builtin_amdgcn_readlane(v, 0) + __builtin_amdgcn_readlane(v, 16) + __builtin_amdgcn_readlane(v, 32) + __builtin_amdgcn_readlane(v, 48);
}
DI f32x16 zero16() { f32x16 z; for (int i = 0; i < 16; ++i) z[i] = 0.f; return z; }

#define XB_TMO      128
#define XB_XCNT(j)  (256  + 64 * (j))
#define XB_XSUB(j)  (1280 + 64 * (j))
#define XB_XGEN(j)  (2304 + 64 * (j))
#define XB_TOP      3328
#define XB_TOPGEN   3392
#define XB_WG(i)    (3456 + 64 * (i))
#define XCD_BAR_WORDS (3456 + 64 * 256)
#define XB_SPIN_CAP (1u << 18)
DI unsigned xb_ld(unsigned* p) { return __hip_atomic_load(p, __ATOMIC_RELAXED, __HIP_MEMORY_SCOPE_AGENT); }
DI unsigned xb_add(unsigned* p, unsigned v) { return __hip_atomic_fetch_add(p, v, __ATOMIC_RELAXED, __HIP_MEMORY_SCOPE_AGENT); }
DI unsigned xb_xcc_id() { return (unsigned)__builtin_amdgcn_s_getreg((3 << 11) | 20) & 0xFu; }
#define XB_SPIN(cond, bar) do { unsigned _sp = 0; while (cond) { __builtin_amdgcn_s_sleep(1); \
    if ((++_sp & 255u) == 0u) { if (xb_ld(&(bar)[XB_TMO])) break; if (_sp > XB_SPIN_CAP) { atomicAdd(&(bar)[XB_TMO], 1u); break; } } } } while (0)
DI void xcd_barrier(unsigned* bar, int wave_id) {
  asm volatile("s_waitcnt vmcnt(0)" ::: "memory");
  __syncthreads();
  if (wave_id == 0) {
    const int lane = lane_id();
    const unsigned x = xb_xcc_id();
    unsigned* slot = &bar[XB_WG(blockIdx.x)];
    unsigned nloc = 0u, nx = 0u;
    if (lane < 2) nloc = xb_ld(slot + lane);
    nx = (unsigned)__builtin_amdgcn_readlane((int)nloc, 1);
    nloc = (unsigned)__builtin_amdgcn_readlane((int)nloc, 0);
    if (nloc == 0u) {
      const unsigned G = gridDim.x * gridDim.y * gridDim.z;
      unsigned sp = 0u, c = 0u;
      for (;;) {
        c = (lane < 16) ? xb_ld(&bar[XB_XCNT(lane)]) : 0u;
        const unsigned sum = (unsigned)wave_sum((int)c);
        if (sum == G) break;
        __builtin_amdgcn_s_sleep(1);
        if ((++sp & 255u) == 0u) { if (xb_ld(&bar[XB_TMO])) break; if (sp > XB_SPIN_CAP) { if (lane == 0) atomicAdd(&bar[XB_TMO], 1u); break; } }
      }
      nx = (unsigned)__popcll(__ballot(c > 0u));
      nloc = (unsigned)__builtin_amdgcn_readlane((int)c, (int)x);
      nloc = nloc > 0u ? nloc : 1u; nx = nx > 0u ? nx : 1u;
      if (lane == 0) { __hip_atomic_store(slot, nloc, __ATOMIC_RELAXED, __HIP_MEMORY_SCOPE_AGENT); __hip_atomic_store(slot + 1, nx, __ATOMIC_RELAXED, __HIP_MEMORY_SCOPE_AGENT); }
    }
    if (lane == 0) {
      __builtin_amdgcn_s_waitcnt(0);
      const unsigned old = xb_add(&bar[XB_XSUB(x)], 1u);
      const unsigned gen = old / nloc;
      if (old + 1u == (gen + 1u) * nloc) {
        __builtin_amdgcn_fence(__ATOMIC_RELEASE, "agent");
        asm volatile("s_waitcnt vmcnt(0)" ::: "memory");
        const unsigned og = xb_add(&bar[XB_TOP], 1u);
        const unsigned tg = og / nx;
        if (og + 1u == (tg + 1u) * nx) xb_add(&bar[XB_TOPGEN], 1u);
        else XB_SPIN(xb_ld(&bar[XB_TOPGEN]) == tg, bar);
        __builtin_amdgcn_fence(__ATOMIC_ACQUIRE, "agent");
        xb_add(&bar[XB_XGEN(x)], 1u);
        asm volatile("s_waitcnt vmcnt(0)" ::: "memory");
      } else {
        XB_SPIN(xb_ld(&bar[XB_XGEN(x)]) == gen, bar);
        __builtin_amdgcn_fence(__ATOMIC_ACQUIRE, "agent");
        asm volatile("s_waitcnt vmcnt(0)" ::: "memory");
      }
    }
  }
  __syncthreads();
}

DI void phase_prep(const Params& p, int tid) {
  const int gt = blockIdx.x * 512 + tid, GT = gridDim.x * 512;
  const int lane = tid & 63;
  for (int row0 = (gt >> 6) * 2; row0 < NTOK; row0 += (GT >> 6) * 2) {
    f32x4 v[2][4];
#pragma unroll
    for (int rr = 0; rr < 2; ++rr) {
      const float* sp = xrow(p, row0 + rr);
#pragma unroll
      for (int i = 0; i < 4; ++i) v[rr][i] = *(const f32x4*)(sp + i * 256 + lane * 4);
    }
#pragma unroll
    for (int rr = 0; rr < 2; ++rr) {
      float ss = 0.f;
#pragma unroll
      for (int i = 0; i < 4; ++i) ss += v[rr][i][0] * v[rr][i][0] + v[rr][i][1] * v[rr][i][1] + v[rr][i][2] * v[rr][i][2] + v[rr][i][3] * v[rr][i][3];
#pragma unroll
      for (int o = 32; o >= 1; o >>= 1) ss += __shfl_xor(ss, o);
#pragma unroll
      for (int i = 0; i < 4; ++i) *(s16x4*)(p.xb() + (size_t)(row0 + rr) * 1024 + i * 256 + lane * 4) = pack4(v[rr][i]);
      if (lane == 0) p.rinv()[row0 + rr] = rsqrtf(ss * (1.f / 1024.f) + 1e-6f);
    }
  }
  for (int i = gt; i < 4096 * 128; i += GT) {
    int n = i & 4095, kg = i >> 12;
    int sc = n;
    if (n < 1024) { const int P = n & 127; sc = (n & ~127) + 64 * ((P >> 4) & 1) + 16 * (P >> 5) + (P & 15); }
    float a[8];
    const float vmask = (n < 3912) ? 1.f : 0.f; const int scc = (sc < 3912) ? sc : 3911;
#pragma unroll
    for (int j = 0; j < 8; ++j) a[j] = p.w_in[(size_t)(kg * 8 + j) * 3912 + scc] * p.norm_g[kg * 8 + j] * vmask;
    *(bf16x8*)(p.WtIn() + (size_t)n * 1024 + kg * 8) = pack8(a[0], a[1], a[2], a[3], a[4], a[5], a[6], a[7]);
  }
  for (int i = gt; i < 1024 * 128; i += GT) {
    int n = i % 1024, kg = i / 1024;
    float a[8];
#pragma unroll
    for (int j = 0; j < 8; ++j) a[j] = p.w_out[(size_t)(kg * 8 + j) * 1024 + n];
    *(bf16x8*)(p.WtOut() + (size_t)n * 1024 + kg * 8) = pack8(a[0], a[1], a[2], a[3], a[4], a[5], a[6], a[7]);
  }
  for (int i = gt; i < 2112 * 64; i += GT) {
    int pos = i >> 6, k = i & 63;
    float inv = powf(10000.f, -(float)k / 64.f);
    float ang = (float)pos * inv;
    p.cosR()[i] = cosf(ang); p.sinR()[i] = sinf(ang);
  }
  for (int i = gt; i < 2112 * 8; i += GT) {
    int pos = i >> 3, k = i & 7;
    float inv = powf(500000.f, -(float)k / 8.f);
    float ang = (float)pos * inv;
    p.cosA()[i] = cosf(ang); p.sinA()[i] = sinf(ang);
  }
  for (int i = gt; i < 8 * 2048 * 2 * 8; i += GT) {
    int dg = i & 7, kvh = (i >> 3) & 1, t = (i >> 4) & 2047, b = i >> 15;
    const float* s = p.cache_k + ((size_t)(b * 2048 + t) * 2 + kvh) * 64 + dg * 8;
    *(bf16x8*)(p.kaS() + ((size_t)(b * 2 + kvh) * 2112 + t) * 64 + dg * 8) = pack8(s[0], s[1], s[2], s[3], s[4], s[5], s[6], s[7]);
  }
  for (int i = gt; i < 8 * 2 * 256 * 64; i += GT) {
    int d = i & 63, tg = (i >> 6) & 255, kvh = (i >> 14) & 1, b = i >> 15;
    float a[8];
#pragma unroll
    for (int j = 0; j < 8; ++j) a[j] = p.cache_v[((size_t)(b * 2048 + tg * 8 + j) * 2 + kvh) * 64 + d];
    *(bf16x8*)(p.vaTS() + ((size_t)(b * 2 + kvh) * 64 + d) * 2112 + tg * 8) = pack8(a[0], a[1], a[2], a[3], a[4], a[5], a[6], a[7]);
  }
  for (int i = gt; i < 8 * 2048 * 8; i += GT) {
    int dg = i & 7, t = (i >> 3) & 2047, b = i >> 14;
    const float* s = p.cache_kidx + (size_t)(b * 2048 + t) * 64 + dg * 8;
    *(bf16x8*)(p.kiS() + ((size_t)b * 2112 + t) * 64 + dg * 8) = pack8(s[0], s[1], s[2], s[3], s[4], s[5], s[6], s[7]);
  }
}

namespace pg8 {
constexpr int BM = 256, BK = 64, HALF = 128, HTB = HALF * BK * 2, STAGE_BYTES = 8 * HTB, NXCD = 8, WGM = 8;
DI int lds_byte(int r, int c) { const int st = (r >> 4) * 2 + (c >> 5), rr = r & 15, cc = c & 31, ob = rr * 64 + cc * 2; return st * 1024 + (ob ^ (((ob >> 9) & 1) << 5)); }
DI void stage_rc(int b, int& R, int& C) { const int st = b / 1024, sb = b % 1024, swz = sb ^ (((sb >> 9) & 1) << 5); R = (st >> 1) * 16 + swz / 64; C = (st & 1) * 32 + (swz % 64) / 2; }
struct Unit { int pm, pn; };
struct Gemm { const u16* A; const u16* Bt; int M, N, K; };
struct StaticOrder {
  int nM, nN, nwg, G, c, padtile; unsigned long long permtab;
  DI void init(int M, int N, int G_, int c_) { nM = M / BM; nN = N / BM; nwg = nM * nN; G = G_; c = c_; permtab = 0xFEDCBA9876543210ull; padtile = -1; }
  DI void map(int L, Unit& u) const {
    int wgid = L; { const int q = nwg / NXCD, r = nwg % NXCD, xcd = wgid % NXCD, off = wgid / NXCD; wgid = (xcd < r ? xcd * (q + 1) : r * (q + 1) + (xcd - r) * q) + off; }
    const int nig = WGM * nN, gid = wgid / nig, fm = gid * WGM, gsz = (nM - fm) < WGM ? (nM - fm) : WGM;
    u.pm = fm + ((wgid % nig) % gsz); u.pn = (int)((permtab >> (4 * ((wgid % nig) / gsz))) & 15ull);
  }
  DI bool next(int i, Unit& u) const {
    const long Ll = (long)i * G + c; if (Ll >= nwg) return false;
    const int L = (int)Ll;
    if (padtile < 0) { map(L, u); return true; }
    const int tail = nwg % G, base = nwg - tail;
    if (L >= base) { u.pm = L - base; u.pn = padtile; return true; }
    map(L, u);
    for (int it = 0; it < 64 && u.pn == padtile && u.pm < tail; ++it) map(base + u.pm, u);
    return true;
  }
};
template <class Epi>
DI void gemm_phase(LAS unsigned char* lds, const Gemm g, const StaticOrder& S, const Epi& E, int wave_id) {
  const int wid = wave_id; int lane = lane_id(); asm volatile("" : "+v"(lane)); const int tid = wid * 64 + lane;
  const int wr = wid >> 2, wc = wid & 3, fr = lane & 15, fq = lane >> 4;
  const int K = g.K, nt = K / BK;
  unsigned voffA[2], voffB[2];
#pragma unroll
  for (int i = 0; i < 2; ++i) { int R, C; stage_rc(tid * 16 + i * 8192, R, C); voffA[i] = (unsigned)(R * K + C) * 2u; voffB[i] = voffA[i]; }
  const size_t kstep = (size_t)(BK * 2);
  const size_t hstep = (size_t)HALF * K * 2;
  const size_t tstep = 2 * hstep;
  const unsigned ldsw = (unsigned)wid * 1024u;
  const int aoff = lds_byte(wr * 64 + fr, fq * 8), boff = lds_byte(wc * 32 + fr, fq * 8);
#define PG8_SA(b, h) (((b) * 2 + (h)) * HTB)
#define PG8_SB(b, h) ((4 + (b) * 2 + (h)) * HTB)
#define PG8_STAGE(bufoff, gbase, voff) do { _Pragma("unroll") for (int _i = 0; _i < 2; ++_i) \
    __builtin_amdgcn_global_load_lds((const unsigned*)((const char*)(gbase) + (voff)[_i]), (LAS unsigned*)(lds + (bufoff) + ldsw + _i * 8192), 16, 0, 0); } while (0)
#define PG8_LDA(dst, b, h) do { _Pragma("unroll") for (int m = 0; m < 4; ++m) _Pragma("unroll") for (int k = 0; k < 2; ++k) dst[m][k] = *(const LAS bf16x8*)(lds + PG8_SA(b, h) + aoff + m * 2048 + k * 1024); } while (0)
#define PG8_LDB(dst, b, h) do { _Pragma("unroll") for (int n = 0; n < 2; ++n) _Pragma("unroll") for (int k = 0; k < 2; ++k) dst[n][k] = *(const LAS bf16x8*)(lds + PG8_SB(b, h) + boff + n * 2048 + k * 1024); } while (0)
#define PG8_MMA(ai, bj, At, Bt) do { __builtin_amdgcn_s_setprio(1); _Pragma("unroll") for (int m = 0; m < 4; ++m) _Pragma("unroll") for (int n = 0; n < 2; ++n) _Pragma("unroll") for (int k = 0; k < 2; ++k) \
    acc[ai][bj][m][n] = __builtin_amdgcn_mfma_f32_16x16x32_bf16(Bt[n][k], At[m][k], acc[ai][bj][m][n], 0, 0, 0); __builtin_amdgcn_s_setprio(0); } while (0)
#define PG8_WAIT_V(n) asm volatile("s_waitcnt vmcnt(" #n ")" ::: "memory")
#define PG8_WAIT_L(n) asm volatile("s_waitcnt lgkmcnt(" #n ")" ::: "memory")
#define PG8_BAR __builtin_amdgcn_s_barrier()
#define PG8_SCHED __builtin_amdgcn_sched_barrier(0)
  Unit cur, nxt; int ui = 0;
  if (!S.next(0, cur)) return;
  f32x4 acc[2][2][4][2];
#pragma unroll
  for (int a = 0; a < 2; ++a)
#pragma unroll
    for (int b = 0; b < 2; ++b)
#pragma unroll
      for (int m = 0; m < 4; ++m)
#pragma unroll
        for (int n = 0; n < 2; ++n) acc[a][b][m][n] = (f32x4){0.f, 0.f, 0.f, 0.f};
  bf16x8 At[4][2], B0[2][2], B1[2][2];
  const char* cA = (const char*)g.A + (size_t)cur.pm * tstep; const char* cB = (const char*)g.Bt + (size_t)cur.pn * tstep;
  PG8_STAGE(PG8_SB(0, 0), cB, voffB); PG8_STAGE(PG8_SA(0, 0), cA, voffA); PG8_STAGE(PG8_SB(0, 1), cB + hstep, voffB); PG8_STAGE(PG8_SA(0, 1), cA + hstep, voffA);
  if (wr == 1) PG8_BAR;
  PG8_WAIT_V(4); PG8_BAR;
  PG8_STAGE(PG8_SB(1, 0), cB + kstep, voffB); PG8_STAGE(PG8_SA(1, 0), cA + kstep, voffA); PG8_STAGE(PG8_SB(1, 1), cB + hstep + kstep, voffB);
  PG8_WAIT_V(6); PG8_BAR;
  for (;;) {
    const bool has_next = S.next(ui + 1, nxt);
    const char* nA = has_next ? (const char*)g.A + (size_t)nxt.pm * tstep : cA; const char* nB = has_next ? (const char*)g.Bt + (size_t)nxt.pn * tstep : cB;
#ifndef REPK
#define REPK 1
#endif
    const bool skip1 = (S.padtile >= 0) && (cur.pn == S.padtile);
    for (int rk = 0; rk < REPK; ++rk) {
    const char* nA2 = (rk == REPK - 1) ? nA : cA; const char* nB2 = (rk == REPK - 1) ? nB : cB;
    for (int t = 0; t < nt; t += 2) {
      const bool last = (t == nt - 2);
      const char* a1 = cA + (size_t)(t + 1) * kstep;
      const char* a2 = last ? nA2 : cA + (size_t)(t + 2) * kstep; const char* b2 = last ? nB2 : cB + (size_t)(t + 2) * kstep;
      const char* a3 = a2 + kstep; const char* b3 = b2 + kstep;
      PG8_LDB(B0, 0, 0); PG8_SCHED; PG8_LDA(At, 0, 0); PG8_STAGE(PG8_SA(1, 1), a1 + hstep, voffA);
      PG8_WAIT_L(8); PG8_BAR; PG8_WAIT_L(0); PG8_MMA(0, 0, At, B0); PG8_BAR; PG8_SCHED;
      PG8_LDB(B1, 0, 1); PG8_STAGE(PG8_SB(0, 0), b2, voffB);
      PG8_BAR; PG8_WAIT_L(0); if (!skip1) PG8_MMA(0, 1, At, B1); PG8_BAR;
      PG8_LDA(At, 0, 1); PG8_STAGE(PG8_SA(0, 0), a2, voffA);
      PG8_BAR; PG8_WAIT_L(0); PG8_MMA(1, 0, At, B0); PG8_BAR; PG8_SCHED;
      PG8_STAGE(PG8_SB(0, 1), b2 + hstep, voffB);
      PG8_WAIT_V(6); PG8_BAR; if (!skip1) PG8_MMA(1, 1, At, B1); PG8_BAR;
      PG8_LDB(B0, 1, 0); PG8_SCHED; PG8_LDA(At, 1, 0); PG8_STAGE(PG8_SA(0, 1), a2 + hstep, voffA);
      PG8_WAIT_L(8); PG8_BAR; PG8_WAIT_L(0); PG8_MMA(0, 0, At, B0); PG8_BAR; PG8_SCHED;
      PG8_LDB(B1, 1, 1); PG8_STAGE(PG8_SB(1, 0), b3, voffB);
      PG8_BAR; PG8_WAIT_L(0); if (!skip1) PG8_MMA(0, 1, At, B1); PG8_BAR;
      PG8_LDA(At, 1, 1); PG8_STAGE(PG8_SA(1, 0), a3, voffA);
      PG8_BAR; PG8_WAIT_L(0); PG8_MMA(1, 0, At, B0); PG8_BAR; PG8_SCHED;
      PG8_STAGE(PG8_SB(1, 1), b3 + hstep, voffB);
      PG8_WAIT_V(6); PG8_BAR; if (!skip1) PG8_MMA(1, 1, At, B1); PG8_BAR;
    }
    }
    {
      Unit eu = cur; int ewr = wr, ewc = wc; int el = lane_id();
      asm volatile("" : "+s"(eu.pm), "+s"(eu.pn), "+s"(ewr), "+s"(ewc), "+v"(el));
      int efr = el & 15, efq = el >> 4;
#ifndef REPEPI
#define REPEPI 1
#endif
      for (int re = 0; re < REPEPI; ++re) E(acc, eu, ewr, ewc, efr, efq, re);
    }
    if (!has_next) break;
#pragma unroll
    for (int a = 0; a < 2; ++a)
#pragma unroll
      for (int b = 0; b < 2; ++b)
#pragma unroll
        for (int m = 0; m < 4; ++m)
#pragma unroll
          for (int n = 0; n < 2; ++n) acc[a][b][m][n] = (f32x4){0.f, 0.f, 0.f, 0.f};
    cur = nxt; cA = nA; cB = nB; ++ui;
  }
  PG8_WAIT_V(0);
  if (wr == 0) PG8_BAR;
  PG8_BAR;
#undef PG8_SA
#undef PG8_SB
#undef PG8_STAGE
#undef PG8_LDA
#undef PG8_LDB
#undef PG8_MMA
#undef PG8_WAIT_V
#undef PG8_WAIT_L
#undef PG8_BAR
#undef PG8_SCHED
}
}


DI unsigned hx_w(int row, int c8) { return (unsigned)(row * 256 + ((c8 ^ ((row & 15) << 1)) << 3)); }
DI unsigned hx_r(int row, int c16) { return (unsigned)(row * 256 + ((c16 ^ (row & 15)) << 4)); }
#define EPI_BAR() asm volatile("s_waitcnt lgkmcnt(0)\n\ts_barrier" ::: "memory")


struct Epi1 {
  Params p; LAS unsigned char* hl0;
  DI void load_tabs(f32x4 (&tc)[4], f32x4 (&ts)[4], int tclass, int R0, bool samp, int wc, int fr, int fq) const {
    const float* cb = (tclass == 1) ? p.cosR() : p.cosA();
    const float* sb = (tclass == 1) ? p.sinR() : p.sinA();
    const int pitch = (tclass == 1) ? 64 : 8;
    const int coff = (tclass == 1) ? (16 * wc + 4 * fq) : (4 * (fq & 1));
#pragma unroll
    for (int m = 0; m < 4; ++m) {
      const int rowg = R0 + 16 * m + fr;
      const int pos = samp ? 2048 + ((rowg - NPROMPT) & 63) : (rowg & 2047);
      tc[m] = *(const f32x4*)(cb + pos * pitch + coff);
      ts[m] = *(const f32x4*)(sb + pos * pitch + coff);
    }
  }
  template <int AI, int BJ>
  DI void compute(f32x4 (&acc)[2][2][4][2], const f32x4 (&tc)[4], const f32x4 (&ts)[4], int blk, int wc, int fq) const {
    if (blk < 8) {
#pragma unroll
      for (int m = 0; m < 4; ++m) {
        const f32x4 v0 = acc[AI][BJ][m][0], v1 = acc[AI][BJ][m][1];
        f32x4 o0 = v0 * tc[m] - v1 * ts[m], o1 = v1 * tc[m] + v0 * ts[m];
        if (blk >= 4) { o0 *= 0.08838834764831845f; o1 *= 0.08838834764831845f; }
        acc[AI][BJ][m][0] = o0; acc[AI][BJ][m][1] = o1;
      }
    } else if ((blk >= 12 && blk < 16) || (blk >= 22 && blk < 26)) {
#pragma unroll
      for (int m = 0; m < 4; ++m)
#pragma unroll
        for (int n = 0; n < 2; ++n) {
          f32x4 v = acc[AI][BJ][m][n];
          v[0] = siluf(v[0]); v[1] = siluf(v[1]); v[2] = siluf(v[2]); v[3] = siluf(v[3]);
          acc[AI][BJ][m][n] = v;
        }
    } else if ((blk >= 8 && blk < 12) || blk == 21 || blk == 31) {
    } else {
      const bool ropew = ((wc & 1) == 0) && !(blk == 30 && wc >= 2);
      if (ropew) {
#pragma unroll
        for (int m = 0; m < 4; ++m) {
          const f32x4 v0 = acc[AI][BJ][m][0];
          f32x4 pr;
          pr[0] = __shfl_xor(v0[0], 32); pr[1] = __shfl_xor(v0[1], 32); pr[2] = __shfl_xor(v0[2], 32); pr[3] = __shfl_xor(v0[3], 32);
          acc[AI][BJ][m][0] = (fq < 2) ? v0 * tc[m] - pr * ts[m] : v0 * tc[m] + pr * ts[m];
        }
      }
      if (blk < 20) {
        const float sc = 0.125f * 1.4426950408889634f;
#pragma unroll
        for (int m = 0; m < 4; ++m) { acc[AI][BJ][m][0] *= sc; acc[AI][BJ][m][1] *= sc; }
      }
    }
  }
  template <int AI, int BJ>
  DI void emit(f32x4 (&acc)[2][2][4][2], const pg8::Unit& u, int blk, bool samp, int wr, int wc, int fr, int fq) const {
    if (blk == 31) return;
    LAS unsigned char* hl = hl0 + wr * 16384;
    asm volatile("" : "+v"(fr), "+v"(fq));
    const int lane = fr + 16 * fq;
    const int P0 = 32 * wc + 4 * fq;
    const int R0 = u.pm * 256 + AI * 128 + wr * 64;
    int b, tb;
    if (!samp) { b = R0 >> 11; tb = R0 & 2047; } else { b = (R0 - NPROMPT) >> 6; tb = 0; }
    const bool retk = blk < 8;
    const bool hasT = (blk >= 4 && blk < 12) || blk == 21;
    const bool hasN = !(blk >= 8 && blk < 12) && blk != 21;
    if (blk == 20 || blk == 21) {
      float* ob = samp ? p.out + (blk == 20 ? OUT_KS : OUT_VS) + (unsigned)(R0 - NPROMPT) * 128u : p.out + (blk == 20 ? OUT_KP : OUT_VP) + (unsigned)R0 * 128u;
#pragma unroll
      for (int m = 0; m < 4; ++m) {
        float* o2 = ob + (unsigned)(16 * m + fr) * 128u + P0;
        *(f32x4*)o2 = acc[AI][BJ][m][0]; *(f32x4*)(o2 + 16) = acc[AI][BJ][m][1];
      }
    } else if (blk == 30) {
      float* ob = samp ? p.out + OUT_KIS + (unsigned)(R0 - NPROMPT) * 64u : p.out + OUT_KIP + (unsigned)R0 * 64u;
      float* wb = p.wi() + (unsigned)R0 * 8u;
#pragma unroll
      for (int m = 0; m < 4; ++m) {
        if (wc < 2) {
          float* o2 = ob + (unsigned)(16 * m + fr) * 64u + P0;
          *(f32x4*)o2 = acc[AI][BJ][m][0]; *(f32x4*)(o2 + 16) = acc[AI][BJ][m][1];
        } else if (wc == 2 && fq < 2) {
          *(f32x4*)(wb + (unsigned)(16 * m + fr) * 8u + 4 * fq) = acc[AI][BJ][m][0] * 0.044194173824159216f;
        }
      }
    }
    if (hasN) {
#pragma unroll
      for (int m = 0; m < 4; ++m)
#pragma unroll
        for (int n = 0; n < 2; ++n) {
          const int c8 = retk ? (16 * n + 4 * wc + fq) : (8 * wc + 4 * n + fq);
          *(LAS s16x4*)(hl + hx_w(16 * m + fr, c8)) = pack4(acc[AI][BJ][m][n]);
        }
      u16* nb; unsigned pitch = 512u, hstr = 0u, cm = 15u;
      if (blk < 4) nb = p.qr() + (unsigned)R0 * 512u + (blk & 3) * 128;
      else if (blk < 8) nb = p.kr() + (unsigned)R0 * 512u + (blk & 3) * 128;
      else if (blk < 16) { nb = p.gate() + (unsigned)R0 * 1024u + (blk - 12) * 128; pitch = 1024u; }
      else if (blk < 20) nb = p.qa() + (unsigned)R0 * 512u + (blk - 16) * 128;
      else if (blk == 20) { nb = samp ? p.kaS() + ((unsigned)(b * 2) * 2112u + 2048u) * 64u : p.kaP() + ((unsigned)(b * 2) * 2048u + tb) * 64u; pitch = 64u; hstr = samp ? 2112u * 64u : 2048u * 64u; cm = 7u; }
      else if (blk < 26) { nb = p.gate() + (unsigned)R0 * 1024u + 512 + (blk - 22) * 128; pitch = 1024u; }
      else if (blk < 30) nb = p.qi() + (unsigned)R0 * 512u + (blk - 26) * 128;
      else { nb = samp ? p.kiS() + ((unsigned)b * 2112u + 2048u) * 64u : p.kiP() + ((unsigned)b * 2048u + tb) * 64u; pitch = 64u; cm = 7u; }
      EPI_BAR();
      const unsigned c16 = lane & 15;
      const unsigned loff = (c16 >> 3) * hstr + (c16 & cm) * 8u;
#pragma unroll
      for (int i = 0; i < 4; ++i) {
        const int row = 16 * wc + 4 * i + (lane >> 4);
        const bf16x8 v = *(const LAS bf16x8*)(hl + hx_r(row, c16));
        if (blk != 30 || c16 < 8) *(bf16x8*)(nb + (unsigned)row * pitch + loff) = v;
      }
      EPI_BAR();
    }
    if (hasT) {
      const float l2g = log2gamma(blk & 3);
#pragma unroll
      for (int m = 0; m < 4; ++m) {
        const int tok = 16 * m + fr;
        const float dec = (blk < 8) ? exp2f((float)(63 - tok) * l2g) : 1.f;
#pragma unroll
        for (int n = 0; n < 2; ++n) {
          const int fb = retk ? (64 * n + 16 * wc + 4 * fq) : (32 * wc + 16 * n + 4 * fq);
#pragma unroll
          for (int j = 0; j < 4; ++j) {
            const int f = fb + j;
            *(LAS u16*)(hl + f * 128 + ((((tok >> 3) ^ (f >> 2)) & 7) << 4) + (tok & 7) * 2) = f2bf(acc[AI][BJ][m][n][j] * dec);
          }
        }
      }
      u16* tbp; unsigned fstr;
      if (blk < 12) {
        u16* base = (blk < 8) ? p.krT() : p.vrT();
        const unsigned bh = (unsigned)(b * 4 + (blk & 3)) * 128u;
        tbp = samp ? base + 64u * 128u * 2048u + bh * 64u : base + bh * 2048u + tb;
        fstr = samp ? 64u : 2048u;
      } else {
        tbp = samp ? p.vaTS() + (unsigned)b * 128u * 2112u + 2048u : p.vaTP() + (unsigned)b * 128u * 2048u + tb;
        fstr = samp ? 2112u : 2048u;
      }
      EPI_BAR();
#pragma unroll
      for (int i = 0; i < 4; ++i) {
        const int f = 32 * wc + 8 * i + (lane >> 3), ch = lane & 7;
        const bf16x8 v = *(const LAS bf16x8*)(hl + f * 128 + (((ch ^ (f >> 2)) & 7) << 4));
        *(bf16x8*)(tbp + (unsigned)f * fstr + ch * 8) = v;
      }
      EPI_BAR();
    }
  }
  DI void operator()(f32x4 (&acc)[2][2][4][2], const pg8::Unit& u, int wr, int wc, int fr, int fq, int re) const {
    const bool samp = (u.pm * 256 >= NPROMPT);
    const int tclass = (u.pn < 4) ? 1 : ((u.pn == 8 || u.pn == 9 || u.pn == 10 || u.pn >= 13) ? 2 : 0);
    const int blk0 = u.pn * 2, blk1 = u.pn * 2 + 1;
    float rvv[2][4];
#pragma unroll
    for (int ai = 0; ai < 2; ++ai)
#pragma unroll
      for (int m = 0; m < 4; ++m) rvv[ai][m] = (1.f / REPK) * p.rinv()[u.pm * 256 + ai * 128 + wr * 64 + 16 * m + fr];
    f32x4 tc[4], ts[4];
    load_tabs(tc, ts, tclass, u.pm * 256 + wr * 64, samp, wc, fr, fq);
#pragma unroll
    for (int ai = 0; ai < 2; ++ai)
#pragma unroll
      for (int m = 0; m < 4; ++m)
#pragma unroll
        for (int bj = 0; bj < 2; ++bj)
#pragma unroll
          for (int n = 0; n < 2; ++n) acc[ai][bj][m][n] *= rvv[ai][m];
    compute<0, 0>(acc, tc, ts, blk0, wc, fq);
    compute<0, 1>(acc, tc, ts, blk1, wc, fq);
    load_tabs(tc, ts, tclass, u.pm * 256 + 128 + wr * 64, samp, wc, fr, fq);
    compute<1, 0>(acc, tc, ts, blk0, wc, fq);
    compute<1, 1>(acc, tc, ts, blk1, wc, fq);
    emit<0, 0>(acc, u, blk0, samp, wr, wc, fr, fq);
    emit<0, 1>(acc, u, blk1, samp, wr, wc, fr, fq);
    emit<1, 0>(acc, u, blk0, samp, wr, wc, fr, fq);
    emit<1, 1>(acc, u, blk1, samp, wr, wc, fr, fq);
  }
};

struct Epi2 {
  Params p; unsigned char* hl;
  DI void operator()(f32x4 (&acc)[2][2][4][2], const pg8::Unit& u, int wr, int wc, int fr, int fq, int re) const {
    u16* z = p.gate();
    const int lane = fr + 16 * fq;
#pragma unroll
    for (int ai = 0; ai < 2; ++ai)
#pragma unroll
      for (int bj = 0; bj < 2; ++bj) {
#pragma unroll
        for (int m = 0; m < 4; ++m)
#pragma unroll
          for (int n = 0; n < 2; ++n)
            *(s16x4*)(hl + hx_w(16 * m + fr, 8 * wc + 4 * n + fq)) = pack4(acc[ai][bj][m][n] * (1.f / REPK));
        EPI_BAR();
        const unsigned R0 = u.pm * 256 + ai * 128 + wr * 64;
        const unsigned cb = u.pn * 256 + bj * 128;
#pragma unroll
        for (int i = 0; i < 4; ++i) {
          const int row = 16 * wc + 4 * i + (lane >> 4), c16 = lane & 15;
          const bf16x8 v = *(const bf16x8*)(hl + hx_r(row, c16));
          *(bf16x8*)(z + (R0 + row) * 1024u + cb + c16 * 8) = v;
        }
        EPI_BAR();
      }
  }
};

DI void ret_kv_item(const Params& p, int item, int tid) {
  const int lane = tid & 63, w = tid >> 6, r = lane & 31, hh = lane >> 5;
  const u16 *kT, *vT; int T, c;
  if (item < 2048) { const int bh = item >> 5; c = item & 31; T = 2048; kT = p.krT() + (size_t)bh * 128 * 2048; vT = p.vrT() + (size_t)bh * 128 * 2048; }
  else { const int bh = item - 2048; c = 0; T = 64; kT = p.krT() + (size_t)64 * 128 * 2048 + (size_t)bh * 128 * 64; vT = p.vrT() + (size_t)64 * 128 * 2048 + (size_t)bh * 128 * 64; }
  const int e0 = (w & 1) * 64, d0 = (w >> 1) * 64;
  f32x16 acc[2][2];
  acc[0][0] = zero16(); acc[0][1] = zero16(); acc[1][0] = zero16(); acc[1][1] = zero16();
#pragma unroll
  for (int ks = 0; ks < 4; ++ks) {
    bf16x8 a0 = ldg8(vT + (size_t)(e0 + r) * T + c * 64 + ks * 16 + hh * 8);
    bf16x8 a1 = ldg8(vT + (size_t)(e0 + 32 + r) * T + c * 64 + ks * 16 + hh * 8);
    bf16x8 b0 = ldg8(kT + (size_t)(d0 + r) * T + c * 64 + ks * 16 + hh * 8);
    bf16x8 b1 = ldg8(kT + (size_t)(d0 + 32 + r) * T + c * 64 + ks * 16 + hh * 8);
    acc[0][0] = MFMA32(a0, b0, acc[0][0]);
    acc[0][1] = MFMA32(a0, b1, acc[0][1]);
    acc[1][0] = MFMA32(a1, b0, acc[1][0]);
    acc[1][1] = MFMA32(a1, b1, acc[1][1]);
  }
  u16* o = (u16*)p.kvT() + (size_t)item * 16384;
#pragma unroll
  for (int a = 0; a < 2; ++a)
#pragma unroll
    for (int b = 0; b < 2; ++b)
#pragma unroll
      for (int i = 0; i < 16; ++i)
        o[(e0 + a * 32 + crow(i, hh)) * 128 + d0 + b * 32 + r] = f2bf(acc[a][b][i]);
}

template <int NS>
DI void select_query(const u16* krow, int nj, int lane, u64* dst) {
  unsigned key[NS];
#pragma unroll
  for (int j = 0; j < NS; ++j) { const unsigned k = krow[j * 64 + lane]; key[j] = (j < nj) ? k : 0u; }
  constexpr int NP = (NS + 1) / 2;
  unsigned pk[NP];
#pragma unroll
  for (int i = 0; i < NP; ++i) pk[i] = key[2 * i] | ((2 * i + 1 < NS ? key[2 * i + 1] : 0u) << 16);
  unsigned prefix = 0;
  int cntp = 0;
  const unsigned ones = 0x00010001u;
  for (int bit = 15; bit >= 0; --bit) {
    const unsigned cand = prefix | (1u << bit);
    const unsigned c1 = cand - 1u;
    const unsigned cv = c1 | (c1 << 16);
    unsigned acc0 = 0, acc1 = 0;
#pragma unroll
    for (int i = 0; i < NP; ++i) {
      unsigned d, m;
      asm("v_pk_sub_u16 %0, %1, %2 clamp" : "=v"(d) : "v"(pk[i]), "v"(cv));
      asm("v_pk_min_u16 %0, %1, %2" : "=v"(m) : "v"(d), "v"(ones));
      if (i & 1) acc1 += m; else acc0 += m;
    }
    const unsigned a = acc0 + acc1;
    const int cnt = wave_sum((int)((a & 0xffffu) + (a >> 16)));
    if (cnt >= 256) { prefix = cand; cntp = cnt; }
    if (cnt == 256) break;
  }
  int wlo = 0, whi = 0;
  if (cntp == 256) {
#pragma unroll
    for (int j = 0; j < NS; ++j) {
      const u64 sm = __ballot(key[j] >= prefix);
      if (lane == j) { wlo = (int)(unsigned)sm; whi = (int)(unsigned)(sm >> 32); }
    }
  } else {
    int cgt = 0;
#pragma unroll
    for (int j = 0; j < NS; ++j) cgt += (key[j] > prefix) ? 1 : 0;
    cgt = wave_sum(cgt);
    const int rneed = 256 - cgt;
    int running = 0;
    const u64 lt = (1ull << lane) - 1ull;
#pragma unroll
    for (int j = 0; j < NS; ++j) {
      const bool eq = key[j] == prefix;
      const u64 em = __ballot(eq);
      const int rank = running + __popcll(em & lt);
      const bool sel = (key[j] > prefix) || (eq && rank < rneed);
      const u64 sm = __ballot(sel);
      if (lane == j) { wlo = (int)(unsigned)sm; whi = (int)(unsigned)(sm >> 32); }
      running += __popcll(em);
    }
  }
  if (lane < nj) dst[lane] = ((u64)(unsigned)whi << 32) | (u64)(unsigned)wlo;
}

DI void idx_item(const Params& p, unsigned char* lds, int tid, bool samp, int b, int grp) {
  const int lane = tid & 63, w = tid >> 6;
  const int t0 = grp * 16;
  int L, g0; const u16* ki;
  if (!samp) { const int c = t0 >> 6; L = (c + 1) * 64; g0 = b * 2048 + t0; ki = p.kiP() + (size_t)b * 2048 * 64; }
  else { L = 2112; g0 = NPROMPT + b * 64 + t0; ki = p.kiS() + (size_t)b * 2112 * 64; }
  const int nj = L >> 6;
  if (L <= 256) {
    for (int qq = 0; qq < 4; ++qq) {
      const int q = w * 4 + qq;
      if (lane < nj) p.maskbits()[(size_t)(g0 + q) * 33 + lane] = ~0ull;
    }
    return;
  }
  u16* keys = (u16*)lds;
#ifndef REPMF
#define REPMF 1
#endif
#ifndef REPSEL
#define REPSEL 1
#endif
#ifndef REPKV
#define REPKV 1
#endif
  for (int rmf = 0; rmf < REPMF; ++rmf) {
    const int qn = lane & 15, quad = lane >> 4;
    bf16x8 qf[8][2];
    float wv[8];
#pragma unroll
    for (int h = 0; h < 8; ++h) {
      qf[h][0] = ldg8(p.qi() + (size_t)(g0 + qn) * 512 + h * 64 + quad * 8);
      qf[h][1] = ldg8(p.qi() + (size_t)(g0 + qn) * 512 + h * 64 + 32 + quad * 8);
      wv[h] = p.wi()[(size_t)(g0 + qn) * 8 + h];
    }
    bf16x8 A0[4], A1[4], N0[4], N1[4];
#pragma unroll
    for (int i = 0; i < 4; ++i) {
      const int kt = w + 4 * i;
      A0[i] = ldg8(ki + (size_t)(kt * 16 + qn) * 64 + quad * 8);
      A1[i] = ldg8(ki + (size_t)(kt * 16 + qn) * 64 + 32 + quad * 8);
    }
    for (int base = 0; base < nj; base += 4) {
#pragma unroll
      for (int i = 0; i < 4; ++i) {
        const int t = min(base + 4 + i, nj - 1);
        const int kt = w + 4 * t;
        N0[i] = ldg8(ki + (size_t)(kt * 16 + qn) * 64 + quad * 8);
        N1[i] = ldg8(ki + (size_t)(kt * 16 + qn) * 64 + 32 + quad * 8);
      }
#pragma unroll
      for (int i = 0; i < 4; ++i) {
        const int t = base + i;
        if (t < nj) {
          const int kt = w + 4 * t;
          float idx[4] = {0.f, 0.f, 0.f, 0.f};
#pragma unroll
          for (int h = 0; h < 8; ++h) {
            f32x4 acc = {0.f, 0.f, 0.f, 0.f};
            acc = MFMA16(A0[i], qf[h][0], acc);
            acc = MFMA16(A1[i], qf[h][1], acc);
#pragma unroll
            for (int e = 0; e < 4; ++e) idx[e] += fmaxf(acc[e], 0.f) * wv[h];
          }
          s16x4 kv;
#pragma unroll
          for (int e = 0; e < 4; ++e) {
            _Float16 hv = (_Float16)idx[e];
            u16 bits = __builtin_bit_cast(u16, hv);
            kv[e] = (short)((bits & 0x8000) ? (u16)~bits : (u16)(bits | 0x8000));
          }
          *(s16x4*)(keys + qn * KPITCH + kt * 16 + quad * 4) = kv;
        }
      }
#pragma unroll
      for (int i = 0; i < 4; ++i) { A0[i] = N0[i]; A1[i] = N1[i]; }
    }
  }
  __syncthreads();
  for (int qq = 0; qq < 4 * REPSEL; ++qq) {
    const int q = w * 4 + (qq & 3);
    const u16* krow = keys + q * KPITCH;
    u64* dst = p.maskbits() + (size_t)(g0 + q) * 33;
    if (nj <= 8) select_query<8>(krow, nj, lane, dst);
    else if (nj <= 16) select_query<16>(krow, nj, lane, dst);
    else if (nj <= 24) select_query<24>(krow, nj, lane, dst);
    else select_query<33>(krow, nj, lane, dst);
  }
  __syncthreads();
}

DI void scan_item(const Params& p, int item, int tid) {
  if (item < 1024) {
    const int bh = item >> 4, slab = item & 15;
    const int idx = slab * 1024 + tid * 4;
    const int h = bh & 3;
    const float cd = exp2f(64.f * log2gamma(h));
    f32x4 s = {0.f, 0.f, 0.f, 0.f};
    for (int c0 = 0; c0 < 32; c0 += 8) {
      f32x4 kvb[8];
#pragma unroll
      for (int i = 0; i < 8; ++i) {
        const s16x4 kk = *(const s16x4*)((const u16*)p.kvT() + (size_t)(bh * 32 + c0 + i) * 16384 + idx);
#pragma unroll
        for (int j = 0; j < 4; ++j) kvb[i][j] = __uint_as_float(((unsigned)(u16)kk[j]) << 16);
      }
#pragma unroll
      for (int i = 0; i < 8; ++i) {
        *(s16x4*)(p.sprevT() + (size_t)(bh * 32 + c0 + i) * 16384 + idx) = pack4(s);
        s = s * cd + kvb[i];
      }
    }
    const int e = idx >> 7, d = idx & 127;
    float* o = p.out + OUT_STP + (size_t)bh * 16384;
#pragma unroll
    for (int j = 0; j < 4; ++j) o[(d + j) * 128 + e] = s[j];
  } else {
    const int it = item - 1024;
    const int bh = it >> 4, slab = it & 15;
    const int idx = slab * 1024 + tid * 4;
    const int h = bh & 3;
    const float cd = exp2f(64.f * log2gamma(h));
    const int e = idx >> 7, d = idx & 127;
    const float* s0 = p.state_ret + (size_t)bh * 16384;
    f32x4 s;
#pragma unroll
    for (int j = 0; j < 4; ++j) s[j] = s0[(d + j) * 128 + e];
    const size_t base = (size_t)(2048 + bh) * 16384 + idx;
    s16x4 o = pack4(s);
    *(s16x4*)(p.sprevT() + base) = o;
    const s16x4 kk = *(const s16x4*)((const u16*)p.kvT() + base);
    f32x4 kv;
#pragma unroll
    for (int j = 0; j < 4; ++j) kv[j] = __uint_as_float(((unsigned)(u16)kk[j]) << 16);
    s = s * cd + kv;
    float* oo = p.out + OUT_STS + (size_t)bh * 16384;
#pragma unroll
    for (int j = 0; j < 4; ++j) oo[(d + j) * 128 + e] = s[j];
  }
}

DI void attn_item(const Params& p, unsigned char* lds, int tid, bool samp, int b, int c, int kvh, int qh, unsigned char* lds_blk, int tid512) {
  const int lane = tid & 63, w = tid >> 6, r = lane & 31, hh = lane >> 5;
  const int T = samp ? 2112 : 2048;
  const int nkt = samp ? 33 : c + 1;
  const int g0 = (samp ? NPROMPT + b * 64 : b * 2048 + c * 64) + qh * 32;
  const u16* K = samp ? p.kaS() + (size_t)(b * 2 + kvh) * 2112 * 64 : p.kaP() + (size_t)(b * 2 + kvh) * 2048 * 64;
  const u16* VT = samp ? p.vaTS() + (size_t)(b * 2 + kvh) * 64 * 2112 : p.vaTP() + (size_t)(b * 2 + kvh) * 64 * 2048;
  const int head = kvh * 4 + w;
  u16* KV0 = (u16*)(lds_blk + 2 * HALF_LDS - 4 * 9216);
  u64* mL = (u64*)lds;
  {
    u64 mv[5];
#pragma unroll
    for (int i = 0; i < 5; ++i) { const int ix = tid + 256 * i; mv[i] = p.maskbits()[(size_t)g0 * 33 + (ix < 32 * 33 ? ix : 32 * 33 - 1)]; }
#pragma unroll
    for (int i = 0; i < 5; ++i) { const int ix = tid + 256 * i; if (ix < 32 * 33) mL[ix] = mv[i]; }
  }
  bf16x8 qf[4];
#pragma unroll
  for (int ks = 0; ks < 4; ++ks) qf[ks] = ldg8(p.qa() + (size_t)(g0 + r) * 512 + head * 64 + ks * 16 + hh * 8);
  f32x16 O[2];
  O[0] = zero16(); O[1] = zero16();
  float mrun = -1e30f, lrun = 0.f;
  const int lrow = tid512 >> 3, lch = tid512 & 7;
  const int loff = lrow * 72 + lch * 8;
  bf16x8 pk0, pv0, nk0, nv0;
  {
    const bf16x8 k0 = ldg8(K + (size_t)(lrow)*64 + lch * 8), v0 = ldg8(VT + (size_t)(lrow)*T + lch * 8);
    const int t1 = nkt > 1 ? 1 : 0, t2 = nkt > 2 ? 2 : (nkt - 1);
    pk0 = ldg8(K + (size_t)(t1 * 64 + lrow) * 64 + lch * 8); pv0 = ldg8(VT + (size_t)(lrow)*T + t1 * 64 + lch * 8);
    nk0 = ldg8(K + (size_t)(t2 * 64 + lrow) * 64 + lch * 8); nv0 = ldg8(VT + (size_t)(lrow)*T + t2 * 64 + lch * 8);
    *(bf16x8*)(KV0 + loff) = k0;
    *(bf16x8*)(KV0 + 64 * 72 + loff) = v0;
  }
  __syncthreads();
  for (int kt = 0; kt < nkt; ++kt) {
    if (kt + 1 < nkt) {
      u16* nb = KV0 + ((kt + 1) & 1) * (2 * 64 * 72);
      *(bf16x8*)(nb + loff) = pk0;
      *(bf16x8*)(nb + 64 * 72 + loff) = pv0;
    }
    pk0 = nk0; pv0 = nv0;
    {
      const int t3 = (kt + 3 < nkt) ? kt + 3 : nkt - 1;
      nk0 = ldg8(K + (size_t)(t3 * 64 + lrow) * 64 + lch * 8);
      nv0 = ldg8(VT + (size_t)(lrow)*T + t3 * 64 + lch * 8);
    }
    const u16* Ks = KV0 + (kt & 1) * (2 * 64 * 72);
    const u16* Vs = Ks + 64 * 72;
    f32x16 S[2];
#pragma unroll
    for (int st = 0; st < 2; ++st) {
      S[st] = zero16();
#pragma unroll
      for (int ks = 0; ks < 4; ++ks) {
        bf16x8 kf = *(const bf16x8*)(Ks + (st * 32 + r) * 72 + ks * 16 + hh * 8);
        S[st] = MFMA32(kf, qf[ks], S[st]);
      }
    }
    const u64 W = mL[r * 33 + kt];
    const int wl = (int)(((unsigned)W) >> (4 * hh)), wh = (int)(((unsigned)(W >> 32)) >> (4 * hh));
    float mx = fmaxf(S[0][0], S[1][0]);
#pragma unroll
    for (int i = 1; i < 16; ++i) mx = fmaxf(mx, fmaxf(S[0][i], S[1][i]));
    mx = fmaxf(mx, __shfl_xor(mx, 32));
    const float mn = fmaxf(mrun, mx);
    const float alpha = __builtin_amdgcn_exp2f(mrun - mn);
    const bool resc = __any(mn != mrun);
    mrun = mn;
    float ls = 0.f;
#pragma unroll
    for (int st = 0; st < 2; ++st)
#pragma unroll
      for (int i = 0; i < 16; ++i) {
        const int keep = __builtin_amdgcn_sbfe(st ? wh : wl, (i & 3) + 8 * (i >> 2), 1);
        const float pvv = __int_as_float(__float_as_int(__builtin_amdgcn_exp2f(S[st][i] - mn)) & keep);
        S[st][i] = pvv;
        ls += pvv;
      }
    lrun = lrun * alpha + ls;
    if (resc) {
#pragma unroll
      for (int dt = 0; dt < 2; ++dt)
#pragma unroll
        for (int i = 0; i < 16; ++i) O[dt][i] *= alpha;
    }
#pragma unroll
    for (int st = 0; st < 2; ++st)
#pragma unroll
      for (int s2 = 0; s2 < 2; ++s2) {
        bf16x8 pf = pack8(S[st][8 * s2 + 0], S[st][8 * s2 + 1], S[st][8 * s2 + 2], S[st][8 * s2 + 3],
                          S[st][8 * s2 + 4], S[st][8 * s2 + 5], S[st][8 * s2 + 6], S[st][8 * s2 + 7]);
#pragma unroll
        for (int dt = 0; dt < 2; ++dt) {
          s16x4 lo = *(const s16x4*)(Vs + (dt * 32 + r) * 72 + st * 32 + 16 * s2 + 4 * hh);
          s16x4 hi = *(const s16x4*)(Vs + (dt * 32 + r) * 72 + st * 32 + 16 * s2 + 8 + 4 * hh);
          bf16x8 vf = __builtin_shufflevector(lo, hi, 0, 1, 2, 3, 4, 5, 6, 7);
          O[dt] = MFMA32(vf, pf, O[dt]);
        }
      }
    __syncthreads();
  }
  {
    float lt = lrun + __shfl_xor(lrun, 32);
    const float inv = 1.f / fmaxf(lt, 1e-30f);
    const u16* grow = p.gate() + (size_t)(g0 + r) * 1024 + 512 + head * 64;
    u16* mrow = p.mix() + (size_t)(g0 + r) * 1024 + 512 + head * 64;
    s16x4 gvv[2][4];
#pragma unroll
    for (int dt = 0; dt < 2; ++dt)
#pragma unroll
      for (int q4 = 0; q4 < 4; ++q4) gvv[dt][q4] = *(const s16x4*)(grow + dt * 32 + 8 * q4 + 4 * hh);
#pragma unroll
    for (int dt = 0; dt < 2; ++dt)
#pragma unroll
      for (int q4 = 0; q4 < 4; ++q4) {
        const int d = dt * 32 + 8 * q4 + 4 * hh;
        f32x4 of;
#pragma unroll
        for (int j = 0; j < 4; ++j) {
          const float gf = __uint_as_float(((unsigned)(u16)gvv[dt][q4][j]) << 16);
          of[j] = O[dt][q4 * 4 + j] * inv * gf;
        }
        *(s16x4*)(mrow + d) = pack4(of);
      }
  }
  __syncthreads();
}

DI void ret_out_item(const Params& p, unsigned char* lds, int item, int tid) {
  const int lane = tid & 63, w = tid >> 6, r = lane & 31, hh = lane >> 5;
  int bh, c, T, g0; const u16* vT;
  if (item < 2048) { bh = item >> 5; c = item & 31; T = 2048; g0 = (bh >> 2) * 2048 + c * 64; vT = p.vrT() + (size_t)bh * 128 * 2048; }
  else { bh = item - 2048; c = 0; T = 64; g0 = NPROMPT + (bh >> 2) * 64; vT = p.vrT() + (size_t)64 * 128 * 2048 + (size_t)bh * 128 * 64; }
  const int h = bh & 3;
  const float l2g = log2gamma(h);
  const int nt = w & 1, eh = w >> 1;
  const int n = nt * 32 + r;
  bf16x8 qf[8], kf[8];
#pragma unroll
  for (int ks = 0; ks < 8; ++ks) qf[ks] = ldg8(p.qr() + (size_t)(g0 + n) * 512 + h * 128 + ks * 16 + hh * 8);
#pragma unroll
  for (int ks = 0; ks < 8; ++ks) kf[ks] = ldg8(p.kr() + (size_t)(g0 + r) * 512 + h * 128 + ks * 16 + hh * 8);
  __builtin_amdgcn_sched_barrier(0);
  bf16x8 pf[2][2];
#pragma unroll
  for (int mt = 0; mt < 2; ++mt) {
    f32x16 S = zero16();
#pragma unroll
    for (int ks = 0; ks < 8; ++ks) S = MFMA32(kf[ks], qf[ks], S);
    if (mt == 0) {
#pragma unroll
      for (int ks = 0; ks < 8; ++ks) kf[ks] = ldg8(p.kr() + (size_t)(g0 + 32 + r) * 512 + h * 128 + ks * 16 + hh * 8);
      __builtin_amdgcn_sched_barrier(0);
    }
#pragma unroll
    for (int i = 0; i < 16; ++i) {
      const int m = mt * 32 + crow(i, hh);
      const int dd = n > m ? n - m : m - n;
      S[i] *= exp2f((float)dd * l2g);
    }
    pf[mt][0] = pack8(S[0], S[1], S[2], S[3], S[4], S[5], S[6], S[7]);
    pf[mt][1] = pack8(S[8], S[9], S[10], S[11], S[12], S[13], S[14], S[15]);
  }
  const float fs = exp2f((float)(n + 1) * l2g);
  const u16* sp = p.sprevT() + (size_t)item * 16384;
  f32x16 tot[2];
  float ss = 0.f;
  s16x4 vlo[2][2][2], vhi[2][2][2];
#pragma unroll
  for (int et = 0; et < 2; ++et)
#pragma unroll
    for (int mt = 0; mt < 2; ++mt)
#pragma unroll
      for (int s2 = 0; s2 < 2; ++s2) {
        const u16* vp = vT + (size_t)((2 * eh + et) * 32 + r) * T + c * 64 + mt * 32 + 16 * s2 + 4 * hh;
        vlo[et][mt][s2] = ldg4(vp); vhi[et][mt][s2] = ldg4(vp + 8);
      }
  __builtin_amdgcn_sched_barrier(0);
#pragma unroll
  for (int et = 0; et < 2; ++et) {
    const int e = (2 * eh + et) * 32 + r;
    bf16x8 sf[8];
#pragma unroll
    for (int ks = 0; ks < 8; ++ks) sf[ks] = ldg8(sp + (size_t)e * 128 + ks * 16 + hh * 8);
    __builtin_amdgcn_sched_barrier(0);
    f32x16 Oi = zero16(), X = zero16();
#pragma unroll
    for (int mt = 0; mt < 2; ++mt)
#pragma unroll
      for (int s2 = 0; s2 < 2; ++s2) {
        bf16x8 vf = __builtin_shufflevector(vlo[et][mt][s2], vhi[et][mt][s2], 0, 1, 2, 3, 4, 5, 6, 7);
        Oi = MFMA32(vf, pf[mt][s2], Oi);
      }
#pragma unroll
    for (int ks = 0; ks < 8; ++ks) X = MFMA32(sf[ks], qf[ks], X);
#pragma unroll
    for (int i = 0; i < 16; ++i) { const float t = Oi[i] + X[i] * fs; tot[et][i] = t; ss += t * t; }
  }
  ss += __shfl_xor(ss, 32);
  float* red = (float*)lds;
  __syncthreads();
  if (hh == 0) red[w * 32 + r] = ss;
  __syncthreads();
  const float tsum = red[w * 32 + r] + red[(w ^ 2) * 32 + r];
  const float rinv = rsqrtf(tsum * (1.f / 128.f) + 1e-6f);
  const u16* grow = p.gate() + (size_t)(g0 + n) * 1024 + h * 128;
  u16* mrow = p.mix() + (size_t)(g0 + n) * 1024 + h * 128;
  s16x4 gvv[2][4];
  f32x4 ggv[2][4];
#pragma unroll
  for (int et = 0; et < 2; ++et)
#pragma unroll
    for (int q4 = 0; q4 < 4; ++q4) {
      const int e = (2 * eh + et) * 32 + 8 * q4 + 4 * hh;
      gvv[et][q4] = *(const s16x4*)(grow + e);
      ggv[et][q4] = *(const f32x4*)(p.ret_gn_g + h * 128 + e);
    }
#pragma unroll
  for (int et = 0; et < 2; ++et)
#pragma unroll
    for (int q4 = 0; q4 < 4; ++q4) {
      const int e = (2 * eh + et) * 32 + 8 * q4 + 4 * hh;
      f32x4 of;
#pragma unroll
      for (int j = 0; j < 4; ++j) {
        const float gf = __uint_as_float(((unsigned)(u16)gvv[et][q4][j]) << 16);
        of[j] = tot[et][q4 * 4 + j] * rinv * ggv[et][q4][j] * gf;
      }
      *(s16x4*)(mrow + e) = pack4(of);
    }
}

DI void phase_final(const Params& p, int tid) {
  const int gt = blockIdx.x * 512 + tid, GT = gridDim.x * 512;
  const int lane = tid & 63;
  for (int row0 = (gt >> 6) * 2; row0 < NTOK; row0 += (GT >> 6) * 2) {
    f32x4 v[2][4];
    s16x4 zz[2][4];
#pragma unroll
    for (int rr = 0; rr < 2; ++rr) {
      const float* xr = xrow(p, row0 + rr);
      const u16* zr = p.gate() + (size_t)(row0 + rr) * 1024;
#pragma unroll
      for (int i = 0; i < 4; ++i) { v[rr][i] = *(const f32x4*)(xr + i * 256 + lane * 4); zz[rr][i] = *(const s16x4*)(zr + i * 256 + lane * 4); }
    }
    f32x4 g[4];
#pragma unroll
    for (int i = 0; i < 4; ++i) g[i] = *(const f32x4*)(p.final_g + i * 256 + lane * 4);
#pragma unroll
    for (int rr = 0; rr < 2; ++rr) {
      float ss = 0.f;
#pragma unroll
      for (int i = 0; i < 4; ++i) {
#pragma unroll
        for (int j = 0; j < 4; ++j) v[rr][i][j] += __uint_as_float(((unsigned)(u16)zz[rr][i][j]) << 16);
        ss += v[rr][i][0] * v[rr][i][0] + v[rr][i][1] * v[rr][i][1] + v[rr][i][2] * v[rr][i][2] + v[rr][i][3] * v[rr][i][3];
      }
#pragma unroll
      for (int o = 32; o >= 1; o >>= 1) ss += __shfl_xor(ss, o);
      const float rv = rsqrtf(ss * (1.f / 1024.f) + 1e-6f);
      float* y = p.out + OUT_Y + (size_t)(row0 + rr) * 1024;
#pragma unroll
      for (int i = 0; i < 4; ++i) *(f32x4*)(y + i * 256 + lane * 4) = v[rr][i] * rv * g[i];
    }
  }
}

#ifndef REP0
#define REP0 1
#endif
#ifndef REP1
#define REP1 1
#endif
#ifndef REP2
#define REP2 1
#endif
#ifndef REP3
#define REP3 1
#endif
#ifndef REP4
#define REP4 1
#endif
#ifndef REP5
#define REP5 1
#endif
__global__ void __launch_bounds__(512, 2) fwd_megakernel(Params p) {
  __shared__ __attribute__((aligned(16))) unsigned char lds[LDS_BYTES];
  cg::grid_group grid = cg::this_grid();
  const int wave_id = __builtin_amdgcn_readfirstlane((int)threadIdx.x >> 6);
#define FRESH_TID() int tid = wave_id * 64 + lane_id(); asm volatile("" : "+v"(tid)); const int half = tid >> 8, htid = tid & 255; unsigned char* ldsh = lds + half * HALF_LDS; (void)htid; (void)ldsh;
  if (p.out == nullptr) grid.sync();
  if (wave_id == 0 && lane_id() == 0) (void)xb_add(&p.bar()[XB_XCNT(xb_xcc_id())], 1u);
  for (int rep = 0; rep < REP0; ++rep) {
  { FRESH_TID(); phase_prep(p, tid); }
  xcd_barrier(p.bar(), wave_id);
  }
  for (int rep = 0; rep < REP1; ++rep) {
  {
    FRESH_TID();
    pg8::Gemm g; g.A = p.xb(); g.Bt = p.WtIn(); g.M = NTOK; g.N = 4096; g.K = 1024;
    pg8::StaticOrder S; S.init(g.M, g.N, (int)gridDim.x, (int)blockIdx.x); S.permtab = 0xEFBCD87694105A32ull; S.padtile = 15;
    Epi1 E; E.p = p; E.hl0 = (LAS unsigned char*)lds + pg8::STAGE_BYTES;
    pg8::gemm_phase<Epi1>((LAS unsigned char*)lds, g, S, E, wave_id);
  }
  xcd_barrier(p.bar(), wave_id);
  }
  for (int rep = 0; rep < REP2; ++rep) {
  {
    FRESH_TID();
    for (int it0 = blockIdx.x * 2; it0 < 2080 + 2080; it0 += gridDim.x * 2) {
      const int it = it0 + half;
      int ht = htid; asm volatile("" : "+v"(ht));
      if (it < 2080) {
        const bool samp = it < 32;
        const int j = it - 32;
        const int c = 31 - (j >> 6);
        const int b = samp ? (it >> 2) : ((j & 63) >> 2);
        const int grp = samp ? (it & 3) : (c * 4 + (j & 3));
        idx_item(p, ldsh, ht, samp, b, grp);
      } else { for (int rkv = 0; rkv < REPKV; ++rkv) ret_kv_item(p, it - 2080, ht); }
    }
  }
  xcd_barrier(p.bar(), wave_id);
  }
  for (int rep = 0; rep < REP3; ++rep) {
  {
    FRESH_TID();
    for (int it0 = blockIdx.x * 2; it0 < 1056 + 1536; it0 += gridDim.x * 2) {
      const int it = it0 + half;
      int ht = htid; asm volatile("" : "+v"(ht));
      if (it < 1056) {
        const bool samp = it < 32;
        const int j = it - 32;
        int c = samp ? 0 : 31 - (j >> 6);
        int b = samp ? (it >> 2) : ((j & 63) >> 2);
        int kvh = (it >> 1) & 1;
        if (!samp && gridDim.x == 256) {
          const int jb = (j >> 1) & 255, rnd = j >> 9;
          const int xcd = jb & 7, ii = jb >> 3;
          b = 2 * xcd + (ii & 1); kvh = (ii >> 1) & 1; c = 31 - rnd * 8 - (ii >> 2);
        }
        attn_item(p, ldsh, ht, samp, b, c, kvh, it & 1, lds, tid);
      } else scan_item(p, it - 1056, ht);
    }
  }
  xcd_barrier(p.bar(), wave_id);
  }
  for (int rep = 0; rep < REP4; ++rep) {
  {
    FRESH_TID();
    for (int it0 = blockIdx.x * 2; it0 < 2080 + 1024; it0 += gridDim.x * 2) {
      const int it = it0 + half;
      int ht = htid; asm volatile("" : "+v"(ht));
      if (it < 2080) ret_out_item(p, ldsh, it, ht);
      else {
        const int ia = it - 2080 + 1056;
        const int j = ia - 32;
        int c = 31 - (j >> 6);
        int b = (j & 63) >> 2;
        int kvh = (ia >> 1) & 1;
        if (gridDim.x == 256) {
          const int jb = (j >> 1) & 255, rnd = j >> 9;
          const int xcd = jb & 7, ii = jb >> 3;
          b = 2 * xcd + (ii & 1); kvh = (ii >> 1) & 1; c = 31 - rnd * 8 - (ii >> 2);
        }
        attn_item(p, ldsh, ht, false, b, c, kvh, ia & 1, lds, tid);
      }
    }
  }
  xcd_barrier(p.bar(), wave_id);
  }
  for (int rep = 0; rep < REP5; ++rep) {
  {
    pg8::Gemm g; g.A = p.mix(); g.Bt = p.WtOut(); g.M = NTOK; g.N = 1024; g.K = 1024;
    pg8::StaticOrder S; S.init(g.M, g.N, (int)gridDim.x, (int)blockIdx.x);
    Epi2 E; E.p = p; E.hl = lds + pg8::STAGE_BYTES + (wave_id >> 2) * 16384;
    pg8::gemm_phase<Epi2>((LAS unsigned char*)lds, g, S, E, wave_id);
  }
  xcd_barrier(p.bar(), wave_id);
  }
  { FRESH_TID(); phase_final(p, tid); }
}

extern "C" void kernel_launch(void* const* d_in, const int* in_sizes, int n_in, void* d_out, int out_size, void* d_ws,
                              size_t ws_size, hipStream_t stream) {
  static int grid_blocks = 0;
  if (!grid_blocks) {
    int dev = 0, cus = 0, per_cu = 0;
    (void)hipGetDevice(&dev);
    (void)hipDeviceGetAttribute(&cus, hipDeviceAttributeMultiprocessorCount, dev);
    (void)hipOccupancyMaxActiveBlocksPerMultiprocessor(&per_cu, fwd_megakernel, 512, 0);
    if (per_cu < 1) per_cu = 1;
    if (per_cu > 1) per_cu = 1;
    grid_blocks = cus * per_cu;
  }
  Params p{};
  p.x_p = (const float*)d_in[0]; p.x_s = (const float*)d_in[1]; p.state_ret = (const float*)d_in[2];
  p.cache_k = (const float*)d_in[3]; p.cache_v = (const float*)d_in[4]; p.cache_kidx = (const float*)d_in[5];
  p.norm_g = (const float*)d_in[6]; p.w_in = (const float*)d_in[7]; p.ret_gn_g = (const float*)d_in[8];
  p.w_out = (const float*)d_in[9]; p.final_g = (const float*)d_in[10];
  p.out = (float*)d_out;
  p.ws = (unsigned char*)d_ws;
  (void)hipMemsetAsync((unsigned char*)d_ws + 530573312ull, 0, (size_t)XCD_BAR_WORDS * 4, stream);
  void* args[] = {&p};
  hipError_t e = hipLaunchCooperativeKernel((void*)fwd_megakernel, dim3(grid_blocks), dim3(512), args, 0, stream);
  if (e != hipSuccess) fprintf(stderr, "cooperative launch failed: %s (grid %d)\n", hipGetErrorString(e), grid_blocks);
}
```

```cpp
#include <hip/hip_runtime.h>
#include <hip/hip_cooperative_groups.h>
#include <stdint.h>
#include <cstdio>
namespace cg = cooperative_groups;

typedef __attribute__((ext_vector_type(8))) short bf16x8;
typedef __attribute__((ext_vector_type(4))) short s16x4;
typedef __attribute__((ext_vector_type(16))) float f32x16;
typedef __attribute__((ext_vector_type(4))) float f32x4;
typedef unsigned short u16;
typedef unsigned long long u64;


#define DI __device__ __forceinline__
#define MFMA32(a, b, c) __builtin_amdgcn_mfma_f32_32x32x16_bf16((a), (b), (c), 0, 0, 0)
#define MFMA16(a, b, c) __builtin_amdgcn_mfma_f32_16x16x32_bf16((a), (b), (c), 0, 0, 0)

#define NTOK 33280
#define NPROMPT 32768
#define LDS_BYTES 163840
#define HALF_LDS 81920
#define LAS __attribute__((address_space(3)))
#define KPITCH 2116

struct Params {
  const float *x_p, *x_s, *state_ret, *cache_k, *cache_v, *cache_kidx, *norm_g, *w_in, *ret_gn_g, *w_out, *final_g;
  float* out;
  unsigned char* ws;
  DI u16* xb() const { return (u16*)(ws + 0ull); }
  DI float* kvT() const { return (float*)(ws + 0ull); }
  DI u16* WtIn() const { return (u16*)(ws + 136314880ull); }
  DI u16* WtOut() const { return (u16*)(ws + 144703488ull); }
  DI u16* qr() const { return (u16*)(ws + 146800640ull); }
  DI u16* kr() const { return (u16*)(ws + 180879360ull); }
  DI u16* sprevT() const { return (u16*)(ws + 214958080ull); }
  DI u16* qi() const { return (u16*)(ws + 214958080ull); }
  DI u16* krT() const { return (u16*)(ws + 249036800ull); }
  DI u16* vrT() const { return (u16*)(ws + 283115520ull); }
  DI u16* gate() const { return (u16*)(ws + 317194240ull); }
  DI u16* mix() const { return (u16*)(ws + 385351680ull); }
  DI u16* qa() const { return (u16*)(ws + 453509120ull); }
  DI u16* kaP() const { return (u16*)(ws + 487587840ull); }
  DI u16* kaS() const { return (u16*)(ws + 495976448ull); }
  DI u16* vaTP() const { return (u16*)(ws + 500301824ull); }
  DI u16* vaTS() const { return (u16*)(ws + 508690432ull); }
  DI u16* kiP() const { return (u16*)(ws + 513015808ull); }
  DI u16* kiS() const { return (u16*)(ws + 517210112ull); }
  DI float* rinv() const { return (float*)(ws + 519372800ull); }
  DI float* wi() const { return (float*)(ws + 519505920ull); }
  DI float* cosR() const { return (float*)(ws + 520570880ull); }
  DI float* sinR() const { return (float*)(ws + 521111552ull); }
  DI float* cosA() const { return (float*)(ws + 521652224ull); }
  DI float* sinA() const { return (float*)(ws + 521719808ull); }
  DI unsigned* bar() const { return (unsigned*)(ws + 530573312ull); }
  DI u64* maskbits() const { return (u64*)(ws + 521787392ull); }
};

#define OUT_Y 0
#define OUT_STP (34078720)
#define OUT_KP (OUT_STP + 1048576)
#define OUT_VP (OUT_KP + 4194304)
#define OUT_KIP (OUT_VP + 4194304)
#define OUT_STS (OUT_KIP + 2097152)
#define OUT_KS (OUT_STS + 524288)
#define OUT_VS (OUT_KS + 65536)
#define OUT_KIS (OUT_VS + 65536)

typedef __bf16 bf16x2_t __attribute__((ext_vector_type(2)));
typedef float f32x2_t __attribute__((ext_vector_type(2)));
typedef unsigned u32x4_t __attribute__((ext_vector_type(4)));
typedef unsigned u32x2_t __attribute__((ext_vector_type(2)));
DI unsigned pk2(float a, float b) { f32x2_t v = {a, b}; bf16x2_t r = __builtin_convertvector(v, bf16x2_t); return __builtin_bit_cast(unsigned, r); }
DI u16 f2bf(float x) { return (u16)(pk2(x, x) & 0xffffu); }
DI bf16x8 ldg8(const u16* p) { return *(const bf16x8*)p; }
DI s16x4 ldg4(const u16* p) { return *(const s16x4*)p; }
DI float siluf(float x) { return x * __builtin_amdgcn_rcpf(1.f + __builtin_amdgcn_exp2f(-1.4426950408889634f * x)); }
DI int lane_id() { return (int)__builtin_amdgcn_mbcnt_hi(~0u, __builtin_amdgcn_mbcnt_lo(~0u, 0u)); }
DI int crow(int reg, int hh) { return (reg & 3) + 8 * (reg >> 2) + 4 * hh; }
DI const float* xrow(const Params& p, int g) { return g < NPROMPT ? p.x_p + (size_t)g * 1024 : p.x_s + (size_t)(g - NPROMPT) * 1024; }
DI float log2gamma(int h) { return log1pf(-exp2f(-5.f - (float)h)) * 1.4426950408889634f; }
DI bf16x8 pack8(float a0, float a1, float a2, float a3, float a4, float a5, float a6, float a7) {
  u32x4_t v = {pk2(a0, a1), pk2(a2, a3), pk2(a4, a5), pk2(a6, a7)};
  return __builtin_bit_cast(bf16x8, v);
}
DI s16x4 pack4(f32x4 v) { u32x2_t o = {pk2(v[0], v[1]), pk2(v[2], v[3])}; return __builtin_bit_cast(s16x4, o); }
DI int wave_sum(int v) {
  v += __builtin_amdgcn_update_dpp(0, v, 0xB1, 0xf, 0xf, false);
  v += __builtin_amdgcn_update_dpp(0, v, 0x4E, 0xf, 0xf, false);
  v += __builtin_amdgcn_update_dpp(0, v, 0x124, 0xf, 0xf, false);
  v += __builtin_amdgcn_update_dpp(0, v, 0x128, 0xf, 0xf, false);
  return __builtin_amdgcn_readlane(v, 0) + __builtin_amdgcn_readlane(v, 16) + __builtin_amdgcn_readlane(v, 32) + __builtin_amdgcn_readlane(v, 48);
}
DI f32x16 zero16() { f32x16 z; for (int i = 0; i < 16; ++i) z[i] = 0.f; return z; }

#define XB_TMO      128
#define XB_XCNT(j)  (256  + 64 * (j))
#define XB_XSUB(j)  (1280 + 64 * (j))
#define XB_XGEN(j)  (2304 + 64 * (j))
#define XB_TOP      3328
#define XB_TOPGEN   3392
#define XB_WG(i)    (3456 + 64 * (i))
#define XCD_BAR_WORDS (3456 + 64 * 256)
#define XB_SPIN_CAP (1u << 18)
DI unsigned xb_ld(unsigned* p) { return __hip_atomic_load(p, __ATOMIC_RELAXED, __HIP_MEMORY_SCOPE_AGENT); }
DI unsigned xb_add(unsigned* p, unsigned v) { return __hip_atomic_fetch_add(p, v, __ATOMIC_RELAXED, __HIP_MEMORY_SCOPE_AGENT); }
DI unsigned xb_xcc_id() { return (unsigned)__builtin_amdgcn_s_getreg((3 << 11) | 20) & 0xFu; }
#define XB_SPIN(cond, bar) do { unsigned _sp = 0; while (cond) { __builtin_amdgcn_s_sleep(1); \
    if ((++_sp & 255u) == 0u) { if (xb_ld(&(bar)[XB_TMO])) break; if (_sp > XB_SPIN_CAP) { atomicAdd(&(bar)[XB_TMO], 1u); break; } } } } while (0)
DI void xcd_barrier(unsigned* bar, int wave_id) {
  asm volatile("s_waitcnt vmcnt(0)" ::: "memory");
  __syncthreads();
  if (wave_id == 0) {
    const int lane = lane_id();
    const unsigned x = xb_xcc_id();
    unsigned* slot = &bar[XB_WG(blockIdx.x)];
    unsigned nloc = 0u, nx = 0u;
    if (lane < 2) nloc = xb_ld(slot + lane);
    nx = (unsigned)__builtin_amdgcn_readlane((int)nloc, 1);
    nloc = (unsigned)__builtin_amdgcn_readlane((int)nloc, 0);
    if (nloc == 0u) {
      const unsigned G = gridDim.x * gridDim.y * gridDim.z;
      unsigned sp = 0u, c = 0u;
      for (;;) {
        c = (lane < 16) ? xb_ld(&bar[XB_XCNT(lane)]) : 0u;
        const unsigned sum = (unsigned)wave_sum((int)c);
        if (sum == G) break;
        __builtin_amdgcn_s_sleep(1);
        if ((++sp & 255u) == 0u) { if (xb_ld(&bar[XB_TMO])) break; if (sp > XB_SPIN_CAP) { if (lane == 0) atomicAdd(&bar[XB_TMO], 1u); break; } }
      }
      nx = (unsigned)__popcll(__ballot(c > 0u));
      nloc = (unsigned)__builtin_amdgcn_readlane((int)c, (int)x);
      nloc = nloc > 0u ? nloc : 1u; nx = nx > 0u ? nx : 1u;
      if (lane == 0) { __hip_atomic_store(slot, nloc, __ATOMIC_RELAXED, __HIP_MEMORY_SCOPE_AGENT); __hip_atomic_store(slot + 1, nx, __ATOMIC_RELAXED, __HIP_MEMORY_SCOPE_AGENT); }
    }
    if (lane == 0) {
      __builtin_amdgcn_s_waitcnt(0);
      const unsigned old = xb_add(&bar[XB_XSUB(x)], 1u);
      const unsigned gen = old / nloc;
      if (old + 1u == (gen + 1u) * nloc) {
        __builtin_amdgcn_fence(__ATOMIC_RELEASE, "agent");
        asm volatile("s_waitcnt vmcnt(0)" ::: "memory");
        const unsigned og = xb_add(&bar[XB_TOP], 1u);
        const unsigned tg = og / nx;
        if (og + 1u == (tg + 1u) * nx) xb_add(&bar[XB_TOPGEN], 1u);
        else XB_SPIN(xb_ld(&bar[XB_TOPGEN]) == tg, bar);
        __builtin_amdgcn_fence(__ATOMIC_ACQUIRE, "agent");
        xb_add(&bar[XB_XGEN(x)], 1u);
        asm volatile("s_waitcnt vmcnt(0)" ::: "memory");
      } else {
        XB_SPIN(xb_ld(&bar[XB_XGEN(x)]) == gen, bar);
        __builtin_amdgcn_fence(__ATOMIC_ACQUIRE, "agent");
        asm volatile("s_waitcnt vmcnt(0)" ::: "memory");
      }
    }
  }
  __syncthreads();
}

DI void phase_prep(const Params& p, int tid) {
  const int gt = blockIdx.x * 512 + tid, GT = gridDim.x * 512;
  const int lane = tid & 63;
  for (int row0 = (gt >> 6) * 2; row0 < NTOK; row0 += (GT >> 6) * 2) {
    f32x4 v[2][4];
#pragma unroll
    for (int rr = 0; rr < 2; ++rr) {
      const float* sp = xrow(p, row0 + rr);
#pragma unroll
      for (int i = 0; i < 4; ++i) v[rr][i] = __builtin_nontemporal_load((const f32x4*)(sp + i * 256 + lane * 4));
    }
#pragma unroll
    for (int rr = 0; rr < 2; ++rr) {
      float ss = 0.f;
#pragma unroll
      for (int i = 0; i < 4; ++i) ss += v[rr][i][0] * v[rr][i][0] + v[rr][i][1] * v[rr][i][1] + v[rr][i][2] * v[rr][i][2] + v[rr][i][3] * v[rr][i][3];
#pragma unroll
      for (int o = 32; o >= 1; o >>= 1) ss += __shfl_xor(ss, o);
#pragma unroll
      for (int i = 0; i < 4; ++i) *(s16x4*)(p.xb() + (size_t)(row0 + rr) * 1024 + i * 256 + lane * 4) = pack4(v[rr][i]);
      if (lane == 0) p.rinv()[row0 + rr] = rsqrtf(ss * (1.f / 1024.f) + 1e-6f);
    }
  }
  for (int i = gt; i < 4096 * 128; i += GT) {
    int n = i & 4095, kg = i >> 12;
    int sc = n;
    if (n < 1024) { const int P = n & 127; sc = (n & ~127) + 64 * ((P >> 4) & 1) + 16 * (P >> 5) + (P & 15); }
    float a[8];
    const float vmask = (n < 3912) ? 1.f : 0.f; const int scc = (sc < 3912) ? sc : 3911;
#pragma unroll
    for (int j = 0; j < 8; ++j) a[j] = p.w_in[(size_t)(kg * 8 + j) * 3912 + scc] * p.norm_g[kg * 8 + j] * vmask;
    *(bf16x8*)(p.WtIn() + (size_t)n * 1024 + kg * 8) = pack8(a[0], a[1], a[2], a[3], a[4], a[5], a[6], a[7]);
  }
  for (int i = gt; i < 1024 * 128; i += GT) {
    int n = i % 1024, kg = i / 1024;
    float a[8];
#pragma unroll
    for (int j = 0; j < 8; ++j) a[j] = p.w_out[(size_t)(kg * 8 + j) * 1024 + n];
    *(bf16x8*)(p.WtOut() + (size_t)n * 1024 + kg * 8) = pack8(a[0], a[1], a[2], a[3], a[4], a[5], a[6], a[7]);
  }
  for (int i = gt; i < 2112 * 64; i += GT) {
    int pos = i >> 6, k = i & 63;
    float inv = powf(10000.f, -(float)k / 64.f);
    float ang = (float)pos * inv;
    p.cosR()[i] = cosf(ang); p.sinR()[i] = sinf(ang);
  }
  for (int i = gt; i < 2112 * 8; i += GT) {
    int pos = i >> 3, k = i & 7;
    float inv = powf(500000.f, -(float)k / 8.f);
    float ang = (float)pos * inv;
    p.cosA()[i] = cosf(ang); p.sinA()[i] = sinf(ang);
  }
  for (int i = gt; i < 8 * 2048 * 2 * 8; i += GT) {
    int dg = i & 7, kvh = (i >> 3) & 1, t = (i >> 4) & 2047, b = i >> 15;
    const float* s = p.cache_k + ((size_t)(b * 2048 + t) * 2 + kvh) * 64 + dg * 8;
    *(bf16x8*)(p.kaS() + ((size_t)(b * 2 + kvh) * 2112 + t) * 64 + dg * 8) = pack8(s[0], s[1], s[2], s[3], s[4], s[5], s[6], s[7]);
  }
  for (int i = gt; i < 8 * 2 * 256 * 64; i += GT) {
    int d = i & 63, tg = (i >> 6) & 255, kvh = (i >> 14) & 1, b = i >> 15;
    float a[8];
#pragma unroll
    for (int j = 0; j < 8; ++j) a[j] = p.cache_v[((size_t)(b * 2048 + tg * 8 + j) * 2 + kvh) * 64 + d];
    *(bf16x8*)(p.vaTS() + ((size_t)(b * 2 + kvh) * 64 + d) * 2112 + tg * 8) = pack8(a[0], a[1], a[2], a[3], a[4], a[5], a[6], a[7]);
  }
  for (int i = gt; i < 8 * 2048 * 8; i += GT) {
    int dg = i & 7, t = (i >> 3) & 2047, b = i >> 14;
    const float* s = p.cache_kidx + (size_t)(b * 2048 + t) * 64 + dg * 8;
    *(bf16x8*)(p.kiS() + ((size_t)b * 2112 + t) * 64 + dg * 8) = pack8(s[0], s[1], s[2], s[3], s[4], s[5], s[6], s[7]);
  }
}

namespace pg8 {
constexpr int BM = 256, BK = 64, HALF = 128, HTB = HALF * BK * 2, STAGE_BYTES = 8 * HTB, NXCD = 8, WGM = 8;
DI int lds_byte(int r, int c) { const int st = (r >> 4) * 2 + (c >> 5), rr = r & 15, cc = c & 31, ob = rr * 64 + cc * 2; return st * 1024 + (ob ^ (((ob >> 9) & 1) << 5)); }
DI void stage_rc(int b, int& R, int& C) { const int st = b / 1024, sb = b % 1024, swz = sb ^ (((sb >> 9) & 1) << 5); R = (st >> 1) * 16 + swz / 64; C = (st & 1) * 32 + (swz % 64) / 2; }
struct Unit { int pm, pn; };
struct Gemm { const u16* A; const u16* Bt; int M, N, K; };
struct StaticOrder {
  int nM, nN, nwg, G, c, padtile; unsigned long long permtab;
  DI void init(int M, int N, int G_, int c_) { nM = M / BM; nN = N / BM; nwg = nM * nN; G = G_; c = c_; permtab = 0xFEDCBA9876543210ull; padtile = -1; }
  DI void map(int L, Unit& u) const {
    int wgid = L; { const int q = nwg / NXCD, r = nwg % NXCD, xcd = wgid % NXCD, off = wgid / NXCD; wgid = (xcd < r ? xcd * (q + 1) : r * (q + 1) + (xcd - r) * q) + off; }
    const int nig = WGM * nN, gid = wgid / nig, fm = gid * WGM, gsz = (nM - fm) < WGM ? (nM - fm) : WGM;
    u.pm = fm + ((wgid % nig) % gsz); u.pn = (int)((permtab >> (4 * ((wgid % nig) / gsz))) & 15ull);
  }
  DI bool next(int i, Unit& u) const {
    const long Ll = (long)i * G + c; if (Ll >= nwg) return false;
    const int L = (int)Ll;
    if (padtile < 0) { map(L, u); return true; }
    const int tail = nwg % G, base = nwg - tail;
    if (L >= base) { u.pm = L - base; u.pn = padtile; return true; }
    map(L, u);
    for (int it = 0; it < 64 && u.pn == padtile && u.pm < tail; ++it) map(base + u.pm, u);
    return true;
  }
};
template <class Epi>
DI void gemm_phase(LAS unsigned char* lds, const Gemm g, const StaticOrder& S, const Epi& E, int wave_id) {
  const int wid = wave_id; int lane = lane_id(); asm volatile("" : "+v"(lane)); const int tid = wid * 64 + lane;
  const int wr = wid >> 2, wc = wid & 3, fr = lane & 15, fq = lane >> 4;
  const int K = g.K, nt = K / BK;
  unsigned voffA[2], voffB[2];
#pragma unroll
  for (int i = 0; i < 2; ++i) { int R, C; stage_rc(tid * 16 + i * 8192, R, C); voffA[i] = (unsigned)(R * K + C) * 2u; voffB[i] = voffA[i]; }
  const size_t kstep = (size_t)(BK * 2);
  const size_t hstep = (size_t)HALF * K * 2;
  const size_t tstep = 2 * hstep;
  const unsigned ldsw = (unsigned)wid * 1024u;
  const int aoff = lds_byte(wr * 64 + fr, fq * 8), boff = lds_byte(wc * 32 + fr, fq * 8);
#define PG8_SA(b, h) (((b) * 2 + (h)) * HTB)
#define PG8_SB(b, h) ((4 + (b) * 2 + (h)) * HTB)
#define PG8_STAGE(bufoff, gbase, voff) do { _Pragma("unroll") for (int _i = 0; _i < 2; ++_i) \
    __builtin_amdgcn_global_load_lds((const unsigned*)((const char*)(gbase) + (voff)[_i]), (LAS unsigned*)(lds + (bufoff) + ldsw + _i * 8192), 16, 0, 0); } while (0)
#define PG8_LDA(dst, b, h) do { _Pragma("unroll") for (int m = 0; m < 4; ++m) _Pragma("unroll") for (int k = 0; k < 2; ++k) dst[m][k] = *(const LAS bf16x8*)(lds + PG8_SA(b, h) + aoff + m * 2048 + k * 1024); } while (0)
#define PG8_LDB(dst, b, h) do { _Pragma("unroll") for (int n = 0; n < 2; ++n) _Pragma("unroll") for (int k = 0; k < 2; ++k) dst[n][k] = *(const LAS bf16x8*)(lds + PG8_SB(b, h) + boff + n * 2048 + k * 1024); } while (0)
#define PG8_MMA(ai, bj, At, Bt) do { __builtin_amdgcn_s_setprio(1); _Pragma("unroll") for (int m = 0; m < 4; ++m) _Pragma("unroll") for (int n = 0; n < 2; ++n) _Pragma("unroll") for (int k = 0; k < 2; ++k) \
    acc[ai][bj][m][n] = __builtin_amdgcn_mfma_f32_16x16x32_bf16(Bt[n][k], At[m][k], acc[ai][bj][m][n], 0, 0, 0); __builtin_amdgcn_s_setprio(0); } while (0)
#define PG8_WAIT_V(n) asm volatile("s_waitcnt vmcnt(" #n ")" ::: "memory")
#define PG8_WAIT_L(n) asm volatile("s_waitcnt lgkmcnt(" #n ")" ::: "memory")
#define PG8_BAR __builtin_amdgcn_s_barrier()
#define PG8_SCHED __builtin_amdgcn_sched_barrier(0)
  Unit cur, nxt; int ui = 0;
  if (!S.next(0, cur)) return;
  f32x4 acc[2][2][4][2];
#pragma unroll
  for (int a = 0; a < 2; ++a)
#pragma unroll
    for (int b = 0; b < 2; ++b)
#pragma unroll
      for (int m = 0; m < 4; ++m)
#pragma unroll
        for (int n = 0; n < 2; ++n) acc[a][b][m][n] = (f32x4){0.f, 0.f, 0.f, 0.f};
  bf16x8 At[4][2], B0[2][2], B1[2][2];
  const char* cA = (const char*)g.A + (size_t)cur.pm * tstep; const char* cB = (const char*)g.Bt + (size_t)cur.pn * tstep;
  PG8_STAGE(PG8_SB(0, 0), cB, voffB); PG8_STAGE(PG8_SA(0, 0), cA, voffA); PG8_STAGE(PG8_SB(0, 1), cB + hstep, voffB); PG8_STAGE(PG8_SA(0, 1), cA + hstep, voffA);
  if (wr == 1) PG8_BAR;
  PG8_WAIT_V(4); PG8_BAR;
  PG8_STAGE(PG8_SB(1, 0), cB + kstep, voffB); PG8_STAGE(PG8_SA(1, 0), cA + kstep, voffA); PG8_STAGE(PG8_SB(1, 1), cB + hstep + kstep, voffB);
  PG8_WAIT_V(6); PG8_BAR;
  for (;;) {
    const bool has_next = S.next(ui + 1, nxt);
    const char* nA = has_next ? (const char*)g.A + (size_t)nxt.pm * tstep : cA; const char* nB = has_next ? (const char*)g.Bt + (size_t)nxt.pn * tstep : cB;
#ifndef REPK
#define REPK 1
#endif
    const bool skip1 = (S.padtile >= 0) && (cur.pn == S.padtile);
    for (int rk = 0; rk < REPK; ++rk) {
    const char* nA2 = (rk == REPK - 1) ? nA : cA; const char* nB2 = (rk == REPK - 1) ? nB : cB;
    for (int t = 0; t < nt; t += 2) {
      const bool last = (t == nt - 2);
      const char* a1 = cA + (size_t)(t + 1) * kstep;
      const char* a2 = last ? nA2 : cA + (size_t)(t + 2) * kstep; const char* b2 = last ? nB2 : cB + (size_t)(t + 2) * kstep;
      const char* a3 = a2 + kstep; const char* b3 = b2 + kstep;
      PG8_LDB(B0, 0, 0); PG8_SCHED; PG8_LDA(At, 0, 0); PG8_STAGE(PG8_SA(1, 1), a1 + hstep, voffA);
      PG8_WAIT_L(8); PG8_BAR; PG8_WAIT_L(0); PG8_MMA(0, 0, At, B0); PG8_BAR; PG8_SCHED;
      PG8_LDB(B1, 0, 1); PG8_STAGE(PG8_SB(0, 0), b2, voffB);
      PG8_BAR; PG8_WAIT_L(0); if (!skip1) PG8_MMA(0, 1, At, B1); PG8_BAR;
      PG8_LDA(At, 0, 1); PG8_STAGE(PG8_SA(0, 0), a2, voffA);
      PG8_BAR; PG8_WAIT_L(0); PG8_MMA(1, 0, At, B0); PG8_BAR; PG8_SCHED;
      PG8_STAGE(PG8_SB(0, 1), b2 + hstep, voffB);
      PG8_WAIT_V(6); PG8_BAR; if (!skip1) PG8_MMA(1, 1, At, B1); PG8_BAR;
      PG8_LDB(B0, 1, 0); PG8_SCHED; PG8_LDA(At, 1, 0); PG8_STAGE(PG8_SA(0, 1), a2 + hstep, voffA);
      PG8_WAIT_L(8); PG8_BAR; PG8_WAIT_L(0); PG8_MMA(0, 0, At, B0); PG8_BAR; PG8_SCHED;
      PG8_LDB(B1, 1, 1); PG8_STAGE(PG8_SB(1, 0), b3, voffB);
      PG8_BAR; PG8_WAIT_L(0); if (!skip1) PG8_MMA(0, 1, At, B1); PG8_BAR;
      PG8_LDA(At, 1, 1); PG8_STAGE(PG8_SA(1, 0), a3, voffA);
      PG8_BAR; PG8_WAIT_L(0); PG8_MMA(1, 0, At, B0); PG8_BAR; PG8_SCHED;
      PG8_STAGE(PG8_SB(1, 1), b3 + hstep, voffB);
      PG8_WAIT_V(6); PG8_BAR; if (!skip1) PG8_MMA(1, 1, At, B1); PG8_BAR;
    }
    }
    {
      Unit eu = cur; int ewr = wr, ewc = wc; int el = lane_id();
      asm volatile("" : "+s"(eu.pm), "+s"(eu.pn), "+s"(ewr), "+s"(ewc), "+v"(el));
      int efr = el & 15, efq = el >> 4;
#ifndef REPEPI
#define REPEPI 1
#endif
      for (int re = 0; re < REPEPI; ++re) E(acc, eu, ewr, ewc, efr, efq, re);
    }
    if (!has_next) break;
#pragma unroll
    for (int a = 0; a < 2; ++a)
#pragma unroll
      for (int b = 0; b < 2; ++b)
#pragma unroll
        for (int m = 0; m < 4; ++m)
#pragma unroll
          for (int n = 0; n < 2; ++n) acc[a][b][m][n] = (f32x4){0.f, 0.f, 0.f, 0.f};
    cur = nxt; cA = nA; cB = nB; ++ui;
  }
  PG8_WAIT_V(0);
  if (wr == 0) PG8_BAR;
  PG8_BAR;
#undef PG8_SA
#undef PG8_SB
#undef PG8_STAGE
#undef PG8_LDA
#undef PG8_LDB
#undef PG8_MMA
#undef PG8_WAIT_V
#undef PG8_WAIT_L
#undef PG8_BAR
#undef PG8_SCHED
}
}


DI unsigned hx_w(int row, int c8) { return (unsigned)(row * 256 + ((c8 ^ ((row & 15) << 1)) << 3)); }
DI unsigned hx_r(int row, int c16) { return (unsigned)(row * 256 + ((c16 ^ (row & 15)) << 4)); }
#define EPI_BAR() asm volatile("s_waitcnt lgkmcnt(0)\n\ts_barrier" ::: "memory")


struct Epi1 {
  Params p; LAS unsigned char* hl0;
  DI void load_tabs(f32x4 (&tc)[4], f32x4 (&ts)[4], int tclass, int R0, bool samp, int wc, int fr, int fq) const {
    const float* cb = (tclass == 1) ? p.cosR() : p.cosA();
    const float* sb = (tclass == 1) ? p.sinR() : p.sinA();
    const int pitch = (tclass == 1) ? 64 : 8;
    const int coff = (tclass == 1) ? (16 * wc + 4 * fq) : (4 * (fq & 1));
#pragma unroll
    for (int m = 0; m < 4; ++m) {
      const int rowg = R0 + 16 * m + fr;
      const int pos = samp ? 2048 + ((rowg - NPROMPT) & 63) : (rowg & 2047);
      tc[m] = *(const f32x4*)(cb + pos * pitch + coff);
      ts[m] = *(const f32x4*)(sb + pos * pitch + coff);
    }
  }
  template <int AI, int BJ>
  DI void compute(f32x4 (&acc)[2][2][4][2], const f32x4 (&tc)[4], const f32x4 (&ts)[4], int blk, int wc, int fq) const {
    if (blk < 8) {
#pragma unroll
      for (int m = 0; m < 4; ++m) {
        const f32x4 v0 = acc[AI][BJ][m][0], v1 = acc[AI][BJ][m][1];
        f32x4 o0 = v0 * tc[m] - v1 * ts[m], o1 = v1 * tc[m] + v0 * ts[m];
        if (blk >= 4) { o0 *= 0.08838834764831845f; o1 *= 0.08838834764831845f; }
        acc[AI][BJ][m][0] = o0; acc[AI][BJ][m][1] = o1;
      }
    } else if ((blk >= 12 && blk < 16) || (blk >= 22 && blk < 26)) {
#pragma unroll
      for (int m = 0; m < 4; ++m)
#pragma unroll
        for (int n = 0; n < 2; ++n) {
          f32x4 v = acc[AI][BJ][m][n];
          v[0] = siluf(v[0]); v[1] = siluf(v[1]); v[2] = siluf(v[2]); v[3] = siluf(v[3]);
          acc[AI][BJ][m][n] = v;
        }
    } else if ((blk >= 8 && blk < 12) || blk == 21 || blk == 31) {
    } else {
      const bool ropew = ((wc & 1) == 0) && !(blk == 30 && wc >= 2);
      if (ropew) {
#pragma unroll
        for (int m = 0; m < 4; ++m) {
          const f32x4 v0 = acc[AI][BJ][m][0];
          f32x4 pr;
          pr[0] = __shfl_xor(v0[0], 32); pr[1] = __shfl_xor(v0[1], 32); pr[2] = __shfl_xor(v0[2], 32); pr[3] = __shfl_xor(v0[3], 32);
          acc[AI][BJ][m][0] = (fq < 2) ? v0 * tc[m] - pr * ts[m] : v0 * tc[m] + pr * ts[m];
        }
      }
      if (blk < 20) {
        const float sc = 0.125f * 1.4426950408889634f;
#pragma unroll
        for (int m = 0; m < 4; ++m) { acc[AI][BJ][m][0] *= sc; acc[AI][BJ][m][1] *= sc; }
      }
    }
  }
  template <int AI, int BJ>
  DI void emit(f32x4 (&acc)[2][2][4][2], const pg8::Unit& u, int blk, bool samp, int wr, int wc, int fr, int fq) const {
    if (blk == 31) return;
    LAS unsigned char* hl = hl0 + wr * 16384;
    asm volatile("" : "+v"(fr), "+v"(fq));
    const int lane = fr + 16 * fq;
    const int P0 = 32 * wc + 4 * fq;
    const int R0 = u.pm * 256 + AI * 128 + wr * 64;
    int b, tb;
    if (!samp) { b = R0 >> 11; tb = R0 & 2047; } else { b = (R0 - NPROMPT) >> 6; tb = 0; }
    const bool retk = blk < 8;
    const bool hasT = (blk >= 4 && blk < 12) || blk == 21;
    const bool hasN = !(blk >= 8 && blk < 12) && blk != 21;
    if (blk == 20 || blk == 21) {
      float* ob = samp ? p.out + (blk == 20 ? OUT_KS : OUT_VS) + (unsigned)(R0 - NPROMPT) * 128u : p.out + (blk == 20 ? OUT_KP : OUT_VP) + (unsigned)R0 * 128u;
#pragma unroll
      for (int m = 0; m < 4; ++m) {
        float* o2 = ob + (unsigned)(16 * m + fr) * 128u + P0;
        __builtin_nontemporal_store(acc[AI][BJ][m][0], (f32x4*)o2); __builtin_nontemporal_store(acc[AI][BJ][m][1], (f32x4*)(o2 + 16));
      }
    } else if (blk == 30) {
      float* ob = samp ? p.out + OUT_KIS + (unsigned)(R0 - NPROMPT) * 64u : p.out + OUT_KIP + (unsigned)R0 * 64u;
      float* wb = p.wi() + (unsigned)R0 * 8u;
#pragma unroll
      for (int m = 0; m < 4; ++m) {
        if (wc < 2) {
          float* o2 = ob + (unsigned)(16 * m + fr) * 64u + P0;
          __builtin_nontemporal_store(acc[AI][BJ][m][0], (f32x4*)o2); __builtin_nontemporal_store(acc[AI][BJ][m][1], (f32x4*)(o2 + 16));
        } else if (wc == 2 && fq < 2) {
          *(f32x4*)(wb + (unsigned)(16 * m + fr) * 8u + 4 * fq) = acc[AI][BJ][m][0] * 0.044194173824159216f;
        }
      }
    }
    if (hasN) {
#pragma unroll
      for (int m = 0; m < 4; ++m)
#pragma unroll
        for (int n = 0; n < 2; ++n) {
          const int c8 = retk ? (16 * n + 4 * wc + fq) : (8 * wc + 4 * n + fq);
          *(LAS s16x4*)(hl + hx_w(16 * m + fr, c8)) = pack4(acc[AI][BJ][m][n]);
        }
      u16* nb; unsigned pitch = 512u, hstr = 0u, cm = 15u;
      if (blk < 4) nb = p.qr() + (unsigned)R0 * 512u + (blk & 3) * 128;
      else if (blk < 8) nb = p.kr() + (unsigned)R0 * 512u + (blk & 3) * 128;
      else if (blk < 16) { nb = p.gate() + (unsigned)R0 * 1024u + (blk - 12) * 128; pitch = 1024u; }
      else if (blk < 20) nb = p.qa() + (unsigned)R0 * 512u + (blk - 16) * 128;
      else if (blk == 20) { nb = samp ? p.kaS() + ((unsigned)(b * 2) * 2112u + 2048u) * 64u : p.kaP() + ((unsigned)(b * 2) * 2048u + tb) * 64u; pitch = 64u; hstr = samp ? 2112u * 64u : 2048u * 64u; cm = 7u; }
      else if (blk < 26) { nb = p.gate() + (unsigned)R0 * 1024u + 512 + (blk - 22) * 128; pitch = 1024u; }
      else if (blk < 30) nb = p.qi() + (unsigned)R0 * 512u + (blk - 26) * 128;
      else { nb = samp ? p.kiS() + ((unsigned)b * 2112u + 2048u) * 64u : p.kiP() + ((unsigned)b * 2048u + tb) * 64u; pitch = 64u; cm = 7u; }
      EPI_BAR();
      const unsigned c16 = lane & 15;
      const unsigned loff = (c16 >> 3) * hstr + (c16 & cm) * 8u;
#pragma unroll
      for (int i = 0; i < 4; ++i) {
        const int row = 16 * wc + 4 * i + (lane >> 4);
        const bf16x8 v = *(const LAS bf16x8*)(hl + hx_r(row, c16));
        if (blk != 30 || c16 < 8) *(bf16x8*)(nb + (unsigned)row * pitch + loff) = v;
      }
      EPI_BAR();
    }
    if (hasT) {
      const float l2g = log2gamma(blk & 3);
#pragma unroll
      for (int m = 0; m < 4; ++m) {
        const int tok = 16 * m + fr;
        const float dec = (blk < 8) ? exp2f((float)(63 - tok) * l2g) : 1.f;
#pragma unroll
        for (int n = 0; n < 2; ++n) {
          const int fb = retk ? (64 * n + 16 * wc + 4 * fq) : (32 * wc + 16 * n + 4 * fq);
#pragma unroll
          for (int j = 0; j < 4; ++j) {
            const int f = fb + j;
            *(LAS u16*)(hl + f * 128 + ((((tok >> 3) ^ (f >> 2)) & 7) << 4) + (tok & 7) * 2) = f2bf(acc[AI][BJ][m][n][j] * dec);
          }
        }
      }
      u16* tbp; unsigned fstr;
      if (blk < 12) {
        u16* base = (blk < 8) ? p.krT() : p.vrT();
        const unsigned bh = (unsigned)(b * 4 + (blk & 3)) * 128u;
        tbp = samp ? base + 64u * 128u * 2048u + bh * 64u : base + bh * 2048u + tb;
        fstr = samp ? 64u : 2048u;
      } else {
        tbp = samp ? p.vaTS() + (unsigned)b * 128u * 2112u + 2048u : p.vaTP() + (unsigned)b * 128u * 2048u + tb;
        fstr = samp ? 2112u : 2048u;
      }
      EPI_BAR();
#pragma unroll
      for (int i = 0; i < 4; ++i) {
        const int f = 32 * wc + 8 * i + (lane >> 3), ch = lane & 7;
        const bf16x8 v = *(const LAS bf16x8*)(hl + f * 128 + (((ch ^ (f >> 2)) & 7) << 4));
        *(bf16x8*)(tbp + (unsigned)f * fstr + ch * 8) = v;
      }
      EPI_BAR();
    }
  }
  DI void operator()(f32x4 (&acc)[2][2][4][2], const pg8::Unit& u, int wr, int wc, int fr, int fq, int re) const {
    const bool samp = (u.pm * 256 >= NPROMPT);
    const int tclass = (u.pn < 4) ? 1 : ((u.pn == 8 || u.pn == 9 || u.pn == 10 || u.pn >= 13) ? 2 : 0);
    const int blk0 = u.pn * 2, blk1 = u.pn * 2 + 1;
    float rvv[2][4];
#pragma unroll
    for (int ai = 0; ai < 2; ++ai)
#pragma unroll
      for (int m = 0; m < 4; ++m) rvv[ai][m] = (1.f / REPK) * p.rinv()[u.pm * 256 + ai * 128 + wr * 64 + 16 * m + fr];
    f32x4 tc[4], ts[4];
    load_tabs(tc, ts, tclass, u.pm * 256 + wr * 64, samp, wc, fr, fq);
#pragma unroll
    for (int ai = 0; ai < 2; ++ai)
#pragma unroll
      for (int m = 0; m < 4; ++m)
#pragma unroll
        for (int bj = 0; bj < 2; ++bj)
#pragma unroll
          for (int n = 0; n < 2; ++n) acc[ai][bj][m][n] *= rvv[ai][m];
    compute<0, 0>(acc, tc, ts, blk0, wc, fq);
    compute<0, 1>(acc, tc, ts, blk1, wc, fq);
    load_tabs(tc, ts, tclass, u.pm * 256 + 128 + wr * 64, samp, wc, fr, fq);
    compute<1, 0>(acc, tc, ts, blk0, wc, fq);
    compute<1, 1>(acc, tc, ts, blk1, wc, fq);
    emit<0, 0>(acc, u, blk0, samp, wr, wc, fr, fq);
    emit<0, 1>(acc, u, blk1, samp, wr, wc, fr, fq);
    emit<1, 0>(acc, u, blk0, samp, wr, wc, fr, fq);
    emit<1, 1>(acc, u, blk1, samp, wr, wc, fr, fq);
  }
};

struct Epi2 {
  Params p; unsigned char* hl;
  DI void operator()(f32x4 (&acc)[2][2][4][2], const pg8::Unit& u, int wr, int wc, int fr, int fq, int re) const {
    u16* z = p.gate();
    const int lane = fr + 16 * fq;
#pragma unroll
    for (int ai = 0; ai < 2; ++ai)
#pragma unroll
      for (int bj = 0; bj < 2; ++bj) {
#pragma unroll
        for (int m = 0; m < 4; ++m)
#pragma unroll
          for (int n = 0; n < 2; ++n)
            *(s16x4*)(hl + hx_w(16 * m + fr, 8 * wc + 4 * n + fq)) = pack4(acc[ai][bj][m][n] * (1.f / REPK));
        EPI_BAR();
        const unsigned R0 = u.pm * 256 + ai * 128 + wr * 64;
        const unsigned cb = u.pn * 256 + bj * 128;
#pragma unroll
        for (int i = 0; i < 4; ++i) {
          const int row = 16 * wc + 4 * i + (lane >> 4), c16 = lane & 15;
          const bf16x8 v = *(const bf16x8*)(hl + hx_r(row, c16));
          *(bf16x8*)(z + (R0 + row) * 1024u + cb + c16 * 8) = v;
        }
        EPI_BAR();
      }
  }
};

DI void ret_kv_item(const Params& p, int item, int tid) {
  const int lane = tid & 63, w = tid >> 6, r = lane & 31, hh = lane >> 5;
  const u16 *kT, *vT; int T, c;
  if (item < 2048) { const int bh = item >> 5; c = item & 31; T = 2048; kT = p.krT() + (size_t)bh * 128 * 2048; vT = p.vrT() + (size_t)bh * 128 * 2048; }
  else { const int bh = item - 2048; c = 0; T = 64; kT = p.krT() + (size_t)64 * 128 * 2048 + (size_t)bh * 128 * 64; vT = p.vrT() + (size_t)64 * 128 * 2048 + (size_t)bh * 128 * 64; }
  const int e0 = (w & 1) * 64, d0 = (w >> 1) * 64;
  f32x16 acc[2][2];
  acc[0][0] = zero16(); acc[0][1] = zero16(); acc[1][0] = zero16(); acc[1][1] = zero16();
#pragma unroll
  for (int ks = 0; ks < 4; ++ks) {
    bf16x8 a0 = ldg8(vT + (size_t)(e0 + r) * T + c * 64 + ks * 16 + hh * 8);
    bf16x8 a1 = ldg8(vT + (size_t)(e0 + 32 + r) * T + c * 64 + ks * 16 + hh * 8);
    bf16x8 b0 = ldg8(kT + (size_t)(d0 + r) * T + c * 64 + ks * 16 + hh * 8);
    bf16x8 b1 = ldg8(kT + (size_t)(d0 + 32 + r) * T + c * 64 + ks * 16 + hh * 8);
    acc[0][0] = MFMA32(a0, b0, acc[0][0]);
    acc[0][1] = MFMA32(a0, b1, acc[0][1]);
    acc[1][0] = MFMA32(a1, b0, acc[1][0]);
    acc[1][1] = MFMA32(a1, b1, acc[1][1]);
  }
  u16* o = (u16*)p.kvT() + (size_t)item * 16384;
#pragma unroll
  for (int a = 0; a < 2; ++a)
#pragma unroll
    for (int b = 0; b < 2; ++b)
#pragma unroll
      for (int i = 0; i < 16; ++i)
        o[(e0 + a * 32 + crow(i, hh)) * 128 + d0 + b * 32 + r] = f2bf(acc[a][b][i]);
}

template <int NS>
DI void select_query(const u16* krow, int nj, int lane, u64* dst) {
  unsigned key[NS];
#pragma unroll
  for (int j = 0; j < NS; ++j) { const unsigned k = krow[j * 64 + lane]; key[j] = (j < nj) ? k : 0u; }
  constexpr int NP = (NS + 1) / 2;
  unsigned pk[NP];
#pragma unroll
  for (int i = 0; i < NP; ++i) pk[i] = key[2 * i] | ((2 * i + 1 < NS ? key[2 * i + 1] : 0u) << 16);
  unsigned prefix = 0;
  int cntp = 0;
  const unsigned ones = 0x00010001u;
  for (int bit = 15; bit >= 0; --bit) {
    const unsigned cand = prefix | (1u << bit);
    const unsigned c1 = cand - 1u;
    const unsigned cv = c1 | (c1 << 16);
    unsigned acc0 = 0, acc1 = 0;
#pragma unroll
    for (int i = 0; i < NP; ++i) {
      unsigned d, m;
      asm("v_pk_sub_u16 %0, %1, %2 clamp" : "=v"(d) : "v"(pk[i]), "v"(cv));
      asm("v_pk_min_u16 %0, %1, %2" : "=v"(m) : "v"(d), "v"(ones));
      if (i & 1) acc1 += m; else acc0 += m;
    }
    const unsigned a = acc0 + acc1;
    const int cnt = wave_sum((int)((a & 0xffffu) + (a >> 16)));
    if (cnt >= 256) { prefix = cand; cntp = cnt; }
    if (cnt == 256) break;
  }
  int wlo = 0, whi = 0;
  if (cntp == 256) {
#pragma unroll
    for (int j = 0; j < NS; ++j) {
      const u64 sm = __ballot(key[j] >= prefix);
      if (lane == j) { wlo = (int)(unsigned)sm; whi = (int)(unsigned)(sm >> 32); }
    }
  } else {
    int cgt = 0;
#pragma unroll
    for (int j = 0; j < NS; ++j) cgt += (key[j] > prefix) ? 1 : 0;
    cgt = wave_sum(cgt);
    const int rneed = 256 - cgt;
    int running = 0;
    const u64 lt = (1ull << lane) - 1ull;
#pragma unroll
    for (int j = 0; j < NS; ++j) {
      const bool eq = key[j] == prefix;
      const u64 em = __ballot(eq);
      const int rank = running + __popcll(em & lt);
      const bool sel = (key[j] > prefix) || (eq && rank < rneed);
      const u64 sm = __ballot(sel);
      if (lane == j) { wlo = (int)(unsigned)sm; whi = (int)(unsigned)(sm >> 32); }
      running += __popcll(em);
    }
  }
  if (lane < nj) dst[lane] = ((u64)(unsigned)whi << 32) | (u64)(unsigned)wlo;
}

DI void idx_item(const Params& p, unsigned char* lds, int tid, bool samp, int b, int grp) {
  const int lane = tid & 63, w = tid >> 6;
  const int t0 = grp * 16;
  int L, g0; const u16* ki;
  if (!samp) { const int c = t0 >> 6; L = (c + 1) * 64; g0 = b * 2048 + t0; ki = p.kiP() + (size_t)b * 2048 * 64; }
  else { L = 2112; g0 = NPROMPT + b * 64 + t0; ki = p.kiS() + (size_t)b * 2112 * 64; }
  const int nj = L >> 6;
  if (L <= 256) {
    for (int qq = 0; qq < 4; ++qq) {
      const int q = w * 4 + qq;
      if (lane < nj) p.maskbits()[(size_t)(g0 + q) * 33 + lane] = ~0ull;
    }
    return;
  }
  u16* keys = (u16*)lds;
#ifndef REPMF
#define REPMF 1
#endif
#ifndef REPSEL
#define REPSEL 1
#endif
#ifndef REPKV
#define REPKV 1
#endif
  for (int rmf = 0; rmf < REPMF; ++rmf) {
    const int qn = lane & 15, quad = lane >> 4;
    bf16x8 qf[8][2];
    float wv[8];
#pragma unroll
    for (int h = 0; h < 8; ++h) {
      qf[h][0] = ldg8(p.qi() + (size_t)(g0 + qn) * 512 + h * 64 + quad * 8);
      qf[h][1] = ldg8(p.qi() + (size_t)(g0 + qn) * 512 + h * 64 + 32 + quad * 8);
      wv[h] = p.wi()[(size_t)(g0 + qn) * 8 + h];
    }
    bf16x8 A0[4], A1[4], N0[4], N1[4];
#pragma unroll
    for (int i = 0; i < 4; ++i) {
      const int kt = w + 4 * i;
      A0[i] = ldg8(ki + (size_t)(kt * 16 + qn) * 64 + quad * 8);
      A1[i] = ldg8(ki + (size_t)(kt * 16 + qn) * 64 + 32 + quad * 8);
    }
    for (int base = 0; base < nj; base += 4) {
#pragma unroll
      for (int i = 0; i < 4; ++i) {
        const int t = min(base + 4 + i, nj - 1);
        const int kt = w + 4 * t;
        N0[i] = ldg8(ki + (size_t)(kt * 16 + qn) * 64 + quad * 8);
        N1[i] = ldg8(ki + (size_t)(kt * 16 + qn) * 64 + 32 + quad * 8);
      }
#pragma unroll
      for (int i = 0; i < 4; ++i) {
        const int t = base + i;
        if (t < nj) {
          const int kt = w + 4 * t;
          float idx[4] = {0.f, 0.f, 0.f, 0.f};
#pragma unroll
          for (int h = 0; h < 8; ++h) {
            f32x4 acc = {0.f, 0.f, 0.f, 0.f};
            acc = MFMA16(A0[i], qf[h][0], acc);
            acc = MFMA16(A1[i], qf[h][1], acc);
#pragma unroll
            for (int e = 0; e < 4; ++e) idx[e] += fmaxf(acc[e], 0.f) * wv[h];
          }
          s16x4 kv;
#pragma unroll
          for (int e = 0; e < 4; ++e) {
            _Float16 hv = (_Float16)idx[e];
            u16 bits = __builtin_bit_cast(u16, hv);
            kv[e] = (short)((bits & 0x8000) ? (u16)~bits : (u16)(bits | 0x8000));
          }
          *(s16x4*)(keys + qn * KPITCH + kt * 16 + quad * 4) = kv;
        }
      }
#pragma unroll
      for (int i = 0; i < 4; ++i) { A0[i] = N0[i]; A1[i] = N1[i]; }
    }
  }
  __syncthreads();
  for (int qq = 0; qq < 4 * REPSEL; ++qq) {
    const int q = w * 4 + (qq & 3);
    const u16* krow = keys + q * KPITCH;
    u64* dst = p.maskbits() + (size_t)(g0 + q) * 33;
    if (nj <= 8) select_query<8>(krow, nj, lane, dst);
    else if (nj <= 16) select_query<16>(krow, nj, lane, dst);
    else if (nj <= 24) select_query<24>(krow, nj, lane, dst);
    else select_query<33>(krow, nj, lane, dst);
  }
  __syncthreads();
}

DI void scan_item(const Params& p, int item, int tid) {
  if (item < 1024) {
    const int bh = item >> 4, slab = item & 15;
    const int idx = slab * 1024 + tid * 4;
    const int h = bh & 3;
    const float cd = exp2f(64.f * log2gamma(h));
    f32x4 s = {0.f, 0.f, 0.f, 0.f};
    for (int c0 = 0; c0 < 32; c0 += 8) {
      f32x4 kvb[8];
#pragma unroll
      for (int i = 0; i < 8; ++i) {
        const s16x4 kk = *(const s16x4*)((const u16*)p.kvT() + (size_t)(bh * 32 + c0 + i) * 16384 + idx);
#pragma unroll
        for (int j = 0; j < 4; ++j) kvb[i][j] = __uint_as_float(((unsigned)(u16)kk[j]) << 16);
      }
#pragma unroll
      for (int i = 0; i < 8; ++i) {
        *(s16x4*)(p.sprevT() + (size_t)(bh * 32 + c0 + i) * 16384 + idx) = pack4(s);
        s = s * cd + kvb[i];
      }
    }
    const int e = idx >> 7, d = idx & 127;
    float* o = p.out + OUT_STP + (size_t)bh * 16384;
#pragma unroll
    for (int j = 0; j < 4; ++j) o[(d + j) * 128 + e] = s[j];
  } else {
    const int it = item - 1024;
    const int bh = it >> 4, slab = it & 15;
    const int idx = slab * 1024 + tid * 4;
    const int h = bh & 3;
    const float cd = exp2f(64.f * log2gamma(h));
    const int e = idx >> 7, d = idx & 127;
    const float* s0 = p.state_ret + (size_t)bh * 16384;
    f32x4 s;
#pragma unroll
    for (int j = 0; j < 4; ++j) s[j] = s0[(d + j) * 128 + e];
    const size_t base = (size_t)(2048 + bh) * 16384 + idx;
    s16x4 o = pack4(s);
    *(s16x4*)(p.sprevT() + base) = o;
    const s16x4 kk = *(const s16x4*)((const u16*)p.kvT() + base);
    f32x4 kv;
#pragma unroll
    for (int j = 0; j < 4; ++j) kv[j] = __uint_as_float(((unsigned)(u16)kk[j]) << 16);
    s = s * cd + kv;
    float* oo = p.out + OUT_STS + (size_t)bh * 16384;
#pragma unroll
    for (int j = 0; j < 4; ++j) oo[(d + j) * 128 + e] = s[j];
  }
}

DI void attn_item(const Params& p, unsigned char* lds, int tid, bool samp, int b, int c, int kvh, int qh, unsigned char* lds_blk, int tid512) {
  const int lane = tid & 63, w = tid >> 6, r = lane & 31, hh = lane >> 5;
  const int T = samp ? 2112 : 2048;
  const int nkt = samp ? 33 : c + 1;
  const int g0 = (samp ? NPROMPT + b * 64 : b * 2048 + c * 64) + qh * 32;
  const u16* K = samp ? p.kaS() + (size_t)(b * 2 + kvh) * 2112 * 64 : p.kaP() + (size_t)(b * 2 + kvh) * 2048 * 64;
  const u16* VT = samp ? p.vaTS() + (size_t)(b * 2 + kvh) * 64 * 2112 : p.vaTP() + (size_t)(b * 2 + kvh) * 64 * 2048;
  const int head = kvh * 4 + w;
  u16* KV0 = (u16*)(lds_blk + 2 * HALF_LDS - 4 * 9216);
  u64* mL = (u64*)lds;
  {
    u64 mv[5];
#pragma unroll
    for (int i = 0; i < 5; ++i) { const int ix = tid + 256 * i; mv[i] = p.maskbits()[(size_t)g0 * 33 + (ix < 32 * 33 ? ix : 32 * 33 - 1)]; }
#pragma unroll
    for (int i = 0; i < 5; ++i) { const int ix = tid + 256 * i; if (ix < 32 * 33) mL[ix] = mv[i]; }
  }
  bf16x8 qf[4];
#pragma unroll
  for (int ks = 0; ks < 4; ++ks) qf[ks] = ldg8(p.qa() + (size_t)(g0 + r) * 512 + head * 64 + ks * 16 + hh * 8);
  f32x16 O[2];
  O[0] = zero16(); O[1] = zero16();
  float mrun = -1e30f, lrun = 0.f;
  const int lrow = tid512 >> 3, lch = tid512 & 7;
  const int loff = lrow * 72 + lch * 8;
  bf16x8 pk0, pv0, nk0, nv0;
  {
    const bf16x8 k0 = ldg8(K + (size_t)(lrow)*64 + lch * 8), v0 = ldg8(VT + (size_t)(lrow)*T + lch * 8);
    const int t1 = nkt > 1 ? 1 : 0, t2 = nkt > 2 ? 2 : (nkt - 1);
    pk0 = ldg8(K + (size_t)(t1 * 64 + lrow) * 64 + lch * 8); pv0 = ldg8(VT + (size_t)(lrow)*T + t1 * 64 + lch * 8);
    nk0 = ldg8(K + (size_t)(t2 * 64 + lrow) * 64 + lch * 8); nv0 = ldg8(VT + (size_t)(lrow)*T + t2 * 64 + lch * 8);
    *(bf16x8*)(KV0 + loff) = k0;
    *(bf16x8*)(KV0 + 64 * 72 + loff) = v0;
  }
  __syncthreads();
  for (int kt = 0; kt < nkt; ++kt) {
    if (kt + 1 < nkt) {
      u16* nb = KV0 + ((kt + 1) & 1) * (2 * 64 * 72);
      *(bf16x8*)(nb + loff) = pk0;
      *(bf16x8*)(nb + 64 * 72 + loff) = pv0;
    }
    pk0 = nk0; pv0 = nv0;
    {
      const int t3 = (kt + 3 < nkt) ? kt + 3 : nkt - 1;
      nk0 = ldg8(K + (size_t)(t3 * 64 + lrow) * 64 + lch * 8);
      nv0 = ldg8(VT + (size_t)(lrow)*T + t3 * 64 + lch * 8);
    }
    const u16* Ks = KV0 + (kt & 1) * (2 * 64 * 72);
    const u16* Vs = Ks + 64 * 72;
    f32x16 S[2];
#pragma unroll
    for (int st = 0; st < 2; ++st) {
      S[st] = zero16();
#pragma unroll
      for (int ks = 0; ks < 4; ++ks) {
        bf16x8 kf = *(const bf16x8*)(Ks + (st * 32 + r) * 72 + ks * 16 + hh * 8);
        S[st] = MFMA32(kf, qf[ks], S[st]);
      }
    }
    const u64 W = mL[r * 33 + kt];
    const int wl = (int)(((unsigned)W) >> (4 * hh)), wh = (int)(((unsigned)(W >> 32)) >> (4 * hh));
    float mx = fmaxf(S[0][0], S[1][0]);
#pragma unroll
    for (int i = 1; i < 16; ++i) mx = fmaxf(mx, fmaxf(S[0][i], S[1][i]));
    mx = fmaxf(mx, __shfl_xor(mx, 32));
    const float mn = fmaxf(mrun, mx);
    const float alpha = __builtin_amdgcn_exp2f(mrun - mn);
    const bool resc = __any(mn != mrun);
    mrun = mn;
    float ls = 0.f;
#pragma unroll
    for (int st = 0; st < 2; ++st)
#pragma unroll
      for (int i = 0; i < 16; ++i) {
        const int keep = __builtin_amdgcn_sbfe(st ? wh : wl, (i & 3) + 8 * (i >> 2), 1);
        const float pvv = __int_as_float(__float_as_int(__builtin_amdgcn_exp2f(S[st][i] - mn)) & keep);
        S[st][i] = pvv;
        ls += pvv;
      }
    lrun = lrun * alpha + ls;
    if (resc) {
#pragma unroll
      for (int dt = 0; dt < 2; ++dt)
#pragma unroll
        for (int i = 0; i < 16; ++i) O[dt][i] *= alpha;
    }
#pragma unroll
    for (int st = 0; st < 2; ++st)
#pragma unroll
      for (int s2 = 0; s2 < 2; ++s2) {
        bf16x8 pf = pack8(S[st][8 * s2 + 0], S[st][8 * s2 + 1], S[st][8 * s2 + 2], S[st][8 * s2 + 3],
                          S[st][8 * s2 + 4], S[st][8 * s2 + 5], S[st][8 * s2 + 6], S[st][8 * s2 + 7]);
#pragma unroll
        for (int dt = 0; dt < 2; ++dt) {
          s16x4 lo = *(const s16x4*)(Vs + (dt * 32 + r) * 72 + st * 32 + 16 * s2 + 4 * hh);
          s16x4 hi = *(const s16x4*)(Vs + (dt * 32 + r) * 72 + st * 32 + 16 * s2 + 8 + 4 * hh);
          bf16x8 vf = __builtin_shufflevector(lo, hi, 0, 1, 2, 3, 4, 5, 6, 7);
          O[dt] = MFMA32(vf, pf, O[dt]);
        }
      }
    __syncthreads();
  }
  {
    float lt = lrun + __shfl_xor(lrun, 32);
    const float inv = 1.f / fmaxf(lt, 1e-30f);
    const u16* grow = p.gate() + (size_t)(g0 + r) * 1024 + 512 + head * 64;
    u16* mrow = p.mix() + (size_t)(g0 + r) * 1024 + 512 + head * 64;
    s16x4 gvv[2][4];
#pragma unroll
    for (int dt = 0; dt < 2; ++dt)
#pragma unroll
      for (int q4 = 0; q4 < 4; ++q4) gvv[dt][q4] = *(const s16x4*)(grow + dt * 32 + 8 * q4 + 4 * hh);
#pragma unroll
    for (int dt = 0; dt < 2; ++dt)
#pragma unroll
      for (int q4 = 0; q4 < 4; ++q4) {
        const int d = dt * 32 + 8 * q4 + 4 * hh;
        f32x4 of;
#pragma unroll
        for (int j = 0; j < 4; ++j) {
          const float gf = __uint_as_float(((unsigned)(u16)gvv[dt][q4][j]) << 16);
          of[j] = O[dt][q4 * 4 + j] * inv * gf;
        }
        *(s16x4*)(mrow + d) = pack4(of);
      }
  }
  __syncthreads();
}

DI void ret_out_item(const Params& p, unsigned char* lds, int item, int tid) {
  const int lane = tid & 63, w = tid >> 6, r = lane & 31, hh = lane >> 5;
  int bh, c, T, g0; const u16* vT;
  if (item < 2048) { bh = item >> 5; c = item & 31; T = 2048; g0 = (bh >> 2) * 2048 + c * 64; vT = p.vrT() + (size_t)bh * 128 * 2048; }
  else { bh = item - 2048; c = 0; T = 64; g0 = NPROMPT + (bh >> 2) * 64; vT = p.vrT() + (size_t)64 * 128 * 2048 + (size_t)bh * 128 * 64; }
  const int h = bh & 3;
  const float l2g = log2gamma(h);
  const int nt = w & 1, eh = w >> 1;
  const int n = nt * 32 + r;
  bf16x8 qf[8], kf[8];
#pragma unroll
  for (int ks = 0; ks < 8; ++ks) qf[ks] = ldg8(p.qr() + (size_t)(g0 + n) * 512 + h * 128 + ks * 16 + hh * 8);
#pragma unroll
  for (int ks = 0; ks < 8; ++ks) kf[ks] = ldg8(p.kr() + (size_t)(g0 + r) * 512 + h * 128 + ks * 16 + hh * 8);
  __builtin_amdgcn_sched_barrier(0);
  bf16x8 pf[2][2];
#pragma unroll
  for (int mt = 0; mt < 2; ++mt) {
    f32x16 S = zero16();
#pragma unroll
    for (int ks = 0; ks < 8; ++ks) S = MFMA32(kf[ks], qf[ks], S);
    if (mt == 0) {
#pragma unroll
      for (int ks = 0; ks < 8; ++ks) kf[ks] = ldg8(p.kr() + (size_t)(g0 + 32 + r) * 512 + h * 128 + ks * 16 + hh * 8);
      __builtin_amdgcn_sched_barrier(0);
    }
#pragma unroll
    for (int i = 0; i < 16; ++i) {
      const int m = mt * 32 + crow(i, hh);
      const int dd = n > m ? n - m : m - n;
      S[i] *= exp2f((float)dd * l2g);
    }
    pf[mt][0] = pack8(S[0], S[1], S[2], S[3], S[4], S[5], S[6], S[7]);
    pf[mt][1] = pack8(S[8], S[9], S[10], S[11], S[12], S[13], S[14], S[15]);
  }
  const float fs = exp2f((float)(n + 1) * l2g);
  const u16* sp = p.sprevT() + (size_t)item * 16384;
  f32x16 tot[2];
  float ss = 0.f;
  s16x4 vlo[2][2][2], vhi[2][2][2];
#pragma unroll
  for (int et = 0; et < 2; ++et)
#pragma unroll
    for (int mt = 0; mt < 2; ++mt)
#pragma unroll
      for (int s2 = 0; s2 < 2; ++s2) {
        const u16* vp = vT + (size_t)((2 * eh + et) * 32 + r) * T + c * 64 + mt * 32 + 16 * s2 + 4 * hh;
        vlo[et][mt][s2] = ldg4(vp); vhi[et][mt][s2] = ldg4(vp + 8);
      }
  __builtin_amdgcn_sched_barrier(0);
#pragma unroll
  for (int et = 0; et < 2; ++et) {
    const int e = (2 * eh + et) * 32 + r;
    bf16x8 sf[8];
#pragma unroll
    for (int ks = 0; ks < 8; ++ks) sf[ks] = ldg8(sp + (size_t)e * 128 + ks * 16 + hh * 8);
    __builtin_amdgcn_sched_barrier(0);
    f32x16 Oi = zero16(), X = zero16();
#pragma unroll
    for (int mt = 0; mt < 2; ++mt)
#pragma unroll
      for (int s2 = 0; s2 < 2; ++s2) {
        bf16x8 vf = __builtin_shufflevector(vlo[et][mt][s2], vhi[et][mt][s2], 0, 1, 2, 3, 4, 5, 6, 7);
        Oi = MFMA32(vf, pf[mt][s2], Oi);
      }
#pragma unroll
    for (int ks = 0; ks < 8; ++ks) X = MFMA32(sf[ks], qf[ks], X);
#pragma unroll
    for (int i = 0; i < 16; ++i) { const float t = Oi[i] + X[i] * fs; tot[et][i] = t; ss += t * t; }
  }
  ss += __shfl_xor(ss, 32);
  float* red = (float*)lds;
  __syncthreads();
  if (hh == 0) red[w * 32 + r] = ss;
  __syncthreads();
  const float tsum = red[w * 32 + r] + red[(w ^ 2) * 32 + r];
  const float rinv = rsqrtf(tsum * (1.f / 128.f) + 1e-6f);
  const u16* grow = p.gate() + (size_t)(g0 + n) * 1024 + h * 128;
  u16* mrow = p.mix() + (size_t)(g0 + n) * 1024 + h * 128;
  s16x4 gvv[2][4];
  f32x4 ggv[2][4];
#pragma unroll
  for (int et = 0; et < 2; ++et)
#pragma unroll
    for (int q4 = 0; q4 < 4; ++q4) {
      const int e = (2 * eh + et) * 32 + 8 * q4 + 4 * hh;
      gvv[et][q4] = *(const s16x4*)(grow + e);
      ggv[et][q4] = *(const f32x4*)(p.ret_gn_g + h * 128 + e);
    }
#pragma unroll
  for (int et = 0; et < 2; ++et)
#pragma unroll
    for (int q4 = 0; q4 < 4; ++q4) {
      const int e = (2 * eh + et) * 32 + 8 * q4 + 4 * hh;
      f32x4 of;
#pragma unroll
      for (int j = 0; j < 4; ++j) {
        const float gf = __uint_as_float(((unsigned)(u16)gvv[et][q4][j]) << 16);
        of[j] = tot[et][q4 * 4 + j] * rinv * ggv[et][q4][j] * gf;
      }
      *(s16x4*)(mrow + e) = pack4(of);
    }
}

DI void phase_final(const Params& p, int tid) {
  const int gt = blockIdx.x * 512 + tid, GT = gridDim.x * 512;
  const int lane = tid & 63;
  for (int row0 = (gt >> 6) * 2; row0 < NTOK; row0 += (GT >> 6) * 2) {
    f32x4 v[2][4];
    s16x4 zz[2][4];
#pragma unroll
    for (int rr = 0; rr < 2; ++rr) {
      const float* xr = xrow(p, row0 + rr);
      const u16* zr = p.gate() + (size_t)(row0 + rr) * 1024;
#pragma unroll
      for (int i = 0; i < 4; ++i) { v[rr][i] = __builtin_nontemporal_load((const f32x4*)(xr + i * 256 + lane * 4)); zz[rr][i] = __builtin_nontemporal_load((const s16x4*)(zr + i * 256 + lane * 4)); }
    }
    f32x4 g[4];
#pragma unroll
    for (int i = 0; i < 4; ++i) g[i] = *(const f32x4*)(p.final_g + i * 256 + lane * 4);
#pragma unroll
    for (int rr = 0; rr < 2; ++rr) {
      float ss = 0.f;
#pragma unroll
      for (int i = 0; i < 4; ++i) {
#pragma unroll
        for (int j = 0; j < 4; ++j) v[rr][i][j] += __uint_as_float(((unsigned)(u16)zz[rr][i][j]) << 16);
        ss += v[rr][i][0] * v[rr][i][0] + v[rr][i][1] * v[rr][i][1] + v[rr][i][2] * v[rr][i][2] + v[rr][i][3] * v[rr][i][3];
      }
#pragma unroll
      for (int o = 32; o >= 1; o >>= 1) ss += __shfl_xor(ss, o);
      const float rv = rsqrtf(ss * (1.f / 1024.f) + 1e-6f);
      float* y = p.out + OUT_Y + (size_t)(row0 + rr) * 1024;
#pragma unroll
      for (int i = 0; i < 4; ++i) __builtin_nontemporal_store(v[rr][i] * rv * g[i], (f32x4*)(y + i * 256 + lane * 4));
    }
  }
}

#ifndef REP0
#define REP0 1
#endif
#ifndef REP1
#define REP1 1
#endif
#ifndef REP2
#define REP2 1
#endif
#ifndef REP3
#define REP3 1
#endif
#ifndef REP4
#define REP4 1
#endif
#ifndef REP5
#define REP5 1
#endif
__global__ void __launch_bounds__(512, 2) fwd_megakernel(Params p) {
  __shared__ __attribute__((aligned(16))) unsigned char lds[LDS_BYTES];
  cg::grid_group grid = cg::this_grid();
  const int wave_id = __builtin_amdgcn_readfirstlane((int)threadIdx.x >> 6);
#define FRESH_TID() int tid = wave_id * 64 + lane_id(); asm volatile("" : "+v"(tid)); const int half = tid >> 8, htid = tid & 255; unsigned char* ldsh = lds + half * HALF_LDS; (void)htid; (void)ldsh;
  if (p.out == nullptr) grid.sync();
  if (wave_id == 0 && lane_id() == 0) (void)xb_add(&p.bar()[XB_XCNT(xb_xcc_id())], 1u);
  for (int rep = 0; rep < REP0; ++rep) {
  { FRESH_TID(); phase_prep(p, tid); }
  xcd_barrier(p.bar(), wave_id);
  }
  for (int rep = 0; rep < REP1; ++rep) {
  {
    FRESH_TID();
    pg8::Gemm g; g.A = p.xb(); g.Bt = p.WtIn(); g.M = NTOK; g.N = 4096; g.K = 1024;
    pg8::StaticOrder S; S.init(g.M, g.N, (int)gridDim.x, (int)blockIdx.x); S.permtab = 0xEFBCD87694105A32ull; S.padtile = 15;
    Epi1 E; E.p = p; E.hl0 = (LAS unsigned char*)lds + pg8::STAGE_BYTES;
    pg8::gemm_phase<Epi1>((LAS unsigned char*)lds, g, S, E, wave_id);
  }
  xcd_barrier(p.bar(), wave_id);
  }
  for (int rep = 0; rep < REP2; ++rep) {
  {
    FRESH_TID();
    for (int it0 = blockIdx.x * 2; it0 < 2080 + 2080; it0 += gridDim.x * 2) {
      const int it = it0 + half;
      int ht = htid; asm volatile("" : "+v"(ht));
      if (it < 2080) {
        const bool samp = it < 32;
        const int j = it - 32;
        const int c = 31 - (j >> 6);
        const int b = samp ? (it >> 2) : ((j & 63) >> 2);
        const int grp = samp ? (it & 3) : (c * 4 + (j & 3));
        idx_item(p, ldsh, ht, samp, b, grp);
      } else { for (int rkv = 0; rkv < REPKV; ++rkv) ret_kv_item(p, it - 2080, ht); }
    }
  }
  xcd_barrier(p.bar(), wave_id);
  }
  for (int rep = 0; rep < REP3; ++rep) {
  {
    FRESH_TID();
    for (int it0 = blockIdx.x * 2; it0 < 1056 + 1536; it0 += gridDim.x * 2) {
      const int it = it0 + half;
      int ht = htid; asm volatile("" : "+v"(ht));
      if (it < 1056) {
        const bool samp = it < 32;
        const int j = it - 32;
        int c = samp ? 0 : 31 - (j >> 6);
        int b = samp ? (it >> 2) : ((j & 63) >> 2);
        int kvh = (it >> 1) & 1;
        if (!samp && gridDim.x == 256) {
          const int jb = (j >> 1) & 255, rnd = j >> 9;
          const int xcd = jb & 7, ii = jb >> 3;
          b = 2 * xcd + (ii & 1); kvh = (ii >> 1) & 1; c = 31 - rnd * 8 - (ii >> 2);
        }
        attn_item(p, ldsh, ht, samp, b, c, kvh, it & 1, lds, tid);
      } else scan_item(p, it - 1056, ht);
    }
  }
  xcd_barrier(p.bar(), wave_id);
  }
  for (int rep = 0; rep < REP4; ++rep) {
  {
    FRESH_TID();
    for (int it0 = blockIdx.x * 2; it0 < 2080 + 1024; it0 += gridDim.x * 2) {
      const int it = it0 + half;
      int ht = htid; asm volatile("" : "+v"(ht));
      if (it < 2080) ret_out_item(p, ldsh, it, ht);
      else {
        const int ia = it - 2080 + 1056;
        const int j = ia - 32;
        int c = 31 - (j >> 6);
        int b = (j & 63) >> 2;
        int kvh = (ia >> 1) & 1;
        if (gridDim.x == 256) {
          const int jb = (j >> 1) & 255, rnd = j >> 9;
          const int xcd = jb & 7, ii = jb >> 3;
          b = 2 * xcd + (ii & 1); kvh = (ii >> 1) & 1; c = 31 - rnd * 8 - (ii >> 2);
        }
        attn_item(p, ldsh, ht, false, b, c, kvh, ia & 1, lds, tid);
      }
    }
  }
  xcd_barrier(p.bar(), wave_id);
  }
  for (int rep = 0; rep < REP5; ++rep) {
  {
    pg8::Gemm g; g.A = p.mix(); g.Bt = p.WtOut(); g.M = NTOK; g.N = 1024; g.K = 1024;
    pg8::StaticOrder S; S.init(g.M, g.N, (int)gridDim.x, (int)blockIdx.x);
    Epi2 E; E.p = p; E.hl = lds + pg8::STAGE_BYTES + (wave_id >> 2) * 16384;
    pg8::gemm_phase<Epi2>((LAS unsigned char*)lds, g, S, E, wave_id);
  }
  xcd_barrier(p.bar(), wave_id);
  }
  { FRESH_TID(); phase_final(p, tid); }
}

extern "C" void kernel_launch(void* const* d_in, const int* in_sizes, int n_in, void* d_out, int out_size, void* d_ws,
                              size_t ws_size, hipStream_t stream) {
  static int grid_blocks = 0;
  if (!grid_blocks) {
    int dev = 0, cus = 0, per_cu = 0;
    (void)hipGetDevice(&dev);
    (void)hipDeviceGetAttribute(&cus, hipDeviceAttributeMultiprocessorCount, dev);
    (void)hipOccupancyMaxActiveBlocksPerMultiprocessor(&per_cu, fwd_megakernel, 512, 0);
    if (per_cu < 1) per_cu = 1;
    if (per_cu > 1) per_cu = 1;
    grid_blocks = cus * per_cu;
  }
  Params p{};
  p.x_p = (const float*)d_in[0]; p.x_s = (const float*)d_in[1]; p.state_ret = (const float*)d_in[2];
  p.cache_k = (const float*)d_in[3]; p.cache_v = (const float*)d_in[4]; p.cache_kidx = (const float*)d_in[5];
  p.norm_g = (const float*)d_in[6]; p.w_in = (const float*)d_in[7]; p.ret_gn_g = (const float*)d_in[8];
  p.w_out = (const float*)d_in[9]; p.final_g = (const float*)d_in[10];
  p.out = (float*)d_out;
  p.ws = (unsigned char*)d_ws;
  (void)hipMemsetAsync((unsigned char*)d_ws + 530573312ull, 0, (size_t)XCD_BAR_WORDS * 4, stream);
  void* args[] = {&p};
  hipError_t e = hipLaunchCooperativeKernel((void*)fwd_megakernel, dim3(grid_blocks), dim3(512), args, 0, stream);
  if (e != hipSuccess) fprintf(stderr, "cooperative launch failed: %s (grid %d)\n", hipGetErrorString(e), grid_blocks);
}
```

```cpp
#include <hip/hip_runtime.h>
#include <hip/hip_cooperative_groups.h>
#include <stdint.h>
#include <cstdio>
namespace cg = cooperative_groups;

typedef __attribute__((ext_vector_type(8))) short bf16x8;
typedef __attribute__((ext_vector_type(4))) short s16x4;
typedef __attribute__((ext_vector_type(16))) float f32x16;
typedef __attribute__((ext_vector_type(4))) float f32x4;
typedef unsigned short u16;
typedef unsigned long long u64;


#define DI __device__ __forceinline__
#define MFMA32(a, b, c) __builtin_amdgcn_mfma_f32_32x32x16_bf16((a), (b), (c), 0, 0, 0)
#define MFMA16(a, b, c) __builtin_amdgcn_mfma_f32_16x16x32_bf16((a), (b), (c), 0, 0, 0)

#define NTOK 33280
#define NPROMPT 32768
#define LDS_BYTES 163840
#define HALF_LDS 81920
#define LAS __attribute__((address_space(3)))
#define KPITCH 2116

struct Params {
  const float *x_p, *x_s, *state_ret, *cache_k, *cache_v, *cache_kidx, *norm_g, *w_in, *ret_gn_g, *w_out, *final_g;
  float* out;
  unsigned char* ws;
  DI u16* xb() const { return (u16*)(ws + 0ull); }
  DI float* kvT() const { return (float*)(ws + 0ull); }
  DI u16* WtIn() const { return (u16*)(ws + 136314880ull); }
  DI u16* WtOut() const { return (u16*)(ws + 144703488ull); }
  DI u16* qr() const { return (u16*)(ws + 146800640ull); }
  DI u16* kr() const { return (u16*)(ws + 180879360ull); }
  DI u16* sprevT() const { return (u16*)(ws + 214958080ull); }
  DI u16* qi() const { return (u16*)(ws + 214958080ull); }
  DI u16* krT() const { return (u16*)(ws + 249036800ull); }
  DI u16* vrT() const { return (u16*)(ws + 283115520ull); }
  DI u16* gate() const { return (u16*)(ws + 317194240ull); }
  DI u16* mix() const { return (u16*)(ws + 385351680ull); }
  DI u16* qa() const { return (u16*)(ws + 453509120ull); }
  DI u16* kaP() const { return (u16*)(ws + 487587840ull); }
  DI u16* kaS() const { return (u16*)(ws + 495976448ull); }
  DI u16* vaTP() const { return (u16*)(ws + 500301824ull); }
  DI u16* vaTS() const { return (u16*)(ws + 508690432ull); }
  DI u16* kiP() const { return (u16*)(ws + 513015808ull); }
  DI u16* kiS() const { return (u16*)(ws + 517210112ull); }
  DI float* rinv() const { return (float*)(ws + 519372800ull); }
  DI float* wi() const { return (float*)(ws + 519505920ull); }
  DI float* cosR() const { return (float*)(ws + 520570880ull); }
  DI float* sinR() const { return (float*)(ws + 521111552ull); }
  DI float* cosA() const { return (float*)(ws + 521652224ull); }
  DI float* sinA() const { return (float*)(ws + 521719808ull); }
  DI unsigned* bar() const { return (unsigned*)(ws + 530573312ull); }
  DI u64* maskbits() const { return (u64*)(ws + 521787392ull); }
};

#define OUT_Y 0
#define OUT_STP (34078720)
#define OUT_KP (OUT_STP + 1048576)
#define OUT_VP (OUT_KP + 4194304)
#define OUT_KIP (OUT_VP + 4194304)
#define OUT_STS (OUT_KIP + 2097152)
#define OUT_KS (OUT_STS + 524288)
#define OUT_VS (OUT_KS + 65536)
#define OUT_KIS (OUT_VS + 65536)

typedef __bf16 bf16x2_t __attribute__((ext_vector_type(2)));
typedef float f32x2_t __attribute__((ext_vector_type(2)));
typedef unsigned u32x4_t __attribute__((ext_vector_type(4)));
typedef unsigned u32x2_t __attribute__((ext_vector_type(2)));
DI unsigned pk2(float a, float b) { f32x2_t v = {a, b}; bf16x2_t r = __builtin_convertvector(v, bf16x2_t); return __builtin_bit_cast(unsigned, r); }
DI u16 f2bf(float x) { return (u16)(pk2(x, x) & 0xffffu); }
DI bf16x8 ldg8(const u16* p) { return *(const bf16x8*)p; }
DI s16x4 ldg4(const u16* p) { return *(const s16x4*)p; }
DI float siluf(float x) { return x * __builtin_amdgcn_rcpf(1.f + __builtin_amdgcn_exp2f(-1.4426950408889634f * x)); }
DI int lane_id() { return (int)__builtin_amdgcn_mbcnt_hi(~0u, __builtin_amdgcn_mbcnt_lo(~0u, 0u)); }
DI int crow(int reg, int hh) { return (reg & 3) + 8 * (reg >> 2) + 4 * hh; }
DI const float* xrow(const Params& p, int g) { return g < NPROMPT ? p.x_p + (size_t)g * 1024 : p.x_s + (size_t)(g - NPROMPT) * 1024; }
DI float log2gamma(int h) { return log1pf(-exp2f(-5.f - (float)h)) * 1.4426950408889634f; }
DI bf16x8 pack8(float a0, float a1, float a2, float a3, float a4, float a5, float a6, float a7) {
  u32x4_t v = {pk2(a0, a1), pk2(a2, a3), pk2(a4, a5), pk2(a6, a7)};
  return __builtin_bit_cast(bf16x8, v);
}
DI s16x4 pack4(f32x4 v) { u32x2_t o = {pk2(v[0], v[1]), pk2(v[2], v[3])}; return __builtin_bit_cast(s16x4, o); }
DI int wave_sum(int v) {
  v += __builtin_amdgcn_update_dpp(0, v, 0xB1, 0xf, 0xf, false);
  v += __builtin_amdgcn_update_dpp(0, v, 0x4E, 0xf, 0xf, false);
  v += __builtin_amdgcn_update_dpp(0, v, 0x124, 0xf, 0xf, false);
  v += __builtin_amdgcn_update_dpp(0, v, 0x128, 0xf, 0xf, false);
  return __builtin_amdgcn_readlane(v, 0) + __builtin_amdgcn_readlane(v, 16) + __builtin_amdgcn_readlane(v, 32) + __builtin_amdgcn_readlane(v, 48);
}
DI f32x16 zero16() { f32x16 z; for (int i = 0; i < 16; ++i) z[i] = 0.f; return z; }

#define XB_TMO      128
#define XB_XCNT(j)  (256  + 64 * (j))
#define XB_XSUB(j)  (1280 + 64 * (j))
#define XB_XGEN(j)  (2304 + 64 * (j))
#define XB_TOP      3328
#define XB_TOPGEN   3392
#define XB_WG(i)    (3456 + 64 * (i))
#define XCD_BAR_WORDS (3456 + 64 * 256)
#define XB_SPIN_CAP (1u << 18)
DI unsigned xb_ld(unsigned* p) { return __hip_atomic_load(p, __ATOMIC_RELAXED, __HIP_MEMORY_SCOPE_AGENT); }
DI unsigned xb_add(unsigned* p, unsigned v) { return __hip_atomic_fetch_add(p, v, __ATOMIC_RELAXED, __HIP_MEMORY_SCOPE_AGENT); }
DI unsigned xb_xcc_id() { return (unsigned)__builtin_amdgcn_s_getreg((3 << 11) | 20) & 0xFu; }
#define XB_SPIN(cond, bar) do { unsigned _sp = 0; while (cond) { __builtin_amdgcn_s_sleep(1); \
    if ((++_sp & 255u) == 0u) { if (xb_ld(&(bar)[XB_TMO])) break; if (_sp > XB_SPIN_CAP) { atomicAdd(&(bar)[XB_TMO], 1u); break; } } } } while (0)
DI void xcd_barrier(unsigned* bar, int wave_id) {
  asm volatile("s_waitcnt vmcnt(0)" ::: "memory");
  __syncthreads();
  if (wave_id == 0) {
    const int lane = lane_id();
    const unsigned x = xb_xcc_id();
    unsigned* slot = &bar[XB_WG(blockIdx.x)];
    unsigned nloc = 0u, nx = 0u;
    if (lane < 2) nloc = xb_ld(slot + lane);
    nx = (unsigned)__builtin_amdgcn_readlane((int)nloc, 1);
    nloc = (unsigned)__builtin_amdgcn_readlane((int)nloc, 0);
    if (nloc == 0u) {
      const unsigned G = gridDim.x * gridDim.y * gridDim.z;
      unsigned sp = 0u, c = 0u;
      for (;;) {
        c = (lane < 16) ? xb_ld(&bar[XB_XCNT(lane)]) : 0u;
        const unsigned sum = (unsigned)wave_sum((int)c);
        if (sum == G) break;
        __builtin_amdgcn_s_sleep(1);
        if ((++sp & 255u) == 0u) { if (xb_ld(&bar[XB_TMO])) break; if (sp > XB_SPIN_CAP) { if (lane == 0) atomicAdd(&bar[XB_TMO], 1u); break; } }
      }
      nx = (unsigned)__popcll(__ballot(c > 0u));
      nloc = (unsigned)__builtin_amdgcn_readlane((int)c, (int)x);
      nloc = nloc > 0u ? nloc : 1u; nx = nx > 0u ? nx : 1u;
      if (lane == 0) { __hip_atomic_store(slot, nloc, __ATOMIC_RELAXED, __HIP_MEMORY_SCOPE_AGENT); __hip_atomic_store(slot + 1, nx, __ATOMIC_RELAXED, __HIP_MEMORY_SCOPE_AGENT); }
    }
    if (lane == 0) {
      __builtin_amdgcn_s_waitcnt(0);
      const unsigned old = xb_add(&bar[XB_XSUB(x)], 1u);
      const unsigned gen = old / nloc;
      if (old + 1u == (gen + 1u) * nloc) {
        __builtin_amdgcn_fence(__ATOMIC_RELEASE, "agent");
        asm volatile("s_waitcnt vmcnt(0)" ::: "memory");
        const unsigned og = xb_add(&bar[XB_TOP], 1u);
        const unsigned tg = og / nx;
        if (og + 1u == (tg + 1u) * nx) xb_add(&bar[XB_TOPGEN], 1u);
        else XB_SPIN(xb_ld(&bar[XB_TOPGEN]) == tg, bar);
        __builtin_amdgcn_fence(__ATOMIC_ACQUIRE, "agent");
        xb_add(&bar[XB_XGEN(x)], 1u);
        asm volatile("s_waitcnt vmcnt(0)" ::: "memory");
      } else {
        XB_SPIN(xb_ld(&bar[XB_XGEN(x)]) == gen, bar);
        __builtin_amdgcn_fence(__ATOMIC_ACQUIRE, "agent");
        asm volatile("s_waitcnt vmcnt(0)" ::: "memory");
      }
    }
  }
  __syncthreads();
}

DI void phase_prep(const Params& p, int tid) {
  const int gt = blockIdx.x * 512 + tid, GT = gridDim.x * 512;
  const int lane = tid & 63;
  for (int row0 = (gt >> 6) * 2; row0 < NTOK; row0 += (GT >> 6) * 2) {
    f32x4 v[2][4];
#pragma unroll
    for (int rr = 0; rr < 2; ++rr) {
      const float* sp = xrow(p, row0 + rr);
#pragma unroll
      for (int i = 0; i < 4; ++i) v[rr][i] = __builtin_nontemporal_load((const f32x4*)(sp + i * 256 + lane * 4));
    }
#pragma unroll
    for (int rr = 0; rr < 2; ++rr) {
      float ss = 0.f;
#pragma unroll
      for (int i = 0; i < 4; ++i) ss += v[rr][i][0] * v[rr][i][0] + v[rr][i][1] * v[rr][i][1] + v[rr][i][2] * v[rr][i][2] + v[rr][i][3] * v[rr][i][3];
#pragma unroll
      for (int o = 32; o >= 1; o >>= 1) ss += __shfl_xor(ss, o);
#pragma unroll
      for (int i = 0; i < 4; ++i) *(s16x4*)(p.xb() + (size_t)(row0 + rr) * 1024 + i * 256 + lane * 4) = pack4(v[rr][i]);
      if (lane == 0) p.rinv()[row0 + rr] = rsqrtf(ss * (1.f / 1024.f) + 1e-6f);
    }
  }
  for (int i = gt; i < 4096 * 128; i += GT) {
    int n = i & 4095, kg = i >> 12;
    int sc = n;
    if (n < 1024) { const int P = n & 127; sc = (n & ~127) + 64 * ((P >> 4) & 1) + 16 * (P >> 5) + (P & 15); }
    float a[8];
    const float vmask = (n < 3912) ? 1.f : 0.f; const int scc = (sc < 3912) ? sc : 3911;
#pragma unroll
    for (int j = 0; j < 8; ++j) a[j] = p.w_in[(size_t)(kg * 8 + j) * 3912 + scc] * p.norm_g[kg * 8 + j] * vmask;
    *(bf16x8*)(p.WtIn() + (size_t)n * 1024 + kg * 8) = pack8(a[0], a[1], a[2], a[3], a[4], a[5], a[6], a[7]);
  }
  for (int i = gt; i < 1024 * 128; i += GT) {
    int n = i % 1024, kg = i / 1024;
    float a[8];
#pragma unroll
    for (int j = 0; j < 8; ++j) a[j] = p.w_out[(size_t)(kg * 8 + j) * 1024 + n];
    *(bf16x8*)(p.WtOut() + (size_t)n * 1024 + kg * 8) = pack8(a[0], a[1], a[2], a[3], a[4], a[5], a[6], a[7]);
  }
  for (int i = gt; i < 2112 * 64; i += GT) {
    int pos = i >> 6, k = i & 63;
    float inv = powf(10000.f, -(float)k / 64.f);
    float ang = (float)pos * inv;
    p.cosR()[i] = cosf(ang); p.sinR()[i] = sinf(ang);
  }
  for (int i = gt; i < 2112 * 8; i += GT) {
    int pos = i >> 3, k = i & 7;
    float inv = powf(500000.f, -(float)k / 8.f);
    float ang = (float)pos * inv;
    p.cosA()[i] = cosf(ang); p.sinA()[i] = sinf(ang);
  }
  for (int i = gt; i < 8 * 2048 * 2 * 8; i += GT) {
    int dg = i & 7, kvh = (i >> 3) & 1, t = (i >> 4) & 2047, b = i >> 15;
    const float* s = p.cache_k + ((size_t)(b * 2048 + t) * 2 + kvh) * 64 + dg * 8;
    *(bf16x8*)(p.kaS() + ((size_t)(b * 2 + kvh) * 2112 + t) * 64 + dg * 8) = pack8(s[0], s[1], s[2], s[3], s[4], s[5], s[6], s[7]);
  }
  for (int i = gt; i < 8 * 2 * 256 * 64; i += GT) {
    int d = i & 63, tg = (i >> 6) & 255, kvh = (i >> 14) & 1, b = i >> 15;
    float a[8];
#pragma unroll
    for (int j = 0; j < 8; ++j) a[j] = p.cache_v[((size_t)(b * 2048 + tg * 8 + j) * 2 + kvh) * 64 + d];
    *(bf16x8*)(p.vaTS() + ((size_t)(b * 2 + kvh) * 64 + d) * 2112 + tg * 8) = pack8(a[0], a[1], a[2], a[3], a[4], a[5], a[6], a[7]);
  }
  for (int i = gt; i < 8 * 2048 * 8; i += GT) {
    int dg = i & 7, t = (i >> 3) & 2047, b = i >> 14;
    const float* s = p.cache_kidx + (size_t)(b * 2048 + t) * 64 + dg * 8;
    *(bf16x8*)(p.kiS() + ((size_t)b * 2112 + t) * 64 + dg * 8) = pack8(s[0], s[1], s[2], s[3], s[4], s[5], s[6], s[7]);
  }
}

namespace pg8 {
constexpr int BM = 256, BK = 64, HALF = 128, HTB = HALF * BK * 2, STAGE_BYTES = 8 * HTB, NXCD = 8, WGM = 8;
DI int lds_byte(int r, int c) { const int st = (r >> 4) * 2 + (c >> 5), rr = r & 15, cc = c & 31, ob = rr * 64 + cc * 2; return st * 1024 + (ob ^ (((ob >> 9) & 1) << 5)); }
DI void stage_rc(int b, int& R, int& C) { const int st = b / 1024, sb = b % 1024, swz = sb ^ (((sb >> 9) & 1) << 5); R = (st >> 1) * 16 + swz / 64; C = (st & 1) * 32 + (swz % 64) / 2; }
struct Unit { int pm, pn; };
struct Gemm { const u16* A; const u16* Bt; int M, N, K; };
struct StaticOrder {
  int nM, nN, nwg, G, c, padtile; unsigned long long permtab;
  DI void init(int M, int N, int G_, int c_) { nM = M / BM; nN = N / BM; nwg = nM * nN; G = G_; c = c_; permtab = 0xFEDCBA9876543210ull; padtile = -1; }
  DI void map(int L, Unit& u) const {
    int wgid = L; { const int q = nwg / NXCD, r = nwg % NXCD, xcd = wgid % NXCD, off = wgid / NXCD; wgid = (xcd < r ? xcd * (q + 1) : r * (q + 1) + (xcd - r) * q) + off; }
    const int nig = WGM * nN, gid = wgid / nig, fm = gid * WGM, gsz = (nM - fm) < WGM ? (nM - fm) : WGM;
    u.pm = fm + ((wgid % nig) % gsz); u.pn = (int)((permtab >> (4 * ((wgid % nig) / gsz))) & 15ull);
  }
  DI bool next(int i, Unit& u) const {
    const long Ll = (long)i * G + c; if (Ll >= nwg) return false;
    const int L = (int)Ll;
    if (padtile < 0) { map(L, u); return true; }
    const int tail = nwg % G, base = nwg - tail;
    if (L >= base) { u.pm = L - base; u.pn = padtile; return true; }
    map(L, u);
    for (int it = 0; it < 64 && u.pn == padtile && u.pm < tail; ++it) map(base + u.pm, u);
    return true;
  }
};
template <class Epi>
DI void gemm_phase(LAS unsigned char* lds, const Gemm g, const StaticOrder& S, const Epi& E, int wave_id) {
  const int wid = wave_id; int lane = lane_id(); asm volatile("" : "+v"(lane)); const int tid = wid * 64 + lane;
  const int wr = wid >> 2, wc = wid & 3, fr = lane & 15, fq = lane >> 4;
  const int K = g.K, nt = K / BK;
  unsigned voffA[2], voffB[2];
#pragma unroll
  for (int i = 0; i < 2; ++i) { int R, C; stage_rc(tid * 16 + i * 8192, R, C); voffA[i] = (unsigned)(R * K + C) * 2u; voffB[i] = voffA[i]; }
  const size_t kstep = (size_t)(BK * 2);
  const size_t hstep = (size_t)HALF * K * 2;
  const size_t tstep = 2 * hstep;
  const unsigned ldsw = (unsigned)wid * 1024u;
  const int aoff = lds_byte(wr * 64 + fr, fq * 8), boff = lds_byte(wc * 32 + fr, fq * 8);
#define PG8_SA(b, h) (((b) * 2 + (h)) * HTB)
#define PG8_SB(b, h) ((4 + (b) * 2 + (h)) * HTB)
#define PG8_STAGE(bufoff, gbase, voff) do { _Pragma("unroll") for (int _i = 0; _i < 2; ++_i) \
    __builtin_amdgcn_global_load_lds((const unsigned*)((const char*)(gbase) + (voff)[_i]), (LAS unsigned*)(lds + (bufoff) + ldsw + _i * 8192), 16, 0, 0); } while (0)
#define PG8_LDA(dst, b, h) do { _Pragma("unroll") for (int m = 0; m < 4; ++m) _Pragma("unroll") for (int k = 0; k < 2; ++k) dst[m][k] = *(const LAS bf16x8*)(lds + PG8_SA(b, h) + aoff + m * 2048 + k * 1024); } while (0)
#define PG8_LDB(dst, b, h) do { _Pragma("unroll") for (int n = 0; n < 2; ++n) _Pragma("unroll") for (int k = 0; k < 2; ++k) dst[n][k] = *(const LAS bf16x8*)(lds + PG8_SB(b, h) + boff + n * 2048 + k * 1024); } while (0)
#define PG8_MMA(ai, bj, At, Bt) do { __builtin_amdgcn_s_setprio(1); _Pragma("unroll") for (int m = 0; m < 4; ++m) _Pragma("unroll") for (int n = 0; n < 2; ++n) _Pragma("unroll") for (int k = 0; k < 2; ++k) \
    acc[ai][bj][m][n] = __builtin_amdgcn_mfma_f32_16x16x32_bf16(Bt[n][k], At[m][k], acc[ai][bj][m][n], 0, 0, 0); __builtin_amdgcn_s_setprio(0); } while (0)
#define PG8_WAIT_V(n) asm volatile("s_waitcnt vmcnt(" #n ")" ::: "memory")
#define PG8_WAIT_L(n) asm volatile("s_waitcnt lgkmcnt(" #n ")" ::: "memory")
#define PG8_BAR __builtin_amdgcn_s_barrier()
#define PG8_SCHED __builtin_amdgcn_sched_barrier(0)
  Unit cur, nxt; int ui = 0;
  if (!S.next(0, cur)) return;
  f32x4 acc[2][2][4][2];
#pragma unroll
  for (int a = 0; a < 2; ++a)
#pragma unroll
    for (int b = 0; b < 2; ++b)
#pragma unroll
      for (int m = 0; m < 4; ++m)
#pragma unroll
        for (int n = 0; n < 2; ++n) acc[a][b][m][n] = (f32x4){0.f, 0.f, 0.f, 0.f};
  bf16x8 At[4][2], B0[2][2], B1[2][2];
  const char* cA = (const char*)g.A + (size_t)cur.pm * tstep; const char* cB = (const char*)g.Bt + (size_t)cur.pn * tstep;
  PG8_STAGE(PG8_SB(0, 0), cB, voffB); PG8_STAGE(PG8_SA(0, 0), cA, voffA); PG8_STAGE(PG8_SB(0, 1), cB + hstep, voffB); PG8_STAGE(PG8_SA(0, 1), cA + hstep, voffA);
  if (wr == 1) PG8_BAR;
  PG8_WAIT_V(4); PG8_BAR;
  PG8_STAGE(PG8_SB(1, 0), cB + kstep, voffB); PG8_STAGE(PG8_SA(1, 0), cA + kstep, voffA); PG8_STAGE(PG8_SB(1, 1), cB + hstep + kstep, voffB);
  PG8_WAIT_V(6); PG8_BAR;
  for (;;) {
    const bool has_next = S.next(ui + 1, nxt);
    const char* nA = has_next ? (const char*)g.A + (size_t)nxt.pm * tstep : cA; const char* nB = has_next ? (const char*)g.Bt + (size_t)nxt.pn * tstep : cB;
#ifndef REPK
#define REPK 1
#endif
    const bool skip1 = (S.padtile >= 0) && (cur.pn == S.padtile);
    for (int rk = 0; rk < REPK; ++rk) {
    const char* nA2 = (rk == REPK - 1) ? nA : cA; const char* nB2 = (rk == REPK - 1) ? nB : cB;
    for (int t = 0; t < nt; t += 2) {
      const bool last = (t == nt - 2);
      const char* a1 = cA + (size_t)(t + 1) * kstep;
      const char* a2 = last ? nA2 : cA + (size_t)(t + 2) * kstep; const char* b2 = last ? nB2 : cB + (size_t)(t + 2) * kstep;
      const char* a3 = a2 + kstep; const char* b3 = b2 + kstep;
      PG8_LDB(B0, 0, 0); PG8_SCHED; PG8_LDA(At, 0, 0); PG8_STAGE(PG8_SA(1, 1), a1 + hstep, voffA);
      PG8_WAIT_L(8); PG8_BAR; PG8_WAIT_L(0); PG8_MMA(0, 0, At, B0); PG8_BAR; PG8_SCHED;
      PG8_LDB(B1, 0, 1); PG8_STAGE(PG8_SB(0, 0), b2, voffB);
      PG8_BAR; PG8_WAIT_L(0); if (!skip1) PG8_MMA(0, 1, At, B1); PG8_BAR;
      PG8_LDA(At, 0, 1); PG8_STAGE(PG8_SA(0, 0), a2, voffA);
      PG8_BAR; PG8_WAIT_L(0); PG8_MMA(1, 0, At, B0); PG8_BAR; PG8_SCHED;
      PG8_STAGE(PG8_SB(0, 1), b2 + hstep, voffB);
      PG8_WAIT_V(6); PG8_BAR; if (!skip1) PG8_MMA(1, 1, At, B1); PG8_BAR;
      PG8_LDB(B0, 1, 0); PG8_SCHED; PG8_LDA(At, 1, 0); PG8_STAGE(PG8_SA(0, 1), a2 + hstep, voffA);
      PG8_WAIT_L(8); PG8_BAR; PG8_WAIT_L(0); PG8_MMA(0, 0, At, B0); PG8_BAR; PG8_SCHED;
      PG8_LDB(B1, 1, 1); PG8_STAGE(PG8_SB(1, 0), b3, voffB);
      PG8_BAR; PG8_WAIT_L(0); if (!skip1) PG8_MMA(0, 1, At, B1); PG8_BAR;
      PG8_LDA(At, 1, 1); PG8_STAGE(PG8_SA(1, 0), a3, voffA);
      PG8_BAR; PG8_WAIT_L(0); PG8_MMA(1, 0, At, B0); PG8_BAR; PG8_SCHED;
      PG8_STAGE(PG8_SB(1, 1), b3 + hstep, voffB);
      PG8_WAIT_V(6); PG8_BAR; if (!skip1) PG8_MMA(1, 1, At, B1); PG8_BAR;
    }
    }
    {
      Unit eu = cur; int ewr = wr, ewc = wc; int el = lane_id();
      asm volatile("" : "+s"(eu.pm), "+s"(eu.pn), "+s"(ewr), "+s"(ewc), "+v"(el));
      int efr = el & 15, efq = el >> 4;
#ifndef REPEPI
#define REPEPI 1
#endif
      for (int re = 0; re < REPEPI; ++re) E(acc, eu, ewr, ewc, efr, efq, re);
    }
    if (!has_next) break;
#pragma unroll
    for (int a = 0; a < 2; ++a)
#pragma unroll
      for (int b = 0; b < 2; ++b)
#pragma unroll
        for (int m = 0; m < 4; ++m)
#pragma unroll
          for (int n = 0; n < 2; ++n) acc[a][b][m][n] = (f32x4){0.f, 0.f, 0.f, 0.f};
    cur = nxt; cA = nA; cB = nB; ++ui;
  }
  PG8_WAIT_V(0);
  if (wr == 0) PG8_BAR;
  PG8_BAR;
#undef PG8_SA
#undef PG8_SB
#undef PG8_STAGE
#undef PG8_LDA
#undef PG8_LDB
#undef PG8_MMA
#undef PG8_WAIT_V
#undef PG8_WAIT_L
#undef PG8_BAR
#undef PG8_SCHED
}
}


DI unsigned hx_w(int row, int c8) { return (unsigned)(row * 256 + ((c8 ^ ((row & 15) << 1)) << 3)); }
DI unsigned hx_r(int row, int c16) { return (unsigned)(row * 256 + ((c16 ^ (row & 15)) << 4)); }
#define EPI_BAR() asm volatile("s_waitcnt lgkmcnt(0)\n\ts_barrier" ::: "memory")


struct Epi1 {
  Params p; LAS unsigned char* hl0;
  DI void load_tabs(f32x4 (&tc)[4], f32x4 (&ts)[4], int tclass, int R0, bool samp, int wc, int fr, int fq) const {
    const float* cb = (tclass == 1) ? p.cosR() : p.cosA();
    const float* sb = (tclass == 1) ? p.sinR() : p.sinA();
    const int pitch = (tclass == 1) ? 64 : 8;
    const int coff = (tclass == 1) ? (16 * wc + 4 * fq) : (4 * (fq & 1));
#pragma unroll
    for (int m = 0; m < 4; ++m) {
      const int rowg = R0 + 16 * m + fr;
      const int pos = samp ? 2048 + ((rowg - NPROMPT) & 63) : (rowg & 2047);
      tc[m] = *(const f32x4*)(cb + pos * pitch + coff);
      ts[m] = *(const f32x4*)(sb + pos * pitch + coff);
    }
  }
  template <int AI, int BJ>
  DI void compute(f32x4 (&acc)[2][2][4][2], const f32x4 (&tc)[4], const f32x4 (&ts)[4], int blk, int wc, int fq) const {
    if (blk < 8) {
#pragma unroll
      for (int m = 0; m < 4; ++m) {
        const f32x4 v0 = acc[AI][BJ][m][0], v1 = acc[AI][BJ][m][1];
        f32x4 o0 = v0 * tc[m] - v1 * ts[m], o1 = v1 * tc[m] + v0 * ts[m];
        if (blk >= 4) { o0 *= 0.08838834764831845f; o1 *= 0.08838834764831845f; }
        acc[AI][BJ][m][0] = o0; acc[AI][BJ][m][1] = o1;
      }
    } else if ((blk >= 12 && blk < 16) || (blk >= 22 && blk < 26)) {
#pragma unroll
      for (int m = 0; m < 4; ++m)
#pragma unroll
        for (int n = 0; n < 2; ++n) {
          f32x4 v = acc[AI][BJ][m][n];
          v[0] = siluf(v[0]); v[1] = siluf(v[1]); v[2] = siluf(v[2]); v[3] = siluf(v[3]);
          acc[AI][BJ][m][n] = v;
        }
    } else if ((blk >= 8 && blk < 12) || blk == 21 || blk == 31) {
    } else {
      const bool ropew = ((wc & 1) == 0) && !(blk == 30 && wc >= 2);
      if (ropew) {
#pragma unroll
        for (int m = 0; m < 4; ++m) {
          const f32x4 v0 = acc[AI][BJ][m][0];
          f32x4 pr;
          pr[0] = __shfl_xor(v0[0], 32); pr[1] = __shfl_xor(v0[1], 32); pr[2] = __shfl_xor(v0[2], 32); pr[3] = __shfl_xor(v0[3], 32);
          acc[AI][BJ][m][0] = (fq < 2) ? v0 * tc[m] - pr * ts[m] : v0 * tc[m] + pr * ts[m];
        }
      }
      if (blk < 20) {
        const float sc = 0.125f * 1.4426950408889634f;
#pragma unroll
        for (int m = 0; m < 4; ++m) { acc[AI][BJ][m][0] *= sc; acc[AI][BJ][m][1] *= sc; }
      }
    }
  }
  template <int AI, int BJ>
  DI void emit(f32x4 (&acc)[2][2][4][2], const pg8::Unit& u, int blk, bool samp, int wr, int wc, int fr, int fq) const {
    if (blk == 31) return;
    LAS unsigned char* hl = hl0 + wr * 16384;
    asm volatile("" : "+v"(fr), "+v"(fq));
    const int lane = fr + 16 * fq;
    const int P0 = 32 * wc + 4 * fq;
    const int R0 = u.pm * 256 + AI * 128 + wr * 64;
    int b, tb;
    if (!samp) { b = R0 >> 11; tb = R0 & 2047; } else { b = (R0 - NPROMPT) >> 6; tb = 0; }
    const bool retk = blk < 8;
    const bool hasT = (blk >= 4 && blk < 12) || blk == 21;
    const bool hasN = !(blk >= 8 && blk < 12) && blk != 21;
    if (blk == 20 || blk == 21) {
      float* ob = samp ? p.out + (blk == 20 ? OUT_KS : OUT_VS) + (unsigned)(R0 - NPROMPT) * 128u : p.out + (blk == 20 ? OUT_KP : OUT_VP) + (unsigned)R0 * 128u;
#pragma unroll
      for (int m = 0; m < 4; ++m) {
        float* o2 = ob + (unsigned)(16 * m + fr) * 128u + P0;
        __builtin_nontemporal_store(acc[AI][BJ][m][0], (f32x4*)o2); __builtin_nontemporal_store(acc[AI][BJ][m][1], (f32x4*)(o2 + 16));
      }
    } else if (blk == 30) {
      float* ob = samp ? p.out + OUT_KIS + (unsigned)(R0 - NPROMPT) * 64u : p.out + OUT_KIP + (unsigned)R0 * 64u;
      float* wb = p.wi() + (unsigned)R0 * 8u;
#pragma unroll
      for (int m = 0; m < 4; ++m) {
        if (wc < 2) {
          float* o2 = ob + (unsigned)(16 * m + fr) * 64u + P0;
          __builtin_nontemporal_store(acc[AI][BJ][m][0], (f32x4*)o2); __builtin_nontemporal_store(acc[AI][BJ][m][1], (f32x4*)(o2 + 16));
        } else if (wc == 2 && fq < 2) {
          *(f32x4*)(wb + (unsigned)(16 * m + fr) * 8u + 4 * fq) = acc[AI][BJ][m][0] * 0.044194173824159216f;
        }
      }
    }
    if (hasN) {
#pragma unroll
      for (int m = 0; m < 4; ++m)
#pragma unroll
        for (int n = 0; n < 2; ++n) {
          const int c8 = retk ? (16 * n + 4 * wc + fq) : (8 * wc + 4 * n + fq);
          *(LAS s16x4*)(hl + hx_w(16 * m + fr, c8)) = pack4(acc[AI][BJ][m][n]);
        }
      u16* nb; unsigned pitch = 512u, hstr = 0u, cm = 15u;
      if (blk < 4) nb = p.qr() + (unsigned)R0 * 512u + (blk & 3) * 128;
      else if (blk < 8) nb = p.kr() + (unsigned)R0 * 512u + (blk & 3) * 128;
      else if (blk < 16) { nb = p.gate() + (unsigned)R0 * 1024u + (blk - 12) * 128; pitch = 1024u; }
      else if (blk < 20) nb = p.qa() + (unsigned)R0 * 512u + (blk - 16) * 128;
      else if (blk == 20) { nb = samp ? p.kaS() + ((unsigned)(b * 2) * 2112u + 2048u) * 64u : p.kaP() + ((unsigned)(b * 2) * 2048u + tb) * 64u; pitch = 64u; hstr = samp ? 2112u * 64u : 2048u * 64u; cm = 7u; }
      else if (blk < 26) { nb = p.gate() + (unsigned)R0 * 1024u + 512 + (blk - 22) * 128; pitch = 1024u; }
      else if (blk < 30) nb = p.qi() + (unsigned)R0 * 512u + (blk - 26) * 128;
      else { nb = samp ? p.kiS() + ((unsigned)b * 2112u + 2048u) * 64u : p.kiP() + ((unsigned)b * 2048u + tb) * 64u; pitch = 64u; cm = 7u; }
      EPI_BAR();
      const unsigned c16 = lane & 15;
      const unsigned loff = (c16 >> 3) * hstr + (c16 & cm) * 8u;
#pragma unroll
      for (int i = 0; i < 4; ++i) {
        const int row = 16 * wc + 4 * i + (lane >> 4);
        const bf16x8 v = *(const LAS bf16x8*)(hl + hx_r(row, c16));
        if (blk != 30 || c16 < 8) *(bf16x8*)(nb + (unsigned)row * pitch + loff) = v;
      }
      EPI_BAR();
    }
    if (hasT) {
      const float l2g = log2gamma(blk & 3);
#pragma unroll
      for (int m = 0; m < 4; ++m) {
        const int tok = 16 * m + fr;
        const float dec = (blk < 8) ? exp2f((float)(63 - tok) * l2g) : 1.f;
#pragma unroll
        for (int n = 0; n < 2; ++n) {
          const int fb = retk ? (64 * n + 16 * wc + 4 * fq) : (32 * wc + 16 * n + 4 * fq);
#pragma unroll
          for (int j = 0; j < 4; ++j) {
            const int f = fb + j;
            *(LAS u16*)(hl + f * 128 + ((((tok >> 3) ^ (f >> 2)) & 7) << 4) + (tok & 7) * 2) = f2bf(acc[AI][BJ][m][n][j] * dec);
          }
        }
      }
      u16* tbp; unsigned fstr;
      if (blk < 12) {
        u16* base = (blk < 8) ? p.krT() : p.vrT();
        const unsigned bh = (unsigned)(b * 4 + (blk & 3)) * 128u;
        tbp = samp ? base + 64u * 128u * 2048u + bh * 64u : base + bh * 2048u + tb;
        fstr = samp ? 64u : 2048u;
      } else {
        tbp = samp ? p.vaTS() + (unsigned)b * 128u * 2112u + 2048u : p.vaTP() + (unsigned)b * 128u * 2048u + tb;
        fstr = samp ? 2112u : 2048u;
      }
      EPI_BAR();
#pragma unroll
      for (int i = 0; i < 4; ++i) {
        const int f = 32 * wc + 8 * i + (lane >> 3), ch = lane & 7;
        const bf16x8 v = *(const LAS bf16x8*)(hl + f * 128 + (((ch ^ (f >> 2)) & 7) << 4));
        *(bf16x8*)(tbp + (unsigned)f * fstr + ch * 8) = v;
      }
      EPI_BAR();
    }
  }
  DI void operator()(f32x4 (&acc)[2][2][4][2], const pg8::Unit& u, int wr, int wc, int fr, int fq, int re) const {
    const bool samp = (u.pm * 256 >= NPROMPT);
    const int tclass = (u.pn < 4) ? 1 : ((u.pn == 8 || u.pn == 9 || u.pn == 10 || u.pn >= 13) ? 2 : 0);
    const int blk0 = u.pn * 2, blk1 = u.pn * 2 + 1;
    float rvv[2][4];
#pragma unroll
    for (int ai = 0; ai < 2; ++ai)
#pragma unroll
      for (int m = 0; m < 4; ++m) rvv[ai][m] = (1.f / REPK) * p.rinv()[u.pm * 256 + ai * 128 + wr * 64 + 16 * m + fr];
    f32x4 tc[4], ts[4];
    load_tabs(tc, ts, tclass, u.pm * 256 + wr * 64, samp, wc, fr, fq);
#pragma unroll
    for (int ai = 0; ai < 2; ++ai)
#pragma unroll
      for (int m = 0; m < 4; ++m)
#pragma unroll
        for (int bj = 0; bj < 2; ++bj)
#pragma unroll
          for (int n = 0; n < 2; ++n) acc[ai][bj][m][n] *= rvv[ai][m];
    compute<0, 0>(acc, tc, ts, blk0, wc, fq);
    compute<0, 1>(acc, tc, ts, blk1, wc, fq);
    load_tabs(tc, ts, tclass, u.pm * 256 + 128 + wr * 64, samp, wc, fr, fq);
    compute<1, 0>(acc, tc, ts, blk0, wc, fq);
    compute<1, 1>(acc, tc, ts, blk1, wc, fq);
    emit<0, 0>(acc, u, blk0, samp, wr, wc, fr, fq);
    emit<0, 1>(acc, u, blk1, samp, wr, wc, fr, fq);
    emit<1, 0>(acc, u, blk0, samp, wr, wc, fr, fq);
    emit<1, 1>(acc, u, blk1, samp, wr, wc, fr, fq);
  }
};

struct Epi2 {
  Params p; unsigned char* hl;
  DI void operator()(f32x4 (&acc)[2][2][4][2], const pg8::Unit& u, int wr, int wc, int fr, int fq, int re) const {
    u16* z = p.gate();
    const int lane = fr + 16 * fq;
#pragma unroll
    for (int ai = 0; ai < 2; ++ai)
#pragma unroll
      for (int bj = 0; bj < 2; ++bj) {
#pragma unroll
        for (int m = 0; m < 4; ++m)
#pragma unroll
          for (int n = 0; n < 2; ++n)
            *(s16x4*)(hl + hx_w(16 * m + fr, 8 * wc + 4 * n + fq)) = pack4(acc[ai][bj][m][n] * (1.f / REPK));
        EPI_BAR();
        const unsigned R0 = u.pm * 256 + ai * 128 + wr * 64;
        const unsigned cb = u.pn * 256 + bj * 128;
#pragma unroll
        for (int i = 0; i < 4; ++i) {
          const int row = 16 * wc + 4 * i + (lane >> 4), c16 = lane & 15;
          const bf16x8 v = *(const bf16x8*)(hl + hx_r(row, c16));
          *(bf16x8*)(z + (R0 + row) * 1024u + cb + c16 * 8) = v;
        }
        EPI_BAR();
      }
  }
};

DI void ret_kv_item(const Params& p, int item, int tid) {
  const int lane = tid & 63, w = tid >> 6, r = lane & 31, hh = lane >> 5;
  const u16 *kT, *vT; int T, c;
  if (item < 2048) { const int bh = item >> 5; c = item & 31; T = 2048; kT = p.krT() + (size_t)bh * 128 * 2048; vT = p.vrT() + (size_t)bh * 128 * 2048; }
  else { const int bh = item - 2048; c = 0; T = 64; kT = p.krT() + (size_t)64 * 128 * 2048 + (size_t)bh * 128 * 64; vT = p.vrT() + (size_t)64 * 128 * 2048 + (size_t)bh * 128 * 64; }
  const int e0 = (w & 1) * 64, d0 = (w >> 1) * 64;
  f32x16 acc[2][2];
  acc[0][0] = zero16(); acc[0][1] = zero16(); acc[1][0] = zero16(); acc[1][1] = zero16();
#pragma unroll
  for (int ks = 0; ks < 4; ++ks) {
    bf16x8 a0 = ldg8(vT + (size_t)(e0 + r) * T + c * 64 + ks * 16 + hh * 8);
    bf16x8 a1 = ldg8(vT + (size_t)(e0 + 32 + r) * T + c * 64 + ks * 16 + hh * 8);
    bf16x8 b0 = ldg8(kT + (size_t)(d0 + r) * T + c * 64 + ks * 16 + hh * 8);
    bf16x8 b1 = ldg8(kT + (size_t)(d0 + 32 + r) * T + c * 64 + ks * 16 + hh * 8);
    acc[0][0] = MFMA32(a0, b0, acc[0][0]);
    acc[0][1] = MFMA32(a0, b1, acc[0][1]);
    acc[1][0] = MFMA32(a1, b0, acc[1][0]);
    acc[1][1] = MFMA32(a1, b1, acc[1][1]);
  }
  u16* o = (u16*)p.kvT() + (size_t)item * 16384;
#pragma unroll
  for (int a = 0; a < 2; ++a)
#pragma unroll
    for (int b = 0; b < 2; ++b)
#pragma unroll
      for (int i = 0; i < 16; ++i)
        o[(e0 + a * 32 + crow(i, hh)) * 128 + d0 + b * 32 + r] = f2bf(acc[a][b][i]);
}

template <int NS>
DI void select_query(const u16* krow, int nj, int lane, u64* dst) {
  unsigned key[NS];
#pragma unroll
  for (int j = 0; j < NS; ++j) { const unsigned k = krow[j * 64 + lane]; key[j] = (j < nj) ? k : 0u; }
  constexpr int NP = (NS + 1) / 2;
  unsigned pk[NP];
#pragma unroll
  for (int i = 0; i < NP; ++i) pk[i] = key[2 * i] | ((2 * i + 1 < NS ? key[2 * i + 1] : 0u) << 16);
  unsigned prefix = 0;
  int cntp = 0;
  const unsigned ones = 0x00010001u;
  for (int bit = 15; bit >= 0; --bit) {
    const unsigned cand = prefix | (1u << bit);
    const unsigned c1 = cand - 1u;
    const unsigned cv = c1 | (c1 << 16);
    unsigned acc0 = 0, acc1 = 0;
#pragma unroll
    for (int i = 0; i < NP; ++i) {
      unsigned d, m;
      asm("v_pk_sub_u16 %0, %1, %2 clamp" : "=v"(d) : "v"(pk[i]), "v"(cv));
      asm("v_pk_min_u16 %0, %1, %2" : "=v"(m) : "v"(d), "v"(ones));
      if (i & 1) acc1 += m; else acc0 += m;
    }
    const unsigned a = acc0 + acc1;
    const int cnt = wave_sum((int)((a & 0xffffu) + (a >> 16)));
    if (cnt >= 256) { prefix = cand; cntp = cnt; }
    if (cnt == 256) break;
  }
  int wlo = 0, whi = 0;
  if (cntp == 256) {
#pragma unroll
    for (int j = 0; j < NS; ++j) {
      const u64 sm = __ballot(key[j] >= prefix);
      if (lane == j) { wlo = (int)(unsigned)sm; whi = (int)(unsigned)(sm >> 32); }
    }
  } else {
    int cgt = 0;
#pragma unroll
    for (int j = 0; j < NS; ++j) cgt += (key[j] > prefix) ? 1 : 0;
    cgt = wave_sum(cgt);
    const int rneed = 256 - cgt;
    int running = 0;
    const u64 lt = (1ull << lane) - 1ull;
#pragma unroll
    for (int j = 0; j < NS; ++j) {
      const bool eq = key[j] == prefix;
      const u64 em = __ballot(eq);
      const int rank = running + __popcll(em & lt);
      const bool sel = (key[j] > prefix) || (eq && rank < rneed);
      const u64 sm = __ballot(sel);
      if (lane == j) { wlo = (int)(unsigned)sm; whi = (int)(unsigned)(sm >> 32); }
      running += __popcll(em);
    }
  }
  if (lane < nj) dst[lane] = ((u64)(unsigned)whi << 32) | (u64)(unsigned)wlo;
}

DI void idx_item(const Params& p, unsigned char* lds, int tid, bool samp, int b, int grp) {
  const int lane = tid & 63, w = tid >> 6;
  const int t0 = grp * 16;
  int L, g0; const u16* ki;
  if (!samp) { const int c = t0 >> 6; L = (c + 1) * 64; g0 = b * 2048 + t0; ki = p.kiP() + (size_t)b * 2048 * 64; }
  else { L = 2112; g0 = NPROMPT + b * 64 + t0; ki = p.kiS() + (size_t)b * 2112 * 64; }
  const int nj = L >> 6;
  if (L <= 256) {
    for (int qq = 0; qq < 4; ++qq) {
      const int q = w * 4 + qq;
      if (lane < nj) p.maskbits()[(size_t)(g0 + q) * 33 + lane] = ~0ull;
    }
    return;
  }
  u16* keys = (u16*)lds;
#ifndef REPMF
#define REPMF 1
#endif
#ifndef REPSEL
#define REPSEL 1
#endif
#ifndef REPKV
#define REPKV 1
#endif
  for (int rmf = 0; rmf < REPMF; ++rmf) {
    const int qn = lane & 15, quad = lane >> 4;
    bf16x8 qf[8][2];
    float wv[8];
#pragma unroll
    for (int h = 0; h < 8; ++h) {
      qf[h][0] = ldg8(p.qi() + (size_t)(g0 + qn) * 512 + h * 64 + quad * 8);
      qf[h][1] = ldg8(p.qi() + (size_t)(g0 + qn) * 512 + h * 64 + 32 + quad * 8);
      wv[h] = p.wi()[(size_t)(g0 + qn) * 8 + h];
    }
    bf16x8 A0[4], A1[4], N0[4], N1[4];
#pragma unroll
    for (int i = 0; i < 4; ++i) {
      const int kt = w + 4 * i;
      A0[i] = ldg8(ki + (size_t)(kt * 16 + qn) * 64 + quad * 8);
      A1[i] = ldg8(ki + (size_t)(kt * 16 + qn) * 64 + 32 + quad * 8);
    }
    for (int base = 0; base < nj; base += 4) {
#pragma unroll
      for (int i = 0; i < 4; ++i) {
        const int t = min(base + 4 + i, nj - 1);
        const int kt = w + 4 * t;
        N0[i] = ldg8(ki + (size_t)(kt * 16 + qn) * 64 + quad * 8);
        N1[i] = ldg8(ki + (size_t)(kt * 16 + qn) * 64 + 32 + quad * 8);
      }
#pragma unroll
      for (int i = 0; i < 4; ++i) {
        const int t = base + i;
        if (t < nj) {
          const int kt = w + 4 * t;
          float idx[4] = {0.f, 0.f, 0.f, 0.f};
#pragma unroll
          for (int h = 0; h < 8; ++h) {
            f32x4 acc = {0.f, 0.f, 0.f, 0.f};
            acc = MFMA16(A0[i], qf[h][0], acc);
            acc = MFMA16(A1[i], qf[h][1], acc);
#pragma unroll
            for (int e = 0; e < 4; ++e) idx[e] += fmaxf(acc[e], 0.f) * wv[h];
          }
          s16x4 kv;
#pragma unroll
          for (int e = 0; e < 4; ++e) {
            _Float16 hv = (_Float16)idx[e];
            u16 bits = __builtin_bit_cast(u16, hv);
            kv[e] = (short)((bits & 0x8000) ? (u16)~bits : (u16)(bits | 0x8000));
          }
          *(s16x4*)(keys + qn * KPITCH + kt * 16 + quad * 4) = kv;
        }
      }
#pragma unroll
      for (int i = 0; i < 4; ++i) { A0[i] = N0[i]; A1[i] = N1[i]; }
    }
  }
  __syncthreads();
  for (int qq = 0; qq < 4 * REPSEL; ++qq) {
    const int q = w * 4 + (qq & 3);
    const u16* krow = keys + q * KPITCH;
    u64* dst = p.maskbits() + (size_t)(g0 + q) * 33;
    if (nj <= 8) select_query<8>(krow, nj, lane, dst);
    else if (nj <= 16) select_query<16>(krow, nj, lane, dst);
    else if (nj <= 24) select_query<24>(krow, nj, lane, dst);
    else select_query<33>(krow, nj, lane, dst);
  }
  __syncthreads();
}

DI void scan_item(const Params& p, int item, int tid) {
  if (item < 1024) {
    const int bh = item >> 4, slab = item & 15;
    const int idx = slab * 1024 + tid * 4;
    const int h = bh & 3;
    const float cd = exp2f(64.f * log2gamma(h));
    f32x4 s = {0.f, 0.f, 0.f, 0.f};
    for (int c0 = 0; c0 < 32; c0 += 8) {
      f32x4 kvb[8];
#pragma unroll
      for (int i = 0; i < 8; ++i) {
        const s16x4 kk = __builtin_nontemporal_load((const s16x4*)((const u16*)p.kvT() + (size_t)(bh * 32 + c0 + i) * 16384 + idx));
#pragma unroll
        for (int j = 0; j < 4; ++j) kvb[i][j] = __uint_as_float(((unsigned)(u16)kk[j]) << 16);
      }
#pragma unroll
      for (int i = 0; i < 8; ++i) {
        __builtin_nontemporal_store(pack4(s), (s16x4*)(p.sprevT() + (size_t)(bh * 32 + c0 + i) * 16384 + idx));
        s = s * cd + kvb[i];
      }
    }
    const int e = idx >> 7, d = idx & 127;
    float* o = p.out + OUT_STP + (size_t)bh * 16384;
#pragma unroll
    for (int j = 0; j < 4; ++j) o[(d + j) * 128 + e] = s[j];
  } else {
    const int it = item - 1024;
    const int bh = it >> 4, slab = it & 15;
    const int idx = slab * 1024 + tid * 4;
    const int h = bh & 3;
    const float cd = exp2f(64.f * log2gamma(h));
    const int e = idx >> 7, d = idx & 127;
    const float* s0 = p.state_ret + (size_t)bh * 16384;
    f32x4 s;
#pragma unroll
    for (int j = 0; j < 4; ++j) s[j] = s0[(d + j) * 128 + e];
    const size_t base = (size_t)(2048 + bh) * 16384 + idx;
    s16x4 o = pack4(s);
    *(s16x4*)(p.sprevT() + base) = o;
    const s16x4 kk = *(const s16x4*)((const u16*)p.kvT() + base);
    f32x4 kv;
#pragma unroll
    for (int j = 0; j < 4; ++j) kv[j] = __uint_as_float(((unsigned)(u16)kk[j]) << 16);
    s = s * cd + kv;
    float* oo = p.out + OUT_STS + (size_t)bh * 16384;
#pragma unroll
    for (int j = 0; j < 4; ++j) oo[(d + j) * 128 + e] = s[j];
  }
}

DI void attn_item(const Params& p, unsigned char* lds, int tid, bool samp, int b, int c, int kvh, int qh, unsigned char* lds_blk, int tid512) {
  const int lane = tid & 63, w = tid >> 6, r = lane & 31, hh = lane >> 5;
  const int T = samp ? 2112 : 2048;
  const int nkt = samp ? 33 : c + 1;
  const int g0 = (samp ? NPROMPT + b * 64 : b * 2048 + c * 64) + qh * 32;
  const u16* K = samp ? p.kaS() + (size_t)(b * 2 + kvh) * 2112 * 64 : p.kaP() + (size_t)(b * 2 + kvh) * 2048 * 64;
  const u16* VT = samp ? p.vaTS() + (size_t)(b * 2 + kvh) * 64 * 2112 : p.vaTP() + (size_t)(b * 2 + kvh) * 64 * 2048;
  const int head = kvh * 4 + w;
  u16* KV0 = (u16*)(lds_blk + 2 * HALF_LDS - 4 * 9216);
  u64* mL = (u64*)lds;
  {
    u64 mv[5];
#pragma unroll
    for (int i = 0; i < 5; ++i) { const int ix = tid + 256 * i; mv[i] = __builtin_nontemporal_load(p.maskbits() + (size_t)g0 * 33 + (ix < 32 * 33 ? ix : 32 * 33 - 1)); }
#pragma unroll
    for (int i = 0; i < 5; ++i) { const int ix = tid + 256 * i; if (ix < 32 * 33) mL[ix] = mv[i]; }
  }
  bf16x8 qf[4];
#pragma unroll
  for (int ks = 0; ks < 4; ++ks) qf[ks] = ldg8(p.qa() + (size_t)(g0 + r) * 512 + head * 64 + ks * 16 + hh * 8);
  f32x16 O[2];
  O[0] = zero16(); O[1] = zero16();
  float mrun = -1e30f, lrun = 0.f;
  const int lrow = tid512 >> 3, lch = tid512 & 7;
  const int loff = lrow * 72 + lch * 8;
  bf16x8 pk0, pv0, nk0, nv0;
  {
    const bf16x8 k0 = ldg8(K + (size_t)(lrow)*64 + lch * 8), v0 = ldg8(VT + (size_t)(lrow)*T + lch * 8);
    const int t1 = nkt > 1 ? 1 : 0, t2 = nkt > 2 ? 2 : (nkt - 1);
    pk0 = ldg8(K + (size_t)(t1 * 64 + lrow) * 64 + lch * 8); pv0 = ldg8(VT + (size_t)(lrow)*T + t1 * 64 + lch * 8);
    nk0 = ldg8(K + (size_t)(t2 * 64 + lrow) * 64 + lch * 8); nv0 = ldg8(VT + (size_t)(lrow)*T + t2 * 64 + lch * 8);
    *(bf16x8*)(KV0 + loff) = k0;
    *(bf16x8*)(KV0 + 64 * 72 + loff) = v0;
  }
  __syncthreads();
  for (int kt = 0; kt < nkt; ++kt) {
    if (kt + 1 < nkt) {
      u16* nb = KV0 + ((kt + 1) & 1) * (2 * 64 * 72);
      *(bf16x8*)(nb + loff) = pk0;
      *(bf16x8*)(nb + 64 * 72 + loff) = pv0;
    }
    pk0 = nk0; pv0 = nv0;
    {
      const int t3 = (kt + 3 < nkt) ? kt + 3 : nkt - 1;
      nk0 = ldg8(K + (size_t)(t3 * 64 + lrow) * 64 + lch * 8);
      nv0 = ldg8(VT + (size_t)(lrow)*T + t3 * 64 + lch * 8);
    }
    const u16* Ks = KV0 + (kt & 1) * (2 * 64 * 72);
    const u16* Vs = Ks + 64 * 72;
    f32x16 S[2];
#pragma unroll
    for (int st = 0; st < 2; ++st) {
      S[st] = zero16();
#pragma unroll
      for (int ks = 0; ks < 4; ++ks) {
        bf16x8 kf = *(const bf16x8*)(Ks + (st * 32 + r) * 72 + ks * 16 + hh * 8);
        S[st] = MFMA32(kf, qf[ks], S[st]);
      }
    }
    const u64 W = mL[r * 33 + kt];
    const int wl = (int)(((unsigned)W) >> (4 * hh)), wh = (int)(((unsigned)(W >> 32)) >> (4 * hh));
    float mx = fmaxf(S[0][0], S[1][0]);
#pragma unroll
    for (int i = 1; i < 16; ++i) mx = fmaxf(mx, fmaxf(S[0][i], S[1][i]));
    mx = fmaxf(mx, __shfl_xor(mx, 32));
    const float mn = fmaxf(mrun, mx);
    const float alpha = __builtin_amdgcn_exp2f(mrun - mn);
    const bool resc = __any(mn != mrun);
    mrun = mn;
    float ls = 0.f;
#pragma unroll
    for (int st = 0; st < 2; ++st)
#pragma unroll
      for (int i = 0; i < 16; ++i) {
        const int keep = __builtin_amdgcn_sbfe(st ? wh : wl, (i & 3) + 8 * (i >> 2), 1);
        const float pvv = __int_as_float(__float_as_int(__builtin_amdgcn_exp2f(S[st][i] - mn)) & keep);
        S[st][i] = pvv;
        ls += pvv;
      }
    lrun = lrun * alpha + ls;
    if (resc) {
#pragma unroll
      for (int dt = 0; dt < 2; ++dt)
#pragma unroll
        for (int i = 0; i < 16; ++i) O[dt][i] *= alpha;
    }
#pragma unroll
    for (int st = 0; st < 2; ++st)
#pragma unroll
      for (int s2 = 0; s2 < 2; ++s2) {
        bf16x8 pf = pack8(S[st][8 * s2 + 0], S[st][8 * s2 + 1], S[st][8 * s2 + 2], S[st][8 * s2 + 3],
                          S[st][8 * s2 + 4], S[st][8 * s2 + 5], S[st][8 * s2 + 6], S[st][8 * s2 + 7]);
#pragma unroll
        for (int dt = 0; dt < 2; ++dt) {
          s16x4 lo = *(const s16x4*)(Vs + (dt * 32 + r) * 72 + st * 32 + 16 * s2 + 4 * hh);
          s16x4 hi = *(const s16x4*)(Vs + (dt * 32 + r) * 72 + st * 32 + 16 * s2 + 8 + 4 * hh);
          bf16x8 vf = __builtin_shufflevector(lo, hi, 0, 1, 2, 3, 4, 5, 6, 7);
          O[dt] = MFMA32(vf, pf, O[dt]);
        }
      }
    __syncthreads();
  }
  {
    float lt = lrun + __shfl_xor(lrun, 32);
    const float inv = 1.f / fmaxf(lt, 1e-30f);
    const u16* grow = p.gate() + (size_t)(g0 + r) * 1024 + 512 + head * 64;
    u16* mrow = p.mix() + (size_t)(g0 + r) * 1024 + 512 + head * 64;
    s16x4 gvv[2][4];
#pragma unroll
    for (int dt = 0; dt < 2; ++dt)
#pragma unroll
      for (int q4 = 0; q4 < 4; ++q4) gvv[dt][q4] = *(const s16x4*)(grow + dt * 32 + 8 * q4 + 4 * hh);
#pragma unroll
    for (int dt = 0; dt < 2; ++dt)
#pragma unroll
      for (int q4 = 0; q4 < 4; ++q4) {
        const int d = dt * 32 + 8 * q4 + 4 * hh;
        f32x4 of;
#pragma unroll
        for (int j = 0; j < 4; ++j) {
          const float gf = __uint_as_float(((unsigned)(u16)gvv[dt][q4][j]) << 16);
          of[j] = O[dt][q4 * 4 + j] * inv * gf;
        }
        *(s16x4*)(mrow + d) = pack4(of);
      }
  }
  __syncthreads();
}

DI void ret_out_item(const Params& p, unsigned char* lds, int item, int tid) {
  const int lane = tid & 63, w = tid >> 6, r = lane & 31, hh = lane >> 5;
  int bh, c, T, g0; const u16* vT;
  if (item < 2048) { bh = item >> 5; c = item & 31; T = 2048; g0 = (bh >> 2) * 2048 + c * 64; vT = p.vrT() + (size_t)bh * 128 * 2048; }
  else { bh = item - 2048; c = 0; T = 64; g0 = NPROMPT + (bh >> 2) * 64; vT = p.vrT() + (size_t)64 * 128 * 2048 + (size_t)bh * 128 * 64; }
  const int h = bh & 3;
  const float l2g = log2gamma(h);
  const int nt = w & 1, eh = w >> 1;
  const int n = nt * 32 + r;
  bf16x8 qf[8], kf[8];
#pragma unroll
  for (int ks = 0; ks < 8; ++ks) qf[ks] = ldg8(p.qr() + (size_t)(g0 + n) * 512 + h * 128 + ks * 16 + hh * 8);
#pragma unroll
  for (int ks = 0; ks < 8; ++ks) kf[ks] = ldg8(p.kr() + (size_t)(g0 + r) * 512 + h * 128 + ks * 16 + hh * 8);
  __builtin_amdgcn_sched_barrier(0);
  bf16x8 pf[2][2];
#pragma unroll
  for (int mt = 0; mt < 2; ++mt) {
    f32x16 S = zero16();
#pragma unroll
    for (int ks = 0; ks < 8; ++ks) S = MFMA32(kf[ks], qf[ks], S);
    if (mt == 0) {
#pragma unroll
      for (int ks = 0; ks < 8; ++ks) kf[ks] = ldg8(p.kr() + (size_t)(g0 + 32 + r) * 512 + h * 128 + ks * 16 + hh * 8);
      __builtin_amdgcn_sched_barrier(0);
    }
#pragma unroll
    for (int i = 0; i < 16; ++i) {
      const int m = mt * 32 + crow(i, hh);
      const int dd = n > m ? n - m : m - n;
      S[i] *= exp2f((float)dd * l2g);
    }
    pf[mt][0] = pack8(S[0], S[1], S[2], S[3], S[4], S[5], S[6], S[7]);
    pf[mt][1] = pack8(S[8], S[9], S[10], S[11], S[12], S[13], S[14], S[15]);
  }
  const float fs = exp2f((float)(n + 1) * l2g);
  const u16* sp = p.sprevT() + (size_t)item * 16384;
  f32x16 tot[2];
  float ss = 0.f;
  s16x4 vlo[2][2][2], vhi[2][2][2];
#pragma unroll
  for (int et = 0; et < 2; ++et)
#pragma unroll
    for (int mt = 0; mt < 2; ++mt)
#pragma unroll
      for (int s2 = 0; s2 < 2; ++s2) {
        const u16* vp = vT + (size_t)((2 * eh + et) * 32 + r) * T + c * 64 + mt * 32 + 16 * s2 + 4 * hh;
        vlo[et][mt][s2] = ldg4(vp); vhi[et][mt][s2] = ldg4(vp + 8);
      }
  __builtin_amdgcn_sched_barrier(0);
#pragma unroll
  for (int et = 0; et < 2; ++et) {
    const int e = (2 * eh + et) * 32 + r;
    bf16x8 sf[8];
#pragma unroll
    for (int ks = 0; ks < 8; ++ks) sf[ks] = ldg8(sp + (size_t)e * 128 + ks * 16 + hh * 8);
    __builtin_amdgcn_sched_barrier(0);
    f32x16 Oi = zero16(), X = zero16();
#pragma unroll
    for (int mt = 0; mt < 2; ++mt)
#pragma unroll
      for (int s2 = 0; s2 < 2; ++s2) {
        bf16x8 vf = __builtin_shufflevector(vlo[et][mt][s2], vhi[et][mt][s2], 0, 1, 2, 3, 4, 5, 6, 7);
        Oi = MFMA32(vf, pf[mt][s2], Oi);
      }
#pragma unroll
    for (int ks = 0; ks < 8; ++ks) X = MFMA32(sf[ks], qf[ks], X);
#pragma unroll
    for (int i = 0; i < 16; ++i) { const float t = Oi[i] + X[i] * fs; tot[et][i] = t; ss += t * t; }
  }
  ss += __shfl_xor(ss, 32);
  float* red = (float*)lds;
  __syncthreads();
  if (hh == 0) red[w * 32 + r] = ss;
  __syncthreads();
  const float tsum = red[w * 32 + r] + red[(w ^ 2) * 32 + r];
  const float rinv = rsqrtf(tsum * (1.f / 128.f) + 1e-6f);
  const u16* grow = p.gate() + (size_t)(g0 + n) * 1024 + h * 128;
  u16* mrow = p.mix() + (size_t)(g0 + n) * 1024 + h * 128;
  s16x4 gvv[2][4];
  f32x4 ggv[2][4];
#pragma unroll
  for (int et = 0; et < 2; ++et)
#pragma unroll
    for (int q4 = 0; q4 < 4; ++q4) {
      const int e = (2 * eh + et) * 32 + 8 * q4 + 4 * hh;
      gvv[et][q4] = *(const s16x4*)(grow + e);
      ggv[et][q4] = *(const f32x4*)(p.ret_gn_g + h * 128 + e);
    }
#pragma unroll
  for (int et = 0; et < 2; ++et)
#pragma unroll
    for (int q4 = 0; q4 < 4; ++q4) {
      const int e = (2 * eh + et) * 32 + 8 * q4 + 4 * hh;
      f32x4 of;
#pragma unroll
      for (int j = 0; j < 4; ++j) {
        const float gf = __uint_as_float(((unsigned)(u16)gvv[et][q4][j]) << 16);
        of[j] = tot[et][q4 * 4 + j] * rinv * ggv[et][q4][j] * gf;
      }
      *(s16x4*)(mrow + e) = pack4(of);
    }
}

DI void phase_final(const Params& p, int tid) {
  const int gt = blockIdx.x * 512 + tid, GT = gridDim.x * 512;
  const int lane = tid & 63;
  for (int row0 = (gt >> 6) * 2; row0 < NTOK; row0 += (GT >> 6) * 2) {
    f32x4 v[2][4];
    s16x4 zz[2][4];
#pragma unroll
    for (int rr = 0; rr < 2; ++rr) {
      const float* xr = xrow(p, row0 + rr);
      const u16* zr = p.gate() + (size_t)(row0 + rr) * 1024;
#pragma unroll
      for (int i = 0; i < 4; ++i) { v[rr][i] = __builtin_nontemporal_load((const f32x4*)(xr + i * 256 + lane * 4)); zz[rr][i] = __builtin_nontemporal_load((const s16x4*)(zr + i * 256 + lane * 4)); }
    }
    f32x4 g[4];
#pragma unroll
    for (int i = 0; i < 4; ++i) g[i] = *(const f32x4*)(p.final_g + i * 256 + lane * 4);
#pragma unroll
    for (int rr = 0; rr < 2; ++rr) {
      float ss = 0.f;
#pragma unroll
      for (int i = 0; i < 4; ++i) {
#pragma unroll
        for (int j = 0; j < 4; ++j) v[rr][i][j] += __uint_as_float(((unsigned)(u16)zz[rr][i][j]) << 16);
        ss += v[rr][i][0] * v[rr][i][0] + v[rr][i][1] * v[rr][i][1] + v[rr][i][2] * v[rr][i][2] + v[rr][i][3] * v[rr][i][3];
      }
#pragma unroll
      for (int o = 32; o >= 1; o >>= 1) ss += __shfl_xor(ss, o);
      const float rv = rsqrtf(ss * (1.f / 1024.f) + 1e-6f);
      float* y = p.out + OUT_Y + (size_t)(row0 + rr) * 1024;
#pragma unroll
      for (int i = 0; i < 4; ++i) __builtin_nontemporal_store(v[rr][i] * rv * g[i], (f32x4*)(y + i * 256 + lane * 4));
    }
  }
}

#ifndef REP0
#define REP0 1
#endif
#ifndef REP1
#define REP1 1
#endif
#ifndef REP2
#define REP2 1
#endif
#ifndef REP3
#define REP3 1
#endif
#ifndef REP4
#define REP4 1
#endif
#ifndef REP5
#define REP5 1
#endif
__global__ void __launch_bounds__(512, 2) fwd_megakernel(Params p) {
  __shared__ __attribute__((aligned(16))) unsigned char lds[LDS_BYTES];
  cg::grid_group grid = cg::this_grid();
  const int wave_id = __builtin_amdgcn_readfirstlane((int)threadIdx.x >> 6);
#define FRESH_TID() int tid = wave_id * 64 + lane_id(); asm volatile("" : "+v"(tid)); const int half = tid >> 8, htid = tid & 255; unsigned char* ldsh = lds + half * HALF_LDS; (void)htid; (void)ldsh;
  if (p.out == nullptr) grid.sync();
  if (wave_id == 0 && lane_id() == 0) (void)xb_add(&p.bar()[XB_XCNT(xb_xcc_id())], 1u);
  for (int rep = 0; rep < REP0; ++rep) {
  { FRESH_TID(); phase_prep(p, tid); }
  xcd_barrier(p.bar(), wave_id);
  }
  for (int rep = 0; rep < REP1; ++rep) {
  {
    FRESH_TID();
    pg8::Gemm g; g.A = p.xb(); g.Bt = p.WtIn(); g.M = NTOK; g.N = 4096; g.K = 1024;
    pg8::StaticOrder S; S.init(g.M, g.N, (int)gridDim.x, (int)blockIdx.x); S.permtab = 0xEFBCD87694105A32ull; S.padtile = 15;
    Epi1 E; E.p = p; E.hl0 = (LAS unsigned char*)lds + pg8::STAGE_BYTES;
    pg8::gemm_phase<Epi1>((LAS unsigned char*)lds, g, S, E, wave_id);
  }
  xcd_barrier(p.bar(), wave_id);
  }
  for (int rep = 0; rep < REP2; ++rep) {
  {
    FRESH_TID();
    for (int it0 = blockIdx.x * 2; it0 < 2080 + 2080; it0 += gridDim.x * 2) {
      const int it = it0 + half;
      int ht = htid; asm volatile("" : "+v"(ht));
      if (it < 2080) {
        const bool samp = it < 32;
        const int j = it - 32;
        const int c = 31 - (j >> 6);
        const int b = samp ? (it >> 2) : ((j & 63) >> 2);
        const int grp = samp ? (it & 3) : (c * 4 + (j & 3));
        idx_item(p, ldsh, ht, samp, b, grp);
      } else { for (int rkv = 0; rkv < REPKV; ++rkv) ret_kv_item(p, it - 2080, ht); }
    }
  }
  xcd_barrier(p.bar(), wave_id);
  }
  for (int rep = 0; rep < REP3; ++rep) {
  {
    FRESH_TID();
    for (int it0 = blockIdx.x * 2; it0 < 1056 + 1536; it0 += gridDim.x * 2) {
      const int it = it0 + half;
      int ht = htid; asm volatile("" : "+v"(ht));
      if (it < 1056) {
        const bool samp = it < 32;
        const int j = it - 32;
        int c = samp ? 0 : 31 - (j >> 6);
        int b = samp ? (it >> 2) : ((j & 63) >> 2);
        int kvh = (it >> 1) & 1;
        if (!samp && gridDim.x == 256) {
          const int jb = (j >> 1) & 255, rnd = j >> 9;
          const int xcd = jb & 7, ii = jb >> 3;
          b = 2 * xcd + (ii & 1); kvh = (ii >> 1) & 1; c = 31 - rnd * 8 - (ii >> 2);
        }
        attn_item(p, ldsh, ht, samp, b, c, kvh, it & 1, lds, tid);
      } else scan_item(p, it - 1056, ht);
    }
  }
  xcd_barrier(p.bar(), wave_id);
  }
  for (int rep = 0; rep < REP4; ++rep) {
  {
    FRESH_TID();
    for (int it0 = blockIdx.x * 2; it0 < 2080 + 1024; it0 += gridDim.x * 2) {
      const int it = it0 + half;
      int ht = htid; asm volatile("" : "+v"(ht));
      if (it < 2080) ret_out_item(p, ldsh, it, ht);
      else {
        const int ia = it - 2080 + 1056;
        const int j = ia - 32;
        int c = 31 - (j >> 6);
        int b = (j & 63) >> 2;
        int kvh = (ia >> 1) & 1;
        if (gridDim.x == 256) {
          const int jb = (j >> 1) & 255, rnd = j >> 9;
          const int xcd = jb & 7, ii = jb >> 3;
          b = 2 * xcd + (ii & 1); kvh = (ii >> 1) & 1; c = 31 - rnd * 8 - (ii >> 2);
        }
        attn_item(p, ldsh, ht, false, b, c, kvh, ia & 1, lds, tid);
      }
    }
  }
  xcd_barrier(p.bar(), wave_id);
  }
  for (int rep = 0; rep < REP5; ++rep) {
  {
    pg8::Gemm g; g.A = p.mix(); g.Bt = p.WtOut(); g.M = NTOK; g.N = 1024; g.K = 1024;
    pg8::StaticOrder S; S.init(g.M, g.N, (int)gridDim.x, (int)blockIdx.x);
    Epi2 E; E.p = p; E.hl = lds + pg8::STAGE_BYTES + (wave_id >> 2) * 16384;
    pg8::gemm_phase<Epi2>((LAS unsigned char*)lds, g, S, E, wave_id);
  }
  xcd_barrier(p.bar(), wave_id);
  }
  { FRESH_TID(); phase_final(p, tid); }
}

extern "C" void kernel_launch(void* const* d_in, const int* in_sizes, int n_in, void* d_out, int out_size, void* d_ws,
                              size_t ws_size, hipStream_t stream) {
  static int grid_blocks = 0;
  if (!grid_blocks) {
    int dev = 0, cus = 0, per_cu = 0;
    (void)hipGetDevice(&dev);
    (void)hipDeviceGetAttribute(&cus, hipDeviceAttributeMultiprocessorCount, dev);
    (void)hipOccupancyMaxActiveBlocksPerMultiprocessor(&per_cu, fwd_megakernel, 512, 0);
    if (per_cu < 1) per_cu = 1;
    if (per_cu > 1) per_cu = 1;
    grid_blocks = cus * per_cu;
  }
  Params p{};
  p.x_p = (const float*)d_in[0]; p.x_s = (const float*)d_in[1]; p.state_ret = (const float*)d_in[2];
  p.cache_k = (const float*)d_in[3]; p.cache_v = (const float*)d_in[4]; p.cache_kidx = (const float*)d_in[5];
  p.norm_g = (const float*)d_in[6]; p.w_in = (const float*)d_in[7]; p.ret_gn_g = (const float*)d_in[8];
  p.w_out = (const float*)d_in[9]; p.final_g = (const float*)d_in[10];
  p.out = (float*)d_out;
  p.ws = (unsigned char*)d_ws;
  (void)hipMemsetAsync((unsigned char*)d_ws + 530573312ull, 0, (size_t)XCD_BAR_WORDS * 4, stream);
  void* args[] = {&p};
  hipError_t e = hipLaunchCooperativeKernel((void*)fwd_megakernel, dim3(grid_blocks), dim3(512), args, 0, stream);
  if (e != hipSuccess) fprintf(stderr, "cooperative launch failed: %s (grid %d)\n", hipGetErrorString(e), grid_blocks);
}
```

```cpp
#include <hip/hip_runtime.h>
#include <hip/hip_cooperative_groups.h>
#include <stdint.h>
#include <cstdio>
namespace cg = cooperative_groups;

typedef __attribute__((ext_vector_type(8))) short bf16x8;
typedef __attribute__((ext_vector_type(4))) short s16x4;
typedef __attribute__((ext_vector_type(16))) float f32x16;
typedef __attribute__((ext_vector_type(4))) float f32x4;
typedef unsigned short u16;
typedef unsigned long long u64;


#define DI __device__ __forceinline__
#define MFMA32(a, b, c) __builtin_amdgcn_mfma_f32_32x32x16_bf16((a), (b), (c), 0, 0, 0)
#define MFMA16(a, b, c) __builtin_amdgcn_mfma_f32_16x16x32_bf16((a), (b), (c), 0, 0, 0)

#define NTOK 33280
#define NPROMPT 32768
#define LDS_BYTES 163840
#define HALF_LDS 81920
#define LAS __attribute__((address_space(3)))
#define KPITCH 2116

struct Params {
  const float *x_p, *x_s, *state_ret, *cache_k, *cache_v, *cache_kidx, *norm_g, *w_in, *ret_gn_g, *w_out, *final_g;
  float* out;
  unsigned char* ws;
  DI u16* xb() const { return (u16*)(ws + 0ull); }
  DI float* kvT() const { return (float*)(ws + 0ull); }
  DI u16* WtIn() const { return (u16*)(ws + 136314880ull); }
  DI u16* WtOut() const { return (u16*)(ws + 144703488ull); }
  DI u16* qr() const { return (u16*)(ws + 146800640ull); }
  DI u16* kr() const { return (u16*)(ws + 180879360ull); }
  DI u16* sprevT() const { return (u16*)(ws + 214958080ull); }
  DI u16* qi() const { return (u16*)(ws + 214958080ull); }
  DI u16* krT() const { return (u16*)(ws + 249036800ull); }
  DI u16* vrT() const { return (u16*)(ws + 283115520ull); }
  DI u16* gate() const { return (u16*)(ws + 317194240ull); }
  DI u16* mix() const { return (u16*)(ws + 385351680ull); }
  DI u16* qa() const { return (u16*)(ws + 453509120ull); }
  DI u16* kaP() const { return (u16*)(ws + 487587840ull); }
  DI u16* kaS() const { return (u16*)(ws + 495976448ull); }
  DI u16* vaTP() const { return (u16*)(ws + 500301824ull); }
  DI u16* vaTS() const { return (u16*)(ws + 508690432ull); }
  DI u16* kiP() const { return (u16*)(ws + 513015808ull); }
  DI u16* kiS() const { return (u16*)(ws + 517210112ull); }
  DI float* rinv() const { return (float*)(ws + 519372800ull); }
  DI float* wi() const { return (float*)(ws + 519505920ull); }
  DI float* cosR() const { return (float*)(ws + 520570880ull); }
  DI float* sinR() const { return (float*)(ws + 521111552ull); }
  DI float* cosA() const { return (float*)(ws + 521652224ull); }
  DI float* sinA() const { return (float*)(ws + 521719808ull); }
  DI unsigned* bar() const { return (unsigned*)(ws + 530573312ull); }
  DI u64* maskbits() const { return (u64*)(ws + 521787392ull); }
};

#define OUT_Y 0
#define OUT_STP (34078720)
#define OUT_KP (OUT_STP + 1048576)
#define OUT_VP (OUT_KP + 4194304)
#define OUT_KIP (OUT_VP + 4194304)
#define OUT_STS (OUT_KIP + 2097152)
#define OUT_KS (OUT_STS + 524288)
#define OUT_VS (OUT_KS + 65536)
#define OUT_KIS (OUT_VS + 65536)

typedef __bf16 bf16x2_t __attribute__((ext_vector_type(2)));
typedef float f32x2_t __attribute__((ext_vector_type(2)));
typedef unsigned u32x4_t __attribute__((ext_vector_type(4)));
typedef unsigned u32x2_t __attribute__((ext_vector_type(2)));
DI unsigned pk2(float a, float b) { f32x2_t v = {a, b}; bf16x2_t r = __builtin_convertvector(v, bf16x2_t); return __builtin_bit_cast(unsigned, r); }
DI u16 f2bf(float x) { return (u16)(pk2(x, x) & 0xffffu); }
DI bf16x8 ldg8(const u16* p) { return *(const bf16x8*)p; }
DI s16x4 ldg4(const u16* p) { return *(const s16x4*)p; }
DI float siluf(float x) { return x * __builtin_amdgcn_rcpf(1.f + __builtin_amdgcn_exp2f(-1.4426950408889634f * x)); }
DI int lane_id() { return (int)__builtin_amdgcn_mbcnt_hi(~0u, __builtin_amdgcn_mbcnt_lo(~0u, 0u)); }
DI int crow(int reg, int hh) { return (reg & 3) + 8 * (reg >> 2) + 4 * hh; }
DI const float* xrow(const Params& p, int g) { return g < NPROMPT ? p.x_p + (size_t)g * 1024 : p.x_s + (size_t)(g - NPROMPT) * 1024; }
DI float log2gamma(int h) { return log1pf(-exp2f(-5.f - (float)h)) * 1.4426950408889634f; }
DI bf16x8 pack8(float a0, float a1, float a2, float a3, float a4, float a5, float a6, float a7) {
  u32x4_t v = {pk2(a0, a1), pk2(a2, a3), pk2(a4, a5), pk2(a6, a7)};
  return __builtin_bit_cast(bf16x8, v);
}
DI s16x4 pack4(f32x4 v) { u32x2_t o = {pk2(v[0], v[1]), pk2(v[2], v[3])}; return __builtin_bit_cast(s16x4, o); }
DI int wave_sum(int v) {
  v += __builtin_amdgcn_update_dpp(0, v, 0xB1, 0xf, 0xf, false);
  v += __builtin_amdgcn_update_dpp(0, v, 0x4E, 0xf, 0xf, false);
  v += __builtin_amdgcn_update_dpp(0, v, 0x124, 0xf, 0xf, false);
  v += __builtin_amdgcn_update_dpp(0, v, 0x128, 0xf, 0xf, false);
  return __builtin_amdgcn_readlane(v, 0) + __builtin_amdgcn_readlane(v, 16) + __builtin_amdgcn_readlane(v, 32) + __builtin_amdgcn_readlane(v, 48);
}
DI f32x16 zero16() { f32x16 z; for (int i = 0; i < 16; ++i) z[i] = 0.f; return z; }

#define XB_TMO      128
#define XB_XCNT(j)  (256  + 64 * (j))
#define XB_XSUB(j)  (1280 + 64 * (j))
#define XB_XGEN(j)  (2304 + 64 * (j))
#define XB_TOP      3328
#define XB_TOPGEN   3392
#define XB_WG(i)    (3456 + 64 * (i))
#define XCD_BAR_WORDS (3456 + 64 * 256)
#define XB_SPIN_CAP (1u << 18)
DI unsigned xb_ld(unsigned* p) { return __hip_atomic_load(p, __ATOMIC_RELAXED, __HIP_MEMORY_SCOPE_AGENT); }
DI unsigned xb_add(unsigned* p, unsigned v) { return __hip_atomic_fetch_add(p, v, __ATOMIC_RELAXED, __HIP_MEMORY_SCOPE_AGENT); }
DI unsigned xb_xcc_id() { return (unsigned)__builtin_amdgcn_s_getreg((3 << 11) | 20) & 0xFu; }
#define XB_SPIN(cond, bar) do { unsigned _sp = 0; while (cond) { __builtin_amdgcn_s_sleep(1); \
    if ((++_sp & 255u) == 0u) { if (xb_ld(&(bar)[XB_TMO])) break; if (_sp > XB_SPIN_CAP) { atomicAdd(&(bar)[XB_TMO], 1u); break; } } } } while (0)
DI void xcd_barrier(unsigned* bar, int wave_id) {
  asm volatile("s_waitcnt vmcnt(0)" ::: "memory");
  __syncthreads();
  if (wave_id == 0) {
    int lane = lane_id(); asm volatile("" : "+v"(lane));
    const unsigned x = xb_xcc_id();
    unsigned* slot = &bar[XB_WG(blockIdx.x)];
    unsigned nloc = 0u, nx = 0u;
    if (lane < 2) nloc = xb_ld(slot + lane);
    nx = (unsigned)__builtin_amdgcn_readlane((int)nloc, 1);
    nloc = (unsigned)__builtin_amdgcn_readlane((int)nloc, 0);
    if (nloc == 0u) {
      const unsigned G = gridDim.x * gridDim.y * gridDim.z;
      unsigned sp = 0u, c = 0u;
      for (;;) {
        c = (lane < 16) ? xb_ld(&bar[XB_XCNT(lane)]) : 0u;
        const unsigned sum = (unsigned)wave_sum((int)c);
        if (sum == G) break;
        __builtin_amdgcn_s_sleep(1);
        if ((++sp & 255u) == 0u) { if (xb_ld(&bar[XB_TMO])) break; if (sp > XB_SPIN_CAP) { if (lane == 0) atomicAdd(&bar[XB_TMO], 1u); break; } }
      }
      nx = (unsigned)__popcll(__ballot(c > 0u));
      nloc = (unsigned)__builtin_amdgcn_readlane((int)c, (int)x);
      nloc = nloc > 0u ? nloc : 1u; nx = nx > 0u ? nx : 1u;
      if (lane == 0) { __hip_atomic_store(slot, nloc, __ATOMIC_RELAXED, __HIP_MEMORY_SCOPE_AGENT); __hip_atomic_store(slot + 1, nx, __ATOMIC_RELAXED, __HIP_MEMORY_SCOPE_AGENT); }
    }
    if (lane == 0) {
      __builtin_amdgcn_s_waitcnt(0);
      const unsigned old = xb_add(&bar[XB_XSUB(x)], 1u);
      const unsigned gen = old / nloc;
      if (old + 1u == (gen + 1u) * nloc) {
        __builtin_amdgcn_fence(__ATOMIC_RELEASE, "agent");
        asm volatile("s_waitcnt vmcnt(0)" ::: "memory");
        const unsigned og = xb_add(&bar[XB_TOP], 1u);
        const unsigned tg = og / nx;
        if (og + 1u == (tg + 1u) * nx) xb_add(&bar[XB_TOPGEN], 1u);
        else XB_SPIN(xb_ld(&bar[XB_TOPGEN]) == tg, bar);
        __builtin_amdgcn_fence(__ATOMIC_ACQUIRE, "agent");
        xb_add(&bar[XB_XGEN(x)], 1u);
        asm volatile("s_waitcnt vmcnt(0)" ::: "memory");
      } else {
        XB_SPIN(xb_ld(&bar[XB_XGEN(x)]) == gen, bar);
        __builtin_amdgcn_fence(__ATOMIC_ACQUIRE, "agent");
        asm volatile("s_waitcnt vmcnt(0)" ::: "memory");
      }
    }
  }
  __syncthreads();
}

DI void phase_prep(const Params& p, int tid) {
  const int gt = blockIdx.x * 512 + tid, GT = gridDim.x * 512;
  const int lane = tid & 63;
  for (int row0 = (gt >> 6) * 2; row0 < NTOK; row0 += (GT >> 6) * 2) {
    f32x4 v[2][4];
#pragma unroll
    for (int rr = 0; rr < 2; ++rr) {
      const float* sp = xrow(p, row0 + rr);
#pragma unroll
      for (int i = 0; i < 4; ++i) v[rr][i] = __builtin_nontemporal_load((const f32x4*)(sp + i * 256 + lane * 4));
    }
#pragma unroll
    for (int rr = 0; rr < 2; ++rr) {
      float ss = 0.f;
#pragma unroll
      for (int i = 0; i < 4; ++i) ss += v[rr][i][0] * v[rr][i][0] + v[rr][i][1] * v[rr][i][1] + v[rr][i][2] * v[rr][i][2] + v[rr][i][3] * v[rr][i][3];
#pragma unroll
      for (int o = 32; o >= 1; o >>= 1) ss += __shfl_xor(ss, o);
#pragma unroll
      for (int i = 0; i < 4; ++i) *(s16x4*)(p.xb() + (size_t)(row0 + rr) * 1024 + i * 256 + lane * 4) = pack4(v[rr][i]);
      if (lane == 0) p.rinv()[row0 + rr] = rsqrtf(ss * (1.f / 1024.f) + 1e-6f);
    }
  }
  for (int i = gt; i < 4096 * 128; i += GT) {
    int n = i & 4095, kg = i >> 12;
    int sc = n;
    if (n < 1024) { const int P = n & 127; sc = (n & ~127) + 64 * ((P >> 4) & 1) + 16 * (P >> 5) + (P & 15); }
    float a[8];
    const float vmask = (n < 3912) ? 1.f : 0.f; const int scc = (sc < 3912) ? sc : 3911;
#pragma unroll
    for (int j = 0; j < 8; ++j) a[j] = p.w_in[(size_t)(kg * 8 + j) * 3912 + scc] * p.norm_g[kg * 8 + j] * vmask;
    *(bf16x8*)(p.WtIn() + (size_t)n * 1024 + kg * 8) = pack8(a[0], a[1], a[2], a[3], a[4], a[5], a[6], a[7]);
  }
  for (int i = gt; i < 1024 * 128; i += GT) {
    int n = i % 1024, kg = i / 1024;
    float a[8];
#pragma unroll
    for (int j = 0; j < 8; ++j) a[j] = p.w_out[(size_t)(kg * 8 + j) * 1024 + n];
    *(bf16x8*)(p.WtOut() + (size_t)n * 1024 + kg * 8) = pack8(a[0], a[1], a[2], a[3], a[4], a[5], a[6], a[7]);
  }
  for (int i = gt; i < 2112 * 64; i += GT) {
    int pos = i >> 6, k = i & 63;
    float inv = powf(10000.f, -(float)k / 64.f);
    float ang = (float)pos * inv;
    p.cosR()[i] = cosf(ang); p.sinR()[i] = sinf(ang);
  }
  for (int i = gt; i < 2112 * 8; i += GT) {
    int pos = i >> 3, k = i & 7;
    float inv = powf(500000.f, -(float)k / 8.f);
    float ang = (float)pos * inv;
    p.cosA()[i] = cosf(ang); p.sinA()[i] = sinf(ang);
  }
  for (int i = gt; i < 8 * 2048 * 2 * 8; i += GT) {
    int dg = i & 7, kvh = (i >> 3) & 1, t = (i >> 4) & 2047, b = i >> 15;
    const float* s = p.cache_k + ((size_t)(b * 2048 + t) * 2 + kvh) * 64 + dg * 8;
    *(bf16x8*)(p.kaS() + ((size_t)(b * 2 + kvh) * 2112 + t) * 64 + dg * 8) = pack8(s[0], s[1], s[2], s[3], s[4], s[5], s[6], s[7]);
  }
  for (int i = gt; i < 8 * 2 * 256 * 64; i += GT) {
    int d = i & 63, tg = (i >> 6) & 255, kvh = (i >> 14) & 1, b = i >> 15;
    float a[8];
#pragma unroll
    for (int j = 0; j < 8; ++j) a[j] = p.cache_v[((size_t)(b * 2048 + tg * 8 + j) * 2 + kvh) * 64 + d];
    *(bf16x8*)(p.vaTS() + ((size_t)(b * 2 + kvh) * 64 + d) * 2112 + tg * 8) = pack8(a[0], a[1], a[2], a[3], a[4], a[5], a[6], a[7]);
  }
  for (int i = gt; i < 8 * 2048 * 8; i += GT) {
    int dg = i & 7, t = (i >> 3) & 2047, b = i >> 14;
    const float* s = p.cache_kidx + (size_t)(b * 2048 + t) * 64 + dg * 8;
    *(bf16x8*)(p.kiS() + ((size_t)b * 2112 + t) * 64 + dg * 8) = pack8(s[0], s[1], s[2], s[3], s[4], s[5], s[6], s[7]);
  }
}

namespace pg8 {
constexpr int BM = 256, BK = 64, HALF = 128, HTB = HALF * BK * 2, STAGE_BYTES = 8 * HTB, NXCD = 8, WGM = 8;
DI int lds_byte(int r, int c) { const int st = (r >> 4) * 2 + (c >> 5), rr = r & 15, cc = c & 31, ob = rr * 64 + cc * 2; return st * 1024 + (ob ^ (((ob >> 9) & 1) << 5)); }
DI void stage_rc(int b, int& R, int& C) { const int st = b / 1024, sb = b % 1024, swz = sb ^ (((sb >> 9) & 1) << 5); R = (st >> 1) * 16 + swz / 64; C = (st & 1) * 32 + (swz % 64) / 2; }
struct Unit { int pm, pn; };
struct Gemm { const u16* A; const u16* Bt; int M, N, K; };
struct StaticOrder {
  int nM, nN, nwg, G, c, padtile; unsigned long long permtab;
  DI void init(int M, int N, int G_, int c_) { nM = M / BM; nN = N / BM; nwg = nM * nN; G = G_; c = c_; permtab = 0xFEDCBA9876543210ull; padtile = -1; }
  DI void map(int L, Unit& u) const {
    int wgid = L; { const int q = nwg / NXCD, r = nwg % NXCD, xcd = wgid % NXCD, off = wgid / NXCD; wgid = (xcd < r ? xcd * (q + 1) : r * (q + 1) + (xcd - r) * q) + off; }
    const int nig = WGM * nN, gid = wgid / nig, fm = gid * WGM, gsz = (nM - fm) < WGM ? (nM - fm) : WGM;
    u.pm = fm + ((wgid % nig) % gsz); u.pn = (int)((permtab >> (4 * ((wgid % nig) / gsz))) & 15ull);
  }
  DI bool next(int i, Unit& u) const {
    const long Ll = (long)i * G + c; if (Ll >= nwg) return false;
    const int L = (int)Ll;
    if (padtile < 0) { map(L, u); return true; }
    const int tail = nwg % G, base = nwg - tail;
    if (L >= base) { u.pm = L - base; u.pn = padtile; return true; }
    map(L, u);
    for (int it = 0; it < 64 && u.pn == padtile && u.pm < tail; ++it) map(base + u.pm, u);
    return true;
  }
};
template <class Epi>
DI void gemm_phase(LAS unsigned char* lds, const Gemm g, const StaticOrder& S, const Epi& E, int wave_id) {
  const int wid = wave_id; int lane = lane_id(); asm volatile("" : "+v"(lane)); const int tid = wid * 64 + lane;
  const int wr = wid >> 2, wc = wid & 3, fr = lane & 15, fq = lane >> 4;
  const int K = g.K, nt = K / BK;
  unsigned voffA[2], voffB[2];
#pragma unroll
  for (int i = 0; i < 2; ++i) { int R, C; stage_rc(tid * 16 + i * 8192, R, C); voffA[i] = (unsigned)(R * K + C) * 2u; voffB[i] = voffA[i]; }
  const size_t kstep = (size_t)(BK * 2);
  const size_t hstep = (size_t)HALF * K * 2;
  const size_t tstep = 2 * hstep;
  const unsigned ldsw = (unsigned)wid * 1024u;
  const int aoff = lds_byte(wr * 64 + fr, fq * 8), boff = lds_byte(wc * 32 + fr, fq * 8);
#define PG8_SA(b, h) (((b) * 2 + (h)) * HTB)
#define PG8_SB(b, h) ((4 + (b) * 2 + (h)) * HTB)
#define PG8_STAGE(bufoff, gbase, voff) do { _Pragma("unroll") for (int _i = 0; _i < 2; ++_i) \
    __builtin_amdgcn_global_load_lds((const unsigned*)((const char*)(gbase) + (voff)[_i]), (LAS unsigned*)(lds + (bufoff) + ldsw + _i * 8192), 16, 0, 0); } while (0)
#define PG8_LDA(dst, b, h) do { _Pragma("unroll") for (int m = 0; m < 4; ++m) _Pragma("unroll") for (int k = 0; k < 2; ++k) dst[m][k] = *(const LAS bf16x8*)(lds + PG8_SA(b, h) + aoff + m * 2048 + k * 1024); } while (0)
#define PG8_LDB(dst, b, h) do { _Pragma("unroll") for (int n = 0; n < 2; ++n) _Pragma("unroll") for (int k = 0; k < 2; ++k) dst[n][k] = *(const LAS bf16x8*)(lds + PG8_SB(b, h) + boff + n * 2048 + k * 1024); } while (0)
#define PG8_MMA(ai, bj, At, Bt) do { __builtin_amdgcn_s_setprio(1); _Pragma("unroll") for (int m = 0; m < 4; ++m) _Pragma("unroll") for (int n = 0; n < 2; ++n) _Pragma("unroll") for (int k = 0; k < 2; ++k) \
    acc[ai][bj][m][n] = __builtin_amdgcn_mfma_f32_16x16x32_bf16(Bt[n][k], At[m][k], acc[ai][bj][m][n], 0, 0, 0); __builtin_amdgcn_s_setprio(0); } while (0)
#define PG8_WAIT_V(n) asm volatile("s_waitcnt vmcnt(" #n ")" ::: "memory")
#define PG8_WAIT_L(n) asm volatile("s_waitcnt lgkmcnt(" #n ")" ::: "memory")
#define PG8_BAR __builtin_amdgcn_s_barrier()
#define PG8_SCHED __builtin_amdgcn_sched_barrier(0)
  Unit cur, nxt; int ui = 0;
  if (!S.next(0, cur)) return;
  f32x4 acc[2][2][4][2];
#pragma unroll
  for (int a = 0; a < 2; ++a)
#pragma unroll
    for (int b = 0; b < 2; ++b)
#pragma unroll
      for (int m = 0; m < 4; ++m)
#pragma unroll
        for (int n = 0; n < 2; ++n) acc[a][b][m][n] = (f32x4){0.f, 0.f, 0.f, 0.f};
  bf16x8 At[4][2], B0[2][2], B1[2][2];
  const char* cA = (const char*)g.A + (size_t)cur.pm * tstep; const char* cB = (const char*)g.Bt + (size_t)cur.pn * tstep;
  PG8_STAGE(PG8_SB(0, 0), cB, voffB); PG8_STAGE(PG8_SA(0, 0), cA, voffA); PG8_STAGE(PG8_SB(0, 1), cB + hstep, voffB); PG8_STAGE(PG8_SA(0, 1), cA + hstep, voffA);
  if (wr == 1) PG8_BAR;
  PG8_WAIT_V(4); PG8_BAR;
  PG8_STAGE(PG8_SB(1, 0), cB + kstep, voffB); PG8_STAGE(PG8_SA(1, 0), cA + kstep, voffA); PG8_STAGE(PG8_SB(1, 1), cB + hstep + kstep, voffB);
  PG8_WAIT_V(6); PG8_BAR;
  for (;;) {
    const bool has_next = S.next(ui + 1, nxt);
    const char* nA = has_next ? (const char*)g.A + (size_t)nxt.pm * tstep : cA; const char* nB = has_next ? (const char*)g.Bt + (size_t)nxt.pn * tstep : cB;
#ifndef REPK
#define REPK 1
#endif
    const bool skip1 = (S.padtile >= 0) && (cur.pn == S.padtile);
    for (int rk = 0; rk < REPK; ++rk) {
    const char* nA2 = (rk == REPK - 1) ? nA : cA; const char* nB2 = (rk == REPK - 1) ? nB : cB;
    for (int t = 0; t < nt; t += 2) {
      const bool last = (t == nt - 2);
      const char* a1 = cA + (size_t)(t + 1) * kstep;
      const char* a2 = last ? nA2 : cA + (size_t)(t + 2) * kstep; const char* b2 = last ? nB2 : cB + (size_t)(t + 2) * kstep;
      const char* a3 = a2 + kstep; const char* b3 = b2 + kstep;
      PG8_LDB(B0, 0, 0); PG8_SCHED; PG8_LDA(At, 0, 0); PG8_STAGE(PG8_SA(1, 1), a1 + hstep, voffA);
      PG8_WAIT_L(8); PG8_BAR; PG8_WAIT_L(0); PG8_MMA(0, 0, At, B0); PG8_BAR; PG8_SCHED;
      PG8_LDB(B1, 0, 1); PG8_STAGE(PG8_SB(0, 0), b2, voffB);
      PG8_BAR; PG8_WAIT_L(0); if (!skip1) PG8_MMA(0, 1, At, B1); PG8_BAR;
      PG8_LDA(At, 0, 1); PG8_STAGE(PG8_SA(0, 0), a2, voffA);
      PG8_BAR; PG8_WAIT_L(0); PG8_MMA(1, 0, At, B0); PG8_BAR; PG8_SCHED;
      PG8_STAGE(PG8_SB(0, 1), b2 + hstep, voffB);
      PG8_WAIT_V(6); PG8_BAR; if (!skip1) PG8_MMA(1, 1, At, B1); PG8_BAR;
      PG8_LDB(B0, 1, 0); PG8_SCHED; PG8_LDA(At, 1, 0); PG8_STAGE(PG8_SA(0, 1), a2 + hstep, voffA);
      PG8_WAIT_L(8); PG8_BAR; PG8_WAIT_L(0); PG8_MMA(0, 0, At, B0); PG8_BAR; PG8_SCHED;
      PG8_LDB(B1, 1, 1); PG8_STAGE(PG8_SB(1, 0), b3, voffB);
      PG8_BAR; PG8_WAIT_L(0); if (!skip1) PG8_MMA(0, 1, At, B1); PG8_BAR;
      PG8_LDA(At, 1, 1); PG8_STAGE(PG8_SA(1, 0), a3, voffA);
      PG8_BAR; PG8_WAIT_L(0); PG8_MMA(1, 0, At, B0); PG8_BAR; PG8_SCHED;
      PG8_STAGE(PG8_SB(1, 1), b3 + hstep, voffB);
      PG8_WAIT_V(6); PG8_BAR; if (!skip1) PG8_MMA(1, 1, At, B1); PG8_BAR;
    }
    }
    {
      Unit eu = cur; int ewr = wr, ewc = wc; int el = lane_id();
      asm volatile("" : "+s"(eu.pm), "+s"(eu.pn), "+s"(ewr), "+s"(ewc), "+v"(el));
      int efr = el & 15, efq = el >> 4;
#ifndef REPEPI
#define REPEPI 1
#endif
      for (int re = 0; re < REPEPI; ++re) E(acc, eu, ewr, ewc, efr, efq, re);
    }
    if (!has_next) break;
#pragma unroll
    for (int a = 0; a < 2; ++a)
#pragma unroll
      for (int b = 0; b < 2; ++b)
#pragma unroll
        for (int m = 0; m < 4; ++m)
#pragma unroll
          for (int n = 0; n < 2; ++n) acc[a][b][m][n] = (f32x4){0.f, 0.f, 0.f, 0.f};
    cur = nxt; cA = nA; cB = nB; ++ui;
  }
  PG8_WAIT_V(0);
  if (wr == 0) PG8_BAR;
  PG8_BAR;
#undef PG8_SA
#undef PG8_SB
#undef PG8_STAGE
#undef PG8_LDA
#undef PG8_LDB
#undef PG8_MMA
#undef PG8_WAIT_V
#undef PG8_WAIT_L
#undef PG8_BAR
#undef PG8_SCHED
}
}


DI unsigned hx_w(int row, int c8) { return (unsigned)(row * 256 + ((c8 ^ ((row & 15) << 1)) << 3)); }
DI unsigned hx_r(int row, int c16) { return (unsigned)(row * 256 + ((c16 ^ (row & 15)) << 4)); }
#define EPI_BAR() asm volatile("s_waitcnt lgkmcnt(0)\n\ts_barrier" ::: "memory")


struct Epi1 {
  Params p; LAS unsigned char* hl0;
  DI void make_tabs(f32x4 (&tc)[4], f32x4 (&ts)[4], f32x4 c0, f32x4 s0, f32x4 c16, f32x4 s16) const {
    tc[0] = c0; ts[0] = s0;
#pragma unroll
    for (int m = 1; m < 4; ++m) { tc[m] = tc[m - 1] * c16 - ts[m - 1] * s16; ts[m] = ts[m - 1] * c16 + tc[m - 1] * s16; }
  }
  template <int AI, int BJ>
  DI void compute(f32x4 (&acc)[2][2][4][2], const f32x4 (&tc)[4], const f32x4 (&ts)[4], int blk, int wc, int fq) const {
    if (blk < 8) {
#pragma unroll
      for (int m = 0; m < 4; ++m) {
        const f32x4 v0 = acc[AI][BJ][m][0], v1 = acc[AI][BJ][m][1];
        f32x4 o0 = v0 * tc[m] - v1 * ts[m], o1 = v1 * tc[m] + v0 * ts[m];
        if (blk >= 4) { o0 *= 0.08838834764831845f; o1 *= 0.08838834764831845f; }
        acc[AI][BJ][m][0] = o0; acc[AI][BJ][m][1] = o1;
      }
    } else if ((blk >= 12 && blk < 16) || (blk >= 22 && blk < 26)) {
#pragma unroll
      for (int m = 0; m < 4; ++m)
#pragma unroll
        for (int n = 0; n < 2; ++n) {
          f32x4 v = acc[AI][BJ][m][n];
          v[0] = siluf(v[0]); v[1] = siluf(v[1]); v[2] = siluf(v[2]); v[3] = siluf(v[3]);
          acc[AI][BJ][m][n] = v;
        }
    } else if ((blk >= 8 && blk < 12) || blk == 21 || blk == 31) {
    } else {
      const bool ropew = ((wc & 1) == 0) && !(blk == 30 && wc >= 2);
      if (ropew) {
#pragma unroll
        for (int m = 0; m < 4; ++m) {
          const f32x4 v0 = acc[AI][BJ][m][0];
          f32x4 pr;
          pr[0] = __shfl_xor(v0[0], 32); pr[1] = __shfl_xor(v0[1], 32); pr[2] = __shfl_xor(v0[2], 32); pr[3] = __shfl_xor(v0[3], 32);
          acc[AI][BJ][m][0] = (fq < 2) ? v0 * tc[m] - pr * ts[m] : v0 * tc[m] + pr * ts[m];
        }
      }
      if (blk < 20) {
        const float sc = 0.125f * 1.4426950408889634f;
#pragma unroll
        for (int m = 0; m < 4; ++m) { acc[AI][BJ][m][0] *= sc; acc[AI][BJ][m][1] *= sc; }
      }
    }
  }
  template <int AI, int BJ>
  DI void emit(f32x4 (&acc)[2][2][4][2], const pg8::Unit& u, int blk, bool samp, int wr, int wc, int fr, int fq) const {
    if (blk == 31) return;
    LAS unsigned char* hl = hl0 + wr * 16384;
    asm volatile("" : "+v"(fr), "+v"(fq));
    const int lane = fr + 16 * fq;
    const int P0 = 32 * wc + 4 * fq;
    const int R0 = u.pm * 256 + AI * 128 + wr * 64;
    int b, tb;
    if (!samp) { b = R0 >> 11; tb = R0 & 2047; } else { b = (R0 - NPROMPT) >> 6; tb = 0; }
    const bool retk = blk < 8;
    const bool hasT = (blk >= 4 && blk < 12) || blk == 21;
    const bool hasN = !(blk >= 8 && blk < 12) && blk != 21;
    if (blk == 20 || blk == 21) {
      float* ob = samp ? p.out + (blk == 20 ? OUT_KS : OUT_VS) + (unsigned)(R0 - NPROMPT) * 128u : p.out + (blk == 20 ? OUT_KP : OUT_VP) + (unsigned)R0 * 128u;
#pragma unroll
      for (int m = 0; m < 4; ++m) {
        float* o2 = ob + (unsigned)(16 * m + fr) * 128u + P0;
        __builtin_nontemporal_store(acc[AI][BJ][m][0], (f32x4*)o2); __builtin_nontemporal_store(acc[AI][BJ][m][1], (f32x4*)(o2 + 16));
      }
    } else if (blk == 30) {
      float* ob = samp ? p.out + OUT_KIS + (unsigned)(R0 - NPROMPT) * 64u : p.out + OUT_KIP + (unsigned)R0 * 64u;
      float* wb = p.wi() + (unsigned)R0 * 8u;
#pragma unroll
      for (int m = 0; m < 4; ++m) {
        if (wc < 2) {
          float* o2 = ob + (unsigned)(16 * m + fr) * 64u + P0;
          __builtin_nontemporal_store(acc[AI][BJ][m][0], (f32x4*)o2); __builtin_nontemporal_store(acc[AI][BJ][m][1], (f32x4*)(o2 + 16));
        } else if (wc == 2 && fq < 2) {
          *(f32x4*)(wb + (unsigned)(16 * m + fr) * 8u + 4 * fq) = acc[AI][BJ][m][0] * 0.044194173824159216f;
        }
      }
    }
    if (hasN) {
#pragma unroll
      for (int m = 0; m < 4; ++m)
#pragma unroll
        for (int n = 0; n < 2; ++n) {
          const int c8 = retk ? (16 * n + 4 * wc + fq) : (8 * wc + 4 * n + fq);
          *(LAS s16x4*)(hl + hx_w(16 * m + fr, c8)) = pack4(acc[AI][BJ][m][n]);
        }
      u16* nb; unsigned pitch = 512u, hstr = 0u, cm = 15u;
      if (blk < 4) nb = p.qr() + (unsigned)R0 * 512u + (blk & 3) * 128;
      else if (blk < 8) nb = p.kr() + (unsigned)R0 * 512u + (blk & 3) * 128;
      else if (blk < 16) { nb = p.gate() + (unsigned)R0 * 1024u + (blk - 12) * 128; pitch = 1024u; }
      else if (blk < 20) nb = p.qa() + (unsigned)R0 * 512u + (blk - 16) * 128;
      else if (blk == 20) { nb = samp ? p.kaS() + ((unsigned)(b * 2) * 2112u + 2048u) * 64u : p.kaP() + ((unsigned)(b * 2) * 2048u + tb) * 64u; pitch = 64u; hstr = samp ? 2112u * 64u : 2048u * 64u; cm = 7u; }
      else if (blk < 26) { nb = p.gate() + (unsigned)R0 * 1024u + 512 + (blk - 22) * 128; pitch = 1024u; }
      else if (blk < 30) nb = p.qi() + (unsigned)R0 * 512u + (blk - 26) * 128;
      else { nb = samp ? p.kiS() + ((unsigned)b * 2112u + 2048u) * 64u : p.kiP() + ((unsigned)b * 2048u + tb) * 64u; pitch = 64u; cm = 7u; }
      EPI_BAR();
      const unsigned c16 = lane & 15;
      const unsigned loff = (c16 >> 3) * hstr + (c16 & cm) * 8u;
#pragma unroll
      for (int i = 0; i < 4; ++i) {
        const int row = 16 * wc + 4 * i + (lane >> 4);
        const bf16x8 v = *(const LAS bf16x8*)(hl + hx_r(row, c16));
        if (blk != 30 || c16 < 8) *(bf16x8*)(nb + (unsigned)row * pitch + loff) = v;
      }
      EPI_BAR();
    }
    if (hasT) {
      const float l2g = log2gamma(blk & 3);
#pragma unroll
      for (int m = 0; m < 4; ++m) {
        const int tok = 16 * m + fr;
        const float dec = (blk < 8) ? exp2f((float)(63 - tok) * l2g) : 1.f;
#pragma unroll
        for (int n = 0; n < 2; ++n) {
          const int fb = retk ? (64 * n + 16 * wc + 4 * fq) : (32 * wc + 16 * n + 4 * fq);
#pragma unroll
          for (int j = 0; j < 4; ++j) {
            const int f = fb + j;
            *(LAS u16*)(hl + f * 128 + ((((tok >> 3) ^ (f >> 2)) & 7) << 4) + (tok & 7) * 2) = f2bf(acc[AI][BJ][m][n][j] * dec);
          }
        }
      }
      u16* tbp; unsigned fstr;
      if (blk < 12) {
        u16* base = (blk < 8) ? p.krT() : p.vrT();
        const unsigned bh = (unsigned)(b * 4 + (blk & 3)) * 128u;
        tbp = samp ? base + 64u * 128u * 2048u + bh * 64u : base + bh * 2048u + tb;
        fstr = samp ? 64u : 2048u;
      } else {
        tbp = samp ? p.vaTS() + (unsigned)b * 128u * 2112u + 2048u : p.vaTP() + (unsigned)b * 128u * 2048u + tb;
        fstr = samp ? 2112u : 2048u;
      }
      EPI_BAR();
#pragma unroll
      for (int i = 0; i < 4; ++i) {
        const int f = 32 * wc + 8 * i + (lane >> 3), ch = lane & 7;
        const bf16x8 v = *(const LAS bf16x8*)(hl + f * 128 + (((ch ^ (f >> 2)) & 7) << 4));
        *(bf16x8*)(tbp + (unsigned)f * fstr + ch * 8) = v;
      }
      EPI_BAR();
    }
  }
  DI void operator()(f32x4 (&acc)[2][2][4][2], const pg8::Unit& u, int wr, int wc, int fr, int fq, int re) const {
    const bool samp = (u.pm * 256 >= NPROMPT);
    const int tclass = (u.pn < 4) ? 1 : ((u.pn == 8 || u.pn == 9 || u.pn == 10 || u.pn >= 13) ? 2 : 0);
    const int blk0 = u.pn * 2, blk1 = u.pn * 2 + 1;
    float rvv[2][4];
#pragma unroll
    for (int ai = 0; ai < 2; ++ai)
#pragma unroll
      for (int m = 0; m < 4; ++m) rvv[ai][m] = (1.f / REPK) * p.rinv()[u.pm * 256 + ai * 128 + wr * 64 + 16 * m + fr];
    const float* cb = (tclass == 1) ? p.cosR() : p.cosA();
    const float* sb = (tclass == 1) ? p.sinR() : p.sinA();
    const int pitch = (tclass == 1) ? 64 : 8;
    const int coff = (tclass == 1) ? (16 * wc + 4 * fq) : (4 * (fq & 1));
    const int rowg0 = u.pm * 256 + wr * 64 + fr;
    const int pos0 = samp ? 2048 + ((rowg0 - NPROMPT) & 63) : (rowg0 & 2047);
    const f32x4 c0 = *(const f32x4*)(cb + pos0 * pitch + coff), s0 = *(const f32x4*)(sb + pos0 * pitch + coff);
    const f32x4 c16 = *(const f32x4*)(cb + 16 * pitch + coff), s16 = *(const f32x4*)(sb + 16 * pitch + coff);
    f32x4 tc[4], ts[4];
#pragma unroll
    for (int ai = 0; ai < 2; ++ai)
#pragma unroll
      for (int m = 0; m < 4; ++m)
#pragma unroll
        for (int bj = 0; bj < 2; ++bj)
#pragma unroll
          for (int n = 0; n < 2; ++n) acc[ai][bj][m][n] *= rvv[ai][m];
    make_tabs(tc, ts, c0, s0, c16, s16);
    compute<0, 0>(acc, tc, ts, blk0, wc, fq);
    compute<0, 1>(acc, tc, ts, blk1, wc, fq);
    {
      const f32x4 c32 = c16 * c16 - s16 * s16, s32 = 2.f * s16 * c16;
      const f32x4 c64 = c32 * c32 - s32 * s32, s64 = 2.f * s32 * c32;
      const f32x4 c80 = c64 * c16 - s64 * s16, s80 = s64 * c16 + c64 * s16;
      const f32x4 c1 = samp ? tc[0] : tc[3] * c80 - ts[3] * s80, s1 = samp ? ts[0] : ts[3] * c80 + tc[3] * s80;
      make_tabs(tc, ts, c1, s1, c16, s16);
    }
    compute<1, 0>(acc, tc, ts, blk0, wc, fq);
    compute<1, 1>(acc, tc, ts, blk1, wc, fq);
    emit<0, 0>(acc, u, blk0, samp, wr, wc, fr, fq);
    emit<0, 1>(acc, u, blk1, samp, wr, wc, fr, fq);
    emit<1, 0>(acc, u, blk0, samp, wr, wc, fr, fq);
    emit<1, 1>(acc, u, blk1, samp, wr, wc, fr, fq);
  }
};

struct Epi2 {
  Params p; unsigned char* hl;
  DI void operator()(f32x4 (&acc)[2][2][4][2], const pg8::Unit& u, int wr, int wc, int fr, int fq, int re) const {
    u16* z = p.gate();
    const int lane = fr + 16 * fq;
#pragma unroll
    for (int ai = 0; ai < 2; ++ai)
#pragma unroll
      for (int bj = 0; bj < 2; ++bj) {
#pragma unroll
        for (int m = 0; m < 4; ++m)
#pragma unroll
          for (int n = 0; n < 2; ++n)
            *(s16x4*)(hl + hx_w(16 * m + fr, 8 * wc + 4 * n + fq)) = pack4(acc[ai][bj][m][n] * (1.f / REPK));
        EPI_BAR();
        const unsigned R0 = u.pm * 256 + ai * 128 + wr * 64;
        const unsigned cb = u.pn * 256 + bj * 128;
#pragma unroll
        for (int i = 0; i < 4; ++i) {
          const int row = 16 * wc + 4 * i + (lane >> 4), c16 = lane & 15;
          const bf16x8 v = *(const bf16x8*)(hl + hx_r(row, c16));
          *(bf16x8*)(z + (R0 + row) * 1024u + cb + c16 * 8) = v;
        }
        EPI_BAR();
      }
  }
};

DI void ret_kv_item(const Params& p, int item, int tid) {
  const int lane = tid & 63, w = tid >> 6, r = lane & 31, hh = lane >> 5;
  const u16 *kT, *vT; int T, c;
  if (item < 2048) { const int bh = item >> 5; c = item & 31; T = 2048; kT = p.krT() + (size_t)bh * 128 * 2048; vT = p.vrT() + (size_t)bh * 128 * 2048; }
  else { const int bh = item - 2048; c = 0; T = 64; kT = p.krT() + (size_t)64 * 128 * 2048 + (size_t)bh * 128 * 64; vT = p.vrT() + (size_t)64 * 128 * 2048 + (size_t)bh * 128 * 64; }
  const int e0 = (w & 1) * 64, d0 = (w >> 1) * 64;
  f32x16 acc[2][2];
  acc[0][0] = zero16(); acc[0][1] = zero16(); acc[1][0] = zero16(); acc[1][1] = zero16();
#pragma unroll
  for (int ks = 0; ks < 4; ++ks) {
    bf16x8 a0 = ldg8(vT + (size_t)(e0 + r) * T + c * 64 + ks * 16 + hh * 8);
    bf16x8 a1 = ldg8(vT + (size_t)(e0 + 32 + r) * T + c * 64 + ks * 16 + hh * 8);
    bf16x8 b0 = ldg8(kT + (size_t)(d0 + r) * T + c * 64 + ks * 16 + hh * 8);
    bf16x8 b1 = ldg8(kT + (size_t)(d0 + 32 + r) * T + c * 64 + ks * 16 + hh * 8);
    acc[0][0] = MFMA32(a0, b0, acc[0][0]);
    acc[0][1] = MFMA32(a0, b1, acc[0][1]);
    acc[1][0] = MFMA32(a1, b0, acc[1][0]);
    acc[1][1] = MFMA32(a1, b1, acc[1][1]);
  }
  u16* o = (u16*)p.kvT() + (size_t)item * 16384;
#pragma unroll
  for (int a = 0; a < 2; ++a)
#pragma unroll
    for (int b = 0; b < 2; ++b)
#pragma unroll
      for (int i = 0; i < 16; ++i)
        o[(e0 + a * 32 + crow(i, hh)) * 128 + d0 + b * 32 + r] = f2bf(acc[a][b][i]);
}

template <int NS>
DI void select_query(const u16* krow, int nj, int lane, u64* dst) {
  unsigned key[NS];
#pragma unroll
  for (int j = 0; j < NS; ++j) { const unsigned k = krow[j * 64 + lane]; key[j] = (j < nj) ? k : 0u; }
  constexpr int NP = (NS + 1) / 2;
  unsigned pk[NP];
#pragma unroll
  for (int i = 0; i < NP; ++i) pk[i] = key[2 * i] | ((2 * i + 1 < NS ? key[2 * i + 1] : 0u) << 16);
  unsigned prefix = 0;
  int cntp = 0;
  const unsigned ones = 0x00010001u;
  for (int bit = 15; bit >= 0; --bit) {
    const unsigned cand = prefix | (1u << bit);
    const unsigned c1 = cand - 1u;
    const unsigned cv = c1 | (c1 << 16);
    unsigned acc0 = 0, acc1 = 0;
#pragma unroll
    for (int i = 0; i < NP; ++i) {
      unsigned d, m;
      asm("v_pk_sub_u16 %0, %1, %2 clamp" : "=v"(d) : "v"(pk[i]), "v"(cv));
      asm("v_pk_min_u16 %0, %1, %2" : "=v"(m) : "v"(d), "v"(ones));
      if (i & 1) acc1 += m; else acc0 += m;
    }
    const unsigned a = acc0 + acc1;
    const int cnt = wave_sum((int)((a & 0xffffu) + (a >> 16)));
    if (cnt >= 256) { prefix = cand; cntp = cnt; }
    if (cnt == 256) break;
  }
  int wlo = 0, whi = 0;
  if (cntp == 256) {
#pragma unroll
    for (int j = 0; j < NS; ++j) {
      const u64 sm = __ballot(key[j] >= prefix);
      if (lane == j) { wlo = (int)(unsigned)sm; whi = (int)(unsigned)(sm >> 32); }
    }
  } else {
    int cgt = 0;
#pragma unroll
    for (int j = 0; j < NS; ++j) cgt += (key[j] > prefix) ? 1 : 0;
    cgt = wave_sum(cgt);
    const int rneed = 256 - cgt;
    int running = 0;
    const u64 lt = (1ull << lane) - 1ull;
#pragma unroll
    for (int j = 0; j < NS; ++j) {
      const bool eq = key[j] == prefix;
      const u64 em = __ballot(eq);
      const int rank = running + __popcll(em & lt);
      const bool sel = (key[j] > prefix) || (eq && rank < rneed);
      const u64 sm = __ballot(sel);
      if (lane == j) { wlo = (int)(unsigned)sm; whi = (int)(unsigned)(sm >> 32); }
      running += __popcll(em);
    }
  }
  if (lane < nj) dst[lane] = ((u64)(unsigned)whi << 32) | (u64)(unsigned)wlo;
}

DI void idx_item(const Params& p, unsigned char* lds, int tid, bool samp, int b, int grp) {
  const int lane = tid & 63, w = tid >> 6;
  const int t0 = grp * 16;
  int L, g0; const u16* ki;
  if (!samp) { const int c = t0 >> 6; L = (c + 1) * 64; g0 = b * 2048 + t0; ki = p.kiP() + (size_t)b * 2048 * 64; }
  else { L = 2112; g0 = NPROMPT + b * 64 + t0; ki = p.kiS() + (size_t)b * 2112 * 64; }
  const int nj = L >> 6;
  if (L <= 256) {
    for (int qq = 0; qq < 4; ++qq) {
      const int q = w * 4 + qq;
      if (lane < nj) p.maskbits()[(size_t)(g0 + q) * 33 + lane] = ~0ull;
    }
    return;
  }
  u16* keys = (u16*)lds;
#ifndef REPMF
#define REPMF 1
#endif
#ifndef REPSEL
#define REPSEL 1
#endif
#ifndef REPKV
#define REPKV 1
#endif
  for (int rmf = 0; rmf < REPMF; ++rmf) {
    const int qn = lane & 15, quad = lane >> 4;
    bf16x8 qf[8][2];
    float wv[8];
#pragma unroll
    for (int h = 0; h < 8; ++h) {
      qf[h][0] = ldg8(p.qi() + (size_t)(g0 + qn) * 512 + h * 64 + quad * 8);
      qf[h][1] = ldg8(p.qi() + (size_t)(g0 + qn) * 512 + h * 64 + 32 + quad * 8);
      wv[h] = p.wi()[(size_t)(g0 + qn) * 8 + h];
    }
    bf16x8 A0[4], A1[4], N0[4], N1[4];
#pragma unroll
    for (int i = 0; i < 4; ++i) {
      const int kt = w + 4 * i;
      A0[i] = ldg8(ki + (size_t)(kt * 16 + qn) * 64 + quad * 8);
      A1[i] = ldg8(ki + (size_t)(kt * 16 + qn) * 64 + 32 + quad * 8);
    }
    for (int base = 0; base < nj; base += 4) {
#pragma unroll
      for (int i = 0; i < 4; ++i) {
        const int t = min(base + 4 + i, nj - 1);
        const int kt = w + 4 * t;
        N0[i] = ldg8(ki + (size_t)(kt * 16 + qn) * 64 + quad * 8);
        N1[i] = ldg8(ki + (size_t)(kt * 16 + qn) * 64 + 32 + quad * 8);
      }
#pragma unroll
      for (int i = 0; i < 4; ++i) {
        const int t = base + i;
        if (t < nj) {
          const int kt = w + 4 * t;
          float idx[4] = {0.f, 0.f, 0.f, 0.f};
#pragma unroll
          for (int h = 0; h < 8; ++h) {
            f32x4 acc = {0.f, 0.f, 0.f, 0.f};
            acc = MFMA16(A0[i], qf[h][0], acc);
            acc = MFMA16(A1[i], qf[h][1], acc);
#pragma unroll
            for (int e = 0; e < 4; ++e) idx[e] += fmaxf(acc[e], 0.f) * wv[h];
          }
          s16x4 kv;
#pragma unroll
          for (int e = 0; e < 4; ++e) {
            _Float16 hv = (_Float16)idx[e];
            u16 bits = __builtin_bit_cast(u16, hv);
            kv[e] = (short)((bits & 0x8000) ? (u16)~bits : (u16)(bits | 0x8000));
          }
          *(s16x4*)(keys + qn * KPITCH + kt * 16 + quad * 4) = kv;
        }
      }
#pragma unroll
      for (int i = 0; i < 4; ++i) { A0[i] = N0[i]; A1[i] = N1[i]; }
    }
  }
  __syncthreads();
  for (int qq = 0; qq < 4 * REPSEL; ++qq) {
    const int q = w * 4 + (qq & 3);
    const u16* krow = keys + q * KPITCH;
    u64* dst = p.maskbits() + (size_t)(g0 + q) * 33;
    if (nj <= 8) select_query<8>(krow, nj, lane, dst);
    else if (nj <= 16) select_query<16>(krow, nj, lane, dst);
    else if (nj <= 24) select_query<24>(krow, nj, lane, dst);
    else select_query<33>(krow, nj, lane, dst);
  }
  __syncthreads();
}

DI void scan_item(const Params& p, int item, int tid) {
  if (item < 1024) {
    const int bh = item >> 4, slab = item & 15;
    const int idx = slab * 1024 + tid * 4;
    const int h = bh & 3;
    const float cd = exp2f(64.f * log2gamma(h));
    f32x4 s = {0.f, 0.f, 0.f, 0.f};
    for (int c0 = 0; c0 < 32; c0 += 8) {
      f32x4 kvb[8];
#pragma unroll
      for (int i = 0; i < 8; ++i) {
        const s16x4 kk = __builtin_nontemporal_load((const s16x4*)((const u16*)p.kvT() + (size_t)(bh * 32 + c0 + i) * 16384 + idx));
#pragma unroll
        for (int j = 0; j < 4; ++j) kvb[i][j] = __uint_as_float(((unsigned)(u16)kk[j]) << 16);
      }
#pragma unroll
      for (int i = 0; i < 8; ++i) {
        __builtin_nontemporal_store(pack4(s), (s16x4*)(p.sprevT() + (size_t)(bh * 32 + c0 + i) * 16384 + idx));
        s = s * cd + kvb[i];
      }
    }
    const int e = idx >> 7, d = idx & 127;
    float* o = p.out + OUT_STP + (size_t)bh * 16384;
#pragma unroll
    for (int j = 0; j < 4; ++j) o[(d + j) * 128 + e] = s[j];
  } else {
    const int it = item - 1024;
    const int bh = it >> 4, slab = it & 15;
    const int idx = slab * 1024 + tid * 4;
    const int h = bh & 3;
    const float cd = exp2f(64.f * log2gamma(h));
    const int e = idx >> 7, d = idx & 127;
    const float* s0 = p.state_ret + (size_t)bh * 16384;
    f32x4 s;
#pragma unroll
    for (int j = 0; j < 4; ++j) s[j] = s0[(d + j) * 128 + e];
    const size_t base = (size_t)(2048 + bh) * 16384 + idx;
    s16x4 o = pack4(s);
    *(s16x4*)(p.sprevT() + base) = o;
    const s16x4 kk = *(const s16x4*)((const u16*)p.kvT() + base);
    f32x4 kv;
#pragma unroll
    for (int j = 0; j < 4; ++j) kv[j] = __uint_as_float(((unsigned)(u16)kk[j]) << 16);
    s = s * cd + kv;
    float* oo = p.out + OUT_STS + (size_t)bh * 16384;
#pragma unroll
    for (int j = 0; j < 4; ++j) oo[(d + j) * 128 + e] = s[j];
  }
}

DI void attn_item(const Params& p, unsigned char* lds, int tid, bool samp, int b, int c, int kvh, int qh, unsigned char* lds_blk, int tid512) {
  const int lane = tid & 63, w = tid >> 6, r = lane & 31, hh = lane >> 5;
  const int T = samp ? 2112 : 2048;
  const int nkt = samp ? 33 : c + 1;
  const int g0 = (samp ? NPROMPT + b * 64 : b * 2048 + c * 64) + qh * 32;
  const u16* K = samp ? p.kaS() + (size_t)(b * 2 + kvh) * 2112 * 64 : p.kaP() + (size_t)(b * 2 + kvh) * 2048 * 64;
  const u16* VT = samp ? p.vaTS() + (size_t)(b * 2 + kvh) * 64 * 2112 : p.vaTP() + (size_t)(b * 2 + kvh) * 64 * 2048;
  const int head = kvh * 4 + w;
  u16* KV0 = (u16*)(lds_blk + 2 * HALF_LDS - 4 * 9216);
  u64* mL = (u64*)lds;
  {
    u64 mv[5];
#pragma unroll
    for (int i = 0; i < 5; ++i) { const int ix = tid + 256 * i; mv[i] = __builtin_nontemporal_load(p.maskbits() + (size_t)g0 * 33 + (ix < 32 * 33 ? ix : 32 * 33 - 1)); }
#pragma unroll
    for (int i = 0; i < 5; ++i) { const int ix = tid + 256 * i; if (ix < 32 * 33) mL[ix] = mv[i]; }
  }
  bf16x8 qf[4];
#pragma unroll
  for (int ks = 0; ks < 4; ++ks) qf[ks] = ldg8(p.qa() + (size_t)(g0 + r) * 512 + head * 64 + ks * 16 + hh * 8);
  f32x16 O[2];
  O[0] = zero16(); O[1] = zero16();
  float mrun = -1e30f, lrun = 0.f;
  const int lrow = tid512 >> 3, lch = tid512 & 7;
  const int loff = lrow * 72 + lch * 8;
  bf16x8 pk0, pv0, nk0, nv0;
  {
    const bf16x8 k0 = ldg8(K + (size_t)(lrow)*64 + lch * 8), v0 = ldg8(VT + (size_t)(lrow)*T + lch * 8);
    const int t1 = nkt > 1 ? 1 : 0, t2 = nkt > 2 ? 2 : (nkt - 1);
    pk0 = ldg8(K + (size_t)(t1 * 64 + lrow) * 64 + lch * 8); pv0 = ldg8(VT + (size_t)(lrow)*T + t1 * 64 + lch * 8);
    nk0 = ldg8(K + (size_t)(t2 * 64 + lrow) * 64 + lch * 8); nv0 = ldg8(VT + (size_t)(lrow)*T + t2 * 64 + lch * 8);
    *(bf16x8*)(KV0 + loff) = k0;
    *(bf16x8*)(KV0 + 64 * 72 + loff) = v0;
  }
  __syncthreads();
  for (int kt = 0; kt < nkt; ++kt) {
    if (kt + 1 < nkt) {
      u16* nb = KV0 + ((kt + 1) & 1) * (2 * 64 * 72);
      *(bf16x8*)(nb + loff) = pk0;
      *(bf16x8*)(nb + 64 * 72 + loff) = pv0;
    }
    pk0 = nk0; pv0 = nv0;
    {
      const int t3 = (kt + 3 < nkt) ? kt + 3 : nkt - 1;
      nk0 = ldg8(K + (size_t)(t3 * 64 + lrow) * 64 + lch * 8);
      nv0 = ldg8(VT + (size_t)(lrow)*T + t3 * 64 + lch * 8);
    }
    const u16* Ks = KV0 + (kt & 1) * (2 * 64 * 72);
    const u16* Vs = Ks + 64 * 72;
    f32x16 S[2];
#pragma unroll
    for (int st = 0; st < 2; ++st) {
      S[st] = zero16();
#pragma unroll
      for (int ks = 0; ks < 4; ++ks) {
        bf16x8 kf = *(const bf16x8*)(Ks + (st * 32 + r) * 72 + ks * 16 + hh * 8);
        S[st] = MFMA32(kf, qf[ks], S[st]);
      }
    }
    const u64 W = mL[r * 33 + kt];
    const int wl = (int)(((unsigned)W) >> (4 * hh)), wh = (int)(((unsigned)(W >> 32)) >> (4 * hh));
    float mx = fmaxf(S[0][0], S[1][0]);
#pragma unroll
    for (int i = 1; i < 16; ++i) mx = fmaxf(mx, fmaxf(S[0][i], S[1][i]));
    mx = fmaxf(mx, __shfl_xor(mx, 32));
    const float mn = fmaxf(mrun, mx);
    const float alpha = __builtin_amdgcn_exp2f(mrun - mn);
    const bool resc = __any(mn != mrun);
    mrun = mn;
    float ls = 0.f;
#pragma unroll
    for (int st = 0; st < 2; ++st)
#pragma unroll
      for (int i = 0; i < 16; ++i) {
        const int keep = __builtin_amdgcn_sbfe(st ? wh : wl, (i & 3) + 8 * (i >> 2), 1);
        const float pvv = __int_as_float(__float_as_int(__builtin_amdgcn_exp2f(S[st][i] - mn)) & keep);
        S[st][i] = pvv;
        ls += pvv;
      }
    lrun = lrun * alpha + ls;
    if (resc) {
#pragma unroll
      for (int dt = 0; dt < 2; ++dt)
#pragma unroll
        for (int i = 0; i < 16; ++i) O[dt][i] *= alpha;
    }
#pragma unroll
    for (int st = 0; st < 2; ++st)
#pragma unroll
      for (int s2 = 0; s2 < 2; ++s2) {
        bf16x8 pf = pack8(S[st][8 * s2 + 0], S[st][8 * s2 + 1], S[st][8 * s2 + 2], S[st][8 * s2 + 3],
                          S[st][8 * s2 + 4], S[st][8 * s2 + 5], S[st][8 * s2 + 6], S[st][8 * s2 + 7]);
#pragma unroll
        for (int dt = 0; dt < 2; ++dt) {
          s16x4 lo = *(const s16x4*)(Vs + (dt * 32 + r) * 72 + st * 32 + 16 * s2 + 4 * hh);
          s16x4 hi = *(const s16x4*)(Vs + (dt * 32 + r) * 72 + st * 32 + 16 * s2 + 8 + 4 * hh);
          bf16x8 vf = __builtin_shufflevector(lo, hi, 0, 1, 2, 3, 4, 5, 6, 7);
          O[dt] = MFMA32(vf, pf, O[dt]);
        }
      }
    __syncthreads();
  }
  {
    float lt = lrun + __shfl_xor(lrun, 32);
    const float inv = 1.f / fmaxf(lt, 1e-30f);
    const u16* grow = p.gate() + (size_t)(g0 + r) * 1024 + 512 + head * 64;
    u16* mrow = p.mix() + (size_t)(g0 + r) * 1024 + 512 + head * 64;
    s16x4 gvv[2][4];
#pragma unroll
    for (int dt = 0; dt < 2; ++dt)
#pragma unroll
      for (int q4 = 0; q4 < 4; ++q4) gvv[dt][q4] = *(const s16x4*)(grow + dt * 32 + 8 * q4 + 4 * hh);
#pragma unroll
    for (int dt = 0; dt < 2; ++dt)
#pragma unroll
      for (int q4 = 0; q4 < 4; ++q4) {
        const int d = dt * 32 + 8 * q4 + 4 * hh;
        f32x4 of;
#pragma unroll
        for (int j = 0; j < 4; ++j) {
          const float gf = __uint_as_float(((unsigned)(u16)gvv[dt][q4][j]) << 16);
          of[j] = O[dt][q4 * 4 + j] * inv * gf;
        }
        *(s16x4*)(mrow + d) = pack4(of);
      }
  }
  __syncthreads();
}

DI void ret_out_item(const Params& p, unsigned char* lds, int item, int tid) {
  const int lane = tid & 63, w = tid >> 6, r = lane & 31, hh = lane >> 5;
  int bh, c, T, g0; const u16* vT;
  if (item < 2048) { bh = item >> 5; c = item & 31; T = 2048; g0 = (bh >> 2) * 2048 + c * 64; vT = p.vrT() + (size_t)bh * 128 * 2048; }
  else { bh = item - 2048; c = 0; T = 64; g0 = NPROMPT + (bh >> 2) * 64; vT = p.vrT() + (size_t)64 * 128 * 2048 + (size_t)bh * 128 * 64; }
  const int h = bh & 3;
  const float l2g = log2gamma(h);
  const int nt = w & 1, eh = w >> 1;
  const int n = nt * 32 + r;
  bf16x8 qf[8], kf[8];
#pragma unroll
  for (int ks = 0; ks < 8; ++ks) qf[ks] = ldg8(p.qr() + (size_t)(g0 + n) * 512 + h * 128 + ks * 16 + hh * 8);
#pragma unroll
  for (int ks = 0; ks < 8; ++ks) kf[ks] = ldg8(p.kr() + (size_t)(g0 + r) * 512 + h * 128 + ks * 16 + hh * 8);
  __builtin_amdgcn_sched_barrier(0);
  bf16x8 pf[2][2];
#pragma unroll
  for (int mt = 0; mt < 2; ++mt) {
    f32x16 S = zero16();
#pragma unroll
    for (int ks = 0; ks < 8; ++ks) S = MFMA32(kf[ks], qf[ks], S);
    if (mt == 0) {
#pragma unroll
      for (int ks = 0; ks < 8; ++ks) kf[ks] = ldg8(p.kr() + (size_t)(g0 + 32 + r) * 512 + h * 128 + ks * 16 + hh * 8);
      __builtin_amdgcn_sched_barrier(0);
    }
#pragma unroll
    for (int i = 0; i < 16; ++i) {
      const int m = mt * 32 + crow(i, hh);
      const int dd = n > m ? n - m : m - n;
      S[i] *= exp2f((float)dd * l2g);
    }
    pf[mt][0] = pack8(S[0], S[1], S[2], S[3], S[4], S[5], S[6], S[7]);
    pf[mt][1] = pack8(S[8], S[9], S[10], S[11], S[12], S[13], S[14], S[15]);
  }
  const float fs = exp2f((float)(n + 1) * l2g);
  const u16* sp = p.sprevT() + (size_t)item * 16384;
  f32x16 tot[2];
  float ss = 0.f;
  s16x4 vlo[2][2][2], vhi[2][2][2];
#pragma unroll
  for (int et = 0; et < 2; ++et)
#pragma unroll
    for (int mt = 0; mt < 2; ++mt)
#pragma unroll
      for (int s2 = 0; s2 < 2; ++s2) {
        const u16* vp = vT + (size_t)((2 * eh + et) * 32 + r) * T + c * 64 + mt * 32 + 16 * s2 + 4 * hh;
        vlo[et][mt][s2] = ldg4(vp); vhi[et][mt][s2] = ldg4(vp + 8);
      }
  __builtin_amdgcn_sched_barrier(0);
#pragma unroll
  for (int et = 0; et < 2; ++et) {
    const int e = (2 * eh + et) * 32 + r;
    bf16x8 sf[8];
#pragma unroll
    for (int ks = 0; ks < 8; ++ks) sf[ks] = ldg8(sp + (size_t)e * 128 + ks * 16 + hh * 8);
    __builtin_amdgcn_sched_barrier(0);
    f32x16 Oi = zero16(), X = zero16();
#pragma unroll
    for (int mt = 0; mt < 2; ++mt)
#pragma unroll
      for (int s2 = 0; s2 < 2; ++s2) {
        bf16x8 vf = __builtin_shufflevector(vlo[et][mt][s2], vhi[et][mt][s2], 0, 1, 2, 3, 4, 5, 6, 7);
        Oi = MFMA32(vf, pf[mt][s2], Oi);
      }
#pragma unroll
    for (int ks = 0; ks < 8; ++ks) X = MFMA32(sf[ks], qf[ks], X);
#pragma unroll
    for (int i = 0; i < 16; ++i) { const float t = Oi[i] + X[i] * fs; tot[et][i] = t; ss += t * t; }
  }
  ss += __shfl_xor(ss, 32);
  float* red = (float*)lds;
  __syncthreads();
  if (hh == 0) red[w * 32 + r] = ss;
  __syncthreads();
  const float tsum = red[w * 32 + r] + red[(w ^ 2) * 32 + r];
  const float rinv = rsqrtf(tsum * (1.f / 128.f) + 1e-6f);
  const u16* grow = p.gate() + (size_t)(g0 + n) * 1024 + h * 128;
  u16* mrow = p.mix() + (size_t)(g0 + n) * 1024 + h * 128;
  s16x4 gvv[2][4];
  f32x4 ggv[2][4];
#pragma unroll
  for (int et = 0; et < 2; ++et)
#pragma unroll
    for (int q4 = 0; q4 < 4; ++q4) {
      const int e = (2 * eh + et) * 32 + 8 * q4 + 4 * hh;
      gvv[et][q4] = *(const s16x4*)(grow + e);
      ggv[et][q4] = *(const f32x4*)(p.ret_gn_g + h * 128 + e);
    }
#pragma unroll
  for (int et = 0; et < 2; ++et)
#pragma unroll
    for (int q4 = 0; q4 < 4; ++q4) {
      const int e = (2 * eh + et) * 32 + 8 * q4 + 4 * hh;
      f32x4 of;
#pragma unroll
      for (int j = 0; j < 4; ++j) {
        const float gf = __uint_as_float(((unsigned)(u16)gvv[et][q4][j]) << 16);
        of[j] = tot[et][q4 * 4 + j] * rinv * ggv[et][q4][j] * gf;
      }
      *(s16x4*)(mrow + e) = pack4(of);
    }
}

DI void phase_final(const Params& p, int tid) {
  const int gt = blockIdx.x * 512 + tid, GT = gridDim.x * 512;
  const int lane = tid & 63;
  for (int row0 = (gt >> 6) * 2; row0 < NTOK; row0 += (GT >> 6) * 2) {
    f32x4 v[2][4];
    s16x4 zz[2][4];
#pragma unroll
    for (int rr = 0; rr < 2; ++rr) {
      const float* xr = xrow(p, row0 + rr);
      const u16* zr = p.gate() + (size_t)(row0 + rr) * 1024;
#pragma unroll
      for (int i = 0; i < 4; ++i) { v[rr][i] = __builtin_nontemporal_load((const f32x4*)(xr + i * 256 + lane * 4)); zz[rr][i] = __builtin_nontemporal_load((const s16x4*)(zr + i * 256 + lane * 4)); }
    }
    f32x4 g[4];
#pragma unroll
    for (int i = 0; i < 4; ++i) g[i] = *(const f32x4*)(p.final_g + i * 256 + lane * 4);
#pragma unroll
    for (int rr = 0; rr < 2; ++rr) {
      float ss = 0.f;
#pragma unroll
      for (int i = 0; i < 4; ++i) {
#pragma unroll
        for (int j = 0; j < 4; ++j) v[rr][i][j] += __uint_as_float(((unsigned)(u16)zz[rr][i][j]) << 16);
        ss += v[rr][i][0] * v[rr][i][0] + v[rr][i][1] * v[rr][i][1] + v[rr][i][2] * v[rr][i][2] + v[rr][i][3] * v[rr][i][3];
      }
#pragma unroll
      for (int o = 32; o >= 1; o >>= 1) ss += __shfl_xor(ss, o);
      const float rv = rsqrtf(ss * (1.f / 1024.f) + 1e-6f);
      float* y = p.out + OUT_Y + (size_t)(row0 + rr) * 1024;
#pragma unroll
      for (int i = 0; i < 4; ++i) __builtin_nontemporal_store(v[rr][i] * rv * g[i], (f32x4*)(y + i * 256 + lane * 4));
    }
  }
}

#ifndef REP0
#define REP0 1
#endif
#ifndef REP1
#define REP1 1
#endif
#ifndef REP2
#define REP2 1
#endif
#ifndef REP3
#define REP3 1
#endif
#ifndef REP4
#define REP4 1
#endif
#ifndef REP5
#define REP5 1
#endif
__global__ void __launch_bounds__(512, 2) fwd_megakernel(Params p) {
  __shared__ __attribute__((aligned(16))) unsigned char lds[LDS_BYTES];
  cg::grid_group grid = cg::this_grid();
  const int wave_id = __builtin_amdgcn_readfirstlane((int)threadIdx.x >> 6);
#define FRESH_TID() int tid = wave_id * 64 + lane_id(); asm volatile("" : "+v"(tid)); const int half = tid >> 8, htid = tid & 255; unsigned char* ldsh = lds + half * HALF_LDS; (void)htid; (void)ldsh;
  if (p.out == nullptr) grid.sync();
  if (wave_id == 0 && lane_id() == 0) (void)xb_add(&p.bar()[XB_XCNT(xb_xcc_id())], 1u);
  for (int rep = 0; rep < REP0; ++rep) {
  { FRESH_TID(); phase_prep(p, tid); }
  xcd_barrier(p.bar(), wave_id);
  }
  for (int rep = 0; rep < REP1; ++rep) {
  {
    FRESH_TID();
    pg8::Gemm g; g.A = p.xb(); g.Bt = p.WtIn(); g.M = NTOK; g.N = 4096; g.K = 1024;
    pg8::StaticOrder S; S.init(g.M, g.N, (int)gridDim.x, (int)blockIdx.x); S.permtab = 0xEFBCD87694105A32ull; S.padtile = 15;
    Epi1 E; E.p = p; E.hl0 = (LAS unsigned char*)lds + pg8::STAGE_BYTES;
    pg8::gemm_phase<Epi1>((LAS unsigned char*)lds, g, S, E, wave_id);
  }
  xcd_barrier(p.bar(), wave_id);
  }
  for (int rep = 0; rep < REP2; ++rep) {
  {
    FRESH_TID();
    for (int it0 = blockIdx.x * 2; it0 < 2080 + 2080; it0 += gridDim.x * 2) {
      const int it = it0 + half;
      int ht = htid; asm volatile("" : "+v"(ht));
      if (it < 2080) {
        const bool samp = it < 32;
        const int j = it - 32;
        const int c = 31 - (j >> 6);
        const int b = samp ? (it >> 2) : ((j & 63) >> 2);
        const int grp = samp ? (it & 3) : (c * 4 + (j & 3));
        idx_item(p, ldsh, ht, samp, b, grp);
      } else { for (int rkv = 0; rkv < REPKV; ++rkv) ret_kv_item(p, it - 2080, ht); }
    }
  }
  xcd_barrier(p.bar(), wave_id);
  }
  for (int rep = 0; rep < REP3; ++rep) {
  {
    FRESH_TID();
    for (int it0 = blockIdx.x * 2; it0 < 1056 + 1536; it0 += gridDim.x * 2) {
      const int it = it0 + half;
      int ht = htid; asm volatile("" : "+v"(ht));
      if (it < 1056) {
        const bool samp = it < 32;
        const int j = it - 32;
        int c = samp ? 0 : 31 - (j >> 6);
        int b = samp ? (it >> 2) : ((j & 63) >> 2);
        int kvh = (it >> 1) & 1;
        if (!samp && gridDim.x == 256) {
          const int jb = (j >> 1) & 255, rnd = j >> 9;
          const int xcd = jb & 7, ii = jb >> 3;
          b = 2 * xcd + (ii & 1); kvh = (ii >> 1) & 1; c = 31 - rnd * 8 - (ii >> 2);
        }
        attn_item(p, ldsh, ht, samp, b, c, kvh, it & 1, lds, tid);
      } else scan_item(p, it - 1056, ht);
    }
  }
  xcd_barrier(p.bar(), wave_id);
  }
  for (int rep = 0; rep < REP4; ++rep) {
  {
    FRESH_TID();
    for (int it0 = blockIdx.x * 2; it0 < 2080 + 1024; it0 += gridDim.x * 2) {
      const int it = it0 + half;
      int ht = htid; asm volatile("" : "+v"(ht));
      if (it < 2080) ret_out_item(p, ldsh, it, ht);
      else {
        const int ia = it - 2080 + 1056;
        const int j = ia - 32;
        int c = 31 - (j >> 6);
        int b = (j & 63) >> 2;
        int kvh = (ia >> 1) & 1;
        if (gridDim.x == 256) {
          const int jb = (j >> 1) & 255, rnd = j >> 9;
          const int xcd = jb & 7, ii = jb >> 3;
          b = 2 * xcd + (ii & 1); kvh = (ii >> 1) & 1; c = 31 - rnd * 8 - (ii >> 2);
        }
        attn_item(p, ldsh, ht, false, b, c, kvh, ia & 1, lds, tid);
      }
    }
  }
  xcd_barrier(p.bar(), wave_id);
  }
  for (int rep = 0; rep < REP5; ++rep) {
  {
    pg8::Gemm g; g.A = p.mix(); g.Bt = p.WtOut(); g.M = NTOK; g.N = 1024; g.K = 1024;
    pg8::StaticOrder S; S.init(g.M, g.N, (int)gridDim.x, (int)blockIdx.x);
    Epi2 E; E.p = p; E.hl = lds + pg8::STAGE_BYTES + (wave_id >> 2) * 16384;
    pg8::gemm_phase<Epi2>((LAS unsigned char*)lds, g, S, E, wave_id);
  }
  xcd_barrier(p.bar(), wave_id);
  }
  { FRESH_TID(); phase_final(p, tid); }
}

extern "C" void kernel_launch(void* const* d_in, const int* in_sizes, int n_in, void* d_out, int out_size, void* d_ws,
                              size_t ws_size, hipStream_t stream) {
  static int grid_blocks = 0;
  if (!grid_blocks) {
    int dev = 0, cus = 0, per_cu = 0;
    (void)hipGetDevice(&dev);
    (void)hipDeviceGetAttribute(&cus, hipDeviceAttributeMultiprocessorCount, dev);
    (void)hipOccupancyMaxActiveBlocksPerMultiprocessor(&per_cu, fwd_megakernel, 512, 0);
    if (per_cu < 1) per_cu = 1;
    if (per_cu > 1) per_cu = 1;
    grid_blocks = cus * per_cu;
  }
  Params p{};
  p.x_p = (const float*)d_in[0]; p.x_s = (const float*)d_in[1]; p.state_ret = (const float*)d_in[2];
  p.cache_k = (const float*)d_in[3]; p.cache_v = (const float*)d_in[4]; p.cache_kidx = (const float*)d_in[5];
  p.norm_g = (const float*)d_in[6]; p.w_in = (const float*)d_in[7]; p.ret_gn_g = (const float*)d_in[8];
  p.w_out = (const float*)d_in[9]; p.final_g = (const float*)d_in[10];
  p.out = (float*)d_out;
  p.ws = (unsigned char*)d_ws;
  (void)hipMemsetAsync((unsigned char*)d_ws + 530573312ull, 0, (size_t)XCD_BAR_WORDS * 4, stream);
  void* args[] = {&p};
  hipError_t e = hipLaunchCooperativeKernel((void*)fwd_megakernel, dim3(grid_blocks), dim3(512), args, 0, stream);
  if (e != hipSuccess) fprintf(stderr, "cooperative launch failed: %s (grid %d)\n", hipGetErrorString(e), grid_blocks);
}
```

```cpp
#include <hip/hip_runtime.h>
#include <hip/hip_cooperative_groups.h>
#include <stdint.h>
#include <cstdio>
namespace cg = cooperative_groups;

typedef __attribute__((ext_vector_type(8))) short bf16x8;
typedef __attribute__((ext_vector_type(4))) short s16x4;
typedef __attribute__((ext_vector_type(16))) float f32x16;
typedef __attribute__((ext_vector_type(4))) float f32x4;
typedef unsigned short u16;
typedef unsigned long long u64;


#define DI __device__ __forceinline__
#define MFMA32(a, b, c) __builtin_amdgcn_mfma_f32_32x32x16_bf16((a), (b), (c), 0, 0, 0)
#define MFMA16(a, b, c) __builtin_amdgcn_mfma_f32_16x16x32_bf16((a), (b), (c), 0, 0, 0)

#define NTOK 33280
#define NPROMPT 32768
#define LDS_BYTES 163840
#define HALF_LDS 81920
#define LAS __attribute__((address_space(3)))
#define KPITCH 2116

struct Params {
  const float *x_p, *x_s, *state_ret, *cache_k, *cache_v, *cache_kidx, *norm_g, *w_in, *ret_gn_g, *w_out, *final_g;
  float* out;
  unsigned char* ws;
  DI u16* xb() const { return (u16*)(ws + 0ull); }
  DI float* kvT() const { return (float*)(ws + 0ull); }
  DI u16* WtIn() const { return (u16*)(ws + 136314880ull); }
  DI u16* WtOut() const { return (u16*)(ws + 144703488ull); }
  DI u16* qr() const { return (u16*)(ws + 146800640ull); }
  DI u16* kr() const { return (u16*)(ws + 180879360ull); }
  DI u16* sprevT() const { return (u16*)(ws + 214958080ull); }
  DI u16* qi() const { return (u16*)(ws + 214958080ull); }
  DI u16* krT() const { return (u16*)(ws + 249036800ull); }
  DI u16* vrT() const { return (u16*)(ws + 283115520ull); }
  DI u16* gate() const { return (u16*)(ws + 317194240ull); }
  DI u16* mix() const { return (u16*)(ws + 385351680ull); }
  DI u16* qa() const { return (u16*)(ws + 453509120ull); }
  DI u16* kaP() const { return (u16*)(ws + 487587840ull); }
  DI u16* kaS() const { return (u16*)(ws + 495976448ull); }
  DI u16* vaTP() const { return (u16*)(ws + 500301824ull); }
  DI u16* vaTS() const { return (u16*)(ws + 508690432ull); }
  DI u16* kiP() const { return (u16*)(ws + 513015808ull); }
  DI u16* kiS() const { return (u16*)(ws + 517210112ull); }
  DI float* rinv() const { return (float*)(ws + 519372800ull); }
  DI float* wi() const { return (float*)(ws + 519505920ull); }
  DI float* cosR() const { return (float*)(ws + 520570880ull); }
  DI float* sinR() const { return (float*)(ws + 521111552ull); }
  DI float* cosA() const { return (float*)(ws + 521652224ull); }
  DI float* sinA() const { return (float*)(ws + 521719808ull); }
  DI unsigned* bar() const { return (unsigned*)(ws + 530573312ull); }
  DI u64* maskbits() const { return (u64*)(ws + 521787392ull); }
};

#define OUT_Y 0
#define OUT_STP (34078720)
#define OUT_KP (OUT_STP + 1048576)
#define OUT_VP (OUT_KP + 4194304)
#define OUT_KIP (OUT_VP + 4194304)
#define OUT_STS (OUT_KIP + 2097152)
#define OUT_KS (OUT_STS + 524288)
#define OUT_VS (OUT_KS + 65536)
#define OUT_KIS (OUT_VS + 65536)

typedef __bf16 bf16x2_t __attribute__((ext_vector_type(2)));
typedef float f32x2_t __attribute__((ext_vector_type(2)));
typedef unsigned u32x4_t __attribute__((ext_vector_type(4)));
typedef unsigned u32x2_t __attribute__((ext_vector_type(2)));
DI unsigned pk2(float a, float b) { f32x2_t v = {a, b}; bf16x2_t r = __builtin_convertvector(v, bf16x2_t); return __builtin_bit_cast(unsigned, r); }
DI u16 f2bf(float x) { return (u16)(pk2(x, x) & 0xffffu); }
DI bf16x8 ldg8(const u16* p) { return *(const bf16x8*)p; }
DI s16x4 ldg4(const u16* p) { return *(const s16x4*)p; }
DI float siluf(float x) { return x * __builtin_amdgcn_rcpf(1.f + __builtin_amdgcn_exp2f(-1.4426950408889634f * x)); }
DI int lane_id() { return (int)__builtin_amdgcn_mbcnt_hi(~0u, __builtin_amdgcn_mbcnt_lo(~0u, 0u)); }
DI int crow(int reg, int hh) { return (reg & 3) + 8 * (reg >> 2) + 4 * hh; }
DI const float* xrow(const Params& p, int g) { return g < NPROMPT ? p.x_p + (size_t)g * 1024 : p.x_s + (size_t)(g - NPROMPT) * 1024; }
DI float log2gamma(int h) { return log1pf(-exp2f(-5.f - (float)h)) * 1.4426950408889634f; }
DI bf16x8 pack8(float a0, float a1, float a2, float a3, float a4, float a5, float a6, float a7) {
  u32x4_t v = {pk2(a0, a1), pk2(a2, a3), pk2(a4, a5), pk2(a6, a7)};
  return __builtin_bit_cast(bf16x8, v);
}
DI s16x4 pack4(f32x4 v) { u32x2_t o = {pk2(v[0], v[1]), pk2(v[2], v[3])}; return __builtin_bit_cast(s16x4, o); }
DI int wave_sum(int v) {
  v += __builtin_amdgcn_update_dpp(0, v, 0xB1, 0xf, 0xf, false);
  v += __builtin_amdgcn_update_dpp(0, v, 0x4E, 0xf, 0xf, false);
  v += __builtin_amdgcn_update_dpp(0, v, 0x124, 0xf, 0xf, false);
  v += __builtin_amdgcn_update_dpp(0, v, 0x128, 0xf, 0xf, false);
  return __builtin_amdgcn_readlane(v, 0) + __builtin_amdgcn_readlane(v, 16) + __builtin_amdgcn_readlane(v, 32) + __builtin_amdgcn_readlane(v, 48);
}
DI f32x16 zero16() { f32x16 z; for (int i = 0; i < 16; ++i) z[i] = 0.f; return z; }

#define XB_TMO      128
#define XB_XCNT(j)  (256  + 64 * (j))
#define XB_XSUB(j)  (1280 + 64 * (j))
#define XB_XGEN(j)  (2304 + 64 * (j))
#define XB_TOP      3328
#define XB_TOPGEN   3392
#define XB_WG(i)    (3456 + 64 * (i))
#define XCD_BAR_WORDS (3456 + 64 * 256)
#define XB_SPIN_CAP (1u << 18)
DI unsigned xb_ld(unsigned* p) { return __hip_atomic_load(p, __ATOMIC_RELAXED, __HIP_MEMORY_SCOPE_AGENT); }
DI unsigned xb_add(unsigned* p, unsigned v) { return __hip_atomic_fetch_add(p, v, __ATOMIC_RELAXED, __HIP_MEMORY_SCOPE_AGENT); }
DI unsigned xb_xcc_id() { return (unsigned)__builtin_amdgcn_s_getreg((3 << 11) | 20) & 0xFu; }
#define XB_SPIN(cond, bar) do { unsigned _sp = 0; while (cond) { __builtin_amdgcn_s_sleep(1); \
    if ((++_sp & 255u) == 0u) { if (xb_ld(&(bar)[XB_TMO])) break; if (_sp > XB_SPIN_CAP) { atomicAdd(&(bar)[XB_TMO], 1u); break; } } } } while (0)
DI void xcd_barrier(unsigned* bar, int wave_id) {
  asm volatile("s_waitcnt vmcnt(0)" ::: "memory");
  __syncthreads();
  if (wave_id == 0) {
    int lane = lane_id(); asm volatile("" : "+v"(lane));
    const unsigned x = xb_xcc_id();
    unsigned* slot = &bar[XB_WG(blockIdx.x)];
    unsigned nloc = 0u, nx = 0u;
    if (lane < 2) nloc = xb_ld(slot + lane);
    nx = (unsigned)__builtin_amdgcn_readlane((int)nloc, 1);
    nloc = (unsigned)__builtin_amdgcn_readlane((int)nloc, 0);
    if (nloc == 0u) {
      const unsigned G = gridDim.x * gridDim.y * gridDim.z;
      unsigned sp = 0u, c = 0u;
      for (;;) {
        c = (lane < 16) ? xb_ld(&bar[XB_XCNT(lane)]) : 0u;
        const unsigned sum = (unsigned)wave_sum((int)c);
        if (sum == G) break;
        __builtin_amdgcn_s_sleep(1);
        if ((++sp & 255u) == 0u) { if (xb_ld(&bar[XB_TMO])) break; if (sp > XB_SPIN_CAP) { if (lane == 0) atomicAdd(&bar[XB_TMO], 1u); break; } }
      }
      nx = (unsigned)__popcll(__ballot(c > 0u));
      nloc = (unsigned)__builtin_amdgcn_readlane((int)c, (int)x);
      nloc = nloc > 0u ? nloc : 1u; nx = nx > 0u ? nx : 1u;
      if (lane == 0) { __hip_atomic_store(slot, nloc, __ATOMIC_RELAXED, __HIP_MEMORY_SCOPE_AGENT); __hip_atomic_store(slot + 1, nx, __ATOMIC_RELAXED, __HIP_MEMORY_SCOPE_AGENT); }
    }
    if (lane == 0) {
      __builtin_amdgcn_s_waitcnt(0);
      const unsigned old = xb_add(&bar[XB_XSUB(x)], 1u);
      const unsigned gen = old / nloc;
      if (old + 1u == (gen + 1u) * nloc) {
        __builtin_amdgcn_fence(__ATOMIC_RELEASE, "agent");
        asm volatile("s_waitcnt vmcnt(0)" ::: "memory");
        const unsigned og = xb_add(&bar[XB_TOP], 1u);
        const unsigned tg = og / nx;
        if (og + 1u == (tg + 1u) * nx) xb_add(&bar[XB_TOPGEN], 1u);
        else XB_SPIN(xb_ld(&bar[XB_TOPGEN]) == tg, bar);
        __builtin_amdgcn_fence(__ATOMIC_ACQUIRE, "agent");
        xb_add(&bar[XB_XGEN(x)], 1u);
        asm volatile("s_waitcnt vmcnt(0)" ::: "memory");
      } else {
        XB_SPIN(xb_ld(&bar[XB_XGEN(x)]) == gen, bar);
        __builtin_amdgcn_fence(__ATOMIC_ACQUIRE, "agent");
        asm volatile("s_waitcnt vmcnt(0)" ::: "memory");
      }
    }
  }
  __syncthreads();
}

DI void phase_prep(const Params& p, int tid) {
  const int gt = blockIdx.x * 512 + tid, GT = gridDim.x * 512;
  const int lane = tid & 63;
  for (int row0 = (gt >> 6) * 2; row0 < NTOK; row0 += (GT >> 6) * 2) {
    f32x4 v[2][4];
#pragma unroll
    for (int rr = 0; rr < 2; ++rr) {
      const float* sp = xrow(p, row0 + rr);
#pragma unroll
      for (int i = 0; i < 4; ++i) v[rr][i] = __builtin_nontemporal_load((const f32x4*)(sp + i * 256 + lane * 4));
    }
#pragma unroll
    for (int rr = 0; rr < 2; ++rr) {
      float ss = 0.f;
#pragma unroll
      for (int i = 0; i < 4; ++i) ss += v[rr][i][0] * v[rr][i][0] + v[rr][i][1] * v[rr][i][1] + v[rr][i][2] * v[rr][i][2] + v[rr][i][3] * v[rr][i][3];
#pragma unroll
      for (int o = 32; o >= 1; o >>= 1) ss += __shfl_xor(ss, o);
#pragma unroll
      for (int i = 0; i < 4; ++i) *(s16x4*)(p.xb() + (size_t)(row0 + rr) * 1024 + i * 256 + lane * 4) = pack4(v[rr][i]);
      if (lane == 0) p.rinv()[row0 + rr] = rsqrtf(ss * (1.f / 1024.f) + 1e-6f);
    }
  }
  for (int i = gt; i < 4096 * 128; i += GT) {
    int n = i & 4095, kg = i >> 12;
    int sc = n;
    if (n < 1024) { const int P = n & 127; sc = (n & ~127) + 64 * ((P >> 4) & 1) + 16 * (P >> 5) + (P & 15); }
    float a[8];
    const float vmask = (n < 3912) ? 1.f : 0.f; const int scc = (sc < 3912) ? sc : 3911;
#pragma unroll
    for (int j = 0; j < 8; ++j) a[j] = p.w_in[(size_t)(kg * 8 + j) * 3912 + scc] * p.norm_g[kg * 8 + j] * vmask;
    *(bf16x8*)(p.WtIn() + (size_t)n * 1024 + kg * 8) = pack8(a[0], a[1], a[2], a[3], a[4], a[5], a[6], a[7]);
  }
  for (int i = gt; i < 1024 * 128; i += GT) {
    int n = i % 1024, kg = i / 1024;
    float a[8];
#pragma unroll
    for (int j = 0; j < 8; ++j) a[j] = p.w_out[(size_t)(kg * 8 + j) * 1024 + n];
    *(bf16x8*)(p.WtOut() + (size_t)n * 1024 + kg * 8) = pack8(a[0], a[1], a[2], a[3], a[4], a[5], a[6], a[7]);
  }
  for (int i = gt; i < 2112 * 64; i += GT) {
    int pos = i >> 6, k = i & 63;
    float inv = powf(10000.f, -(float)k / 64.f);
    float ang = (float)pos * inv;
    p.cosR()[i] = cosf(ang); p.sinR()[i] = sinf(ang);
  }
  for (int i = gt; i < 2112 * 8; i += GT) {
    int pos = i >> 3, k = i & 7;
    float inv = powf(500000.f, -(float)k / 8.f);
    float ang = (float)pos * inv;
    p.cosA()[i] = cosf(ang); p.sinA()[i] = sinf(ang);
  }
  for (int i = gt; i < 8 * 2048 * 2 * 8; i += GT) {
    int dg = i & 7, kvh = (i >> 3) & 1, t = (i >> 4) & 2047, b = i >> 15;
    const float* s = p.cache_k + ((size_t)(b * 2048 + t) * 2 + kvh) * 64 + dg * 8;
    *(bf16x8*)(p.kaS() + ((size_t)(b * 2 + kvh) * 2112 + t) * 64 + dg * 8) = pack8(s[0], s[1], s[2], s[3], s[4], s[5], s[6], s[7]);
  }
  for (int i = gt; i < 8 * 2 * 256 * 64; i += GT) {
    int d = i & 63, tg = (i >> 6) & 255, kvh = (i >> 14) & 1, b = i >> 15;
    float a[8];
#pragma unroll
    for (int j = 0; j < 8; ++j) a[j] = p.cache_v[((size_t)(b * 2048 + tg * 8 + j) * 2 + kvh) * 64 + d];
    *(bf16x8*)(p.vaTS() + ((size_t)(b * 2 + kvh) * 64 + d) * 2112 + tg * 8) = pack8(a[0], a[1], a[2], a[3], a[4], a[5], a[6], a[7]);
  }
  for (int i = gt; i < 8 * 2048 * 8; i += GT) {
    int dg = i & 7, t = (i >> 3) & 2047, b = i >> 14;
    const float* s = p.cache_kidx + (size_t)(b * 2048 + t) * 64 + dg * 8;
    *(bf16x8*)(p.kiS() + ((size_t)b * 2112 + t) * 64 + dg * 8) = pack8(s[0], s[1], s[2], s[3], s[4], s[5], s[6], s[7]);
  }
}

namespace pg8 {
constexpr int BM = 256, BK = 64, HALF = 128, HTB = HALF * BK * 2, STAGE_BYTES = 8 * HTB, NXCD = 8, WGM = 8;
DI int lds_byte(int r, int c) { const int st = (r >> 4) * 2 + (c >> 5), rr = r & 15, cc = c & 31, ob = rr * 64 + cc * 2; return st * 1024 + (ob ^ (((ob >> 9) & 1) << 5)); }
DI void stage_rc(int b, int& R, int& C) { const int st = b / 1024, sb = b % 1024, swz = sb ^ (((sb >> 9) & 1) << 5); R = (st >> 1) * 16 + swz / 64; C = (st & 1) * 32 + (swz % 64) / 2; }
struct Unit { int pm, pn; };
struct Gemm { const u16* A; const u16* Bt; int M, N, K; };
struct StaticOrder {
  int nM, nN, nwg, G, c, padtile; unsigned long long permtab;
  DI void init(int M, int N, int G_, int c_) { nM = M / BM; nN = N / BM; nwg = nM * nN; G = G_; c = c_; permtab = 0xFEDCBA9876543210ull; padtile = -1; }
  DI void map(int L, Unit& u) const {
    int wgid = L; { const int q = nwg / NXCD, r = nwg % NXCD, xcd = wgid % NXCD, off = wgid / NXCD; wgid = (xcd < r ? xcd * (q + 1) : r * (q + 1) + (xcd - r) * q) + off; }
    const int nig = WGM * nN, gid = wgid / nig, fm = gid * WGM, gsz = (nM - fm) < WGM ? (nM - fm) : WGM;
    u.pm = fm + ((wgid % nig) % gsz); u.pn = (int)((permtab >> (4 * ((wgid % nig) / gsz))) & 15ull);
  }
  DI bool next(int i, Unit& u) const {
    const long Ll = (long)i * G + c; if (Ll >= nwg) return false;
    const int L = (int)Ll;
    if (padtile < 0) { map(L, u); return true; }
    const int tail = nwg % G, base = nwg - tail;
    if (L >= base) { u.pm = L - base; u.pn = padtile; return true; }
    map(L, u);
    for (int it = 0; it < 64 && u.pn == padtile && u.pm < tail; ++it) map(base + u.pm, u);
    return true;
  }
};
template <class Epi>
DI void gemm_phase(LAS unsigned char* lds, const Gemm g, const StaticOrder& S, const Epi& E, int wave_id) {
  const int wid = wave_id; int lane = lane_id(); asm volatile("" : "+v"(lane)); const int tid = wid * 64 + lane;
  const int wr = wid >> 2, wc = wid & 3, fr = lane & 15, fq = lane >> 4;
  const int K = g.K, nt = K / BK;
  unsigned voffA[2], voffB[2];
#pragma unroll
  for (int i = 0; i < 2; ++i) { int R, C; stage_rc(tid * 16 + i * 8192, R, C); voffA[i] = (unsigned)(R * K + C) * 2u; voffB[i] = voffA[i]; }
  const size_t kstep = (size_t)(BK * 2);
  const size_t hstep = (size_t)HALF * K * 2;
  const size_t tstep = 2 * hstep;
  const unsigned ldsw = (unsigned)wid * 1024u;
  const int aoff = lds_byte(wr * 64 + fr, fq * 8), boff = lds_byte(wc * 32 + fr, fq * 8);
#define PG8_SA(b, h) (((b) * 2 + (h)) * HTB)
#define PG8_SB(b, h) ((4 + (b) * 2 + (h)) * HTB)
#define PG8_STAGE(bufoff, gbase, voff) do { _Pragma("unroll") for (int _i = 0; _i < 2; ++_i) \
    __builtin_amdgcn_global_load_lds((const unsigned*)((const char*)(gbase) + (voff)[_i]), (LAS unsigned*)(lds + (bufoff) + ldsw + _i * 8192), 16, 0, 0); } while (0)
#define PG8_LDA(dst, b, h) do { _Pragma("unroll") for (int m = 0; m < 4; ++m) _Pragma("unroll") for (int k = 0; k < 2; ++k) dst[m][k] = *(const LAS bf16x8*)(lds + PG8_SA(b, h) + aoff + m * 2048 + k * 1024); } while (0)
#define PG8_LDB(dst, b, h) do { _Pragma("unroll") for (int n = 0; n < 2; ++n) _Pragma("unroll") for (int k = 0; k < 2; ++k) dst[n][k] = *(const LAS bf16x8*)(lds + PG8_SB(b, h) + boff + n * 2048 + k * 1024); } while (0)
#define PG8_MMA(ai, bj, At, Bt) do { __builtin_amdgcn_s_setprio(1); _Pragma("unroll") for (int m = 0; m < 4; ++m) _Pragma("unroll") for (int n = 0; n < 2; ++n) _Pragma("unroll") for (int k = 0; k < 2; ++k) \
    acc[ai][bj][m][n] = __builtin_amdgcn_mfma_f32_16x16x32_bf16(Bt[n][k], At[m][k], acc[ai][bj][m][n], 0, 0, 0); __builtin_amdgcn_s_setprio(0); } while (0)
#define PG8_WAIT_V(n) asm volatile("s_waitcnt vmcnt(" #n ")" ::: "memory")
#define PG8_WAIT_L(n) asm volatile("s_waitcnt lgkmcnt(" #n ")" ::: "memory")
#define PG8_BAR __builtin_amdgcn_s_barrier()
#define PG8_SCHED __builtin_amdgcn_sched_barrier(0)
  Unit cur, nxt; int ui = 0;
  if (!S.next(0, cur)) return;
  f32x4 acc[2][2][4][2];
#pragma unroll
  for (int a = 0; a < 2; ++a)
#pragma unroll
    for (int b = 0; b < 2; ++b)
#pragma unroll
      for (int m = 0; m < 4; ++m)
#pragma unroll
        for (int n = 0; n < 2; ++n) acc[a][b][m][n] = (f32x4){0.f, 0.f, 0.f, 0.f};
  bf16x8 At[4][2], B0[2][2], B1[2][2];
  const char* cA = (const char*)g.A + (size_t)cur.pm * tstep; const char* cB = (const char*)g.Bt + (size_t)cur.pn * tstep;
  PG8_STAGE(PG8_SB(0, 0), cB, voffB); PG8_STAGE(PG8_SA(0, 0), cA, voffA); PG8_STAGE(PG8_SB(0, 1), cB + hstep, voffB); PG8_STAGE(PG8_SA(0, 1), cA + hstep, voffA);
  if (wr == 1) PG8_BAR;
  PG8_WAIT_V(4); PG8_BAR;
  PG8_STAGE(PG8_SB(1, 0), cB + kstep, voffB); PG8_STAGE(PG8_SA(1, 0), cA + kstep, voffA); PG8_STAGE(PG8_SB(1, 1), cB + hstep + kstep, voffB);
  PG8_WAIT_V(6); PG8_BAR;
  for (;;) {
    const bool has_next = S.next(ui + 1, nxt);
    const char* nA = has_next ? (const char*)g.A + (size_t)nxt.pm * tstep : cA; const char* nB = has_next ? (const char*)g.Bt + (size_t)nxt.pn * tstep : cB;
#ifndef REPK
#define REPK 1
#endif
    const bool skip1 = (S.padtile >= 0) && (cur.pn == S.padtile);
    for (int rk = 0; rk < REPK; ++rk) {
    const char* nA2 = (rk == REPK - 1) ? nA : cA; const char* nB2 = (rk == REPK - 1) ? nB : cB;
    for (int t = 0; t < nt; t += 2) {
      const bool last = (t == nt - 2);
      const char* a1 = cA + (size_t)(t + 1) * kstep;
      const char* a2 = last ? nA2 : cA + (size_t)(t + 2) * kstep; const char* b2 = last ? nB2 : cB + (size_t)(t + 2) * kstep;
      const char* a3 = a2 + kstep; const char* b3 = b2 + kstep;
      PG8_LDB(B0, 0, 0); PG8_SCHED; PG8_LDA(At, 0, 0); PG8_STAGE(PG8_SA(1, 1), a1 + hstep, voffA);
      PG8_WAIT_L(8); PG8_BAR; PG8_WAIT_L(0); PG8_MMA(0, 0, At, B0); PG8_BAR; PG8_SCHED;
      PG8_LDB(B1, 0, 1); PG8_STAGE(PG8_SB(0, 0), b2, voffB);
      PG8_BAR; PG8_WAIT_L(0); if (!skip1) PG8_MMA(0, 1, At, B1); PG8_BAR;
      PG8_LDA(At, 0, 1); PG8_STAGE(PG8_SA(0, 0), a2, voffA);
      PG8_BAR; PG8_WAIT_L(0); PG8_MMA(1, 0, At, B0); PG8_BAR; PG8_SCHED;
      PG8_STAGE(PG8_SB(0, 1), b2 + hstep, voffB);
      PG8_WAIT_V(6); PG8_BAR; if (!skip1) PG8_MMA(1, 1, At, B1); PG8_BAR;
      PG8_LDB(B0, 1, 0); PG8_SCHED; PG8_LDA(At, 1, 0); PG8_STAGE(PG8_SA(0, 1), a2 + hstep, voffA);
      PG8_WAIT_L(8); PG8_BAR; PG8_WAIT_L(0); PG8_MMA(0, 0, At, B0); PG8_BAR; PG8_SCHED;
      PG8_LDB(B1, 1, 1); PG8_STAGE(PG8_SB(1, 0), b3, voffB);
      PG8_BAR; PG8_WAIT_L(0); if (!skip1) PG8_MMA(0, 1, At, B1); PG8_BAR;
      PG8_LDA(At, 1, 1); PG8_STAGE(PG8_SA(1, 0), a3, voffA);
      PG8_BAR; PG8_WAIT_L(0); PG8_MMA(1, 0, At, B0); PG8_BAR; PG8_SCHED;
      PG8_STAGE(PG8_SB(1, 1), b3 + hstep, voffB);
      PG8_WAIT_V(6); PG8_BAR; if (!skip1) PG8_MMA(1, 1, At, B1); PG8_BAR;
    }
    }
    {
      Unit eu = cur; int ewr = wr, ewc = wc; int el = lane_id();
      asm volatile("" : "+s"(eu.pm), "+s"(eu.pn), "+s"(ewr), "+s"(ewc), "+v"(el));
      int efr = el & 15, efq = el >> 4;
#ifndef REPEPI
#define REPEPI 1
#endif
      for (int re = 0; re < REPEPI; ++re) E(acc, eu, ewr, ewc, efr, efq, re);
    }
    if (!has_next) break;
#pragma unroll
    for (int a = 0; a < 2; ++a)
#pragma unroll
      for (int b = 0; b < 2; ++b)
#pragma unroll
        for (int m = 0; m < 4; ++m)
#pragma unroll
          for (int n = 0; n < 2; ++n) acc[a][b][m][n] = (f32x4){0.f, 0.f, 0.f, 0.f};
    cur = nxt; cA = nA; cB = nB; ++ui;
  }
  PG8_WAIT_V(0);
  if (wr == 0) PG8_BAR;
  PG8_BAR;
#undef PG8_SA
#undef PG8_SB
#undef PG8_STAGE
#undef PG8_LDA
#undef PG8_LDB
#undef PG8_MMA
#undef PG8_WAIT_V
#undef PG8_WAIT_L
#undef PG8_BAR
#undef PG8_SCHED
}
}


DI unsigned hx_w(int row, int c8) { return (unsigned)(row * 256 + ((c8 ^ ((row & 15) << 1)) << 3)); }
DI unsigned hx_r(int row, int c16) { return (unsigned)(row * 256 + ((c16 ^ (row & 15)) << 4)); }
#define EPI_BAR() asm volatile("s_waitcnt lgkmcnt(0)\n\ts_barrier" ::: "memory")


struct Epi1 {
  Params p; LAS unsigned char* hl0;
  DI void make_tabs(f32x4 (&tc)[4], f32x4 (&ts)[4], f32x4 c0, f32x4 s0, f32x4 c16, f32x4 s16) const {
    tc[0] = c0; ts[0] = s0;
#pragma unroll
    for (int m = 1; m < 4; ++m) { tc[m] = tc[m - 1] * c16 - ts[m - 1] * s16; ts[m] = ts[m - 1] * c16 + tc[m - 1] * s16; }
  }
  template <int AI, int BJ>
  DI void compute(f32x4 (&acc)[2][2][4][2], const f32x4 (&tc)[4], const f32x4 (&ts)[4], int blk, int wc, int fq) const {
    if (blk < 8) {
#pragma unroll
      for (int m = 0; m < 4; ++m) {
        const f32x4 v0 = acc[AI][BJ][m][0], v1 = acc[AI][BJ][m][1];
        f32x4 o0 = v0 * tc[m] - v1 * ts[m], o1 = v1 * tc[m] + v0 * ts[m];
        if (blk >= 4) { o0 *= 0.08838834764831845f; o1 *= 0.08838834764831845f; }
        acc[AI][BJ][m][0] = o0; acc[AI][BJ][m][1] = o1;
      }
    } else if ((blk >= 12 && blk < 16) || (blk >= 22 && blk < 26)) {
#pragma unroll
      for (int m = 0; m < 4; ++m)
#pragma unroll
        for (int n = 0; n < 2; ++n) {
          f32x4 v = acc[AI][BJ][m][n];
          v[0] = siluf(v[0]); v[1] = siluf(v[1]); v[2] = siluf(v[2]); v[3] = siluf(v[3]);
          acc[AI][BJ][m][n] = v;
        }
    } else if ((blk >= 8 && blk < 12) || blk == 21 || blk == 31) {
    } else {
      const bool ropew = ((wc & 1) == 0) && !(blk == 30 && wc >= 2);
      if (ropew) {
#pragma unroll
        for (int m = 0; m < 4; ++m) {
          const f32x4 v0 = acc[AI][BJ][m][0];
          f32x4 pr;
          pr[0] = __shfl_xor(v0[0], 32); pr[1] = __shfl_xor(v0[1], 32); pr[2] = __shfl_xor(v0[2], 32); pr[3] = __shfl_xor(v0[3], 32);
          acc[AI][BJ][m][0] = (fq < 2) ? v0 * tc[m] - pr * ts[m] : v0 * tc[m] + pr * ts[m];
        }
      }
      if (blk < 20) {
        const float sc = 0.125f * 1.4426950408889634f;
#pragma unroll
        for (int m = 0; m < 4; ++m) { acc[AI][BJ][m][0] *= sc; acc[AI][BJ][m][1] *= sc; }
      }
    }
  }
  template <int AI, int BJ>
  DI void emit(f32x4 (&acc)[2][2][4][2], const pg8::Unit& u, int blk, bool samp, int wr, int wc, int fr, int fq) const {
    if (blk == 31) return;
    LAS unsigned char* hl = hl0 + wr * 16384;
    asm volatile("" : "+v"(fr), "+v"(fq));
    const int lane = fr + 16 * fq;
    const int P0 = 32 * wc + 4 * fq;
    const int R0 = u.pm * 256 + AI * 128 + wr * 64;
    int b, tb;
    if (!samp) { b = R0 >> 11; tb = R0 & 2047; } else { b = (R0 - NPROMPT) >> 6; tb = 0; }
    const bool retk = blk < 8;
    const bool hasT = (blk >= 4 && blk < 12) || blk == 21;
    const bool hasN = !(blk >= 8 && blk < 12) && blk != 21;
    if (blk == 20 || blk == 21) {
      float* ob = samp ? p.out + (blk == 20 ? OUT_KS : OUT_VS) + (unsigned)(R0 - NPROMPT) * 128u : p.out + (blk == 20 ? OUT_KP : OUT_VP) + (unsigned)R0 * 128u;
#pragma unroll
      for (int m = 0; m < 4; ++m) {
        float* o2 = ob + (unsigned)(16 * m + fr) * 128u + P0;
        __builtin_nontemporal_store(acc[AI][BJ][m][0], (f32x4*)o2); __builtin_nontemporal_store(acc[AI][BJ][m][1], (f32x4*)(o2 + 16));
      }
    } else if (blk == 30) {
      float* ob = samp ? p.out + OUT_KIS + (unsigned)(R0 - NPROMPT) * 64u : p.out + OUT_KIP + (unsigned)R0 * 64u;
      float* wb = p.wi() + (unsigned)R0 * 8u;
#pragma unroll
      for (int m = 0; m < 4; ++m) {
        if (wc < 2) {
          float* o2 = ob + (unsigned)(16 * m + fr) * 64u + P0;
          __builtin_nontemporal_store(acc[AI][BJ][m][0], (f32x4*)o2); __builtin_nontemporal_store(acc[AI][BJ][m][1], (f32x4*)(o2 + 16));
        } else if (wc == 2 && fq < 2) {
          *(f32x4*)(wb + (unsigned)(16 * m + fr) * 8u + 4 * fq) = acc[AI][BJ][m][0] * 0.044194173824159216f;
        }
      }
    }
    if (hasN) {
#pragma unroll
      for (int m = 0; m < 4; ++m)
#pragma unroll
        for (int n = 0; n < 2; ++n) {
          const int c8 = retk ? (16 * n + 4 * wc + fq) : (8 * wc + 4 * n + fq);
          *(LAS s16x4*)(hl + hx_w(16 * m + fr, c8)) = pack4(acc[AI][BJ][m][n]);
        }
      u16* nb; unsigned pitch = 512u, hstr = 0u, cm = 15u;
      if (blk < 4) nb = p.qr() + (unsigned)R0 * 512u + (blk & 3) * 128;
      else if (blk < 8) nb = p.kr() + (unsigned)R0 * 512u + (blk & 3) * 128;
      else if (blk < 16) { nb = p.gate() + (unsigned)R0 * 1024u + (blk - 12) * 128; pitch = 1024u; }
      else if (blk < 20) nb = p.qa() + (unsigned)R0 * 512u + (blk - 16) * 128;
      else if (blk == 20) { nb = samp ? p.kaS() + ((unsigned)(b * 2) * 2112u + 2048u) * 64u : p.kaP() + ((unsigned)(b * 2) * 2048u + tb) * 64u; pitch = 64u; hstr = samp ? 2112u * 64u : 2048u * 64u; cm = 7u; }
      else if (blk < 26) { nb = p.gate() + (unsigned)R0 * 1024u + 512 + (blk - 22) * 128; pitch = 1024u; }
      else if (blk < 30) nb = p.qi() + (unsigned)R0 * 512u + (blk - 26) * 128;
      else { nb = samp ? p.kiS() + ((unsigned)b * 2112u + 2048u) * 64u : p.kiP() + ((unsigned)b * 2048u + tb) * 64u; pitch = 64u; cm = 7u; }
      EPI_BAR();
      const unsigned c16 = lane & 15;
      const unsigned loff = (c16 >> 3) * hstr + (c16 & cm) * 8u;
#pragma unroll
      for (int i = 0; i < 4; ++i) {
        const int row = 16 * wc + 4 * i + (lane >> 4);
        const bf16x8 v = *(const LAS bf16x8*)(hl + hx_r(row, c16));
        if (blk != 30 || c16 < 8) *(bf16x8*)(nb + (unsigned)row * pitch + loff) = v;
      }
      EPI_BAR();
    }
    if (hasT) {
      const float l2g = log2gamma(blk & 3);
#pragma unroll
      for (int m = 0; m < 4; ++m) {
        const int tok = 16 * m + fr;
        const float dec = (blk < 8) ? exp2f((float)(63 - tok) * l2g) : 1.f;
#pragma unroll
        for (int n = 0; n < 2; ++n) {
          const int fb = retk ? (64 * n + 16 * wc + 4 * fq) : (32 * wc + 16 * n + 4 * fq);
#pragma unroll
          for (int j = 0; j < 4; ++j) {
            const int f = fb + j;
            *(LAS u16*)(hl + f * 128 + ((((tok >> 3) ^ (f >> 2)) & 7) << 4) + (tok & 7) * 2) = f2bf(acc[AI][BJ][m][n][j] * dec);
          }
        }
      }
      u16* tbp; unsigned fstr;
      if (blk < 12) {
        u16* base = (blk < 8) ? p.krT() : p.vrT();
        const unsigned bh = (unsigned)(b * 4 + (blk & 3)) * 128u;
        tbp = samp ? base + 64u * 128u * 2048u + bh * 64u : base + bh * 2048u + tb;
        fstr = samp ? 64u : 2048u;
      } else {
        tbp = samp ? p.vaTS() + (unsigned)b * 128u * 2112u + 2048u : p.vaTP() + (unsigned)b * 128u * 2048u + tb;
        fstr = samp ? 2112u : 2048u;
      }
      EPI_BAR();
#pragma unroll
      for (int i = 0; i < 4; ++i) {
        const int f = 32 * wc + 8 * i + (lane >> 3), ch = lane & 7;
        const bf16x8 v = *(const LAS bf16x8*)(hl + f * 128 + (((ch ^ (f >> 2)) & 7) << 4));
        *(bf16x8*)(tbp + (unsigned)f * fstr + ch * 8) = v;
      }
      EPI_BAR();
    }
  }
  DI void operator()(f32x4 (&acc)[2][2][4][2], const pg8::Unit& u, int wr, int wc, int fr, int fq, int re) const {
    const bool samp = (u.pm * 256 >= NPROMPT);
    const int tclass = (u.pn < 4) ? 1 : ((u.pn == 8 || u.pn == 9 || u.pn == 10 || u.pn >= 13) ? 2 : 0);
    const int blk0 = u.pn * 2, blk1 = u.pn * 2 + 1;
    float rvv[2][4];
#pragma unroll
    for (int ai = 0; ai < 2; ++ai)
#pragma unroll
      for (int m = 0; m < 4; ++m) rvv[ai][m] = (1.f / REPK) * p.rinv()[u.pm * 256 + ai * 128 + wr * 64 + 16 * m + fr];
    const float* cb = (tclass == 1) ? p.cosR() : p.cosA();
    const float* sb = (tclass == 1) ? p.sinR() : p.sinA();
    const int pitch = (tclass == 1) ? 64 : 8;
    const int coff = (tclass == 1) ? (16 * wc + 4 * fq) : (4 * (fq & 1));
    const int rowg0 = u.pm * 256 + wr * 64 + fr;
    const int pos0 = samp ? 2048 + ((rowg0 - NPROMPT) & 63) : (rowg0 & 2047);
    const f32x4 c0 = *(const f32x4*)(cb + pos0 * pitch + coff), s0 = *(const f32x4*)(sb + pos0 * pitch + coff);
    const f32x4 c16 = *(const f32x4*)(cb + 16 * pitch + coff), s16 = *(const f32x4*)(sb + 16 * pitch + coff);
    f32x4 tc[4], ts[4];
#pragma unroll
    for (int ai = 0; ai < 2; ++ai)
#pragma unroll
      for (int m = 0; m < 4; ++m)
#pragma unroll
        for (int bj = 0; bj < 2; ++bj)
#pragma unroll
          for (int n = 0; n < 2; ++n) acc[ai][bj][m][n] *= rvv[ai][m];
    make_tabs(tc, ts, c0, s0, c16, s16);
    compute<0, 0>(acc, tc, ts, blk0, wc, fq);
    compute<0, 1>(acc, tc, ts, blk1, wc, fq);
    {
      const f32x4 c32 = c16 * c16 - s16 * s16, s32 = 2.f * s16 * c16;
      const f32x4 c64 = c32 * c32 - s32 * s32, s64 = 2.f * s32 * c32;
      const f32x4 c80 = c64 * c16 - s64 * s16, s80 = s64 * c16 + c64 * s16;
      const f32x4 c1 = samp ? tc[0] : tc[3] * c80 - ts[3] * s80, s1 = samp ? ts[0] : ts[3] * c80 + tc[3] * s80;
      make_tabs(tc, ts, c1, s1, c16, s16);
    }
    compute<1, 0>(acc, tc, ts, blk0, wc, fq);
    compute<1, 1>(acc, tc, ts, blk1, wc, fq);
    emit<0, 0>(acc, u, blk0, samp, wr, wc, fr, fq);
    emit<0, 1>(acc, u, blk1, samp, wr, wc, fr, fq);
    emit<1, 0>(acc, u, blk0, samp, wr, wc, fr, fq);
    emit<1, 1>(acc, u, blk1, samp, wr, wc, fr, fq);
  }
};

struct Epi2 {
  Params p; unsigned char* hl;
  DI void operator()(f32x4 (&acc)[2][2][4][2], const pg8::Unit& u, int wr, int wc, int fr, int fq, int re) const {
    u16* z = p.gate();
    const int lane = fr + 16 * fq;
#pragma unroll
    for (int ai = 0; ai < 2; ++ai)
#pragma unroll
      for (int bj = 0; bj < 2; ++bj) {
#pragma unroll
        for (int m = 0; m < 4; ++m)
#pragma unroll
          for (int n = 0; n < 2; ++n)
            *(s16x4*)(hl + hx_w(16 * m + fr, 8 * wc + 4 * n + fq)) = pack4(acc[ai][bj][m][n] * (1.f / REPK));
        EPI_BAR();
        const unsigned R0 = u.pm * 256 + ai * 128 + wr * 64;
        const unsigned cb = u.pn * 256 + bj * 128;
#pragma unroll
        for (int i = 0; i < 4; ++i) {
          const int row = 16 * wc + 4 * i + (lane >> 4), c16 = lane & 15;
          const bf16x8 v = *(const bf16x8*)(hl + hx_r(row, c16));
          *(bf16x8*)(z + (R0 + row) * 1024u + cb + c16 * 8) = v;
        }
        EPI_BAR();
      }
  }
};

DI void ret_kv_item(const Params& p, int item, int tid) {
  const int lane = tid & 63, w = tid >> 6, r = lane & 31, hh = lane >> 5;
  const u16 *kT, *vT; int T, c;
  if (item < 2048) { const int bh = item >> 5; c = item & 31; T = 2048; kT = p.krT() + (size_t)bh * 128 * 2048; vT = p.vrT() + (size_t)bh * 128 * 2048; }
  else { const int bh = item - 2048; c = 0; T = 64; kT = p.krT() + (size_t)64 * 128 * 2048 + (size_t)bh * 128 * 64; vT = p.vrT() + (size_t)64 * 128 * 2048 + (size_t)bh * 128 * 64; }
  const int e0 = (w & 1) * 64, d0 = (w >> 1) * 64;
  f32x16 acc[2][2];
  acc[0][0] = zero16(); acc[0][1] = zero16(); acc[1][0] = zero16(); acc[1][1] = zero16();
#pragma unroll
  for (int ks = 0; ks < 4; ++ks) {
    bf16x8 a0 = ldg8(vT + (size_t)(e0 + r) * T + c * 64 + ks * 16 + hh * 8);
    bf16x8 a1 = ldg8(vT + (size_t)(e0 + 32 + r) * T + c * 64 + ks * 16 + hh * 8);
    bf16x8 b0 = ldg8(kT + (size_t)(d0 + r) * T + c * 64 + ks * 16 + hh * 8);
    bf16x8 b1 = ldg8(kT + (size_t)(d0 + 32 + r) * T + c * 64 + ks * 16 + hh * 8);
    acc[0][0] = MFMA32(a0, b0, acc[0][0]);
    acc[0][1] = MFMA32(a0, b1, acc[0][1]);
    acc[1][0] = MFMA32(a1, b0, acc[1][0]);
    acc[1][1] = MFMA32(a1, b1, acc[1][1]);
  }
  u16* o = (u16*)p.kvT() + (size_t)item * 16384;
#pragma unroll
  for (int a = 0; a < 2; ++a)
#pragma unroll
    for (int b = 0; b < 2; ++b)
#pragma unroll
      for (int i = 0; i < 16; ++i)
        o[(e0 + a * 32 + crow(i, hh)) * 128 + d0 + b * 32 + r] = f2bf(acc[a][b][i]);
}

template <int NS>
DI void select_query(const u16* krow, int nj, int lane, u64* dst) {
  unsigned key[NS];
#pragma unroll
  for (int j = 0; j < NS; ++j) { const unsigned k = krow[j * 64 + lane]; key[j] = (j < nj) ? k : 0u; }
  constexpr int NP = (NS + 1) / 2;
  unsigned pk[NP];
#pragma unroll
  for (int i = 0; i < NP; ++i) pk[i] = key[2 * i] | ((2 * i + 1 < NS ? key[2 * i + 1] : 0u) << 16);
  unsigned prefix = 0;
  int cntp = 0;
  const unsigned ones = 0x00010001u;
  for (int bit = 15; bit >= 0; --bit) {
    const unsigned cand = prefix | (1u << bit);
    const unsigned c1 = cand - 1u;
    const unsigned cv = c1 | (c1 << 16);
    unsigned acc0 = 0, acc1 = 0;
#pragma unroll
    for (int i = 0; i < NP; ++i) {
      unsigned d, m;
      asm("v_pk_sub_u16 %0, %1, %2 clamp" : "=v"(d) : "v"(pk[i]), "v"(cv));
      asm("v_pk_min_u16 %0, %1, %2" : "=v"(m) : "v"(d), "v"(ones));
      if (i & 1) acc1 += m; else acc0 += m;
    }
    const unsigned a = acc0 + acc1;
    const int cnt = wave_sum((int)((a & 0xffffu) + (a >> 16)));
    if (cnt >= 256) { prefix = cand; cntp = cnt; }
    if (cnt == 256) break;
  }
  int wlo = 0, whi = 0;
  if (cntp == 256) {
#pragma unroll
    for (int j = 0; j < NS; ++j) {
      const u64 sm = __ballot(key[j] >= prefix);
      if (lane == j) { wlo = (int)(unsigned)sm; whi = (int)(unsigned)(sm >> 32); }
    }
  } else {
    int cgt = 0;
#pragma unroll
    for (int j = 0; j < NS; ++j) cgt += (key[j] > prefix) ? 1 : 0;
    cgt = wave_sum(cgt);
    const int rneed = 256 - cgt;
    int running = 0;
    const u64 lt = (1ull << lane) - 1ull;
#pragma unroll
    for (int j = 0; j < NS; ++j) {
      const bool eq = key[j] == prefix;
      const u64 em = __ballot(eq);
      const int rank = running + __popcll(em & lt);
      const bool sel = (key[j] > prefix) || (eq && rank < rneed);
      const u64 sm = __ballot(sel);
      if (lane == j) { wlo = (int)(unsigned)sm; whi = (int)(unsigned)(sm >> 32); }
      running += __popcll(em);
    }
  }
  if (lane < nj) dst[lane] = ((u64)(unsigned)whi << 32) | (u64)(unsigned)wlo;
}

DI void idx_item(const Params& p, unsigned char* lds, int tid, bool samp, int b, int grp) {
  const int lane = tid & 63, w = tid >> 6;
  const int t0 = grp * 16;
  int L, g0; const u16* ki;
  if (!samp) { const int c = t0 >> 6; L = (c + 1) * 64; g0 = b * 2048 + t0; ki = p.kiP() + (size_t)b * 2048 * 64; }
  else { L = 2112; g0 = NPROMPT + b * 64 + t0; ki = p.kiS() + (size_t)b * 2112 * 64; }
  const int nj = L >> 6;
  if (L <= 256) {
    for (int qq = 0; qq < 4; ++qq) {
      const int q = w * 4 + qq;
      if (lane < nj) p.maskbits()[(size_t)(g0 + q) * 33 + lane] = ~0ull;
    }
    return;
  }
  u16* keys = (u16*)lds;
#ifndef REPMF
#define REPMF 1
#endif
#ifndef REPSEL
#define REPSEL 1
#endif
#ifndef REPKV
#define REPKV 1
#endif
  for (int rmf = 0; rmf < REPMF; ++rmf) {
    const int qn = lane & 15, quad = lane >> 4;
    bf16x8 qf[8][2];
    float wv[8];
#pragma unroll
    for (int h = 0; h < 8; ++h) {
      qf[h][0] = ldg8(p.qi() + (size_t)(g0 + qn) * 512 + h * 64 + quad * 8);
      qf[h][1] = ldg8(p.qi() + (size_t)(g0 + qn) * 512 + h * 64 + 32 + quad * 8);
      wv[h] = p.wi()[(size_t)(g0 + qn) * 8 + h];
    }
    bf16x8 A0[4], A1[4], N0[4], N1[4];
#pragma unroll
    for (int i = 0; i < 4; ++i) {
      const int kt = w + 4 * i;
      A0[i] = ldg8(ki + (size_t)(kt * 16 + qn) * 64 + quad * 8);
      A1[i] = ldg8(ki + (size_t)(kt * 16 + qn) * 64 + 32 + quad * 8);
    }
    for (int base = 0; base < nj; base += 4) {
#pragma unroll
      for (int i = 0; i < 4; ++i) {
        const int t = min(base + 4 + i, nj - 1);
        const int kt = w + 4 * t;
        N0[i] = ldg8(ki + (size_t)(kt * 16 + qn) * 64 + quad * 8);
        N1[i] = ldg8(ki + (size_t)(kt * 16 + qn) * 64 + 32 + quad * 8);
      }
#pragma unroll
      for (int i = 0; i < 4; ++i) {
        const int t = base + i;
        if (t < nj) {
          const int kt = w + 4 * t;
          float idx[4] = {0.f, 0.f, 0.f, 0.f};
#pragma unroll
          for (int h = 0; h < 8; ++h) {
            f32x4 acc = {0.f, 0.f, 0.f, 0.f};
            acc = MFMA16(A0[i], qf[h][0], acc);
            acc = MFMA16(A1[i], qf[h][1], acc);
#pragma unroll
            for (int e = 0; e < 4; ++e) idx[e] += fmaxf(acc[e], 0.f) * wv[h];
          }
          s16x4 kv;
#pragma unroll
          for (int e = 0; e < 4; ++e) {
            _Float16 hv = (_Float16)idx[e];
            u16 bits = __builtin_bit_cast(u16, hv);
            kv[e] = (short)((bits & 0x8000) ? (u16)~bits : (u16)(bits | 0x8000));
          }
          *(s16x4*)(keys + qn * KPITCH + kt * 16 + quad * 4) = kv;
        }
      }
#pragma unroll
      for (int i = 0; i < 4; ++i) { A0[i] = N0[i]; A1[i] = N1[i]; }
    }
  }
  __syncthreads();
  for (int qq = 0; qq < 4 * REPSEL; ++qq) {
    const int q = w * 4 + (qq & 3);
    const u16* krow = keys + q * KPITCH;
    u64* dst = p.maskbits() + (size_t)(g0 + q) * 33;
    if (nj <= 8) select_query<8>(krow, nj, lane, dst);
    else if (nj <= 16) select_query<16>(krow, nj, lane, dst);
    else if (nj <= 24) select_query<24>(krow, nj, lane, dst);
    else select_query<33>(krow, nj, lane, dst);
  }
  __syncthreads();
}

DI void scan_item(const Params& p, int item, int tid) {
  if (item < 1024) {
    const int bh = item >> 4, slab = item & 15;
    const int idx = slab * 1024 + tid * 4;
    const int h = bh & 3;
    const float cd = exp2f(64.f * log2gamma(h));
    f32x4 s = {0.f, 0.f, 0.f, 0.f};
    s16x4 kraw[2][8];
#pragma unroll
    for (int i = 0; i < 8; ++i) kraw[0][i] = __builtin_nontemporal_load((const s16x4*)((const u16*)p.kvT() + (size_t)(bh * 32 + i) * 16384 + idx));
#pragma unroll
    for (int b8 = 0; b8 < 4; ++b8) {
      if (b8 < 3) {
#pragma unroll
        for (int i = 0; i < 8; ++i) kraw[(b8 + 1) & 1][i] = __builtin_nontemporal_load((const s16x4*)((const u16*)p.kvT() + (size_t)(bh * 32 + (b8 + 1) * 8 + i) * 16384 + idx));
      }
#pragma unroll
      for (int i = 0; i < 8; ++i) {
        __builtin_nontemporal_store(pack4(s), (s16x4*)(p.sprevT() + (size_t)(bh * 32 + b8 * 8 + i) * 16384 + idx));
        f32x4 kv;
#pragma unroll
        for (int j = 0; j < 4; ++j) kv[j] = __uint_as_float(((unsigned)(u16)kraw[b8 & 1][i][j]) << 16);
        s = s * cd + kv;
      }
    }
    const int e = idx >> 7, d = idx & 127;
    float* o = p.out + OUT_STP + (size_t)bh * 16384;
#pragma unroll
    for (int j = 0; j < 4; ++j) o[(d + j) * 128 + e] = s[j];
  } else {
    const int it = item - 1024;
    const int bh = it >> 4, slab = it & 15;
    const int idx = slab * 1024 + tid * 4;
    const int h = bh & 3;
    const float cd = exp2f(64.f * log2gamma(h));
    const int e = idx >> 7, d = idx & 127;
    const float* s0 = p.state_ret + (size_t)bh * 16384;
    f32x4 s;
#pragma unroll
    for (int j = 0; j < 4; ++j) s[j] = s0[(d + j) * 128 + e];
    const size_t base = (size_t)(2048 + bh) * 16384 + idx;
    s16x4 o = pack4(s);
    *(s16x4*)(p.sprevT() + base) = o;
    const s16x4 kk = *(const s16x4*)((const u16*)p.kvT() + base);
    f32x4 kv;
#pragma unroll
    for (int j = 0; j < 4; ++j) kv[j] = __uint_as_float(((unsigned)(u16)kk[j]) << 16);
    s = s * cd + kv;
    float* oo = p.out + OUT_STS + (size_t)bh * 16384;
#pragma unroll
    for (int j = 0; j < 4; ++j) oo[(d + j) * 128 + e] = s[j];
  }
}

DI void attn_item(const Params& p, unsigned char* lds, int tid, bool samp, int b, int c, int kvh, int qh, unsigned char* lds_blk, int tid512) {
  const int lane = tid & 63, w = tid >> 6, r = lane & 31, hh = lane >> 5;
  const int T = samp ? 2112 : 2048;
  const int nkt = samp ? 33 : c + 1;
  const int g0 = (samp ? NPROMPT + b * 64 : b * 2048 + c * 64) + qh * 32;
  const u16* K = samp ? p.kaS() + (size_t)(b * 2 + kvh) * 2112 * 64 : p.kaP() + (size_t)(b * 2 + kvh) * 2048 * 64;
  const u16* VT = samp ? p.vaTS() + (size_t)(b * 2 + kvh) * 64 * 2112 : p.vaTP() + (size_t)(b * 2 + kvh) * 64 * 2048;
  const int head = kvh * 4 + w;
  u16* KV0 = (u16*)(lds_blk + 2 * HALF_LDS - 4 * 9216);
  u64* mL = (u64*)lds;
  {
    u64 mv[5];
#pragma unroll
    for (int i = 0; i < 5; ++i) { const int ix = tid + 256 * i; mv[i] = __builtin_nontemporal_load(p.maskbits() + (size_t)g0 * 33 + (ix < 32 * 33 ? ix : 32 * 33 - 1)); }
#pragma unroll
    for (int i = 0; i < 5; ++i) { const int ix = tid + 256 * i; if (ix < 32 * 33) mL[ix] = mv[i]; }
  }
  bf16x8 qf[4];
#pragma unroll
  for (int ks = 0; ks < 4; ++ks) qf[ks] = ldg8(p.qa() + (size_t)(g0 + r) * 512 + head * 64 + ks * 16 + hh * 8);
  f32x16 O[2];
  O[0] = zero16(); O[1] = zero16();
  float mrun = -1e30f, lrun = 0.f;
  const int lrow = tid512 >> 3, lch = tid512 & 7;
  const int loff = lrow * 72 + lch * 8;
  bf16x8 pk0, pv0, nk0, nv0;
  {
    const bf16x8 k0 = ldg8(K + (size_t)(lrow)*64 + lch * 8), v0 = ldg8(VT + (size_t)(lrow)*T + lch * 8);
    const int t1 = nkt > 1 ? 1 : 0, t2 = nkt > 2 ? 2 : (nkt - 1);
    pk0 = ldg8(K + (size_t)(t1 * 64 + lrow) * 64 + lch * 8); pv0 = ldg8(VT + (size_t)(lrow)*T + t1 * 64 + lch * 8);
    nk0 = ldg8(K + (size_t)(t2 * 64 + lrow) * 64 + lch * 8); nv0 = ldg8(VT + (size_t)(lrow)*T + t2 * 64 + lch * 8);
    *(bf16x8*)(KV0 + loff) = k0;
    *(bf16x8*)(KV0 + 64 * 72 + loff) = v0;
  }
  __syncthreads();
  for (int kt = 0; kt < nkt; ++kt) {
    if (kt + 1 < nkt) {
      u16* nb = KV0 + ((kt + 1) & 1) * (2 * 64 * 72);
      *(bf16x8*)(nb + loff) = pk0;
      *(bf16x8*)(nb + 64 * 72 + loff) = pv0;
    }
    pk0 = nk0; pv0 = nv0;
    {
      const int t3 = (kt + 3 < nkt) ? kt + 3 : nkt - 1;
      nk0 = ldg8(K + (size_t)(t3 * 64 + lrow) * 64 + lch * 8);
      nv0 = ldg8(VT + (size_t)(lrow)*T + t3 * 64 + lch * 8);
    }
    const u16* Ks = KV0 + (kt & 1) * (2 * 64 * 72);
    const u16* Vs = Ks + 64 * 72;
    f32x16 S[2];
#pragma unroll
    for (int st = 0; st < 2; ++st) {
      S[st] = zero16();
#pragma unroll
      for (int ks = 0; ks < 4; ++ks) {
        bf16x8 kf = *(const bf16x8*)(Ks + (st * 32 + r) * 72 + ks * 16 + hh * 8);
        S[st] = MFMA32(kf, qf[ks], S[st]);
      }
    }
    const u64 W = mL[r * 33 + kt];
    const int wl = (int)(((unsigned)W) >> (4 * hh)), wh = (int)(((unsigned)(W >> 32)) >> (4 * hh));
    float mx = fmaxf(S[0][0], S[1][0]);
#pragma unroll
    for (int i = 1; i < 16; ++i) mx = fmaxf(mx, fmaxf(S[0][i], S[1][i]));
    mx = fmaxf(mx, __shfl_xor(mx, 32));
    const float mn = fmaxf(mrun, mx);
    const float alpha = __builtin_amdgcn_exp2f(mrun - mn);
    const bool resc = __any(mn != mrun);
    mrun = mn;
    float ls = 0.f;
#pragma unroll
    for (int st = 0; st < 2; ++st)
#pragma unroll
      for (int i = 0; i < 16; ++i) {
        const int keep = __builtin_amdgcn_sbfe(st ? wh : wl, (i & 3) + 8 * (i >> 2), 1);
        const float pvv = __int_as_float(__float_as_int(__builtin_amdgcn_exp2f(S[st][i] - mn)) & keep);
        S[st][i] = pvv;
        ls += pvv;
      }
    lrun = lrun * alpha + ls;
    if (resc) {
#pragma unroll
      for (int dt = 0; dt < 2; ++dt)
#pragma unroll
        for (int i = 0; i < 16; ++i) O[dt][i] *= alpha;
    }
#pragma unroll
    for (int st = 0; st < 2; ++st)
#pragma unroll
      for (int s2 = 0; s2 < 2; ++s2) {
        bf16x8 pf = pack8(S[st][8 * s2 + 0], S[st][8 * s2 + 1], S[st][8 * s2 + 2], S[st][8 * s2 + 3],
                          S[st][8 * s2 + 4], S[st][8 * s2 + 5], S[st][8 * s2 + 6], S[st][8 * s2 + 7]);
#pragma unroll
        for (int dt = 0; dt < 2; ++dt) {
          s16x4 lo = *(const s16x4*)(Vs + (dt * 32 + r) * 72 + st * 32 + 16 * s2 + 4 * hh);
          s16x4 hi = *(const s16x4*)(Vs + (dt * 32 + r) * 72 + st * 32 + 16 * s2 + 8 + 4 * hh);
          bf16x8 vf = __builtin_shufflevector(lo, hi, 0, 1, 2, 3, 4, 5, 6, 7);
          O[dt] = MFMA32(vf, pf, O[dt]);
        }
      }
    __syncthreads();
  }
  {
    float lt = lrun + __shfl_xor(lrun, 32);
    const float inv = 1.f / fmaxf(lt, 1e-30f);
    const u16* grow = p.gate() + (size_t)(g0 + r) * 1024 + 512 + head * 64;
    u16* mrow = p.mix() + (size_t)(g0 + r) * 1024 + 512 + head * 64;
    s16x4 gvv[2][4];
#pragma unroll
    for (int dt = 0; dt < 2; ++dt)
#pragma unroll
      for (int q4 = 0; q4 < 4; ++q4) gvv[dt][q4] = *(const s16x4*)(grow + dt * 32 + 8 * q4 + 4 * hh);
#pragma unroll
    for (int dt = 0; dt < 2; ++dt)
#pragma unroll
      for (int q4 = 0; q4 < 4; ++q4) {
        const int d = dt * 32 + 8 * q4 + 4 * hh;
        f32x4 of;
#pragma unroll
        for (int j = 0; j < 4; ++j) {
          const float gf = __uint_as_float(((unsigned)(u16)gvv[dt][q4][j]) << 16);
          of[j] = O[dt][q4 * 4 + j] * inv * gf;
        }
        *(s16x4*)(mrow + d) = pack4(of);
      }
  }
  __syncthreads();
}

DI void ret_out_item(const Params& p, unsigned char* lds, int item, int tid) {
  const int lane = tid & 63, w = tid >> 6, r = lane & 31, hh = lane >> 5;
  int bh, c, T, g0; const u16* vT;
  if (item < 2048) { bh = item >> 5; c = item & 31; T = 2048; g0 = (bh >> 2) * 2048 + c * 64; vT = p.vrT() + (size_t)bh * 128 * 2048; }
  else { bh = item - 2048; c = 0; T = 64; g0 = NPROMPT + (bh >> 2) * 64; vT = p.vrT() + (size_t)64 * 128 * 2048 + (size_t)bh * 128 * 64; }
  const int h = bh & 3;
  const float l2g = log2gamma(h);
  const int nt = w & 1, eh = w >> 1;
  const int n = nt * 32 + r;
  const u16* sp = p.sprevT() + (size_t)item * 16384;
  bf16x8 qf[8], kf[8], sf[8];
  s16x4 vlo[2][2][2], vhi[2][2][2];
#pragma unroll
  for (int ks = 0; ks < 8; ++ks) qf[ks] = ldg8(p.qr() + (size_t)(g0 + n) * 512 + h * 128 + ks * 16 + hh * 8);
#pragma unroll
  for (int ks = 0; ks < 8; ++ks) kf[ks] = ldg8(p.kr() + (size_t)(g0 + r) * 512 + h * 128 + ks * 16 + hh * 8);
#pragma unroll
  for (int et = 0; et < 2; ++et)
#pragma unroll
    for (int mt = 0; mt < 2; ++mt)
#pragma unroll
      for (int s2 = 0; s2 < 2; ++s2) {
        const u16* vp = vT + (size_t)((2 * eh + et) * 32 + r) * T + c * 64 + mt * 32 + 16 * s2 + 4 * hh;
        vlo[et][mt][s2] = ldg4(vp); vhi[et][mt][s2] = ldg4(vp + 8);
      }
  __builtin_amdgcn_sched_barrier(0);
  bf16x8 pf[2][2];
#pragma unroll
  for (int mt = 0; mt < 2; ++mt) {
    f32x16 S = zero16();
#pragma unroll
    for (int ks = 0; ks < 8; ++ks) S = MFMA32(kf[ks], qf[ks], S);
    if (mt == 0) {
#pragma unroll
      for (int ks = 0; ks < 8; ++ks) kf[ks] = ldg8(p.kr() + (size_t)(g0 + 32 + r) * 512 + h * 128 + ks * 16 + hh * 8);
#pragma unroll
      for (int ks = 0; ks < 8; ++ks) sf[ks] = ldg8(sp + (size_t)((2 * eh) * 32 + r) * 128 + ks * 16 + hh * 8);
      __builtin_amdgcn_sched_barrier(0);
    }
#pragma unroll
    for (int i = 0; i < 16; ++i) {
      const int m = mt * 32 + crow(i, hh);
      const int dd = n > m ? n - m : m - n;
      S[i] *= exp2f((float)dd * l2g);
    }
    pf[mt][0] = pack8(S[0], S[1], S[2], S[3], S[4], S[5], S[6], S[7]);
    pf[mt][1] = pack8(S[8], S[9], S[10], S[11], S[12], S[13], S[14], S[15]);
  }
  const float fs = exp2f((float)(n + 1) * l2g);
  f32x16 tot[2];
  float ss = 0.f;
#pragma unroll
  for (int et = 0; et < 2; ++et) {
    f32x16 Oi = zero16(), X = zero16();
#pragma unroll
    for (int ks = 0; ks < 8; ++ks) X = MFMA32(sf[ks], qf[ks], X);
    if (et == 0) {
#pragma unroll
      for (int ks = 0; ks < 8; ++ks) sf[ks] = ldg8(sp + (size_t)((2 * eh + 1) * 32 + r) * 128 + ks * 16 + hh * 8);
      __builtin_amdgcn_sched_barrier(0);
    }
#pragma unroll
    for (int mt = 0; mt < 2; ++mt)
#pragma unroll
      for (int s2 = 0; s2 < 2; ++s2) {
        bf16x8 vf = __builtin_shufflevector(vlo[et][mt][s2], vhi[et][mt][s2], 0, 1, 2, 3, 4, 5, 6, 7);
        Oi = MFMA32(vf, pf[mt][s2], Oi);
      }
#pragma unroll
    for (int i = 0; i < 16; ++i) { const float t = Oi[i] + X[i] * fs; tot[et][i] = t; ss += t * t; }
  }
  ss += __shfl_xor(ss, 32);
  float* red = (float*)lds;
  __syncthreads();
  if (hh == 0) red[w * 32 + r] = ss;
  __syncthreads();
  const float tsum = red[w * 32 + r] + red[(w ^ 2) * 32 + r];
  const float rinv = rsqrtf(tsum * (1.f / 128.f) + 1e-6f);
  const u16* grow = p.gate() + (size_t)(g0 + n) * 1024 + h * 128;
  u16* mrow = p.mix() + (size_t)(g0 + n) * 1024 + h * 128;
  s16x4 gvv[2][4];
  f32x4 ggv[2][4];
#pragma unroll
  for (int et = 0; et < 2; ++et)
#pragma unroll
    for (int q4 = 0; q4 < 4; ++q4) {
      const int e = (2 * eh + et) * 32 + 8 * q4 + 4 * hh;
      gvv[et][q4] = *(const s16x4*)(grow + e);
      ggv[et][q4] = *(const f32x4*)(p.ret_gn_g + h * 128 + e);
    }
#pragma unroll
  for (int et = 0; et < 2; ++et)
#pragma unroll
    for (int q4 = 0; q4 < 4; ++q4) {
      const int e = (2 * eh + et) * 32 + 8 * q4 + 4 * hh;
      f32x4 of;
#pragma unroll
      for (int j = 0; j < 4; ++j) {
        const float gf = __uint_as_float(((unsigned)(u16)gvv[et][q4][j]) << 16);
        of[j] = tot[et][q4 * 4 + j] * rinv * ggv[et][q4][j] * gf;
      }
      *(s16x4*)(mrow + e) = pack4(of);
    }
}

DI void phase_final(const Params& p, int tid) {
  const int gt = blockIdx.x * 512 + tid, GT = gridDim.x * 512;
  const int lane = tid & 63;
  for (int row0 = (gt >> 6) * 2; row0 < NTOK; row0 += (GT >> 6) * 2) {
    f32x4 v[2][4];
    s16x4 zz[2][4];
#pragma unroll
    for (int rr = 0; rr < 2; ++rr) {
      const float* xr = xrow(p, row0 + rr);
      const u16* zr = p.gate() + (size_t)(row0 + rr) * 1024;
#pragma unroll
      for (int i = 0; i < 4; ++i) { v[rr][i] = __builtin_nontemporal_load((const f32x4*)(xr + i * 256 + lane * 4)); zz[rr][i] = __builtin_nontemporal_load((const s16x4*)(zr + i * 256 + lane * 4)); }
    }
    f32x4 g[4];
#pragma unroll
    for (int i = 0; i < 4; ++i) g[i] = *(const f32x4*)(p.final_g + i * 256 + lane * 4);
#pragma unroll
    for (int rr = 0; rr < 2; ++rr) {
      float ss = 0.f;
#pragma unroll
      for (int i = 0; i < 4; ++i) {
#pragma unroll
        for (int j = 0; j < 4; ++j) v[rr][i][j] += __uint_as_float(((unsigned)(u16)zz[rr][i][j]) << 16);
        ss += v[rr][i][0] * v[rr][i][0] + v[rr][i][1] * v[rr][i][1] + v[rr][i][2] * v[rr][i][2] + v[rr][i][3] * v[rr][i][3];
      }
#pragma unroll
      for (int o = 32; o >= 1; o >>= 1) ss += __shfl_xor(ss, o);
      const float rv = rsqrtf(ss * (1.f / 1024.f) + 1e-6f);
      float* y = p.out + OUT_Y + (size_t)(row0 + rr) * 1024;
#pragma unroll
      for (int i = 0; i < 4; ++i) __builtin_nontemporal_store(v[rr][i] * rv * g[i], (f32x4*)(y + i * 256 + lane * 4));
    }
  }
}

#ifndef REP0
#define REP0 1
#endif
#ifndef REP1
#define REP1 1
#endif
#ifndef REP2
#define REP2 1
#endif
#ifndef REP3
#define REP3 1
#endif
#ifndef REP4
#define REP4 1
#endif
#ifndef REP5
#define REP5 1
#endif
__global__ void __launch_bounds__(512, 2) fwd_megakernel(Params p) {
  __shared__ __attribute__((aligned(16))) unsigned char lds[LDS_BYTES];
  cg::grid_group grid = cg::this_grid();
  const int wave_id = __builtin_amdgcn_readfirstlane((int)threadIdx.x >> 6);
#define FRESH_TID() int tid = wave_id * 64 + lane_id(); asm volatile("" : "+v"(tid)); const int half = tid >> 8, htid = tid & 255; unsigned char* ldsh = lds + half * HALF_LDS; (void)htid; (void)ldsh;
  if (p.out == nullptr) grid.sync();
  if (wave_id == 0 && lane_id() == 0) (void)xb_add(&p.bar()[XB_XCNT(xb_xcc_id())], 1u);
  for (int rep = 0; rep < REP0; ++rep) {
  { FRESH_TID(); phase_prep(p, tid); }
  xcd_barrier(p.bar(), wave_id);
  }
  for (int rep = 0; rep < REP1; ++rep) {
  {
    FRESH_TID();
    pg8::Gemm g; g.A = p.xb(); g.Bt = p.WtIn(); g.M = NTOK; g.N = 4096; g.K = 1024;
    pg8::StaticOrder S; S.init(g.M, g.N, (int)gridDim.x, (int)blockIdx.x); S.permtab = 0xEFBCD87694105A32ull; S.padtile = 15;
    Epi1 E; E.p = p; E.hl0 = (LAS unsigned char*)lds + pg8::STAGE_BYTES;
    pg8::gemm_phase<Epi1>((LAS unsigned char*)lds, g, S, E, wave_id);
  }
  xcd_barrier(p.bar(), wave_id);
  }
  for (int rep = 0; rep < REP2; ++rep) {
  {
    FRESH_TID();
    for (int it0 = blockIdx.x * 2; it0 < 2080 + 2080; it0 += gridDim.x * 2) {
      const int it = it0 + half;
      int ht = htid; asm volatile("" : "+v"(ht));
      if (it < 2080) {
        const bool samp = it < 32;
        const int j = it - 32;
        const int c = 31 - (j >> 6);
        const int b = samp ? (it >> 2) : ((j & 63) >> 2);
        const int grp = samp ? (it & 3) : (c * 4 + (j & 3));
        idx_item(p, ldsh, ht, samp, b, grp);
      } else { for (int rkv = 0; rkv < REPKV; ++rkv) ret_kv_item(p, it - 2080, ht); }
    }
  }
  xcd_barrier(p.bar(), wave_id);
  }
  for (int rep = 0; rep < REP3; ++rep) {
  {
    FRESH_TID();
    for (int it0 = blockIdx.x * 2; it0 < 1056 + 1536; it0 += gridDim.x * 2) {
      const int it = it0 + half;
      int ht = htid; asm volatile("" : "+v"(ht));
      if (it < 1056) {
        const bool samp = it < 32;
        const int j = it - 32;
        int c = samp ? 0 : 31 - (j >> 6);
        int b = samp ? (it >> 2) : ((j & 63) >> 2);
        int kvh = (it >> 1) & 1;
        if (!samp && gridDim.x == 256) {
          const int jb = (j >> 1) & 255, rnd = j >> 9;
          const int xcd = jb & 7, ii = jb >> 3;
          b = 2 * xcd + (ii & 1); kvh = (ii >> 1) & 1; c = 31 - rnd * 8 - (ii >> 2);
        }
        attn_item(p, ldsh, ht, samp, b, c, kvh, it & 1, lds, tid);
      } else scan_item(p, it - 1056, ht);
    }
  }
  xcd_barrier(p.bar(), wave_id);
  }
  for (int rep = 0; rep < REP4; ++rep) {
  {
    FRESH_TID();
    for (int it0 = blockIdx.x * 2; it0 < 2080 + 1024; it0 += gridDim.x * 2) {
      const int it = it0 + half;
      int ht = htid; asm volatile("" : "+v"(ht));
      if (it < 2080) ret_out_item(p, ldsh, it, ht);
      else {
        const int ia = it - 2080 + 1056;
        const int j = ia - 32;
        int c = 31 - (j >> 6);
        int b = (j & 63) >> 2;
        int kvh = (ia >> 1) & 1;
        if (gridDim.x == 256) {
          const int jb = (j >> 1) & 255, rnd = j >> 9;
          const int xcd = jb & 7, ii = jb >> 3;
          b = 2 * xcd + (ii & 1); kvh = (ii >> 1) & 1; c = 31 - rnd * 8 - (ii >> 2);
        }
        attn_item(p, ldsh, ht, false, b, c, kvh, ia & 1, lds, tid);
      }
    }
  }
  xcd_barrier(p.bar(), wave_id);
  }
  for (int rep = 0; rep < REP5; ++rep) {
  {
    pg8::Gemm g; g.A = p.mix(); g.Bt = p.WtOut(); g.M = NTOK; g.N = 1024; g.K = 1024;
    pg8::StaticOrder S; S.init(g.M, g.N, (int)gridDim.x, (int)blockIdx.x);
    Epi2 E; E.p = p; E.hl = lds + pg8::STAGE_BYTES + (wave_id >> 2) * 16384;
    pg8::gemm_phase<Epi2>((LAS unsigned char*)lds, g, S, E, wave_id);
  }
  xcd_barrier(p.bar(), wave_id);
  }
  { FRESH_TID(); phase_final(p, tid); }
}

extern "C" void kernel_launch(void* const* d_in, const int* in_sizes, int n_in, void* d_out, int out_size, void* d_ws,
                              size_t ws_size, hipStream_t stream) {
  static int grid_blocks = 0;
  if (!grid_blocks) {
    int dev = 0, cus = 0, per_cu = 0;
    (void)hipGetDevice(&dev);
    (void)hipDeviceGetAttribute(&cus, hipDeviceAttributeMultiprocessorCount, dev);
    (void)hipOccupancyMaxActiveBlocksPerMultiprocessor(&per_cu, fwd_megakernel, 512, 0);
    if (per_cu < 1) per_cu = 1;
    if (per_cu > 1) per_cu = 1;
    grid_blocks = cus * per_cu;
  }
  Params p{};
  p.x_p = (const float*)d_in[0]; p.x_s = (const float*)d_in[1]; p.state_ret = (const float*)d_in[2];
  p.cache_k = (const float*)d_in[3]; p.cache_v = (const float*)d_in[4]; p.cache_kidx = (const float*)d_in[5];
  p.norm_g = (const float*)d_in[6]; p.w_in = (const float*)d_in[7]; p.ret_gn_g = (const float*)d_in[8];
  p.w_out = (const float*)d_in[9]; p.final_g = (const float*)d_in[10];
  p.out = (float*)d_out;
  p.ws = (unsigned char*)d_ws;
  (void)hipMemsetAsync((unsigned char*)d_ws + 530573312ull, 0, (size_t)XCD_BAR_WORDS * 4, stream);
  void* args[] = {&p};
  hipError_t e = hipLaunchCooperativeKernel((void*)fwd_megakernel, dim3(grid_blocks), dim3(512), args, 0, stream);
  if (e != hipSuccess) fprintf(stderr, "cooperative launch failed: %s (grid %d)\n", hipGetErrorString(e), grid_blocks);
}
```

```cpp
#include <hip/hip_runtime.h>
#include <hip/hip_cooperative_groups.h>
#include <stdint.h>
#include <cstdio>
namespace cg = cooperative_groups;

typedef __attribute__((ext_vector_type(8))) short bf16x8;
typedef __attribute__((ext_vector_type(4))) short s16x4;
typedef __attribute__((ext_vector_type(16))) float f32x16;
typedef __attribute__((ext_vector_type(4))) float f32x4;
typedef unsigned short u16;
typedef unsigned long long u64;


#define DI __device__ __forceinline__
#define MFMA32(a, b, c) __builtin_amdgcn_mfma_f32_32x32x16_bf16((a), (b), (c), 0, 0, 0)
#define MFMA16(a, b, c) __builtin_amdgcn_mfma_f32_16x16x32_bf16((a), (b), (c), 0, 0, 0)

#define NTOK 33280
#define NPROMPT 32768
#define LDS_BYTES 163840
#define HALF_LDS 81920
#define LAS __attribute__((address_space(3)))
#define KPITCH 2116

struct Params {
  const float *x_p, *x_s, *state_ret, *cache_k, *cache_v, *cache_kidx, *norm_g, *w_in, *ret_gn_g, *w_out, *final_g;
  float* out;
  unsigned char* ws;
  DI u16* xb() const { return (u16*)(ws + 0ull); }
  DI float* kvT() const { return (float*)(ws + 0ull); }
  DI u16* WtIn() const { return (u16*)(ws + 136314880ull); }
  DI u16* WtOut() const { return (u16*)(ws + 144703488ull); }
  DI u16* qr() const { return (u16*)(ws + 146800640ull); }
  DI u16* kr() const { return (u16*)(ws + 180879360ull); }
  DI u16* sprevT() const { return (u16*)(ws + 214958080ull); }
  DI u16* qi() const { return (u16*)(ws + 214958080ull); }
  DI u16* krT() const { return (u16*)(ws + 249036800ull); }
  DI u16* vrT() const { return (u16*)(ws + 283115520ull); }
  DI u16* gate() const { return (u16*)(ws + 317194240ull); }
  DI u16* mix() const { return (u16*)(ws + 385351680ull); }
  DI u16* qa() const { return (u16*)(ws + 453509120ull); }
  DI u16* kaP() const { return (u16*)(ws + 487587840ull); }
  DI u16* kaS() const { return (u16*)(ws + 495976448ull); }
  DI u16* vaTP() const { return (u16*)(ws + 500301824ull); }
  DI u16* vaTS() const { return (u16*)(ws + 508690432ull); }
  DI u16* kiP() const { return (u16*)(ws + 513015808ull); }
  DI u16* kiS() const { return (u16*)(ws + 517210112ull); }
  DI float* rinv() const { return (float*)(ws + 519372800ull); }
  DI float* wi() const { return (float*)(ws + 519505920ull); }
  DI float* cosR() const { return (float*)(ws + 520570880ull); }
  DI float* sinR() const { return (float*)(ws + 521111552ull); }
  DI float* cosA() const { return (float*)(ws + 521652224ull); }
  DI float* sinA() const { return (float*)(ws + 521719808ull); }
  DI unsigned* bar() const { return (unsigned*)(ws + 530573312ull); }
  DI u64* maskbits() const { return (u64*)(ws + 521787392ull); }
};

#define OUT_Y 0
#define OUT_STP (34078720)
#define OUT_KP (OUT_STP + 1048576)
#define OUT_VP (OUT_KP + 4194304)
#define OUT_KIP (OUT_VP + 4194304)
#define OUT_STS (OUT_KIP + 2097152)
#define OUT_KS (OUT_STS + 524288)
#define OUT_VS (OUT_KS + 65536)
#define OUT_KIS (OUT_VS + 65536)

typedef __bf16 bf16x2_t __attribute__((ext_vector_type(2)));
typedef float f32x2_t __attribute__((ext_vector_type(2)));
typedef unsigned u32x4_t __attribute__((ext_vector_type(4)));
typedef unsigned u32x2_t __attribute__((ext_vector_type(2)));
DI unsigned pk2(float a, float b) { f32x2_t v = {a, b}; bf16x2_t r = __builtin_convertvector(v, bf16x2_t); return __builtin_bit_cast(unsigned, r); }
DI u16 f2bf(float x) { return (u16)(pk2(x, x) & 0xffffu); }
DI bf16x8 ldg8(const u16* p) { return *(const bf16x8*)p; }
DI s16x4 ldg4(const u16* p) { return *(const s16x4*)p; }
DI float siluf(float x) { return x * __builtin_amdgcn_rcpf(1.f + __builtin_amdgcn_exp2f(-1.4426950408889634f * x)); }
DI int lane_id() { return (int)__builtin_amdgcn_mbcnt_hi(~0u, __builtin_amdgcn_mbcnt_lo(~0u, 0u)); }
DI int crow(int reg, int hh) { return (reg & 3) + 8 * (reg >> 2) + 4 * hh; }
DI const float* xrow(const Params& p, int g) { return g < NPROMPT ? p.x_p + (size_t)g * 1024 : p.x_s + (size_t)(g - NPROMPT) * 1024; }
DI float log2gamma(int h) { return log1pf(-exp2f(-5.f - (float)h)) * 1.4426950408889634f; }
DI bf16x8 pack8(float a0, float a1, float a2, float a3, float a4, float a5, float a6, float a7) {
  u32x4_t v = {pk2(a0, a1), pk2(a2, a3), pk2(a4, a5), pk2(a6, a7)};
  return __builtin_bit_cast(bf16x8, v);
}
DI s16x4 pack4(f32x4 v) { u32x2_t o = {pk2(v[0], v[1]), pk2(v[2], v[3])}; return __builtin_bit_cast(s16x4, o); }
DI int wave_sum(int v) {
  v += __builtin_amdgcn_update_dpp(0, v, 0xB1, 0xf, 0xf, false);
  v += __builtin_amdgcn_update_dpp(0, v, 0x4E, 0xf, 0xf, false);
  v += __builtin_amdgcn_update_dpp(0, v, 0x124, 0xf, 0xf, false);
  v += __builtin_amdgcn_update_dpp(0, v, 0x128, 0xf, 0xf, false);
  return __builtin_amdgcn_readlane(v, 0) + __builtin_amdgcn_readlane(v, 16) + __builtin_amdgcn_readlane(v, 32) + __builtin_amdgcn_readlane(v, 48);
}
DI f32x16 zero16() { f32x16 z; for (int i = 0; i < 16; ++i) z[i] = 0.f; return z; }

#define XB_TMO      128
#define XB_XCNT(j)  (256  + 64 * (j))
#define XB_XSUB(j)  (1280 + 64 * (j))
#define XB_XGEN(j)  (2304 + 64 * (j))
#define XB_TOP      3328
#define XB_TOPGEN   3392
#define XB_WG(i)    (3456 + 64 * (i))
#define XCD_BAR_WORDS (3456 + 64 * 256)
#define XB_SPIN_CAP (1u << 18)
DI unsigned xb_ld(unsigned* p) { return __hip_atomic_load(p, __ATOMIC_RELAXED, __HIP_MEMORY_SCOPE_AGENT); }
DI unsigned xb_add(unsigned* p, unsigned v) { return __hip_atomic_fetch_add(p, v, __ATOMIC_RELAXED, __HIP_MEMORY_SCOPE_AGENT); }
DI unsigned xb_xcc_id() { return (unsigned)__builtin_amdgcn_s_getreg((3 << 11) | 20) & 0xFu; }
#define XB_SPIN(cond, bar) do { unsigned _sp = 0; while (cond) { __builtin_amdgcn_s_sleep(1); \
    if ((++_sp & 255u) == 0u) { if (xb_ld(&(bar)[XB_TMO])) break; if (_sp > XB_SPIN_CAP) { atomicAdd(&(bar)[XB_TMO], 1u); break; } } } } while (0)
DI void xcd_barrier(unsigned* bar, int wave_id) {
  asm volatile("s_waitcnt vmcnt(0)" ::: "memory");
  __syncthreads();
  if (wave_id == 0) {
    int lane = lane_id(); asm volatile("" : "+v"(lane));
    const unsigned x = xb_xcc_id();
    unsigned* slot = &bar[XB_WG(blockIdx.x)];
    unsigned nloc = 0u, nx = 0u;
    if (lane < 2) nloc = xb_ld(slot + lane);
    nx = (unsigned)__builtin_amdgcn_readlane((int)nloc, 1);
    nloc = (unsigned)__builtin_amdgcn_readlane((int)nloc, 0);
    if (nloc == 0u) {
      const unsigned G = gridDim.x * gridDim.y * gridDim.z;
      unsigned sp = 0u, c = 0u;
      for (;;) {
        c = (lane < 16) ? xb_ld(&bar[XB_XCNT(lane)]) : 0u;
        const unsigned sum = (unsigned)wave_sum((int)c);
        if (sum == G) break;
        __builtin_amdgcn_s_sleep(1);
        if ((++sp & 255u) == 0u) { if (xb_ld(&bar[XB_TMO])) break; if (sp > XB_SPIN_CAP) { if (lane == 0) atomicAdd(&bar[XB_TMO], 1u); break; } }
      }
      nx = (unsigned)__popcll(__ballot(c > 0u));
      nloc = (unsigned)__builtin_amdgcn_readlane((int)c, (int)x);
      nloc = nloc > 0u ? nloc : 1u; nx = nx > 0u ? nx : 1u;
      if (lane == 0) { __hip_atomic_store(slot, nloc, __ATOMIC_RELAXED, __HIP_MEMORY_SCOPE_AGENT); __hip_atomic_store(slot + 1, nx, __ATOMIC_RELAXED, __HIP_MEMORY_SCOPE_AGENT); }
    }
    if (lane == 0) {
      __builtin_amdgcn_s_waitcnt(0);
      const unsigned old = xb_add(&bar[XB_XSUB(x)], 1u);
      const unsigned gen = old / nloc;
      if (old + 1u == (gen + 1u) * nloc) {
        __builtin_amdgcn_fence(__ATOMIC_RELEASE, "agent");
        asm volatile("s_waitcnt vmcnt(0)" ::: "memory");
        const unsigned og = xb_add(&bar[XB_TOP], 1u);
        const unsigned tg = og / nx;
        if (og + 1u == (tg + 1u) * nx) xb_add(&bar[XB_TOPGEN], 1u);
        else XB_SPIN(xb_ld(&bar[XB_TOPGEN]) == tg, bar);
        __builtin_amdgcn_fence(__ATOMIC_ACQUIRE, "agent");
        xb_add(&bar[XB_XGEN(x)], 1u);
        asm volatile("s_waitcnt vmcnt(0)" ::: "memory");
      } else {
        XB_SPIN(xb_ld(&bar[XB_XGEN(x)]) == gen, bar);
        __builtin_amdgcn_fence(__ATOMIC_ACQUIRE, "agent");
        asm volatile("s_waitcnt vmcnt(0)" ::: "memory");
      }
    }
  }
  __syncthreads();
}

DI void phase_prep(const Params& p, int tid) {
  const int gt = blockIdx.x * 512 + tid, GT = gridDim.x * 512;
  const int lane = tid & 63;
  for (int row0 = (gt >> 6) * 2; row0 < NTOK; row0 += (GT >> 6) * 2) {
    f32x4 v[2][4];
#pragma unroll
    for (int rr = 0; rr < 2; ++rr) {
      const float* sp = xrow(p, row0 + rr);
#pragma unroll
      for (int i = 0; i < 4; ++i) v[rr][i] = __builtin_nontemporal_load((const f32x4*)(sp + i * 256 + lane * 4));
    }
#pragma unroll
    for (int rr = 0; rr < 2; ++rr) {
      float ss = 0.f;
#pragma unroll
      for (int i = 0; i < 4; ++i) ss += v[rr][i][0] * v[rr][i][0] + v[rr][i][1] * v[rr][i][1] + v[rr][i][2] * v[rr][i][2] + v[rr][i][3] * v[rr][i][3];
#pragma unroll
      for (int o = 32; o >= 1; o >>= 1) ss += __shfl_xor(ss, o);
#pragma unroll
      for (int i = 0; i < 4; ++i) *(s16x4*)(p.xb() + (size_t)(row0 + rr) * 1024 + i * 256 + lane * 4) = pack4(v[rr][i]);
      if (lane == 0) p.rinv()[row0 + rr] = rsqrtf(ss * (1.f / 1024.f) + 1e-6f);
    }
  }
  for (int i = gt; i < 4096 * 128; i += GT) {
    int n = i & 4095, kg = i >> 12;
    int sc = n;
    if (n < 1024) { const int P = n & 127; sc = (n & ~127) + 64 * ((P >> 4) & 1) + 16 * (P >> 5) + (P & 15); }
    float a[8];
    const float vmask = (n < 3912) ? 1.f : 0.f; const int scc = (sc < 3912) ? sc : 3911;
#pragma unroll
    for (int j = 0; j < 8; ++j) a[j] = p.w_in[(size_t)(kg * 8 + j) * 3912 + scc] * p.norm_g[kg * 8 + j] * vmask;
    *(bf16x8*)(p.WtIn() + (size_t)n * 1024 + kg * 8) = pack8(a[0], a[1], a[2], a[3], a[4], a[5], a[6], a[7]);
  }
  for (int i = gt; i < 1024 * 128; i += GT) {
    int n = i % 1024, kg = i / 1024;
    float a[8];
#pragma unroll
    for (int j = 0; j < 8; ++j) a[j] = p.w_out[(size_t)(kg * 8 + j) * 1024 + n];
    *(bf16x8*)(p.WtOut() + (size_t)n * 1024 + kg * 8) = pack8(a[0], a[1], a[2], a[3], a[4], a[5], a[6], a[7]);
  }
  for (int i = gt; i < 2112 * 64; i += GT) {
    int pos = i >> 6, k = i & 63;
    float inv = powf(10000.f, -(float)k / 64.f);
    float ang = (float)pos * inv;
    p.cosR()[i] = cosf(ang); p.sinR()[i] = sinf(ang);
  }
  for (int i = gt; i < 2112 * 8; i += GT) {
    int pos = i >> 3, k = i & 7;
    float inv = powf(500000.f, -(float)k / 8.f);
    float ang = (float)pos * inv;
    p.cosA()[i] = cosf(ang); p.sinA()[i] = sinf(ang);
  }
  for (int i = gt; i < 8 * 2048 * 2 * 8; i += GT) {
    int dg = i & 7, kvh = (i >> 3) & 1, t = (i >> 4) & 2047, b = i >> 15;
    const float* s = p.cache_k + ((size_t)(b * 2048 + t) * 2 + kvh) * 64 + dg * 8;
    *(bf16x8*)(p.kaS() + ((size_t)(b * 2 + kvh) * 2112 + t) * 64 + dg * 8) = pack8(s[0], s[1], s[2], s[3], s[4], s[5], s[6], s[7]);
  }
  for (int i = gt; i < 8 * 2 * 256 * 64; i += GT) {
    int d = i & 63, tg = (i >> 6) & 255, kvh = (i >> 14) & 1, b = i >> 15;
    float a[8];
#pragma unroll
    for (int j = 0; j < 8; ++j) a[j] = p.cache_v[((size_t)(b * 2048 + tg * 8 + j) * 2 + kvh) * 64 + d];
    *(bf16x8*)(p.vaTS() + ((size_t)(b * 2 + kvh) * 64 + d) * 2112 + tg * 8) = pack8(a[0], a[1], a[2], a[3], a[4], a[5], a[6], a[7]);
  }
  for (int i = gt; i < 8 * 2048 * 8; i += GT) {
    int dg = i & 7, t = (i >> 3) & 2047, b = i >> 14;
    const float* s = p.cache_kidx + (size_t)(b * 2048 + t) * 64 + dg * 8;
    *(bf16x8*)(p.kiS() + ((size_t)b * 2112 + t) * 64 + dg * 8) = pack8(s[0], s[1], s[2], s[3], s[4], s[5], s[6], s[7]);
  }
}

namespace pg8 {
constexpr int BM = 256, BK = 64, HALF = 128, HTB = HALF * BK * 2, STAGE_BYTES = 8 * HTB, NXCD = 8, WGM = 8;
DI int lds_byte(int r, int c) { const int st = (r >> 4) * 2 + (c >> 5), rr = r & 15, cc = c & 31, ob = rr * 64 + cc * 2; return st * 1024 + (ob ^ (((ob >> 9) & 1) << 5)); }
DI void stage_rc(int b, int& R, int& C) { const int st = b / 1024, sb = b % 1024, swz = sb ^ (((sb >> 9) & 1) << 5); R = (st >> 1) * 16 + swz / 64; C = (st & 1) * 32 + (swz % 64) / 2; }
struct Unit { int pm, pn; };
struct Gemm { const u16* A; const u16* Bt; int M, N, K; };
struct StaticOrder {
  int nM, nN, nwg, G, c, padtile; unsigned long long permtab;
  DI void init(int M, int N, int G_, int c_) { nM = M / BM; nN = N / BM; nwg = nM * nN; G = G_; c = c_; permtab = 0xFEDCBA9876543210ull; padtile = -1; }
  DI void map(int L, Unit& u) const {
    int wgid = L; { const int q = nwg / NXCD, r = nwg % NXCD, xcd = wgid % NXCD, off = wgid / NXCD; wgid = (xcd < r ? xcd * (q + 1) : r * (q + 1) + (xcd - r) * q) + off; }
    const int nig = WGM * nN, gid = wgid / nig, fm = gid * WGM, gsz = (nM - fm) < WGM ? (nM - fm) : WGM;
    u.pm = fm + ((wgid % nig) % gsz); u.pn = (int)((permtab >> (4 * ((wgid % nig) / gsz))) & 15ull);
  }
  DI bool next(int i, Unit& u) const {
    const long Ll = (long)i * G + c; if (Ll >= nwg) return false;
    const int L = (int)Ll;
    if (padtile < 0) { map(L, u); return true; }
    const int tail = nwg % G, base = nwg - tail;
    if (L >= base) { u.pm = L - base; u.pn = padtile; return true; }
    map(L, u);
    for (int it = 0; it < 64 && u.pn == padtile && u.pm < tail; ++it) map(base + u.pm, u);
    return true;
  }
};
template <class Epi>
DI void gemm_phase(LAS unsigned char* lds, const Gemm g, const StaticOrder& S, const Epi& E, int wave_id) {
  const int wid = wave_id; int lane = lane_id(); asm volatile("" : "+v"(lane)); const int tid = wid * 64 + lane;
  const int wr = wid >> 2, wc = wid & 3, fr = lane & 15, fq = lane >> 4;
  const int K = g.K, nt = K / BK;
  unsigned voffA[2], voffB[2];
#pragma unroll
  for (int i = 0; i < 2; ++i) { int R, C; stage_rc(tid * 16 + i * 8192, R, C); voffA[i] = (unsigned)(R * K + C) * 2u; voffB[i] = voffA[i]; }
  const size_t kstep = (size_t)(BK * 2);
  const size_t hstep = (size_t)HALF * K * 2;
  const size_t tstep = 2 * hstep;
  const unsigned ldsw = (unsigned)wid * 1024u;
  const int aoff = lds_byte(wr * 64 + fr, fq * 8), boff = lds_byte(wc * 32 + fr, fq * 8);
#define PG8_SA(b, h) (((b) * 2 + (h)) * HTB)
#define PG8_SB(b, h) ((4 + (b) * 2 + (h)) * HTB)
#define PG8_STAGE(bufoff, gbase, voff) do { _Pragma("unroll") for (int _i = 0; _i < 2; ++_i) \
    __builtin_amdgcn_global_load_lds((const unsigned*)((const char*)(gbase) + (voff)[_i]), (LAS unsigned*)(lds + (bufoff) + ldsw + _i * 8192), 16, 0, 0); } while (0)
#define PG8_LDA(dst, b, h) do { _Pragma("unroll") for (int m = 0; m < 4; ++m) _Pragma("unroll") for (int k = 0; k < 2; ++k) dst[m][k] = *(const LAS bf16x8*)(lds + PG8_SA(b, h) + aoff + m * 2048 + k * 1024); } while (0)
#define PG8_LDB(dst, b, h) do { _Pragma("unroll") for (int n = 0; n < 2; ++n) _Pragma("unroll") for (int k = 0; k < 2; ++k) dst[n][k] = *(const LAS bf16x8*)(lds + PG8_SB(b, h) + boff + n * 2048 + k * 1024); } while (0)
#define PG8_MMA(ai, bj, At, Bt) do { __builtin_amdgcn_s_setprio(1); _Pragma("unroll") for (int m = 0; m < 4; ++m) _Pragma("unroll") for (int n = 0; n < 2; ++n) _Pragma("unroll") for (int k = 0; k < 2; ++k) \
    acc[ai][bj][m][n] = __builtin_amdgcn_mfma_f32_16x16x32_bf16(Bt[n][k], At[m][k], acc[ai][bj][m][n], 0, 0, 0); __builtin_amdgcn_s_setprio(0); } while (0)
#define PG8_WAIT_V(n) asm volatile("s_waitcnt vmcnt(" #n ")" ::: "memory")
#define PG8_WAIT_L(n) asm volatile("s_waitcnt lgkmcnt(" #n ")" ::: "memory")
#define PG8_BAR __builtin_amdgcn_s_barrier()
#define PG8_SCHED __builtin_amdgcn_sched_barrier(0)
  Unit cur, nxt; int ui = 0;
  if (!S.next(0, cur)) return;
  f32x4 acc[2][2][4][2];
#pragma unroll
  for (int a = 0; a < 2; ++a)
#pragma unroll
    for (int b = 0; b < 2; ++b)
#pragma unroll
      for (int m = 0; m < 4; ++m)
#pragma unroll
        for (int n = 0; n < 2; ++n) acc[a][b][m][n] = (f32x4){0.f, 0.f, 0.f, 0.f};
  bf16x8 At[4][2], B0[2][2], B1[2][2];
  const char* cA = (const char*)g.A + (size_t)cur.pm * tstep; const char* cB = (const char*)g.Bt + (size_t)cur.pn * tstep;
  PG8_STAGE(PG8_SB(0, 0), cB, voffB); PG8_STAGE(PG8_SA(0, 0), cA, voffA); PG8_STAGE(PG8_SB(0, 1), cB + hstep, voffB); PG8_STAGE(PG8_SA(0, 1), cA + hstep, voffA);
  if (wr == 1) PG8_BAR;
  PG8_WAIT_V(4); PG8_BAR;
  PG8_STAGE(PG8_SB(1, 0), cB + kstep, voffB); PG8_STAGE(PG8_SA(1, 0), cA + kstep, voffA); PG8_STAGE(PG8_SB(1, 1), cB + hstep + kstep, voffB);
  PG8_WAIT_V(6); PG8_BAR;
  for (;;) {
    const bool has_next = S.next(ui + 1, nxt);
    const char* nA = has_next ? (const char*)g.A + (size_t)nxt.pm * tstep : cA; const char* nB = has_next ? (const char*)g.Bt + (size_t)nxt.pn * tstep : cB;
#ifndef REPK
#define REPK 1
#endif
    const bool skip1 = (S.padtile >= 0) && (cur.pn == S.padtile);
    for (int rk = 0; rk < REPK; ++rk) {
    const char* nA2 = (rk == REPK - 1) ? nA : cA; const char* nB2 = (rk == REPK - 1) ? nB : cB;
    for (int t = 0; t < nt; t += 2) {
      const bool last = (t == nt - 2);
      const char* a1 = cA + (size_t)(t + 1) * kstep;
      const char* a2 = last ? nA2 : cA + (size_t)(t + 2) * kstep; const char* b2 = last ? nB2 : cB + (size_t)(t + 2) * kstep;
      const char* a3 = a2 + kstep; const char* b3 = b2 + kstep;
      PG8_LDB(B0, 0, 0); PG8_SCHED; PG8_LDA(At, 0, 0); PG8_STAGE(PG8_SA(1, 1), a1 + hstep, voffA);
      PG8_WAIT_L(8); PG8_BAR; PG8_WAIT_L(0); PG8_MMA(0, 0, At, B0); PG8_BAR; PG8_SCHED;
      PG8_LDB(B1, 0, 1); PG8_STAGE(PG8_SB(0, 0), b2, voffB);
      PG8_BAR; PG8_WAIT_L(0); if (!skip1) PG8_MMA(0, 1, At, B1); PG8_BAR;
      PG8_LDA(At, 0, 1); PG8_STAGE(PG8_SA(0, 0), a2, voffA);
      PG8_BAR; PG8_WAIT_L(0); PG8_MMA(1, 0, At, B0); PG8_BAR; PG8_SCHED;
      PG8_STAGE(PG8_SB(0, 1), b2 + hstep, voffB);
      PG8_WAIT_V(6); PG8_BAR; if (!skip1) PG8_MMA(1, 1, At, B1); PG8_BAR;
      PG8_LDB(B0, 1, 0); PG8_SCHED; PG8_LDA(At, 1, 0); PG8_STAGE(PG8_SA(0, 1), a2 + hstep, voffA);
      PG8_WAIT_L(8); PG8_BAR; PG8_WAIT_L(0); PG8_MMA(0, 0, At, B0); PG8_BAR; PG8_SCHED;
      PG8_LDB(B1, 1, 1); PG8_STAGE(PG8_SB(1, 0), b3, voffB);
      PG8_BAR; PG8_WAIT_L(0); if (!skip1) PG8_MMA(0, 1, At, B1); PG8_BAR;
      PG8_LDA(At, 1, 1); PG8_STAGE(PG8_SA(1, 0), a3, voffA);
      PG8_BAR; PG8_WAIT_L(0); PG8_MMA(1, 0, At, B0); PG8_BAR; PG8_SCHED;
      PG8_STAGE(PG8_SB(1, 1), b3 + hstep, voffB);
      PG8_WAIT_V(6); PG8_BAR; if (!skip1) PG8_MMA(1, 1, At, B1); PG8_BAR;
    }
    }
    {
      Unit eu = cur; int ewr = wr, ewc = wc; int el = lane_id();
      asm volatile("" : "+s"(eu.pm), "+s"(eu.pn), "+s"(ewr), "+s"(ewc), "+v"(el));
      int efr = el & 15, efq = el >> 4;
#ifndef REPEPI
#define REPEPI 1
#endif
      for (int re = 0; re < REPEPI; ++re) E(acc, eu, ewr, ewc, efr, efq, re);
    }
    if (!has_next) break;
#pragma unroll
    for (int a = 0; a < 2; ++a)
#pragma unroll
      for (int b = 0; b < 2; ++b)
#pragma unroll
        for (int m = 0; m < 4; ++m)
#pragma unroll
          for (int n = 0; n < 2; ++n) acc[a][b][m][n] = (f32x4){0.f, 0.f, 0.f, 0.f};
    cur = nxt; cA = nA; cB = nB; ++ui;
  }
  PG8_WAIT_V(0);
  if (wr == 0) PG8_BAR;
  PG8_BAR;
#undef PG8_SA
#undef PG8_SB
#undef PG8_STAGE
#undef PG8_LDA
#undef PG8_LDB
#undef PG8_MMA
#undef PG8_WAIT_V
#undef PG8_WAIT_L
#undef PG8_BAR
#undef PG8_SCHED
}
}


DI unsigned hx_w(int row, int c8) { return (unsigned)(row * 256 + ((c8 ^ ((row & 15) << 1)) << 3)); }
DI unsigned hx_r(int row, int c16) { return (unsigned)(row * 256 + ((c16 ^ (row & 15)) << 4)); }
#define EPI_BAR() asm volatile("s_waitcnt lgkmcnt(0)\n\ts_barrier" ::: "memory")


struct Epi1 {
  Params p; LAS unsigned char* hl0;
  DI void make_tabs(f32x4 (&tc)[4], f32x4 (&ts)[4], f32x4 c0, f32x4 s0, f32x4 c16, f32x4 s16) const {
    tc[0] = c0; ts[0] = s0;
#pragma unroll
    for (int m = 1; m < 4; ++m) { tc[m] = tc[m - 1] * c16 - ts[m - 1] * s16; ts[m] = ts[m - 1] * c16 + tc[m - 1] * s16; }
  }
  template <int AI, int BJ>
  DI void compute(f32x4 (&acc)[2][2][4][2], const f32x4 (&tc)[4], const f32x4 (&ts)[4], int blk, int wc, int fq) const {
    if (blk < 8) {
#pragma unroll
      for (int m = 0; m < 4; ++m) {
        const f32x4 v0 = acc[AI][BJ][m][0], v1 = acc[AI][BJ][m][1];
        f32x4 o0 = v0 * tc[m] - v1 * ts[m], o1 = v1 * tc[m] + v0 * ts[m];
        if (blk >= 4) { o0 *= 0.08838834764831845f; o1 *= 0.08838834764831845f; }
        acc[AI][BJ][m][0] = o0; acc[AI][BJ][m][1] = o1;
      }
    } else if ((blk >= 12 && blk < 16) || (blk >= 22 && blk < 26)) {
#pragma unroll
      for (int m = 0; m < 4; ++m)
#pragma unroll
        for (int n = 0; n < 2; ++n) {
          f32x4 v = acc[AI][BJ][m][n];
          v[0] = siluf(v[0]); v[1] = siluf(v[1]); v[2] = siluf(v[2]); v[3] = siluf(v[3]);
          acc[AI][BJ][m][n] = v;
        }
    } else if ((blk >= 8 && blk < 12) || blk == 21 || blk == 31) {
    } else {
      const bool ropew = ((wc & 1) == 0) && !(blk == 30 && wc >= 2);
      if (ropew) {
#pragma unroll
        for (int m = 0; m < 4; ++m) {
          const f32x4 v0 = acc[AI][BJ][m][0];
          f32x4 pr;
          pr[0] = __shfl_xor(v0[0], 32); pr[1] = __shfl_xor(v0[1], 32); pr[2] = __shfl_xor(v0[2], 32); pr[3] = __shfl_xor(v0[3], 32);
          acc[AI][BJ][m][0] = (fq < 2) ? v0 * tc[m] - pr * ts[m] : v0 * tc[m] + pr * ts[m];
        }
      }
      if (blk < 20) {
        const float sc = 0.125f * 1.4426950408889634f;
#pragma unroll
        for (int m = 0; m < 4; ++m) { acc[AI][BJ][m][0] *= sc; acc[AI][BJ][m][1] *= sc; }
      }
    }
  }
  template <int AI, int BJ>
  DI void emit(f32x4 (&acc)[2][2][4][2], const pg8::Unit& u, int blk, bool samp, int wr, int wc, int fr, int fq) const {
    if (blk == 31) return;
    LAS unsigned char* hl = hl0 + wr * 16384;
    asm volatile("" : "+v"(fr), "+v"(fq));
    const int lane = fr + 16 * fq;
    const int P0 = 32 * wc + 4 * fq;
    const int R0 = u.pm * 256 + AI * 128 + wr * 64;
    int b, tb;
    if (!samp) { b = R0 >> 11; tb = R0 & 2047; } else { b = (R0 - NPROMPT) >> 6; tb = 0; }
    const bool retk = blk < 8;
    const bool hasT = (blk >= 4 && blk < 12) || blk == 21;
    const bool hasN = !(blk >= 8 && blk < 12) && blk != 21;
    if (blk == 20 || blk == 21) {
      float* ob = samp ? p.out + (blk == 20 ? OUT_KS : OUT_VS) + (unsigned)(R0 - NPROMPT) * 128u : p.out + (blk == 20 ? OUT_KP : OUT_VP) + (unsigned)R0 * 128u;
#pragma unroll
      for (int m = 0; m < 4; ++m) {
        float* o2 = ob + (unsigned)(16 * m + fr) * 128u + P0;
        __builtin_nontemporal_store(acc[AI][BJ][m][0], (f32x4*)o2); __builtin_nontemporal_store(acc[AI][BJ][m][1], (f32x4*)(o2 + 16));
      }
    } else if (blk == 30) {
      float* ob = samp ? p.out + OUT_KIS + (unsigned)(R0 - NPROMPT) * 64u : p.out + OUT_KIP + (unsigned)R0 * 64u;
      float* wb = p.wi() + (unsigned)R0 * 8u;
#pragma unroll
      for (int m = 0; m < 4; ++m) {
        if (wc < 2) {
          float* o2 = ob + (unsigned)(16 * m + fr) * 64u + P0;
          __builtin_nontemporal_store(acc[AI][BJ][m][0], (f32x4*)o2); __builtin_nontemporal_store(acc[AI][BJ][m][1], (f32x4*)(o2 + 16));
        } else if (wc == 2 && fq < 2) {
          *(f32x4*)(wb + (unsigned)(16 * m + fr) * 8u + 4 * fq) = acc[AI][BJ][m][0] * 0.044194173824159216f;
        }
      }
    }
    if (hasN) {
#pragma unroll
      for (int m = 0; m < 4; ++m)
#pragma unroll
        for (int n = 0; n < 2; ++n) {
          const int c8 = retk ? (16 * n + 4 * wc + fq) : (8 * wc + 4 * n + fq);
          *(LAS s16x4*)(hl + hx_w(16 * m + fr, c8)) = pack4(acc[AI][BJ][m][n]);
        }
      u16* nb; unsigned pitch = 512u, hstr = 0u, cm = 15u;
      if (blk < 4) nb = p.qr() + (unsigned)R0 * 512u + (blk & 3) * 128;
      else if (blk < 8) nb = p.kr() + (unsigned)R0 * 512u + (blk & 3) * 128;
      else if (blk < 16) { nb = p.gate() + (unsigned)R0 * 1024u + (blk - 12) * 128; pitch = 1024u; }
      else if (blk < 20) nb = p.qa() + (unsigned)R0 * 512u + (blk - 16) * 128;
      else if (blk == 20) { nb = samp ? p.kaS() + ((unsigned)(b * 2) * 2112u + 2048u) * 64u : p.kaP() + ((unsigned)(b * 2) * 2048u + tb) * 64u; pitch = 64u; hstr = samp ? 2112u * 64u : 2048u * 64u; cm = 7u; }
      else if (blk < 26) { nb = p.gate() + (unsigned)R0 * 1024u + 512 + (blk - 22) * 128; pitch = 1024u; }
      else if (blk < 30) nb = p.qi() + (unsigned)R0 * 512u + (blk - 26) * 128;
      else { nb = samp ? p.kiS() + ((unsigned)b * 2112u + 2048u) * 64u : p.kiP() + ((unsigned)b * 2048u + tb) * 64u; pitch = 64u; cm = 7u; }
      EPI_BAR();
      const unsigned c16 = lane & 15;
      const unsigned loff = (c16 >> 3) * hstr + (c16 & cm) * 8u;
#pragma unroll
      for (int i = 0; i < 4; ++i) {
        const int row = 16 * wc + 4 * i + (lane >> 4);
        const bf16x8 v = *(const LAS bf16x8*)(hl + hx_r(row, c16));
        if (blk != 30 || c16 < 8) *(bf16x8*)(nb + (unsigned)row * pitch + loff) = v;
      }
      EPI_BAR();
    }
    if (hasT) {
      const float l2g = log2gamma(blk & 3);
#pragma unroll
      for (int m = 0; m < 4; ++m) {
        const int tok = 16 * m + fr;
        const float dec = (blk < 8) ? exp2f((float)(63 - tok) * l2g) : 1.f;
#pragma unroll
        for (int n = 0; n < 2; ++n) {
          const int fb = retk ? (64 * n + 16 * wc + 4 * fq) : (32 * wc + 16 * n + 4 * fq);
#pragma unroll
          for (int j = 0; j < 4; ++j) {
            const int f = fb + j;
            *(LAS u16*)(hl + f * 128 + ((((tok >> 3) ^ (f >> 2)) & 7) << 4) + (tok & 7) * 2) = f2bf(acc[AI][BJ][m][n][j] * dec);
          }
        }
      }
      u16* tbp; unsigned fstr;
      if (blk < 12) {
        u16* base = (blk < 8) ? p.krT() : p.vrT();
        const unsigned bh = (unsigned)(b * 4 + (blk & 3)) * 128u;
        tbp = samp ? base + 64u * 128u * 2048u + bh * 64u : base + bh * 2048u + tb;
        fstr = samp ? 64u : 2048u;
      } else {
        tbp = samp ? p.vaTS() + (unsigned)b * 128u * 2112u + 2048u : p.vaTP() + (unsigned)b * 128u * 2048u + tb;
        fstr = samp ? 2112u : 2048u;
      }
      EPI_BAR();
#pragma unroll
      for (int i = 0; i < 4; ++i) {
        const int f = 32 * wc + 8 * i + (lane >> 3), ch = lane & 7;
        const bf16x8 v = *(const LAS bf16x8*)(hl + f * 128 + (((ch ^ (f >> 2)) & 7) << 4));
        *(bf16x8*)(tbp + (unsigned)f * fstr + ch * 8) = v;
      }
      EPI_BAR();
    }
  }
  DI void operator()(f32x4 (&acc)[2][2][4][2], const pg8::Unit& u, int wr, int wc, int fr, int fq, int re) const {
    const bool samp = (u.pm * 256 >= NPROMPT);
    const int tclass = (u.pn < 4) ? 1 : ((u.pn == 8 || u.pn == 9 || u.pn == 10 || u.pn >= 13) ? 2 : 0);
    const int blk0 = u.pn * 2, blk1 = u.pn * 2 + 1;
    float rvv[2][4];
#pragma unroll
    for (int ai = 0; ai < 2; ++ai)
#pragma unroll
      for (int m = 0; m < 4; ++m) rvv[ai][m] = (1.f / REPK) * p.rinv()[u.pm * 256 + ai * 128 + wr * 64 + 16 * m + fr];
    const float* cb = (tclass == 1) ? p.cosR() : p.cosA();
    const float* sb = (tclass == 1) ? p.sinR() : p.sinA();
    const int pitch = (tclass == 1) ? 64 : 8;
    const int coff = (tclass == 1) ? (16 * wc + 4 * fq) : (4 * (fq & 1));
    const int rowg0 = u.pm * 256 + wr * 64 + fr;
    const int pos0 = samp ? 2048 + ((rowg0 - NPROMPT) & 63) : (rowg0 & 2047);
    const f32x4 c0 = *(const f32x4*)(cb + pos0 * pitch + coff), s0 = *(const f32x4*)(sb + pos0 * pitch + coff);
    const f32x4 c16 = *(const f32x4*)(cb + 16 * pitch + coff), s16 = *(const f32x4*)(sb + 16 * pitch + coff);
    f32x4 tc[4], ts[4];
#pragma unroll
    for (int ai = 0; ai < 2; ++ai)
#pragma unroll
      for (int m = 0; m < 4; ++m)
#pragma unroll
        for (int bj = 0; bj < 2; ++bj)
#pragma unroll
          for (int n = 0; n < 2; ++n) acc[ai][bj][m][n] *= rvv[ai][m];
    make_tabs(tc, ts, c0, s0, c16, s16);
    compute<0, 0>(acc, tc, ts, blk0, wc, fq);
    compute<0, 1>(acc, tc, ts, blk1, wc, fq);
    {
      const f32x4 c32 = c16 * c16 - s16 * s16, s32 = 2.f * s16 * c16;
      const f32x4 c64 = c32 * c32 - s32 * s32, s64 = 2.f * s32 * c32;
      const f32x4 c80 = c64 * c16 - s64 * s16, s80 = s64 * c16 + c64 * s16;
      const f32x4 c1 = samp ? tc[0] : tc[3] * c80 - ts[3] * s80, s1 = samp ? ts[0] : ts[3] * c80 + tc[3] * s80;
      make_tabs(tc, ts, c1, s1, c16, s16);
    }
    compute<1, 0>(acc, tc, ts, blk0, wc, fq);
    compute<1, 1>(acc, tc, ts, blk1, wc, fq);
    emit<0, 0>(acc, u, blk0, samp, wr, wc, fr, fq);
    emit<0, 1>(acc, u, blk1, samp, wr, wc, fr, fq);
    emit<1, 0>(acc, u, blk0, samp, wr, wc, fr, fq);
    emit<1, 1>(acc, u, blk1, samp, wr, wc, fr, fq);
  }
};

struct Epi2 {
  Params p; unsigned char* hl;
  DI void operator()(f32x4 (&acc)[2][2][4][2], const pg8::Unit& u, int wr, int wc, int fr, int fq, int re) const {
    u16* z = p.gate();
    const int lane = fr + 16 * fq;
#pragma unroll
    for (int ai = 0; ai < 2; ++ai)
#pragma unroll
      for (int bj = 0; bj < 2; ++bj) {
#pragma unroll
        for (int m = 0; m < 4; ++m)
#pragma unroll
          for (int n = 0; n < 2; ++n)
            *(s16x4*)(hl + hx_w(16 * m + fr, 8 * wc + 4 * n + fq)) = pack4(acc[ai][bj][m][n] * (1.f / REPK));
        EPI_BAR();
        const unsigned R0 = u.pm * 256 + ai * 128 + wr * 64;
        const unsigned cb = u.pn * 256 + bj * 128;
#pragma unroll
        for (int i = 0; i < 4; ++i) {
          const int row = 16 * wc + 4 * i + (lane >> 4), c16 = lane & 15;
          const bf16x8 v = *(const bf16x8*)(hl + hx_r(row, c16));
          *(bf16x8*)(z + (R0 + row) * 1024u + cb + c16 * 8) = v;
        }
        EPI_BAR();
      }
  }
};

DI void ret_kv_item(const Params& p, int item, int tid) {
  const int lane = tid & 63, w = tid >> 6, r = lane & 31, hh = lane >> 5;
  const u16 *kT, *vT; int T, c;
  if (item < 2048) { const int bh = item >> 5; c = item & 31; T = 2048; kT = p.krT() + (size_t)bh * 128 * 2048; vT = p.vrT() + (size_t)bh * 128 * 2048; }
  else { const int bh = item - 2048; c = 0; T = 64; kT = p.krT() + (size_t)64 * 128 * 2048 + (size_t)bh * 128 * 64; vT = p.vrT() + (size_t)64 * 128 * 2048 + (size_t)bh * 128 * 64; }
  const int e0 = (w & 1) * 64, d0 = (w >> 1) * 64;
  f32x16 acc[2][2];
  acc[0][0] = zero16(); acc[0][1] = zero16(); acc[1][0] = zero16(); acc[1][1] = zero16();
#pragma unroll
  for (int ks = 0; ks < 4; ++ks) {
    bf16x8 a0 = ldg8(vT + (size_t)(e0 + r) * T + c * 64 + ks * 16 + hh * 8);
    bf16x8 a1 = ldg8(vT + (size_t)(e0 + 32 + r) * T + c * 64 + ks * 16 + hh * 8);
    bf16x8 b0 = ldg8(kT + (size_t)(d0 + r) * T + c * 64 + ks * 16 + hh * 8);
    bf16x8 b1 = ldg8(kT + (size_t)(d0 + 32 + r) * T + c * 64 + ks * 16 + hh * 8);
    acc[0][0] = MFMA32(a0, b0, acc[0][0]);
    acc[0][1] = MFMA32(a0, b1, acc[0][1]);
    acc[1][0] = MFMA32(a1, b0, acc[1][0]);
    acc[1][1] = MFMA32(a1, b1, acc[1][1]);
  }
  u16* o = (u16*)p.kvT() + (size_t)item * 16384;
#pragma unroll
  for (int a = 0; a < 2; ++a)
#pragma unroll
    for (int b = 0; b < 2; ++b)
#pragma unroll
      for (int i = 0; i < 16; ++i)
        o[(e0 + a * 32 + crow(i, hh)) * 128 + d0 + b * 32 + r] = f2bf(acc[a][b][i]);
}

template <int NS>
DI void select_query(const u16* krow, int nj, int lane, u64* dst) {
  unsigned key[NS];
#pragma unroll
  for (int j = 0; j < NS; ++j) { const unsigned k = krow[j * 64 + lane]; key[j] = (j < nj) ? k : 0u; }
  constexpr int NP = (NS + 1) / 2;
  unsigned pk[NP];
#pragma unroll
  for (int i = 0; i < NP; ++i) pk[i] = key[2 * i] | ((2 * i + 1 < NS ? key[2 * i + 1] : 0u) << 16);
  unsigned prefix = 0;
  int cntp = 0;
  const unsigned ones = 0x00010001u;
  for (int bit = 15; bit >= 0; --bit) {
    const unsigned cand = prefix | (1u << bit);
    const unsigned c1 = cand - 1u;
    const unsigned cv = c1 | (c1 << 16);
    unsigned acc0 = 0, acc1 = 0;
#pragma unroll
    for (int i = 0; i < NP; ++i) {
      unsigned d, m;
      asm("v_pk_sub_u16 %0, %1, %2 clamp" : "=v"(d) : "v"(pk[i]), "v"(cv));
      asm("v_pk_min_u16 %0, %1, %2" : "=v"(m) : "v"(d), "v"(ones));
      if (i & 1) acc1 += m; else acc0 += m;
    }
    const unsigned a = acc0 + acc1;
    const int cnt = wave_sum((int)((a & 0xffffu) + (a >> 16)));
    if (cnt >= 256) { prefix = cand; cntp = cnt; }
    if (cnt == 256) break;
  }
  int wlo = 0, whi = 0;
  if (cntp == 256) {
#pragma unroll
    for (int j = 0; j < NS; ++j) {
      const u64 sm = __ballot(key[j] >= prefix);
      if (lane == j) { wlo = (int)(unsigned)sm; whi = (int)(unsigned)(sm >> 32); }
    }
  } else {
    int cgt = 0;
#pragma unroll
    for (int j = 0; j < NS; ++j) cgt += (key[j] > prefix) ? 1 : 0;
    cgt = wave_sum(cgt);
    const int rneed = 256 - cgt;
    int running = 0;
    const u64 lt = (1ull << lane) - 1ull;
#pragma unroll
    for (int j = 0; j < NS; ++j) {
      const bool eq = key[j] == prefix;
      const u64 em = __ballot(eq);
      const int rank = running + __popcll(em & lt);
      const bool sel = (key[j] > prefix) || (eq && rank < rneed);
      const u64 sm = __ballot(sel);
      if (lane == j) { wlo = (int)(unsigned)sm; whi = (int)(unsigned)(sm >> 32); }
      running += __popcll(em);
    }
  }
  if (lane < nj) dst[lane] = ((u64)(unsigned)whi << 32) | (u64)(unsigned)wlo;
}

DI void idx_item(const Params& p, unsigned char* lds, int tid, bool samp, int b, int grp) {
  const int lane = tid & 63, w = tid >> 6;
  const int t0 = grp * 16;
  int L, g0; const u16* ki;
  if (!samp) { const int c = t0 >> 6; L = (c + 1) * 64; g0 = b * 2048 + t0; ki = p.kiP() + (size_t)b * 2048 * 64; }
  else { L = 2112; g0 = NPROMPT + b * 64 + t0; ki = p.kiS() + (size_t)b * 2112 * 64; }
  const int nj = L >> 6;
  if (L <= 256) {
    for (int qq = 0; qq < 4; ++qq) {
      const int q = w * 4 + qq;
      if (lane < nj) p.maskbits()[(size_t)(g0 + q) * 33 + lane] = ~0ull;
    }
    return;
  }
  u16* keys = (u16*)lds;
#ifndef REPMF
#define REPMF 1
#endif
#ifndef REPSEL
#define REPSEL 1
#endif
#ifndef REPKV
#define REPKV 1
#endif
  for (int rmf = 0; rmf < REPMF; ++rmf) {
    const int qn = lane & 15, quad = lane >> 4;
    bf16x8 qf[8][2];
    float wv[8];
#pragma unroll
    for (int h = 0; h < 8; ++h) {
      qf[h][0] = ldg8(p.qi() + (size_t)(g0 + qn) * 512 + h * 64 + quad * 8);
      qf[h][1] = ldg8(p.qi() + (size_t)(g0 + qn) * 512 + h * 64 + 32 + quad * 8);
      wv[h] = p.wi()[(size_t)(g0 + qn) * 8 + h];
    }
    bf16x8 A0[4], A1[4], N0[4], N1[4];
#pragma unroll
    for (int i = 0; i < 4; ++i) {
      const int kt = w + 4 * i;
      A0[i] = ldg8(ki + (size_t)(kt * 16 + qn) * 64 + quad * 8);
      A1[i] = ldg8(ki + (size_t)(kt * 16 + qn) * 64 + 32 + quad * 8);
    }
    for (int base = 0; base < nj; base += 4) {
#pragma unroll
      for (int i = 0; i < 4; ++i) {
        const int t = min(base + 4 + i, nj - 1);
        const int kt = w + 4 * t;
        N0[i] = ldg8(ki + (size_t)(kt * 16 + qn) * 64 + quad * 8);
        N1[i] = ldg8(ki + (size_t)(kt * 16 + qn) * 64 + 32 + quad * 8);
      }
#pragma unroll
      for (int i = 0; i < 4; ++i) {
        const int t = base + i;
        if (t < nj) {
          const int kt = w + 4 * t;
          float idx[4] = {0.f, 0.f, 0.f, 0.f};
#pragma unroll
          for (int h = 0; h < 8; ++h) {
            f32x4 acc = {0.f, 0.f, 0.f, 0.f};
            acc = MFMA16(A0[i], qf[h][0], acc);
            acc = MFMA16(A1[i], qf[h][1], acc);
#pragma unroll
            for (int e = 0; e < 4; ++e) idx[e] += fmaxf(acc[e], 0.f) * wv[h];
          }
          s16x4 kv;
#pragma unroll
          for (int e = 0; e < 4; ++e) {
            _Float16 hv = (_Float16)idx[e];
            u16 bits = __builtin_bit_cast(u16, hv);
            kv[e] = (short)((bits & 0x8000) ? (u16)~bits : (u16)(bits | 0x8000));
          }
          *(s16x4*)(keys + qn * KPITCH + kt * 16 + quad * 4) = kv;
        }
      }
#pragma unroll
      for (int i = 0; i < 4; ++i) { A0[i] = N0[i]; A1[i] = N1[i]; }
    }
  }
  __syncthreads();
  for (int qq = 0; qq < 4 * REPSEL; ++qq) {
    const int q = w * 4 + (qq & 3);
    const u16* krow = keys + q * KPITCH;
    u64* dst = p.maskbits() + (size_t)(g0 + q) * 33;
    if (nj <= 8) select_query<8>(krow, nj, lane, dst);
    else if (nj <= 16) select_query<16>(krow, nj, lane, dst);
    else if (nj <= 24) select_query<24>(krow, nj, lane, dst);
    else select_query<33>(krow, nj, lane, dst);
  }
  __syncthreads();
}

DI void scan_item(const Params& p, int item, int tid) {
  if (item < 1024) {
    const int bh = item >> 4, slab = item & 15;
    const int idx = slab * 1024 + tid * 4;
    const int h = bh & 3;
    const float cd = exp2f(64.f * log2gamma(h));
    f32x4 s = {0.f, 0.f, 0.f, 0.f};
    s16x4 kraw[2][8];
#pragma unroll
    for (int i = 0; i < 8; ++i) kraw[0][i] = __builtin_nontemporal_load((const s16x4*)((const u16*)p.kvT() + (size_t)(bh * 32 + i) * 16384 + idx));
#pragma unroll
    for (int b8 = 0; b8 < 4; ++b8) {
      if (b8 < 3) {
#pragma unroll
        for (int i = 0; i < 8; ++i) kraw[(b8 + 1) & 1][i] = __builtin_nontemporal_load((const s16x4*)((const u16*)p.kvT() + (size_t)(bh * 32 + (b8 + 1) * 8 + i) * 16384 + idx));
      }
#pragma unroll
      for (int i = 0; i < 8; ++i) {
        __builtin_nontemporal_store(pack4(s), (s16x4*)(p.sprevT() + (size_t)(bh * 32 + b8 * 8 + i) * 16384 + idx));
        f32x4 kv;
#pragma unroll
        for (int j = 0; j < 4; ++j) kv[j] = __uint_as_float(((unsigned)(u16)kraw[b8 & 1][i][j]) << 16);
        s = s * cd + kv;
      }
    }
    const int e = idx >> 7, d = idx & 127;
    float* o = p.out + OUT_STP + (size_t)bh * 16384;
#pragma unroll
    for (int j = 0; j < 4; ++j) o[(d + j) * 128 + e] = s[j];
  } else {
    const int it = item - 1024;
    const int bh = it >> 4, slab = it & 15;
    const int idx = slab * 1024 + tid * 4;
    const int h = bh & 3;
    const float cd = exp2f(64.f * log2gamma(h));
    const int e = idx >> 7, d = idx & 127;
    const float* s0 = p.state_ret + (size_t)bh * 16384;
    f32x4 s;
#pragma unroll
    for (int j = 0; j < 4; ++j) s[j] = s0[(d + j) * 128 + e];
    const size_t base = (size_t)(2048 + bh) * 16384 + idx;
    s16x4 o = pack4(s);
    *(s16x4*)(p.sprevT() + base) = o;
    const s16x4 kk = *(const s16x4*)((const u16*)p.kvT() + base);
    f32x4 kv;
#pragma unroll
    for (int j = 0; j < 4; ++j) kv[j] = __uint_as_float(((unsigned)(u16)kk[j]) << 16);
    s = s * cd + kv;
    float* oo = p.out + OUT_STS + (size_t)bh * 16384;
#pragma unroll
    for (int j = 0; j < 4; ++j) oo[(d + j) * 128 + e] = s[j];
  }
}

DI void attn_item(const Params& p, unsigned char* lds, int tid, bool samp, int b, int c, int kvh, int qh, unsigned char* lds_blk, int tid512) {
  const int lane = tid & 63, w = tid >> 6, r = lane & 31, hh = lane >> 5;
  const int T = samp ? 2112 : 2048;
  const int nkt = samp ? 33 : c + 1;
  const int g0 = (samp ? NPROMPT + b * 64 : b * 2048 + c * 64) + qh * 32;
  const u16* K = samp ? p.kaS() + (size_t)(b * 2 + kvh) * 2112 * 64 : p.kaP() + (size_t)(b * 2 + kvh) * 2048 * 64;
  const u16* VT = samp ? p.vaTS() + (size_t)(b * 2 + kvh) * 64 * 2112 : p.vaTP() + (size_t)(b * 2 + kvh) * 64 * 2048;
  const int head = kvh * 4 + w;
  u16* KV0 = (u16*)(lds_blk + 2 * HALF_LDS - 4 * 9216);
  u64* mL = (u64*)lds;
  {
    u64 mv[5];
#pragma unroll
    for (int i = 0; i < 5; ++i) { const int ix = tid + 256 * i; mv[i] = __builtin_nontemporal_load(p.maskbits() + (size_t)g0 * 33 + (ix < 32 * 33 ? ix : 32 * 33 - 1)); }
#pragma unroll
    for (int i = 0; i < 5; ++i) { const int ix = tid + 256 * i; if (ix < 32 * 33) mL[ix] = mv[i]; }
  }
  bf16x8 qf[4];
#pragma unroll
  for (int ks = 0; ks < 4; ++ks) qf[ks] = ldg8(p.qa() + (size_t)(g0 + r) * 512 + head * 64 + ks * 16 + hh * 8);
  const u16* grow = p.gate() + (size_t)(g0 + r) * 1024 + 512 + head * 64;
  s16x4 gvv[2][4];
#pragma unroll
  for (int dt = 0; dt < 2; ++dt)
#pragma unroll
    for (int q4 = 0; q4 < 4; ++q4) gvv[dt][q4] = *(const s16x4*)(grow + dt * 32 + 8 * q4 + 4 * hh);
  f32x16 O[2];
  O[0] = zero16(); O[1] = zero16();
  float mrun = -1e30f, lrun = 0.f;
  const int lrow = tid512 >> 3, lch = tid512 & 7;
  const int loff = lrow * 72 + lch * 8;
  bf16x8 pk0, pv0, nk0, nv0;
  {
    const bf16x8 k0 = ldg8(K + (size_t)(lrow)*64 + lch * 8), v0 = ldg8(VT + (size_t)(lrow)*T + lch * 8);
    const int t1 = nkt > 1 ? 1 : 0, t2 = nkt > 2 ? 2 : (nkt - 1);
    pk0 = ldg8(K + (size_t)(t1 * 64 + lrow) * 64 + lch * 8); pv0 = ldg8(VT + (size_t)(lrow)*T + t1 * 64 + lch * 8);
    nk0 = ldg8(K + (size_t)(t2 * 64 + lrow) * 64 + lch * 8); nv0 = ldg8(VT + (size_t)(lrow)*T + t2 * 64 + lch * 8);
    *(bf16x8*)(KV0 + loff) = k0;
    *(bf16x8*)(KV0 + 64 * 72 + loff) = v0;
  }
  __syncthreads();
  for (int kt = 0; kt < nkt; ++kt) {
    if (kt + 1 < nkt) {
      u16* nb = KV0 + ((kt + 1) & 1) * (2 * 64 * 72);
      *(bf16x8*)(nb + loff) = pk0;
      *(bf16x8*)(nb + 64 * 72 + loff) = pv0;
    }
    pk0 = nk0; pv0 = nv0;
    {
      const int t3 = (kt + 3 < nkt) ? kt + 3 : nkt - 1;
      nk0 = ldg8(K + (size_t)(t3 * 64 + lrow) * 64 + lch * 8);
      nv0 = ldg8(VT + (size_t)(lrow)*T + t3 * 64 + lch * 8);
    }
    const u16* Ks = KV0 + (kt & 1) * (2 * 64 * 72);
    const u16* Vs = Ks + 64 * 72;
    f32x16 S[2];
#pragma unroll
    for (int st = 0; st < 2; ++st) {
      S[st] = zero16();
#pragma unroll
      for (int ks = 0; ks < 4; ++ks) {
        bf16x8 kf = *(const bf16x8*)(Ks + (st * 32 + r) * 72 + ks * 16 + hh * 8);
        S[st] = MFMA32(kf, qf[ks], S[st]);
      }
    }
    const u64 W = mL[r * 33 + kt];
    const int wl = (int)(((unsigned)W) >> (4 * hh)), wh = (int)(((unsigned)(W >> 32)) >> (4 * hh));
    float mx = fmaxf(S[0][0], S[1][0]);
#pragma unroll
    for (int i = 1; i < 16; ++i) mx = fmaxf(mx, fmaxf(S[0][i], S[1][i]));
    mx = fmaxf(mx, __shfl_xor(mx, 32));
    const float mn = fmaxf(mrun, mx);
    const float alpha = __builtin_amdgcn_exp2f(mrun - mn);
    const bool resc = __any(mn != mrun);
    mrun = mn;
    float ls = 0.f;
#pragma unroll
    for (int st = 0; st < 2; ++st)
#pragma unroll
      for (int i = 0; i < 16; ++i) {
        const int keep = __builtin_amdgcn_sbfe(st ? wh : wl, (i & 3) + 8 * (i >> 2), 1);
        const float pvv = __int_as_float(__float_as_int(__builtin_amdgcn_exp2f(S[st][i] - mn)) & keep);
        S[st][i] = pvv;
        ls += pvv;
      }
    lrun = lrun * alpha + ls;
    if (resc) {
#pragma unroll
      for (int dt = 0; dt < 2; ++dt)
#pragma unroll
        for (int i = 0; i < 16; ++i) O[dt][i] *= alpha;
    }
#pragma unroll
    for (int st = 0; st < 2; ++st)
#pragma unroll
      for (int s2 = 0; s2 < 2; ++s2) {
        bf16x8 pf = pack8(S[st][8 * s2 + 0], S[st][8 * s2 + 1], S[st][8 * s2 + 2], S[st][8 * s2 + 3],
                          S[st][8 * s2 + 4], S[st][8 * s2 + 5], S[st][8 * s2 + 6], S[st][8 * s2 + 7]);
#pragma unroll
        for (int dt = 0; dt < 2; ++dt) {
          s16x4 lo = *(const s16x4*)(Vs + (dt * 32 + r) * 72 + st * 32 + 16 * s2 + 4 * hh);
          s16x4 hi = *(const s16x4*)(Vs + (dt * 32 + r) * 72 + st * 32 + 16 * s2 + 8 + 4 * hh);
          bf16x8 vf = __builtin_shufflevector(lo, hi, 0, 1, 2, 3, 4, 5, 6, 7);
          O[dt] = MFMA32(vf, pf, O[dt]);
        }
      }
    __syncthreads();
  }
  {
    float lt = lrun + __shfl_xor(lrun, 32);
    const float inv = 1.f / fmaxf(lt, 1e-30f);
    u16* mrow = p.mix() + (size_t)(g0 + r) * 1024 + 512 + head * 64;
#pragma unroll
    for (int dt = 0; dt < 2; ++dt)
#pragma unroll
      for (int q4 = 0; q4 < 4; ++q4) {
        const int d = dt * 32 + 8 * q4 + 4 * hh;
        f32x4 of;
#pragma unroll
        for (int j = 0; j < 4; ++j) {
          const float gf = __uint_as_float(((unsigned)(u16)gvv[dt][q4][j]) << 16);
          of[j] = O[dt][q4 * 4 + j] * inv * gf;
        }
        *(s16x4*)(mrow + d) = pack4(of);
      }
  }
  __syncthreads();
}

DI void ret_out_item(const Params& p, unsigned char* lds, int item, int tid) {
  const int lane = tid & 63, w = tid >> 6, r = lane & 31, hh = lane >> 5;
  int bh, c, T, g0; const u16* vT;
  if (item < 2048) { bh = item >> 5; c = item & 31; T = 2048; g0 = (bh >> 2) * 2048 + c * 64; vT = p.vrT() + (size_t)bh * 128 * 2048; }
  else { bh = item - 2048; c = 0; T = 64; g0 = NPROMPT + (bh >> 2) * 64; vT = p.vrT() + (size_t)64 * 128 * 2048 + (size_t)bh * 128 * 64; }
  const int h = bh & 3;
  const float l2g = log2gamma(h);
  const int nt = w & 1, eh = w >> 1;
  const int n = nt * 32 + r;
  const u16* sp = p.sprevT() + (size_t)item * 16384;
  bf16x8 qf[8], kf[8], sf[8];
  s16x4 vlo[2][2][2], vhi[2][2][2];
#pragma unroll
  for (int ks = 0; ks < 8; ++ks) qf[ks] = ldg8(p.qr() + (size_t)(g0 + n) * 512 + h * 128 + ks * 16 + hh * 8);
#pragma unroll
  for (int ks = 0; ks < 8; ++ks) kf[ks] = ldg8(p.kr() + (size_t)(g0 + r) * 512 + h * 128 + ks * 16 + hh * 8);
#pragma unroll
  for (int et = 0; et < 2; ++et)
#pragma unroll
    for (int mt = 0; mt < 2; ++mt)
#pragma unroll
      for (int s2 = 0; s2 < 2; ++s2) {
        const u16* vp = vT + (size_t)((2 * eh + et) * 32 + r) * T + c * 64 + mt * 32 + 16 * s2 + 4 * hh;
        vlo[et][mt][s2] = ldg4(vp); vhi[et][mt][s2] = ldg4(vp + 8);
      }
  __builtin_amdgcn_sched_barrier(0);
  bf16x8 pf[2][2];
#pragma unroll
  for (int mt = 0; mt < 2; ++mt) {
    f32x16 S = zero16();
#pragma unroll
    for (int ks = 0; ks < 8; ++ks) S = MFMA32(kf[ks], qf[ks], S);
    if (mt == 0) {
#pragma unroll
      for (int ks = 0; ks < 8; ++ks) kf[ks] = ldg8(p.kr() + (size_t)(g0 + 32 + r) * 512 + h * 128 + ks * 16 + hh * 8);
#pragma unroll
      for (int ks = 0; ks < 8; ++ks) sf[ks] = ldg8(sp + (size_t)((2 * eh) * 32 + r) * 128 + ks * 16 + hh * 8);
      __builtin_amdgcn_sched_barrier(0);
    }
#pragma unroll
    for (int i = 0; i < 16; ++i) {
      const int m = mt * 32 + crow(i, hh);
      const int dd = n > m ? n - m : m - n;
      S[i] *= exp2f((float)dd * l2g);
    }
    pf[mt][0] = pack8(S[0], S[1], S[2], S[3], S[4], S[5], S[6], S[7]);
    pf[mt][1] = pack8(S[8], S[9], S[10], S[11], S[12], S[13], S[14], S[15]);
  }
  const float fs = exp2f((float)(n + 1) * l2g);
  f32x16 tot[2];
  float ss = 0.f;
#pragma unroll
  for (int et = 0; et < 2; ++et) {
    f32x16 Oi = zero16(), X = zero16();
#pragma unroll
    for (int ks = 0; ks < 8; ++ks) X = MFMA32(sf[ks], qf[ks], X);
    if (et == 0) {
#pragma unroll
      for (int ks = 0; ks < 8; ++ks) sf[ks] = ldg8(sp + (size_t)((2 * eh + 1) * 32 + r) * 128 + ks * 16 + hh * 8);
      __builtin_amdgcn_sched_barrier(0);
    }
#pragma unroll
    for (int mt = 0; mt < 2; ++mt)
#pragma unroll
      for (int s2 = 0; s2 < 2; ++s2) {
        bf16x8 vf = __builtin_shufflevector(vlo[et][mt][s2], vhi[et][mt][s2], 0, 1, 2, 3, 4, 5, 6, 7);
        Oi = MFMA32(vf, pf[mt][s2], Oi);
      }
#pragma unroll
    for (int i = 0; i < 16; ++i) { const float t = Oi[i] + X[i] * fs; tot[et][i] = t; ss += t * t; }
  }
  ss += __shfl_xor(ss, 32);
  float* red = (float*)lds;
  __syncthreads();
  if (hh == 0) red[w * 32 + r] = ss;
  __syncthreads();
  const float tsum = red[w * 32 + r] + red[(w ^ 2) * 32 + r];
  const float rinv = rsqrtf(tsum * (1.f / 128.f) + 1e-6f);
  const u16* grow = p.gate() + (size_t)(g0 + n) * 1024 + h * 128;
  u16* mrow = p.mix() + (size_t)(g0 + n) * 1024 + h * 128;
  s16x4 gvv[2][4];
  f32x4 ggv[2][4];
#pragma unroll
  for (int et = 0; et < 2; ++et)
#pragma unroll
    for (int q4 = 0; q4 < 4; ++q4) {
      const int e = (2 * eh + et) * 32 + 8 * q4 + 4 * hh;
      gvv[et][q4] = *(const s16x4*)(grow + e);
      ggv[et][q4] = *(const f32x4*)(p.ret_gn_g + h * 128 + e);
    }
#pragma unroll
  for (int et = 0; et < 2; ++et)
#pragma unroll
    for (int q4 = 0; q4 < 4; ++q4) {
      const int e = (2 * eh + et) * 32 + 8 * q4 + 4 * hh;
      f32x4 of;
#pragma unroll
      for (int j = 0; j < 4; ++j) {
        const float gf = __uint_as_float(((unsigned)(u16)gvv[et][q4][j]) << 16);
        of[j] = tot[et][q4 * 4 + j] * rinv * ggv[et][q4][j] * gf;
      }
      *(s16x4*)(mrow + e) = pack4(of);
    }
}

DI void phase_final(const Params& p, int tid) {
  const int gt = blockIdx.x * 512 + tid, GT = gridDim.x * 512;
  const int lane = tid & 63;
  for (int row0 = (gt >> 6) * 2; row0 < NTOK; row0 += (GT >> 6) * 2) {
    f32x4 v[2][4];
    s16x4 zz[2][4];
#pragma unroll
    for (int rr = 0; rr < 2; ++rr) {
      const float* xr = xrow(p, row0 + rr);
      const u16* zr = p.gate() + (size_t)(row0 + rr) * 1024;
#pragma unroll
      for (int i = 0; i < 4; ++i) { v[rr][i] = __builtin_nontemporal_load((const f32x4*)(xr + i * 256 + lane * 4)); zz[rr][i] = __builtin_nontemporal_load((const s16x4*)(zr + i * 256 + lane * 4)); }
    }
    f32x4 g[4];
#pragma unroll
    for (int i = 0; i < 4; ++i) g[i] = *(const f32x4*)(p.final_g + i * 256 + lane * 4);
#pragma unroll
    for (int rr = 0; rr < 2; ++rr) {
      float ss = 0.f;
#pragma unroll
      for (int i = 0; i < 4; ++i) {
#pragma unroll
        for (int j = 0; j < 4; ++j) v[rr][i][j] += __uint_as_float(((unsigned)(u16)zz[rr][i][j]) << 16);
        ss += v[rr][i][0] * v[rr][i][0] + v[rr][i][1] * v[rr][i][1] + v[rr][i][2] * v[rr][i][2] + v[rr][i][3] * v[rr][i][3];
      }
#pragma unroll
      for (int o = 32; o >= 1; o >>= 1) ss += __shfl_xor(ss, o);
      const float rv = rsqrtf(ss * (1.f / 1024.f) + 1e-6f);
      float* y = p.out + OUT_Y + (size_t)(row0 + rr) * 1024;
#pragma unroll
      for (int i = 0; i < 4; ++i) __builtin_nontemporal_store(v[rr][i] * rv * g[i], (f32x4*)(y + i * 256 + lane * 4));
    }
  }
}

static __device__ const u16 idx_tab[1280] = {32, 16, 80, 65535, 65535, 96, 144, 208, 65535, 65535, 160, 272, 336, 65535, 65535, 224, 400, 464, 65535, 65535, 288, 528, 592, 65535, 65535, 352, 656, 720, 65535, 65535, 416, 784, 848, 65535, 65535, 480, 912, 976, 65535, 65535, 544, 1040, 1104, 65535, 65535, 608, 1168, 1232, 65535, 65535, 672, 1296, 1360, 65535, 65535, 736, 1424, 1488, 65535, 65535, 800, 1552, 1616, 65535, 65535, 864, 1680, 1744, 65535, 65535, 928, 1808, 1872, 65535, 65535, 992, 1936, 2000, 65535, 65535, 31, 17, 15, 3, 67, 95, 81, 79, 131, 195, 159, 145, 143, 259, 323, 223, 209, 207, 387, 451, 287, 273, 271, 515, 579, 351, 337, 335, 643, 707, 415, 401, 399, 771, 835, 479, 465, 463, 899, 963, 543, 529, 527, 1027, 1091, 607, 593, 591, 1155, 1219, 671, 657, 655, 1283, 1347, 735, 721, 719, 1411, 1475, 799, 785, 783, 1539, 1603, 863, 849, 847, 1667, 1731, 927, 913, 911, 1795, 1859, 991, 977, 975, 1923, 1987, 1055, 1041, 1039, 65535, 65535, 1119, 1105, 1103, 65535, 65535, 1183, 1169, 1167, 65535, 65535, 1247, 1233, 1231, 65535, 65535, 1311, 1297, 1295, 65535, 65535, 1375, 1361, 1359, 65535, 65535, 1439, 1425, 1423, 65535, 65535, 1503, 1489, 1487, 65535, 65535, 1567, 1553, 1551, 65535, 65535, 1631, 1617, 1615, 65535, 65535, 1695, 1681, 1679, 65535, 65535, 1759, 1745, 1743, 65535, 65535, 1823, 1809, 1807, 65535, 65535, 1887, 1873, 1871, 65535, 65535, 1951, 1937, 1935, 65535, 65535, 2015, 2001, 1999, 65535, 65535, 30, 18, 14, 1, 65, 94, 82, 78, 129, 193, 158, 146, 142, 257, 321, 222, 210, 206, 385, 449, 286, 274, 270, 513, 577, 350, 338, 334, 641, 705, 414, 402, 398, 769, 833, 478, 466, 462, 897, 961, 542, 530, 526, 1025, 1089, 606, 594, 590, 1153, 1217, 670, 658, 654, 1281, 1345, 734, 722, 718, 1409, 1473, 798, 786, 782, 1537, 1601, 862, 850, 846, 1665, 1729, 926, 914, 910, 1793, 1857, 990, 978, 974, 1921, 1985, 1054, 1042, 1038, 2, 66, 1118, 1106, 1102, 130, 194, 1182, 1170, 1166, 258, 322, 1246, 1234, 1230, 386, 450, 1310, 1298, 1294, 514, 578, 1374, 1362, 1358, 642, 706, 1438, 1426, 1422, 770, 834, 1502, 1490, 1486, 898, 962, 1566, 1554, 1550, 1026, 1090, 1630, 1618, 1614, 1154, 1218, 1694, 1682, 1678, 1282, 1346, 1758, 1746, 1742, 1410, 1474, 1822, 1810, 1806, 1538, 1602, 1886, 1874, 1870, 1666, 1730, 1950, 1938, 1934, 1794, 1858, 2014, 2002, 1998, 1922, 1986, 29, 19, 13, 4, 65535, 93, 83, 77, 68, 65535, 157, 147, 141, 132, 65535, 221, 211, 205, 196, 65535, 285, 275, 269, 260, 65535, 349, 339, 333, 324, 65535, 413, 403, 397, 388, 65535, 477, 467, 461, 452, 65535, 541, 531, 525, 516, 65535, 605, 595, 589, 580, 65535, 669, 659, 653, 644, 65535, 733, 723, 717, 708, 65535, 797, 787, 781, 772, 65535, 861, 851, 845, 836, 65535, 925, 915, 909, 900, 65535, 989, 979, 973, 964, 65535, 1053, 1043, 1037, 0, 64, 1117, 1107, 1101, 128, 192, 1181, 1171, 1165, 256, 320, 1245, 1235, 1229, 384, 448, 1309, 1299, 1293, 512, 576, 1373, 1363, 1357, 640, 704, 1437, 1427, 1421, 768, 832, 1501, 1491, 1485, 896, 960, 1565, 1555, 1549, 1024, 1088, 1629, 1619, 1613, 1152, 1216, 1693, 1683, 1677, 1280, 1344, 1757, 1747, 1741, 1408, 1472, 1821, 1811, 1805, 1536, 1600, 1885, 1875, 1869, 1664, 1728, 1949, 1939, 1933, 1792, 1856, 2013, 2003, 1997, 1920, 1984, 28, 20, 12, 5, 65535, 92, 84, 76, 69, 65535, 156, 148, 140, 133, 65535, 220, 212, 204, 197, 65535, 284, 276, 268, 261, 65535, 348, 340, 332, 325, 65535, 412, 404, 396, 389, 65535, 476, 468, 460, 453, 65535, 540, 532, 524, 517, 65535, 604, 596, 588, 581, 65535, 668, 660, 652, 645, 65535, 732, 724, 716, 709, 65535, 796, 788, 780, 773, 65535, 860, 852, 844, 837, 65535, 924, 916, 908, 901, 65535, 988, 980, 972, 965, 65535, 1052, 1044, 1036, 1028, 65535, 1116, 1108, 1100, 1092, 65535, 1180, 1172, 1164, 1156, 65535, 1244, 1236, 1228, 1220, 65535, 1308, 1300, 1292, 1284, 65535, 1372, 1364, 1356, 1348, 65535, 1436, 1428, 1420, 1412, 65535, 1500, 1492, 1484, 1476, 65535, 1564, 1556, 1548, 1540, 65535, 1628, 1620, 1612, 1604, 65535, 1692, 1684, 1676, 1668, 65535, 1756, 1748, 1740, 1732, 65535, 1820, 1812, 1804, 1796, 65535, 1884, 1876, 1868, 1860, 65535, 1948, 1940, 1932, 1924, 65535, 2012, 2004, 1996, 1988, 65535, 27, 21, 11, 6, 65535, 91, 85, 75, 70, 65535, 155, 149, 139, 134, 65535, 219, 213, 203, 198, 65535, 283, 277, 267, 262, 65535, 347, 341, 331, 326, 65535, 411, 405, 395, 390, 65535, 475, 469, 459, 454, 65535, 539, 533, 523, 518, 65535, 603, 597, 587, 582, 65535, 667, 661, 651, 646, 65535, 731, 725, 715, 710, 65535, 795, 789, 779, 774, 65535, 859, 853, 843, 838, 65535, 923, 917, 907, 902, 65535, 987, 981, 971, 966, 65535, 1051, 1045, 1035, 1029, 65535, 1115, 1109, 1099, 1093, 65535, 1179, 1173, 1163, 1157, 65535, 1243, 1237, 1227, 1221, 65535, 1307, 1301, 1291, 1285, 65535, 1371, 1365, 1355, 1349, 65535, 1435, 1429, 1419, 1413, 65535, 1499, 1493, 1483, 1477, 65535, 1563, 1557, 1547, 1541, 65535, 1627, 1621, 1611, 1605, 65535, 1691, 1685, 1675, 1669, 65535, 1755, 1749, 1739, 1733, 65535, 1819, 1813, 1803, 1797, 65535, 1883, 1877, 1867, 1861, 65535, 1947, 1941, 1931, 1925, 65535, 2011, 2005, 1995, 1989, 65535, 26, 22, 10, 7, 65535, 90, 86, 74, 71, 65535, 154, 150, 138, 135, 65535, 218, 214, 202, 199, 65535, 282, 278, 266, 263, 65535, 346, 342, 330, 327, 65535, 410, 406, 394, 391, 65535, 474, 470, 458, 455, 65535, 538, 534, 522, 519, 65535, 602, 598, 586, 583, 65535, 666, 662, 650, 647, 65535, 730, 726, 714, 711, 65535, 794, 790, 778, 775, 65535, 858, 854, 842, 839, 65535, 922, 918, 906, 903, 65535, 986, 982, 970, 967, 65535, 1050, 1046, 1034, 1030, 65535, 1114, 1110, 1098, 1094, 65535, 1178, 1174, 1162, 1158, 65535, 1242, 1238, 1226, 1222, 65535, 1306, 1302, 1290, 1286, 65535, 1370, 1366, 1354, 1350, 65535, 1434, 1430, 1418, 1414, 65535, 1498, 1494, 1482, 1478, 65535, 1562, 1558, 1546, 1542, 65535, 1626, 1622, 1610, 1606, 65535, 1690, 1686, 1674, 1670, 65535, 1754, 1750, 1738, 1734, 65535, 1818, 1814, 1802, 1798, 65535, 1882, 1878, 1866, 1862, 65535, 1946, 1942, 1930, 1926, 65535, 2010, 2006, 1994, 1990, 65535, 25, 23, 9, 8, 65535, 89, 87, 73, 72, 65535, 153, 151, 137, 136, 65535, 217, 215, 201, 200, 65535, 281, 279, 265, 264, 65535, 345, 343, 329, 328, 65535, 409, 407, 393, 392, 65535, 473, 471, 457, 456, 65535, 537, 535, 521, 520, 65535, 601, 599, 585, 584, 65535, 665, 663, 649, 648, 65535, 729, 727, 713, 712, 65535, 793, 791, 777, 776, 65535, 857, 855, 841, 840, 65535, 921, 919, 905, 904, 65535, 985, 983, 969, 968, 65535, 1049, 1047, 1033, 1031, 65535, 1113, 1111, 1097, 1095, 65535, 1177, 1175, 1161, 1159, 65535, 1241, 1239, 1225, 1223, 65535, 1305, 1303, 1289, 1287, 65535, 1369, 1367, 1353, 1351, 65535, 1433, 1431, 1417, 1415, 65535, 1497, 1495, 1481, 1479, 65535, 1561, 1559, 1545, 1543, 65535, 1625, 1623, 1609, 1607, 65535, 1689, 1687, 1673, 1671, 65535, 1753, 1751, 1737, 1735, 65535, 1817, 1815, 1801, 1799, 65535, 1881, 1879, 1865, 1863, 65535, 1945, 1943, 1929, 1927, 65535, 2009, 2007, 1993, 1991, 65535, 24, 88, 1032, 65535, 65535, 152, 216, 1096, 65535, 65535, 280, 344, 1160, 65535, 65535, 408, 472, 1224, 65535, 65535, 536, 600, 1288, 65535, 65535, 664, 728, 1352, 65535, 65535, 792, 856, 1416, 65535, 65535, 920, 984, 1480, 65535, 65535, 1048, 1112, 1544, 65535, 65535, 1176, 1240, 1608, 65535, 65535, 1304, 1368, 1672, 65535, 65535, 1432, 1496, 1736, 65535, 65535, 1560, 1624, 1800, 65535, 65535, 1688, 1752, 1864, 65535, 65535, 1816, 1880, 1928, 65535, 65535, 1944, 2008, 1992, 65535, 65535};

#ifndef REP0
#define REP0 1
#endif
#ifndef REP1
#define REP1 1
#endif
#ifndef REP2
#define REP2 1
#endif
#ifndef REP3
#define REP3 1
#endif
#ifndef REP4
#define REP4 1
#endif
#ifndef REP5
#define REP5 1
#endif
__global__ void __launch_bounds__(512, 2) fwd_megakernel(Params p) {
  __shared__ __attribute__((aligned(16))) unsigned char lds[LDS_BYTES];
  cg::grid_group grid = cg::this_grid();
  const int wave_id = __builtin_amdgcn_readfirstlane((int)threadIdx.x >> 6);
#define FRESH_TID() int tid = wave_id * 64 + lane_id(); asm volatile("" : "+v"(tid)); const int half = tid >> 8, htid = tid & 255; unsigned char* ldsh = lds + half * HALF_LDS; (void)htid; (void)ldsh;
  if (p.out == nullptr) grid.sync();
  if (wave_id == 0 && lane_id() == 0) (void)xb_add(&p.bar()[XB_XCNT(xb_xcc_id())], 1u);
  for (int rep = 0; rep < REP0; ++rep) {
  { FRESH_TID(); phase_prep(p, tid); }
  xcd_barrier(p.bar(), wave_id);
  }
  for (int rep = 0; rep < REP1; ++rep) {
  {
    FRESH_TID();
    pg8::Gemm g; g.A = p.xb(); g.Bt = p.WtIn(); g.M = NTOK; g.N = 4096; g.K = 1024;
    pg8::StaticOrder S; S.init(g.M, g.N, (int)gridDim.x, (int)blockIdx.x); S.permtab = 0xEFBCD87694105A32ull; S.padtile = 15;
    Epi1 E; E.p = p; E.hl0 = (LAS unsigned char*)lds + pg8::STAGE_BYTES;
    pg8::gemm_phase<Epi1>((LAS unsigned char*)lds, g, S, E, wave_id);
  }
  xcd_barrier(p.bar(), wave_id);
  }
  for (int rep = 0; rep < REP2; ++rep) {
  {
    FRESH_TID();
    if (gridDim.x == 256) {
      for (int k = 0; k < 5; ++k) {
        const unsigned ent = idx_tab[blockIdx.x * 5 + k];
        if (ent == 0xFFFFu) continue;
        int ht = htid; asm volatile("" : "+v"(ht));
        const int code = (int)(ent & 63u), pr = (int)(ent >> 6);
        const bool samp = (code == 32);
        const int b = pr >> 1, sub = 2 * (pr & 1) + half;
        idx_item(p, ldsh, ht, samp, b, samp ? sub : code * 4 + sub);
      }
      for (int it0 = blockIdx.x * 2; it0 < 2080; it0 += gridDim.x * 2) {
        int ht = htid; asm volatile("" : "+v"(ht));
        ret_kv_item(p, it0 + half, ht);
      }
    } else
    for (int it0 = blockIdx.x * 2; it0 < 2080 + 2080; it0 += gridDim.x * 2) {
      const int it = it0 + half;
      int ht = htid; asm volatile("" : "+v"(ht));
      if (it < 2080) {
        const bool samp = it < 32;
        const int j = it - 32;
        const int c = 31 - (j >> 6);
        const int b = samp ? (it >> 2) : ((j & 63) >> 2);
        const int grp = samp ? (it & 3) : (c * 4 + (j & 3));
        idx_item(p, ldsh, ht, samp, b, grp);
      } else { for (int rkv = 0; rkv < REPKV; ++rkv) ret_kv_item(p, it - 2080, ht); }
    }
  }
  xcd_barrier(p.bar(), wave_id);
  }
  for (int rep = 0; rep < REP3; ++rep) {
  {
    FRESH_TID();
    const int nit3 = ((1056 + 1536) - (int)blockIdx.x * 2 + (int)gridDim.x * 2 - 1) / ((int)gridDim.x * 2);
    const bool rev3 = ((blockIdx.x >> 3) & 1) != 0;
    for (int kk = 0; kk < nit3; ++kk) {
      const int it0 = (int)blockIdx.x * 2 + (rev3 ? nit3 - 1 - kk : kk) * (int)gridDim.x * 2;

      const int it = it0 + half;
      int ht = htid; asm volatile("" : "+v"(ht));
      if (it < 1056) {
        bool samp = it < 32;
        const int j = it - 32;
        int c = samp ? 0 : 31 - (j >> 6);
        int b = samp ? (it >> 2) : ((j & 63) >> 2);
        int kvh = (it >> 1) & 1;
        if (gridDim.x == 256) {
          const int blk = (int)blockIdx.x, k = it0 >> 9, x = blk & 7;
          int q;
          samp = false;
          if (blk < 16) { const int s = blk >> 3; c = (k < 2) ? 16 : 17; q = (k < 2) ? s + 2 * k : s; }
          else {
            const int m = (blk - 16) >> 3, cls = m >> 2;
            q = m & 3;
            if (cls < 7) c = (k == 0) ? 31 - cls : 18 + cls;
            else if (k == 0) { samp = true; c = 0; }
            else { c = 17; q += 2; }
          }
          if (samp) { b = x; kvh = q & 1; } else { b = 2 * x + (q & 1); kvh = q >> 1; }
        }
        attn_item(p, ldsh, ht, samp, b, c, kvh, it & 1, lds, tid);
      } else scan_item(p, it - 1056, ht);
    }
  }
  xcd_barrier(p.bar(), wave_id);
  }
  for (int rep = 0; rep < REP4; ++rep) {
  {
    FRESH_TID();
    const int nit4 = ((2080 + 1024) - (int)blockIdx.x * 2 + (int)gridDim.x * 2 - 1) / ((int)gridDim.x * 2);
    const bool rev4 = ((blockIdx.x >> 3) & 1) != 0;
    for (int kk = 0; kk < nit4; ++kk) {
      const int it0 = (int)blockIdx.x * 2 + (rev4 ? nit4 - 1 - kk : kk) * (int)gridDim.x * 2;

      const int it = it0 + half;
      int ht = htid; asm volatile("" : "+v"(ht));
      if (it < 2080) ret_out_item(p, ldsh, it, ht);
      else {
        const int ia = it - 2080 + 1056;
        const int j = ia - 32;
        int c = 31 - (j >> 6);
        int b = (j & 63) >> 2;
        int kvh = (ia >> 1) & 1;
        if (gridDim.x == 256) {
          const int blk = (int)blockIdx.x, k = it0 >> 9, x = blk & 7;
          int q;
          if (blk < 16) { q = blk >> 3; c = (k == 5) ? 9 : 0; }
          else {
            const int m = (blk - 16) >> 3, cls = m >> 2;
            const bool first = (k == 4);
            q = m & 3;
            if (cls < 6) c = first ? 15 - cls : 1 + cls;
            else if (cls == 6) c = first ? 8 : 7;
            else { c = first ? 9 : 0; q += 2; }
          }
          b = 2 * x + (q & 1); kvh = q >> 1;
        }
        attn_item(p, ldsh, ht, false, b, c, kvh, ia & 1, lds, tid);
      }
    }
  }
  xcd_barrier(p.bar(), wave_id);
  }
  for (int rep = 0; rep < REP5; ++rep) {
  {
    pg8::Gemm g; g.A = p.mix(); g.Bt = p.WtOut(); g.M = NTOK; g.N = 1024; g.K = 1024;
    pg8::StaticOrder S; S.init(g.M, g.N, (int)gridDim.x, (int)blockIdx.x);
    Epi2 E; E.p = p; E.hl = lds + pg8::STAGE_BYTES + (wave_id >> 2) * 16384;
    pg8::gemm_phase<Epi2>((LAS unsigned char*)lds, g, S, E, wave_id);
  }
  xcd_barrier(p.bar(), wave_id);
  }
  { FRESH_TID(); phase_final(p, tid); }
}

extern "C" void kernel_launch(void* const* d_in, const int* in_sizes, int n_in, void* d_out, int out_size, void* d_ws,
                              size_t ws_size, hipStream_t stream) {
  static int grid_blocks = 0;
  if (!grid_blocks) {
    int dev = 0, cus = 0, per_cu = 0;
    (void)hipGetDevice(&dev);
    (void)hipDeviceGetAttribute(&cus, hipDeviceAttributeMultiprocessorCount, dev);
    (void)hipOccupancyMaxActiveBlocksPerMultiprocessor(&per_cu, fwd_megakernel, 512, 0);
    if (per_cu < 1) per_cu = 1;
    if (per_cu > 1) per_cu = 1;
    grid_blocks = cus * per_cu;
  }
  Params p{};
  p.x_p = (const float*)d_in[0]; p.x_s = (const float*)d_in[1]; p.state_ret = (const float*)d_in[2];
  p.cache_k = (const float*)d_in[3]; p.cache_v = (const float*)d_in[4]; p.cache_kidx = (const float*)d_in[5];
  p.norm_g = (const float*)d_in[6]; p.w_in = (const float*)d_in[7]; p.ret_gn_g = (const float*)d_in[8];
  p.w_out = (const float*)d_in[9]; p.final_g = (const float*)d_in[10];
  p.out = (float*)d_out;
  p.ws = (unsigned char*)d_ws;
  (void)hipMemsetAsync((unsigned char*)d_ws + 530573312ull, 0, (size_t)XCD_BAR_WORDS * 4, stream);
  void* args[] = {&p};
  hipError_t e = hipLaunchCooperativeKernel((void*)fwd_megakernel, dim3(grid_blocks), dim3(512), args, 0, stream);
  if (e != hipSuccess) fprintf(stderr, "cooperative launch failed: %s (grid %d)\n", hipGetErrorString(e), grid_blocks);
}
```

```cpp
#include <hip/hip_runtime.h>
#include <hip/hip_cooperative_groups.h>
#include <stdint.h>
#include <cstdio>
namespace cg = cooperative_groups;

typedef __attribute__((ext_vector_type(8))) short bf16x8;
typedef __attribute__((ext_vector_type(4))) short s16x4;
typedef __attribute__((ext_vector_type(16))) float f32x16;
typedef __attribute__((ext_vector_type(4))) float f32x4;
typedef unsigned short u16;
typedef unsigned long long u64;


#define DI __device__ __forceinline__
#define MFMA32(a, b, c) __builtin_amdgcn_mfma_f32_32x32x16_bf16((a), (b), (c), 0, 0, 0)
#define MFMA16(a, b, c) __builtin_amdgcn_mfma_f32_16x16x32_bf16((a), (b), (c), 0, 0, 0)

#define NTOK 33280
#define NPROMPT 32768
#define LDS_BYTES 163840
#define HALF_LDS 81920
#define LAS __attribute__((address_space(3)))
#define KPITCH 2116

struct Params {
  const float *x_p, *x_s, *state_ret, *cache_k, *cache_v, *cache_kidx, *norm_g, *w_in, *ret_gn_g, *w_out, *final_g;
  float* out;
  unsigned char* ws;
  DI u16* xb() const { return (u16*)(ws + 0ull); }
  DI float* kvT() const { return (float*)(ws + 0ull); }
  DI u16* WtIn() const { return (u16*)(ws + 136314880ull); }
  DI u16* WtOut() const { return (u16*)(ws + 144703488ull); }
  DI u16* qr() const { return (u16*)(ws + 146800640ull); }
  DI u16* kr() const { return (u16*)(ws + 180879360ull); }
  DI u16* sprevT() const { return (u16*)(ws + 214958080ull); }
  DI u16* qi() const { return (u16*)(ws + 214958080ull); }
  DI u16* krT() const { return (u16*)(ws + 249036800ull); }
  DI u16* vrT() const { return (u16*)(ws + 283115520ull); }
  DI u16* gate() const { return (u16*)(ws + 317194240ull); }
  DI u16* mix() const { return (u16*)(ws + 385351680ull); }
  DI u16* qa() const { return (u16*)(ws + 453509120ull); }
  DI u16* kaP() const { return (u16*)(ws + 487587840ull); }
  DI u16* kaS() const { return (u16*)(ws + 495976448ull); }
  DI u16* vaTP() const { return (u16*)(ws + 500301824ull); }
  DI u16* vaTS() const { return (u16*)(ws + 508690432ull); }
  DI u16* kiP() const { return (u16*)(ws + 513015808ull); }
  DI u16* kiS() const { return (u16*)(ws + 517210112ull); }
  DI float* rinv() const { return (float*)(ws + 519372800ull); }
  DI float* wi() const { return (float*)(ws + 519505920ull); }
  DI float* cosR() const { return (float*)(ws + 520570880ull); }
  DI float* sinR() const { return (float*)(ws + 521111552ull); }
  DI float* cosA() const { return (float*)(ws + 521652224ull); }
  DI float* sinA() const { return (float*)(ws + 521719808ull); }
  DI unsigned* bar() const { return (unsigned*)(ws + 530573312ull); }
  DI u64* maskbits() const { return (u64*)(ws + 521787392ull); }
};

#define OUT_Y 0
#define OUT_STP (34078720)
#define OUT_KP (OUT_STP + 1048576)
#define OUT_VP (OUT_KP + 4194304)
#define OUT_KIP (OUT_VP + 4194304)
#define OUT_STS (OUT_KIP + 2097152)
#define OUT_KS (OUT_STS + 524288)
#define OUT_VS (OUT_KS + 65536)
#define OUT_KIS (OUT_VS + 65536)

typedef __bf16 bf16x2_t __attribute__((ext_vector_type(2)));
typedef float f32x2_t __attribute__((ext_vector_type(2)));
typedef unsigned u32x4_t __attribute__((ext_vector_type(4)));
typedef unsigned u32x2_t __attribute__((ext_vector_type(2)));
DI unsigned pk2(float a, float b) { f32x2_t v = {a, b}; bf16x2_t r = __builtin_convertvector(v, bf16x2_t); return __builtin_bit_cast(unsigned, r); }
DI u16 f2bf(float x) { return (u16)(pk2(x, x) & 0xffffu); }
DI bf16x8 ldg8(const u16* p) { return *(const bf16x8*)p; }
DI s16x4 ldg4(const u16* p) { return *(const s16x4*)p; }
DI float siluf(float x) { return x * __builtin_amdgcn_rcpf(1.f + __builtin_amdgcn_exp2f(-1.4426950408889634f * x)); }
DI int lane_id() { return (int)__builtin_amdgcn_mbcnt_hi(~0u, __builtin_amdgcn_mbcnt_lo(~0u, 0u)); }
DI int crow(int reg, int hh) { return (reg & 3) + 8 * (reg >> 2) + 4 * hh; }
DI const float* xrow(const Params& p, int g) { return g < NPROMPT ? p.x_p + (size_t)g * 1024 : p.x_s + (size_t)(g - NPROMPT) * 1024; }
DI float log2gamma(int h) { return log1pf(-exp2f(-5.f - (float)h)) * 1.4426950408889634f; }
DI bf16x8 pack8(float a0, float a1, float a2, float a3, float a4, float a5, float a6, float a7) {
  u32x4_t v = {pk2(a0, a1), pk2(a2, a3), pk2(a4, a5), pk2(a6, a7)};
  return __builtin_bit_cast(bf16x8, v);
}
DI s16x4 pack4(f32x4 v) { u32x2_t o = {pk2(v[0], v[1]), pk2(v[2], v[3])}; return __builtin_bit_cast(s16x4, o); }
DI int wave_sum(int v) {
  v += __builtin_amdgcn_update_dpp(0, v, 0xB1, 0xf, 0xf, false);
  v += __builtin_amdgcn_update_dpp(0, v, 0x4E, 0xf, 0xf, false);
  v += __builtin_amdgcn_update_dpp(0, v, 0x124, 0xf, 0xf, false);
  v += __builtin_amdgcn_update_dpp(0, v, 0x128, 0xf, 0xf, false);
  return __builtin_amdgcn_readlane(v, 0) + __builtin_amdgcn_readlane(v, 16) + __builtin_amdgcn_readlane(v, 32) + __builtin_amdgcn_readlane(v, 48);
}
DI f32x16 zero16() { f32x16 z; for (int i = 0; i < 16; ++i) z[i] = 0.f; return z; }

#define XB_TMO      128
#define XB_XCNT(j)  (256  + 64 * (j))
#define XB_XSUB(j)  (1280 + 64 * (j))
#define XB_XGEN(j)  (2304 + 64 * (j))
#define XB_TOP      3328
#define XB_TOPGEN   3392
#define XB_WG(i)    (3456 + 64 * (i))
#define XCD_BAR_WORDS (3456 + 64 * 256)
#define XB_SPIN_CAP (1u << 18)
DI unsigned xb_ld(unsigned* p) { return __hip_atomic_load(p, __ATOMIC_RELAXED, __HIP_MEMORY_SCOPE_AGENT); }
DI unsigned xb_add(unsigned* p, unsigned v) { return __hip_atomic_fetch_add(p, v, __ATOMIC_RELAXED, __HIP_MEMORY_SCOPE_AGENT); }
DI unsigned xb_xcc_id() { return (unsigned)__builtin_amdgcn_s_getreg((3 << 11) | 20) & 0xFu; }
#define XB_SPIN(cond, bar) do { unsigned _sp = 0; while (cond) { __builtin_amdgcn_s_sleep(1); \
    if ((++_sp & 255u) == 0u) { if (xb_ld(&(bar)[XB_TMO])) break; if (_sp > XB_SPIN_CAP) { atomicAdd(&(bar)[XB_TMO], 1u); break; } } } } while (0)
DI void xcd_barrier(unsigned* bar, int wave_id) {
  asm volatile("s_waitcnt vmcnt(0)" ::: "memory");
  __syncthreads();
  if (wave_id == 0) {
    int lane = lane_id(); asm volatile("" : "+v"(lane));
    const unsigned x = xb_xcc_id();
    unsigned* slot = &bar[XB_WG(blockIdx.x)];
    unsigned nloc = 0u, nx = 0u;
    if (lane < 2) nloc = xb_ld(slot + lane);
    nx = (unsigned)__builtin_amdgcn_readlane((int)nloc, 1);
    nloc = (unsigned)__builtin_amdgcn_readlane((int)nloc, 0);
    if (nloc == 0u) {
      const unsigned G = gridDim.x * gridDim.y * gridDim.z;
      unsigned sp = 0u, c = 0u;
      for (;;) {
        c = (lane < 16) ? xb_ld(&bar[XB_XCNT(lane)]) : 0u;
        const unsigned sum = (unsigned)wave_sum((int)c);
        if (sum == G) break;
        __builtin_amdgcn_s_sleep(1);
        if ((++sp & 255u) == 0u) { if (xb_ld(&bar[XB_TMO])) break; if (sp > XB_SPIN_CAP) { if (lane == 0) atomicAdd(&bar[XB_TMO], 1u); break; } }
      }
      nx = (unsigned)__popcll(__ballot(c > 0u));
      nloc = (unsigned)__builtin_amdgcn_readlane((int)c, (int)x);
      nloc = nloc > 0u ? nloc : 1u; nx = nx > 0u ? nx : 1u;
      if (lane == 0) { __hip_atomic_store(slot, nloc, __ATOMIC_RELAXED, __HIP_MEMORY_SCOPE_AGENT); __hip_atomic_store(slot + 1, nx, __ATOMIC_RELAXED, __HIP_MEMORY_SCOPE_AGENT); }
    }
    if (lane == 0) {
      __builtin_amdgcn_s_waitcnt(0);
      const unsigned old = xb_add(&bar[XB_XSUB(x)], 1u);
      const unsigned gen = old / nloc;
      if (old + 1u == (gen + 1u) * nloc) {
        __builtin_amdgcn_fence(__ATOMIC_RELEASE, "agent");
        asm volatile("s_waitcnt vmcnt(0)" ::: "memory");
        const unsigned og = xb_add(&bar[XB_TOP], 1u);
        const unsigned tg = og / nx;
        if (og + 1u == (tg + 1u) * nx) xb_add(&bar[XB_TOPGEN], 1u);
        else XB_SPIN(xb_ld(&bar[XB_TOPGEN]) == tg, bar);
        __builtin_amdgcn_fence(__ATOMIC_ACQUIRE, "agent");
        xb_add(&bar[XB_XGEN(x)], 1u);
        asm volatile("s_waitcnt vmcnt(0)" ::: "memory");
      } else {
        XB_SPIN(xb_ld(&bar[XB_XGEN(x)]) == gen, bar);
        __builtin_amdgcn_fence(__ATOMIC_ACQUIRE, "agent");
        asm volatile("s_waitcnt vmcnt(0)" ::: "memory");
      }
    }
  }
  __syncthreads();
}

DI void phase_prep(const Params& p, int tid) {
  const int gt = blockIdx.x * 512 + tid, GT = gridDim.x * 512;
  const int lane = tid & 63;
  for (int row0 = (gt >> 6) * 2; row0 < NTOK; row0 += (GT >> 6) * 2) {
    f32x4 v[2][4];
#pragma unroll
    for (int rr = 0; rr < 2; ++rr) {
      const float* sp = xrow(p, row0 + rr);
#pragma unroll
      for (int i = 0; i < 4; ++i) v[rr][i] = __builtin_nontemporal_load((const f32x4*)(sp + i * 256 + lane * 4));
    }
#pragma unroll
    for (int rr = 0; rr < 2; ++rr) {
      float ss = 0.f;
#pragma unroll
      for (int i = 0; i < 4; ++i) ss += v[rr][i][0] * v[rr][i][0] + v[rr][i][1] * v[rr][i][1] + v[rr][i][2] * v[rr][i][2] + v[rr][i][3] * v[rr][i][3];
#pragma unroll
      for (int o = 32; o >= 1; o >>= 1) ss += __shfl_xor(ss, o);
#pragma unroll
      for (int i = 0; i < 4; ++i) *(s16x4*)(p.xb() + (size_t)(row0 + rr) * 1024 + i * 256 + lane * 4) = pack4(v[rr][i]);
      if (lane == 0) p.rinv()[row0 + rr] = rsqrtf(ss * (1.f / 1024.f) + 1e-6f);
    }
  }
  for (int i = gt; i < 4096 * 128; i += GT) {
    int n = i & 4095, kg = i >> 12;
    int sc = n;
    if (n < 1024) { const int P = n & 127; sc = (n & ~127) + 64 * ((P >> 4) & 1) + 16 * (P >> 5) + (P & 15); }
    float a[8];
    const float vmask = (n < 3912) ? 1.f : 0.f; const int scc = (sc < 3912) ? sc : 3911;
#pragma unroll
    for (int j = 0; j < 8; ++j) a[j] = __builtin_nontemporal_load(p.w_in + (size_t)(kg * 8 + j) * 3912 + scc) * p.norm_g[kg * 8 + j] * vmask;
    *(bf16x8*)(p.WtIn() + (size_t)n * 1024 + kg * 8) = pack8(a[0], a[1], a[2], a[3], a[4], a[5], a[6], a[7]);
  }
  for (int i = gt; i < 1024 * 128; i += GT) {
    int n = i % 1024, kg = i / 1024;
    float a[8];
#pragma unroll
    for (int j = 0; j < 8; ++j) a[j] = __builtin_nontemporal_load(p.w_out + (size_t)(kg * 8 + j) * 1024 + n);
    *(bf16x8*)(p.WtOut() + (size_t)n * 1024 + kg * 8) = pack8(a[0], a[1], a[2], a[3], a[4], a[5], a[6], a[7]);
  }
  for (int i = gt; i < 2112 * 64; i += GT) {
    int pos = i >> 6, k = i & 63;
    float inv = powf(10000.f, -(float)k / 64.f);
    float ang = (float)pos * inv;
    p.cosR()[i] = cosf(ang); p.sinR()[i] = sinf(ang);
  }
  for (int i = gt; i < 2112 * 8; i += GT) {
    int pos = i >> 3, k = i & 7;
    float inv = powf(500000.f, -(float)k / 8.f);
    float ang = (float)pos * inv;
    p.cosA()[i] = cosf(ang); p.sinA()[i] = sinf(ang);
  }
  for (int i = gt; i < 8 * 2048 * 2 * 8; i += GT) {
    int dg = i & 7, kvh = (i >> 3) & 1, t = (i >> 4) & 2047, b = i >> 15;
    const float* s = p.cache_k + ((size_t)(b * 2048 + t) * 2 + kvh) * 64 + dg * 8;
    *(bf16x8*)(p.kaS() + ((size_t)(b * 2 + kvh) * 2112 + t) * 64 + dg * 8) = pack8(s[0], s[1], s[2], s[3], s[4], s[5], s[6], s[7]);
  }
  for (int i = gt; i < 8 * 2 * 256 * 64; i += GT) {
    int d = i & 63, tg = (i >> 6) & 255, kvh = (i >> 14) & 1, b = i >> 15;
    float a[8];
#pragma unroll
    for (int j = 0; j < 8; ++j) a[j] = __builtin_nontemporal_load(p.cache_v + ((size_t)(b * 2048 + tg * 8 + j) * 2 + kvh) * 64 + d);
    *(bf16x8*)(p.vaTS() + ((size_t)(b * 2 + kvh) * 64 + d) * 2112 + tg * 8) = pack8(a[0], a[1], a[2], a[3], a[4], a[5], a[6], a[7]);
  }
  for (int i = gt; i < 8 * 2048 * 8; i += GT) {
    int dg = i & 7, t = (i >> 3) & 2047, b = i >> 14;
    const float* s = p.cache_kidx + (size_t)(b * 2048 + t) * 64 + dg * 8;
    *(bf16x8*)(p.kiS() + ((size_t)b * 2112 + t) * 64 + dg * 8) = pack8(s[0], s[1], s[2], s[3], s[4], s[5], s[6], s[7]);
  }
}

namespace pg8 {
constexpr int BM = 256, BK = 64, HALF = 128, HTB = HALF * BK * 2, STAGE_BYTES = 8 * HTB, NXCD = 8, WGM = 8;
DI int lds_byte(int r, int c) { const int st = (r >> 4) * 2 + (c >> 5), rr = r & 15, cc = c & 31, ob = rr * 64 + cc * 2; return st * 1024 + (ob ^ (((ob >> 9) & 1) << 5)); }
DI void stage_rc(int b, int& R, int& C) { const int st = b / 1024, sb = b % 1024, swz = sb ^ (((sb >> 9) & 1) << 5); R = (st >> 1) * 16 + swz / 64; C = (st & 1) * 32 + (swz % 64) / 2; }
struct Unit { int pm, pn; };
struct Gemm { const u16* A; const u16* Bt; int M, N, K; };
struct StaticOrder {
  int nM, nN, nwg, G, c, padtile; unsigned long long permtab;
  DI void init(int M, int N, int G_, int c_) { nM = M / BM; nN = N / BM; nwg = nM * nN; G = G_; c = c_; permtab = 0xFEDCBA9876543210ull; padtile = -1; }
  DI void map(int L, Unit& u) const {
    int wgid = L; { const int q = nwg / NXCD, r = nwg % NXCD, xcd = wgid % NXCD, off = wgid / NXCD; wgid = (xcd < r ? xcd * (q + 1) : r * (q + 1) + (xcd - r) * q) + off; }
    const int nig = WGM * nN, gid = wgid / nig, fm = gid * WGM, gsz = (nM - fm) < WGM ? (nM - fm) : WGM;
    u.pm = fm + ((wgid % nig) % gsz); u.pn = (int)((permtab >> (4 * ((wgid % nig) / gsz))) & 15ull);
  }
  DI bool next(int i, Unit& u) const {
    const long Ll = (long)i * G + c; if (Ll >= nwg) return false;
    const int L = (int)Ll;
    if (padtile < 0) { map(L, u); return true; }
    const int tail = nwg % G, base = nwg - tail;
    if (L >= base) { u.pm = L - base; u.pn = padtile; return true; }
    map(L, u);
    for (int it = 0; it < 64 && u.pn == padtile && u.pm < tail; ++it) map(base + u.pm, u);
    return true;
  }
};
template <class Epi>
DI void gemm_phase(LAS unsigned char* lds, const Gemm g, const StaticOrder& S, const Epi& E, int wave_id) {
  const int wid = wave_id; int lane = lane_id(); asm volatile("" : "+v"(lane)); const int tid = wid * 64 + lane;
  const int wr = wid >> 2, wc = wid & 3, fr = lane & 15, fq = lane >> 4;
  const int K = g.K, nt = K / BK;
  unsigned voffA[2], voffB[2];
#pragma unroll
  for (int i = 0; i < 2; ++i) { int R, C; stage_rc(tid * 16 + i * 8192, R, C); voffA[i] = (unsigned)(R * K + C) * 2u; voffB[i] = voffA[i]; }
  const size_t kstep = (size_t)(BK * 2);
  const size_t hstep = (size_t)HALF * K * 2;
  const size_t tstep = 2 * hstep;
  const unsigned ldsw = (unsigned)wid * 1024u;
  const int aoff = lds_byte(wr * 64 + fr, fq * 8), boff = lds_byte(wc * 32 + fr, fq * 8);
#define PG8_SA(b, h) (((b) * 2 + (h)) * HTB)
#define PG8_SB(b, h) ((4 + (b) * 2 + (h)) * HTB)
#define PG8_STAGE(bufoff, gbase, voff) do { _Pragma("unroll") for (int _i = 0; _i < 2; ++_i) \
    __builtin_amdgcn_global_load_lds((const unsigned*)((const char*)(gbase) + (voff)[_i]), (LAS unsigned*)(lds + (bufoff) + ldsw + _i * 8192), 16, 0, 0); } while (0)
#define PG8_LDA(dst, b, h) do { _Pragma("unroll") for (int m = 0; m < 4; ++m) _Pragma("unroll") for (int k = 0; k < 2; ++k) dst[m][k] = *(const LAS bf16x8*)(lds + PG8_SA(b, h) + aoff + m * 2048 + k * 1024); } while (0)
#define PG8_LDB(dst, b, h) do { _Pragma("unroll") for (int n = 0; n < 2; ++n) _Pragma("unroll") for (int k = 0; k < 2; ++k) dst[n][k] = *(const LAS bf16x8*)(lds + PG8_SB(b, h) + boff + n * 2048 + k * 1024); } while (0)
#define PG8_MMA(ai, bj, At, Bt) do { __builtin_amdgcn_s_setprio(1); _Pragma("unroll") for (int m = 0; m < 4; ++m) _Pragma("unroll") for (int n = 0; n < 2; ++n) _Pragma("unroll") for (int k = 0; k < 2; ++k) \
    acc[ai][bj][m][n] = __builtin_amdgcn_mfma_f32_16x16x32_bf16(Bt[n][k], At[m][k], acc[ai][bj][m][n], 0, 0, 0); __builtin_amdgcn_s_setprio(0); } while (0)
#define PG8_WAIT_V(n) asm volatile("s_waitcnt vmcnt(" #n ")" ::: "memory")
#define PG8_WAIT_L(n) asm volatile("s_waitcnt lgkmcnt(" #n ")" ::: "memory")
#define PG8_BAR __builtin_amdgcn_s_barrier()
#define PG8_SCHED __builtin_amdgcn_sched_barrier(0)
  Unit cur, nxt; int ui = 0;
  if (!S.next(0, cur)) return;
  f32x4 acc[2][2][4][2];
#pragma unroll
  for (int a = 0; a < 2; ++a)
#pragma unroll
    for (int b = 0; b < 2; ++b)
#pragma unroll
      for (int m = 0; m < 4; ++m)
#pragma unroll
        for (int n = 0; n < 2; ++n) acc[a][b][m][n] = (f32x4){0.f, 0.f, 0.f, 0.f};
  bf16x8 At[4][2], B0[2][2], B1[2][2];
  const char* cA = (const char*)g.A + (size_t)cur.pm * tstep; const char* cB = (const char*)g.Bt + (size_t)cur.pn * tstep;
  PG8_STAGE(PG8_SB(0, 0), cB, voffB); PG8_STAGE(PG8_SA(0, 0), cA, voffA); PG8_STAGE(PG8_SB(0, 1), cB + hstep, voffB); PG8_STAGE(PG8_SA(0, 1), cA + hstep, voffA);
  if (wr == 1) PG8_BAR;
  PG8_WAIT_V(4); PG8_BAR;
  PG8_STAGE(PG8_SB(1, 0), cB + kstep, voffB); PG8_STAGE(PG8_SA(1, 0), cA + kstep, voffA); PG8_STAGE(PG8_SB(1, 1), cB + hstep + kstep, voffB);
  PG8_WAIT_V(6); PG8_BAR;
  for (;;) {
    const bool has_next = S.next(ui + 1, nxt);
    const char* nA = has_next ? (const char*)g.A + (size_t)nxt.pm * tstep : cA; const char* nB = has_next ? (const char*)g.Bt + (size_t)nxt.pn * tstep : cB;
#ifndef REPK
#define REPK 1
#endif
    const bool skip1 = (S.padtile >= 0) && (cur.pn == S.padtile);
    for (int rk = 0; rk < REPK; ++rk) {
    const char* nA2 = (rk == REPK - 1) ? nA : cA; const char* nB2 = (rk == REPK - 1) ? nB : cB;
    for (int t = 0; t < nt; t += 2) {
      const bool last = (t == nt - 2);
      const char* a1 = cA + (size_t)(t + 1) * kstep;
      const char* a2 = last ? nA2 : cA + (size_t)(t + 2) * kstep; const char* b2 = last ? nB2 : cB + (size_t)(t + 2) * kstep;
      const char* a3 = a2 + kstep; const char* b3 = b2 + kstep;
      PG8_LDB(B0, 0, 0); PG8_SCHED; PG8_LDA(At, 0, 0); PG8_STAGE(PG8_SA(1, 1), a1 + hstep, voffA);
      PG8_WAIT_L(8); PG8_BAR; PG8_WAIT_L(0); PG8_MMA(0, 0, At, B0); PG8_BAR; PG8_SCHED;
      PG8_LDB(B1, 0, 1); PG8_STAGE(PG8_SB(0, 0), b2, voffB);
      PG8_BAR; PG8_WAIT_L(0); if (!skip1) PG8_MMA(0, 1, At, B1); PG8_BAR;
      PG8_LDA(At, 0, 1); PG8_STAGE(PG8_SA(0, 0), a2, voffA);
      PG8_BAR; PG8_WAIT_L(0); PG8_MMA(1, 0, At, B0); PG8_BAR; PG8_SCHED;
      PG8_STAGE(PG8_SB(0, 1), b2 + hstep, voffB);
      PG8_WAIT_V(6); PG8_BAR; if (!skip1) PG8_MMA(1, 1, At, B1); PG8_BAR;
      PG8_LDB(B0, 1, 0); PG8_SCHED; PG8_LDA(At, 1, 0); PG8_STAGE(PG8_SA(0, 1), a2 + hstep, voffA);
      PG8_WAIT_L(8); PG8_BAR; PG8_WAIT_L(0); PG8_MMA(0, 0, At, B0); PG8_BAR; PG8_SCHED;
      PG8_LDB(B1, 1, 1); PG8_STAGE(PG8_SB(1, 0), b3, voffB);
      PG8_BAR; PG8_WAIT_L(0); if (!skip1) PG8_MMA(0, 1, At, B1); PG8_BAR;
      PG8_LDA(At, 1, 1); PG8_STAGE(PG8_SA(1, 0), a3, voffA);
      PG8_BAR; PG8_WAIT_L(0); PG8_MMA(1, 0, At, B0); PG8_BAR; PG8_SCHED;
      PG8_STAGE(PG8_SB(1, 1), b3 + hstep, voffB);
      PG8_WAIT_V(6); PG8_BAR; if (!skip1) PG8_MMA(1, 1, At, B1); PG8_BAR;
    }
    }
    {
      Unit eu = cur; int ewr = wr, ewc = wc; int el = lane_id();
      asm volatile("" : "+s"(eu.pm), "+s"(eu.pn), "+s"(ewr), "+s"(ewc), "+v"(el));
      int efr = el & 15, efq = el >> 4;
#ifndef REPEPI
#define REPEPI 1
#endif
      for (int re = 0; re < REPEPI; ++re) E(acc, eu, ewr, ewc, efr, efq, re);
    }
    if (!has_next) break;
#pragma unroll
    for (int a = 0; a < 2; ++a)
#pragma unroll
      for (int b = 0; b < 2; ++b)
#pragma unroll
        for (int m = 0; m < 4; ++m)
#pragma unroll
          for (int n = 0; n < 2; ++n) acc[a][b][m][n] = (f32x4){0.f, 0.f, 0.f, 0.f};
    cur = nxt; cA = nA; cB = nB; ++ui;
  }
  PG8_WAIT_V(0);
  if (wr == 0) PG8_BAR;
  PG8_BAR;
#undef PG8_SA
#undef PG8_SB
#undef PG8_STAGE
#undef PG8_LDA
#undef PG8_LDB
#undef PG8_MMA
#undef PG8_WAIT_V
#undef PG8_WAIT_L
#undef PG8_BAR
#undef PG8_SCHED
}
}


DI unsigned hx_w(int row, int c8) { return (unsigned)(row * 256 + ((c8 ^ ((row & 15) << 1)) << 3)); }
DI unsigned hx_r(int row, int c16) { return (unsigned)(row * 256 + ((c16 ^ (row & 15)) << 4)); }
#define EPI_BAR() asm volatile("s_waitcnt lgkmcnt(0)\n\ts_barrier" ::: "memory")


struct Epi1 {
  Params p; LAS unsigned char* hl0;
  DI void make_tabs(f32x4 (&tc)[4], f32x4 (&ts)[4], f32x4 c0, f32x4 s0, f32x4 c16, f32x4 s16) const {
    tc[0] = c0; ts[0] = s0;
#pragma unroll
    for (int m = 1; m < 4; ++m) { tc[m] = tc[m - 1] * c16 - ts[m - 1] * s16; ts[m] = ts[m - 1] * c16 + tc[m - 1] * s16; }
  }
  template <int AI, int BJ>
  DI void compute(f32x4 (&acc)[2][2][4][2], const f32x4 (&tc)[4], const f32x4 (&ts)[4], int blk, int wc, int fq) const {
    if (blk < 8) {
#pragma unroll
      for (int m = 0; m < 4; ++m) {
        const f32x4 v0 = acc[AI][BJ][m][0], v1 = acc[AI][BJ][m][1];
        f32x4 o0 = v0 * tc[m] - v1 * ts[m], o1 = v1 * tc[m] + v0 * ts[m];
        if (blk >= 4) { o0 *= 0.08838834764831845f; o1 *= 0.08838834764831845f; }
        acc[AI][BJ][m][0] = o0; acc[AI][BJ][m][1] = o1;
      }
    } else if ((blk >= 12 && blk < 16) || (blk >= 22 && blk < 26)) {
#pragma unroll
      for (int m = 0; m < 4; ++m)
#pragma unroll
        for (int n = 0; n < 2; ++n) {
          f32x4 v = acc[AI][BJ][m][n];
          v[0] = siluf(v[0]); v[1] = siluf(v[1]); v[2] = siluf(v[2]); v[3] = siluf(v[3]);
          acc[AI][BJ][m][n] = v;
        }
    } else if ((blk >= 8 && blk < 12) || blk == 21 || blk == 31) {
    } else {
      const bool ropew = ((wc & 1) == 0) && !(blk == 30 && wc >= 2);
      if (ropew) {
#pragma unroll
        for (int m = 0; m < 4; ++m) {
          const f32x4 v0 = acc[AI][BJ][m][0];
          f32x4 pr;
          pr[0] = __shfl_xor(v0[0], 32); pr[1] = __shfl_xor(v0[1], 32); pr[2] = __shfl_xor(v0[2], 32); pr[3] = __shfl_xor(v0[3], 32);
          acc[AI][BJ][m][0] = (fq < 2) ? v0 * tc[m] - pr * ts[m] : v0 * tc[m] + pr * ts[m];
        }
      }
      if (blk < 20) {
        const float sc = 0.125f * 1.4426950408889634f;
#pragma unroll
        for (int m = 0; m < 4; ++m) { acc[AI][BJ][m][0] *= sc; acc[AI][BJ][m][1] *= sc; }
      }
    }
  }
  template <int AI, int BJ>
  DI void emit(f32x4 (&acc)[2][2][4][2], const pg8::Unit& u, int blk, bool samp, int wr, int wc, int fr, int fq) const {
    if (blk == 31) return;
    LAS unsigned char* hl = hl0 + wr * 16384;
    asm volatile("" : "+v"(fr), "+v"(fq));
    const int lane = fr + 16 * fq;
    const int P0 = 32 * wc + 4 * fq;
    const int R0 = u.pm * 256 + AI * 128 + wr * 64;
    int b, tb;
    if (!samp) { b = R0 >> 11; tb = R0 & 2047; } else { b = (R0 - NPROMPT) >> 6; tb = 0; }
    const bool retk = blk < 8;
    const bool hasT = (blk >= 4 && blk < 12) || blk == 21;
    const bool hasN = !(blk >= 8 && blk < 12) && blk != 21;
    if (blk == 20 || blk == 21) {
      float* ob = samp ? p.out + (blk == 20 ? OUT_KS : OUT_VS) + (unsigned)(R0 - NPROMPT) * 128u : p.out + (blk == 20 ? OUT_KP : OUT_VP) + (unsigned)R0 * 128u;
#pragma unroll
      for (int m = 0; m < 4; ++m) {
        float* o2 = ob + (unsigned)(16 * m + fr) * 128u + P0;
        __builtin_nontemporal_store(acc[AI][BJ][m][0], (f32x4*)o2); __builtin_nontemporal_store(acc[AI][BJ][m][1], (f32x4*)(o2 + 16));
      }
    } else if (blk == 30) {
      float* ob = samp ? p.out + OUT_KIS + (unsigned)(R0 - NPROMPT) * 64u : p.out + OUT_KIP + (unsigned)R0 * 64u;
      float* wb = p.wi() + (unsigned)R0 * 8u;
#pragma unroll
      for (int m = 0; m < 4; ++m) {
        if (wc < 2) {
          float* o2 = ob + (unsigned)(16 * m + fr) * 64u + P0;
          __builtin_nontemporal_store(acc[AI][BJ][m][0], (f32x4*)o2); __builtin_nontemporal_store(acc[AI][BJ][m][1], (f32x4*)(o2 + 16));
        } else if (wc == 2 && fq < 2) {
          *(f32x4*)(wb + (unsigned)(16 * m + fr) * 8u + 4 * fq) = acc[AI][BJ][m][0] * 0.044194173824159216f;
        }
      }
    }
    if (hasN) {
#pragma unroll
      for (int m = 0; m < 4; ++m)
#pragma unroll
        for (int n = 0; n < 2; ++n) {
          const int c8 = retk ? (16 * n + 4 * wc + fq) : (8 * wc + 4 * n + fq);
          *(LAS s16x4*)(hl + hx_w(16 * m + fr, c8)) = pack4(acc[AI][BJ][m][n]);
        }
      u16* nb; unsigned pitch = 512u, hstr = 0u, cm = 15u;
      if (blk < 4) nb = p.qr() + (unsigned)R0 * 512u + (blk & 3) * 128;
      else if (blk < 8) nb = p.kr() + (unsigned)R0 * 512u + (blk & 3) * 128;
      else if (blk < 16) { nb = p.gate() + (unsigned)R0 * 1024u + (blk - 12) * 128; pitch = 1024u; }
      else if (blk < 20) nb = p.qa() + (unsigned)R0 * 512u + (blk - 16) * 128;
      else if (blk == 20) { nb = samp ? p.kaS() + ((unsigned)(b * 2) * 2112u + 2048u) * 64u : p.kaP() + ((unsigned)(b * 2) * 2048u + tb) * 64u; pitch = 64u; hstr = samp ? 2112u * 64u : 2048u * 64u; cm = 7u; }
      else if (blk < 26) { nb = p.gate() + (unsigned)R0 * 1024u + 512 + (blk - 22) * 128; pitch = 1024u; }
      else if (blk < 30) nb = p.qi() + (unsigned)R0 * 512u + (blk - 26) * 128;
      else { nb = samp ? p.kiS() + ((unsigned)b * 2112u + 2048u) * 64u : p.kiP() + ((unsigned)b * 2048u + tb) * 64u; pitch = 64u; cm = 7u; }
      EPI_BAR();
      const unsigned c16 = lane & 15;
      const unsigned loff = (c16 >> 3) * hstr + (c16 & cm) * 8u;
#pragma unroll
      for (int i = 0; i < 4; ++i) {
        const int row = 16 * wc + 4 * i + (lane >> 4);
        const bf16x8 v = *(const LAS bf16x8*)(hl + hx_r(row, c16));
        if (blk != 30 || c16 < 8) *(bf16x8*)(nb + (unsigned)row * pitch + loff) = v;
      }
      EPI_BAR();
    }
    if (hasT) {
      const float l2g = log2gamma(blk & 3);
#pragma unroll
      for (int m = 0; m < 4; ++m) {
        const int tok = 16 * m + fr;
        const float dec = (blk < 8) ? exp2f((float)(63 - tok) * l2g) : 1.f;
#pragma unroll
        for (int n = 0; n < 2; ++n) {
          const int fb = retk ? (64 * n + 16 * wc + 4 * fq) : (32 * wc + 16 * n + 4 * fq);
#pragma unroll
          for (int j = 0; j < 4; ++j) {
            const int f = fb + j;
            *(LAS u16*)(hl + f * 128 + ((((tok >> 3) ^ (f >> 2)) & 7) << 4) + (tok & 7) * 2) = f2bf(acc[AI][BJ][m][n][j] * dec);
          }
        }
      }
      u16* tbp; unsigned fstr;
      if (blk < 12) {
        u16* base = (blk < 8) ? p.krT() : p.vrT();
        const unsigned bh = (unsigned)(b * 4 + (blk & 3)) * 128u;
        tbp = samp ? base + 64u * 128u * 2048u + bh * 64u : base + bh * 2048u + tb;
        fstr = samp ? 64u : 2048u;
      } else {
        tbp = samp ? p.vaTS() + (unsigned)b * 128u * 2112u + 2048u : p.vaTP() + (unsigned)b * 128u * 2048u + tb;
        fstr = samp ? 2112u : 2048u;
      }
      EPI_BAR();
#pragma unroll
      for (int i = 0; i < 4; ++i) {
        const int f = 32 * wc + 8 * i + (lane >> 3), ch = lane & 7;
        const bf16x8 v = *(const LAS bf16x8*)(hl + f * 128 + (((ch ^ (f >> 2)) & 7) << 4));
        *(bf16x8*)(tbp + (unsigned)f * fstr + ch * 8) = v;
      }
      EPI_BAR();
    }
  }
  DI void operator()(f32x4 (&acc)[2][2][4][2], const pg8::Unit& u, int wr, int wc, int fr, int fq, int re) const {
    const bool samp = (u.pm * 256 >= NPROMPT);
    const int tclass = (u.pn < 4) ? 1 : ((u.pn == 8 || u.pn == 9 || u.pn == 10 || u.pn >= 13) ? 2 : 0);
    const int blk0 = u.pn * 2, blk1 = u.pn * 2 + 1;
    float rvv[2][4];
#pragma unroll
    for (int ai = 0; ai < 2; ++ai)
#pragma unroll
      for (int m = 0; m < 4; ++m) rvv[ai][m] = (1.f / REPK) * p.rinv()[u.pm * 256 + ai * 128 + wr * 64 + 16 * m + fr];
    const float* cb = (tclass == 1) ? p.cosR() : p.cosA();
    const float* sb = (tclass == 1) ? p.sinR() : p.sinA();
    const int pitch = (tclass == 1) ? 64 : 8;
    const int coff = (tclass == 1) ? (16 * wc + 4 * fq) : (4 * (fq & 1));
    const int rowg0 = u.pm * 256 + wr * 64 + fr;
    const int pos0 = samp ? 2048 + ((rowg0 - NPROMPT) & 63) : (rowg0 & 2047);
    const f32x4 c0 = *(const f32x4*)(cb + pos0 * pitch + coff), s0 = *(const f32x4*)(sb + pos0 * pitch + coff);
    const f32x4 c16 = *(const f32x4*)(cb + 16 * pitch + coff), s16 = *(const f32x4*)(sb + 16 * pitch + coff);
    f32x4 tc[4], ts[4];
#pragma unroll
    for (int ai = 0; ai < 2; ++ai)
#pragma unroll
      for (int m = 0; m < 4; ++m)
#pragma unroll
        for (int bj = 0; bj < 2; ++bj)
#pragma unroll
          for (int n = 0; n < 2; ++n) acc[ai][bj][m][n] *= rvv[ai][m];
    make_tabs(tc, ts, c0, s0, c16, s16);
    compute<0, 0>(acc, tc, ts, blk0, wc, fq);
    compute<0, 1>(acc, tc, ts, blk1, wc, fq);
    {
      const f32x4 c32 = c16 * c16 - s16 * s16, s32 = 2.f * s16 * c16;
      const f32x4 c64 = c32 * c32 - s32 * s32, s64 = 2.f * s32 * c32;
      const f32x4 c80 = c64 * c16 - s64 * s16, s80 = s64 * c16 + c64 * s16;
      const f32x4 c1 = samp ? tc[0] : tc[3] * c80 - ts[3] * s80, s1 = samp ? ts[0] : ts[3] * c80 + tc[3] * s80;
      make_tabs(tc, ts, c1, s1, c16, s16);
    }
    compute<1, 0>(acc, tc, ts, blk0, wc, fq);
    compute<1, 1>(acc, tc, ts, blk1, wc, fq);
    emit<0, 0>(acc, u, blk0, samp, wr, wc, fr, fq);
    emit<0, 1>(acc, u, blk1, samp, wr, wc, fr, fq);
    emit<1, 0>(acc, u, blk0, samp, wr, wc, fr, fq);
    emit<1, 1>(acc, u, blk1, samp, wr, wc, fr, fq);
  }
};

struct Epi2 {
  Params p; unsigned char* hl;
  DI void operator()(f32x4 (&acc)[2][2][4][2], const pg8::Unit& u, int wr, int wc, int fr, int fq, int re) const {
    u16* z = p.gate();
    const int lane = fr + 16 * fq;
#pragma unroll
    for (int ai = 0; ai < 2; ++ai)
#pragma unroll
      for (int bj = 0; bj < 2; ++bj) {
#pragma unroll
        for (int m = 0; m < 4; ++m)
#pragma unroll
          for (int n = 0; n < 2; ++n)
            *(s16x4*)(hl + hx_w(16 * m + fr, 8 * wc + 4 * n + fq)) = pack4(acc[ai][bj][m][n] * (1.f / REPK));
        EPI_BAR();
        const unsigned R0 = u.pm * 256 + ai * 128 + wr * 64;
        const unsigned cb = u.pn * 256 + bj * 128;
#pragma unroll
        for (int i = 0; i < 4; ++i) {
          const int row = 16 * wc + 4 * i + (lane >> 4), c16 = lane & 15;
          const bf16x8 v = *(const bf16x8*)(hl + hx_r(row, c16));
          *(bf16x8*)(z + (R0 + row) * 1024u + cb + c16 * 8) = v;
        }
        EPI_BAR();
      }
  }
};

DI void ret_kv_item(const Params& p, int item, int tid) {
  const int lane = tid & 63, w = tid >> 6, r = lane & 31, hh = lane >> 5;
  const u16 *kT, *vT; int T, c;
  if (item < 2048) { const int bh = item >> 5; c = item & 31; T = 2048; kT = p.krT() + (size_t)bh * 128 * 2048; vT = p.vrT() + (size_t)bh * 128 * 2048; }
  else { const int bh = item - 2048; c = 0; T = 64; kT = p.krT() + (size_t)64 * 128 * 2048 + (size_t)bh * 128 * 64; vT = p.vrT() + (size_t)64 * 128 * 2048 + (size_t)bh * 128 * 64; }
  const int e0 = (w & 1) * 64, d0 = (w >> 1) * 64;
  f32x16 acc[2][2];
  acc[0][0] = zero16(); acc[0][1] = zero16(); acc[1][0] = zero16(); acc[1][1] = zero16();
#pragma unroll
  for (int ks = 0; ks < 4; ++ks) {
    bf16x8 a0 = ldg8(vT + (size_t)(e0 + r) * T + c * 64 + ks * 16 + hh * 8);
    bf16x8 a1 = ldg8(vT + (size_t)(e0 + 32 + r) * T + c * 64 + ks * 16 + hh * 8);
    bf16x8 b0 = ldg8(kT + (size_t)(d0 + r) * T + c * 64 + ks * 16 + hh * 8);
    bf16x8 b1 = ldg8(kT + (size_t)(d0 + 32 + r) * T + c * 64 + ks * 16 + hh * 8);
    acc[0][0] = MFMA32(a0, b0, acc[0][0]);
    acc[0][1] = MFMA32(a0, b1, acc[0][1]);
    acc[1][0] = MFMA32(a1, b0, acc[1][0]);
    acc[1][1] = MFMA32(a1, b1, acc[1][1]);
  }
  u16* o = (u16*)p.kvT() + (size_t)item * 16384;
#pragma unroll
  for (int a = 0; a < 2; ++a)
#pragma unroll
    for (int b = 0; b < 2; ++b)
#pragma unroll
      for (int i = 0; i < 16; ++i)
        o[(e0 + a * 32 + crow(i, hh)) * 128 + d0 + b * 32 + r] = f2bf(acc[a][b][i]);
}

template <int NS>
DI void select_query(const u16* krow, int nj, int lane, u64* dst) {
  unsigned key[NS];
#pragma unroll
  for (int j = 0; j < NS; ++j) { const unsigned k = krow[j * 64 + lane]; key[j] = (j < nj) ? k : 0u; }
  constexpr int NP = (NS + 1) / 2;
  unsigned pk[NP];
#pragma unroll
  for (int i = 0; i < NP; ++i) pk[i] = key[2 * i] | ((2 * i + 1 < NS ? key[2 * i + 1] : 0u) << 16);
  unsigned prefix = 0;
  int cntp = 0;
  const unsigned ones = 0x00010001u;
  for (int bit = 15; bit >= 0; --bit) {
    const unsigned cand = prefix | (1u << bit);
    const unsigned c1 = cand - 1u;
    const unsigned cv = c1 | (c1 << 16);
    unsigned acc0 = 0, acc1 = 0;
#pragma unroll
    for (int i = 0; i < NP; ++i) {
      unsigned d, m;
      asm("v_pk_sub_u16 %0, %1, %2 clamp" : "=v"(d) : "v"(pk[i]), "v"(cv));
      asm("v_pk_min_u16 %0, %1, %2" : "=v"(m) : "v"(d), "v"(ones));
      if (i & 1) acc1 += m; else acc0 += m;
    }
    const unsigned a = acc0 + acc1;
    const int cnt = wave_sum((int)((a & 0xffffu) + (a >> 16)));
    if (cnt >= 256) { prefix = cand; cntp = cnt; }
    if (cnt == 256) break;
  }
  int wlo = 0, whi = 0;
  if (cntp == 256) {
#pragma unroll
    for (int j = 0; j < NS; ++j) {
      const u64 sm = __ballot(key[j] >= prefix);
      if (lane == j) { wlo = (int)(unsigned)sm; whi = (int)(unsigned)(sm >> 32); }
    }
  } else {
    int cgt = 0;
#pragma unroll
    for (int j = 0; j < NS; ++j) cgt += (key[j] > prefix) ? 1 : 0;
    cgt = wave_sum(cgt);
    const int rneed = 256 - cgt;
    int running = 0;
    const u64 lt = (1ull << lane) - 1ull;
#pragma unroll
    for (int j = 0; j < NS; ++j) {
      const bool eq = key[j] == prefix;
      const u64 em = __ballot(eq);
      const int rank = running + __popcll(em & lt);
      const bool sel = (key[j] > prefix) || (eq && rank < rneed);
      const u64 sm = __ballot(sel);
      if (lane == j) { wlo = (int)(unsigned)sm; whi = (int)(unsigned)(sm >> 32); }
      running += __popcll(em);
    }
  }
  if (lane < nj) __builtin_nontemporal_store(((u64)(unsigned)whi << 32) | (u64)(unsigned)wlo, dst + lane);
}

DI void idx_item(const Params& p, unsigned char* lds, int tid, bool samp, int b, int grp) {
  const int lane = tid & 63, w = tid >> 6;
  const int t0 = grp * 16;
  int L, g0; const u16* ki;
  if (!samp) { const int c = t0 >> 6; L = (c + 1) * 64; g0 = b * 2048 + t0; ki = p.kiP() + (size_t)b * 2048 * 64; }
  else { L = 2112; g0 = NPROMPT + b * 64 + t0; ki = p.kiS() + (size_t)b * 2112 * 64; }
  const int nj = L >> 6;
  if (L <= 256) {
    for (int qq = 0; qq < 4; ++qq) {
      const int q = w * 4 + qq;
      if (lane < nj) p.maskbits()[(size_t)(g0 + q) * 33 + lane] = ~0ull;
    }
    return;
  }
  u16* keys = (u16*)lds;
#ifndef REPMF
#define REPMF 1
#endif
#ifndef REPSEL
#define REPSEL 1
#endif
#ifndef REPKV
#define REPKV 1
#endif
  for (int rmf = 0; rmf < REPMF; ++rmf) {
    const int qn = lane & 15, quad = lane >> 4;
    bf16x8 qf[8][2];
    float wv[8];
#pragma unroll
    for (int h = 0; h < 8; ++h) {
      qf[h][0] = ldg8(p.qi() + (size_t)(g0 + qn) * 512 + h * 64 + quad * 8);
      qf[h][1] = ldg8(p.qi() + (size_t)(g0 + qn) * 512 + h * 64 + 32 + quad * 8);
      wv[h] = p.wi()[(size_t)(g0 + qn) * 8 + h];
    }
    bf16x8 A0[4], A1[4], N0[4], N1[4];
#pragma unroll
    for (int i = 0; i < 4; ++i) {
      const int kt = w + 4 * i;
      A0[i] = ldg8(ki + (size_t)(kt * 16 + qn) * 64 + quad * 8);
      A1[i] = ldg8(ki + (size_t)(kt * 16 + qn) * 64 + 32 + quad * 8);
    }
    for (int base = 0; base < nj; base += 4) {
#pragma unroll
      for (int i = 0; i < 4; ++i) {
        const int t = min(base + 4 + i, nj - 1);
        const int kt = w + 4 * t;
        N0[i] = ldg8(ki + (size_t)(kt * 16 + qn) * 64 + quad * 8);
        N1[i] = ldg8(ki + (size_t)(kt * 16 + qn) * 64 + 32 + quad * 8);
      }
#pragma unroll
      for (int i = 0; i < 4; ++i) {
        const int t = base + i;
        if (t < nj) {
          const int kt = w + 4 * t;
          float idx[4] = {0.f, 0.f, 0.f, 0.f};
#pragma unroll
          for (int h = 0; h < 8; ++h) {
            f32x4 acc = {0.f, 0.f, 0.f, 0.f};
            acc = MFMA16(A0[i], qf[h][0], acc);
            acc = MFMA16(A1[i], qf[h][1], acc);
#pragma unroll
            for (int e = 0; e < 4; ++e) idx[e] += fmaxf(acc[e], 0.f) * wv[h];
          }
          s16x4 kv;
#pragma unroll
          for (int e = 0; e < 4; ++e) {
            _Float16 hv = (_Float16)idx[e];
            u16 bits = __builtin_bit_cast(u16, hv);
            kv[e] = (short)((bits & 0x8000) ? (u16)~bits : (u16)(bits | 0x8000));
          }
          *(s16x4*)(keys + qn * KPITCH + kt * 16 + quad * 4) = kv;
        }
      }
#pragma unroll
      for (int i = 0; i < 4; ++i) { A0[i] = N0[i]; A1[i] = N1[i]; }
    }
  }
  __syncthreads();
  for (int qq = 0; qq < 4 * REPSEL; ++qq) {
    const int q = w * 4 + (qq & 3);
    const u16* krow = keys + q * KPITCH;
    u64* dst = p.maskbits() + (size_t)(g0 + q) * 33;
    if (nj <= 8) select_query<8>(krow, nj, lane, dst);
    else if (nj <= 16) select_query<16>(krow, nj, lane, dst);
    else if (nj <= 24) select_query<24>(krow, nj, lane, dst);
    else select_query<33>(krow, nj, lane, dst);
  }
  __syncthreads();
}

DI void scan_item(const Params& p, int item, int tid) {
  if (item < 1024) {
    const int bh = item >> 4, slab = item & 15;
    const int idx = slab * 1024 + tid * 4;
    const int h = bh & 3;
    const float cd = exp2f(64.f * log2gamma(h));
    f32x4 s = {0.f, 0.f, 0.f, 0.f};
    s16x4 kraw[2][8];
#pragma unroll
    for (int i = 0; i < 8; ++i) kraw[0][i] = __builtin_nontemporal_load((const s16x4*)((const u16*)p.kvT() + (size_t)(bh * 32 + i) * 16384 + idx));
#pragma unroll
    for (int b8 = 0; b8 < 4; ++b8) {
      if (b8 < 3) {
#pragma unroll
        for (int i = 0; i < 8; ++i) kraw[(b8 + 1) & 1][i] = __builtin_nontemporal_load((const s16x4*)((const u16*)p.kvT() + (size_t)(bh * 32 + (b8 + 1) * 8 + i) * 16384 + idx));
      }
#pragma unroll
      for (int i = 0; i < 8; ++i) {
        __builtin_nontemporal_store(pack4(s), (s16x4*)(p.sprevT() + (size_t)(bh * 32 + b8 * 8 + i) * 16384 + idx));
        f32x4 kv;
#pragma unroll
        for (int j = 0; j < 4; ++j) kv[j] = __uint_as_float(((unsigned)(u16)kraw[b8 & 1][i][j]) << 16);
        s = s * cd + kv;
      }
    }
    const int e = idx >> 7, d = idx & 127;
    float* o = p.out + OUT_STP + (size_t)bh * 16384;
#pragma unroll
    for (int j = 0; j < 4; ++j) o[(d + j) * 128 + e] = s[j];
  } else {
    const int it = item - 1024;
    const int bh = it >> 4, slab = it & 15;
    const int idx = slab * 1024 + tid * 4;
    const int h = bh & 3;
    const float cd = exp2f(64.f * log2gamma(h));
    const int e = idx >> 7, d = idx & 127;
    const float* s0 = p.state_ret + (size_t)bh * 16384;
    f32x4 s;
#pragma unroll
    for (int j = 0; j < 4; ++j) s[j] = s0[(d + j) * 128 + e];
    const size_t base = (size_t)(2048 + bh) * 16384 + idx;
    s16x4 o = pack4(s);
    *(s16x4*)(p.sprevT() + base) = o;
    const s16x4 kk = *(const s16x4*)((const u16*)p.kvT() + base);
    f32x4 kv;
#pragma unroll
    for (int j = 0; j < 4; ++j) kv[j] = __uint_as_float(((unsigned)(u16)kk[j]) << 16);
    s = s * cd + kv;
    float* oo = p.out + OUT_STS + (size_t)bh * 16384;
#pragma unroll
    for (int j = 0; j < 4; ++j) oo[(d + j) * 128 + e] = s[j];
  }
}

DI void attn_item(const Params& p, unsigned char* lds, int tid, bool samp, int b, int c, int kvh, int qh, unsigned char* lds_blk, int tid512) {
  const int lane = tid & 63, w = tid >> 6, r = lane & 31, hh = lane >> 5;
  const int T = samp ? 2112 : 2048;
  const int nkt = samp ? 33 : c + 1;
  const int g0 = (samp ? NPROMPT + b * 64 : b * 2048 + c * 64) + qh * 32;
  const u16* K = samp ? p.kaS() + (size_t)(b * 2 + kvh) * 2112 * 64 : p.kaP() + (size_t)(b * 2 + kvh) * 2048 * 64;
  const u16* VT = samp ? p.vaTS() + (size_t)(b * 2 + kvh) * 64 * 2112 : p.vaTP() + (size_t)(b * 2 + kvh) * 64 * 2048;
  const int head = kvh * 4 + w;
  u16* KV0 = (u16*)(lds_blk + 2 * HALF_LDS - 4 * 9216);
  u64* mL = (u64*)lds;
  {
    u64 mv[5];
#pragma unroll
    for (int i = 0; i < 5; ++i) { const int ix = tid + 256 * i; mv[i] = __builtin_nontemporal_load(p.maskbits() + (size_t)g0 * 33 + (ix < 32 * 33 ? ix : 32 * 33 - 1)); }
#pragma unroll
    for (int i = 0; i < 5; ++i) { const int ix = tid + 256 * i; if (ix < 32 * 33) mL[ix] = mv[i]; }
  }
  bf16x8 qf[4];
#pragma unroll
  for (int ks = 0; ks < 4; ++ks) qf[ks] = ldg8(p.qa() + (size_t)(g0 + r) * 512 + head * 64 + ks * 16 + hh * 8);
  const u16* grow = p.gate() + (size_t)(g0 + r) * 1024 + 512 + head * 64;
  s16x4 gvv[2][4];
#pragma unroll
  for (int dt = 0; dt < 2; ++dt)
#pragma unroll
    for (int q4 = 0; q4 < 4; ++q4) gvv[dt][q4] = *(const s16x4*)(grow + dt * 32 + 8 * q4 + 4 * hh);
  f32x16 O[2];
  O[0] = zero16(); O[1] = zero16();
  float mrun = -1e30f, lrun = 0.f;
  const int lrow = tid512 >> 3, lch = tid512 & 7;
  const int loff = lrow * 72 + lch * 8;
  bf16x8 pk0, pv0, nk0, nv0;
  {
    const bf16x8 k0 = ldg8(K + (size_t)(lrow)*64 + lch * 8), v0 = ldg8(VT + (size_t)(lrow)*T + lch * 8);
    const int t1 = nkt > 1 ? 1 : 0, t2 = nkt > 2 ? 2 : (nkt - 1);
    pk0 = ldg8(K + (size_t)(t1 * 64 + lrow) * 64 + lch * 8); pv0 = ldg8(VT + (size_t)(lrow)*T + t1 * 64 + lch * 8);
    nk0 = ldg8(K + (size_t)(t2 * 64 + lrow) * 64 + lch * 8); nv0 = ldg8(VT + (size_t)(lrow)*T + t2 * 64 + lch * 8);
    *(bf16x8*)(KV0 + loff) = k0;
    *(bf16x8*)(KV0 + 64 * 72 + loff) = v0;
  }
  __syncthreads();
  for (int kt = 0; kt < nkt; ++kt) {
    if (kt + 1 < nkt) {
      u16* nb = KV0 + ((kt + 1) & 1) * (2 * 64 * 72);
      *(bf16x8*)(nb + loff) = pk0;
      *(bf16x8*)(nb + 64 * 72 + loff) = pv0;
    }
    pk0 = nk0; pv0 = nv0;
    {
      const int t3 = (kt + 3 < nkt) ? kt + 3 : nkt - 1;
      nk0 = ldg8(K + (size_t)(t3 * 64 + lrow) * 64 + lch * 8);
      nv0 = ldg8(VT + (size_t)(lrow)*T + t3 * 64 + lch * 8);
    }
    const u16* Ks = KV0 + (kt & 1) * (2 * 64 * 72);
    const u16* Vs = Ks + 64 * 72;
    f32x16 S[2];
#pragma unroll
    for (int st = 0; st < 2; ++st) {
      S[st] = zero16();
#pragma unroll
      for (int ks = 0; ks < 4; ++ks) {
        bf16x8 kf = *(const bf16x8*)(Ks + (st * 32 + r) * 72 + ks * 16 + hh * 8);
        S[st] = MFMA32(kf, qf[ks], S[st]);
      }
    }
    const u64 W = mL[r * 33 + kt];
    const int wl = (int)(((unsigned)W) >> (4 * hh)), wh = (int)(((unsigned)(W >> 32)) >> (4 * hh));
    float mx = fmaxf(S[0][0], S[1][0]);
#pragma unroll
    for (int i = 1; i < 16; ++i) mx = fmaxf(mx, fmaxf(S[0][i], S[1][i]));
    mx = fmaxf(mx, __shfl_xor(mx, 32));
    const float mn = fmaxf(mrun, mx);
    const float alpha = __builtin_amdgcn_exp2f(mrun - mn);
    const bool resc = __any(mn != mrun);
    mrun = mn;
    float ls = 0.f;
#pragma unroll
    for (int st = 0; st < 2; ++st)
#pragma unroll
      for (int i = 0; i < 16; ++i) {
        const int keep = __builtin_amdgcn_sbfe(st ? wh : wl, (i & 3) + 8 * (i >> 2), 1);
        const float pvv = __int_as_float(__float_as_int(__builtin_amdgcn_exp2f(S[st][i] - mn)) & keep);
        S[st][i] = pvv;
        ls += pvv;
      }
    lrun = lrun * alpha + ls;
    if (resc) {
#pragma unroll
      for (int dt = 0; dt < 2; ++dt)
#pragma unroll
        for (int i = 0; i < 16; ++i) O[dt][i] *= alpha;
    }
#pragma unroll
    for (int st = 0; st < 2; ++st)
#pragma unroll
      for (int s2 = 0; s2 < 2; ++s2) {
        bf16x8 pf = pack8(S[st][8 * s2 + 0], S[st][8 * s2 + 1], S[st][8 * s2 + 2], S[st][8 * s2 + 3],
                          S[st][8 * s2 + 4], S[st][8 * s2 + 5], S[st][8 * s2 + 6], S[st][8 * s2 + 7]);
#pragma unroll
        for (int dt = 0; dt < 2; ++dt) {
          s16x4 lo = *(const s16x4*)(Vs + (dt * 32 + r) * 72 + st * 32 + 16 * s2 + 4 * hh);
          s16x4 hi = *(const s16x4*)(Vs + (dt * 32 + r) * 72 + st * 32 + 16 * s2 + 8 + 4 * hh);
          bf16x8 vf = __builtin_shufflevector(lo, hi, 0, 1, 2, 3, 4, 5, 6, 7);
          O[dt] = MFMA32(vf, pf, O[dt]);
        }
      }
    __syncthreads();
  }
  {
    float lt = lrun + __shfl_xor(lrun, 32);
    const float inv = 1.f / fmaxf(lt, 1e-30f);
    u16* mrow = p.mix() + (size_t)(g0 + r) * 1024 + 512 + head * 64;
#pragma unroll
    for (int dt = 0; dt < 2; ++dt)
#pragma unroll
      for (int q4 = 0; q4 < 4; ++q4) {
        const int d = dt * 32 + 8 * q4 + 4 * hh;
        f32x4 of;
#pragma unroll
        for (int j = 0; j < 4; ++j) {
          const float gf = __uint_as_float(((unsigned)(u16)gvv[dt][q4][j]) << 16);
          of[j] = O[dt][q4 * 4 + j] * inv * gf;
        }
        *(s16x4*)(mrow + d) = pack4(of);
      }
  }
  __syncthreads();
}

DI void ret_out_item(const Params& p, unsigned char* lds, int item, int tid) {
  const int lane = tid & 63, w = tid >> 6, r = lane & 31, hh = lane >> 5;
  int bh, c, T, g0; const u16* vT;
  if (item < 2048) { bh = item >> 5; c = item & 31; T = 2048; g0 = (bh >> 2) * 2048 + c * 64; vT = p.vrT() + (size_t)bh * 128 * 2048; }
  else { bh = item - 2048; c = 0; T = 64; g0 = NPROMPT + (bh >> 2) * 64; vT = p.vrT() + (size_t)64 * 128 * 2048 + (size_t)bh * 128 * 64; }
  const int h = bh & 3;
  const float l2g = log2gamma(h);
  const int nt = w & 1, eh = w >> 1;
  const int n = nt * 32 + r;
  const u16* sp = p.sprevT() + (size_t)item * 16384;
  bf16x8 qf[8], kf[8], sf[8];
  s16x4 vlo[2][2][2], vhi[2][2][2];
#pragma unroll
  for (int ks = 0; ks < 8; ++ks) qf[ks] = ldg8(p.qr() + (size_t)(g0 + n) * 512 + h * 128 + ks * 16 + hh * 8);
#pragma unroll
  for (int ks = 0; ks < 8; ++ks) kf[ks] = ldg8(p.kr() + (size_t)(g0 + r) * 512 + h * 128 + ks * 16 + hh * 8);
#pragma unroll
  for (int et = 0; et < 2; ++et)
#pragma unroll
    for (int mt = 0; mt < 2; ++mt)
#pragma unroll
      for (int s2 = 0; s2 < 2; ++s2) {
        const u16* vp = vT + (size_t)((2 * eh + et) * 32 + r) * T + c * 64 + mt * 32 + 16 * s2 + 4 * hh;
        vlo[et][mt][s2] = ldg4(vp); vhi[et][mt][s2] = ldg4(vp + 8);
      }
  __builtin_amdgcn_sched_barrier(0);
  bf16x8 pf[2][2];
#pragma unroll
  for (int mt = 0; mt < 2; ++mt) {
    f32x16 S = zero16();
#pragma unroll
    for (int ks = 0; ks < 8; ++ks) S = MFMA32(kf[ks], qf[ks], S);
    if (mt == 0) {
#pragma unroll
      for (int ks = 0; ks < 8; ++ks) kf[ks] = ldg8(p.kr() + (size_t)(g0 + 32 + r) * 512 + h * 128 + ks * 16 + hh * 8);
#pragma unroll
      for (int ks = 0; ks < 8; ++ks) sf[ks] = ldg8(sp + (size_t)((2 * eh) * 32 + r) * 128 + ks * 16 + hh * 8);
      __builtin_amdgcn_sched_barrier(0);
    }
#pragma unroll
    for (int i = 0; i < 16; ++i) {
      const int m = mt * 32 + crow(i, hh);
      const int dd = n > m ? n - m : m - n;
      S[i] *= exp2f((float)dd * l2g);
    }
    pf[mt][0] = pack8(S[0], S[1], S[2], S[3], S[4], S[5], S[6], S[7]);
    pf[mt][1] = pack8(S[8], S[9], S[10], S[11], S[12], S[13], S[14], S[15]);
  }
  const float fs = exp2f((float)(n + 1) * l2g);
  f32x16 tot[2];
  float ss = 0.f;
#pragma unroll
  for (int et = 0; et < 2; ++et) {
    f32x16 Oi = zero16(), X = zero16();
#pragma unroll
    for (int ks = 0; ks < 8; ++ks) X = MFMA32(sf[ks], qf[ks], X);
    if (et == 0) {
#pragma unroll
      for (int ks = 0; ks < 8; ++ks) sf[ks] = ldg8(sp + (size_t)((2 * eh + 1) * 32 + r) * 128 + ks * 16 + hh * 8);
      __builtin_amdgcn_sched_barrier(0);
    }
#pragma unroll
    for (int mt = 0; mt < 2; ++mt)
#pragma unroll
      for (int s2 = 0; s2 < 2; ++s2) {
        bf16x8 vf = __builtin_shufflevector(vlo[et][mt][s2], vhi[et][mt][s2], 0, 1, 2, 3, 4, 5, 6, 7);
        Oi = MFMA32(vf, pf[mt][s2], Oi);
      }
#pragma unroll
    for (int i = 0; i < 16; ++i) { const float t = Oi[i] + X[i] * fs; tot[et][i] = t; ss += t * t; }
  }
  ss += __shfl_xor(ss, 32);
  float* red = (float*)lds;
  __syncthreads();
  if (hh == 0) red[w * 32 + r] = ss;
  __syncthreads();
  const float tsum = red[w * 32 + r] + red[(w ^ 2) * 32 + r];
  const float rinv = rsqrtf(tsum * (1.f / 128.f) + 1e-6f);
  const u16* grow = p.gate() + (size_t)(g0 + n) * 1024 + h * 128;
  u16* mrow = p.mix() + (size_t)(g0 + n) * 1024 + h * 128;
  s16x4 gvv[2][4];
  f32x4 ggv[2][4];
#pragma unroll
  for (int et = 0; et < 2; ++et)
#pragma unroll
    for (int q4 = 0; q4 < 4; ++q4) {
      const int e = (2 * eh + et) * 32 + 8 * q4 + 4 * hh;
      gvv[et][q4] = *(const s16x4*)(grow + e);
      ggv[et][q4] = *(const f32x4*)(p.ret_gn_g + h * 128 + e);
    }
#pragma unroll
  for (int et = 0; et < 2; ++et)
#pragma unroll
    for (int q4 = 0; q4 < 4; ++q4) {
      const int e = (2 * eh + et) * 32 + 8 * q4 + 4 * hh;
      f32x4 of;
#pragma unroll
      for (int j = 0; j < 4; ++j) {
        const float gf = __uint_as_float(((unsigned)(u16)gvv[et][q4][j]) << 16);
        of[j] = tot[et][q4 * 4 + j] * rinv * ggv[et][q4][j] * gf;
      }
      *(s16x4*)(mrow + e) = pack4(of);
    }
}

DI void phase_final(const Params& p, int tid) {
  const int gt = blockIdx.x * 512 + tid, GT = gridDim.x * 512;
  const int lane = tid & 63;
  for (int row0 = (gt >> 6) * 2; row0 < NTOK; row0 += (GT >> 6) * 2) {
    f32x4 v[2][4];
    s16x4 zz[2][4];
#pragma unroll
    for (int rr = 0; rr < 2; ++rr) {
      const float* xr = xrow(p, row0 + rr);
      const u16* zr = p.gate() + (size_t)(row0 + rr) * 1024;
#pragma unroll
      for (int i = 0; i < 4; ++i) { v[rr][i] = __builtin_nontemporal_load((const f32x4*)(xr + i * 256 + lane * 4)); zz[rr][i] = __builtin_nontemporal_load((const s16x4*)(zr + i * 256 + lane * 4)); }
    }
    f32x4 g[4];
#pragma unroll
    for (int i = 0; i < 4; ++i) g[i] = *(const f32x4*)(p.final_g + i * 256 + lane * 4);
#pragma unroll
    for (int rr = 0; rr < 2; ++rr) {
      float ss = 0.f;
#pragma unroll
      for (int i = 0; i < 4; ++i) {
#pragma unroll
        for (int j = 0; j < 4; ++j) v[rr][i][j] += __uint_as_float(((unsigned)(u16)zz[rr][i][j]) << 16);
        ss += v[rr][i][0] * v[rr][i][0] + v[rr][i][1] * v[rr][i][1] + v[rr][i][2] * v[rr][i][2] + v[rr][i][3] * v[rr][i][3];
      }
#pragma unroll
      for (int o = 32; o >= 1; o >>= 1) ss += __shfl_xor(ss, o);
      const float rv = rsqrtf(ss * (1.f / 1024.f) + 1e-6f);
      float* y = p.out + OUT_Y + (size_t)(row0 + rr) * 1024;
#pragma unroll
      for (int i = 0; i < 4; ++i) __builtin_nontemporal_store(v[rr][i] * rv * g[i], (f32x4*)(y + i * 256 + lane * 4));
    }
  }
}

static __device__ const u16 idx_tab[1280] = {32, 16, 80, 65535, 65535, 96, 144, 208, 65535, 65535, 160, 272, 336, 65535, 65535, 224, 400, 464, 65535, 65535, 288, 528, 592, 65535, 65535, 352, 656, 720, 65535, 65535, 416, 784, 848, 65535, 65535, 480, 912, 976, 65535, 65535, 544, 1040, 1104, 65535, 65535, 608, 1168, 1232, 65535, 65535, 672, 1296, 1360, 65535, 65535, 736, 1424, 1488, 65535, 65535, 800, 1552, 1616, 65535, 65535, 864, 1680, 1744, 65535, 65535, 928, 1808, 1872, 65535, 65535, 992, 1936, 2000, 65535, 65535, 31, 17, 15, 3, 67, 95, 81, 79, 131, 195, 159, 145, 143, 259, 323, 223, 209, 207, 387, 451, 287, 273, 271, 515, 579, 351, 337, 335, 643, 707, 415, 401, 399, 771, 835, 479, 465, 463, 899, 963, 543, 529, 527, 1027, 1091, 607, 593, 591, 1155, 1219, 671, 657, 655, 1283, 1347, 735, 721, 719, 1411, 1475, 799, 785, 783, 1539, 1603, 863, 849, 847, 1667, 1731, 927, 913, 911, 1795, 1859, 991, 977, 975, 1923, 1987, 1055, 1041, 1039, 65535, 65535, 1119, 1105, 1103, 65535, 65535, 1183, 1169, 1167, 65535, 65535, 1247, 1233, 1231, 65535, 65535, 1311, 1297, 1295, 65535, 65535, 1375, 1361, 1359, 65535, 65535, 1439, 1425, 1423, 65535, 65535, 1503, 1489, 1487, 65535, 65535, 1567, 1553, 1551, 65535, 65535, 1631, 1617, 1615, 65535, 65535, 1695, 1681, 1679, 65535, 65535, 1759, 1745, 1743, 65535, 65535, 1823, 1809, 1807, 65535, 65535, 1887, 1873, 1871, 65535, 65535, 1951, 1937, 1935, 65535, 65535, 2015, 2001, 1999, 65535, 65535, 30, 18, 14, 1, 65, 94, 82, 78, 129, 193, 158, 146, 142, 257, 321, 222, 210, 206, 385, 449, 286, 274, 270, 513, 577, 350, 338, 334, 641, 705, 414, 402, 398, 769, 833, 478, 466, 462, 897, 961, 542, 530, 526, 1025, 1089, 606, 594, 590, 1153, 1217, 670, 658, 654, 1281, 1345, 734, 722, 718, 1409, 1473, 798, 786, 782, 1537, 1601, 862, 850, 846, 1665, 1729, 926, 914, 910, 1793, 1857, 990, 978, 974, 1921, 1985, 1054, 1042, 1038, 2, 66, 1118, 1106, 1102, 130, 194, 1182, 1170, 1166, 258, 322, 1246, 1234, 1230, 386, 450, 1310, 1298, 1294, 514, 578, 1374, 1362, 1358, 642, 706, 1438, 1426, 1422, 770, 834, 1502, 1490, 1486, 898, 962, 1566, 1554, 1550, 1026, 1090, 1630, 1618, 1614, 1154, 1218, 1694, 1682, 1678, 1282, 1346, 1758, 1746, 1742, 1410, 1474, 1822, 1810, 1806, 1538, 1602, 1886, 1874, 1870, 1666, 1730, 1950, 1938, 1934, 1794, 1858, 2014, 2002, 1998, 1922, 1986, 29, 19, 13, 4, 65535, 93, 83, 77, 68, 65535, 157, 147, 141, 132, 65535, 221, 211, 205, 196, 65535, 285, 275, 269, 260, 65535, 349, 339, 333, 324, 65535, 413, 403, 397, 388, 65535, 477, 467, 461, 452, 65535, 541, 531, 525, 516, 65535, 605, 595, 589, 580, 65535, 669, 659, 653, 644, 65535, 733, 723, 717, 708, 65535, 797, 787, 781, 772, 65535, 861, 851, 845, 836, 65535, 925, 915, 909, 900, 65535, 989, 979, 973, 964, 65535, 1053, 1043, 1037, 0, 64, 1117, 1107, 1101, 128, 192, 1181, 1171, 1165, 256, 320, 1245, 1235, 1229, 384, 448, 1309, 1299, 1293, 512, 576, 1373, 1363, 1357, 640, 704, 1437, 1427, 1421, 768, 832, 1501, 1491, 1485, 896, 960, 1565, 1555, 1549, 1024, 1088, 1629, 1619, 1613, 1152, 1216, 1693, 1683, 1677, 1280, 1344, 1757, 1747, 1741, 1408, 1472, 1821, 1811, 1805, 1536, 1600, 1885, 1875, 1869, 1664, 1728, 1949, 1939, 1933, 1792, 1856, 2013, 2003, 1997, 1920, 1984, 28, 20, 12, 5, 65535, 92, 84, 76, 69, 65535, 156, 148, 140, 133, 65535, 220, 212, 204, 197, 65535, 284, 276, 268, 261, 65535, 348, 340, 332, 325, 65535, 412, 404, 396, 389, 65535, 476, 468, 460, 453, 65535, 540, 532, 524, 517, 65535, 604, 596, 588, 581, 65535, 668, 660, 652, 645, 65535, 732, 724, 716, 709, 65535, 796, 788, 780, 773, 65535, 860, 852, 844, 837, 65535, 924, 916, 908, 901, 65535, 988, 980, 972, 965, 65535, 1052, 1044, 1036, 1028, 65535, 1116, 1108, 1100, 1092, 65535, 1180, 1172, 1164, 1156, 65535, 1244, 1236, 1228, 1220, 65535, 1308, 1300, 1292, 1284, 65535, 1372, 1364, 1356, 1348, 65535, 1436, 1428, 1420, 1412, 65535, 1500, 1492, 1484, 1476, 65535, 1564, 1556, 1548, 1540, 65535, 1628, 1620, 1612, 1604, 65535, 1692, 1684, 1676, 1668, 65535, 1756, 1748, 1740, 1732, 65535, 1820, 1812, 1804, 1796, 65535, 1884, 1876, 1868, 1860, 65535, 1948, 1940, 1932, 1924, 65535, 2012, 2004, 1996, 1988, 65535, 27, 21, 11, 6, 65535, 91, 85, 75, 70, 65535, 155, 149, 139, 134, 65535, 219, 213, 203, 198, 65535, 283, 277, 267, 262, 65535, 347, 341, 331, 326, 65535, 411, 405, 395, 390, 65535, 475, 469, 459, 454, 65535, 539, 533, 523, 518, 65535, 603, 597, 587, 582, 65535, 667, 661, 651, 646, 65535, 731, 725, 715, 710, 65535, 795, 789, 779, 774, 65535, 859, 853, 843, 838, 65535, 923, 917, 907, 902, 65535, 987, 981, 971, 966, 65535, 1051, 1045, 1035, 1029, 65535, 1115, 1109, 1099, 1093, 65535, 1179, 1173, 1163, 1157, 65535, 1243, 1237, 1227, 1221, 65535, 1307, 1301, 1291, 1285, 65535, 1371, 1365, 1355, 1349, 65535, 1435, 1429, 1419, 1413, 65535, 1499, 1493, 1483, 1477, 65535, 1563, 1557, 1547, 1541, 65535, 1627, 1621, 1611, 1605, 65535, 1691, 1685, 1675, 1669, 65535, 1755, 1749, 1739, 1733, 65535, 1819, 1813, 1803, 1797, 65535, 1883, 1877, 1867, 1861, 65535, 1947, 1941, 1931, 1925, 65535, 2011, 2005, 1995, 1989, 65535, 26, 22, 10, 7, 65535, 90, 86, 74, 71, 65535, 154, 150, 138, 135, 65535, 218, 214, 202, 199, 65535, 282, 278, 266, 263, 65535, 346, 342, 330, 327, 65535, 410, 406, 394, 391, 65535, 474, 470, 458, 455, 65535, 538, 534, 522, 519, 65535, 602, 598, 586, 583, 65535, 666, 662, 650, 647, 65535, 730, 726, 714, 711, 65535, 794, 790, 778, 775, 65535, 858, 854, 842, 839, 65535, 922, 918, 906, 903, 65535, 986, 982, 970, 967, 65535, 1050, 1046, 1034, 1030, 65535, 1114, 1110, 1098, 1094, 65535, 1178, 1174, 1162, 1158, 65535, 1242, 1238, 1226, 1222, 65535, 1306, 1302, 1290, 1286, 65535, 1370, 1366, 1354, 1350, 65535, 1434, 1430, 1418, 1414, 65535, 1498, 1494, 1482, 1478, 65535, 1562, 1558, 1546, 1542, 65535, 1626, 1622, 1610, 1606, 65535, 1690, 1686, 1674, 1670, 65535, 1754, 1750, 1738, 1734, 65535, 1818, 1814, 1802, 1798, 65535, 1882, 1878, 1866, 1862, 65535, 1946, 1942, 1930, 1926, 65535, 2010, 2006, 1994, 1990, 65535, 25, 23, 9, 8, 65535, 89, 87, 73, 72, 65535, 153, 151, 137, 136, 65535, 217, 215, 201, 200, 65535, 281, 279, 265, 264, 65535, 345, 343, 329, 328, 65535, 409, 407, 393, 392, 65535, 473, 471, 457, 456, 65535, 537, 535, 521, 520, 65535, 601, 599, 585, 584, 65535, 665, 663, 649, 648, 65535, 729, 727, 713, 712, 65535, 793, 791, 777, 776, 65535, 857, 855, 841, 840, 65535, 921, 919, 905, 904, 65535, 985, 983, 969, 968, 65535, 1049, 1047, 1033, 1031, 65535, 1113, 1111, 1097, 1095, 65535, 1177, 1175, 1161, 1159, 65535, 1241, 1239, 1225, 1223, 65535, 1305, 1303, 1289, 1287, 65535, 1369, 1367, 1353, 1351, 65535, 1433, 1431, 1417, 1415, 65535, 1497, 1495, 1481, 1479, 65535, 1561, 1559, 1545, 1543, 65535, 1625, 1623, 1609, 1607, 65535, 1689, 1687, 1673, 1671, 65535, 1753, 1751, 1737, 1735, 65535, 1817, 1815, 1801, 1799, 65535, 1881, 1879, 1865, 1863, 65535, 1945, 1943, 1929, 1927, 65535, 2009, 2007, 1993, 1991, 65535, 24, 88, 1032, 65535, 65535, 152, 216, 1096, 65535, 65535, 280, 344, 1160, 65535, 65535, 408, 472, 1224, 65535, 65535, 536, 600, 1288, 65535, 65535, 664, 728, 1352, 65535, 65535, 792, 856, 1416, 65535, 65535, 920, 984, 1480, 65535, 65535, 1048, 1112, 1544, 65535, 65535, 1176, 1240, 1608, 65535, 65535, 1304, 1368, 1672, 65535, 65535, 1432, 1496, 1736, 65535, 65535, 1560, 1624, 1800, 65535, 65535, 1688, 1752, 1864, 65535, 65535, 1816, 1880, 1928, 65535, 65535, 1944, 2008, 1992, 65535, 65535};

#ifndef REP0
#define REP0 1
#endif
#ifndef REP1
#define REP1 1
#endif
#ifndef REP2
#define REP2 1
#endif
#ifndef REP3
#define REP3 1
#endif
#ifndef REP4
#define REP4 1
#endif
#ifndef REP5
#define REP5 1
#endif
__global__ void __launch_bounds__(512, 2) fwd_megakernel(Params p) {
  __shared__ __attribute__((aligned(16))) unsigned char lds[LDS_BYTES];
  cg::grid_group grid = cg::this_grid();
  const int wave_id = __builtin_amdgcn_readfirstlane((int)threadIdx.x >> 6);
#define FRESH_TID() int tid = wave_id * 64 + lane_id(); asm volatile("" : "+v"(tid)); const int half = tid >> 8, htid = tid & 255; unsigned char* ldsh = lds + half * HALF_LDS; (void)htid; (void)ldsh;
  if (p.out == nullptr) grid.sync();
  if (wave_id == 0 && lane_id() == 0) (void)xb_add(&p.bar()[XB_XCNT(xb_xcc_id())], 1u);
  for (int rep = 0; rep < REP0; ++rep) {
  { FRESH_TID(); phase_prep(p, tid); }
  xcd_barrier(p.bar(), wave_id);
  }
  for (int rep = 0; rep < REP1; ++rep) {
  {
    FRESH_TID();
    pg8::Gemm g; g.A = p.xb(); g.Bt = p.WtIn(); g.M = NTOK; g.N = 4096; g.K = 1024;
    pg8::StaticOrder S; S.init(g.M, g.N, (int)gridDim.x, (int)blockIdx.x); S.permtab = 0xEFBCD87694105A32ull; S.padtile = 15;
    Epi1 E; E.p = p; E.hl0 = (LAS unsigned char*)lds + pg8::STAGE_BYTES;
    pg8::gemm_phase<Epi1>((LAS unsigned char*)lds, g, S, E, wave_id);
  }
  xcd_barrier(p.bar(), wave_id);
  }
  for (int rep = 0; rep < REP2; ++rep) {
  {
    FRESH_TID();
    if (gridDim.x == 256) {
      for (int k = 0; k < 5; ++k) {
        const unsigned ent = idx_tab[blockIdx.x * 5 + k];
        if (ent == 0xFFFFu) continue;
        int ht = htid; asm volatile("" : "+v"(ht));
        const int code = (int)(ent & 63u), pr = (int)(ent >> 6);
        const bool samp = (code == 32);
        const int b = pr >> 1, sub = 2 * (pr & 1) + half;
        idx_item(p, ldsh, ht, samp, b, samp ? sub : code * 4 + sub);
      }
      for (int it0 = blockIdx.x * 2; it0 < 2080; it0 += gridDim.x * 2) {
        int ht = htid; asm volatile("" : "+v"(ht));
        ret_kv_item(p, it0 + half, ht);
      }
    } else
    for (int it0 = blockIdx.x * 2; it0 < 2080 + 2080; it0 += gridDim.x * 2) {
      const int it = it0 + half;
      int ht = htid; asm volatile("" : "+v"(ht));
      if (it < 2080) {
        const bool samp = it < 32;
        const int j = it - 32;
        const int c = 31 - (j >> 6);
        const int b = samp ? (it >> 2) : ((j & 63) >> 2);
        const int grp = samp ? (it & 3) : (c * 4 + (j & 3));
        idx_item(p, ldsh, ht, samp, b, grp);
      } else { for (int rkv = 0; rkv < REPKV; ++rkv) ret_kv_item(p, it - 2080, ht); }
    }
  }
  xcd_barrier(p.bar(), wave_id);
  }
  for (int rep = 0; rep < REP3; ++rep) {
  {
    FRESH_TID();
    for (int it0 = blockIdx.x * 2; it0 < 1056 + 1536; it0 += gridDim.x * 2) {
      const int it = it0 + half;
      int ht = htid; asm volatile("" : "+v"(ht));
      if (it < 1056) {
        bool samp = it < 32;
        const int j = it - 32;
        int c = samp ? 0 : 31 - (j >> 6);
        int b = samp ? (it >> 2) : ((j & 63) >> 2);
        int kvh = (it >> 1) & 1;
        if (gridDim.x == 256) {
          const int blk = (int)blockIdx.x, k = it0 >> 9, x = blk & 7;
          int q;
          samp = false;
          if (blk < 16) { const int s = blk >> 3; c = (k < 2) ? 16 : 17; q = (k < 2) ? s + 2 * k : s; }
          else {
            const int m = (blk - 16) >> 3, cls = m >> 2;
            q = m & 3;
            if (cls < 7) c = (k == 0) ? 31 - cls : 18 + cls;
            else if (k == 0) { samp = true; c = 0; }
            else { c = 17; q += 2; }
          }
          if (samp) { b = x; kvh = q & 1; } else { b = 2 * x + (q & 1); kvh = q >> 1; }
        }
        attn_item(p, ldsh, ht, samp, b, c, kvh, it & 1, lds, tid);
      } else scan_item(p, it - 1056, ht);
    }
  }
  xcd_barrier(p.bar(), wave_id);
  }
  for (int rep = 0; rep < REP4; ++rep) {
  {
    FRESH_TID();
    for (int it0 = blockIdx.x * 2; it0 < 2080 + 1024; it0 += gridDim.x * 2) {
      const int it = it0 + half;
      int ht = htid; asm volatile("" : "+v"(ht));
      if (it < 2080) ret_out_item(p, ldsh, it, ht);
      else {
        const int ia = it - 2080 + 1056;
        const int j = ia - 32;
        int c = 31 - (j >> 6);
        int b = (j & 63) >> 2;
        int kvh = (ia >> 1) & 1;
        if (gridDim.x == 256) {
          const int blk = (int)blockIdx.x, k = it0 >> 9, x = blk & 7;
          int q;
          if (blk < 16) { q = blk >> 3; c = (k == 5) ? 9 : 0; }
          else {
            const int m = (blk - 16) >> 3, cls = m >> 2;
            const bool first = (k == 4);
            q = m & 3;
            if (cls < 6) c = first ? 15 - cls : 1 + cls;
            else if (cls == 6) c = first ? 8 : 7;
            else { c = first ? 9 : 0; q += 2; }
          }
          b = 2 * x + (q & 1); kvh = q >> 1;
        }
        attn_item(p, ldsh, ht, false, b, c, kvh, ia & 1, lds, tid);
      }
    }
  }
  xcd_barrier(p.bar(), wave_id);
  }
  for (int rep = 0; rep < REP5; ++rep) {
  {
    pg8::Gemm g; g.A = p.mix(); g.Bt = p.WtOut(); g.M = NTOK; g.N = 1024; g.K = 1024;
    pg8::StaticOrder S; S.init(g.M, g.N, (int)gridDim.x, (int)blockIdx.x);
    Epi2 E; E.p = p; E.hl = lds + pg8::STAGE_BYTES + (wave_id >> 2) * 16384;
    pg8::gemm_phase<Epi2>((LAS unsigned char*)lds, g, S, E, wave_id);
  }
  xcd_barrier(p.bar(), wave_id);
  }
  { FRESH_TID(); phase_final(p, tid); }
}

extern "C" void kernel_launch(void* const* d_in, const int* in_sizes, int n_in, void* d_out, int out_size, void* d_ws,
                              size_t ws_size, hipStream_t stream) {
  static int grid_blocks = 0;
  if (!grid_blocks) {
    int dev = 0, cus = 0, per_cu = 0;
    (void)hipGetDevice(&dev);
    (void)hipDeviceGetAttribute(&cus, hipDeviceAttributeMultiprocessorCount, dev);
    (void)hipOccupancyMaxActiveBlocksPerMultiprocessor(&per_cu, fwd_megakernel, 512, 0);
    if (per_cu < 1) per_cu = 1;
    if (per_cu > 1) per_cu = 1;
    grid_blocks = cus * per_cu;
  }
  Params p{};
  p.x_p = (const float*)d_in[0]; p.x_s = (const float*)d_in[1]; p.state_ret = (const float*)d_in[2];
  p.cache_k = (const float*)d_in[3]; p.cache_v = (const float*)d_in[4]; p.cache_kidx = (const float*)d_in[5];
  p.norm_g = (const float*)d_in[6]; p.w_in = (const float*)d_in[7]; p.ret_gn_g = (const float*)d_in[8];
  p.w_out = (const float*)d_in[9]; p.final_g = (const float*)d_in[10];
  p.out = (float*)d_out;
  p.ws = (unsigned char*)d_ws;
  (void)hipMemsetAsync((unsigned char*)d_ws + 530573312ull, 0, (size_t)XCD_BAR_WORDS * 4, stream);
  void* args[] = {&p};
  hipError_t e = hipLaunchCooperativeKernel((void*)fwd_megakernel, dim3(grid_blocks), dim3(512), args, 0, stream);
  if (e != hipSuccess) fprintf(stderr, "cooperative launch failed: %s (grid %d)\n", hipGetErrorString(e), grid_blocks);
}
```

```cpp
#include <hip/hip_runtime.h>
#include <hip/hip_cooperative_groups.h>
#include <stdint.h>
#include <cstdio>
namespace cg = cooperative_groups;

typedef __attribute__((ext_vector_type(8))) short bf16x8;
typedef __attribute__((ext_vector_type(4))) short s16x4;
typedef __attribute__((ext_vector_type(16))) float f32x16;
typedef __attribute__((ext_vector_type(4))) float f32x4;
typedef unsigned short u16;
typedef unsigned long long u64;


#define DI __device__ __forceinline__
#define MFMA32(a, b, c) __builtin_amdgcn_mfma_f32_32x32x16_bf16((a), (b), (c), 0, 0, 0)
#define MFMA16(a, b, c) __builtin_amdgcn_mfma_f32_16x16x32_bf16((a), (b), (c), 0, 0, 0)

#define NTOK 33280
#define NPROMPT 32768
#define LDS_BYTES 163840
#define HALF_LDS 81920
#define LAS __attribute__((address_space(3)))
#define KPITCH 2116

struct Params {
  const float *x_p, *x_s, *state_ret, *cache_k, *cache_v, *cache_kidx, *norm_g, *w_in, *ret_gn_g, *w_out, *final_g;
  float* out;
  unsigned char* ws;
  DI u16* xb() const { return (u16*)(ws + 0ull); }
  DI float* kvT() const { return (float*)(ws + 0ull); }
  DI u16* WtIn() const { return (u16*)(ws + 136314880ull); }
  DI u16* WtOut() const { return (u16*)(ws + 144703488ull); }
  DI u16* qr() const { return (u16*)(ws + 146800640ull); }
  DI u16* kr() const { return (u16*)(ws + 180879360ull); }
  DI u16* sprevT() const { return (u16*)(ws + 214958080ull); }
  DI u16* qi() const { return (u16*)(ws + 214958080ull); }
  DI u16* krT() const { return (u16*)(ws + 249036800ull); }
  DI u16* vrT() const { return (u16*)(ws + 283115520ull); }
  DI u16* gate() const { return (u16*)(ws + 317194240ull); }
  DI u16* mix() const { return (u16*)(ws + 385351680ull); }
  DI u16* qa() const { return (u16*)(ws + 453509120ull); }
  DI u16* kaP() const { return (u16*)(ws + 487587840ull); }
  DI u16* kaS() const { return (u16*)(ws + 495976448ull); }
  DI u16* vaTP() const { return (u16*)(ws + 500301824ull); }
  DI u16* vaTS() const { return (u16*)(ws + 508690432ull); }
  DI u16* kiP() const { return (u16*)(ws + 513015808ull); }
  DI u16* kiS() const { return (u16*)(ws + 517210112ull); }
  DI float* rinv() const { return (float*)(ws + 519372800ull); }
  DI float* wi() const { return (float*)(ws + 519505920ull); }
  DI float* cosR() const { return (float*)(ws + 520570880ull); }
  DI float* sinR() const { return (float*)(ws + 521111552ull); }
  DI float* cosA() const { return (float*)(ws + 521652224ull); }
  DI float* sinA() const { return (float*)(ws + 521719808ull); }
  DI unsigned* bar() const { return (unsigned*)(ws + 530573312ull); }
  DI u64* maskbits() const { return (u64*)(ws + 521787392ull); }
};

#define OUT_Y 0
#define OUT_STP (34078720)
#define OUT_KP (OUT_STP + 1048576)
#define OUT_VP (OUT_KP + 4194304)
#define OUT_KIP (OUT_VP + 4194304)
#define OUT_STS (OUT_KIP + 2097152)
#define OUT_KS (OUT_STS + 524288)
#define OUT_VS (OUT_KS + 65536)
#define OUT_KIS (OUT_VS + 65536)

typedef __bf16 bf16x2_t __attribute__((ext_vector_type(2)));
typedef float f32x2_t __attribute__((ext_vector_type(2)));
typedef unsigned u32x4_t __attribute__((ext_vector_type(4)));
typedef unsigned u32x2_t __attribute__((ext_vector_type(2)));
DI unsigned pk2(float a, float b) { f32x2_t v = {a, b}; bf16x2_t r = __builtin_convertvector(v, bf16x2_t); return __builtin_bit_cast(unsigned, r); }
DI u16 f2bf(float x) { return (u16)(pk2(x, x) & 0xffffu); }
DI bf16x8 ldg8(const u16* p) { return *(const bf16x8*)p; }
DI s16x4 ldg4(const u16* p) { return *(const s16x4*)p; }
DI float siluf(float x) { return x * __builtin_amdgcn_rcpf(1.f + __builtin_amdgcn_exp2f(-1.4426950408889634f * x)); }
DI int lane_id() { return (int)__builtin_amdgcn_mbcnt_hi(~0u, __builtin_amdgcn_mbcnt_lo(~0u, 0u)); }
DI int crow(int reg, int hh) { return (reg & 3) + 8 * (reg >> 2) + 4 * hh; }
DI const float* xrow(const Params& p, int g) { return g < NPROMPT ? p.x_p + (size_t)g * 1024 : p.x_s + (size_t)(g - NPROMPT) * 1024; }
DI float log2gamma(int h) { return log1pf(-exp2f(-5.f - (float)h)) * 1.4426950408889634f; }
DI bf16x8 pack8(float a0, float a1, float a2, float a3, float a4, float a5, float a6, float a7) {
  u32x4_t v = {pk2(a0, a1), pk2(a2, a3), pk2(a4, a5), pk2(a6, a7)};
  return __builtin_bit_cast(bf16x8, v);
}
DI s16x4 pack4(f32x4 v) { u32x2_t o = {pk2(v[0], v[1]), pk2(v[2], v[3])}; return __builtin_bit_cast(s16x4, o); }
DI int wave_sum(int v) {
  v += __builtin_amdgcn_update_dpp(0, v, 0xB1, 0xf, 0xf, false);
  v += __builtin_amdgcn_update_dpp(0, v, 0x4E, 0xf, 0xf, false);
  v += __builtin_amdgcn_update_dpp(0, v, 0x124, 0xf, 0xf, false);
  v += __builtin_amdgcn_update_dpp(0, v, 0x128, 0xf, 0xf, false);
  return __builtin_amdgcn_readlane(v, 0) + __builtin_amdgcn_readlane(v, 16) + __builtin_amdgcn_readlane(v, 32) + __builtin_amdgcn_readlane(v, 48);
}
DI f32x16 zero16() { f32x16 z; for (int i = 0; i < 16; ++i) z[i] = 0.f; return z; }

#define XB_TMO      128
#define XB_XCNT(j)  (256  + 64 * (j))
#define XB_XSUB(j)  (1280 + 64 * (j))
#define XB_XGEN(j)  (2304 + 64 * (j))
#define XB_TOP      3328
#define XB_TOPGEN   3392
#define XB_WG(i)    (3456 + 64 * (i))
#define XCD_BAR_WORDS (3456 + 64 * 256)
#define XB_SPIN_CAP (1u << 18)
DI unsigned xb_ld(unsigned* p) { return __hip_atomic_load(p, __ATOMIC_RELAXED, __HIP_MEMORY_SCOPE_AGENT); }
DI unsigned xb_add(unsigned* p, unsigned v) { return __hip_atomic_fetch_add(p, v, __ATOMIC_RELAXED, __HIP_MEMORY_SCOPE_AGENT); }
DI unsigned xb_xcc_id() { return (unsigned)__builtin_amdgcn_s_getreg((3 << 11) | 20) & 0xFu; }
#define XB_SPIN(cond, bar) do { unsigned _sp = 0; while (cond) { __builtin_amdgcn_s_sleep(1); \
    if ((++_sp & 255u) == 0u) { if (xb_ld(&(bar)[XB_TMO])) break; if (_sp > XB_SPIN_CAP) { atomicAdd(&(bar)[XB_TMO], 1u); break; } } } } while (0)
DI void xcd_barrier(unsigned* bar, int wave_id) {
  asm volatile("s_waitcnt vmcnt(0)" ::: "memory");
  __syncthreads();
  if (wave_id == 0) {
    int lane = lane_id(); asm volatile("" : "+v"(lane));
    const unsigned x = xb_xcc_id();
    unsigned* slot = &bar[XB_WG(blockIdx.x)];
    unsigned nloc = 0u, nx = 0u;
    if (lane < 2) nloc = xb_ld(slot + lane);
    nx = (unsigned)__builtin_amdgcn_readlane((int)nloc, 1);
    nloc = (unsigned)__builtin_amdgcn_readlane((int)nloc, 0);
    if (nloc == 0u) {
      const unsigned G = gridDim.x * gridDim.y * gridDim.z;
      unsigned sp = 0u, c = 0u;
      for (;;) {
        c = (lane < 16) ? xb_ld(&bar[XB_XCNT(lane)]) : 0u;
        const unsigned sum = (unsigned)wave_sum((int)c);
        if (sum == G) break;
        __builtin_amdgcn_s_sleep(1);
        if ((++sp & 255u) == 0u) { if (xb_ld(&bar[XB_TMO])) break; if (sp > XB_SPIN_CAP) { if (lane == 0) atomicAdd(&bar[XB_TMO], 1u); break; } }
      }
      nx = (unsigned)__popcll(__ballot(c > 0u));
      nloc = (unsigned)__builtin_amdgcn_readlane((int)c, (int)x);
      nloc = nloc > 0u ? nloc : 1u; nx = nx > 0u ? nx : 1u;
      if (lane == 0) { __hip_atomic_store(slot, nloc, __ATOMIC_RELAXED, __HIP_MEMORY_SCOPE_AGENT); __hip_atomic_store(slot + 1, nx, __ATOMIC_RELAXED, __HIP_MEMORY_SCOPE_AGENT); }
    }
    if (lane == 0) {
      __builtin_amdgcn_s_waitcnt(0);
      const unsigned old = xb_add(&bar[XB_XSUB(x)], 1u);
      const unsigned gen = old / nloc;
      if (old + 1u == (gen + 1u) * nloc) {
        __builtin_amdgcn_fence(__ATOMIC_RELEASE, "agent");
        asm volatile("s_waitcnt vmcnt(0)" ::: "memory");
        const unsigned og = xb_add(&bar[XB_TOP], 1u);
        const unsigned tg = og / nx;
        if (og + 1u == (tg + 1u) * nx) xb_add(&bar[XB_TOPGEN], 1u);
        else XB_SPIN(xb_ld(&bar[XB_TOPGEN]) == tg, bar);
        __builtin_amdgcn_fence(__ATOMIC_ACQUIRE, "agent");
        xb_add(&bar[XB_XGEN(x)], 1u);
        asm volatile("s_waitcnt vmcnt(0)" ::: "memory");
      } else {
        XB_SPIN(xb_ld(&bar[XB_XGEN(x)]) == gen, bar);
        __builtin_amdgcn_fence(__ATOMIC_ACQUIRE, "agent");
        asm volatile("s_waitcnt vmcnt(0)" ::: "memory");
      }
    }
  }
  __syncthreads();
}

DI void phase_prep(const Params& p, int tid) {
  const int gt = blockIdx.x * 512 + tid, GT = gridDim.x * 512;
  const int lane = tid & 63;
  for (int row0 = (gt >> 6) * 2; row0 < NTOK; row0 += (GT >> 6) * 2) {
    f32x4 v[2][4];
#pragma unroll
    for (int rr = 0; rr < 2; ++rr) {
      const float* sp = xrow(p, row0 + rr);
#pragma unroll
      for (int i = 0; i < 4; ++i) v[rr][i] = __builtin_nontemporal_load((const f32x4*)(sp + i * 256 + lane * 4));
    }
#pragma unroll
    for (int rr = 0; rr < 2; ++rr) {
      float ss = 0.f;
#pragma unroll
      for (int i = 0; i < 4; ++i) ss += v[rr][i][0] * v[rr][i][0] + v[rr][i][1] * v[rr][i][1] + v[rr][i][2] * v[rr][i][2] + v[rr][i][3] * v[rr][i][3];
#pragma unroll
      for (int o = 32; o >= 1; o >>= 1) ss += __shfl_xor(ss, o);
#pragma unroll
      for (int i = 0; i < 4; ++i) *(s16x4*)(p.xb() + (size_t)(row0 + rr) * 1024 + i * 256 + lane * 4) = pack4(v[rr][i]);
      if (lane == 0) p.rinv()[row0 + rr] = rsqrtf(ss * (1.f / 1024.f) + 1e-6f);
    }
  }
  for (int i = gt; i < 4096 * 128; i += GT) {
    int n = i & 4095, kg = i >> 12;
    int sc = n;
    if (n < 1024) { const int P = n & 127; sc = (n & ~127) + 64 * ((P >> 4) & 1) + 16 * (P >> 5) + (P & 15); }
    float a[8];
    const float vmask = (n < 3912) ? 1.f : 0.f; const int scc = (sc < 3912) ? sc : 3911;
#pragma unroll
    for (int j = 0; j < 8; ++j) a[j] = __builtin_nontemporal_load(p.w_in + (size_t)(kg * 8 + j) * 3912 + scc) * p.norm_g[kg * 8 + j] * vmask;
    *(bf16x8*)(p.WtIn() + (size_t)n * 1024 + kg * 8) = pack8(a[0], a[1], a[2], a[3], a[4], a[5], a[6], a[7]);
  }
  for (int i = gt; i < 1024 * 128; i += GT) {
    int n = i % 1024, kg = i / 1024;
    float a[8];
#pragma unroll
    for (int j = 0; j < 8; ++j) a[j] = __builtin_nontemporal_load(p.w_out + (size_t)(kg * 8 + j) * 1024 + n);
    *(bf16x8*)(p.WtOut() + (size_t)n * 1024 + kg * 8) = pack8(a[0], a[1], a[2], a[3], a[4], a[5], a[6], a[7]);
  }
  for (int i = gt; i < 2112 * 64; i += GT) {
    int pos = i >> 6, k = i & 63;
    float inv = powf(10000.f, -(float)k / 64.f);
    float ang = (float)pos * inv;
    p.cosR()[i] = cosf(ang); p.sinR()[i] = sinf(ang);
  }
  for (int i = gt; i < 2112 * 8; i += GT) {
    int pos = i >> 3, k = i & 7;
    float inv = powf(500000.f, -(float)k / 8.f);
    float ang = (float)pos * inv;
    p.cosA()[i] = cosf(ang); p.sinA()[i] = sinf(ang);
  }
  for (int i = gt; i < 8 * 2048 * 2 * 8; i += GT) {
    int dg = i & 7, kvh = (i >> 3) & 1, t = (i >> 4) & 2047, b = i >> 15;
    const float* s = p.cache_k + ((size_t)(b * 2048 + t) * 2 + kvh) * 64 + dg * 8;
    const f32x4 s0 = __builtin_nontemporal_load((const f32x4*)s), s1 = __builtin_nontemporal_load((const f32x4*)(s + 4));
    *(bf16x8*)(p.kaS() + ((size_t)(b * 2 + kvh) * 2112 + t) * 64 + dg * 8) = pack8(s0[0], s0[1], s0[2], s0[3], s1[0], s1[1], s1[2], s1[3]);
  }
  for (int i = gt; i < 8 * 2 * 256 * 64; i += GT) {
    int d = i & 63, tg = (i >> 6) & 255, kvh = (i >> 14) & 1, b = i >> 15;
    float a[8];
#pragma unroll
    for (int j = 0; j < 8; ++j) a[j] = __builtin_nontemporal_load(p.cache_v + ((size_t)(b * 2048 + tg * 8 + j) * 2 + kvh) * 64 + d);
    *(bf16x8*)(p.vaTS() + ((size_t)(b * 2 + kvh) * 64 + d) * 2112 + tg * 8) = pack8(a[0], a[1], a[2], a[3], a[4], a[5], a[6], a[7]);
  }
  for (int i = gt; i < 8 * 2048 * 8; i += GT) {
    int dg = i & 7, t = (i >> 3) & 2047, b = i >> 14;
    const float* s = p.cache_kidx + (size_t)(b * 2048 + t) * 64 + dg * 8;
    const f32x4 s0 = __builtin_nontemporal_load((const f32x4*)s), s1 = __builtin_nontemporal_load((const f32x4*)(s + 4));
    *(bf16x8*)(p.kiS() + ((size_t)b * 2112 + t) * 64 + dg * 8) = pack8(s0[0], s0[1], s0[2], s0[3], s1[0], s1[1], s1[2], s1[3]);
  }
}

namespace pg8 {
constexpr int BM = 256, BK = 64, HALF = 128, HTB = HALF * BK * 2, STAGE_BYTES = 8 * HTB, NXCD = 8, WGM = 8;
DI int lds_byte(int r, int c) { const int st = (r >> 4) * 2 + (c >> 5), rr = r & 15, cc = c & 31, ob = rr * 64 + cc * 2; return st * 1024 + (ob ^ (((ob >> 9) & 1) << 5)); }
DI void stage_rc(int b, int& R, int& C) { const int st = b / 1024, sb = b % 1024, swz = sb ^ (((sb >> 9) & 1) << 5); R = (st >> 1) * 16 + swz / 64; C = (st & 1) * 32 + (swz % 64) / 2; }
struct Unit { int pm, pn; };
struct Gemm { const u16* A; const u16* Bt; int M, N, K; };
struct StaticOrder {
  int nM, nN, nwg, G, c, padtile; unsigned long long permtab;
  DI void init(int M, int N, int G_, int c_) { nM = M / BM; nN = N / BM; nwg = nM * nN; G = G_; c = c_; permtab = 0xFEDCBA9876543210ull; padtile = -1; }
  DI void map(int L, Unit& u) const {
    int wgid = L; { const int q = nwg / NXCD, r = nwg % NXCD, xcd = wgid % NXCD, off = wgid / NXCD; wgid = (xcd < r ? xcd * (q + 1) : r * (q + 1) + (xcd - r) * q) + off; }
    const int nig = WGM * nN, gid = wgid / nig, fm = gid * WGM, gsz = (nM - fm) < WGM ? (nM - fm) : WGM;
    u.pm = fm + ((wgid % nig) % gsz); u.pn = (int)((permtab >> (4 * ((wgid % nig) / gsz))) & 15ull);
  }
  DI bool next(int i, Unit& u) const {
    const long Ll = (long)i * G + c; if (Ll >= nwg) return false;
    const int L = (int)Ll;
    if (padtile < 0) { map(L, u); return true; }
    const int tail = nwg % G, base = nwg - tail;
    if (L >= base) { u.pm = L - base; u.pn = padtile; return true; }
    map(L, u);
    for (int it = 0; it < 64 && u.pn == padtile && u.pm < tail; ++it) map(base + u.pm, u);
    return true;
  }
};
template <class Epi>
DI void gemm_phase(LAS unsigned char* lds, const Gemm g, const StaticOrder& S, const Epi& E, int wave_id) {
  const int wid = wave_id; int lane = lane_id(); asm volatile("" : "+v"(lane)); const int tid = wid * 64 + lane;
  const int wr = wid >> 2, wc = wid & 3, fr = lane & 15, fq = lane >> 4;
  const int K = g.K, nt = K / BK;
  unsigned voffA[2], voffB[2];
#pragma unroll
  for (int i = 0; i < 2; ++i) { int R, C; stage_rc(tid * 16 + i * 8192, R, C); voffA[i] = (unsigned)(R * K + C) * 2u; voffB[i] = voffA[i]; }
  const size_t kstep = (size_t)(BK * 2);
  const size_t hstep = (size_t)HALF * K * 2;
  const size_t tstep = 2 * hstep;
  const unsigned ldsw = (unsigned)wid * 1024u;
  const int aoff = lds_byte(wr * 64 + fr, fq * 8), boff = lds_byte(wc * 32 + fr, fq * 8);
#define PG8_SA(b, h) (((b) * 2 + (h)) * HTB)
#define PG8_SB(b, h) ((4 + (b) * 2 + (h)) * HTB)
#define PG8_STAGE(bufoff, gbase, voff) do { _Pragma("unroll") for (int _i = 0; _i < 2; ++_i) \
    __builtin_amdgcn_global_load_lds((const unsigned*)((const char*)(gbase) + (voff)[_i]), (LAS unsigned*)(lds + (bufoff) + ldsw + _i * 8192), 16, 0, 0); } while (0)
#define PG8_LDA(dst, b, h) do { _Pragma("unroll") for (int m = 0; m < 4; ++m) _Pragma("unroll") for (int k = 0; k < 2; ++k) dst[m][k] = *(const LAS bf16x8*)(lds + PG8_SA(b, h) + aoff + m * 2048 + k * 1024); } while (0)
#define PG8_LDB(dst, b, h) do { _Pragma("unroll") for (int n = 0; n < 2; ++n) _Pragma("unroll") for (int k = 0; k < 2; ++k) dst[n][k] = *(const LAS bf16x8*)(lds + PG8_SB(b, h) + boff + n * 2048 + k * 1024); } while (0)
#define PG8_MMA(ai, bj, At, Bt) do { __builtin_amdgcn_s_setprio(1); _Pragma("unroll") for (int m = 0; m < 4; ++m) _Pragma("unroll") for (int n = 0; n < 2; ++n) _Pragma("unroll") for (int k = 0; k < 2; ++k) \
    acc[ai][bj][m][n] = __builtin_amdgcn_mfma_f32_16x16x32_bf16(Bt[n][k], At[m][k], acc[ai][bj][m][n], 0, 0, 0); __builtin_amdgcn_s_setprio(0); } while (0)
#define PG8_WAIT_V(n) asm volatile("s_waitcnt vmcnt(" #n ")" ::: "memory")
#define PG8_WAIT_L(n) asm volatile("s_waitcnt lgkmcnt(" #n ")" ::: "memory")
#define PG8_BAR __builtin_amdgcn_s_barrier()
#define PG8_SCHED __builtin_amdgcn_sched_barrier(0)
  Unit cur, nxt; int ui = 0;
  if (!S.next(0, cur)) return;
  f32x4 acc[2][2][4][2];
#pragma unroll
  for (int a = 0; a < 2; ++a)
#pragma unroll
    for (int b = 0; b < 2; ++b)
#pragma unroll
      for (int m = 0; m < 4; ++m)
#pragma unroll
        for (int n = 0; n < 2; ++n) acc[a][b][m][n] = (f32x4){0.f, 0.f, 0.f, 0.f};
  bf16x8 At[4][2], B0[2][2], B1[2][2];
  const char* cA = (const char*)g.A + (size_t)cur.pm * tstep; const char* cB = (const char*)g.Bt + (size_t)cur.pn * tstep;
  PG8_STAGE(PG8_SB(0, 0), cB, voffB); PG8_STAGE(PG8_SA(0, 0), cA, voffA); PG8_STAGE(PG8_SB(0, 1), cB + hstep, voffB); PG8_STAGE(PG8_SA(0, 1), cA + hstep, voffA);
  if (wr == 1) PG8_BAR;
  PG8_WAIT_V(4); PG8_BAR;
  PG8_STAGE(PG8_SB(1, 0), cB + kstep, voffB); PG8_STAGE(PG8_SA(1, 0), cA + kstep, voffA); PG8_STAGE(PG8_SB(1, 1), cB + hstep + kstep, voffB);
  PG8_WAIT_V(6); PG8_BAR;
  for (;;) {
    const bool has_next = S.next(ui + 1, nxt);
    const char* nA = has_next ? (const char*)g.A + (size_t)nxt.pm * tstep : cA; const char* nB = has_next ? (const char*)g.Bt + (size_t)nxt.pn * tstep : cB;
#ifndef REPK
#define REPK 1
#endif
    const bool skip1 = (S.padtile >= 0) && (cur.pn == S.padtile);
    for (int rk = 0; rk < REPK; ++rk) {
    const char* nA2 = (rk == REPK - 1) ? nA : cA; const char* nB2 = (rk == REPK - 1) ? nB : cB;
    for (int t = 0; t < nt; t += 2) {
      const bool last = (t == nt - 2);
      const char* a1 = cA + (size_t)(t + 1) * kstep;
      const char* a2 = last ? nA2 : cA + (size_t)(t + 2) * kstep; const char* b2 = last ? nB2 : cB + (size_t)(t + 2) * kstep;
      const char* a3 = a2 + kstep; const char* b3 = b2 + kstep;
      PG8_LDB(B0, 0, 0); PG8_SCHED; PG8_LDA(At, 0, 0); PG8_STAGE(PG8_SA(1, 1), a1 + hstep, voffA);
      PG8_WAIT_L(8); PG8_BAR; PG8_WAIT_L(0); PG8_MMA(0, 0, At, B0); PG8_BAR; PG8_SCHED;
      PG8_LDB(B1, 0, 1); PG8_STAGE(PG8_SB(0, 0), b2, voffB);
      PG8_BAR; PG8_WAIT_L(0); if (!skip1) PG8_MMA(0, 1, At, B1); PG8_BAR;
      PG8_LDA(At, 0, 1); PG8_STAGE(PG8_SA(0, 0), a2, voffA);
      PG8_BAR; PG8_WAIT_L(0); PG8_MMA(1, 0, At, B0); PG8_BAR; PG8_SCHED;
      PG8_STAGE(PG8_SB(0, 1), b2 + hstep, voffB);
      PG8_WAIT_V(6); PG8_BAR; if (!skip1) PG8_MMA(1, 1, At, B1); PG8_BAR;
      PG8_LDB(B0, 1, 0); PG8_SCHED; PG8_LDA(At, 1, 0); PG8_STAGE(PG8_SA(0, 1), a2 + hstep, voffA);
      PG8_WAIT_L(8); PG8_BAR; PG8_WAIT_L(0); PG8_MMA(0, 0, At, B0); PG8_BAR; PG8_SCHED;
      PG8_LDB(B1, 1, 1); PG8_STAGE(PG8_SB(1, 0), b3, voffB);
      PG8_BAR; PG8_WAIT_L(0); if (!skip1) PG8_MMA(0, 1, At, B1); PG8_BAR;
      PG8_LDA(At, 1, 1); PG8_STAGE(PG8_SA(1, 0), a3, voffA);
      PG8_BAR; PG8_WAIT_L(0); PG8_MMA(1, 0, At, B0); PG8_BAR; PG8_SCHED;
      PG8_STAGE(PG8_SB(1, 1), b3 + hstep, voffB);
      PG8_WAIT_V(6); PG8_BAR; if (!skip1) PG8_MMA(1, 1, At, B1); PG8_BAR;
    }
    }
    {
      Unit eu = cur; int ewr = wr, ewc = wc; int el = lane_id();
      asm volatile("" : "+s"(eu.pm), "+s"(eu.pn), "+s"(ewr), "+s"(ewc), "+v"(el));
      int efr = el & 15, efq = el >> 4;
#ifndef REPEPI
#define REPEPI 1
#endif
      for (int re = 0; re < REPEPI; ++re) E(acc, eu, ewr, ewc, efr, efq, re);
    }
    if (!has_next) break;
#pragma unroll
    for (int a = 0; a < 2; ++a)
#pragma unroll
      for (int b = 0; b < 2; ++b)
#pragma unroll
        for (int m = 0; m < 4; ++m)
#pragma unroll
          for (int n = 0; n < 2; ++n) acc[a][b][m][n] = (f32x4){0.f, 0.f, 0.f, 0.f};
    cur = nxt; cA = nA; cB = nB; ++ui;
  }
  PG8_WAIT_V(0);
  if (wr == 0) PG8_BAR;
  PG8_BAR;
#undef PG8_SA
#undef PG8_SB
#undef PG8_STAGE
#undef PG8_LDA
#undef PG8_LDB
#undef PG8_MMA
#undef PG8_WAIT_V
#undef PG8_WAIT_L
#undef PG8_BAR
#undef PG8_SCHED
}
}


DI unsigned hx_w(int row, int c8) { return (unsigned)(row * 256 + ((c8 ^ ((row & 15) << 1)) << 3)); }
DI unsigned hx_r(int row, int c16) { return (unsigned)(row * 256 + ((c16 ^ (row & 15)) << 4)); }
#define EPI_BAR() asm volatile("s_waitcnt lgkmcnt(0)\n\ts_barrier" ::: "memory")


struct Epi1 {
  Params p; LAS unsigned char* hl0;
  DI void make_tabs(f32x4 (&tc)[4], f32x4 (&ts)[4], f32x4 c0, f32x4 s0, f32x4 c16, f32x4 s16) const {
    tc[0] = c0; ts[0] = s0;
#pragma unroll
    for (int m = 1; m < 4; ++m) { tc[m] = tc[m - 1] * c16 - ts[m - 1] * s16; ts[m] = ts[m - 1] * c16 + tc[m - 1] * s16; }
  }
  template <int AI, int BJ>
  DI void compute(f32x4 (&acc)[2][2][4][2], const f32x4 (&tc)[4], const f32x4 (&ts)[4], int blk, int wc, int fq) const {
    if (blk < 8) {
#pragma unroll
      for (int m = 0; m < 4; ++m) {
        const f32x4 v0 = acc[AI][BJ][m][0], v1 = acc[AI][BJ][m][1];
        f32x4 o0 = v0 * tc[m] - v1 * ts[m], o1 = v1 * tc[m] + v0 * ts[m];
        if (blk >= 4) { o0 *= 0.08838834764831845f; o1 *= 0.08838834764831845f; }
        acc[AI][BJ][m][0] = o0; acc[AI][BJ][m][1] = o1;
      }
    } else if ((blk >= 12 && blk < 16) || (blk >= 22 && blk < 26)) {
#pragma unroll
      for (int m = 0; m < 4; ++m)
#pragma unroll
        for (int n = 0; n < 2; ++n) {
          f32x4 v = acc[AI][BJ][m][n];
          v[0] = siluf(v[0]); v[1] = siluf(v[1]); v[2] = siluf(v[2]); v[3] = siluf(v[3]);
          acc[AI][BJ][m][n] = v;
        }
    } else if ((blk >= 8 && blk < 12) || blk == 21 || blk == 31) {
    } else {
      const bool ropew = ((wc & 1) == 0) && !(blk == 30 && wc >= 2);
      if (ropew) {
#pragma unroll
        for (int m = 0; m < 4; ++m) {
          const f32x4 v0 = acc[AI][BJ][m][0];
          f32x4 pr;
          pr[0] = __shfl_xor(v0[0], 32); pr[1] = __shfl_xor(v0[1], 32); pr[2] = __shfl_xor(v0[2], 32); pr[3] = __shfl_xor(v0[3], 32);
          acc[AI][BJ][m][0] = (fq < 2) ? v0 * tc[m] - pr * ts[m] : v0 * tc[m] + pr * ts[m];
        }
      }
      if (blk < 20) {
        const float sc = 0.125f * 1.4426950408889634f;
#pragma unroll
        for (int m = 0; m < 4; ++m) { acc[AI][BJ][m][0] *= sc; acc[AI][BJ][m][1] *= sc; }
      }
    }
  }
  template <int AI, int BJ>
  DI void emit(f32x4 (&acc)[2][2][4][2], const pg8::Unit& u, int blk, bool samp, int wr, int wc, int fr, int fq) const {
    if (blk == 31) return;
    LAS unsigned char* hl = hl0 + wr * 16384;
    asm volatile("" : "+v"(fr), "+v"(fq));
    const int lane = fr + 16 * fq;
    const int P0 = 32 * wc + 4 * fq;
    const int R0 = u.pm * 256 + AI * 128 + wr * 64;
    int b, tb;
    if (!samp) { b = R0 >> 11; tb = R0 & 2047; } else { b = (R0 - NPROMPT) >> 6; tb = 0; }
    const bool retk = blk < 8;
    const bool hasT = (blk >= 4 && blk < 12) || blk == 21;
    const bool hasN = !(blk >= 8 && blk < 12) && blk != 21;
    if (blk == 20 || blk == 21) {
      float* ob = samp ? p.out + (blk == 20 ? OUT_KS : OUT_VS) + (unsigned)(R0 - NPROMPT) * 128u : p.out + (blk == 20 ? OUT_KP : OUT_VP) + (unsigned)R0 * 128u;
#pragma unroll
      for (int m = 0; m < 4; ++m) {
        float* o2 = ob + (unsigned)(16 * m + fr) * 128u + P0;
        __builtin_nontemporal_store(acc[AI][BJ][m][0], (f32x4*)o2); __builtin_nontemporal_store(acc[AI][BJ][m][1], (f32x4*)(o2 + 16));
      }
    } else if (blk == 30) {
      float* ob = samp ? p.out + OUT_KIS + (unsigned)(R0 - NPROMPT) * 64u : p.out + OUT_KIP + (unsigned)R0 * 64u;
      float* wb = p.wi() + (unsigned)R0 * 8u;
#pragma unroll
      for (int m = 0; m < 4; ++m) {
        if (wc < 2) {
          float* o2 = ob + (unsigned)(16 * m + fr) * 64u + P0;
          __builtin_nontemporal_store(acc[AI][BJ][m][0], (f32x4*)o2); __builtin_nontemporal_store(acc[AI][BJ][m][1], (f32x4*)(o2 + 16));
        } else if (wc == 2 && fq < 2) {
          *(f32x4*)(wb + (unsigned)(16 * m + fr) * 8u + 4 * fq) = acc[AI][BJ][m][0] * 0.044194173824159216f;
        }
      }
    }
    if (hasN) {
#pragma unroll
      for (int m = 0; m < 4; ++m)
#pragma unroll
        for (int n = 0; n < 2; ++n) {
          const int c8 = retk ? (16 * n + 4 * wc + fq) : (8 * wc + 4 * n + fq);
          *(LAS s16x4*)(hl + hx_w(16 * m + fr, c8)) = pack4(acc[AI][BJ][m][n]);
        }
      u16* nb; unsigned pitch = 512u, hstr = 0u, cm = 15u;
      if (blk < 4) nb = p.qr() + (unsigned)R0 * 512u + (blk & 3) * 128;
      else if (blk < 8) nb = p.kr() + (unsigned)R0 * 512u + (blk & 3) * 128;
      else if (blk < 16) { nb = p.gate() + (unsigned)R0 * 1024u + (blk - 12) * 128; pitch = 1024u; }
      else if (blk < 20) nb = p.qa() + (unsigned)R0 * 512u + (blk - 16) * 128;
      else if (blk == 20) { nb = samp ? p.kaS() + ((unsigned)(b * 2) * 2112u + 2048u) * 64u : p.kaP() + ((unsigned)(b * 2) * 2048u + tb) * 64u; pitch = 64u; hstr = samp ? 2112u * 64u : 2048u * 64u; cm = 7u; }
      else if (blk < 26) { nb = p.gate() + (unsigned)R0 * 1024u + 512 + (blk - 22) * 128; pitch = 1024u; }
      else if (blk < 30) nb = p.qi() + (unsigned)R0 * 512u + (blk - 26) * 128;
      else { nb = samp ? p.kiS() + ((unsigned)b * 2112u + 2048u) * 64u : p.kiP() + ((unsigned)b * 2048u + tb) * 64u; pitch = 64u; cm = 7u; }
      EPI_BAR();
      const unsigned c16 = lane & 15;
      const unsigned loff = (c16 >> 3) * hstr + (c16 & cm) * 8u;
#pragma unroll
      for (int i = 0; i < 4; ++i) {
        const int row = 16 * wc + 4 * i + (lane >> 4);
        const bf16x8 v = *(const LAS bf16x8*)(hl + hx_r(row, c16));
        if (blk != 30 || c16 < 8) *(bf16x8*)(nb + (unsigned)row * pitch + loff) = v;
      }
      EPI_BAR();
    }
    if (hasT) {
      const float l2g = log2gamma(blk & 3);
#pragma unroll
      for (int m = 0; m < 4; ++m) {
        const int tok = 16 * m + fr;
        const float dec = (blk < 8) ? exp2f((float)(63 - tok) * l2g) : 1.f;
#pragma unroll
        for (int n = 0; n < 2; ++n) {
          const int fb = retk ? (64 * n + 16 * wc + 4 * fq) : (32 * wc + 16 * n + 4 * fq);
#pragma unroll
          for (int j = 0; j < 4; ++j) {
            const int f = fb + j;
            *(LAS u16*)(hl + f * 128 + ((((tok >> 3) ^ (f >> 2)) & 7) << 4) + (tok & 7) * 2) = f2bf(acc[AI][BJ][m][n][j] * dec);
          }
        }
      }
      u16* tbp; unsigned fstr;
      if (blk < 12) {
        u16* base = (blk < 8) ? p.krT() : p.vrT();
        const unsigned bh = (unsigned)(b * 4 + (blk & 3)) * 128u;
        tbp = samp ? base + 64u * 128u * 2048u + bh * 64u : base + bh * 2048u + tb;
        fstr = samp ? 64u : 2048u;
      } else {
        tbp = samp ? p.vaTS() + (unsigned)b * 128u * 2112u + 2048u : p.vaTP() + (unsigned)b * 128u * 2048u + tb;
        fstr = samp ? 2112u : 2048u;
      }
      EPI_BAR();
#pragma unroll
      for (int i = 0; i < 4; ++i) {
        const int f = 32 * wc + 8 * i + (lane >> 3), ch = lane & 7;
        const bf16x8 v = *(const LAS bf16x8*)(hl + f * 128 + (((ch ^ (f >> 2)) & 7) << 4));
        *(bf16x8*)(tbp + (unsigned)f * fstr + ch * 8) = v;
      }
      EPI_BAR();
    }
  }
  DI void operator()(f32x4 (&acc)[2][2][4][2], const pg8::Unit& u, int wr, int wc, int fr, int fq, int re) const {
    const bool samp = (u.pm * 256 >= NPROMPT);
    const int tclass = (u.pn < 4) ? 1 : ((u.pn == 8 || u.pn == 9 || u.pn == 10 || u.pn >= 13) ? 2 : 0);
    const int blk0 = u.pn * 2, blk1 = u.pn * 2 + 1;
    float rvv[2][4];
#pragma unroll
    for (int ai = 0; ai < 2; ++ai)
#pragma unroll
      for (int m = 0; m < 4; ++m) rvv[ai][m] = (1.f / REPK) * p.rinv()[u.pm * 256 + ai * 128 + wr * 64 + 16 * m + fr];
    const float* cb = (tclass == 1) ? p.cosR() : p.cosA();
    const float* sb = (tclass == 1) ? p.sinR() : p.sinA();
    const int pitch = (tclass == 1) ? 64 : 8;
    const int coff = (tclass == 1) ? (16 * wc + 4 * fq) : (4 * (fq & 1));
    const int rowg0 = u.pm * 256 + wr * 64 + fr;
    const int pos0 = samp ? 2048 + ((rowg0 - NPROMPT) & 63) : (rowg0 & 2047);
    const f32x4 c0 = *(const f32x4*)(cb + pos0 * pitch + coff), s0 = *(const f32x4*)(sb + pos0 * pitch + coff);
    const f32x4 c16 = *(const f32x4*)(cb + 16 * pitch + coff), s16 = *(const f32x4*)(sb + 16 * pitch + coff);
    f32x4 tc[4], ts[4];
#pragma unroll
    for (int ai = 0; ai < 2; ++ai)
#pragma unroll
      for (int m = 0; m < 4; ++m)
#pragma unroll
        for (int bj = 0; bj < 2; ++bj)
#pragma unroll
          for (int n = 0; n < 2; ++n) acc[ai][bj][m][n] *= rvv[ai][m];
    make_tabs(tc, ts, c0, s0, c16, s16);
    compute<0, 0>(acc, tc, ts, blk0, wc, fq);
    compute<0, 1>(acc, tc, ts, blk1, wc, fq);
    {
      const f32x4 c32 = c16 * c16 - s16 * s16, s32 = 2.f * s16 * c16;
      const f32x4 c64 = c32 * c32 - s32 * s32, s64 = 2.f * s32 * c32;
      const f32x4 c80 = c64 * c16 - s64 * s16, s80 = s64 * c16 + c64 * s16;
      const f32x4 c1 = samp ? tc[0] : tc[3] * c80 - ts[3] * s80, s1 = samp ? ts[0] : ts[3] * c80 + tc[3] * s80;
      make_tabs(tc, ts, c1, s1, c16, s16);
    }
    compute<1, 0>(acc, tc, ts, blk0, wc, fq);
    compute<1, 1>(acc, tc, ts, blk1, wc, fq);
    emit<0, 0>(acc, u, blk0, samp, wr, wc, fr, fq);
    emit<0, 1>(acc, u, blk1, samp, wr, wc, fr, fq);
    emit<1, 0>(acc, u, blk0, samp, wr, wc, fr, fq);
    emit<1, 1>(acc, u, blk1, samp, wr, wc, fr, fq);
  }
};

struct Epi2 {
  Params p; unsigned char* hl;
  DI void operator()(f32x4 (&acc)[2][2][4][2], const pg8::Unit& u, int wr, int wc, int fr, int fq, int re) const {
    u16* z = p.gate();
    const int lane = fr + 16 * fq;
#pragma unroll
    for (int ai = 0; ai < 2; ++ai)
#pragma unroll
      for (int bj = 0; bj < 2; ++bj) {
#pragma unroll
        for (int m = 0; m < 4; ++m)
#pragma unroll
          for (int n = 0; n < 2; ++n)
            *(s16x4*)(hl + hx_w(16 * m + fr, 8 * wc + 4 * n + fq)) = pack4(acc[ai][bj][m][n] * (1.f / REPK));
        EPI_BAR();
        const unsigned R0 = u.pm * 256 + ai * 128 + wr * 64;
        const unsigned cb = u.pn * 256 + bj * 128;
#pragma unroll
        for (int i = 0; i < 4; ++i) {
          const int row = 16 * wc + 4 * i + (lane >> 4), c16 = lane & 15;
          const bf16x8 v = *(const bf16x8*)(hl + hx_r(row, c16));
          *(bf16x8*)(z + (R0 + row) * 1024u + cb + c16 * 8) = v;
        }
        EPI_BAR();
      }
  }
};

DI void ret_kv_item(const Params& p, int item, int tid) {
  const int lane = tid & 63, w = tid >> 6, r = lane & 31, hh = lane >> 5;
  const u16 *kT, *vT; int T, c;
  if (item < 2048) { const int bh = item >> 5; c = item & 31; T = 2048; kT = p.krT() + (size_t)bh * 128 * 2048; vT = p.vrT() + (size_t)bh * 128 * 2048; }
  else { const int bh = item - 2048; c = 0; T = 64; kT = p.krT() + (size_t)64 * 128 * 2048 + (size_t)bh * 128 * 64; vT = p.vrT() + (size_t)64 * 128 * 2048 + (size_t)bh * 128 * 64; }
  const int e0 = (w & 1) * 64, d0 = (w >> 1) * 64;
  f32x16 acc[2][2];
  acc[0][0] = zero16(); acc[0][1] = zero16(); acc[1][0] = zero16(); acc[1][1] = zero16();
#pragma unroll
  for (int ks = 0; ks < 4; ++ks) {
    bf16x8 a0 = ldg8(vT + (size_t)(e0 + r) * T + c * 64 + ks * 16 + hh * 8);
    bf16x8 a1 = ldg8(vT + (size_t)(e0 + 32 + r) * T + c * 64 + ks * 16 + hh * 8);
    bf16x8 b0 = ldg8(kT + (size_t)(d0 + r) * T + c * 64 + ks * 16 + hh * 8);
    bf16x8 b1 = ldg8(kT + (size_t)(d0 + 32 + r) * T + c * 64 + ks * 16 + hh * 8);
    acc[0][0] = MFMA32(a0, b0, acc[0][0]);
    acc[0][1] = MFMA32(a0, b1, acc[0][1]);
    acc[1][0] = MFMA32(a1, b0, acc[1][0]);
    acc[1][1] = MFMA32(a1, b1, acc[1][1]);
  }
  u16* o = (u16*)p.kvT() + (size_t)item * 16384;
#pragma unroll
  for (int a = 0; a < 2; ++a)
#pragma unroll
    for (int b = 0; b < 2; ++b)
#pragma unroll
      for (int i = 0; i < 16; ++i)
        o[(e0 + a * 32 + crow(i, hh)) * 128 + d0 + b * 32 + r] = f2bf(acc[a][b][i]);
}

template <int NS>
DI void select_query(const u16* krow, int nj, int lane, u64* dst) {
  unsigned key[NS];
#pragma unroll
  for (int j = 0; j < NS; ++j) { const unsigned k = krow[j * 64 + lane]; key[j] = (j < nj) ? k : 0u; }
  constexpr int NP = (NS + 1) / 2;
  unsigned pk[NP];
#pragma unroll
  for (int i = 0; i < NP; ++i) pk[i] = key[2 * i] | ((2 * i + 1 < NS ? key[2 * i + 1] : 0u) << 16);
  unsigned prefix = 0;
  int cntp = 0;
  const unsigned ones = 0x00010001u;
  for (int bit = 15; bit >= 0; --bit) {
    const unsigned cand = prefix | (1u << bit);
    const unsigned c1 = cand - 1u;
    const unsigned cv = c1 | (c1 << 16);
    unsigned acc0 = 0, acc1 = 0;
#pragma unroll
    for (int i = 0; i < NP; ++i) {
      unsigned d, m;
      asm("v_pk_sub_u16 %0, %1, %2 clamp" : "=v"(d) : "v"(pk[i]), "v"(cv));
      asm("v_pk_min_u16 %0, %1, %2" : "=v"(m) : "v"(d), "v"(ones));
      if (i & 1) acc1 += m; else acc0 += m;
    }
    const unsigned a = acc0 + acc1;
    const int cnt = wave_sum((int)((a & 0xffffu) + (a >> 16)));
    if (cnt >= 256) { prefix = cand; cntp = cnt; }
    if (cnt == 256) break;
  }
  int wlo = 0, whi = 0;
  if (cntp == 256) {
#pragma unroll
    for (int j = 0; j < NS; ++j) {
      const u64 sm = __ballot(key[j] >= prefix);
      if (lane == j) { wlo = (int)(unsigned)sm; whi = (int)(unsigned)(sm >> 32); }
    }
  } else {
    int cgt = 0;
#pragma unroll
    for (int j = 0; j < NS; ++j) cgt += (key[j] > prefix) ? 1 : 0;
    cgt = wave_sum(cgt);
    const int rneed = 256 - cgt;
    int running = 0;
    const u64 lt = (1ull << lane) - 1ull;
#pragma unroll
    for (int j = 0; j < NS; ++j) {
      const bool eq = key[j] == prefix;
      const u64 em = __ballot(eq);
      const int rank = running + __popcll(em & lt);
      const bool sel = (key[j] > prefix) || (eq && rank < rneed);
      const u64 sm = __ballot(sel);
      if (lane == j) { wlo = (int)(unsigned)sm; whi = (int)(unsigned)(sm >> 32); }
      running += __popcll(em);
    }
  }
  if (lane < nj) __builtin_nontemporal_store(((u64)(unsigned)whi << 32) | (u64)(unsigned)wlo, dst + lane);
}

DI void idx_item(const Params& p, unsigned char* lds, int tid, bool samp, int b, int grp) {
  const int lane = tid & 63, w = tid >> 6;
  const int t0 = grp * 16;
  int L, g0; const u16* ki;
  if (!samp) { const int c = t0 >> 6; L = (c + 1) * 64; g0 = b * 2048 + t0; ki = p.kiP() + (size_t)b * 2048 * 64; }
  else { L = 2112; g0 = NPROMPT + b * 64 + t0; ki = p.kiS() + (size_t)b * 2112 * 64; }
  const int nj = L >> 6;
  if (L <= 256) {
    for (int qq = 0; qq < 4; ++qq) {
      const int q = w * 4 + qq;
      if (lane < nj) p.maskbits()[(size_t)(g0 + q) * 33 + lane] = ~0ull;
    }
    return;
  }
  u16* keys = (u16*)lds;
#ifndef REPMF
#define REPMF 1
#endif
#ifndef REPSEL
#define REPSEL 1
#endif
#ifndef REPKV
#define REPKV 1
#endif
  for (int rmf = 0; rmf < REPMF; ++rmf) {
    const int qn = lane & 15, quad = lane >> 4;
    bf16x8 qf[8][2];
    float wv[8];
#pragma unroll
    for (int h = 0; h < 8; ++h) {
      qf[h][0] = ldg8(p.qi() + (size_t)(g0 + qn) * 512 + h * 64 + quad * 8);
      qf[h][1] = ldg8(p.qi() + (size_t)(g0 + qn) * 512 + h * 64 + 32 + quad * 8);
      wv[h] = p.wi()[(size_t)(g0 + qn) * 8 + h];
    }
    bf16x8 A0[4], A1[4], N0[4], N1[4];
#pragma unroll
    for (int i = 0; i < 4; ++i) {
      const int kt = w + 4 * i;
      A0[i] = ldg8(ki + (size_t)(kt * 16 + qn) * 64 + quad * 8);
      A1[i] = ldg8(ki + (size_t)(kt * 16 + qn) * 64 + 32 + quad * 8);
    }
    for (int base = 0; base < nj; base += 4) {
#pragma unroll
      for (int i = 0; i < 4; ++i) {
        const int t = min(base + 4 + i, nj - 1);
        const int kt = w + 4 * t;
        N0[i] = ldg8(ki + (size_t)(kt * 16 + qn) * 64 + quad * 8);
        N1[i] = ldg8(ki + (size_t)(kt * 16 + qn) * 64 + 32 + quad * 8);
      }
#pragma unroll
      for (int i = 0; i < 4; ++i) {
        const int t = base + i;
        if (t < nj) {
          const int kt = w + 4 * t;
          float idx[4] = {0.f, 0.f, 0.f, 0.f};
#pragma unroll
          for (int h = 0; h < 8; ++h) {
            f32x4 acc = {0.f, 0.f, 0.f, 0.f};
            acc = MFMA16(A0[i], qf[h][0], acc);
            acc = MFMA16(A1[i], qf[h][1], acc);
#pragma unroll
            for (int e = 0; e < 4; ++e) idx[e] += fmaxf(acc[e], 0.f) * wv[h];
          }
          s16x4 kv;
#pragma unroll
          for (int e = 0; e < 4; ++e) {
            _Float16 hv = (_Float16)idx[e];
            u16 bits = __builtin_bit_cast(u16, hv);
            kv[e] = (short)((bits & 0x8000) ? (u16)~bits : (u16)(bits | 0x8000));
          }
          *(s16x4*)(keys + qn * KPITCH + kt * 16 + quad * 4) = kv;
        }
      }
#pragma unroll
      for (int i = 0; i < 4; ++i) { A0[i] = N0[i]; A1[i] = N1[i]; }
    }
  }
  __syncthreads();
  for (int qq = 0; qq < 4 * REPSEL; ++qq) {
    const int q = w * 4 + (qq & 3);
    const u16* krow = keys + q * KPITCH;
    u64* dst = p.maskbits() + (size_t)(g0 + q) * 33;
    if (nj <= 8) select_query<8>(krow, nj, lane, dst);
    else if (nj <= 16) select_query<16>(krow, nj, lane, dst);
    else if (nj <= 24) select_query<24>(krow, nj, lane, dst);
    else select_query<33>(krow, nj, lane, dst);
  }
  __syncthreads();
}

DI void scan_item(const Params& p, int item, int tid) {
  if (item < 1024) {
    const int bh = item >> 4, slab = item & 15;
    const int idx = slab * 1024 + tid * 4;
    const int h = bh & 3;
    const float cd = exp2f(64.f * log2gamma(h));
    f32x4 s = {0.f, 0.f, 0.f, 0.f};
    s16x4 kraw[2][8];
#pragma unroll
    for (int i = 0; i < 8; ++i) kraw[0][i] = __builtin_nontemporal_load((const s16x4*)((const u16*)p.kvT() + (size_t)(bh * 32 + i) * 16384 + idx));
#pragma unroll
    for (int b8 = 0; b8 < 4; ++b8) {
      if (b8 < 3) {
#pragma unroll
        for (int i = 0; i < 8; ++i) kraw[(b8 + 1) & 1][i] = __builtin_nontemporal_load((const s16x4*)((const u16*)p.kvT() + (size_t)(bh * 32 + (b8 + 1) * 8 + i) * 16384 + idx));
      }
#pragma unroll
      for (int i = 0; i < 8; ++i) {
        __builtin_nontemporal_store(pack4(s), (s16x4*)(p.sprevT() + (size_t)(bh * 32 + b8 * 8 + i) * 16384 + idx));
        f32x4 kv;
#pragma unroll
        for (int j = 0; j < 4; ++j) kv[j] = __uint_as_float(((unsigned)(u16)kraw[b8 & 1][i][j]) << 16);
        s = s * cd + kv;
      }
    }
    const int e = idx >> 7, d = idx & 127;
    float* o = p.out + OUT_STP + (size_t)bh * 16384;
#pragma unroll
    for (int j = 0; j < 4; ++j) o[(d + j) * 128 + e] = s[j];
  } else {
    const int it = item - 1024;
    const int bh = it >> 4, slab = it & 15;
    const int idx = slab * 1024 + tid * 4;
    const int h = bh & 3;
    const float cd = exp2f(64.f * log2gamma(h));
    const int e = idx >> 7, d = idx & 127;
    const float* s0 = p.state_ret + (size_t)bh * 16384;
    f32x4 s;
#pragma unroll
    for (int j = 0; j < 4; ++j) s[j] = s0[(d + j) * 128 + e];
    const size_t base = (size_t)(2048 + bh) * 16384 + idx;
    s16x4 o = pack4(s);
    *(s16x4*)(p.sprevT() + base) = o;
    const s16x4 kk = *(const s16x4*)((const u16*)p.kvT() + base);
    f32x4 kv;
#pragma unroll
    for (int j = 0; j < 4; ++j) kv[j] = __uint_as_float(((unsigned)(u16)kk[j]) << 16);
    s = s * cd + kv;
    float* oo = p.out + OUT_STS + (size_t)bh * 16384;
#pragma unroll
    for (int j = 0; j < 4; ++j) oo[(d + j) * 128 + e] = s[j];
  }
}

DI void attn_item(const Params& p, unsigned char* lds, int tid, bool samp, int b, int c, int kvh, int qh, unsigned char* lds_blk, int tid512) {
  const int lane = tid & 63, w = tid >> 6, r = lane & 31, hh = lane >> 5;
  const int T = samp ? 2112 : 2048;
  const int nkt = samp ? 33 : c + 1;
  const int g0 = (samp ? NPROMPT + b * 64 : b * 2048 + c * 64) + qh * 32;
  const u16* K = samp ? p.kaS() + (size_t)(b * 2 + kvh) * 2112 * 64 : p.kaP() + (size_t)(b * 2 + kvh) * 2048 * 64;
  const u16* VT = samp ? p.vaTS() + (size_t)(b * 2 + kvh) * 64 * 2112 : p.vaTP() + (size_t)(b * 2 + kvh) * 64 * 2048;
  const int head = kvh * 4 + w;
  u16* KV0 = (u16*)(lds_blk + 2 * HALF_LDS - 4 * 9216);
  u64* mL = (u64*)lds;
  {
    u64 mv[5];
#pragma unroll
    for (int i = 0; i < 5; ++i) { const int ix = tid + 256 * i; mv[i] = __builtin_nontemporal_load(p.maskbits() + (size_t)g0 * 33 + (ix < 32 * 33 ? ix : 32 * 33 - 1)); }
#pragma unroll
    for (int i = 0; i < 5; ++i) { const int ix = tid + 256 * i; if (ix < 32 * 33) mL[ix] = mv[i]; }
  }
  bf16x8 qf[4];
#pragma unroll
  for (int ks = 0; ks < 4; ++ks) qf[ks] = ldg8(p.qa() + (size_t)(g0 + r) * 512 + head * 64 + ks * 16 + hh * 8);
  const u16* grow = p.gate() + (size_t)(g0 + r) * 1024 + 512 + head * 64;
  s16x4 gvv[2][4];
#pragma unroll
  for (int dt = 0; dt < 2; ++dt)
#pragma unroll
    for (int q4 = 0; q4 < 4; ++q4) gvv[dt][q4] = *(const s16x4*)(grow + dt * 32 + 8 * q4 + 4 * hh);
  f32x16 O[2];
  O[0] = zero16(); O[1] = zero16();
  float mrun = -1e30f, lrun = 0.f;
  const int lrow = tid512 >> 3, lch = tid512 & 7;
  const int loff = lrow * 72 + lch * 8;
  bf16x8 pk0, pv0, nk0, nv0;
  {
    const bf16x8 k0 = ldg8(K + (size_t)(lrow)*64 + lch * 8), v0 = ldg8(VT + (size_t)(lrow)*T + lch * 8);
    const int t1 = nkt > 1 ? 1 : 0, t2 = nkt > 2 ? 2 : (nkt - 1);
    pk0 = ldg8(K + (size_t)(t1 * 64 + lrow) * 64 + lch * 8); pv0 = ldg8(VT + (size_t)(lrow)*T + t1 * 64 + lch * 8);
    nk0 = ldg8(K + (size_t)(t2 * 64 + lrow) * 64 + lch * 8); nv0 = ldg8(VT + (size_t)(lrow)*T + t2 * 64 + lch * 8);
    *(bf16x8*)(KV0 + loff) = k0;
    *(bf16x8*)(KV0 + 64 * 72 + loff) = v0;
  }
  __syncthreads();
  for (int kt = 0; kt < nkt; ++kt) {
    if (kt + 1 < nkt) {
      u16* nb = KV0 + ((kt + 1) & 1) * (2 * 64 * 72);
      *(bf16x8*)(nb + loff) = pk0;
      *(bf16x8*)(nb + 64 * 72 + loff) = pv0;
    }
    pk0 = nk0; pv0 = nv0;
    {
      const int t3 = (kt + 3 < nkt) ? kt + 3 : nkt - 1;
      nk0 = ldg8(K + (size_t)(t3 * 64 + lrow) * 64 + lch * 8);
      nv0 = ldg8(VT + (size_t)(lrow)*T + t3 * 64 + lch * 8);
    }
    const u16* Ks = KV0 + (kt & 1) * (2 * 64 * 72);
    const u16* Vs = Ks + 64 * 72;
    f32x16 S[2];
#pragma unroll
    for (int st = 0; st < 2; ++st) {
      S[st] = zero16();
#pragma unroll
      for (int ks = 0; ks < 4; ++ks) {
        bf16x8 kf = *(const bf16x8*)(Ks + (st * 32 + r) * 72 + ks * 16 + hh * 8);
        S[st] = MFMA32(kf, qf[ks], S[st]);
      }
    }
    const u64 W = mL[r * 33 + kt];
    const int wl = (int)(((unsigned)W) >> (4 * hh)), wh = (int)(((unsigned)(W >> 32)) >> (4 * hh));
    float mx = fmaxf(S[0][0], S[1][0]);
#pragma unroll
    for (int i = 1; i < 16; ++i) mx = fmaxf(mx, fmaxf(S[0][i], S[1][i]));
    mx = fmaxf(mx, __shfl_xor(mx, 32));
    const float mn = fmaxf(mrun, mx);
    const float alpha = __builtin_amdgcn_exp2f(mrun - mn);
    const bool resc = __any(mn != mrun);
    mrun = mn;
    float ls = 0.f;
#pragma unroll
    for (int st = 0; st < 2; ++st)
#pragma unroll
      for (int i = 0; i < 16; ++i) {
        const int keep = __builtin_amdgcn_sbfe(st ? wh : wl, (i & 3) + 8 * (i >> 2), 1);
        const float pvv = __int_as_float(__float_as_int(__builtin_amdgcn_exp2f(S[st][i] - mn)) & keep);
        S[st][i] = pvv;
        ls += pvv;
      }
    lrun = lrun * alpha + ls;
    if (resc) {
#pragma unroll
      for (int dt = 0; dt < 2; ++dt)
#pragma unroll
        for (int i = 0; i < 16; ++i) O[dt][i] *= alpha;
    }
#pragma unroll
    for (int st = 0; st < 2; ++st)
#pragma unroll
      for (int s2 = 0; s2 < 2; ++s2) {
        bf16x8 pf = pack8(S[st][8 * s2 + 0], S[st][8 * s2 + 1], S[st][8 * s2 + 2], S[st][8 * s2 + 3],
                          S[st][8 * s2 + 4], S[st][8 * s2 + 5], S[st][8 * s2 + 6], S[st][8 * s2 + 7]);
#pragma unroll
        for (int dt = 0; dt < 2; ++dt) {
          s16x4 lo = *(const s16x4*)(Vs + (dt * 32 + r) * 72 + st * 32 + 16 * s2 + 4 * hh);
          s16x4 hi = *(const s16x4*)(Vs + (dt * 32 + r) * 72 + st * 32 + 16 * s2 + 8 + 4 * hh);
          bf16x8 vf = __builtin_shufflevector(lo, hi, 0, 1, 2, 3, 4, 5, 6, 7);
          O[dt] = MFMA32(vf, pf, O[dt]);
        }
      }
    __syncthreads();
  }
  {
    float lt = lrun + __shfl_xor(lrun, 32);
    const float inv = 1.f / fmaxf(lt, 1e-30f);
    u16* mrow = p.mix() + (size_t)(g0 + r) * 1024 + 512 + head * 64;
#pragma unroll
    for (int dt = 0; dt < 2; ++dt)
#pragma unroll
      for (int q4 = 0; q4 < 4; ++q4) {
        const int d = dt * 32 + 8 * q4 + 4 * hh;
        f32x4 of;
#pragma unroll
        for (int j = 0; j < 4; ++j) {
          const float gf = __uint_as_float(((unsigned)(u16)gvv[dt][q4][j]) << 16);
          of[j] = O[dt][q4 * 4 + j] * inv * gf;
        }
        *(s16x4*)(mrow + d) = pack4(of);
      }
  }
  __syncthreads();
}

DI void ret_out_item(const Params& p, unsigned char* lds, int item, int tid) {
  const int lane = tid & 63, w = tid >> 6, r = lane & 31, hh = lane >> 5;
  int bh, c, T, g0; const u16* vT;
  if (item < 2048) { bh = item >> 5; c = item & 31; T = 2048; g0 = (bh >> 2) * 2048 + c * 64; vT = p.vrT() + (size_t)bh * 128 * 2048; }
  else { bh = item - 2048; c = 0; T = 64; g0 = NPROMPT + (bh >> 2) * 64; vT = p.vrT() + (size_t)64 * 128 * 2048 + (size_t)bh * 128 * 64; }
  const int h = bh & 3;
  const float l2g = log2gamma(h);
  const int nt = w & 1, eh = w >> 1;
  const int n = nt * 32 + r;
  const u16* sp = p.sprevT() + (size_t)item * 16384;
  bf16x8 qf[8], kf[8], sf[8];
  s16x4 vlo[2][2][2], vhi[2][2][2];
#pragma unroll
  for (int ks = 0; ks < 8; ++ks) qf[ks] = ldg8(p.qr() + (size_t)(g0 + n) * 512 + h * 128 + ks * 16 + hh * 8);
#pragma unroll
  for (int ks = 0; ks < 8; ++ks) kf[ks] = ldg8(p.kr() + (size_t)(g0 + r) * 512 + h * 128 + ks * 16 + hh * 8);
#pragma unroll
  for (int et = 0; et < 2; ++et)
#pragma unroll
    for (int mt = 0; mt < 2; ++mt)
#pragma unroll
      for (int s2 = 0; s2 < 2; ++s2) {
        const u16* vp = vT + (size_t)((2 * eh + et) * 32 + r) * T + c * 64 + mt * 32 + 16 * s2 + 4 * hh;
        vlo[et][mt][s2] = ldg4(vp); vhi[et][mt][s2] = ldg4(vp + 8);
      }
  __builtin_amdgcn_sched_barrier(0);
  bf16x8 pf[2][2];
#pragma unroll
  for (int mt = 0; mt < 2; ++mt) {
    f32x16 S = zero16();
#pragma unroll
    for (int ks = 0; ks < 8; ++ks) S = MFMA32(kf[ks], qf[ks], S);
    if (mt == 0) {
#pragma unroll
      for (int ks = 0; ks < 8; ++ks) kf[ks] = ldg8(p.kr() + (size_t)(g0 + 32 + r) * 512 + h * 128 + ks * 16 + hh * 8);
#pragma unroll
      for (int ks = 0; ks < 8; ++ks) sf[ks] = ldg8(sp + (size_t)((2 * eh) * 32 + r) * 128 + ks * 16 + hh * 8);
      __builtin_amdgcn_sched_barrier(0);
    }
#pragma unroll
    for (int i = 0; i < 16; ++i) {
      const int m = mt * 32 + crow(i, hh);
      const int dd = n > m ? n - m : m - n;
      S[i] *= exp2f((float)dd * l2g);
    }
    pf[mt][0] = pack8(S[0], S[1], S[2], S[3], S[4], S[5], S[6], S[7]);
    pf[mt][1] = pack8(S[8], S[9], S[10], S[11], S[12], S[13], S[14], S[15]);
  }
  const float fs = exp2f((float)(n + 1) * l2g);
  f32x16 tot[2];
  float ss = 0.f;
#pragma unroll
  for (int et = 0; et < 2; ++et) {
    f32x16 Oi = zero16(), X = zero16();
#pragma unroll
    for (int ks = 0; ks < 8; ++ks) X = MFMA32(sf[ks], qf[ks], X);
    if (et == 0) {
#pragma unroll
      for (int ks = 0; ks < 8; ++ks) sf[ks] = ldg8(sp + (size_t)((2 * eh + 1) * 32 + r) * 128 + ks * 16 + hh * 8);
      __builtin_amdgcn_sched_barrier(0);
    }
#pragma unroll
    for (int mt = 0; mt < 2; ++mt)
#pragma unroll
      for (int s2 = 0; s2 < 2; ++s2) {
        bf16x8 vf = __builtin_shufflevector(vlo[et][mt][s2], vhi[et][mt][s2], 0, 1, 2, 3, 4, 5, 6, 7);
        Oi = MFMA32(vf, pf[mt][s2], Oi);
      }
#pragma unroll
    for (int i = 0; i < 16; ++i) { const float t = Oi[i] + X[i] * fs; tot[et][i] = t; ss += t * t; }
  }
  ss += __shfl_xor(ss, 32);
  float* red = (float*)lds;
  __syncthreads();
  if (hh == 0) red[w * 32 + r] = ss;
  __syncthreads();
  const float tsum = red[w * 32 + r] + red[(w ^ 2) * 32 + r];
  const float rinv = rsqrtf(tsum * (1.f / 128.f) + 1e-6f);
  const u16* grow = p.gate() + (size_t)(g0 + n) * 1024 + h * 128;
  u16* mrow = p.mix() + (size_t)(g0 + n) * 1024 + h * 128;
  s16x4 gvv[2][4];
  f32x4 ggv[2][4];
#pragma unroll
  for (int et = 0; et < 2; ++et)
#pragma unroll
    for (int q4 = 0; q4 < 4; ++q4) {
      const int e = (2 * eh + et) * 32 + 8 * q4 + 4 * hh;
      gvv[et][q4] = *(const s16x4*)(grow + e);
      ggv[et][q4] = *(const f32x4*)(p.ret_gn_g + h * 128 + e);
    }
#pragma unroll
  for (int et = 0; et < 2; ++et)
#pragma unroll
    for (int q4 = 0; q4 < 4; ++q4) {
      const int e = (2 * eh + et) * 32 + 8 * q4 + 4 * hh;
      f32x4 of;
#pragma unroll
      for (int j = 0; j < 4; ++j) {
        const float gf = __uint_as_float(((unsigned)(u16)gvv[et][q4][j]) << 16);
        of[j] = tot[et][q4 * 4 + j] * rinv * ggv[et][q4][j] * gf;
      }
      *(s16x4*)(mrow + e) = pack4(of);
    }
}

DI void phase_final(const Params& p, int tid) {
  const int gt = blockIdx.x * 512 + tid, GT = gridDim.x * 512;
  const int lane = tid & 63;
  for (int row0 = (gt >> 6) * 2; row0 < NTOK; row0 += (GT >> 6) * 2) {
    f32x4 v[2][4];
    s16x4 zz[2][4];
#pragma unroll
    for (int rr = 0; rr < 2; ++rr) {
      const float* xr = xrow(p, row0 + rr);
      const u16* zr = p.gate() + (size_t)(row0 + rr) * 1024;
#pragma unroll
      for (int i = 0; i < 4; ++i) { v[rr][i] = __builtin_nontemporal_load((const f32x4*)(xr + i * 256 + lane * 4)); zz[rr][i] = __builtin_nontemporal_load((const s16x4*)(zr + i * 256 + lane * 4)); }
    }
    f32x4 g[4];
#pragma unroll
    for (int i = 0; i < 4; ++i) g[i] = *(const f32x4*)(p.final_g + i * 256 + lane * 4);
#pragma unroll
    for (int rr = 0; rr < 2; ++rr) {
      float ss = 0.f;
#pragma unroll
      for (int i = 0; i < 4; ++i) {
#pragma unroll
        for (int j = 0; j < 4; ++j) v[rr][i][j] += __uint_as_float(((unsigned)(u16)zz[rr][i][j]) << 16);
        ss += v[rr][i][0] * v[rr][i][0] + v[rr][i][1] * v[rr][i][1] + v[rr][i][2] * v[rr][i][2] + v[rr][i][3] * v[rr][i][3];
      }
#pragma unroll
      for (int o = 32; o >= 1; o >>= 1) ss += __shfl_xor(ss, o);
      const float rv = rsqrtf(ss * (1.f / 1024.f) + 1e-6f);
      float* y = p.out + OUT_Y + (size_t)(row0 + rr) * 1024;
#pragma unroll
      for (int i = 0; i < 4; ++i) __builtin_nontemporal_store(v[rr][i] * rv * g[i], (f32x4*)(y + i * 256 + lane * 4));
    }
  }
}

static __device__ const u16 idx_tab[1280] = {32, 16, 80, 65535, 65535, 96, 144, 208, 65535, 65535, 160, 272, 336, 65535, 65535, 224, 400, 464, 65535, 65535, 288, 528, 592, 65535, 65535, 352, 656, 720, 65535, 65535, 416, 784, 848, 65535, 65535, 480, 912, 976, 65535, 65535, 544, 1040, 1104, 65535, 65535, 608, 1168, 1232, 65535, 65535, 672, 1296, 1360, 65535, 65535, 736, 1424, 1488, 65535, 65535, 800, 1552, 1616, 65535, 65535, 864, 1680, 1744, 65535, 65535, 928, 1808, 1872, 65535, 65535, 992, 1936, 2000, 65535, 65535, 31, 17, 15, 3, 67, 95, 81, 79, 131, 195, 159, 145, 143, 259, 323, 223, 209, 207, 387, 451, 287, 273, 271, 515, 579, 351, 337, 335, 643, 707, 415, 401, 399, 771, 835, 479, 465, 463, 899, 963, 543, 529, 527, 1027, 1091, 607, 593, 591, 1155, 1219, 671, 657, 655, 1283, 1347, 735, 721, 719, 1411, 1475, 799, 785, 783, 1539, 1603, 863, 849, 847, 1667, 1731, 927, 913, 911, 1795, 1859, 991, 977, 975, 1923, 1987, 1055, 1041, 1039, 65535, 65535, 1119, 1105, 1103, 65535, 65535, 1183, 1169, 1167, 65535, 65535, 1247, 1233, 1231, 65535, 65535, 1311, 1297, 1295, 65535, 65535, 1375, 1361, 1359, 65535, 65535, 1439, 1425, 1423, 65535, 65535, 1503, 1489, 1487, 65535, 65535, 1567, 1553, 1551, 65535, 65535, 1631, 1617, 1615, 65535, 65535, 1695, 1681, 1679, 65535, 65535, 1759, 1745, 1743, 65535, 65535, 1823, 1809, 1807, 65535, 65535, 1887, 1873, 1871, 65535, 65535, 1951, 1937, 1935, 65535, 65535, 2015, 2001, 1999, 65535, 65535, 30, 18, 14, 1, 65, 94, 82, 78, 129, 193, 158, 146, 142, 257, 321, 222, 210, 206, 385, 449, 286, 274, 270, 513, 577, 350, 338, 334, 641, 705, 414, 402, 398, 769, 833, 478, 466, 462, 897, 961, 542, 530, 526, 1025, 1089, 606, 594, 590, 1153, 1217, 670, 658, 654, 1281, 1345, 734, 722, 718, 1409, 1473, 798, 786, 782, 1537, 1601, 862, 850, 846, 1665, 1729, 926, 914, 910, 1793, 1857, 990, 978, 974, 1921, 1985, 1054, 1042, 1038, 2, 66, 1118, 1106, 1102, 130, 194, 1182, 1170, 1166, 258, 322, 1246, 1234, 1230, 386, 450, 1310, 1298, 1294, 514, 578, 1374, 1362, 1358, 642, 706, 1438, 1426, 1422, 770, 834, 1502, 1490, 1486, 898, 962, 1566, 1554, 1550, 1026, 1090, 1630, 1618, 1614, 1154, 1218, 1694, 1682, 1678, 1282, 1346, 1758, 1746, 1742, 1410, 1474, 1822, 1810, 1806, 1538, 1602, 1886, 1874, 1870, 1666, 1730, 1950, 1938, 1934, 1794, 1858, 2014, 2002, 1998, 1922, 1986, 29, 19, 13, 4, 65535, 93, 83, 77, 68, 65535, 157, 147, 141, 132, 65535, 221, 211, 205, 196, 65535, 285, 275, 269, 260, 65535, 349, 339, 333, 324, 65535, 413, 403, 397, 388, 65535, 477, 467, 461, 452, 65535, 541, 531, 525, 516, 65535, 605, 595, 589, 580, 65535, 669, 659, 653, 644, 65535, 733, 723, 717, 708, 65535, 797, 787, 781, 772, 65535, 861, 851, 845, 836, 65535, 925, 915, 909, 900, 65535, 989, 979, 973, 964, 65535, 1053, 1043, 1037, 0, 64, 1117, 1107, 1101, 128, 192, 1181, 1171, 1165, 256, 320, 1245, 1235, 1229, 384, 448, 1309, 1299, 1293, 512, 576, 1373, 1363, 1357, 640, 704, 1437, 1427, 1421, 768, 832, 1501, 1491, 1485, 896, 960, 1565, 1555, 1549, 1024, 1088, 1629, 1619, 1613, 1152, 1216, 1693, 1683, 1677, 1280, 1344, 1757, 1747, 1741, 1408, 1472, 1821, 1811, 1805, 1536, 1600, 1885, 1875, 1869, 1664, 1728, 1949, 1939, 1933, 1792, 1856, 2013, 2003, 1997, 1920, 1984, 28, 20, 12, 5, 65535, 92, 84, 76, 69, 65535, 156, 148, 140, 133, 65535, 220, 212, 204, 197, 65535, 284, 276, 268, 261, 65535, 348, 340, 332, 325, 65535, 412, 404, 396, 389, 65535, 476, 468, 460, 453, 65535, 540, 532, 524, 517, 65535, 604, 596, 588, 581, 65535, 668, 660, 652, 645, 65535, 732, 724, 716, 709, 65535, 796, 788, 780, 773, 65535, 860, 852, 844, 837, 65535, 924, 916, 908, 901, 65535, 988, 980, 972, 965, 65535, 1052, 1044, 1036, 1028, 65535, 1116, 1108, 1100, 1092, 65535, 1180, 1172, 1164, 1156, 65535, 1244, 1236, 1228, 1220, 65535, 1308, 1300, 1292, 1284, 65535, 1372, 1364, 1356, 1348, 65535, 1436, 1428, 1420, 1412, 65535, 1500, 1492, 1484, 1476, 65535, 1564, 1556, 1548, 1540, 65535, 1628, 1620, 1612, 1604, 65535, 1692, 1684, 1676, 1668, 65535, 1756, 1748, 1740, 1732, 65535, 1820, 1812, 1804, 1796, 65535, 1884, 1876, 1868, 1860, 65535, 1948, 1940, 1932, 1924, 65535, 2012, 2004, 1996, 1988, 65535, 27, 21, 11, 6, 65535, 91, 85, 75, 70, 65535, 155, 149, 139, 134, 65535, 219, 213, 203, 198, 65535, 283, 277, 267, 262, 65535, 347, 341, 331, 326, 65535, 411, 405, 395, 390, 65535, 475, 469, 459, 454, 65535, 539, 533, 523, 518, 65535, 603, 597, 587, 582, 65535, 667, 661, 651, 646, 65535, 731, 725, 715, 710, 65535, 795, 789, 779, 774, 65535, 859, 853, 843, 838, 65535, 923, 917, 907, 902, 65535, 987, 981, 971, 966, 65535, 1051, 1045, 1035, 1029, 65535, 1115, 1109, 1099, 1093, 65535, 1179, 1173, 1163, 1157, 65535, 1243, 1237, 1227, 1221, 65535, 1307, 1301, 1291, 1285, 65535, 1371, 1365, 1355, 1349, 65535, 1435, 1429, 1419, 1413, 65535, 1499, 1493, 1483, 1477, 65535, 1563, 1557, 1547, 1541, 65535, 1627, 1621, 1611, 1605, 65535, 1691, 1685, 1675, 1669, 65535, 1755, 1749, 1739, 1733, 65535, 1819, 1813, 1803, 1797, 65535, 1883, 1877, 1867, 1861, 65535, 1947, 1941, 1931, 1925, 65535, 2011, 2005, 1995, 1989, 65535, 26, 22, 10, 7, 65535, 90, 86, 74, 71, 65535, 154, 150, 138, 135, 65535, 218, 214, 202, 199, 65535, 282, 278, 266, 263, 65535, 346, 342, 330, 327, 65535, 410, 406, 394, 391, 65535, 474, 470, 458, 455, 65535, 538, 534, 522, 519, 65535, 602, 598, 586, 583, 65535, 666, 662, 650, 647, 65535, 730, 726, 714, 711, 65535, 794, 790, 778, 775, 65535, 858, 854, 842, 839, 65535, 922, 918, 906, 903, 65535, 986, 982, 970, 967, 65535, 1050, 1046, 1034, 1030, 65535, 1114, 1110, 1098, 1094, 65535, 1178, 1174, 1162, 1158, 65535, 1242, 1238, 1226, 1222, 65535, 1306, 1302, 1290, 1286, 65535, 1370, 1366, 1354, 1350, 65535, 1434, 1430, 1418, 1414, 65535, 1498, 1494, 1482, 1478, 65535, 1562, 1558, 1546, 1542, 65535, 1626, 1622, 1610, 1606, 65535, 1690, 1686, 1674, 1670, 65535, 1754, 1750, 1738, 1734, 65535, 1818, 1814, 1802, 1798, 65535, 1882, 1878, 1866, 1862, 65535, 1946, 1942, 1930, 1926, 65535, 2010, 2006, 1994, 1990, 65535, 25, 23, 9, 8, 65535, 89, 87, 73, 72, 65535, 153, 151, 137, 136, 65535, 217, 215, 201, 200, 65535, 281, 279, 265, 264, 65535, 345, 343, 329, 328, 65535, 409, 407, 393, 392, 65535, 473, 471, 457, 456, 65535, 537, 535, 521, 520, 65535, 601, 599, 585, 584, 65535, 665, 663, 649, 648, 65535, 729, 727, 713, 712, 65535, 793, 791, 777, 776, 65535, 857, 855, 841, 840, 65535, 921, 919, 905, 904, 65535, 985, 983, 969, 968, 65535, 1049, 1047, 1033, 1031, 65535, 1113, 1111, 1097, 1095, 65535, 1177, 1175, 1161, 1159, 65535, 1241, 1239, 1225, 1223, 65535, 1305, 1303, 1289, 1287, 65535, 1369, 1367, 1353, 1351, 65535, 1433, 1431, 1417, 1415, 65535, 1497, 1495, 1481, 1479, 65535, 1561, 1559, 1545, 1543, 65535, 1625, 1623, 1609, 1607, 65535, 1689, 1687, 1673, 1671, 65535, 1753, 1751, 1737, 1735, 65535, 1817, 1815, 1801, 1799, 65535, 1881, 1879, 1865, 1863, 65535, 1945, 1943, 1929, 1927, 65535, 2009, 2007, 1993, 1991, 65535, 24, 88, 1032, 65535, 65535, 152, 216, 1096, 65535, 65535, 280, 344, 1160, 65535, 65535, 408, 472, 1224, 65535, 65535, 536, 600, 1288, 65535, 65535, 664, 728, 1352, 65535, 65535, 792, 856, 1416, 65535, 65535, 920, 984, 1480, 65535, 65535, 1048, 1112, 1544, 65535, 65535, 1176, 1240, 1608, 65535, 65535, 1304, 1368, 1672, 65535, 65535, 1432, 1496, 1736, 65535, 65535, 1560, 1624, 1800, 65535, 65535, 1688, 1752, 1864, 65535, 65535, 1816, 1880, 1928, 65535, 65535, 1944, 2008, 1992, 65535, 65535};

#ifndef REP0
#define REP0 1
#endif
#ifndef REP1
#define REP1 1
#endif
#ifndef REP2
#define REP2 1
#endif
#ifndef REP3
#define REP3 1
#endif
#ifndef REP4
#define REP4 1
#endif
#ifndef REP5
#define REP5 1
#endif
__global__ void __launch_bounds__(512, 2) fwd_megakernel(Params p) {
  __shared__ __attribute__((aligned(16))) unsigned char lds[LDS_BYTES];
  cg::grid_group grid = cg::this_grid();
  const int wave_id = __builtin_amdgcn_readfirstlane((int)threadIdx.x >> 6);
#define FRESH_TID() int tid = wave_id * 64 + lane_id(); asm volatile("" : "+v"(tid)); const int half = tid >> 8, htid = tid & 255; unsigned char* ldsh = lds + half * HALF_LDS; (void)htid; (void)ldsh;
  if (p.out == nullptr) grid.sync();
  if (wave_id == 0 && lane_id() == 0) (void)xb_add(&p.bar()[XB_XCNT(xb_xcc_id())], 1u);
  for (int rep = 0; rep < REP0; ++rep) {
  { FRESH_TID(); phase_prep(p, tid); }
  xcd_barrier(p.bar(), wave_id);
  }
  for (int rep = 0; rep < REP1; ++rep) {
  {
    FRESH_TID();
    pg8::Gemm g; g.A = p.xb(); g.Bt = p.WtIn(); g.M = NTOK; g.N = 4096; g.K = 1024;
    pg8::StaticOrder S; S.init(g.M, g.N, (int)gridDim.x, (int)blockIdx.x); S.permtab = 0xEFBCD87694105A32ull; S.padtile = 15;
    Epi1 E; E.p = p; E.hl0 = (LAS unsigned char*)lds + pg8::STAGE_BYTES;
    pg8::gemm_phase<Epi1>((LAS unsigned char*)lds, g, S, E, wave_id);
  }
  xcd_barrier(p.bar(), wave_id);
  }
  for (int rep = 0; rep < REP2; ++rep) {
  {
    FRESH_TID();
    if (gridDim.x == 256) {
      for (int k = 0; k < 5; ++k) {
        const unsigned ent = idx_tab[blockIdx.x * 5 + k];
        if (ent == 0xFFFFu) continue;
        int ht = htid; asm volatile("" : "+v"(ht));
        const int code = (int)(ent & 63u), pr = (int)(ent >> 6);
        const bool samp = (code == 32);
        const int b = pr >> 1, sub = 2 * (pr & 1) + half;
        idx_item(p, ldsh, ht, samp, b, samp ? sub : code * 4 + sub);
      }
      for (int it0 = blockIdx.x * 2; it0 < 2080; it0 += gridDim.x * 2) {
        int ht = htid; asm volatile("" : "+v"(ht));
        ret_kv_item(p, it0 + half, ht);
      }
    } else
    for (int it0 = blockIdx.x * 2; it0 < 2080 + 2080; it0 += gridDim.x * 2) {
      const int it = it0 + half;
      int ht = htid; asm volatile("" : "+v"(ht));
      if (it < 2080) {
        const bool samp = it < 32;
        const int j = it - 32;
        const int c = 31 - (j >> 6);
        const int b = samp ? (it >> 2) : ((j & 63) >> 2);
        const int grp = samp ? (it & 3) : (c * 4 + (j & 3));
        idx_item(p, ldsh, ht, samp, b, grp);
      } else { for (int rkv = 0; rkv < REPKV; ++rkv) ret_kv_item(p, it - 2080, ht); }
    }
  }
  xcd_barrier(p.bar(), wave_id);
  }
  for (int rep = 0; rep < REP3; ++rep) {
  {
    FRESH_TID();
    for (int it0 = blockIdx.x * 2; it0 < 1056 + 1536; it0 += gridDim.x * 2) {
      const int it = it0 + half;
      int ht = htid; asm volatile("" : "+v"(ht));
      if (it < 1056) {
        bool samp = it < 32;
        const int j = it - 32;
        int c = samp ? 0 : 31 - (j >> 6);
        int b = samp ? (it >> 2) : ((j & 63) >> 2);
        int kvh = (it >> 1) & 1;
        if (gridDim.x == 256) {
          const int blk = (int)blockIdx.x, k = it0 >> 9, x = blk & 7;
          int q;
          samp = false;
          if (blk < 16) { const int s = blk >> 3; c = (k < 2) ? 16 : 17; q = (k < 2) ? s + 2 * k : s; }
          else {
            const int m = (blk - 16) >> 3, cls = m >> 2;
            q = m & 3;
            if (cls < 7) c = (k == 0) ? 31 - cls : 18 + cls;
            else if (k == 0) { samp = true; c = 0; }
            else { c = 17; q += 2; }
          }
          if (samp) { b = x; kvh = q & 1; } else { b = 2 * x + (q & 1); kvh = q >> 1; }
        }
        attn_item(p, ldsh, ht, samp, b, c, kvh, it & 1, lds, tid);
      } else scan_item(p, it - 1056, ht);
    }
  }
  xcd_barrier(p.bar(), wave_id);
  }
  for (int rep = 0; rep < REP4; ++rep) {
  {
    FRESH_TID();
    for (int it0 = blockIdx.x * 2; it0 < 2080 + 1024; it0 += gridDim.x * 2) {
      const int it = it0 + half;
      int ht = htid; asm volatile("" : "+v"(ht));
      if (it < 2080) ret_out_item(p, ldsh, it, ht);
      else {
        const int ia = it - 2080 + 1056;
        const int j = ia - 32;
        int c = 31 - (j >> 6);
        int b = (j & 63) >> 2;
        int kvh = (ia >> 1) & 1;
        if (gridDim.x == 256) {
          const int blk = (int)blockIdx.x, k = it0 >> 9, x = blk & 7;
          int q;
          if (blk < 16) { q = blk >> 3; c = (k == 5) ? 9 : 0; }
          else {
            const int m = (blk - 16) >> 3, cls = m >> 2;
            const bool first = (k == 4);
            q = m & 3;
            if (cls < 6) c = first ? 15 - cls : 1 + cls;
            else if (cls == 6) c = first ? 8 : 7;
            else { c = first ? 9 : 0; q += 2; }
          }
          b = 2 * x + (q & 1); kvh = q >> 1;
        }
        attn_item(p, ldsh, ht, false, b, c, kvh, ia & 1, lds, tid);
      }
    }
  }
  xcd_barrier(p.bar(), wave_id);
  }
  for (int rep = 0; rep < REP5; ++rep) {
  {
    pg8::Gemm g; g.A = p.mix(); g.Bt = p.WtOut(); g.M = NTOK; g.N = 1024; g.K = 1024;
    pg8::StaticOrder S; S.init(g.M, g.N, (int)gridDim.x, (int)blockIdx.x);
    Epi2 E; E.p = p; E.hl = lds + pg8::STAGE_BYTES + (wave_id >> 2) * 16384;
    pg8::gemm_phase<Epi2>((LAS unsigned char*)lds, g, S, E, wave_id);
  }
  xcd_barrier(p.bar(), wave_id);
  }
  { FRESH_TID(); phase_final(p, tid); }
}

extern "C" void kernel_launch(void* const* d_in, const int* in_sizes, int n_in, void* d_out, int out_size, void* d_ws,
                              size_t ws_size, hipStream_t stream) {
  static int grid_blocks = 0;
  if (!grid_blocks) {
    int dev = 0, cus = 0, per_cu = 0;
    (void)hipGetDevice(&dev);
    (void)hipDeviceGetAttribute(&cus, hipDeviceAttributeMultiprocessorCount, dev);
    (void)hipOccupancyMaxActiveBlocksPerMultiprocessor(&per_cu, fwd_megakernel, 512, 0);
    if (per_cu < 1) per_cu = 1;
    if (per_cu > 1) per_cu = 1;
    grid_blocks = cus * per_cu;
  }
  Params p{};
  p.x_p = (const float*)d_in[0]; p.x_s = (const float*)d_in[1]; p.state_ret = (const float*)d_in[2];
  p.cache_k = (const float*)d_in[3]; p.cache_v = (const float*)d_in[4]; p.cache_kidx = (const float*)d_in[5];
  p.norm_g = (const float*)d_in[6]; p.w_in = (const float*)d_in[7]; p.ret_gn_g = (const float*)d_in[8];
  p.w_out = (const float*)d_in[9]; p.final_g = (const float*)d_in[10];
  p.out = (float*)d_out;
  p.ws = (unsigned char*)d_ws;
  (void)hipMemsetAsync((unsigned char*)d_ws + 530573312ull, 0, (size_t)XCD_BAR_WORDS * 4, stream);
  void* args[] = {&p};
  hipError_t e = hipLaunchCooperativeKernel((void*)fwd_megakernel, dim3(grid_blocks), dim3(512), args, 0, stream);
  if (e != hipSuccess) fprintf(stderr, "cooperative launch failed: %s (grid %d)\n", hipGetErrorString(e), grid_blocks);
}
```

```cpp
#include <hip/hip_runtime.h>
#include <hip/hip_cooperative_groups.h>
#include <stdint.h>
#include <cstdio>
namespace cg = cooperative_groups;

typedef __attribute__((ext_vector_type(8))) short bf16x8;
typedef __attribute__((ext_vector_type(4))) short s16x4;
typedef __attribute__((ext_vector_type(16))) float f32x16;
typedef __attribute__((ext_vector_type(4))) float f32x4;
typedef unsigned short u16;
typedef unsigned long long u64;


#define DI __device__ __forceinline__
#define MFMA32(a, b, c) __builtin_amdgcn_mfma_f32_32x32x16_bf16((a), (b), (c), 0, 0, 0)
#define MFMA16(a, b, c) __builtin_amdgcn_mfma_f32_16x16x32_bf16((a), (b), (c), 0, 0, 0)

#define NTOK 33280
#define NPROMPT 32768
#define LDS_BYTES 163840
#define HALF_LDS 81920
#define LAS __attribute__((address_space(3)))
#define KPITCH 2116

struct Params {
  const float *x_p, *x_s, *state_ret, *cache_k, *cache_v, *cache_kidx, *norm_g, *w_in, *ret_gn_g, *w_out, *final_g;
  float* out;
  unsigned char* ws;
  DI u16* xb() const { return (u16*)(ws + 0ull); }
  DI float* kvT() const { return (float*)(ws + 0ull); }
  DI u16* WtIn() const { return (u16*)(ws + 136314880ull); }
  DI u16* WtOut() const { return (u16*)(ws + 144703488ull); }
  DI u16* qr() const { return (u16*)(ws + 146800640ull); }
  DI u16* kr() const { return (u16*)(ws + 180879360ull); }
  DI u16* sprevT() const { return (u16*)(ws + 214958080ull); }
  DI u16* qi() const { return (u16*)(ws + 214958080ull); }
  DI u16* krT() const { return (u16*)(ws + 249036800ull); }
  DI u16* vrT() const { return (u16*)(ws + 283115520ull); }
  DI u16* gate() const { return (u16*)(ws + 317194240ull); }
  DI u16* mix() const { return (u16*)(ws + 385351680ull); }
  DI u16* qa() const { return (u16*)(ws + 453509120ull); }
  DI u16* kaP() const { return (u16*)(ws + 487587840ull); }
  DI u16* kaS() const { return (u16*)(ws + 495976448ull); }
  DI u16* vaTP() const { return (u16*)(ws + 500301824ull); }
  DI u16* vaTS() const { return (u16*)(ws + 508690432ull); }
  DI u16* kiP() const { return (u16*)(ws + 513015808ull); }
  DI u16* kiS() const { return (u16*)(ws + 517210112ull); }
  DI float* rinv() const { return (float*)(ws + 519372800ull); }
  DI float* wi() const { return (float*)(ws + 519505920ull); }
  DI float* cosR() const { return (float*)(ws + 520570880ull); }
  DI float* sinR() const { return (float*)(ws + 521111552ull); }
  DI float* cosA() const { return (float*)(ws + 521652224ull); }
  DI float* sinA() const { return (float*)(ws + 521719808ull); }
  DI unsigned* bar() const { return (unsigned*)(ws + 530573312ull); }
  DI u64* maskbits() const { return (u64*)(ws + 521787392ull); }
};

#define OUT_Y 0
#define OUT_STP (34078720)
#define OUT_KP (OUT_STP + 1048576)
#define OUT_VP (OUT_KP + 4194304)
#define OUT_KIP (OUT_VP + 4194304)
#define OUT_STS (OUT_KIP + 2097152)
#define OUT_KS (OUT_STS + 524288)
#define OUT_VS (OUT_KS + 65536)
#define OUT_KIS (OUT_VS + 65536)

typedef __bf16 bf16x2_t __attribute__((ext_vector_type(2)));
typedef float f32x2_t __attribute__((ext_vector_type(2)));
typedef unsigned u32x4_t __attribute__((ext_vector_type(4)));
typedef unsigned u32x2_t __attribute__((ext_vector_type(2)));
DI unsigned pk2(float a, float b) { f32x2_t v = {a, b}; bf16x2_t r = __builtin_convertvector(v, bf16x2_t); return __builtin_bit_cast(unsigned, r); }
DI u16 f2bf(float x) { return (u16)(pk2(x, x) & 0xffffu); }
DI bf16x8 ldg8(const u16* p) { return *(const bf16x8*)p; }
DI s16x4 ldg4(const u16* p) { return *(const s16x4*)p; }
DI float siluf(float x) { return x * __builtin_amdgcn_rcpf(1.f + __builtin_amdgcn_exp2f(-1.4426950408889634f * x)); }
DI int lane_id() { return (int)__builtin_amdgcn_mbcnt_hi(~0u, __builtin_amdgcn_mbcnt_lo(~0u, 0u)); }
DI int crow(int reg, int hh) { return (reg & 3) + 8 * (reg >> 2) + 4 * hh; }
DI const float* xrow(const Params& p, int g) { return g < NPROMPT ? p.x_p + (size_t)g * 1024 : p.x_s + (size_t)(g - NPROMPT) * 1024; }
DI float log2gamma(int h) { return log1pf(-exp2f(-5.f - (float)h)) * 1.4426950408889634f; }
DI bf16x8 pack8(float a0, float a1, float a2, float a3, float a4, float a5, float a6, float a7) {
  u32x4_t v = {pk2(a0, a1), pk2(a2, a3), pk2(a4, a5), pk2(a6, a7)};
  return __builtin_bit_cast(bf16x8, v);
}
DI s16x4 pack4(f32x4 v) { u32x2_t o = {pk2(v[0], v[1]), pk2(v[2], v[3])}; return __builtin_bit_cast(s16x4, o); }
DI int wave_sum(int v) {
  v += __builtin_amdgcn_update_dpp(0, v, 0xB1, 0xf, 0xf, false);
  v += __builtin_amdgcn_update_dpp(0, v, 0x4E, 0xf, 0xf, false);
  v += __builtin_amdgcn_update_dpp(0, v, 0x124, 0xf, 0xf, false);
  v += __builtin_amdgcn_update_dpp(0, v, 0x128, 0xf, 0xf, false);
  return __builtin_amdgcn_readlane(v, 0) + __builtin_amdgcn_readlane(v, 16) + __builtin_amdgcn_readlane(v, 32) + __builtin_amdgcn_readlane(v, 48);
}
DI f32x16 zero16() { f32x16 z; for (int i = 0; i < 16; ++i) z[i] = 0.f; return z; }

#define XB_TMO      128
#define XB_XCNT(j)  (256  + 64 * (j))
#define XB_XSUB(j)  (1280 + 64 * (j))
#define XB_XGEN(j)  (2304 + 64 * (j))
#define XB_TOP      3328
#define XB_TOPGEN   3392
#define XB_WG(i)    (3456 + 64 * (i))
#define XCD_BAR_WORDS (3456 + 64 * 256)
#define XB_SPIN_CAP (1u << 18)
DI unsigned xb_ld(unsigned* p) { return __hip_atomic_load(p, __ATOMIC_RELAXED, __HIP_MEMORY_SCOPE_AGENT); }
DI unsigned xb_add(unsigned* p, unsigned v) { return __hip_atomic_fetch_add(p, v, __ATOMIC_RELAXED, __HIP_MEMORY_SCOPE_AGENT); }
DI unsigned xb_xcc_id() { return (unsigned)__builtin_amdgcn_s_getreg((3 << 11) | 20) & 0xFu; }
#define XB_SPIN(cond, bar) do { unsigned _sp = 0; while (cond) { __builtin_amdgcn_s_sleep(1); \
    if ((++_sp & 255u) == 0u) { if (xb_ld(&(bar)[XB_TMO])) break; if (_sp > XB_SPIN_CAP) { atomicAdd(&(bar)[XB_TMO], 1u); break; } } } } while (0)
DI void xcd_barrier(unsigned* bar, int wave_id) {
  asm volatile("s_waitcnt vmcnt(0)" ::: "memory");
  __syncthreads();
  if (wave_id == 0) {
    int lane = lane_id(); asm volatile("" : "+v"(lane));
    const unsigned x = xb_xcc_id();
    unsigned* slot = &bar[XB_WG(blockIdx.x)];
    unsigned nloc = 0u, nx = 0u;
    if (lane < 2) nloc = xb_ld(slot + lane);
    nx = (unsigned)__builtin_amdgcn_readlane((int)nloc, 1);
    nloc = (unsigned)__builtin_amdgcn_readlane((int)nloc, 0);
    if (nloc == 0u) {
      const unsigned G = gridDim.x * gridDim.y * gridDim.z;
      unsigned sp = 0u, c = 0u;
      for (;;) {
        c = (lane < 16) ? xb_ld(&bar[XB_XCNT(lane)]) : 0u;
        const unsigned sum = (unsigned)wave_sum((int)c);
        if (sum == G) break;
        __builtin_amdgcn_s_sleep(1);
        if ((++sp & 255u) == 0u) { if (xb_ld(&bar[XB_TMO])) break; if (sp > XB_SPIN_CAP) { if (lane == 0) atomicAdd(&bar[XB_TMO], 1u); break; } }
      }
      nx = (unsigned)__popcll(__ballot(c > 0u));
      nloc = (unsigned)__builtin_amdgcn_readlane((int)c, (int)x);
      nloc = nloc > 0u ? nloc : 1u; nx = nx > 0u ? nx : 1u;
      if (lane == 0) { __hip_atomic_store(slot, nloc, __ATOMIC_RELAXED, __HIP_MEMORY_SCOPE_AGENT); __hip_atomic_store(slot + 1, nx, __ATOMIC_RELAXED, __HIP_MEMORY_SCOPE_AGENT); }
    }
    if (lane == 0) {
      __builtin_amdgcn_s_waitcnt(0);
      const unsigned old = xb_add(&bar[XB_XSUB(x)], 1u);
      const unsigned gen = old / nloc;
      if (old + 1u == (gen + 1u) * nloc) {
        __builtin_amdgcn_fence(__ATOMIC_RELEASE, "agent");
        asm volatile("s_waitcnt vmcnt(0)" ::: "memory");
        const unsigned og = xb_add(&bar[XB_TOP], 1u);
        const unsigned tg = og / nx;
        if (og + 1u == (tg + 1u) * nx) xb_add(&bar[XB_TOPGEN], 1u);
        else XB_SPIN(xb_ld(&bar[XB_TOPGEN]) == tg, bar);
        __builtin_amdgcn_fence(__ATOMIC_ACQUIRE, "agent");
        xb_add(&bar[XB_XGEN(x)], 1u);
        asm volatile("s_waitcnt vmcnt(0)" ::: "memory");
      } else {
        XB_SPIN(xb_ld(&bar[XB_XGEN(x)]) == gen, bar);
        __builtin_amdgcn_fence(__ATOMIC_ACQUIRE, "agent");
        asm volatile("s_waitcnt vmcnt(0)" ::: "memory");
      }
    }
  }
  __syncthreads();
}

DI void phase_prep(const Params& p, int tid) {
  const int gt = blockIdx.x * 512 + tid, GT = gridDim.x * 512;
  const int lane = tid & 63;
  for (int row0 = (gt >> 6) * 2; row0 < NTOK; row0 += (GT >> 6) * 2) {
    f32x4 v[2][4];
#pragma unroll
    for (int rr = 0; rr < 2; ++rr) {
      const float* sp = xrow(p, row0 + rr);
#pragma unroll
      for (int i = 0; i < 4; ++i) v[rr][i] = __builtin_nontemporal_load((const f32x4*)(sp + i * 256 + lane * 4));
    }
#pragma unroll
    for (int rr = 0; rr < 2; ++rr) {
      float ss = 0.f;
#pragma unroll
      for (int i = 0; i < 4; ++i) ss += v[rr][i][0] * v[rr][i][0] + v[rr][i][1] * v[rr][i][1] + v[rr][i][2] * v[rr][i][2] + v[rr][i][3] * v[rr][i][3];
#pragma unroll
      for (int o = 32; o >= 1; o >>= 1) ss += __shfl_xor(ss, o);
#pragma unroll
      for (int i = 0; i < 4; ++i) *(s16x4*)(p.xb() + (size_t)(row0 + rr) * 1024 + i * 256 + lane * 4) = pack4(v[rr][i]);
      if (lane == 0) p.rinv()[row0 + rr] = rsqrtf(ss * (1.f / 1024.f) + 1e-6f);
    }
  }
  for (int i = gt; i < 4096 * 128; i += GT) {
    int n = i & 4095, kg = i >> 12;
    int sc = n;
    if (n < 1024) { const int P = n & 127; sc = (n & ~127) + 64 * ((P >> 4) & 1) + 16 * (P >> 5) + (P & 15); }
    float a[8];
    const float vmask = (n < 3912) ? 1.f : 0.f; const int scc = (sc < 3912) ? sc : 3911;
#pragma unroll
    for (int j = 0; j < 8; ++j) a[j] = __builtin_nontemporal_load(p.w_in + (size_t)(kg * 8 + j) * 3912 + scc) * p.norm_g[kg * 8 + j] * vmask;
    *(bf16x8*)(p.WtIn() + (size_t)n * 1024 + kg * 8) = pack8(a[0], a[1], a[2], a[3], a[4], a[5], a[6], a[7]);
  }
  for (int i = gt; i < 1024 * 128; i += GT) {
    int n = i % 1024, kg = i / 1024;
    float a[8];
#pragma unroll
    for (int j = 0; j < 8; ++j) a[j] = __builtin_nontemporal_load(p.w_out + (size_t)(kg * 8 + j) * 1024 + n);
    *(bf16x8*)(p.WtOut() + (size_t)n * 1024 + kg * 8) = pack8(a[0], a[1], a[2], a[3], a[4], a[5], a[6], a[7]);
  }
  for (int i = gt; i < 2112 * 64; i += GT) {
    int pos = i >> 6, k = i & 63;
    float inv = powf(10000.f, -(float)k / 64.f);
    float ang = (float)pos * inv;
    p.cosR()[i] = cosf(ang); p.sinR()[i] = sinf(ang);
  }
  for (int i = gt; i < 2112 * 8; i += GT) {
    int pos = i >> 3, k = i & 7;
    float inv = powf(500000.f, -(float)k / 8.f);
    float ang = (float)pos * inv;
    p.cosA()[i] = cosf(ang); p.sinA()[i] = sinf(ang);
  }
  for (int i = gt; i < 8 * 2048 * 2 * 8; i += GT) {
    int dg = i & 7, kvh = (i >> 3) & 1, t = (i >> 4) & 2047, b = i >> 15;
    const float* s = p.cache_k + ((size_t)(b * 2048 + t) * 2 + kvh) * 64 + dg * 8;
    const f32x4 s0 = __builtin_nontemporal_load((const f32x4*)s), s1 = __builtin_nontemporal_load((const f32x4*)(s + 4));
    *(bf16x8*)(p.kaS() + ((size_t)(b * 2 + kvh) * 2112 + t) * 64 + dg * 8) = pack8(s0[0], s0[1], s0[2], s0[3], s1[0], s1[1], s1[2], s1[3]);
  }
  for (int i = gt; i < 8 * 2 * 256 * 64; i += GT) {
    int d = i & 63, tg = (i >> 6) & 255, kvh = (i >> 14) & 1, b = i >> 15;
    float a[8];
#pragma unroll
    for (int j = 0; j < 8; ++j) a[j] = __builtin_nontemporal_load(p.cache_v + ((size_t)(b * 2048 + tg * 8 + j) * 2 + kvh) * 64 + d);
    *(bf16x8*)(p.vaTS() + ((size_t)(b * 2 + kvh) * 64 + d) * 2112 + tg * 8) = pack8(a[0], a[1], a[2], a[3], a[4], a[5], a[6], a[7]);
  }
  for (int i = gt; i < 8 * 2048 * 8; i += GT) {
    int dg = i & 7, t = (i >> 3) & 2047, b = i >> 14;
    const float* s = p.cache_kidx + (size_t)(b * 2048 + t) * 64 + dg * 8;
    const f32x4 s0 = __builtin_nontemporal_load((const f32x4*)s), s1 = __builtin_nontemporal_load((const f32x4*)(s + 4));
    *(bf16x8*)(p.kiS() + ((size_t)b * 2112 + t) * 64 + dg * 8) = pack8(s0[0], s0[1], s0[2], s0[3], s1[0], s1[1], s1[2], s1[3]);
  }
}

namespace pg8 {
constexpr int BM = 256, BK = 64, HALF = 128, HTB = HALF * BK * 2, STAGE_BYTES = 8 * HTB, NXCD = 8, WGM = 8;
DI int lds_byte(int r, int c) { const int st = (r >> 4) * 2 + (c >> 5), rr = r & 15, cc = c & 31, ob = rr * 64 + cc * 2; return st * 1024 + (ob ^ (((ob >> 9) & 1) << 5)); }
DI void stage_rc(int b, int& R, int& C) { const int st = b / 1024, sb = b % 1024, swz = sb ^ (((sb >> 9) & 1) << 5); R = (st >> 1) * 16 + swz / 64; C = (st & 1) * 32 + (swz % 64) / 2; }
struct Unit { int pm, pn; };
struct Gemm { const u16* A; const u16* Bt; int M, N, K; };
struct StaticOrder {
  int nM, nN, nwg, G, c, padtile; unsigned long long permtab;
  DI void init(int M, int N, int G_, int c_) { nM = M / BM; nN = N / BM; nwg = nM * nN; G = G_; c = c_; permtab = 0xFEDCBA9876543210ull; padtile = -1; }
  DI void map(int L, Unit& u) const {
    int wgid = L; { const int q = nwg / NXCD, r = nwg % NXCD, xcd = wgid % NXCD, off = wgid / NXCD; wgid = (xcd < r ? xcd * (q + 1) : r * (q + 1) + (xcd - r) * q) + off; }
    const int nig = WGM * nN, gid = wgid / nig, fm = gid * WGM, gsz = (nM - fm) < WGM ? (nM - fm) : WGM;
    u.pm = fm + ((wgid % nig) % gsz); u.pn = (int)((permtab >> (4 * ((wgid % nig) / gsz))) & 15ull);
  }
  DI bool next(int i, Unit& u) const {
    const long Ll = (long)i * G + c; if (Ll >= nwg) return false;
    const int L = (int)Ll;
    if (padtile < 0) { map(L, u); return true; }
    const int tail = nwg % G, base = nwg - tail;
    if (L >= base) { u.pm = L - base; u.pn = padtile; return true; }
    map(L, u);
    for (int it = 0; it < 64 && u.pn == padtile && u.pm < tail; ++it) map(base + u.pm, u);
    return true;
  }
};
template <class Epi>
DI void gemm_phase(LAS unsigned char* lds, const Gemm g, const StaticOrder& S, const Epi& E, int wave_id) {
  const int wid = wave_id; int lane = lane_id(); asm volatile("" : "+v"(lane)); const int tid = wid * 64 + lane;
  const int wr = wid >> 2, wc = wid & 3, fr = lane & 15, fq = lane >> 4;
  const int K = g.K, nt = K / BK;
  unsigned voffA[2], voffB[2];
#pragma unroll
  for (int i = 0; i < 2; ++i) { int R, C; stage_rc(tid * 16 + i * 8192, R, C); voffA[i] = (unsigned)(R * K + C) * 2u; voffB[i] = voffA[i]; }
  const size_t kstep = (size_t)(BK * 2);
  const size_t hstep = (size_t)HALF * K * 2;
  const size_t tstep = 2 * hstep;
  const unsigned ldsw = (unsigned)wid * 1024u;
  const int aoff = lds_byte(wr * 64 + fr, fq * 8), boff = lds_byte(wc * 32 + fr, fq * 8);
#define PG8_SA(b, h) (((b) * 2 + (h)) * HTB)
#define PG8_SB(b, h) ((4 + (b) * 2 + (h)) * HTB)
#define PG8_STAGE(bufoff, gbase, voff) do { _Pragma("unroll") for (int _i = 0; _i < 2; ++_i) \
    __builtin_amdgcn_global_load_lds((const unsigned*)((const char*)(gbase) + (voff)[_i]), (LAS unsigned*)(lds + (bufoff) + ldsw + _i * 8192), 16, 0, 0); } while (0)
#define PG8_LDA(dst, b, h) do { _Pragma("unroll") for (int m = 0; m < 4; ++m) _Pragma("unroll") for (int k = 0; k < 2; ++k) dst[m][k] = *(const LAS bf16x8*)(lds + PG8_SA(b, h) + aoff + m * 2048 + k * 1024); } while (0)
#define PG8_LDB(dst, b, h) do { _Pragma("unroll") for (int n = 0; n < 2; ++n) _Pragma("unroll") for (int k = 0; k < 2; ++k) dst[n][k] = *(const LAS bf16x8*)(lds + PG8_SB(b, h) + boff + n * 2048 + k * 1024); } while (0)
#define PG8_MMA(ai, bj, At, Bt) do { __builtin_amdgcn_s_setprio(1); _Pragma("unroll") for (int m = 0; m < 4; ++m) _Pragma("unroll") for (int n = 0; n < 2; ++n) _Pragma("unroll") for (int k = 0; k < 2; ++k) \
    acc[ai][bj][m][n] = __builtin_amdgcn_mfma_f32_16x16x32_bf16(Bt[n][k], At[m][k], acc[ai][bj][m][n], 0, 0, 0); __builtin_amdgcn_s_setprio(0); } while (0)
#define PG8_WAIT_V(n) asm volatile("s_waitcnt vmcnt(" #n ")" ::: "memory")
#define PG8_WAIT_L(n) asm volatile("s_waitcnt lgkmcnt(" #n ")" ::: "memory")
#define PG8_BAR __builtin_amdgcn_s_barrier()
#define PG8_SCHED __builtin_amdgcn_sched_barrier(0)
  Unit cur, nxt; int ui = 0;
  if (!S.next(0, cur)) return;
  f32x4 acc[2][2][4][2];
#pragma unroll
  for (int a = 0; a < 2; ++a)
#pragma unroll
    for (int b = 0; b < 2; ++b)
#pragma unroll
      for (int m = 0; m < 4; ++m)
#pragma unroll
        for (int n = 0; n < 2; ++n) acc[a][b][m][n] = (f32x4){0.f, 0.f, 0.f, 0.f};
  bf16x8 At[4][2], B0[2][2], B1[2][2];
  const char* cA = (const char*)g.A + (size_t)cur.pm * tstep; const char* cB = (const char*)g.Bt + (size_t)cur.pn * tstep;
  PG8_STAGE(PG8_SB(0, 0), cB, voffB); PG8_STAGE(PG8_SA(0, 0), cA, voffA); PG8_STAGE(PG8_SB(0, 1), cB + hstep, voffB); PG8_STAGE(PG8_SA(0, 1), cA + hstep, voffA);
  if (wr == 1) PG8_BAR;
  PG8_WAIT_V(4); PG8_BAR;
  PG8_STAGE(PG8_SB(1, 0), cB + kstep, voffB); PG8_STAGE(PG8_SA(1, 0), cA + kstep, voffA); PG8_STAGE(PG8_SB(1, 1), cB + hstep + kstep, voffB);
  PG8_WAIT_V(6); PG8_BAR;
  for (;;) {
    const bool has_next = S.next(ui + 1, nxt);
    const char* nA = has_next ? (const char*)g.A + (size_t)nxt.pm * tstep : cA; const char* nB = has_next ? (const char*)g.Bt + (size_t)nxt.pn * tstep : cB;
#ifndef REPK
#define REPK 1
#endif
    const bool skip1 = (S.padtile >= 0) && (cur.pn == S.padtile);
    for (int rk = 0; rk < REPK; ++rk) {
    const char* nA2 = (rk == REPK - 1) ? nA : cA; const char* nB2 = (rk == REPK - 1) ? nB : cB;
    for (int t = 0; t < nt; t += 2) {
      const bool last = (t == nt - 2);
      const char* a1 = cA + (size_t)(t + 1) * kstep;
      const char* a2 = last ? nA2 : cA + (size_t)(t + 2) * kstep; const char* b2 = last ? nB2 : cB + (size_t)(t + 2) * kstep;
      const char* a3 = a2 + kstep; const char* b3 = b2 + kstep;
      PG8_LDB(B0, 0, 0); PG8_SCHED; PG8_LDA(At, 0, 0); PG8_STAGE(PG8_SA(1, 1), a1 + hstep, voffA);
      PG8_WAIT_L(8); PG8_BAR; PG8_WAIT_L(0); PG8_MMA(0, 0, At, B0); PG8_BAR; PG8_SCHED;
      PG8_LDB(B1, 0, 1); PG8_STAGE(PG8_SB(0, 0), b2, voffB);
      PG8_BAR; PG8_WAIT_L(0); if (!skip1) PG8_MMA(0, 1, At, B1); PG8_BAR;
      PG8_LDA(At, 0, 1); PG8_STAGE(PG8_SA(0, 0), a2, voffA);
      PG8_BAR; PG8_WAIT_L(0); PG8_MMA(1, 0, At, B0); PG8_BAR; PG8_SCHED;
      PG8_STAGE(PG8_SB(0, 1), b2 + hstep, voffB);
      PG8_WAIT_V(6); PG8_BAR; if (!skip1) PG8_MMA(1, 1, At, B1); PG8_BAR;
      PG8_LDB(B0, 1, 0); PG8_SCHED; PG8_LDA(At, 1, 0); PG8_STAGE(PG8_SA(0, 1), a2 + hstep, voffA);
      PG8_WAIT_L(8); PG8_BAR; PG8_WAIT_L(0); PG8_MMA(0, 0, At, B0); PG8_BAR; PG8_SCHED;
      PG8_LDB(B1, 1, 1); PG8_STAGE(PG8_SB(1, 0), b3, voffB);
      PG8_BAR; PG8_WAIT_L(0); if (!skip1) PG8_MMA(0, 1, At, B1); PG8_BAR;
      PG8_LDA(At, 1, 1); PG8_STAGE(PG8_SA(1, 0), a3, voffA);
      PG8_BAR; PG8_WAIT_L(0); PG8_MMA(1, 0, At, B0); PG8_BAR; PG8_SCHED;
      PG8_STAGE(PG8_SB(1, 1), b3 + hstep, voffB);
      PG8_WAIT_V(6); PG8_BAR; if (!skip1) PG8_MMA(1, 1, At, B1); PG8_BAR;
    }
    }
    {
      Unit eu = cur; int ewr = wr, ewc = wc; int el = lane_id();
      asm volatile("" : "+s"(eu.pm), "+s"(eu.pn), "+s"(ewr), "+s"(ewc), "+v"(el));
      int efr = el & 15, efq = el >> 4;
#ifndef REPEPI
#define REPEPI 1
#endif
      for (int re = 0; re < REPEPI; ++re) E(acc, eu, ewr, ewc, efr, efq, re);
    }
    if (!has_next) break;
#pragma unroll
    for (int a = 0; a < 2; ++a)
#pragma unroll
      for (int b = 0; b < 2; ++b)
#pragma unroll
        for (int m = 0; m < 4; ++m)
#pragma unroll
          for (int n = 0; n < 2; ++n) acc[a][b][m][n] = (f32x4){0.f, 0.f, 0.f, 0.f};
    cur = nxt; cA = nA; cB = nB; ++ui;
  }
  PG8_WAIT_V(0);
  if (wr == 0) PG8_BAR;
  PG8_BAR;
#undef PG8_SA
#undef PG8_SB
#undef PG8_STAGE
#undef PG8_LDA
#undef PG8_LDB
#undef PG8_MMA
#undef PG8_WAIT_V
#undef PG8_WAIT_L
#undef PG8_BAR
#undef PG8_SCHED
}
}


DI unsigned hx_w(int row, int c8) { return (unsigned)(row * 256 + ((c8 ^ ((row & 15) << 1)) << 3)); }
DI unsigned hx_r(int row, int c16) { return (unsigned)(row * 256 + ((c16 ^ (row & 15)) << 4)); }
#define EPI_BAR() asm volatile("s_waitcnt lgkmcnt(0)\n\ts_barrier" ::: "memory")


struct Epi1 {
  Params p; LAS unsigned char* hl0;
  DI void make_tabs(f32x4 (&tc)[4], f32x4 (&ts)[4], f32x4 c0, f32x4 s0, f32x4 c16, f32x4 s16) const {
    tc[0] = c0; ts[0] = s0;
#pragma unroll
    for (int m = 1; m < 4; ++m) { tc[m] = tc[m - 1] * c16 - ts[m - 1] * s16; ts[m] = ts[m - 1] * c16 + tc[m - 1] * s16; }
  }
  template <int AI, int BJ>
  DI void compute(f32x4 (&acc)[2][2][4][2], const f32x4 (&tc)[4], const f32x4 (&ts)[4], int blk, int wc, int fq) const {
    if (blk < 8) {
#pragma unroll
      for (int m = 0; m < 4; ++m) {
        const f32x4 v0 = acc[AI][BJ][m][0], v1 = acc[AI][BJ][m][1];
        f32x4 o0 = v0 * tc[m] - v1 * ts[m], o1 = v1 * tc[m] + v0 * ts[m];
        if (blk >= 4) { o0 *= 0.08838834764831845f; o1 *= 0.08838834764831845f; }
        acc[AI][BJ][m][0] = o0; acc[AI][BJ][m][1] = o1;
      }
    } else if ((blk >= 12 && blk < 16) || (blk >= 22 && blk < 26)) {
#pragma unroll
      for (int m = 0; m < 4; ++m)
#pragma unroll
        for (int n = 0; n < 2; ++n) {
          f32x4 v = acc[AI][BJ][m][n];
          v[0] = siluf(v[0]); v[1] = siluf(v[1]); v[2] = siluf(v[2]); v[3] = siluf(v[3]);
          acc[AI][BJ][m][n] = v;
        }
    } else if ((blk >= 8 && blk < 12) || blk == 21 || blk == 31) {
    } else {
      const bool ropew = ((wc & 1) == 0) && !(blk == 30 && wc >= 2);
      if (ropew) {
#pragma unroll
        for (int m = 0; m < 4; ++m) {
          const f32x4 v0 = acc[AI][BJ][m][0];
          f32x4 pr;
          pr[0] = __shfl_xor(v0[0], 32); pr[1] = __shfl_xor(v0[1], 32); pr[2] = __shfl_xor(v0[2], 32); pr[3] = __shfl_xor(v0[3], 32);
          acc[AI][BJ][m][0] = (fq < 2) ? v0 * tc[m] - pr * ts[m] : v0 * tc[m] + pr * ts[m];
        }
      }
      if (blk < 20) {
        const float sc = 0.125f * 1.4426950408889634f;
#pragma unroll
        for (int m = 0; m < 4; ++m) { acc[AI][BJ][m][0] *= sc; acc[AI][BJ][m][1] *= sc; }
      }
    }
  }
  template <int AI, int BJ>
  DI void emit(f32x4 (&acc)[2][2][4][2], const pg8::Unit& u, int blk, bool samp, int wr, int wc, int fr, int fq) const {
    if (blk == 31) return;
    LAS unsigned char* hl = hl0 + wr * 16384;
    asm volatile("" : "+v"(fr), "+v"(fq));
    const int lane = fr + 16 * fq;
    const int P0 = 32 * wc + 4 * fq;
    const int R0 = u.pm * 256 + AI * 128 + wr * 64;
    int b, tb;
    if (!samp) { b = R0 >> 11; tb = R0 & 2047; } else { b = (R0 - NPROMPT) >> 6; tb = 0; }
    const bool retk = blk < 8;
    const bool hasT = (blk >= 4 && blk < 12) || blk == 21;
    const bool hasN = !(blk >= 8 && blk < 12) && blk != 21;
    if (blk == 20 || blk == 21) {
      float* ob = samp ? p.out + (blk == 20 ? OUT_KS : OUT_VS) + (unsigned)(R0 - NPROMPT) * 128u : p.out + (blk == 20 ? OUT_KP : OUT_VP) + (unsigned)R0 * 128u;
#pragma unroll
      for (int m = 0; m < 4; ++m) {
        float* o2 = ob + (unsigned)(16 * m + fr) * 128u + P0;
        __builtin_nontemporal_store(acc[AI][BJ][m][0], (f32x4*)o2); __builtin_nontemporal_store(acc[AI][BJ][m][1], (f32x4*)(o2 + 16));
      }
    } else if (blk == 30) {
      float* ob = samp ? p.out + OUT_KIS + (unsigned)(R0 - NPROMPT) * 64u : p.out + OUT_KIP + (unsigned)R0 * 64u;
      float* wb = p.wi() + (unsigned)R0 * 8u;
#pragma unroll
      for (int m = 0; m < 4; ++m) {
        if (wc < 2) {
          float* o2 = ob + (unsigned)(16 * m + fr) * 64u + P0;
          __builtin_nontemporal_store(acc[AI][BJ][m][0], (f32x4*)o2); __builtin_nontemporal_store(acc[AI][BJ][m][1], (f32x4*)(o2 + 16));
        } else if (wc == 2 && fq < 2) {
          *(f32x4*)(wb + (unsigned)(16 * m + fr) * 8u + 4 * fq) = acc[AI][BJ][m][0] * 0.044194173824159216f;
        }
      }
    }
    if (hasN) {
#pragma unroll
      for (int m = 0; m < 4; ++m)
#pragma unroll
        for (int n = 0; n < 2; ++n) {
          const int c8 = retk ? (16 * n + 4 * wc + fq) : (8 * wc + 4 * n + fq);
          *(LAS s16x4*)(hl + hx_w(16 * m + fr, c8)) = pack4(acc[AI][BJ][m][n]);
        }
      u16* nb; unsigned pitch = 512u, hstr = 0u, cm = 15u;
      if (blk < 4) nb = p.qr() + (unsigned)R0 * 512u + (blk & 3) * 128;
      else if (blk < 8) nb = p.kr() + (unsigned)R0 * 512u + (blk & 3) * 128;
      else if (blk < 16) { nb = p.gate() + (unsigned)R0 * 1024u + (blk - 12) * 128; pitch = 1024u; }
      else if (blk < 20) nb = p.qa() + (unsigned)R0 * 512u + (blk - 16) * 128;
      else if (blk == 20) { nb = samp ? p.kaS() + ((unsigned)(b * 2) * 2112u + 2048u) * 64u : p.kaP() + ((unsigned)(b * 2) * 2048u + tb) * 64u; pitch = 64u; hstr = samp ? 2112u * 64u : 2048u * 64u; cm = 7u; }
      else if (blk < 26) { nb = p.gate() + (unsigned)R0 * 1024u + 512 + (blk - 22) * 128; pitch = 1024u; }
      else if (blk < 30) nb = p.qi() + (unsigned)R0 * 512u + (blk - 26) * 128;
      else { nb = samp ? p.kiS() + ((unsigned)b * 2112u + 2048u) * 64u : p.kiP() + ((unsigned)b * 2048u + tb) * 64u; pitch = 64u; cm = 7u; }
      EPI_BAR();
      const unsigned c16 = lane & 15;
      const unsigned loff = (c16 >> 3) * hstr + (c16 & cm) * 8u;
#pragma unroll
      for (int i = 0; i < 4; ++i) {
        const int row = 16 * wc + 4 * i + (lane >> 4);
        const bf16x8 v = *(const LAS bf16x8*)(hl + hx_r(row, c16));
        if (blk != 30 || c16 < 8) *(bf16x8*)(nb + (unsigned)row * pitch + loff) = v;
      }
      EPI_BAR();
    }
    if (hasT) {
      const float l2g = log2gamma(blk & 3);
#pragma unroll
      for (int m = 0; m < 4; ++m) {
        const int tok = 16 * m + fr;
        const float dec = (blk < 8) ? exp2f((float)(63 - tok) * l2g) : 1.f;
#pragma unroll
        for (int n = 0; n < 2; ++n) {
          const int fb = retk ? (64 * n + 16 * wc + 4 * fq) : (32 * wc + 16 * n + 4 * fq);
#pragma unroll
          for (int j = 0; j < 4; ++j) {
            const int f = fb + j;
            *(LAS u16*)(hl + f * 128 + ((((tok >> 3) ^ (f >> 2)) & 7) << 4) + (tok & 7) * 2) = f2bf(acc[AI][BJ][m][n][j] * dec);
          }
        }
      }
      u16* tbp; unsigned fstr;
      if (blk < 12) {
        u16* base = (blk < 8) ? p.krT() : p.vrT();
        const unsigned bh = (unsigned)(b * 4 + (blk & 3)) * 128u;
        tbp = samp ? base + 64u * 128u * 2048u + bh * 64u : base + bh * 2048u + tb;
        fstr = samp ? 64u : 2048u;
      } else {
        tbp = samp ? p.vaTS() + (unsigned)b * 128u * 2112u + 2048u : p.vaTP() + (unsigned)b * 128u * 2048u + tb;
        fstr = samp ? 2112u : 2048u;
      }
      EPI_BAR();
#pragma unroll
      for (int i = 0; i < 4; ++i) {
        const int f = 32 * wc + 8 * i + (lane >> 3), ch = lane & 7;
        const bf16x8 v = *(const LAS bf16x8*)(hl + f * 128 + (((ch ^ (f >> 2)) & 7) << 4));
        *(bf16x8*)(tbp + (unsigned)f * fstr + ch * 8) = v;
      }
      EPI_BAR();
    }
  }
  DI void operator()(f32x4 (&acc)[2][2][4][2], const pg8::Unit& u, int wr, int wc, int fr, int fq, int re) const {
    const bool samp = (u.pm * 256 >= NPROMPT);
    const int tclass = (u.pn < 4) ? 1 : ((u.pn == 8 || u.pn == 9 || u.pn == 10 || u.pn >= 13) ? 2 : 0);
    const int blk0 = u.pn * 2, blk1 = u.pn * 2 + 1;
    float rvv[2][4];
#pragma unroll
    for (int ai = 0; ai < 2; ++ai)
#pragma unroll
      for (int m = 0; m < 4; ++m) rvv[ai][m] = (1.f / REPK) * p.rinv()[u.pm * 256 + ai * 128 + wr * 64 + 16 * m + fr];
    const float* cb = (tclass == 1) ? p.cosR() : p.cosA();
    const float* sb = (tclass == 1) ? p.sinR() : p.sinA();
    const int pitch = (tclass == 1) ? 64 : 8;
    const int coff = (tclass == 1) ? (16 * wc + 4 * fq) : (4 * (fq & 1));
    const int rowg0 = u.pm * 256 + wr * 64 + fr;
    const int pos0 = samp ? 2048 + ((rowg0 - NPROMPT) & 63) : (rowg0 & 2047);
    const f32x4 c0 = *(const f32x4*)(cb + pos0 * pitch + coff), s0 = *(const f32x4*)(sb + pos0 * pitch + coff);
    const f32x4 c16 = *(const f32x4*)(cb + 16 * pitch + coff), s16 = *(const f32x4*)(sb + 16 * pitch + coff);
    f32x4 tc[4], ts[4];
#pragma unroll
    for (int ai = 0; ai < 2; ++ai)
#pragma unroll
      for (int m = 0; m < 4; ++m)
#pragma unroll
        for (int bj = 0; bj < 2; ++bj)
#pragma unroll
          for (int n = 0; n < 2; ++n) acc[ai][bj][m][n] *= rvv[ai][m];
    make_tabs(tc, ts, c0, s0, c16, s16);
    compute<0, 0>(acc, tc, ts, blk0, wc, fq);
    compute<0, 1>(acc, tc, ts, blk1, wc, fq);
    {
      const f32x4 c32 = c16 * c16 - s16 * s16, s32 = 2.f * s16 * c16;
      const f32x4 c64 = c32 * c32 - s32 * s32, s64 = 2.f * s32 * c32;
      const f32x4 c80 = c64 * c16 - s64 * s16, s80 = s64 * c16 + c64 * s16;
      const f32x4 c1 = samp ? tc[0] : tc[3] * c80 - ts[3] * s80, s1 = samp ? ts[0] : ts[3] * c80 + tc[3] * s80;
      make_tabs(tc, ts, c1, s1, c16, s16);
    }
    compute<1, 0>(acc, tc, ts, blk0, wc, fq);
    compute<1, 1>(acc, tc, ts, blk1, wc, fq);
    emit<0, 0>(acc, u, blk0, samp, wr, wc, fr, fq);
    emit<0, 1>(acc, u, blk1, samp, wr, wc, fr, fq);
    emit<1, 0>(acc, u, blk0, samp, wr, wc, fr, fq);
    emit<1, 1>(acc, u, blk1, samp, wr, wc, fr, fq);
  }
};

struct Epi2 {
  Params p; unsigned char* hl;
  DI void operator()(f32x4 (&acc)[2][2][4][2], const pg8::Unit& u, int wr, int wc, int fr, int fq, int re) const {
    u16* z = p.gate();
    const int lane = fr + 16 * fq;
#pragma unroll
    for (int ai = 0; ai < 2; ++ai)
#pragma unroll
      for (int bj = 0; bj < 2; ++bj) {
#pragma unroll
        for (int m = 0; m < 4; ++m)
#pragma unroll
          for (int n = 0; n < 2; ++n)
            *(s16x4*)(hl + hx_w(16 * m + fr, 8 * wc + 4 * n + fq)) = pack4(acc[ai][bj][m][n] * (1.f / REPK));
        EPI_BAR();
        const unsigned R0 = u.pm * 256 + ai * 128 + wr * 64;
        const unsigned cb = u.pn * 256 + bj * 128;
#pragma unroll
        for (int i = 0; i < 4; ++i) {
          const int row = 16 * wc + 4 * i + (lane >> 4), c16 = lane & 15;
          const bf16x8 v = *(const bf16x8*)(hl + hx_r(row, c16));
          *(bf16x8*)(z + (R0 + row) * 1024u + cb + c16 * 8) = v;
        }
        EPI_BAR();
      }
  }
};

DI void ret_kv_item(const Params& p, int item, int tid) {
  const int lane = tid & 63, w = tid >> 6, r = lane & 31, hh = lane >> 5;
  const u16 *kT, *vT; int T, c;
  if (item < 2048) { const int bh = item >> 5; c = item & 31; T = 2048; kT = p.krT() + (size_t)bh * 128 * 2048; vT = p.vrT() + (size_t)bh * 128 * 2048; }
  else { const int bh = item - 2048; c = 0; T = 64; kT = p.krT() + (size_t)64 * 128 * 2048 + (size_t)bh * 128 * 64; vT = p.vrT() + (size_t)64 * 128 * 2048 + (size_t)bh * 128 * 64; }
  const int e0 = (w & 1) * 64, d0 = (w >> 1) * 64;
  f32x16 acc[2][2];
  acc[0][0] = zero16(); acc[0][1] = zero16(); acc[1][0] = zero16(); acc[1][1] = zero16();
#pragma unroll
  for (int ks = 0; ks < 4; ++ks) {
    bf16x8 a0 = ldg8(vT + (size_t)(e0 + r) * T + c * 64 + ks * 16 + hh * 8);
    bf16x8 a1 = ldg8(vT + (size_t)(e0 + 32 + r) * T + c * 64 + ks * 16 + hh * 8);
    bf16x8 b0 = ldg8(kT + (size_t)(d0 + r) * T + c * 64 + ks * 16 + hh * 8);
    bf16x8 b1 = ldg8(kT + (size_t)(d0 + 32 + r) * T + c * 64 + ks * 16 + hh * 8);
    acc[0][0] = MFMA32(a0, b0, acc[0][0]);
    acc[0][1] = MFMA32(a0, b1, acc[0][1]);
    acc[1][0] = MFMA32(a1, b0, acc[1][0]);
    acc[1][1] = MFMA32(a1, b1, acc[1][1]);
  }
  u16* o = (u16*)p.kvT() + (size_t)item * 16384;
#pragma unroll
  for (int a = 0; a < 2; ++a)
#pragma unroll
    for (int b = 0; b < 2; ++b)
#pragma unroll
      for (int i = 0; i < 16; ++i)
        o[(e0 + a * 32 + crow(i, hh)) * 128 + d0 + b * 32 + r] = f2bf(acc[a][b][i]);
}

template <int NS>
DI void select_query(const u16* krow, int nj, int lane, u64* dst) {
  unsigned key[NS];
#pragma unroll
  for (int j = 0; j < NS; ++j) { const unsigned k = krow[j * 64 + lane]; key[j] = (j < nj) ? k : 0u; }
  constexpr int NP = (NS + 1) / 2;
  unsigned pk[NP];
#pragma unroll
  for (int i = 0; i < NP; ++i) pk[i] = key[2 * i] | ((2 * i + 1 < NS ? key[2 * i + 1] : 0u) << 16);
  unsigned prefix = 0;
  int cntp = 0;
  const unsigned ones = 0x00010001u;
  for (int bit = 15; bit >= 0; --bit) {
    const unsigned cand = prefix | (1u << bit);
    const unsigned c1 = cand - 1u;
    const unsigned cv = c1 | (c1 << 16);
    unsigned acc0 = 0, acc1 = 0;
#pragma unroll
    for (int i = 0; i < NP; ++i) {
      unsigned d, m;
      asm("v_pk_sub_u16 %0, %1, %2 clamp" : "=v"(d) : "v"(pk[i]), "v"(cv));
      asm("v_pk_min_u16 %0, %1, %2" : "=v"(m) : "v"(d), "v"(ones));
      if (i & 1) acc1 += m; else acc0 += m;
    }
    const unsigned a = acc0 + acc1;
    const int cnt = wave_sum((int)((a & 0xffffu) + (a >> 16)));
    if (cnt >= 256) { prefix = cand; cntp = cnt; }
    if (cnt == 256) break;
  }
  int wlo = 0, whi = 0;
  if (cntp == 256) {
#pragma unroll
    for (int j = 0; j < NS; ++j) {
      const u64 sm = __ballot(key[j] >= prefix);
      if (lane == j) { wlo = (int)(unsigned)sm; whi = (int)(unsigned)(sm >> 32); }
    }
  } else {
    int cgt = 0;
#pragma unroll
    for (int j = 0; j < NS; ++j) cgt += (key[j] > prefix) ? 1 : 0;
    cgt = wave_sum(cgt);
    const int rneed = 256 - cgt;
    int running = 0;
    const u64 lt = (1ull << lane) - 1ull;
#pragma unroll
    for (int j = 0; j < NS; ++j) {
      const bool eq = key[j] == prefix;
      const u64 em = __ballot(eq);
      const int rank = running + __popcll(em & lt);
      const bool sel = (key[j] > prefix) || (eq && rank < rneed);
      const u64 sm = __ballot(sel);
      if (lane == j) { wlo = (int)(unsigned)sm; whi = (int)(unsigned)(sm >> 32); }
      running += __popcll(em);
    }
  }
  if (lane < nj) __builtin_nontemporal_store(((u64)(unsigned)whi << 32) | (u64)(unsigned)wlo, dst + lane);
}

DI void idx_item(const Params& p, unsigned char* lds, int tid, bool samp, int b, int grp) {
  const int lane = tid & 63, w = tid >> 6;
  const int t0 = grp * 16;
  int L, g0; const u16* ki;
  if (!samp) { const int c = t0 >> 6; L = (c + 1) * 64; g0 = b * 2048 + t0; ki = p.kiP() + (size_t)b * 2048 * 64; }
  else { L = 2112; g0 = NPROMPT + b * 64 + t0; ki = p.kiS() + (size_t)b * 2112 * 64; }
  const int nj = L >> 6;
  if (L <= 256) {
    for (int qq = 0; qq < 4; ++qq) {
      const int q = w * 4 + qq;
      if (lane < nj) p.maskbits()[(size_t)(g0 + q) * 33 + lane] = ~0ull;
    }
    return;
  }
  u16* keys = (u16*)lds;
#ifndef REPMF
#define REPMF 1
#endif
#ifndef REPSEL
#define REPSEL 1
#endif
#ifndef REPKV
#define REPKV 1
#endif
  for (int rmf = 0; rmf < REPMF; ++rmf) {
    const int qn = lane & 15, quad = lane >> 4;
    bf16x8 qf[8][2];
    float wv[8];
#pragma unroll
    for (int h = 0; h < 8; ++h) {
      qf[h][0] = ldg8(p.qi() + (size_t)(g0 + qn) * 512 + h * 64 + quad * 8);
      qf[h][1] = ldg8(p.qi() + (size_t)(g0 + qn) * 512 + h * 64 + 32 + quad * 8);
      wv[h] = p.wi()[(size_t)(g0 + qn) * 8 + h];
    }
    bf16x8 A0[4], A1[4], N0[4], N1[4];
#pragma unroll
    for (int i = 0; i < 4; ++i) {
      const int kt = w + 4 * i;
      A0[i] = ldg8(ki + (size_t)(kt * 16 + qn) * 64 + quad * 8);
      A1[i] = ldg8(ki + (size_t)(kt * 16 + qn) * 64 + 32 + quad * 8);
    }
    for (int base = 0; base < nj; base += 4) {
#pragma unroll
      for (int i = 0; i < 4; ++i) {
        const int t = min(base + 4 + i, nj - 1);
        const int kt = w + 4 * t;
        N0[i] = ldg8(ki + (size_t)(kt * 16 + qn) * 64 + quad * 8);
        N1[i] = ldg8(ki + (size_t)(kt * 16 + qn) * 64 + 32 + quad * 8);
      }
#pragma unroll
      for (int i = 0; i < 4; ++i) {
        const int t = base + i;
        if (t < nj) {
          const int kt = w + 4 * t;
          float idx[4] = {0.f, 0.f, 0.f, 0.f};
#pragma unroll
          for (int h = 0; h < 8; ++h) {
            f32x4 acc = {0.f, 0.f, 0.f, 0.f};
            acc = MFMA16(A0[i], qf[h][0], acc);
            acc = MFMA16(A1[i], qf[h][1], acc);
#pragma unroll
            for (int e = 0; e < 4; ++e) idx[e] += fmaxf(acc[e], 0.f) * wv[h];
          }
          s16x4 kv;
#pragma unroll
          for (int e = 0; e < 4; ++e) {
            _Float16 hv = (_Float16)idx[e];
            u16 bits = __builtin_bit_cast(u16, hv);
            kv[e] = (short)((bits & 0x8000) ? (u16)~bits : (u16)(bits | 0x8000));
          }
          *(s16x4*)(keys + qn * KPITCH + kt * 16 + quad * 4) = kv;
        }
      }
#pragma unroll
      for (int i = 0; i < 4; ++i) { A0[i] = N0[i]; A1[i] = N1[i]; }
    }
  }
  __syncthreads();
  for (int qq = 0; qq < 4 * REPSEL; ++qq) {
    const int q = w * 4 + (qq & 3);
    const u16* krow = keys + q * KPITCH;
    u64* dst = p.maskbits() + (size_t)(g0 + q) * 33;
    if (nj <= 8) select_query<8>(krow, nj, lane, dst);
    else if (nj <= 16) select_query<16>(krow, nj, lane, dst);
    else if (nj <= 24) select_query<24>(krow, nj, lane, dst);
    else select_query<33>(krow, nj, lane, dst);
  }
  __syncthreads();
}

DI void scan_item(const Params& p, int item, int tid) {
  if (item < 1024) {
    const int bh = item >> 4, slab = item & 15;
    const int idx = slab * 1024 + tid * 4;
    const int h = bh & 3;
    const float cd = exp2f(64.f * log2gamma(h));
    f32x4 s = {0.f, 0.f, 0.f, 0.f};
    s16x4 kraw[2][8];
#pragma unroll
    for (int i = 0; i < 8; ++i) kraw[0][i] = __builtin_nontemporal_load((const s16x4*)((const u16*)p.kvT() + (size_t)(bh * 32 + i) * 16384 + idx));
#pragma unroll
    for (int b8 = 0; b8 < 4; ++b8) {
      if (b8 < 3) {
#pragma unroll
        for (int i = 0; i < 8; ++i) kraw[(b8 + 1) & 1][i] = __builtin_nontemporal_load((const s16x4*)((const u16*)p.kvT() + (size_t)(bh * 32 + (b8 + 1) * 8 + i) * 16384 + idx));
      }
#pragma unroll
      for (int i = 0; i < 8; ++i) {
        __builtin_nontemporal_store(pack4(s), (s16x4*)(p.sprevT() + (size_t)(bh * 32 + b8 * 8 + i) * 16384 + idx));
        f32x4 kv;
#pragma unroll
        for (int j = 0; j < 4; ++j) kv[j] = __uint_as_float(((unsigned)(u16)kraw[b8 & 1][i][j]) << 16);
        s = s * cd + kv;
      }
    }
    const int e = idx >> 7, d = idx & 127;
    float* o = p.out + OUT_STP + (size_t)bh * 16384;
#pragma unroll
    for (int j = 0; j < 4; ++j) o[(d + j) * 128 + e] = s[j];
  } else {
    const int it = item - 1024;
    const int bh = it >> 4, slab = it & 15;
    const int idx = slab * 1024 + tid * 4;
    const int h = bh & 3;
    const float cd = exp2f(64.f * log2gamma(h));
    const int e = idx >> 7, d = idx & 127;
    const float* s0 = p.state_ret + (size_t)bh * 16384;
    f32x4 s;
#pragma unroll
    for (int j = 0; j < 4; ++j) s[j] = s0[(d + j) * 128 + e];
    const size_t base = (size_t)(2048 + bh) * 16384 + idx;
    s16x4 o = pack4(s);
    *(s16x4*)(p.sprevT() + base) = o;
    const s16x4 kk = *(const s16x4*)((const u16*)p.kvT() + base);
    f32x4 kv;
#pragma unroll
    for (int j = 0; j < 4; ++j) kv[j] = __uint_as_float(((unsigned)(u16)kk[j]) << 16);
    s = s * cd + kv;
    float* oo = p.out + OUT_STS + (size_t)bh * 16384;
#pragma unroll
    for (int j = 0; j < 4; ++j) oo[(d + j) * 128 + e] = s[j];
  }
}

DI void attn_item(const Params& p, unsigned char* lds, int tid, bool samp, int b, int c, int kvh, int qh, unsigned char* lds_blk, int tid512) {
  const int lane = tid & 63, w = tid >> 6, r = lane & 31, hh = lane >> 5;
  const int T = samp ? 2112 : 2048;
  const int nkt = samp ? 33 : c + 1;
  const int g0 = (samp ? NPROMPT + b * 64 : b * 2048 + c * 64) + qh * 32;
  const u16* K = samp ? p.kaS() + (size_t)(b * 2 + kvh) * 2112 * 64 : p.kaP() + (size_t)(b * 2 + kvh) * 2048 * 64;
  const u16* VT = samp ? p.vaTS() + (size_t)(b * 2 + kvh) * 64 * 2112 : p.vaTP() + (size_t)(b * 2 + kvh) * 64 * 2048;
  const int head = kvh * 4 + w;
  u16* KV0 = (u16*)(lds_blk + 2 * HALF_LDS - 4 * 9216);
  u64* mL = (u64*)lds;
  {
    u64 mv[5];
#pragma unroll
    for (int i = 0; i < 5; ++i) { const int ix = tid + 256 * i; mv[i] = __builtin_nontemporal_load(p.maskbits() + (size_t)g0 * 33 + (ix < 32 * 33 ? ix : 32 * 33 - 1)); }
#pragma unroll
    for (int i = 0; i < 5; ++i) { const int ix = tid + 256 * i; if (ix < 32 * 33) mL[ix] = mv[i]; }
  }
  bf16x8 qf[4];
#pragma unroll
  for (int ks = 0; ks < 4; ++ks) qf[ks] = ldg8(p.qa() + (size_t)(g0 + r) * 512 + head * 64 + ks * 16 + hh * 8);
  const u16* grow = p.gate() + (size_t)(g0 + r) * 1024 + 512 + head * 64;
  s16x4 gvv[2][4];
#pragma unroll
  for (int dt = 0; dt < 2; ++dt)
#pragma unroll
    for (int q4 = 0; q4 < 4; ++q4) gvv[dt][q4] = *(const s16x4*)(grow + dt * 32 + 8 * q4 + 4 * hh);
  f32x16 O[2];
  O[0] = zero16(); O[1] = zero16();
  float mrun = -1e30f, lrun = 0.f;
  const int lrow = tid512 >> 3, lch = tid512 & 7;
  const int loff = lrow * 72 + lch * 8;
  bf16x8 pk0, pv0, nk0, nv0;
  {
    const bf16x8 k0 = ldg8(K + (size_t)(lrow)*64 + lch * 8), v0 = ldg8(VT + (size_t)(lrow)*T + lch * 8);
    const int t1 = nkt > 1 ? 1 : 0, t2 = nkt > 2 ? 2 : (nkt - 1);
    pk0 = ldg8(K + (size_t)(t1 * 64 + lrow) * 64 + lch * 8); pv0 = ldg8(VT + (size_t)(lrow)*T + t1 * 64 + lch * 8);
    nk0 = ldg8(K + (size_t)(t2 * 64 + lrow) * 64 + lch * 8); nv0 = ldg8(VT + (size_t)(lrow)*T + t2 * 64 + lch * 8);
    *(bf16x8*)(KV0 + loff) = k0;
    *(bf16x8*)(KV0 + 64 * 72 + loff) = v0;
  }
  __syncthreads();
  for (int kt = 0; kt < nkt; ++kt) {
    if (kt + 1 < nkt) {
      u16* nb = KV0 + ((kt + 1) & 1) * (2 * 64 * 72);
      *(bf16x8*)(nb + loff) = pk0;
      *(bf16x8*)(nb + 64 * 72 + loff) = pv0;
    }
    pk0 = nk0; pv0 = nv0;
    {
      const int t3 = (kt + 3 < nkt) ? kt + 3 : nkt - 1;
      nk0 = ldg8(K + (size_t)(t3 * 64 + lrow) * 64 + lch * 8);
      nv0 = ldg8(VT + (size_t)(lrow)*T + t3 * 64 + lch * 8);
    }
    const u16* Ks = KV0 + (kt & 1) * (2 * 64 * 72);
    const u16* Vs = Ks + 64 * 72;
    f32x16 S[2];
    __builtin_amdgcn_s_setprio(1);
#pragma unroll
    for (int st = 0; st < 2; ++st) {
      S[st] = zero16();
#pragma unroll
      for (int ks = 0; ks < 4; ++ks) {
        bf16x8 kf = *(const bf16x8*)(Ks + (st * 32 + r) * 72 + ks * 16 + hh * 8);
        S[st] = MFMA32(kf, qf[ks], S[st]);
      }
    }
    __builtin_amdgcn_s_setprio(0);
    const u64 W = mL[r * 33 + kt];
    const int wl = (int)(((unsigned)W) >> (4 * hh)), wh = (int)(((unsigned)(W >> 32)) >> (4 * hh));
    float mx = fmaxf(S[0][0], S[1][0]);
#pragma unroll
    for (int i = 1; i < 16; ++i) mx = fmaxf(mx, fmaxf(S[0][i], S[1][i]));
    mx = fmaxf(mx, __shfl_xor(mx, 32));
    const float mn = fmaxf(mrun, mx);
    const float alpha = __builtin_amdgcn_exp2f(mrun - mn);
    const bool resc = __any(mn != mrun);
    mrun = mn;
    float ls = 0.f;
#pragma unroll
    for (int st = 0; st < 2; ++st)
#pragma unroll
      for (int i = 0; i < 16; ++i) {
        const int keep = __builtin_amdgcn_sbfe(st ? wh : wl, (i & 3) + 8 * (i >> 2), 1);
        const float pvv = __int_as_float(__float_as_int(__builtin_amdgcn_exp2f(S[st][i] - mn)) & keep);
        S[st][i] = pvv;
        ls += pvv;
      }
    lrun = lrun * alpha + ls;
    if (resc) {
#pragma unroll
      for (int dt = 0; dt < 2; ++dt)
#pragma unroll
        for (int i = 0; i < 16; ++i) O[dt][i] *= alpha;
    }
#pragma unroll
    for (int st = 0; st < 2; ++st)
#pragma unroll
      for (int s2 = 0; s2 < 2; ++s2) {
        bf16x8 pf = pack8(S[st][8 * s2 + 0], S[st][8 * s2 + 1], S[st][8 * s2 + 2], S[st][8 * s2 + 3],
                          S[st][8 * s2 + 4], S[st][8 * s2 + 5], S[st][8 * s2 + 6], S[st][8 * s2 + 7]);
#pragma unroll
        for (int dt = 0; dt < 2; ++dt) {
          s16x4 lo = *(const s16x4*)(Vs + (dt * 32 + r) * 72 + st * 32 + 16 * s2 + 4 * hh);
          s16x4 hi = *(const s16x4*)(Vs + (dt * 32 + r) * 72 + st * 32 + 16 * s2 + 8 + 4 * hh);
          bf16x8 vf = __builtin_shufflevector(lo, hi, 0, 1, 2, 3, 4, 5, 6, 7);
          O[dt] = MFMA32(vf, pf, O[dt]);
        }
      }
    __syncthreads();
  }
  {
    float lt = lrun + __shfl_xor(lrun, 32);
    const float inv = 1.f / fmaxf(lt, 1e-30f);
    u16* mrow = p.mix() + (size_t)(g0 + r) * 1024 + 512 + head * 64;
#pragma unroll
    for (int dt = 0; dt < 2; ++dt)
#pragma unroll
      for (int q4 = 0; q4 < 4; ++q4) {
        const int d = dt * 32 + 8 * q4 + 4 * hh;
        f32x4 of;
#pragma unroll
        for (int j = 0; j < 4; ++j) {
          const float gf = __uint_as_float(((unsigned)(u16)gvv[dt][q4][j]) << 16);
          of[j] = O[dt][q4 * 4 + j] * inv * gf;
        }
        *(s16x4*)(mrow + d) = pack4(of);
      }
  }
  __syncthreads();
}

DI void ret_out_item(const Params& p, unsigned char* lds, int item, int tid) {
  const int lane = tid & 63, w = tid >> 6, r = lane & 31, hh = lane >> 5;
  int bh, c, T, g0; const u16* vT;
  if (item < 2048) { bh = item >> 5; c = item & 31; T = 2048; g0 = (bh >> 2) * 2048 + c * 64; vT = p.vrT() + (size_t)bh * 128 * 2048; }
  else { bh = item - 2048; c = 0; T = 64; g0 = NPROMPT + (bh >> 2) * 64; vT = p.vrT() + (size_t)64 * 128 * 2048 + (size_t)bh * 128 * 64; }
  const int h = bh & 3;
  const float l2g = log2gamma(h);
  const int nt = w & 1, eh = w >> 1;
  const int n = nt * 32 + r;
  const u16* sp = p.sprevT() + (size_t)item * 16384;
  bf16x8 qf[8], kf[8], sf[8];
  s16x4 vlo[2][2][2], vhi[2][2][2];
#pragma unroll
  for (int ks = 0; ks < 8; ++ks) qf[ks] = ldg8(p.qr() + (size_t)(g0 + n) * 512 + h * 128 + ks * 16 + hh * 8);
#pragma unroll
  for (int ks = 0; ks < 8; ++ks) kf[ks] = ldg8(p.kr() + (size_t)(g0 + r) * 512 + h * 128 + ks * 16 + hh * 8);
#pragma unroll
  for (int et = 0; et < 2; ++et)
#pragma unroll
    for (int mt = 0; mt < 2; ++mt)
#pragma unroll
      for (int s2 = 0; s2 < 2; ++s2) {
        const u16* vp = vT + (size_t)((2 * eh + et) * 32 + r) * T + c * 64 + mt * 32 + 16 * s2 + 4 * hh;
        vlo[et][mt][s2] = ldg4(vp); vhi[et][mt][s2] = ldg4(vp + 8);
      }
  __builtin_amdgcn_sched_barrier(0);
  bf16x8 pf[2][2];
#pragma unroll
  for (int mt = 0; mt < 2; ++mt) {
    f32x16 S = zero16();
#pragma unroll
    for (int ks = 0; ks < 8; ++ks) S = MFMA32(kf[ks], qf[ks], S);
    if (mt == 0) {
#pragma unroll
      for (int ks = 0; ks < 8; ++ks) kf[ks] = ldg8(p.kr() + (size_t)(g0 + 32 + r) * 512 + h * 128 + ks * 16 + hh * 8);
#pragma unroll
      for (int ks = 0; ks < 8; ++ks) sf[ks] = ldg8(sp + (size_t)((2 * eh) * 32 + r) * 128 + ks * 16 + hh * 8);
      __builtin_amdgcn_sched_barrier(0);
    }
#pragma unroll
    for (int i = 0; i < 16; ++i) {
      const int m = mt * 32 + crow(i, hh);
      const int dd = n > m ? n - m : m - n;
      S[i] *= exp2f((float)dd * l2g);
    }
    pf[mt][0] = pack8(S[0], S[1], S[2], S[3], S[4], S[5], S[6], S[7]);
    pf[mt][1] = pack8(S[8], S[9], S[10], S[11], S[12], S[13], S[14], S[15]);
  }
  const float fs = exp2f((float)(n + 1) * l2g);
  f32x16 tot[2];
  float ss = 0.f;
#pragma unroll
  for (int et = 0; et < 2; ++et) {
    f32x16 Oi = zero16(), X = zero16();
#pragma unroll
    for (int ks = 0; ks < 8; ++ks) X = MFMA32(sf[ks], qf[ks], X);
    if (et == 0) {
#pragma unroll
      for (int ks = 0; ks < 8; ++ks) sf[ks] = ldg8(sp + (size_t)((2 * eh + 1) * 32 + r) * 128 + ks * 16 + hh * 8);
      __builtin_amdgcn_sched_barrier(0);
    }
#pragma unroll
    for (int mt = 0; mt < 2; ++mt)
#pragma unroll
      for (int s2 = 0; s2 < 2; ++s2) {
        bf16x8 vf = __builtin_shufflevector(vlo[et][mt][s2], vhi[et][mt][s2], 0, 1, 2, 3, 4, 5, 6, 7);
        Oi = MFMA32(vf, pf[mt][s2], Oi);
      }
#pragma unroll
    for (int i = 0; i < 16; ++i) { const float t = Oi[i] + X[i] * fs; tot[et][i] = t; ss += t * t; }
  }
  ss += __shfl_xor(ss, 32);
  float* red = (float*)lds;
  __syncthreads();
  if (hh == 0) red[w * 32 + r] = ss;
  __syncthreads();
  const float tsum = red[w * 32 + r] + red[(w ^ 2) * 32 + r];
  const float rinv = rsqrtf(tsum * (1.f / 128.f) + 1e-6f);
  const u16* grow = p.gate() + (size_t)(g0 + n) * 1024 + h * 128;
  u16* mrow = p.mix() + (size_t)(g0 + n) * 1024 + h * 128;
  s16x4 gvv[2][4];
  f32x4 ggv[2][4];
#pragma unroll
  for (int et = 0; et < 2; ++et)
#pragma unroll
    for (int q4 = 0; q4 < 4; ++q4) {
      const int e = (2 * eh + et) * 32 + 8 * q4 + 4 * hh;
      gvv[et][q4] = *(const s16x4*)(grow + e);
      ggv[et][q4] = *(const f32x4*)(p.ret_gn_g + h * 128 + e);
    }
#pragma unroll
  for (int et = 0; et < 2; ++et)
#pragma unroll
    for (int q4 = 0; q4 < 4; ++q4) {
      const int e = (2 * eh + et) * 32 + 8 * q4 + 4 * hh;
      f32x4 of;
#pragma unroll
      for (int j = 0; j < 4; ++j) {
        const float gf = __uint_as_float(((unsigned)(u16)gvv[et][q4][j]) << 16);
        of[j] = tot[et][q4 * 4 + j] * rinv * ggv[et][q4][j] * gf;
      }
      *(s16x4*)(mrow + e) = pack4(of);
    }
}

DI void phase_final(const Params& p, int tid) {
  const int gt = blockIdx.x * 512 + tid, GT = gridDim.x * 512;
  const int lane = tid & 63;
  for (int row0 = (gt >> 6) * 2; row0 < NTOK; row0 += (GT >> 6) * 2) {
    f32x4 v[2][4];
    s16x4 zz[2][4];
#pragma unroll
    for (int rr = 0; rr < 2; ++rr) {
      const float* xr = xrow(p, row0 + rr);
      const u16* zr = p.gate() + (size_t)(row0 + rr) * 1024;
#pragma unroll
      for (int i = 0; i < 4; ++i) { v[rr][i] = __builtin_nontemporal_load((const f32x4*)(xr + i * 256 + lane * 4)); zz[rr][i] = __builtin_nontemporal_load((const s16x4*)(zr + i * 256 + lane * 4)); }
    }
    f32x4 g[4];
#pragma unroll
    for (int i = 0; i < 4; ++i) g[i] = *(const f32x4*)(p.final_g + i * 256 + lane * 4);
#pragma unroll
    for (int rr = 0; rr < 2; ++rr) {
      float ss = 0.f;
#pragma unroll
      for (int i = 0; i < 4; ++i) {
#pragma unroll
        for (int j = 0; j < 4; ++j) v[rr][i][j] += __uint_as_float(((unsigned)(u16)zz[rr][i][j]) << 16);
        ss += v[rr][i][0] * v[rr][i][0] + v[rr][i][1] * v[rr][i][1] + v[rr][i][2] * v[rr][i][2] + v[rr][i][3] * v[rr][i][3];
      }
#pragma unroll
      for (int o = 32; o >= 1; o >>= 1) ss += __shfl_xor(ss, o);
      const float rv = rsqrtf(ss * (1.f / 1024.f) + 1e-6f);
      float* y = p.out + OUT_Y + (size_t)(row0 + rr) * 1024;
#pragma unroll
      for (int i = 0; i < 4; ++i) __builtin_nontemporal_store(v[rr][i] * rv * g[i], (f32x4*)(y + i * 256 + lane * 4));
    }
  }
}

static __device__ const u16 idx_tab[1280] = {32, 16, 80, 65535, 65535, 96, 144, 208, 65535, 65535, 160, 272, 336, 65535, 65535, 224, 400, 464, 65535, 65535, 288, 528, 592, 65535, 65535, 352, 656, 720, 65535, 65535, 416, 784, 848, 65535, 65535, 480, 912, 976, 65535, 65535, 544, 1040, 1104, 65535, 65535, 608, 1168, 1232, 65535, 65535, 672, 1296, 1360, 65535, 65535, 736, 1424, 1488, 65535, 65535, 800, 1552, 1616, 65535, 65535, 864, 1680, 1744, 65535, 65535, 928, 1808, 1872, 65535, 65535, 992, 1936, 2000, 65535, 65535, 31, 17, 15, 3, 67, 95, 81, 79, 131, 195, 159, 145, 143, 259, 323, 223, 209, 207, 387, 451, 287, 273, 271, 515, 579, 351, 337, 335, 643, 707, 415, 401, 399, 771, 835, 479, 465, 463, 899, 963, 543, 529, 527, 1027, 1091, 607, 593, 591, 1155, 1219, 671, 657, 655, 1283, 1347, 735, 721, 719, 1411, 1475, 799, 785, 783, 1539, 1603, 863, 849, 847, 1667, 1731, 927, 913, 911, 1795, 1859, 991, 977, 975, 1923, 1987, 1055, 1041, 1039, 65535, 65535, 1119, 1105, 1103, 65535, 65535, 1183, 1169, 1167, 65535, 65535, 1247, 1233, 1231, 65535, 65535, 1311, 1297, 1295, 65535, 65535, 1375, 1361, 1359, 65535, 65535, 1439, 1425, 1423, 65535, 65535, 1503, 1489, 1487, 65535, 65535, 1567, 1553, 1551, 65535, 65535, 1631, 1617, 1615, 65535, 65535, 1695, 1681, 1679, 65535, 65535, 1759, 1745, 1743, 65535, 65535, 1823, 1809, 1807, 65535, 65535, 1887, 1873, 1871, 65535, 65535, 1951, 1937, 1935, 65535, 65535, 2015, 2001, 1999, 65535, 65535, 30, 18, 14, 1, 65, 94, 82, 78, 129, 193, 158, 146, 142, 257, 321, 222, 210, 206, 385, 449, 286, 274, 270, 513, 577, 350, 338, 334, 641, 705, 414, 402, 398, 769, 833, 478, 466, 462, 897, 961, 542, 530, 526, 1025, 1089, 606, 594, 590, 1153, 1217, 670, 658, 654, 1281, 1345, 734, 722, 718, 1409, 1473, 798, 786, 782, 1537, 1601, 862, 850, 846, 1665, 1729, 926, 914, 910, 1793, 1857, 990, 978, 974, 1921, 1985, 1054, 1042, 1038, 2, 66, 1118, 1106, 1102, 130, 194, 1182, 1170, 1166, 258, 322, 1246, 1234, 1230, 386, 450, 1310, 1298, 1294, 514, 578, 1374, 1362, 1358, 642, 706, 1438, 1426, 1422, 770, 834, 1502, 1490, 1486, 898, 962, 1566, 1554, 1550, 1026, 1090, 1630, 1618, 1614, 1154, 1218, 1694, 1682, 1678, 1282, 1346, 1758, 1746, 1742, 1410, 1474, 1822, 1810, 1806, 1538, 1602, 1886, 1874, 1870, 1666, 1730, 1950, 1938, 1934, 1794, 1858, 2014, 2002, 1998, 1922, 1986, 29, 19, 13, 4, 65535, 93, 83, 77, 68, 65535, 157, 147, 141, 132, 65535, 221, 211, 205, 196, 65535, 285, 275, 269, 260, 65535, 349, 339, 333, 324, 65535, 413, 403, 397, 388, 65535, 477, 467, 461, 452, 65535, 541, 531, 525, 516, 65535, 605, 595, 589, 580, 65535, 669, 659, 653, 644, 65535, 733, 723, 717, 708, 65535, 797, 787, 781, 772, 65535, 861, 851, 845, 836, 65535, 925, 915, 909, 900, 65535, 989, 979, 973, 964, 65535, 1053, 1043, 1037, 0, 64, 1117, 1107, 1101, 128, 192, 1181, 1171, 1165, 256, 320, 1245, 1235, 1229, 384, 448, 1309, 1299, 1293, 512, 576, 1373, 1363, 1357, 640, 704, 1437, 1427, 1421, 768, 832, 1501, 1491, 1485, 896, 960, 1565, 1555, 1549, 1024, 1088, 1629, 1619, 1613, 1152, 1216, 1693, 1683, 1677, 1280, 1344, 1757, 1747, 1741, 1408, 1472, 1821, 1811, 1805, 1536, 1600, 1885, 1875, 1869, 1664, 1728, 1949, 1939, 1933, 1792, 1856, 2013, 2003, 1997, 1920, 1984, 28, 20, 12, 5, 65535, 92, 84, 76, 69, 65535, 156, 148, 140, 133, 65535, 220, 212, 204, 197, 65535, 284, 276, 268, 261, 65535, 348, 340, 332, 325, 65535, 412, 404, 396, 389, 65535, 476, 468, 460, 453, 65535, 540, 532, 524, 517, 65535, 604, 596, 588, 581, 65535, 668, 660, 652, 645, 65535, 732, 724, 716, 709, 65535, 796, 788, 780, 773, 65535, 860, 852, 844, 837, 65535, 924, 916, 908, 901, 65535, 988, 980, 972, 965, 65535, 1052, 1044, 1036, 1028, 65535, 1116, 1108, 1100, 1092, 65535, 1180, 1172, 1164, 1156, 65535, 1244, 1236, 1228, 1220, 65535, 1308, 1300, 1292, 1284, 65535, 1372, 1364, 1356, 1348, 65535, 1436, 1428, 1420, 1412, 65535, 1500, 1492, 1484, 1476, 65535, 1564, 1556, 1548, 1540, 65535, 1628, 1620, 1612, 1604, 65535, 1692, 1684, 1676, 1668, 65535, 1756, 1748, 1740, 1732, 65535, 1820, 1812, 1804, 1796, 65535, 1884, 1876, 1868, 1860, 65535, 1948, 1940, 1932, 1924, 65535, 2012, 2004, 1996, 1988, 65535, 27, 21, 11, 6, 65535, 91, 85, 75, 70, 65535, 155, 149, 139, 134, 65535, 219, 213, 203, 198, 65535, 283, 277, 267, 262, 65535, 347, 341, 331, 326, 65535, 411, 405, 395, 390, 65535, 475, 469, 459, 454, 65535, 539, 533, 523, 518, 65535, 603, 597, 587, 582, 65535, 667, 661, 651, 646, 65535, 731, 725, 715, 710, 65535, 795, 789, 779, 774, 65535, 859, 853, 843, 838, 65535, 923, 917, 907, 902, 65535, 987, 981, 971, 966, 65535, 1051, 1045, 1035, 1029, 65535, 1115, 1109, 1099, 1093, 65535, 1179, 1173, 1163, 1157, 65535, 1243, 1237, 1227, 1221, 65535, 1307, 1301, 1291, 1285, 65535, 1371, 1365, 1355, 1349, 65535, 1435, 1429, 1419, 1413, 65535, 1499, 1493, 1483, 1477, 65535, 1563, 1557, 1547, 1541, 65535, 1627, 1621, 1611, 1605, 65535, 1691, 1685, 1675, 1669, 65535, 1755, 1749, 1739, 1733, 65535, 1819, 1813, 1803, 1797, 65535, 1883, 1877, 1867, 1861, 65535, 1947, 1941, 1931, 1925, 65535, 2011, 2005, 1995, 1989, 65535, 26, 22, 10, 7, 65535, 90, 86, 74, 71, 65535, 154, 150, 138, 135, 65535, 218, 214, 202, 199, 65535, 282, 278, 266, 263, 65535, 346, 342, 330, 327, 65535, 410, 406, 394, 391, 65535, 474, 470, 458, 455, 65535, 538, 534, 522, 519, 65535, 602, 598, 586, 583, 65535, 666, 662, 650, 647, 65535, 730, 726, 714, 711, 65535, 794, 790, 778, 775, 65535, 858, 854, 842, 839, 65535, 922, 918, 906, 903, 65535, 986, 982, 970, 967, 65535, 1050, 1046, 1034, 1030, 65535, 1114, 1110, 1098, 1094, 65535, 1178, 1174, 1162, 1158, 65535, 1242, 1238, 1226, 1222, 65535, 1306, 1302, 1290, 1286, 65535, 1370, 1366, 1354, 1350, 65535, 1434, 1430, 1418, 1414, 65535, 1498, 1494, 1482, 1478, 65535, 1562, 1558, 1546, 1542, 65535, 1626, 1622, 1610, 1606, 65535, 1690, 1686, 1674, 1670, 65535, 1754, 1750, 1738, 1734, 65535, 1818, 1814, 1802, 1798, 65535, 1882, 1878, 1866, 1862, 65535, 1946, 1942, 1930, 1926, 65535, 2010, 2006, 1994, 1990, 65535, 25, 23, 9, 8, 65535, 89, 87, 73, 72, 65535, 153, 151, 137, 136, 65535, 217, 215, 201, 200, 65535, 281, 279, 265, 264, 65535, 345, 343, 329, 328, 65535, 409, 407, 393, 392, 65535, 473, 471, 457, 456, 65535, 537, 535, 521, 520, 65535, 601, 599, 585, 584, 65535, 665, 663, 649, 648, 65535, 729, 727, 713, 712, 65535, 793, 791, 777, 776, 65535, 857, 855, 841, 840, 65535, 921, 919, 905, 904, 65535, 985, 983, 969, 968, 65535, 1049, 1047, 1033, 1031, 65535, 1113, 1111, 1097, 1095, 65535, 1177, 1175, 1161, 1159, 65535, 1241, 1239, 1225, 1223, 65535, 1305, 1303, 1289, 1287, 65535, 1369, 1367, 1353, 1351, 65535, 1433, 1431, 1417, 1415, 65535, 1497, 1495, 1481, 1479, 65535, 1561, 1559, 1545, 1543, 65535, 1625, 1623, 1609, 1607, 65535, 1689, 1687, 1673, 1671, 65535, 1753, 1751, 1737, 1735, 65535, 1817, 1815, 1801, 1799, 65535, 1881, 1879, 1865, 1863, 65535, 1945, 1943, 1929, 1927, 65535, 2009, 2007, 1993, 1991, 65535, 24, 88, 1032, 65535, 65535, 152, 216, 1096, 65535, 65535, 280, 344, 1160, 65535, 65535, 408, 472, 1224, 65535, 65535, 536, 600, 1288, 65535, 65535, 664, 728, 1352, 65535, 65535, 792, 856, 1416, 65535, 65535, 920, 984, 1480, 65535, 65535, 1048, 1112, 1544, 65535, 65535, 1176, 1240, 1608, 65535, 65535, 1304, 1368, 1672, 65535, 65535, 1432, 1496, 1736, 65535, 65535, 1560, 1624, 1800, 65535, 65535, 1688, 1752, 1864, 65535, 65535, 1816, 1880, 1928, 65535, 65535, 1944, 2008, 1992, 65535, 65535};

#ifndef REP0
#define REP0 1
#endif
#ifndef REP1
#define REP1 1
#endif
#ifndef REP2
#define REP2 1
#endif
#ifndef REP3
#define REP3 1
#endif
#ifndef REP4
#define REP4 1
#endif
#ifndef REP5
#define REP5 1
#endif
__global__ void __launch_bounds__(512, 2) fwd_megakernel(Params p) {
  __shared__ __attribute__((aligned(16))) unsigned char lds[LDS_BYTES];
  cg::grid_group grid = cg::this_grid();
  const int wave_id = __builtin_amdgcn_readfirstlane((int)threadIdx.x >> 6);
#define FRESH_TID() int tid = wave_id * 64 + lane_id(); asm volatile("" : "+v"(tid)); const int half = tid >> 8, htid = tid & 255; unsigned char* ldsh = lds + half * HALF_LDS; (void)htid; (void)ldsh;
  if (p.out == nullptr) grid.sync();
  if (wave_id == 0 && lane_id() == 0) (void)xb_add(&p.bar()[XB_XCNT(xb_xcc_id())], 1u);
  for (int rep = 0; rep < REP0; ++rep) {
  { FRESH_TID(); phase_prep(p, tid); }
  xcd_barrier(p.bar(), wave_id);
  }
  for (int rep = 0; rep < REP1; ++rep) {
  {
    FRESH_TID();
    pg8::Gemm g; g.A = p.xb(); g.Bt = p.WtIn(); g.M = NTOK; g.N = 4096; g.K = 1024;
    pg8::StaticOrder S; S.init(g.M, g.N, (int)gridDim.x, (int)blockIdx.x); S.permtab = 0xEFBCD87694105A32ull; S.padtile = 15;
    Epi1 E; E.p = p; E.hl0 = (LAS unsigned char*)lds + pg8::STAGE_BYTES;
    pg8::gemm_phase<Epi1>((LAS unsigned char*)lds, g, S, E, wave_id);
  }
  xcd_barrier(p.bar(), wave_id);
  }
  for (int rep = 0; rep < REP2; ++rep) {
  {
    FRESH_TID();
    if (gridDim.x == 256) {
      for (int k = 0; k < 5; ++k) {
        const unsigned ent = idx_tab[blockIdx.x * 5 + k];
        if (ent == 0xFFFFu) continue;
        int ht = htid; asm volatile("" : "+v"(ht));
        const int code = (int)(ent & 63u), pr = (int)(ent >> 6);
        const bool samp = (code == 32);
        const int b = pr >> 1, sub = 2 * (pr & 1) + half;
        idx_item(p, ldsh, ht, samp, b, samp ? sub : code * 4 + sub);
      }
      for (int it0 = blockIdx.x * 2; it0 < 2080; it0 += gridDim.x * 2) {
        int ht = htid; asm volatile("" : "+v"(ht));
        ret_kv_item(p, it0 + half, ht);
      }
    } else
    for (int it0 = blockIdx.x * 2; it0 < 2080 + 2080; it0 += gridDim.x * 2) {
      const int it = it0 + half;
      int ht = htid; asm volatile("" : "+v"(ht));
      if (it < 2080) {
        const bool samp = it < 32;
        const int j = it - 32;
        const int c = 31 - (j >> 6);
        const int b = samp ? (it >> 2) : ((j & 63) >> 2);
        const int grp = samp ? (it & 3) : (c * 4 + (j & 3));
        idx_item(p, ldsh, ht, samp, b, grp);
      } else { for (int rkv = 0; rkv < REPKV; ++rkv) ret_kv_item(p, it - 2080, ht); }
    }
  }
  xcd_barrier(p.bar(), wave_id);
  }
  for (int rep = 0; rep < REP3; ++rep) {
  {
    FRESH_TID();
    for (int it0 = blockIdx.x * 2; it0 < 1056 + 1536; it0 += gridDim.x * 2) {
      const int it = it0 + half;
      int ht = htid; asm volatile("" : "+v"(ht));
      if (it < 1056) {
        bool samp = it < 32;
        const int j = it - 32;
        int c = samp ? 0 : 31 - (j >> 6);
        int b = samp ? (it >> 2) : ((j & 63) >> 2);
        int kvh = (it >> 1) & 1;
        if (gridDim.x == 256) {
          const int blk = (int)blockIdx.x, k = it0 >> 9, x = blk & 7;
          int q;
          samp = false;
          if (blk < 16) { const int s = blk >> 3; c = (k < 2) ? 16 : 17; q = (k < 2) ? s + 2 * k : s; }
          else {
            const int m = (blk - 16) >> 3, cls = m >> 2;
            q = m & 3;
            if (cls < 7) c = (k == 0) ? 31 - cls : 18 + cls;
            else if (k == 0) { samp = true; c = 0; }
            else { c = 17; q += 2; }
          }
          if (samp) { b = x; kvh = q & 1; } else { b = 2 * x + (q & 1); kvh = q >> 1; }
        }
        attn_item(p, ldsh, ht, samp, b, c, kvh, it & 1, lds, tid);
      } else scan_item(p, it - 1056, ht);
    }
  }
  xcd_barrier(p.bar(), wave_id);
  }
  for (int rep = 0; rep < REP4; ++rep) {
  {
    FRESH_TID();
    for (int it0 = blockIdx.x * 2; it0 < 2080 + 1024; it0 += gridDim.x * 2) {
      const int it = it0 + half;
      int ht = htid; asm volatile("" : "+v"(ht));
      if (it < 2080) ret_out_item(p, ldsh, it, ht);
      else {
        const int ia = it - 2080 + 1056;
        const int j = ia - 32;
        int c = 31 - (j >> 6);
        int b = (j & 63) >> 2;
        int kvh = (ia >> 1) & 1;
        if (gridDim.x == 256) {
          const int blk = (int)blockIdx.x, k = it0 >> 9, x = blk & 7;
          int q;
          if (blk < 16) { q = blk >> 3; c = (k == 5) ? 9 : 0; }
          else {
            const int m = (blk - 16) >> 3, cls = m >> 2;
            const bool first = (k == 4);
            q = m & 3;
            if (cls < 6) c = first ? 15 - cls : 1 + cls;
            else if (cls == 6) c = first ? 8 : 7;
            else { c = first ? 9 : 0; q += 2; }
          }
          b = 2 * x + (q & 1); kvh = q >> 1;
        }
        attn_item(p, ldsh, ht, false, b, c, kvh, ia & 1, lds, tid);
      }
    }
  }
  xcd_barrier(p.bar(), wave_id);
  }
  for (int rep = 0; rep < REP5; ++rep) {
  {
    pg8::Gemm g; g.A = p.mix(); g.Bt = p.WtOut(); g.M = NTOK; g.N = 1024; g.K = 1024;
    pg8::StaticOrder S; S.init(g.M, g.N, (int)gridDim.x, (int)blockIdx.x);
    Epi2 E; E.p = p; E.hl = lds + pg8::STAGE_BYTES + (wave_id >> 2) * 16384;
    pg8::gemm_phase<Epi2>((LAS unsigned char*)lds, g, S, E, wave_id);
  }
  xcd_barrier(p.bar(), wave_id);
  }
  { FRESH_TID(); phase_final(p, tid); }
}

extern "C" void kernel_launch(void* const* d_in, const int* in_sizes, int n_in, void* d_out, int out_size, void* d_ws,
                              size_t ws_size, hipStream_t stream) {
  static int grid_blocks = 0;
  if (!grid_blocks) {
    int dev = 0, cus = 0, per_cu = 0;
    (void)hipGetDevice(&dev);
    (void)hipDeviceGetAttribute(&cus, hipDeviceAttributeMultiprocessorCount, dev);
    (void)hipOccupancyMaxActiveBlocksPerMultiprocessor(&per_cu, fwd_megakernel, 512, 0);
    if (per_cu < 1) per_cu = 1;
    if (per_cu > 1) per_cu = 1;
    grid_blocks = cus * per_cu;
  }
  Params p{};
  p.x_p = (const float*)d_in[0]; p.x_s = (const float*)d_in[1]; p.state_ret = (const float*)d_in[2];
  p.cache_k = (const float*)d_in[3]; p.cache_v = (const float*)d_in[4]; p.cache_kidx = (const float*)d_in[5];
  p.norm_g = (const float*)d_in[6]; p.w_in = (const float*)d_in[7]; p.ret_gn_g = (const float*)d_in[8];
  p.w_out = (const float*)d_in[9]; p.final_g = (const float*)d_in[10];
  p.out = (float*)d_out;
  p.ws = (unsigned char*)d_ws;
  (void)hipMemsetAsync((unsigned char*)d_ws + 530573312ull, 0, (size_t)XCD_BAR_WORDS * 4, stream);
  void* args[] = {&p};
  hipError_t e = hipLaunchCooperativeKernel((void*)fwd_megakernel, dim3(grid_blocks), dim3(512), args, 0, stream);
  if (e != hipSuccess) fprintf(stderr, "cooperative launch failed: %s (grid %d)\n", hipGetErrorString(e), grid_blocks);
}
```
